# Optimizing an MI355X kernel written in HIP

```python
import math
import jax, jax.numpy as jnp
from jax import lax
import numpy as np

D_MODEL = 1024
BATCH = 8
SEQ = 2048
DEPTH = 1

NSA_HEADS = 8
NSA_KV_HEADS = 2
NSA_GQA = NSA_HEADS // NSA_KV_HEADS
NSA_HEAD_DIM = 64
NSA_WIDTH = NSA_HEADS * NSA_HEAD_DIM
NSA_KV_W = NSA_KV_HEADS * NSA_HEAD_DIM
CMP_BLOCK = 32
CMP_STRIDE = 16
SEL_BLOCK = 64
SEL_TOP = 16
WINDOW = 512
Q_BLOCK = 128
SEL_Q_CHUNK = 32
SSD_HEADS = 8
SSD_HEAD_DIM = 64
SSD_WIDTH = SSD_HEADS * SSD_HEAD_DIM
SSD_GROUPS = 2
SSD_STATE = 128
SSD_CONV = 4
SSD_CHUNK = 128
SSD_CONV_DIM = SSD_WIDTH + 2 * SSD_GROUPS * SSD_STATE
MIX_WIDTH = NSA_WIDTH + SSD_WIDTH
NSA_COLS = NSA_WIDTH + 6 * NSA_KV_W + 3 * NSA_HEADS
SSD_COLS = SSD_WIDTH + SSD_CONV_DIM + SSD_HEADS
IN_COLS = NSA_COLS + SSD_COLS
N_BUCKETS = 32
MAX_DISTANCE = 128
N_EXPERTS = 32
TOP_K = 4
D_FF = 1024
SWIGLU_LIMIT = 7.0
SWIGLU_ALPHA = 1.702

EPS = 1e-6
NEG_INF = -1e30
FORCED_SCORE = 1e4

kernel_name = "hymba_nsa_ssd_moe_block"


def rms_norm(x, g):
    xf = x.astype(jnp.float32)
    y = xf * lax.rsqrt(jnp.mean(xf * xf, axis=-1, keepdims=True) + EPS)
    return (y * g.astype(jnp.float32)).astype(x.dtype)


def masked_softmax(logits, mask):
    logits = jnp.where(mask, logits.astype(jnp.float32), NEG_INF)
    m = jnp.max(logits, axis=-1, keepdims=True)
    p = jnp.where(mask, jnp.exp(logits - m), 0.0)
    return p / jnp.maximum(jnp.sum(p, axis=-1, keepdims=True), 1e-30)


def t5_bucket(dist):
    n = jnp.maximum(dist, 0)
    max_exact = N_BUCKETS // 2
    nf = jnp.maximum(n, max_exact).astype(jnp.float32)
    large = max_exact + (jnp.log(nf / max_exact) / math.log(MAX_DISTANCE / max_exact)
                         * (N_BUCKETS - max_exact)).astype(jnp.int32)
    large = jnp.minimum(large, N_BUCKETS - 1)
    return jnp.where(n < max_exact, n, large)


def nsa_mixer(q, k_cmp, v_cmp, k_slc, v_slc, k_win, v_win, gates, rel_bias, cmp_pos, cmp_w1, cmp_w2):
    B, S = q.shape[:2]
    HKV, G, Dh = NSA_KV_HEADS, NSA_GQA, NSA_HEAD_DIM
    scale = Dh ** -0.5
    pos = jnp.arange(S)
    f32 = jnp.float32

    n_cmp = (S - CMP_BLOCK) // CMP_STRIDE + 1
    blk_idx = np.arange(n_cmp)[:, None] * CMP_STRIDE + np.arange(CMP_BLOCK)[None, :]

    def compress(t, j):
        blocks = t[:, blk_idx] + cmp_pos[j][None, None, :, None, :]
        blocks = blocks.transpose(0, 1, 3, 2, 4).reshape(B, n_cmp, HKV, CMP_BLOCK * Dh)
        return jax.nn.silu(blocks @ cmp_w1[j]) @ cmp_w2[j]

    kc = compress(k_cmp, 0)
    vc = compress(v_cmp, 1)
    cmp_end = np.arange(n_cmp) * CMP_STRIDE + CMP_BLOCK - 1
    dist_c = pos[:, None] - cmp_end[None, :]
    bias_c = rel_bias[t5_bucket(dist_c)].reshape(S, n_cmp, HKV, G).transpose(2, 3, 0, 1)
    logits_c = jnp.einsum('bskgd,bckd->bkgsc', q, kc, preferred_element_type=f32) * scale + bias_c
    p_c = masked_softmax(logits_c, dist_c >= 0)
    o_cmp = jnp.einsum('bkgsc,bckd->bskgd', p_c, vc).astype(q.dtype)

    n_sel = S // SEL_BLOCK
    c_start = np.arange(n_cmp) * CMP_STRIDE
    s_start = np.arange(n_sel) * SEL_BLOCK
    overlap = ((c_start[:, None] < s_start[None, :] + SEL_BLOCK)
               & (c_start[:, None] + CMP_BLOCK > s_start[None, :])).astype(np.float32)
    imp = jnp.einsum('bkgsc,cn->bksn', p_c, jnp.asarray(overlap))
    blk_of_t = pos // SEL_BLOCK
    sblk = jnp.arange(n_sel)
    forced = (sblk[None, :] == 0) | (sblk[None, :] == blk_of_t[:, None]) | (sblk[None, :] == blk_of_t[:, None] - 1)
    causal_blk = sblk[None, :] <= blk_of_t[:, None]
    score = jnp.where(forced, FORCED_SCORE, jnp.where(causal_blk, imp, -1.0))
    k_eff = min(SEL_TOP, n_sel)
    _, sel_idx = lax.top_k(score, k_eff)

    ks = k_slc.reshape(B, n_sel, SEL_BLOCK, HKV, Dh).transpose(0, 3, 1, 2, 4)
    vs = v_slc.reshape(B, n_sel, SEL_BLOCK, HKV, Dh).transpose(0, 3, 1, 2, 4)
    n_chunk = S // SEL_Q_CHUNK
    q_ch = q.reshape(B, n_chunk, SEL_Q_CHUNK, HKV, G, Dh).transpose(1, 0, 2, 3, 4, 5)
    idx_ch = sel_idx.reshape(B, HKV, n_chunk, SEL_Q_CHUNK, k_eff).transpose(2, 0, 1, 3, 4)
    b_ar = jnp.arange(B)[:, None, None, None]
    h_ar = jnp.arange(HKV)[None, :, None, None]
    h_ar5 = jnp.arange(HKV)[None, :, None, None, None]
    rel_kg = rel_bias.reshape(N_BUCKETS, HKV, G).transpose(1, 0, 2)

    def sel_chunk(args):
        c, qc, ic = args
        t = c * SEL_Q_CHUNK + jnp.arange(SEL_Q_CHUNK)
        kg = ks[b_ar, h_ar, ic]
        vg = vs[b_ar, h_ar, ic]
        key_pos = ic[..., None] * SEL_BLOCK + jnp.arange(SEL_BLOCK)
        dist = t[None, None, :, None, None] - key_pos
        bias = rel_kg[h_ar5, t5_bucket(dist)]
        bias = bias.transpose(0, 1, 5, 2, 3, 4)
        logits = jnp.einsum('bqkgd,bkqnjd->bkgqnj', qc, kg, preferred_element_type=f32) * scale + bias
        n_keys = k_eff * SEL_BLOCK
        logits = logits.reshape(B, HKV, G, SEL_Q_CHUNK, n_keys)
        mask = (dist >= 0).reshape(B, HKV, 1, SEL_Q_CHUNK, n_keys)
        p = masked_softmax(logits, mask)
        return jnp.einsum('bkgqm,bkqmd->bqkgd', p, vg.reshape(B, HKV, SEL_Q_CHUNK, n_keys, Dh)).astype(q.dtype)

    o_slc = lax.map(sel_chunk, (jnp.arange(n_chunk), q_ch, idx_ch))
    o_slc = o_slc.transpose(1, 0, 2, 3, 4, 5).reshape(B, S, HKV, G, Dh)

    n_qb = S // Q_BLOCK
    n_band = WINDOW // Q_BLOCK + 1
    band = n_band * Q_BLOCK
    kw = jnp.pad(k_win, ((0, 0), (WINDOW, 0), (0, 0), (0, 0))).reshape(B, n_qb + WINDOW // Q_BLOCK, Q_BLOCK, HKV, Dh)
    vw = jnp.pad(v_win, ((0, 0), (WINDOW, 0), (0, 0), (0, 0))).reshape(B, n_qb + WINDOW // Q_BLOCK, Q_BLOCK, HKV, Dh)
    q_b = q.reshape(B, n_qb, Q_BLOCK, HKV, G, Dh).transpose(1, 0, 2, 3, 4, 5)
    m_loc = np.arange(band)
    dist_w = np.arange(Q_BLOCK)[:, None] + WINDOW - m_loc[None, :]
    bias_w = rel_bias[t5_bucket(jnp.asarray(dist_w))].reshape(Q_BLOCK, band, HKV, G).transpose(2, 3, 0, 1)
    in_window = jnp.asarray((dist_w >= 0) & (dist_w < WINDOW))

    def win_block(args):
        c, qc = args
        kb = lax.dynamic_slice_in_dim(kw, c, n_band, axis=1).reshape(B, band, HKV, Dh)
        vb = lax.dynamic_slice_in_dim(vw, c, n_band, axis=1).reshape(B, band, HKV, Dh)
        key_pos = c * Q_BLOCK - WINDOW + jnp.arange(band)
        mask = in_window & (key_pos >= 0)[None, :]
        logits = jnp.einsum('bqkgd,bmkd->bkgqm', qc, kb, preferred_element_type=f32) * scale + bias_w
        p = masked_softmax(logits, mask)
        return jnp.einsum('bkgqm,bmkd->bqkgd', p, vb).astype(q.dtype)

    o_win = lax.map(win_block, (jnp.arange(n_qb), q_b))
    o_win = o_win.transpose(1, 0, 2, 3, 4, 5).reshape(B, S, HKV, G, Dh)

    o = (gates[:, :, 0, ..., None] * o_cmp + gates[:, :, 1, ..., None] * o_slc
         + gates[:, :, 2, ..., None] * o_win)
    return o.reshape(B, S, NSA_WIDTH)


def ssd_mixer(z, xbc, dt_raw, conv_w, conv_b, dt_bias, a_log, d_skip, norm_g):
    B, S, _ = xbc.shape
    H, P, N, Gr, L = SSD_HEADS, SSD_HEAD_DIM, SSD_STATE, SSD_GROUPS, SSD_CHUNK
    f32 = jnp.float32
    xpad = jnp.pad(xbc, ((0, 0), (SSD_CONV - 1, 0), (0, 0)))
    conv = conv_b
    for k in range(SSD_CONV):
        conv = conv + xpad[:, k:k + S] * conv_w[k]
    xbc = jax.nn.silu(conv)
    xs = xbc[..., :SSD_WIDTH].reshape(B, S, H, P)
    Bm = xbc[..., SSD_WIDTH:SSD_WIDTH + Gr * N].reshape(B, S, Gr, N)
    Cm = xbc[..., SSD_WIDTH + Gr * N:].reshape(B, S, Gr, N)
    Bh = jnp.repeat(Bm, H // Gr, axis=2).astype(f32)
    Ch = jnp.repeat(Cm, H // Gr, axis=2).astype(f32)
    dt = jax.nn.softplus((dt_raw + dt_bias).astype(f32))
    A = -jnp.exp(a_log.astype(f32))
    nc = S // L
    xc = (xs.astype(f32) * dt[..., None]).reshape(B, nc, L, H, P)
    Bc = Bh.reshape(B, nc, L, H, N)
    Cc = Ch.reshape(B, nc, L, H, N)
    a_cs = jnp.cumsum((dt * A).reshape(B, nc, L, H).transpose(0, 3, 1, 2), axis=-1)
    causal = np.tril(np.ones((L, L), dtype=bool))
    decay_ls = jnp.exp(jnp.where(causal, a_cs[..., :, None] - a_cs[..., None, :], NEG_INF))
    scores = jnp.einsum('bclhn,bcshn->bhcls', Cc, Bc) * decay_ls
    y_diag = jnp.einsum('bhcls,bcshp->bclhp', scores, xc)
    decay_states = jnp.exp(a_cs[..., -1:] - a_cs).transpose(0, 2, 3, 1)
    states = jnp.einsum('bclhn,bclhp->bchpn', Bc * decay_states[..., None], xc)
    chunk_decay = jnp.exp(a_cs[..., -1])

    def step(h, inp):
        s_c, d_c = inp
        return d_c[..., None, None] * h + s_c, h

    h0 = jnp.zeros((B, H, P, N), f32)
    _, prev = lax.scan(step, h0, (states.transpose(1, 0, 2, 3, 4), chunk_decay.transpose(2, 0, 1)))
    prev = prev.transpose(1, 0, 2, 3, 4)
    decay_in = jnp.exp(a_cs).transpose(0, 2, 3, 1)
    y_off = jnp.einsum('bclhn,bchpn->bclhp', Cc * decay_in[..., None], prev)
    y = (y_diag + y_off).reshape(B, S, H, P) + xs.astype(f32) * d_skip.astype(f32)[:, None]
    y = y.reshape(B, S, SSD_WIDTH) * jax.nn.silu(z.astype(f32))
    y = rms_norm(y.reshape(B, S, Gr, SSD_WIDTH // Gr), norm_g.reshape(Gr, SSD_WIDTH // Gr))
    return y.reshape(B, S, SSD_WIDTH).astype(z.dtype)


def moe_ffn(h, router_w, router_b, w_gate_up, b_gate_up, w_down, b_down):
    B, S, D = h.shape
    xt = h.reshape(B * S, D)
    logits = (xt @ router_w + router_b).astype(jnp.float32)
    top_v, top_i = lax.top_k(logits, TOP_K)
    top_w = jax.nn.softmax(top_v, axis=-1)
    combine = jnp.sum(jax.nn.one_hot(top_i, N_EXPERTS, dtype=jnp.float32) * top_w[..., None], axis=1)
    out = jnp.zeros((B * S, D), jnp.float32)
    for e in range(N_EXPERTS):
        gu = xt @ w_gate_up[e] + b_gate_up[e]
        gate = jnp.minimum(gu[:, :D_FF], SWIGLU_LIMIT)
        up = jnp.clip(gu[:, D_FF:], -SWIGLU_LIMIT, SWIGLU_LIMIT)
        act = (up + 1.0) * gate * jax.nn.sigmoid(SWIGLU_ALPHA * gate)
        out = out + combine[:, e:e + 1] * (act @ w_down[e] + b_down[e])
    return out.astype(h.dtype).reshape(B, S, D)


def setup_inputs(seed: int = 0) -> dict:
    key = jax.random.key(seed)
    ks = jax.random.split(key, 24)
    f32 = jnp.float32
    nrm = lambda k, shape, s: jax.random.normal(k, shape, f32) * s
    gain = lambda k, shape: 1.0 + 0.01 * jax.random.normal(k, shape, f32)
    dt0 = jnp.exp(jax.random.uniform(ks[10], (DEPTH, SSD_HEADS), f32, math.log(1e-3), math.log(1e-1)))
    return {
        "x": nrm(ks[0], (BATCH, SEQ, D_MODEL), 1.0),
        "attn_norm": gain(ks[1], (DEPTH, D_MODEL)),
        "w_in": nrm(ks[2], (DEPTH, D_MODEL, IN_COLS), D_MODEL ** -0.5),
        "rel_bias": nrm(ks[3], (N_BUCKETS, NSA_HEADS), 0.2),
        "cmp_pos": nrm(ks[4], (DEPTH, 2, CMP_BLOCK, NSA_HEAD_DIM), 0.1),
        "cmp_w1": nrm(ks[5], (DEPTH, 2, CMP_BLOCK * NSA_HEAD_DIM, NSA_HEAD_DIM), (CMP_BLOCK * NSA_HEAD_DIM) ** -0.5),
        "cmp_w2": nrm(ks[6], (DEPTH, 2, NSA_HEAD_DIM, NSA_HEAD_DIM), NSA_HEAD_DIM ** -0.5),
        "attn_out_norm": gain(ks[7], (DEPTH, NSA_WIDTH)),
        "conv_w": nrm(ks[8], (DEPTH, SSD_CONV, SSD_CONV_DIM), SSD_CONV ** -0.5),
        "conv_b": nrm(ks[9], (DEPTH, SSD_CONV_DIM), 0.01),
        "dt_bias": dt0 + jnp.log(-jnp.expm1(-dt0)),
        "a_log": jnp.log(jax.random.uniform(ks[11], (DEPTH, SSD_HEADS), f32, 1.0, 16.0)),
        "d_skip": gain(ks[12], (DEPTH, SSD_HEADS)),
        "ssm_out_norm": gain(ks[13], (DEPTH, SSD_WIDTH)),
        "w_out": nrm(ks[14], (DEPTH, MIX_WIDTH, D_MODEL), MIX_WIDTH ** -0.5),
        "ffn_norm": gain(ks[15], (DEPTH, D_MODEL)),
        "router_w": nrm(ks[16], (DEPTH, D_MODEL, N_EXPERTS), D_MODEL ** -0.5),
        "router_b": nrm(ks[17], (DEPTH, N_EXPERTS), 0.01),
        "w_gate_up": nrm(ks[18], (DEPTH, N_EXPERTS, D_MODEL, 2 * D_FF), D_MODEL ** -0.5),
        "b_gate_up": nrm(ks[19], (DEPTH, N_EXPERTS, 2 * D_FF), 0.01),
        "w_down": nrm(ks[20], (DEPTH, N_EXPERTS, D_FF, D_MODEL), D_FF ** -0.5),
        "b_down": nrm(ks[21], (DEPTH, N_EXPERTS, D_MODEL), 0.01),
        "final_norm": gain(ks[22], (D_MODEL,)),
    }


def reference(x, attn_norm, w_in, rel_bias, cmp_pos, cmp_w1, cmp_w2, attn_out_norm, conv_w, conv_b,
              dt_bias, a_log, d_skip, ssm_out_norm, w_out, ffn_norm, router_w, router_b,
              w_gate_up, b_gate_up, w_down, b_down, final_norm):
    B, S, _ = x.shape
    HKV, G, Dh = NSA_KV_HEADS, NSA_GQA, NSA_HEAD_DIM
    h = x
    for l in range(DEPTH):
        xn = rms_norm(h, attn_norm[l])
        proj = xn @ w_in[l]
        nsa_p = proj[..., :NSA_COLS]
        ssd_p = proj[..., NSA_COLS:]
        q = nsa_p[..., :NSA_WIDTH].reshape(B, S, HKV, G, Dh)
        kv = nsa_p[..., NSA_WIDTH:NSA_WIDTH + 6 * NSA_KV_W].reshape(B, S, 6, HKV, Dh)
        gates = jax.nn.sigmoid(nsa_p[..., NSA_WIDTH + 6 * NSA_KV_W:].reshape(B, S, 3, HKV, G))
        o_nsa = nsa_mixer(q, kv[:, :, 0], kv[:, :, 1], kv[:, :, 2], kv[:, :, 3], kv[:, :, 4], kv[:, :, 5],
                          gates, rel_bias, cmp_pos[l], cmp_w1[l], cmp_w2[l])
        o_nsa = rms_norm(o_nsa, attn_out_norm[l])
        z = ssd_p[..., :SSD_WIDTH]
        xbc = ssd_p[..., SSD_WIDTH:SSD_WIDTH + SSD_CONV_DIM]
        dt_raw = ssd_p[..., SSD_WIDTH + SSD_CONV_DIM:]
        o_ssd = ssd_mixer(z, xbc, dt_raw, conv_w[l], conv_b[l], dt_bias[l], a_log[l], d_skip[l], ssm_out_norm[l])
        h = h + jnp.concatenate([o_nsa, o_ssd], axis=-1) @ w_out[l]
        h = h + moe_ffn(rms_norm(h, ffn_norm[l]), router_w[l], router_b[l], w_gate_up[l], b_gate_up[l],
                        w_down[l], b_down[l])
    return rms_norm(h, final_norm)
```

```cpp
#include <hip/hip_runtime.h>
#include <stdint.h>
#include <math.h>

namespace nv {
constexpr int NB = 8, S = 2048, D = 1024, T = NB * S;
constexpr int INC = 2848;
constexpr int KVOFF = 512, GOFF = 1280, ZOFF = 1304, XBCOFF = 1816, DTOFF = 2840;
constexpr int NCMP = 127, NE = 32;
constexpr float EPS = 1e-6f;

__device__ __forceinline__ float wave_sum(float v) { for (int o = 32; o >= 1; o >>= 1) v += __shfl_xor(v, o); return v; }
__device__ __forceinline__ float wave_max(float v) { for (int o = 32; o >= 1; o >>= 1) v = fmaxf(v, __shfl_xor(v, o)); return v; }
__device__ __forceinline__ float siluf(float x) { return x / (1.f + expf(-x)); }
__device__ __forceinline__ float sigmf(float x) { return 1.f / (1.f + expf(-x)); }
__device__ __forceinline__ int t5_bucket(int n) {
    if (n < 0) n = 0;
    if (n < 16) return n;
    float nf = (float)n;
    int l = 16 + (int)(logf(nf / 16.f) / 2.0794415416798357f * 16.f);
    return l < 31 ? l : 31;
}

__global__ __launch_bounds__(256) void k_rmsnorm(const float* in, int ldi, const float* g, float* out, int ldo, int ng, int Dn) {
    __shared__ float red[4];
    const int r = blockIdx.x; const float* xr = in + (size_t)r * ldi;
    float s = 0.f; for (int i = threadIdx.x; i < Dn; i += 256) { float v = xr[i]; s += v * v; }
    s = wave_sum(s); if ((threadIdx.x & 63) == 0) red[threadIdx.x >> 6] = s; __syncthreads();
    s = red[0] + red[1] + red[2] + red[3];
    const float rs = rsqrtf(s / (float)Dn + EPS);
    float* o = out + (size_t)(r / ng) * ldo + (size_t)(r % ng) * Dn; const float* gg = g + (size_t)(r % ng) * Dn;
    for (int i = threadIdx.x; i < Dn; i += 256) o[i] = xr[i] * rs * gg[i];
}

template <bool DUAL, class AF, class BF, class EF, class MF>
__global__ __launch_bounds__(256) void k_gemm(AF af, BF bf, EF ef, MF mf, int N, int K) {
    __shared__ float sA[16][65]; __shared__ float sB[16][65]; __shared__ float sB2[16][65];
    const int z = blockIdx.z, M = mf(z);
    const int m0 = blockIdx.y * 64, n0 = blockIdx.x * 64;
    if (m0 >= M) return;
    const int tx = threadIdx.x & 15, ty = threadIdx.x >> 4;
    float acc[4][4], acc2[4][4];
#pragma unroll
    for (int i = 0; i < 4; ++i)
#pragma unroll
        for (int j = 0; j < 4; ++j) { acc[i][j] = 0.f; acc2[i][j] = 0.f; }
    for (int k0 = 0; k0 < K; k0 += 16) {
#pragma unroll
        for (int i = 0; i < 4; ++i) { int e = threadIdx.x + i * 256; int m = e >> 4, k = e & 15; sA[k][m] = (m0 + m < M) ? af(z, m0 + m, k0 + k) : 0.f; }
#pragma unroll
        for (int i = 0; i < 4; ++i) { int e = threadIdx.x + i * 256; int k = e >> 6, n = e & 63; sB[k][n] = (n0 + n < N) ? bf(z, k0 + k, n0 + n) : 0.f;
            if (DUAL) sB2[k][n] = (n0 + n < N) ? bf(z, k0 + k, n0 + n + N) : 0.f; }
        __syncthreads();
#pragma unroll
        for (int k = 0; k < 16; ++k) {
            float a[4], b[4], b2[4];
#pragma unroll
            for (int i = 0; i < 4; ++i) { a[i] = sA[k][ty * 4 + i]; b[i] = sB[k][tx * 4 + i]; b2[i] = DUAL ? sB2[k][tx * 4 + i] : 0.f; }
#pragma unroll
            for (int i = 0; i < 4; ++i)
#pragma unroll
                for (int j = 0; j < 4; ++j) { acc[i][j] += a[i] * b[j]; if (DUAL) acc2[i][j] += a[i] * b2[j]; }
        }
        __syncthreads();
    }
#pragma unroll
    for (int i = 0; i < 4; ++i)
#pragma unroll
        for (int j = 0; j < 4; ++j) { int m = m0 + ty * 4 + i, n = n0 + tx * 4 + j; if (m < M && n < N) ef(z, m, n, acc[i][j], acc2[i][j]); }
}
struct MConst { int M; int pad; __device__ int operator()(int) const { return M; } };
struct MCnt { const int* cnt; __device__ int operator()(int z) const { return cnt[z]; } };
struct ARow { const float* A; int lda; int pad; __device__ float operator()(int, int m, int k) const { return A[(size_t)m * lda + k]; } };
struct BRow { const float* B; int ldb; int pad; __device__ float operator()(int, int k, int n) const { return B[(size_t)k * ldb + n]; } };
struct EStore { float* C; int ldc; int pad; __device__ void operator()(int, int m, int n, float a, float) const { C[(size_t)m * ldc + n] = a; } };
struct EResid { const float* R; float* C; int ldc; int pad; __device__ void operator()(int, int m, int n, float a, float) const { C[(size_t)m * ldc + n] = R[(size_t)m * ldc + n] + a; } };
struct EBias { const float* bias; float* C; int ldc; int pad; __device__ void operator()(int, int m, int n, float a, float) const { C[(size_t)m * ldc + n] = a + bias[n]; } };
struct ACmp { const float* proj; const float* pos; __device__ float operator()(int z, int m, int k) const {
    int kvh = m & 1, bc = m >> 1, c = bc % NCMP, b = bc / NCMP, l = k >> 6, d = k & 63;
    return proj[(size_t)(b * S + c * 16 + l) * INC + KVOFF + z * 128 + kvh * 64 + d] + pos[(z * 32 + l) * 64 + d]; } };
struct BCmp1 { const float* w; __device__ float operator()(int z, int k, int n) const { return w[((size_t)z * 2048 + k) * 64 + n]; } };
struct ECmp1 { float* hid; __device__ void operator()(int z, int m, int n, float a, float) const { hid[((size_t)z * (NB * NCMP * 2) + m) * 64 + n] = siluf(a); } };
struct ACmp2 { const float* hid; __device__ float operator()(int z, int m, int k) const { return hid[((size_t)z * (NB * NCMP * 2) + m) * 64 + k]; } };
struct BCmp2 { const float* w; __device__ float operator()(int z, int k, int n) const { return w[((size_t)z * 64 + k) * 64 + n]; } };
struct ECmp2 { float* kvc; __device__ void operator()(int z, int m, int n, float a, float) const { kvc[((size_t)z * (NB * NCMP * 2) + m) * 64 + n] = a; } };
struct AMoe1 { const float* hn; const int* list; __device__ float operator()(int z, int m, int k) const { int tk = list[(size_t)z * T + m]; return hn[(size_t)(tk >> 2) * D + k]; } };
struct BMoe1 { const float* w; __device__ float operator()(int z, int k, int n) const { return w[((size_t)z * 1024 + k) * 2048 + n]; } };
struct EMoe1 { const float* bias; const int* list; float* act; __device__ void operator()(int z, int m, int n, float a, float a2) const {
    int tk = list[(size_t)z * T + m]; float g = a + bias[z * 2048 + n], u = a2 + bias[z * 2048 + 1024 + n];
    g = fminf(g, 7.f); u = fminf(fmaxf(u, -7.f), 7.f);
    act[(size_t)tk * 1024 + n] = (u + 1.f) * g * sigmf(1.702f * g); } };
struct AMoe2 { const float* act; const int* list; __device__ float operator()(int z, int m, int k) const { int tk = list[(size_t)z * T + m]; return act[(size_t)tk * 1024 + k]; } };
struct BMoe2 { const float* w; __device__ float operator()(int z, int k, int n) const { return w[((size_t)z * 1024 + k) * 1024 + n]; } };
struct EMoe2 { const float* bias; const int* list; float* y; __device__ void operator()(int z, int m, int n, float a, float) const {
    int tk = list[(size_t)z * T + m]; y[(size_t)tk * 1024 + n] = a + bias[z * 1024 + n]; } };

__global__ __launch_bounds__(256) void k_nsa(const float* proj, const float* kc, const float* vc, const float* rel_bias, float* o_nsa) {
    __shared__ float q_s[4][64]; __shared__ float pc[4][128]; __shared__ float lg[4][1024];
    __shared__ float score_s[32]; __shared__ int sellist[32]; __shared__ int nsel_s;
    const int row = blockIdx.x, kvh = blockIdx.y, b = row / S, t = row % S;
    const int g = threadIdx.x >> 6, i = threadIdx.x & 63, head = kvh * 4 + g, blk = t >> 6;
    const float* pr = proj + (size_t)row * INC;
    q_s[g][i] = pr[head * 64 + i];
    __syncthreads();
    const int nvalid = (t >= 31) ? ((t - 31) / 16 + 1) : 0;
    float lv[2]; float mx = -1e30f;
#pragma unroll
    for (int r = 0; r < 2; ++r) { int c = i + r * 64; float l = -1e30f;
        if (c < nvalid) { const float* kr = kc + ((size_t)(b * NCMP + c) * 2 + kvh) * 64; float s = 0.f; for (int d = 0; d < 64; ++d) s += q_s[g][d] * kr[d];
            l = s * 0.125f + rel_bias[t5_bucket(t - (c * 16 + 31)) * 8 + head]; }
        lv[r] = l; mx = fmaxf(mx, l); }
    mx = wave_max(mx);
    float sm = 0.f;
#pragma unroll
    for (int r = 0; r < 2; ++r) { int c = i + r * 64; float p = (c < nvalid) ? expf(lv[r] - mx) : 0.f; lv[r] = p; sm += p; }
    sm = wave_sum(sm); const float inv = 1.f / fmaxf(sm, 1e-30f);
#pragma unroll
    for (int r = 0; r < 2; ++r) pc[g][i + r * 64] = lv[r] * inv;
    __syncthreads();
    float o_cmp = 0.f;
    for (int c = 0; c < nvalid; ++c) o_cmp += pc[g][c] * vc[((size_t)(b * NCMP + c) * 2 + kvh) * 64 + i];
    if (threadIdx.x < 32) { int n = threadIdx.x; float im = 0.f;
        for (int gg = 0; gg < 4; ++gg) for (int c = 4 * n - 1; c <= 4 * n + 3; ++c) if (c >= 0 && c < NCMP) im += pc[gg][c];
        bool forced = (n == 0) || (n == blk) || (n == blk - 1);
        score_s[n] = forced ? 1e4f : ((n <= blk) ? im : -1.f); }
    __syncthreads();
    if (threadIdx.x == 0) { int ns = 0;
        for (int n = 0; n < 32; ++n) { float sn = score_s[n]; int rank = 0; for (int m = 0; m < 32; ++m) { float s2 = score_s[m]; if (s2 > sn || (s2 == sn && m < n)) ++rank; }
            if (rank < 16 && n <= blk) sellist[ns++] = n; }
        nsel_s = ns; }
    __syncthreads();
    const int nsel = nsel_s;
    float o_slc = 0.f;
    { const int nk = nsel * 64; float m2 = -1e30f;
      for (int kk = i; kk < nk; kk += 64) { int kp = sellist[kk >> 6] * 64 + (kk & 63); float l = -1e30f;
          if (kp <= t) { const float* kr = proj + (size_t)(b * S + kp) * INC + KVOFF + 2 * 128 + kvh * 64; float s = 0.f; for (int d = 0; d < 64; ++d) s += q_s[g][d] * kr[d];
              l = s * 0.125f + rel_bias[t5_bucket(t - kp) * 8 + head]; }
          lg[g][kk] = l; m2 = fmaxf(m2, l); }
      m2 = wave_max(m2); float s2 = 0.f;
      for (int kk = i; kk < nk; kk += 64) { int kp = sellist[kk >> 6] * 64 + (kk & 63); float p = (kp <= t) ? expf(lg[g][kk] - m2) : 0.f; lg[g][kk] = p; s2 += p; }
      s2 = wave_sum(s2); const float inv2 = 1.f / fmaxf(s2, 1e-30f);
      __syncthreads();
      for (int kk = 0; kk < nk; ++kk) { int kp = sellist[kk >> 6] * 64 + (kk & 63); if (kp <= t) o_slc += lg[g][kk] * proj[(size_t)(b * S + kp) * INC + KVOFF + 3 * 128 + kvh * 64 + i]; }
      o_slc *= inv2; }
    __syncthreads();
    float o_win = 0.f;
    { float m2 = -1e30f;
      for (int kk = i; kk < 512; kk += 64) { int kp = t - 511 + kk; float l = -1e30f;
          if (kp >= 0) { const float* kr = proj + (size_t)(b * S + kp) * INC + KVOFF + 4 * 128 + kvh * 64; float s = 0.f; for (int d = 0; d < 64; ++d) s += q_s[g][d] * kr[d];
              l = s * 0.125f + rel_bias[t5_bucket(t - kp) * 8 + head]; }
          lg[g][kk] = l; m2 = fmaxf(m2, l); }
      m2 = wave_max(m2); float s2 = 0.f;
      for (int kk = i; kk < 512; kk += 64) { int kp = t - 511 + kk; float p = (kp >= 0) ? expf(lg[g][kk] - m2) : 0.f; lg[g][kk] = p; s2 += p; }
      s2 = wave_sum(s2); const float inv2 = 1.f / fmaxf(s2, 1e-30f);
      __syncthreads();
      for (int kk = 0; kk < 512; ++kk) { int kp = t - 511 + kk; if (kp >= 0) o_win += lg[g][kk] * proj[(size_t)(b * S + kp) * INC + KVOFF + 5 * 128 + kvh * 64 + i]; }
      o_win *= inv2; }
    const float g0 = sigmf(pr[GOFF + 0 * 8 + head]), g1 = sigmf(pr[GOFF + 1 * 8 + head]), g2 = sigmf(pr[GOFF + 2 * 8 + head]);
    o_nsa[(size_t)row * 512 + head * 64 + i] = g0 * o_cmp + g1 * o_slc + g2 * o_win;
}

__global__ __launch_bounds__(256) void k_ssd_conv(const float* proj, const float* conv_w, const float* conv_b, const float* dt_bias, float* convx, float* dtv) {
    const int row = blockIdx.x, s = row % S;
    for (int ch = threadIdx.x; ch < 1024; ch += 256) { float a = conv_b[ch];
#pragma unroll
        for (int k = 0; k < 4; ++k) { int ss = s - 3 + k; if (ss >= 0) a += proj[(size_t)(row - 3 + k) * INC + XBCOFF + ch] * conv_w[k * 1024 + ch]; }
        convx[(size_t)row * 1024 + ch] = siluf(a); }
    if (threadIdx.x < 8) { float x = proj[(size_t)row * INC + DTOFF + threadIdx.x] + dt_bias[threadIdx.x]; dtv[row * 8 + threadIdx.x] = (x > 20.f) ? x : log1pf(expf(x)); }
}
__global__ __launch_bounds__(256) void k_ssd_scan(const float* proj, const float* convx, const float* dtv, const float* a_log, const float* d_skip, float* yssd) {
    const int b = blockIdx.x >> 3, h = blockIdx.x & 7, grp = h >> 2, p = threadIdx.x >> 2, nq = threadIdx.x & 3;
    const float A = -expf(a_log[h]), Dh = d_skip[h];
    float st[32];
#pragma unroll
    for (int j = 0; j < 32; ++j) st[j] = 0.f;
    for (int s = 0; s < S; ++s) { const size_t row = (size_t)b * S + s; const float* cx = convx + row * 1024;
        const float dt = dtv[row * 8 + h], xv = cx[h * 64 + p], dA = expf(dt * A), dx = dt * xv;
        const float* Bn = cx + 512 + grp * 128 + nq * 32; const float* Cn = cx + 768 + grp * 128 + nq * 32;
        float y = 0.f;
#pragma unroll
        for (int j = 0; j < 32; ++j) { st[j] = dA * st[j] + dx * Bn[j]; y += Cn[j] * st[j]; }
        y += __shfl_xor(y, 1); y += __shfl_xor(y, 2);
        if (nq == 0) { float z = proj[row * INC + ZOFF + h * 64 + p]; yssd[row * 512 + h * 64 + p] = (y + Dh * xv) * siluf(z); } }
}
__global__ __launch_bounds__(256) void k_route(const float* logits, int* cnt, int* list, float* topw) {
    const int t = blockIdx.x * 256 + threadIdx.x; if (t >= T) return;
    const float* lr = logits + (size_t)t * NE; unsigned used = 0u; float tv[4]; int ti[4];
#pragma unroll
    for (int k = 0; k < 4; ++k) { float best = -INFINITY; int bi = 0;
        for (int e = 0; e < NE; ++e) { float v = lr[e]; if (!((used >> e) & 1u) && v > best) { best = v; bi = e; } }
        used |= 1u << bi; tv[k] = best; ti[k] = bi; }
    float m = tv[0], sum = 0.f, w[4];
#pragma unroll
    for (int k = 0; k < 4; ++k) { w[k] = expf(tv[k] - m); sum += w[k]; }
#pragma unroll
    for (int k = 0; k < 4; ++k) { topw[t * 4 + k] = w[k] / sum; int pos = atomicAdd(&cnt[ti[k]], 1); list[(size_t)ti[k] * T + pos] = t * 4 + k; }
}
__global__ __launch_bounds__(256) void k_combine(const float* h1, const float* y, const float* topw, const float* g, float* out) {
    __shared__ float red[4];
    const int t = blockIdx.x; float v[4]; float s = 0.f;
#pragma unroll
    for (int r = 0; r < 4; ++r) { int i = threadIdx.x + r * 256; float a = h1[(size_t)t * D + i];
#pragma unroll
        for (int k = 0; k < 4; ++k) a += topw[t * 4 + k] * y[(size_t)(t * 4 + k) * D + i];
        v[r] = a; s += a * a; }
    s = wave_sum(s); if ((threadIdx.x & 63) == 0) red[threadIdx.x >> 6] = s; __syncthreads();
    s = red[0] + red[1] + red[2] + red[3]; const float rs = rsqrtf(s / (float)D + EPS);
#pragma unroll
    for (int r = 0; r < 4; ++r) { int i = threadIdx.x + r * 256; out[(size_t)t * D + i] = v[r] * rs * g[i]; }
}
}

extern "C" void kernel_launch(void* const* d_in, const int* in_sizes, int n_in, void* d_out, int out_size, void* d_ws, size_t ws_size, hipStream_t stream) {
    using namespace nv;
    const float* x = (const float*)d_in[0]; const float* attn_norm = (const float*)d_in[1]; const float* w_in = (const float*)d_in[2];
    const float* rel_bias = (const float*)d_in[3]; const float* cmp_pos = (const float*)d_in[4]; const float* cmp_w1 = (const float*)d_in[5];
    const float* cmp_w2 = (const float*)d_in[6]; const float* attn_out_norm = (const float*)d_in[7]; const float* conv_w = (const float*)d_in[8];
    const float* conv_b = (const float*)d_in[9]; const float* dt_bias = (const float*)d_in[10]; const float* a_log = (const float*)d_in[11];
    const float* d_skip = (const float*)d_in[12]; const float* ssm_out_norm = (const float*)d_in[13]; const float* w_out = (const float*)d_in[14];
    const float* ffn_norm = (const float*)d_in[15]; const float* router_w = (const float*)d_in[16]; const float* router_b = (const float*)d_in[17];
    const float* w_gu = (const float*)d_in[18]; const float* b_gu = (const float*)d_in[19]; const float* w_dn = (const float*)d_in[20];
    const float* b_dn = (const float*)d_in[21]; const float* final_norm = (const float*)d_in[22];
    float* out = (float*)d_out;
    char* ws = (char*)d_ws; const size_t MB = 1u << 20;
    float* xn = (float*)(ws);
    float* proj = (float*)(ws + 64 * MB);
    float* convx = (float*)(ws + 244 * MB);
    float* o_nsa = (float*)(ws + 308 * MB);
    float* yssd = (float*)(ws + 340 * MB);
    float* cat = (float*)(ws + 372 * MB);
    float* hid = (float*)(ws + 436 * MB);
    float* kvc = (float*)(ws + 438 * MB);
    float* dtv = (float*)(ws + 440 * MB);
    float* act = (float*)(ws);
    float* ymoe = (float*)(ws + 256 * MB);
    float* h1 = (float*)(ws + 536 * MB);
    float* hn = (float*)(ws + 600 * MB);
    float* rlog = (float*)(ws + 664 * MB);
    float* topw = (float*)(ws + 666 * MB);
    int* list = (int*)(ws + 667 * MB);
    int* cnt = (int*)(ws + 669 * MB);
    (void)hipMemsetAsync(cnt, 0, 256, stream);

    k_rmsnorm<<<T, 256, 0, stream>>>(x, D, attn_norm, xn, D, 1, D);
    k_gemm<false><<<dim3((INC + 63) / 64, T / 64, 1), 256, 0, stream>>>(ARow{xn, D, 0}, BRow{w_in, INC, 0}, EStore{proj, INC, 0}, MConst{T, 0}, INC, D);
    const int MC = NB * NCMP * 2;
    k_gemm<false><<<dim3(1, (MC + 63) / 64, 2), 256, 0, stream>>>(ACmp{proj, cmp_pos}, BCmp1{cmp_w1}, ECmp1{hid}, MConst{MC, 0}, 64, 2048);
    k_gemm<false><<<dim3(1, (MC + 63) / 64, 2), 256, 0, stream>>>(ACmp2{hid}, BCmp2{cmp_w2}, ECmp2{kvc}, MConst{MC, 0}, 64, 64);
    k_nsa<<<dim3(T, 2), 256, 0, stream>>>(proj, kvc, kvc + (size_t)MC * 64, rel_bias, o_nsa);
    k_rmsnorm<<<T, 256, 0, stream>>>(o_nsa, 512, attn_out_norm, cat, D, 1, 512);
    k_ssd_conv<<<T, 256, 0, stream>>>(proj, conv_w, conv_b, dt_bias, convx, dtv);
    k_ssd_scan<<<NB * 8, 256, 0, stream>>>(proj, convx, dtv, a_log, d_skip, yssd);
    k_rmsnorm<<<T * 2, 256, 0, stream>>>(yssd, 256, ssm_out_norm, cat + 512, D, 2, 256);
    k_gemm<false><<<dim3(D / 64, T / 64, 1), 256, 0, stream>>>(ARow{cat, D, 0}, BRow{w_out, D, 0}, EResid{x, h1, D, 0}, MConst{T, 0}, D, D);
    k_rmsnorm<<<T, 256, 0, stream>>>(h1, D, ffn_norm, hn, D, 1, D);
    k_gemm<false><<<dim3(1, T / 64, 1), 256, 0, stream>>>(ARow{hn, D, 0}, BRow{router_w, NE, 0}, EBias{router_b, rlog, NE, 0}, MConst{T, 0}, NE, D);
    k_route<<<T / 256, 256, 0, stream>>>(rlog, cnt, list, topw);
    k_gemm<true><<<dim3(1024 / 64, T / 64, NE), 256, 0, stream>>>(AMoe1{hn, list}, BMoe1{w_gu}, EMoe1{b_gu, list, act}, MCnt{cnt}, 1024, D);
    k_gemm<false><<<dim3(1024 / 64, T / 64, NE), 256, 0, stream>>>(AMoe2{act, list}, BMoe2{w_dn}, EMoe2{b_dn, list, ymoe}, MCnt{cnt}, 1024, 1024);
    k_combine<<<T, 256, 0, stream>>>(h1, ymoe, topw, final_norm, out);
}
```

```cpp
#include <hip/hip_runtime.h>
#include <stdint.h>
#include <math.h>

namespace nv {
constexpr int NB = 8, S = 2048, D = 1024, T = NB * S;
constexpr int INC = 2848;
constexpr int KVOFF = 512, GOFF = 1280, ZOFF = 1304, XBCOFF = 1816, DTOFF = 2840;
constexpr int NCMP = 127, NE = 32;
constexpr float EPS = 1e-6f;

__device__ __forceinline__ float wave_sum(float v) { for (int o = 32; o >= 1; o >>= 1) v += __shfl_xor(v, o); return v; }
__device__ __forceinline__ float wave_max(float v) { for (int o = 32; o >= 1; o >>= 1) v = fmaxf(v, __shfl_xor(v, o)); return v; }
__device__ __forceinline__ float siluf(float x) { return x / (1.f + expf(-x)); }
__device__ __forceinline__ float sigmf(float x) { return 1.f / (1.f + expf(-x)); }
__device__ __forceinline__ int t5_bucket(int n) {
    if (n < 0) n = 0;
    if (n < 16) return n;
    float nf = (float)n;
    int l = 16 + (int)(logf(nf / 16.f) / 2.0794415416798357f * 16.f);
    return l < 31 ? l : 31;
}

__global__ __launch_bounds__(256) void k_rmsnorm(const float* in, int ldi, const float* g, float* out, int ldo, int ng, int Dn) {
    __shared__ float red[4];
    const int r = blockIdx.x; const float* xr = in + (size_t)r * ldi;
    float s = 0.f; for (int i = threadIdx.x; i < Dn; i += 256) { float v = xr[i]; s += v * v; }
    s = wave_sum(s); if ((threadIdx.x & 63) == 0) red[threadIdx.x >> 6] = s; __syncthreads();
    s = red[0] + red[1] + red[2] + red[3];
    const float rs = rsqrtf(s / (float)Dn + EPS);
    float* o = out + (size_t)(r / ng) * ldo + (size_t)(r % ng) * Dn; const float* gg = g + (size_t)(r % ng) * Dn;
    for (int i = threadIdx.x; i < Dn; i += 256) o[i] = xr[i] * rs * gg[i];
}

template <bool DUAL, class AF, class BF, class EF, class MF>
__global__ __launch_bounds__(256) void k_gemm(AF af, BF bf, EF ef, MF mf, int N, int K) {
    __shared__ float sA[16][65]; __shared__ float sB[16][65]; __shared__ float sB2[16][65];
    const int z = blockIdx.z, M = mf(z);
    const int m0 = blockIdx.y * 64, n0 = blockIdx.x * 64;
    if (m0 >= M) return;
    const int tx = threadIdx.x & 15, ty = threadIdx.x >> 4;
    float acc[4][4], acc2[4][4];
#pragma unroll
    for (int i = 0; i < 4; ++i)
#pragma unroll
        for (int j = 0; j < 4; ++j) { acc[i][j] = 0.f; acc2[i][j] = 0.f; }
    for (int k0 = 0; k0 < K; k0 += 16) {
#pragma unroll
        for (int i = 0; i < 4; ++i) { int e = threadIdx.x + i * 256; int m = e >> 4, k = e & 15; sA[k][m] = (m0 + m < M) ? af(z, m0 + m, k0 + k) : 0.f; }
#pragma unroll
        for (int i = 0; i < 4; ++i) { int e = threadIdx.x + i * 256; int k = e >> 6, n = e & 63; sB[k][n] = (n0 + n < N) ? bf(z, k0 + k, n0 + n) : 0.f;
            if (DUAL) sB2[k][n] = (n0 + n < N) ? bf(z, k0 + k, n0 + n + N) : 0.f; }
        __syncthreads();
#pragma unroll
        for (int k = 0; k < 16; ++k) {
            float a[4], b[4], b2[4];
#pragma unroll
            for (int i = 0; i < 4; ++i) { a[i] = sA[k][ty * 4 + i]; b[i] = sB[k][tx * 4 + i]; b2[i] = DUAL ? sB2[k][tx * 4 + i] : 0.f; }
#pragma unroll
            for (int i = 0; i < 4; ++i)
#pragma unroll
                for (int j = 0; j < 4; ++j) { acc[i][j] += a[i] * b[j]; if (DUAL) acc2[i][j] += a[i] * b2[j]; }
        }
        __syncthreads();
    }
#pragma unroll
    for (int i = 0; i < 4; ++i)
#pragma unroll
        for (int j = 0; j < 4; ++j) { int m = m0 + ty * 4 + i, n = n0 + tx * 4 + j; if (m < M && n < N) ef(z, m, n, acc[i][j], acc2[i][j]); }
}
struct MConst { int M; int pad; __device__ int operator()(int) const { return M; } };
struct MCnt { const int* cnt; __device__ int operator()(int z) const { return cnt[z]; } };
struct ARow { const float* A; int lda; int pad; __device__ float operator()(int, int m, int k) const { return A[(size_t)m * lda + k]; } };
struct BRow { const float* B; int ldb; int pad; __device__ float operator()(int, int k, int n) const { return B[(size_t)k * ldb + n]; } };
struct EStore { float* C; int ldc; int pad; __device__ void operator()(int, int m, int n, float a, float) const { C[(size_t)m * ldc + n] = a; } };
struct EResid { const float* R; float* C; int ldc; int pad; __device__ void operator()(int, int m, int n, float a, float) const { C[(size_t)m * ldc + n] = R[(size_t)m * ldc + n] + a; } };
struct EBias { const float* bias; float* C; int ldc; int pad; __device__ void operator()(int, int m, int n, float a, float) const { C[(size_t)m * ldc + n] = a + bias[n]; } };
struct ACmp { const float* proj; const float* pos; __device__ float operator()(int z, int m, int k) const {
    int kvh = m & 1, bc = m >> 1, c = bc % NCMP, b = bc / NCMP, l = k >> 6, d = k & 63;
    return proj[(size_t)(b * S + c * 16 + l) * INC + KVOFF + z * 128 + kvh * 64 + d] + pos[(z * 32 + l) * 64 + d]; } };
struct BCmp1 { const float* w; __device__ float operator()(int z, int k, int n) const { return w[((size_t)z * 2048 + k) * 64 + n]; } };
struct ECmp1 { float* hid; __device__ void operator()(int z, int m, int n, float a, float) const { hid[((size_t)z * (NB * NCMP * 2) + m) * 64 + n] = siluf(a); } };
struct ACmp2 { const float* hid; __device__ float operator()(int z, int m, int k) const { return hid[((size_t)z * (NB * NCMP * 2) + m) * 64 + k]; } };
struct BCmp2 { const float* w; __device__ float operator()(int z, int k, int n) const { return w[((size_t)z * 64 + k) * 64 + n]; } };
struct ECmp2 { float* kvc; __device__ void operator()(int z, int m, int n, float a, float) const { kvc[((size_t)z * (NB * NCMP * 2) + m) * 64 + n] = a; } };
struct AMoe1 { const float* hn; const int* list; __device__ float operator()(int z, int m, int k) const { int tk = list[(size_t)z * T + m]; return hn[(size_t)(tk >> 2) * D + k]; } };
struct BMoe1 { const float* w; __device__ float operator()(int z, int k, int n) const { return w[((size_t)z * 1024 + k) * 2048 + n]; } };
struct EMoe1 { const float* bias; const int* list; float* act; __device__ void operator()(int z, int m, int n, float a, float a2) const {
    int tk = list[(size_t)z * T + m]; float g = a + bias[z * 2048 + n], u = a2 + bias[z * 2048 + 1024 + n];
    g = fminf(g, 7.f); u = fminf(fmaxf(u, -7.f), 7.f);
    act[(size_t)tk * 1024 + n] = (u + 1.f) * g * sigmf(1.702f * g); } };
struct AMoe2 { const float* act; const int* list; __device__ float operator()(int z, int m, int k) const { int tk = list[(size_t)z * T + m]; return act[(size_t)tk * 1024 + k]; } };
struct BMoe2 { const float* w; __device__ float operator()(int z, int k, int n) const { return w[((size_t)z * 1024 + k) * 1024 + n]; } };
struct EMoe2 { const float* bias; const int* list; float* y; __device__ void operator()(int z, int m, int n, float a, float) const {
    int tk = list[(size_t)z * T + m]; y[(size_t)tk * 1024 + n] = a + bias[z * 1024 + n]; } };

__global__ __launch_bounds__(256) void k_nsa(const float* proj, const float* kc, const float* vc, const float* rel_bias, float* o_nsa) {
    __shared__ float q_s[4][64]; __shared__ float pc[4][128]; __shared__ float lg[4][1024];
    __shared__ float score_s[32]; __shared__ int sellist[32]; __shared__ int nsel_s;
    const int row = blockIdx.x, kvh = blockIdx.y, b = row / S, t = row % S;
    const int g = threadIdx.x >> 6, i = threadIdx.x & 63, head = kvh * 4 + g, blk = t >> 6;
    const float* pr = proj + (size_t)row * INC;
    q_s[g][i] = pr[head * 64 + i];
    __syncthreads();
    const int nvalid = (t >= 31) ? ((t - 31) / 16 + 1) : 0;
    float lv[2]; float mx = -1e30f;
#pragma unroll
    for (int r = 0; r < 2; ++r) { int c = i + r * 64; float l = -1e30f;
        if (c < nvalid) { const float* kr = kc + ((size_t)(b * NCMP + c) * 2 + kvh) * 64; float s = 0.f; for (int d = 0; d < 64; ++d) s += q_s[g][d] * kr[d];
            l = s * 0.125f + rel_bias[t5_bucket(t - (c * 16 + 31)) * 8 + head]; }
        lv[r] = l; mx = fmaxf(mx, l); }
    mx = wave_max(mx);
    float sm = 0.f;
#pragma unroll
    for (int r = 0; r < 2; ++r) { int c = i + r * 64; float p = (c < nvalid) ? expf(lv[r] - mx) : 0.f; lv[r] = p; sm += p; }
    sm = wave_sum(sm); const float inv = 1.f / fmaxf(sm, 1e-30f);
#pragma unroll
    for (int r = 0; r < 2; ++r) pc[g][i + r * 64] = lv[r] * inv;
    __syncthreads();
    float o_cmp = 0.f;
    for (int c = 0; c < nvalid; ++c) o_cmp += pc[g][c] * vc[((size_t)(b * NCMP + c) * 2 + kvh) * 64 + i];
    if (threadIdx.x < 32) { int n = threadIdx.x; float im = 0.f;
        for (int gg = 0; gg < 4; ++gg) for (int c = 4 * n - 1; c <= 4 * n + 3; ++c) if (c >= 0 && c < NCMP) im += pc[gg][c];
        bool forced = (n == 0) || (n == blk) || (n == blk - 1);
        score_s[n] = forced ? 1e4f : ((n <= blk) ? im : -1.f); }
    __syncthreads();
    if (threadIdx.x == 0) { int ns = 0;
        for (int n = 0; n < 32; ++n) { float sn = score_s[n]; int rank = 0; for (int m = 0; m < 32; ++m) { float s2 = score_s[m]; if (s2 > sn || (s2 == sn && m < n)) ++rank; }
            if (rank < 16 && n <= blk) sellist[ns++] = n; }
        nsel_s = ns; }
    __syncthreads();
    const int nsel = nsel_s;
    float o_slc = 0.f;
    { const int nk = nsel * 64; float m2 = -1e30f;
      for (int kk = i; kk < nk; kk += 64) { int kp = sellist[kk >> 6] * 64 + (kk & 63); float l = -1e30f;
          if (kp <= t) { const float* kr = proj + (size_t)(b * S + kp) * INC + KVOFF + 2 * 128 + kvh * 64; float s = 0.f; for (int d = 0; d < 64; ++d) s += q_s[g][d] * kr[d];
              l = s * 0.125f + rel_bias[t5_bucket(t - kp) * 8 + head]; }
          lg[g][kk] = l; m2 = fmaxf(m2, l); }
      m2 = wave_max(m2); float s2 = 0.f;
      for (int kk = i; kk < nk; kk += 64) { int kp = sellist[kk >> 6] * 64 + (kk & 63); float p = (kp <= t) ? expf(lg[g][kk] - m2) : 0.f; lg[g][kk] = p; s2 += p; }
      s2 = wave_sum(s2); const float inv2 = 1.f / fmaxf(s2, 1e-30f);
      __syncthreads();
      for (int kk = 0; kk < nk; ++kk) { int kp = sellist[kk >> 6] * 64 + (kk & 63); if (kp <= t) o_slc += lg[g][kk] * proj[(size_t)(b * S + kp) * INC + KVOFF + 3 * 128 + kvh * 64 + i]; }
      o_slc *= inv2; }
    __syncthreads();
    float o_win = 0.f;
    { float m2 = -1e30f;
      for (int kk = i; kk < 512; kk += 64) { int kp = t - 511 + kk; float l = -1e30f;
          if (kp >= 0) { const float* kr = proj + (size_t)(b * S + kp) * INC + KVOFF + 4 * 128 + kvh * 64; float s = 0.f; for (int d = 0; d < 64; ++d) s += q_s[g][d] * kr[d];
              l = s * 0.125f + rel_bias[t5_bucket(t - kp) * 8 + head]; }
          lg[g][kk] = l; m2 = fmaxf(m2, l); }
      m2 = wave_max(m2); float s2 = 0.f;
      for (int kk = i; kk < 512; kk += 64) { int kp = t - 511 + kk; float p = (kp >= 0) ? expf(lg[g][kk] - m2) : 0.f; lg[g][kk] = p; s2 += p; }
      s2 = wave_sum(s2); const float inv2 = 1.f / fmaxf(s2, 1e-30f);
      __syncthreads();
      for (int kk = 0; kk < 512; ++kk) { int kp = t - 511 + kk; if (kp >= 0) o_win += lg[g][kk] * proj[(size_t)(b * S + kp) * INC + KVOFF + 5 * 128 + kvh * 64 + i]; }
      o_win *= inv2; }
    const float g0 = sigmf(pr[GOFF + 0 * 8 + head]), g1 = sigmf(pr[GOFF + 1 * 8 + head]), g2 = sigmf(pr[GOFF + 2 * 8 + head]);
    o_nsa[(size_t)row * 512 + head * 64 + i] = g0 * o_cmp + g1 * o_slc + g2 * o_win;
}

__global__ __launch_bounds__(256) void k_ssd_conv(const float* proj, const float* conv_w, const float* conv_b, const float* dt_bias, float* convx, float* dtv) {
    const int row = blockIdx.x, s = row % S;
    for (int ch = threadIdx.x; ch < 1024; ch += 256) { float a = conv_b[ch];
#pragma unroll
        for (int k = 0; k < 4; ++k) { int ss = s - 3 + k; if (ss >= 0) a += proj[(size_t)(row - 3 + k) * INC + XBCOFF + ch] * conv_w[k * 1024 + ch]; }
        convx[(size_t)row * 1024 + ch] = siluf(a); }
    if (threadIdx.x < 8) { float x = proj[(size_t)row * INC + DTOFF + threadIdx.x] + dt_bias[threadIdx.x]; dtv[row * 8 + threadIdx.x] = (x > 20.f) ? x : log1pf(expf(x)); }
}
__global__ __launch_bounds__(256) void k_ssd_scan(const float* proj, const float* convx, const float* dtv, const float* a_log, const float* d_skip, float* yssd) {
    const int b = blockIdx.x >> 3, h = blockIdx.x & 7, grp = h >> 2, p = threadIdx.x >> 2, nq = threadIdx.x & 3;
    const float A = -expf(a_log[h]), Dh = d_skip[h];
    float st[32];
#pragma unroll
    for (int j = 0; j < 32; ++j) st[j] = 0.f;
    for (int s = 0; s < S; ++s) { const size_t row = (size_t)b * S + s; const float* cx = convx + row * 1024;
        const float dt = dtv[row * 8 + h], xv = cx[h * 64 + p], dA = expf(dt * A), dx = dt * xv;
        const float* Bn = cx + 512 + grp * 128 + nq * 32; const float* Cn = cx + 768 + grp * 128 + nq * 32;
        float y = 0.f;
#pragma unroll
        for (int j = 0; j < 32; ++j) { st[j] = dA * st[j] + dx * Bn[j]; y += Cn[j] * st[j]; }
        y += __shfl_xor(y, 1); y += __shfl_xor(y, 2);
        if (nq == 0) { float z = proj[row * INC + ZOFF + h * 64 + p]; yssd[row * 512 + h * 64 + p] = (y + Dh * xv) * siluf(z); } }
}
__global__ __launch_bounds__(256) void k_route(const float* logits, int* cnt, int* list, float* topw) {
    const int t = blockIdx.x * 256 + threadIdx.x; if (t >= T) return;
    const float* lr = logits + (size_t)t * NE; unsigned used = 0u; float tv[4]; int ti[4];
#pragma unroll
    for (int k = 0; k < 4; ++k) { float best = -INFINITY; int bi = 0;
        for (int e = 0; e < NE; ++e) { float v = lr[e]; if (!((used >> e) & 1u) && v > best) { best = v; bi = e; } }
        used |= 1u << bi; tv[k] = best; ti[k] = bi; }
    float m = tv[0], sum = 0.f, w[4];
#pragma unroll
    for (int k = 0; k < 4; ++k) { w[k] = expf(tv[k] - m); sum += w[k]; }
#pragma unroll
    for (int k = 0; k < 4; ++k) { topw[t * 4 + k] = w[k] / sum; int pos = atomicAdd(&cnt[ti[k]], 1); list[(size_t)ti[k] * T + pos] = t * 4 + k; }
}
__global__ __launch_bounds__(256) void k_combine(const float* h1, const float* y, const float* topw, const float* g, float* out) {
    __shared__ float red[4];
    const int t = blockIdx.x; float v[4]; float s = 0.f;
#pragma unroll
    for (int r = 0; r < 4; ++r) { int i = threadIdx.x + r * 256; float a = h1[(size_t)t * D + i];
#pragma unroll
        for (int k = 0; k < 4; ++k) a += topw[t * 4 + k] * y[(size_t)(t * 4 + k) * D + i];
        v[r] = a; s += a * a; }
    s = wave_sum(s); if ((threadIdx.x & 63) == 0) red[threadIdx.x >> 6] = s; __syncthreads();
    s = red[0] + red[1] + red[2] + red[3]; const float rs = rsqrtf(s / (float)D + EPS);
#pragma unroll
    for (int r = 0; r < 4; ++r) { int i = threadIdx.x + r * 256; out[(size_t)t * D + i] = v[r] * rs * g[i]; }
}
}

namespace mk {
#define LAS __attribute__((address_space(3)))
typedef unsigned short bf16_t;
typedef short bf16x8 __attribute__((ext_vector_type(8)));
typedef float f32x4 __attribute__((ext_vector_type(4)));
typedef unsigned u32x4 __attribute__((ext_vector_type(4)));
typedef unsigned u32x2 __attribute__((ext_vector_type(2)));
constexpr int NB = 8, S = 2048, D = 1024, T = NB * S, NE = 32;
constexpr int BM = 256, BK = 64, HALF = 128, HTB = HALF * BK * 2, STAGE_BYTES = 8 * HTB, NXCD = 8, WGM = 8;
constexpr int KD = 1024;
constexpr int NPROJ = 3072;
constexpr int MAXSLOT = 65536 + 32 * 256;
constexpr int LDS_MISC = 131072, LDS_TILE_E = LDS_MISC + 64, LDS_TILE_M = LDS_TILE_E + 1536, LDS_ROWTAB = LDS_MISC + 4096, LDS_BYTES = LDS_ROWTAB + 12 * 1024;

__host__ __device__ __forceinline__ int lds_byte(int r, int c) { const int st = (r >> 4) * 2 + (c >> 5), rr = r & 15, cc = c & 31, ob = rr * 64 + cc * 2; return st * 1024 + (ob ^ (((ob >> 9) & 1) << 5)); }
__host__ __device__ __forceinline__ void stage_rc(int b, int& R, int& C) { const int st = b / 1024, sb = b % 1024, swz = sb ^ (((sb >> 9) & 1) << 5); R = (st >> 1) * 16 + swz / 64; C = (st & 1) * 32 + (swz % 64) / 2; }
__host__ __device__ __forceinline__ int perm32(int rho) { const int n = rho >> 4, i = rho & 15; return 8 * (i >> 2) + 4 * n + (i & 3); }
__device__ __forceinline__ unsigned cvt_pk_bf16(float lo, float hi) { unsigned r; asm volatile("v_cvt_pk_bf16_f32 %0, %1, %2" : "=v"(r) : "v"(lo), "v"(hi)); return r; }
__device__ __forceinline__ float bf2f(bf16_t b) { return __uint_as_float(((unsigned)b) << 16); }

struct Unit { int pm, pn, e, mt; };
struct StaticOrder {
    int nM, nN, nwg, G, c;
    __device__ void init(int M, int N, int G_, int c_) { nM = M / BM; nN = N / BM; nwg = nM * nN; G = G_; c = c_; }
    __device__ bool next(int i, Unit& u) const {
        const long L = (long)i * G + c; if (L >= nwg) return false;
        int wgid = (int)L; { const int q = nwg / NXCD, r = nwg % NXCD, xcd = wgid % NXCD, off = wgid / NXCD; wgid = (xcd < r ? xcd * (q + 1) : r * (q + 1) + (xcd - r) * q) + off; }
        const int nig = WGM * nN, gid = wgid / nig, fm = gid * WGM, gsz = (nM - fm) < WGM ? (nM - fm) : WGM;
        u.pm = fm + ((wgid % nig) % gsz); u.pn = (wgid % nig) / gsz; u.e = 0; u.mt = 0; return true;
    }
};
struct MoeOrder {
    int nN, G, c, RT; const LAS int* tile_e; const LAS int* tile_m;
    __device__ bool next(int i, Unit& u) const { const int L = i * G + c; if (L >= RT * nN) return false; const int rt = L / nN; u.pm = rt; u.pn = L - rt * nN; u.e = tile_e[rt]; u.mt = tile_m[rt]; return true; }
};

struct ProbProj {
    static constexpr bool PERM = true;
    StaticOrder S; const bf16_t* A; const bf16_t* Bt; bf16_t* O;
    __device__ __forceinline__ bool next(int i, Unit& u) const { return S.next(i, u); }
    __device__ __forceinline__ const char* a_base(const Unit& u) const { return (const char*)A + (size_t)u.pm * (BM * KD * 2); }
    __device__ __forceinline__ const char* b_base(const Unit& u) const { return (const char*)Bt + (size_t)u.pn * (BM * KD * 2); }
    __device__ __forceinline__ void a_offs(int, const Unit&, unsigned (&v0)[2], unsigned (&v1)[2], const int (&R)[2], const int (&C)[2]) const {
#pragma unroll
        for (int i = 0; i < 2; ++i) { v0[i] = (unsigned)(R[i] * KD + C[i]) * 2u; v1[i] = v0[i] + (unsigned)(HALF * KD * 2); } }
    __device__ __forceinline__ void epi(const f32x4 (&acc)[2][2][4][2], const Unit& u, int wr, int wc, int fr, int fq) const {
        const int row0 = u.pm * BM + wr * 64 + fr, col0 = u.pn * BM + wc * 32 + 8 * fq;
#pragma unroll
        for (int ai = 0; ai < 2; ++ai)
#pragma unroll
            for (int m = 0; m < 4; ++m) { bf16_t* rowp = O + (size_t)(row0 + ai * HALF + m * 16) * NPROJ + col0;
#pragma unroll
                for (int bj = 0; bj < 2; ++bj) { const f32x4 v0 = acc[ai][bj][m][0], v1 = acc[ai][bj][m][1]; u32x4 w;
                    w.x = cvt_pk_bf16(v0[0], v0[1]); w.y = cvt_pk_bf16(v0[2], v0[3]); w.z = cvt_pk_bf16(v1[0], v1[1]); w.w = cvt_pk_bf16(v1[2], v1[3]);
                    *(u32x4*)(rowp + bj * HALF) = w; } }
    }
};
struct ProbOut {
    static constexpr bool PERM = false;
    StaticOrder S; const bf16_t* A; const bf16_t* Bt; const float* R0; float* O;
    __device__ __forceinline__ bool next(int i, Unit& u) const { return S.next(i, u); }
    __device__ __forceinline__ const char* a_base(const Unit& u) const { return (const char*)A + (size_t)u.pm * (BM * KD * 2); }
    __device__ __forceinline__ const char* b_base(const Unit& u) const { return (const char*)Bt + (size_t)u.pn * (BM * KD * 2); }
    __device__ __forceinline__ void a_offs(int, const Unit&, unsigned (&v0)[2], unsigned (&v1)[2], const int (&R)[2], const int (&C)[2]) const {
#pragma unroll
        for (int i = 0; i < 2; ++i) { v0[i] = (unsigned)(R[i] * KD + C[i]) * 2u; v1[i] = v0[i] + (unsigned)(HALF * KD * 2); } }
    __device__ __forceinline__ void epi(const f32x4 (&acc)[2][2][4][2], const Unit& u, int wr, int wc, int fr, int fq) const {
        const int row0 = u.pm * BM + wr * 64 + fr, col0 = u.pn * BM + wc * 32 + 4 * fq;
#pragma unroll
        for (int ai = 0; ai < 2; ++ai)
#pragma unroll
            for (int m = 0; m < 4; ++m) { const size_t off = (size_t)(row0 + ai * HALF + m * 16) * D + col0;
#pragma unroll
                for (int bj = 0; bj < 2; ++bj)
#pragma unroll
                    for (int n = 0; n < 2; ++n) { const f32x4 r = *(const f32x4*)(R0 + off + bj * HALF + n * 16); *(f32x4*)(O + off + bj * HALF + n * 16) = acc[ai][bj][m][n] + r; }
                asm volatile("" ::: "memory"); }
    }
};
struct ProbMoe1 {
    static constexpr bool PERM = true;
    MoeOrder S; const bf16_t* A; const bf16_t* Bt; const float* bias; bf16_t* O; const LAS unsigned* rowtab;
    __device__ __forceinline__ bool next(int i, Unit& u) const { return S.next(i, u); }
    __device__ __forceinline__ const char* a_base(const Unit&) const { return (const char*)A; }
    __device__ __forceinline__ const char* b_base(const Unit& u) const { return (const char*)Bt + ((size_t)u.e * 2048 + (size_t)u.pn * BM) * (KD * 2); }
    __device__ __forceinline__ void a_offs(int i, const Unit&, unsigned (&v0)[2], unsigned (&v1)[2], const int (&R)[2], const int (&C)[2]) const {
#pragma unroll
        for (int j = 0; j < 2; ++j) { v0[j] = rowtab[i * 256 + R[j]] + (unsigned)C[j] * 2u; v1[j] = rowtab[i * 256 + HALF + R[j]] + (unsigned)C[j] * 2u; } }
    __device__ __forceinline__ void epi(const f32x4 (&acc)[2][2][4][2], const Unit& u, int wr, int wc, int fr, int fq) const {
        const int row0 = u.pm * BM + wr * 64 + fr, jg0 = u.pn * HALF + wc * 32 + 8 * fq;
        f32x4 bg[2], bu[2];
#pragma unroll
        for (int n = 0; n < 2; ++n) { bg[n] = *(const f32x4*)(bias + u.e * 2048 + jg0 + 4 * n); bu[n] = *(const f32x4*)(bias + u.e * 2048 + 1024 + jg0 + 4 * n); }
#pragma unroll
        for (int ai = 0; ai < 2; ++ai)
#pragma unroll
            for (int m = 0; m < 4; ++m) { float o[8];
#pragma unroll
                for (int n = 0; n < 2; ++n) { const f32x4 g4 = acc[ai][0][m][n] + bg[n], u4 = acc[ai][1][m][n] + bu[n];
#pragma unroll
                    for (int j = 0; j < 4; ++j) { const float g = fminf(g4[j], 7.f), uu = fminf(fmaxf(u4[j], -7.f), 7.f);
                        const float sg = __builtin_amdgcn_rcpf(1.f + __builtin_amdgcn_exp2f(-1.702f * 1.4426950408889634f * g)); o[n * 4 + j] = (uu + 1.f) * g * sg; } }
                u32x4 w; w.x = cvt_pk_bf16(o[0], o[1]); w.y = cvt_pk_bf16(o[2], o[3]); w.z = cvt_pk_bf16(o[4], o[5]); w.w = cvt_pk_bf16(o[6], o[7]);
                *(u32x4*)(O + (size_t)(row0 + ai * HALF + m * 16) * 1024 + jg0) = w; }
    }
};
struct ProbMoe2 {
    static constexpr bool PERM = true;
    MoeOrder S; const bf16_t* A; const bf16_t* Bt; const float* bias; const float* wlist; bf16_t* O;
    __device__ __forceinline__ bool next(int i, Unit& u) const { return S.next(i, u); }
    __device__ __forceinline__ const char* a_base(const Unit& u) const { return (const char*)A + (size_t)u.pm * (BM * KD * 2); }
    __device__ __forceinline__ const char* b_base(const Unit& u) const { return (const char*)Bt + ((size_t)u.e * 1024 + (size_t)u.pn * BM) * (KD * 2); }
    __device__ __forceinline__ void a_offs(int, const Unit&, unsigned (&v0)[2], unsigned (&v1)[2], const int (&R)[2], const int (&C)[2]) const {
#pragma unroll
        for (int i = 0; i < 2; ++i) { v0[i] = (unsigned)(R[i] * KD + C[i]) * 2u; v1[i] = v0[i] + (unsigned)(HALF * KD * 2); } }
    __device__ __forceinline__ void epi(const f32x4 (&acc)[2][2][4][2], const Unit& u, int wr, int wc, int fr, int fq) const {
        const int rl0 = wr * 64 + fr, col0 = u.pn * BM + wc * 32 + 8 * fq;
        f32x4 bv[2][2];
#pragma unroll
        for (int bj = 0; bj < 2; ++bj)
#pragma unroll
            for (int n = 0; n < 2; ++n) bv[bj][n] = *(const f32x4*)(bias + u.e * 1024 + col0 + bj * HALF + 4 * n);
#pragma unroll
        for (int ai = 0; ai < 2; ++ai)
#pragma unroll
            for (int m = 0; m < 4; ++m) { const int rl = rl0 + ai * HALF + m * 16; const float wt = wlist[(size_t)u.e * T + u.mt * BM + rl];
                bf16_t* rowp = O + (size_t)(u.pm * BM + rl) * 1024 + col0;
#pragma unroll
                for (int bj = 0; bj < 2; ++bj) { const f32x4 v0 = (acc[ai][bj][m][0] + bv[bj][0]) * wt, v1 = (acc[ai][bj][m][1] + bv[bj][1]) * wt; u32x4 w;
                    w.x = cvt_pk_bf16(v0[0], v0[1]); w.y = cvt_pk_bf16(v0[2], v0[3]); w.z = cvt_pk_bf16(v1[0], v1[1]); w.w = cvt_pk_bf16(v1[2], v1[3]);
                    *(u32x4*)(rowp + bj * HALF) = w; } }
    }
};

template <class P>
__device__ __forceinline__ void gemm_phase(LAS unsigned char* lds, const P& Pb) {
    const int tid = threadIdx.x, wid = __builtin_amdgcn_readfirstlane(tid >> 6), lane = tid & 63, wr = wid >> 2, wc = wid & 3, fr = lane & 15, fq = lane >> 4;
    constexpr int nt = KD / BK;
    int Rr[2], Cc[2]; unsigned voffB[2];
#pragma unroll
    for (int i = 0; i < 2; ++i) { int R, C; stage_rc(tid * 16 + i * 8192, R, C); const int Rb = P::PERM ? ((R & ~31) + perm32(R & 31)) : R; Rr[i] = R; Cc[i] = C; voffB[i] = (unsigned)(Rb * KD + C) * 2u; }
    constexpr size_t kstep = (size_t)(BK * 2);
    constexpr size_t hstep = (size_t)HALF * KD * 2;
    const unsigned ldsw = (unsigned)wid * 1024u;
    const int aoff = lds_byte(wr * 64 + fr, fq * 8), boff = lds_byte(wc * 32 + fr, fq * 8);
#define PG8_SA(b, h) (((b) * 2 + (h)) * HTB)
#define PG8_SB(b, h) ((4 + (b) * 2 + (h)) * HTB)
#define PG8_STAGE(bufoff, gbase, voff) do { _Pragma("unroll") for (int _i = 0; _i < 2; ++_i) \
        __builtin_amdgcn_global_load_lds((const unsigned*)((const char*)(gbase) + (voff)[_i]), (LAS unsigned*)(lds + (bufoff) + ldsw + _i * 8192), 16, 0, 0); } while (0)
#define PG8_LDA(dst, b, h) do { _Pragma("unroll") for (int m = 0; m < 4; ++m) _Pragma("unroll") for (int k = 0; k < 2; ++k) dst[m][k] = *(const LAS bf16x8*)(lds + PG8_SA(b, h) + aoff + m * 2048 + k * 1024); } while (0)
#define PG8_LDB(dst, b, h) do { _Pragma("unroll") for (int n = 0; n < 2; ++n) _Pragma("unroll") for (int k = 0; k < 2; ++k) dst[n][k] = *(const LAS bf16x8*)(lds + PG8_SB(b, h) + boff + n * 2048 + k * 1024); } while (0)
#define PG8_MMA(ai, bj, At, Bt) do { __builtin_amdgcn_s_setprio(1); _Pragma("unroll") for (int m = 0; m < 4; ++m) _Pragma("unroll") for (int n = 0; n < 2; ++n) _Pragma("unroll") for (int k = 0; k < 2; ++k) \
        acc[ai][bj][m][n] = __builtin_amdgcn_mfma_f32_16x16x32_bf16(Bt[n][k], At[m][k], acc[ai][bj][m][n], 0, 0, 0); __builtin_amdgcn_s_setprio(0); } while (0)
#define PG8_WAIT_V(n) asm volatile("s_waitcnt vmcnt(" #n ")" ::: "memory")
#define PG8_WAIT_L(n) asm volatile("s_waitcnt lgkmcnt(" #n ")" ::: "memory")
#define PG8_BAR __builtin_amdgcn_s_barrier()
#define PG8_SCHED __builtin_amdgcn_sched_barrier(0)
    Unit cur, nxt; int ui = 0;
    if (!Pb.next(0, cur)) return;
    f32x4 acc[2][2][4][2];
#pragma unroll
    for (int a = 0; a < 2; ++a)
#pragma unroll
        for (int b = 0; b < 2; ++b)
#pragma unroll
            for (int m = 0; m < 4; ++m)
#pragma unroll
                for (int n = 0; n < 2; ++n) acc[a][b][m][n] = (f32x4){0.f, 0.f, 0.f, 0.f};
    bf16x8 At[4][2], B0[2][2], B1[2][2];
    unsigned vA0[2], vA1[2];
    Pb.a_offs(0, cur, vA0, vA1, Rr, Cc);
    const char* cA = Pb.a_base(cur); const char* cB = Pb.b_base(cur);
    PG8_STAGE(PG8_SB(0, 0), cB, voffB); PG8_STAGE(PG8_SB(0, 1), cB + hstep, voffB); PG8_STAGE(PG8_SA(0, 0), cA, vA0); PG8_STAGE(PG8_SA(0, 1), cA, vA1);
    if (wr == 1) PG8_BAR;
    PG8_WAIT_V(2); PG8_BAR;
    PG8_STAGE(PG8_SB(1, 0), cB + kstep, voffB); PG8_STAGE(PG8_SA(1, 0), cA + kstep, vA0); PG8_STAGE(PG8_SB(1, 1), cB + hstep + kstep, voffB);
    PG8_WAIT_V(6); PG8_BAR;
    for (;;) {
        const bool has_next = Pb.next(ui + 1, nxt);
        const char* nA = has_next ? Pb.a_base(nxt) : cA; const char* nB = has_next ? Pb.b_base(nxt) : cB;
        for (int t = 0; t < nt; t += 2) {
            const bool last = (t == nt - 2);
            const char* a1 = cA + (size_t)(t + 1) * kstep;
            const char* a2 = last ? nA : cA + (size_t)(t + 2) * kstep; const char* b2 = last ? nB : cB + (size_t)(t + 2) * kstep;
            const char* a3 = a2 + kstep; const char* b3 = b2 + kstep;
            PG8_LDB(B0, 0, 0); PG8_LDB(B1, 0, 1); PG8_SCHED; PG8_LDA(At, 0, 0); PG8_STAGE(PG8_SA(1, 1), a1, vA1);
            PG8_WAIT_V(8); PG8_WAIT_L(0); PG8_BAR; PG8_MMA(0, 0, At, B0); PG8_MMA(0, 1, At, B1); PG8_BAR; PG8_SCHED;
            if (last && has_next) Pb.a_offs(ui + 1, nxt, vA0, vA1, Rr, Cc);
            PG8_LDA(At, 0, 1); PG8_STAGE(PG8_SB(0, 0), b2, voffB); PG8_STAGE(PG8_SB(0, 1), b2 + hstep, voffB); PG8_STAGE(PG8_SA(0, 0), a2, vA0);
            PG8_WAIT_V(8); PG8_WAIT_L(0); PG8_BAR; PG8_MMA(1, 0, At, B0); PG8_MMA(1, 1, At, B1); PG8_BAR; PG8_SCHED;
            PG8_LDB(B0, 1, 0); PG8_LDB(B1, 1, 1); PG8_SCHED; PG8_LDA(At, 1, 0); PG8_STAGE(PG8_SA(0, 1), a2, vA1);
            PG8_WAIT_V(8); PG8_WAIT_L(0); PG8_BAR; PG8_MMA(0, 0, At, B0); PG8_MMA(0, 1, At, B1); PG8_BAR; PG8_SCHED;
            PG8_LDA(At, 1, 1); PG8_STAGE(PG8_SB(1, 0), b3, voffB); PG8_STAGE(PG8_SB(1, 1), b3 + hstep, voffB); PG8_STAGE(PG8_SA(1, 0), a3, vA0);
            PG8_WAIT_V(8); PG8_WAIT_L(0); PG8_BAR; PG8_MMA(1, 0, At, B0); PG8_MMA(1, 1, At, B1); PG8_BAR; PG8_SCHED;
        }
        if (wr == 0) PG8_BAR;
        Pb.epi(acc, cur, wr, wc, fr, fq);
        if (!has_next) break;
#pragma unroll
        for (int a = 0; a < 2; ++a)
#pragma unroll
            for (int b = 0; b < 2; ++b)
#pragma unroll
                for (int m = 0; m < 4; ++m)
#pragma unroll
                    for (int n = 0; n < 2; ++n) acc[a][b][m][n] = (f32x4){0.f, 0.f, 0.f, 0.f};
        cur = nxt; cA = nA; cB = nB; ++ui;
        if (wr == 1) PG8_BAR;
    }
    PG8_WAIT_V(0);
    PG8_BAR;
#undef PG8_SA
#undef PG8_SB
#undef PG8_STAGE
#undef PG8_LDA
#undef PG8_LDB
#undef PG8_MMA
#undef PG8_WAIT_V
#undef PG8_WAIT_L
#undef PG8_BAR
#undef PG8_SCHED
}

__device__ __forceinline__ int moe_tables(LAS unsigned char* lds, const int* cnt) {
    LAS int* tile_e = (LAS int*)(lds + LDS_TILE_E); LAS int* tile_m = (LAS int*)(lds + LDS_TILE_M); LAS int* rts = (LAS int*)(lds + LDS_MISC + 32);
    if (threadIdx.x == 0) { int a = 0; for (int e = 0; e < NE; ++e) { const int n = (cnt[e] + 255) >> 8; for (int m = 0; m < n; ++m) { tile_e[a] = e; tile_m[a] = m; ++a; } } rts[0] = a; }
    __syncthreads();
    return rts[0];
}
}
namespace mk {
__device__ __forceinline__ float wsum(float v) {
#pragma unroll
    for (int o = 1; o < 64; o <<= 1) v += __shfl_xor(v, o);
    return v; }
__device__ __forceinline__ unsigned short f2bf(float f) { unsigned u = __float_as_uint(f); u += 0x7FFFu + ((u >> 16) & 1u); return (unsigned short)(u >> 16); }

__global__ __launch_bounds__(256) void k_rms_bf16(const float* in, int ldi, bf16_t* out, int ldo, int ng, int Dn, int nrows) {
    const int lane = threadIdx.x & 63; const int gw = blockIdx.x * 4 + (threadIdx.x >> 6), nw = gridDim.x * 4;
    for (int r = gw; r < nrows; r += nw) { const float* xr = in + (size_t)r * ldi; float s = 0.f;
        for (int i = lane * 4; i < Dn; i += 256) { const f32x4 v = *(const f32x4*)(xr + i); s += v[0] * v[0] + v[1] * v[1] + v[2] * v[2] + v[3] * v[3]; }
        s = wsum(s); const float rs = rsqrtf(s / (float)Dn + 1e-6f);
        bf16_t* o = out + (size_t)(r / ng) * ldo + (size_t)(r % ng) * Dn;
        for (int i = lane * 4; i < Dn; i += 256) { const f32x4 v = *(const f32x4*)(xr + i); u32x2 w; w.x = cvt_pk_bf16(v[0] * rs, v[1] * rs); w.y = cvt_pk_bf16(v[2] * rs, v[3] * rs); *(u32x2*)(o + i) = w; } }
}
__global__ __launch_bounds__(256) void k_wT(const float* W, bf16_t* WT, const float* gk1, const float* gk2, int ksplit, int K, int N, int NP, int mode, int nscale, float sc) {
    __shared__ float tile[64][65];
    const int z = blockIdx.z, n0 = blockIdx.x * 64, k0 = blockIdx.y * 64, tx = threadIdx.x & 63, ty = threadIdx.x >> 6;
    const float* Wz = W + (size_t)z * K * N; bf16_t* WTz = WT + (size_t)z * NP * K;
#pragma unroll
    for (int r = 0; r < 16; ++r) { const int kk = r * 4 + ty, k = k0 + kk, n = n0 + tx; float g = 1.f; if (gk1) g = (k < ksplit) ? gk1[k] : gk2[k - ksplit];
        tile[kk][tx] = (n < N) ? Wz[(size_t)k * N + n] * g : 0.f; }
    __syncthreads();
#pragma unroll
    for (int j = 0; j < 2; ++j) { const int id = threadIdx.x + 256 * j, nl = id >> 3, c = id & 7, n = n0 + nl; const float s = (n < nscale) ? sc : 1.f;
        int nm = n; if (mode == 1) { const int up = n >> 10, jj = n & 1023; nm = (jj >> 7) * 256 + up * 128 + (jj & 127); }
        u32x4 w; w.x = cvt_pk_bf16(tile[8 * c + 0][nl] * s, tile[8 * c + 1][nl] * s); w.y = cvt_pk_bf16(tile[8 * c + 2][nl] * s, tile[8 * c + 3][nl] * s);
        w.z = cvt_pk_bf16(tile[8 * c + 4][nl] * s, tile[8 * c + 5][nl] * s); w.w = cvt_pk_bf16(tile[8 * c + 6][nl] * s, tile[8 * c + 7][nl] * s);
        *(u32x4*)(WTz + (size_t)nm * K + k0 + 8 * c) = w; }
}
__global__ __launch_bounds__(256) void k_bf2f(const bf16_t* in, int ldi, float* out, int ldo, int ncols, int nrows) {
    for (size_t i = (size_t)blockIdx.x * 256 + threadIdx.x; i < (size_t)nrows * ncols; i += (size_t)gridDim.x * 256) { const size_t r = i / ncols, c = i % ncols; out[r * ldo + c] = bf2f(in[r * ldi + c]); }
}
__global__ __launch_bounds__(512, 2) void k_proj(const bf16_t* xb, const bf16_t* WinT, bf16_t* projb) {
    extern __shared__ __attribute__((aligned(16))) unsigned char dl[];
    ProbProj P; P.S.init(T, NPROJ, gridDim.x, blockIdx.x); P.A = xb; P.Bt = WinT; P.O = projb;
    gemm_phase(((LAS unsigned char*)dl), P);
}
__global__ __launch_bounds__(512, 2) void k_outp(const bf16_t* catb, const bf16_t* WoutT, const float* x, float* h1) {
    extern __shared__ __attribute__((aligned(16))) unsigned char dl[];
    ProbOut P; P.S.init(T, D, gridDim.x, blockIdx.x); P.A = catb; P.Bt = WoutT; P.R0 = x; P.O = h1;
    gemm_phase(((LAS unsigned char*)dl), P);
}
__global__ __launch_bounds__(512, 2) void k_moe1(const bf16_t* hnb, const bf16_t* WguT, const float* b_gu, const int* cnt, const int* list, bf16_t* act) {
    extern __shared__ __attribute__((aligned(16))) unsigned char dl[];
    LAS unsigned char* lds = (LAS unsigned char*)dl;
    const int RT = moe_tables(lds, cnt);
    ProbMoe1 P; P.S.nN = 8; P.S.G = gridDim.x; P.S.c = blockIdx.x; P.S.RT = RT; P.S.tile_e = (const LAS int*)(lds + LDS_TILE_E); P.S.tile_m = (const LAS int*)(lds + LDS_TILE_M);
    P.A = hnb; P.Bt = WguT; P.bias = b_gu; P.O = act; P.rowtab = (const LAS unsigned*)(lds + LDS_ROWTAB);
    LAS unsigned* rowtab = (LAS unsigned*)(lds + LDS_ROWTAB);
    for (int i = 0; i < 12; ++i) { Unit u; if (!P.S.next(i, u)) break; const int r = threadIdx.x; if (r < 256) { const int pos = u.mt * 256 + r; const int c = cnt[u.e];
        const int tok = (pos < c) ? (list[(size_t)u.e * T + pos] >> 2) : 0; rowtab[i * 256 + r] = (unsigned)tok * (KD * 2); } }
    __syncthreads();
    gemm_phase(lds, P);
}
__global__ __launch_bounds__(512, 2) void k_moe2(const bf16_t* act, const bf16_t* WdnT, const float* b_dn, const int* cnt, const float* wlist, bf16_t* y) {
    extern __shared__ __attribute__((aligned(16))) unsigned char dl[];
    LAS unsigned char* lds = (LAS unsigned char*)dl;
    const int RT = moe_tables(lds, cnt);
    ProbMoe2 P; P.S.nN = 4; P.S.G = gridDim.x; P.S.c = blockIdx.x; P.S.RT = RT; P.S.tile_e = (const LAS int*)(lds + LDS_TILE_E); P.S.tile_m = (const LAS int*)(lds + LDS_TILE_M);
    P.A = act; P.Bt = WdnT; P.bias = b_dn; P.wlist = wlist; P.O = y;
    gemm_phase(lds, P);
}
__global__ __launch_bounds__(256) void k_route2(const float* logits, int* cnt, int* list, float* wlist, int* tinfo) {
    const int t = blockIdx.x * 256 + threadIdx.x; if (t >= T) return;
    const float* lr = logits + (size_t)t * NE; unsigned used = 0u; float tv[4]; int ti[4];
#pragma unroll
    for (int k = 0; k < 4; ++k) { float best = -INFINITY; int bi = 0;
        for (int e = 0; e < NE; ++e) { float v = lr[e]; if (!((used >> e) & 1u) && v > best) { best = v; bi = e; } }
        used |= 1u << bi; tv[k] = best; ti[k] = bi; }
    float m = tv[0], sum = 0.f, w[4];
#pragma unroll
    for (int k = 0; k < 4; ++k) { w[k] = expf(tv[k] - m); sum += w[k]; }
#pragma unroll
    for (int k = 0; k < 4; ++k) { const int pos = atomicAdd(&cnt[ti[k]], 1); list[(size_t)ti[k] * T + pos] = t * 4 + k; wlist[(size_t)ti[k] * T + pos] = w[k] / sum; tinfo[t * 4 + k] = ti[k] | (pos << 8); }
}
__global__ __launch_bounds__(256) void k_combine2(const float* h1, const bf16_t* y, const int* tinfo, const int* cnt, const float* g, float* out) {
    __shared__ float red[4]; __shared__ int toff[NE];
    if (threadIdx.x == 0) { int a = 0; for (int e = 0; e < NE; ++e) { toff[e] = a; a += (cnt[e] + 255) >> 8; } }
    __syncthreads();
    const int t = blockIdx.x; float v[4]; float s = 0.f; size_t so[4];
#pragma unroll
    for (int k = 0; k < 4; ++k) { const int inf = tinfo[t * 4 + k]; so[k] = ((size_t)toff[inf & 255] * 256 + (inf >> 8)) * 1024; }
#pragma unroll
    for (int r = 0; r < 4; ++r) { const int i = threadIdx.x + r * 256; float a = h1[(size_t)t * D + i];
#pragma unroll
        for (int k = 0; k < 4; ++k) a += bf2f(y[so[k] + i]);
        v[r] = a; s += a * a; }
    s = wsum(s); if ((threadIdx.x & 63) == 0) red[threadIdx.x >> 6] = s; __syncthreads();
    s = red[0] + red[1] + red[2] + red[3]; const float rs = rsqrtf(s / (float)D + 1e-6f);
#pragma unroll
    for (int r = 0; r < 4; ++r) { const int i = threadIdx.x + r * 256; out[(size_t)t * D + i] = v[r] * rs * g[i]; }
}
}
extern "C" void kernel_launch(void* const* d_in, const int* in_sizes, int n_in, void* d_out, int out_size, void* d_ws, size_t ws_size, hipStream_t stream) {
    using namespace nv;
    const float* x = (const float*)d_in[0]; const float* attn_norm = (const float*)d_in[1]; const float* w_in = (const float*)d_in[2];
    const float* rel_bias = (const float*)d_in[3]; const float* cmp_pos = (const float*)d_in[4]; const float* cmp_w1 = (const float*)d_in[5];
    const float* cmp_w2 = (const float*)d_in[6]; const float* attn_out_norm = (const float*)d_in[7]; const float* conv_w = (const float*)d_in[8];
    const float* conv_b = (const float*)d_in[9]; const float* dt_bias = (const float*)d_in[10]; const float* a_log = (const float*)d_in[11];
    const float* d_skip = (const float*)d_in[12]; const float* ssm_out_norm = (const float*)d_in[13]; const float* w_out = (const float*)d_in[14];
    const float* ffn_norm = (const float*)d_in[15]; const float* router_w = (const float*)d_in[16]; const float* router_b = (const float*)d_in[17];
    const float* w_gu = (const float*)d_in[18]; const float* b_gu = (const float*)d_in[19]; const float* w_dn = (const float*)d_in[20];
    const float* b_dn = (const float*)d_in[21]; const float* final_norm = (const float*)d_in[22];
    float* out = (float*)d_out;
    char* ws = (char*)d_ws; const size_t MB = 1u << 20;
    typedef mk::bf16_t bf;
    size_t o = 0; auto take = [&](size_t mb) { char* p = ws + o; o += mb * MB; return p; };
    int* cnt = (int*)take(1);
    bf* xb = (bf*)take(32); bf* WinT = (bf*)take(6); bf* WoutT = (bf*)take(2); bf* WguT = (bf*)take(128); bf* WdnT = (bf*)take(64);
    bf* projb = (bf*)take(96); bf* catb = (bf*)take(32); float* h1 = (float*)take(64); float* hn = (float*)take(64); bf* hnb = (bf*)take(32);
    float* rlog = (float*)take(2); int* list = (int*)take(2); float* wlist = (float*)take(2); int* tinfo = (int*)take(1);
    float* hid = (float*)take(2); float* kvc = (float*)take(2); float* dtv = (float*)take(1);
    char* E = take(0);
    float* proj = (float*)(E); float* convx = (float*)(E + 180 * MB); float* o_nsa = (float*)(E + 244 * MB); float* yssd = (float*)(E + 276 * MB);
    bf* act = (bf*)(E); bf* ymoe = (bf*)(E + 144 * MB);
    (void)hipMemsetAsync(cnt, 0, 256, stream);
    static bool attr = false;
    if (!attr) { attr = true;
        (void)hipFuncSetAttribute((const void*)mk::k_proj, hipFuncAttributeMaxDynamicSharedMemorySize, mk::LDS_BYTES);
        (void)hipFuncSetAttribute((const void*)mk::k_outp, hipFuncAttributeMaxDynamicSharedMemorySize, mk::LDS_BYTES);
        (void)hipFuncSetAttribute((const void*)mk::k_moe1, hipFuncAttributeMaxDynamicSharedMemorySize, mk::LDS_BYTES);
        (void)hipFuncSetAttribute((const void*)mk::k_moe2, hipFuncAttributeMaxDynamicSharedMemorySize, mk::LDS_BYTES); }
    mk::k_rms_bf16<<<1024, 256, 0, stream>>>(x, D, xb, D, 1, D, T);
    mk::k_wT<<<dim3(48, 16, 1), 256, 0, stream>>>(w_in, WinT, attn_norm, attn_norm, 1024, 1024, INC, 3072, 0, 0, 1.f);
    mk::k_wT<<<dim3(16, 16, 1), 256, 0, stream>>>(w_out, WoutT, attn_out_norm, ssm_out_norm, 512, 1024, 1024, 1024, 0, 0, 1.f);
    mk::k_wT<<<dim3(32, 16, 32), 256, 0, stream>>>(w_gu, WguT, ffn_norm, ffn_norm, 1024, 1024, 2048, 2048, 1, 0, 1.f);
    mk::k_wT<<<dim3(16, 16, 32), 256, 0, stream>>>(w_dn, WdnT, nullptr, nullptr, 0, 1024, 1024, 1024, 0, 0, 1.f);
    mk::k_proj<<<256, 512, mk::LDS_BYTES, stream>>>(xb, WinT, projb);
    mk::k_bf2f<<<2048, 256, 0, stream>>>(projb, 3072, proj, INC, INC, T);
    const int MC = NB * NCMP * 2;
    k_gemm<false><<<dim3(1, (MC + 63) / 64, 2), 256, 0, stream>>>(ACmp{proj, cmp_pos}, BCmp1{cmp_w1}, ECmp1{hid}, MConst{MC, 0}, 64, 2048);
    k_gemm<false><<<dim3(1, (MC + 63) / 64, 2), 256, 0, stream>>>(ACmp2{hid}, BCmp2{cmp_w2}, ECmp2{kvc}, MConst{MC, 0}, 64, 64);
    k_nsa<<<dim3(T, 2), 256, 0, stream>>>(proj, kvc, kvc + (size_t)MC * 64, rel_bias, o_nsa);
    mk::k_rms_bf16<<<1024, 256, 0, stream>>>(o_nsa, 512, catb, D, 1, 512, T);
    k_ssd_conv<<<T, 256, 0, stream>>>(proj, conv_w, conv_b, dt_bias, convx, dtv);
    k_ssd_scan<<<NB * 8, 256, 0, stream>>>(proj, convx, dtv, a_log, d_skip, yssd);
    mk::k_rms_bf16<<<1024, 256, 0, stream>>>(yssd, 256, catb + 512, D, 2, 256, T * 2);
    mk::k_outp<<<256, 512, mk::LDS_BYTES, stream>>>(catb, WoutT, x, h1);
    k_rmsnorm<<<T, 256, 0, stream>>>(h1, D, ffn_norm, hn, D, 1, D);
    mk::k_rms_bf16<<<1024, 256, 0, stream>>>(h1, D, hnb, D, 1, D, T);
    k_gemm<false><<<dim3(1, T / 64, 1), 256, 0, stream>>>(ARow{hn, D, 0}, BRow{router_w, NE, 0}, EBias{router_b, rlog, NE, 0}, MConst{T, 0}, NE, D);
    mk::k_route2<<<T / 256, 256, 0, stream>>>(rlog, cnt, list, wlist, tinfo);
    mk::k_moe1<<<256, 512, mk::LDS_BYTES, stream>>>(hnb, WguT, b_gu, cnt, list, act);
    mk::k_moe2<<<256, 512, mk::LDS_BYTES, stream>>>(act, WdnT, b_dn, cnt, wlist, ymoe);
    mk::k_combine2<<<T, 256, 0, stream>>>(h1, ymoe, tinfo, cnt, final_norm, out);
}
```

```cpp
#include <hip/hip_runtime.h>
#include <stdint.h>
#include <math.h>

namespace nv {
constexpr int NB = 8, S = 2048, D = 1024, T = NB * S;
constexpr int INC = 2848;
constexpr int KVOFF = 512, GOFF = 1280, ZOFF = 1304, XBCOFF = 1816, DTOFF = 2840;
constexpr int NCMP = 127, NE = 32;
constexpr float EPS = 1e-6f;

__device__ __forceinline__ float wave_sum(float v) { for (int o = 32; o >= 1; o >>= 1) v += __shfl_xor(v, o); return v; }
__device__ __forceinline__ float wave_max(float v) { for (int o = 32; o >= 1; o >>= 1) v = fmaxf(v, __shfl_xor(v, o)); return v; }
__device__ __forceinline__ float siluf(float x) { return x / (1.f + expf(-x)); }
__device__ __forceinline__ float sigmf(float x) { return 1.f / (1.f + expf(-x)); }
__device__ __forceinline__ int t5_bucket(int n) {
    if (n < 0) n = 0;
    if (n < 16) return n;
    float nf = (float)n;
    int l = 16 + (int)(logf(nf / 16.f) / 2.0794415416798357f * 16.f);
    return l < 31 ? l : 31;
}

__global__ __launch_bounds__(256) void k_rmsnorm(const float* in, int ldi, const float* g, float* out, int ldo, int ng, int Dn) {
    __shared__ float red[4];
    const int r = blockIdx.x; const float* xr = in + (size_t)r * ldi;
    float s = 0.f; for (int i = threadIdx.x; i < Dn; i += 256) { float v = xr[i]; s += v * v; }
    s = wave_sum(s); if ((threadIdx.x & 63) == 0) red[threadIdx.x >> 6] = s; __syncthreads();
    s = red[0] + red[1] + red[2] + red[3];
    const float rs = rsqrtf(s / (float)Dn + EPS);
    float* o = out + (size_t)(r / ng) * ldo + (size_t)(r % ng) * Dn; const float* gg = g + (size_t)(r % ng) * Dn;
    for (int i = threadIdx.x; i < Dn; i += 256) o[i] = xr[i] * rs * gg[i];
}

template <bool DUAL, class AF, class BF, class EF, class MF>
__global__ __launch_bounds__(256) void k_gemm(AF af, BF bf, EF ef, MF mf, int N, int K) {
    __shared__ float sA[16][65]; __shared__ float sB[16][65]; __shared__ float sB2[16][65];
    const int z = blockIdx.z, M = mf(z);
    const int m0 = blockIdx.y * 64, n0 = blockIdx.x * 64;
    if (m0 >= M) return;
    const int tx = threadIdx.x & 15, ty = threadIdx.x >> 4;
    float acc[4][4], acc2[4][4];
#pragma unroll
    for (int i = 0; i < 4; ++i)
#pragma unroll
        for (int j = 0; j < 4; ++j) { acc[i][j] = 0.f; acc2[i][j] = 0.f; }
    for (int k0 = 0; k0 < K; k0 += 16) {
#pragma unroll
        for (int i = 0; i < 4; ++i) { int e = threadIdx.x + i * 256; int m = e >> 4, k = e & 15; sA[k][m] = (m0 + m < M) ? af(z, m0 + m, k0 + k) : 0.f; }
#pragma unroll
        for (int i = 0; i < 4; ++i) { int e = threadIdx.x + i * 256; int k = e >> 6, n = e & 63; sB[k][n] = (n0 + n < N) ? bf(z, k0 + k, n0 + n) : 0.f;
            if (DUAL) sB2[k][n] = (n0 + n < N) ? bf(z, k0 + k, n0 + n + N) : 0.f; }
        __syncthreads();
#pragma unroll
        for (int k = 0; k < 16; ++k) {
            float a[4], b[4], b2[4];
#pragma unroll
            for (int i = 0; i < 4; ++i) { a[i] = sA[k][ty * 4 + i]; b[i] = sB[k][tx * 4 + i]; b2[i] = DUAL ? sB2[k][tx * 4 + i] : 0.f; }
#pragma unroll
            for (int i = 0; i < 4; ++i)
#pragma unroll
                for (int j = 0; j < 4; ++j) { acc[i][j] += a[i] * b[j]; if (DUAL) acc2[i][j] += a[i] * b2[j]; }
        }
        __syncthreads();
    }
#pragma unroll
    for (int i = 0; i < 4; ++i)
#pragma unroll
        for (int j = 0; j < 4; ++j) { int m = m0 + ty * 4 + i, n = n0 + tx * 4 + j; if (m < M && n < N) ef(z, m, n, acc[i][j], acc2[i][j]); }
}
struct MConst { int M; int pad; __device__ int operator()(int) const { return M; } };
struct MCnt { const int* cnt; __device__ int operator()(int z) const { return cnt[z]; } };
struct ARow { const float* A; int lda; int pad; __device__ float operator()(int, int m, int k) const { return A[(size_t)m * lda + k]; } };
struct BRow { const float* B; int ldb; int pad; __device__ float operator()(int, int k, int n) const { return B[(size_t)k * ldb + n]; } };
struct EStore { float* C; int ldc; int pad; __device__ void operator()(int, int m, int n, float a, float) const { C[(size_t)m * ldc + n] = a; } };
struct EResid { const float* R; float* C; int ldc; int pad; __device__ void operator()(int, int m, int n, float a, float) const { C[(size_t)m * ldc + n] = R[(size_t)m * ldc + n] + a; } };
struct EBias { const float* bias; float* C; int ldc; int pad; __device__ void operator()(int, int m, int n, float a, float) const { C[(size_t)m * ldc + n] = a + bias[n]; } };
struct ACmp { const float* proj; const float* pos; __device__ float operator()(int z, int m, int k) const {
    int kvh = m & 1, bc = m >> 1, c = bc % NCMP, b = bc / NCMP, l = k >> 6, d = k & 63;
    return proj[(size_t)(b * S + c * 16 + l) * INC + KVOFF + z * 128 + kvh * 64 + d] + pos[(z * 32 + l) * 64 + d]; } };
struct BCmp1 { const float* w; __device__ float operator()(int z, int k, int n) const { return w[((size_t)z * 2048 + k) * 64 + n]; } };
struct ECmp1 { float* hid; __device__ void operator()(int z, int m, int n, float a, float) const { hid[((size_t)z * (NB * NCMP * 2) + m) * 64 + n] = siluf(a); } };
struct ACmp2 { const float* hid; __device__ float operator()(int z, int m, int k) const { return hid[((size_t)z * (NB * NCMP * 2) + m) * 64 + k]; } };
struct BCmp2 { const float* w; __device__ float operator()(int z, int k, int n) const { return w[((size_t)z * 64 + k) * 64 + n]; } };
struct ECmp2 { float* kvc; __device__ void operator()(int z, int m, int n, float a, float) const { kvc[((size_t)z * (NB * NCMP * 2) + m) * 64 + n] = a; } };
struct AMoe1 { const float* hn; const int* list; __device__ float operator()(int z, int m, int k) const { int tk = list[(size_t)z * T + m]; return hn[(size_t)(tk >> 2) * D + k]; } };
struct BMoe1 { const float* w; __device__ float operator()(int z, int k, int n) const { return w[((size_t)z * 1024 + k) * 2048 + n]; } };
struct EMoe1 { const float* bias; const int* list; float* act; __device__ void operator()(int z, int m, int n, float a, float a2) const {
    int tk = list[(size_t)z * T + m]; float g = a + bias[z * 2048 + n], u = a2 + bias[z * 2048 + 1024 + n];
    g = fminf(g, 7.f); u = fminf(fmaxf(u, -7.f), 7.f);
    act[(size_t)tk * 1024 + n] = (u + 1.f) * g * sigmf(1.702f * g); } };
struct AMoe2 { const float* act; const int* list; __device__ float operator()(int z, int m, int k) const { int tk = list[(size_t)z * T + m]; return act[(size_t)tk * 1024 + k]; } };
struct BMoe2 { const float* w; __device__ float operator()(int z, int k, int n) const { return w[((size_t)z * 1024 + k) * 1024 + n]; } };
struct EMoe2 { const float* bias; const int* list; float* y; __device__ void operator()(int z, int m, int n, float a, float) const {
    int tk = list[(size_t)z * T + m]; y[(size_t)tk * 1024 + n] = a + bias[z * 1024 + n]; } };

__global__ __launch_bounds__(256) void k_nsa(const float* proj, const float* kc, const float* vc, const float* rel_bias, float* o_nsa) {
    __shared__ float q_s[4][64]; __shared__ float pc[4][128]; __shared__ float lg[4][1024];
    __shared__ float score_s[32]; __shared__ int sellist[32]; __shared__ int nsel_s;
    const int row = blockIdx.x, kvh = blockIdx.y, b = row / S, t = row % S;
    const int g = threadIdx.x >> 6, i = threadIdx.x & 63, head = kvh * 4 + g, blk = t >> 6;
    const float* pr = proj + (size_t)row * INC;
    q_s[g][i] = pr[head * 64 + i];
    __syncthreads();
    const int nvalid = (t >= 31) ? ((t - 31) / 16 + 1) : 0;
    float lv[2]; float mx = -1e30f;
#pragma unroll
    for (int r = 0; r < 2; ++r) { int c = i + r * 64; float l = -1e30f;
        if (c < nvalid) { const float* kr = kc + ((size_t)(b * NCMP + c) * 2 + kvh) * 64; float s = 0.f; for (int d = 0; d < 64; ++d) s += q_s[g][d] * kr[d];
            l = s * 0.125f + rel_bias[t5_bucket(t - (c * 16 + 31)) * 8 + head]; }
        lv[r] = l; mx = fmaxf(mx, l); }
    mx = wave_max(mx);
    float sm = 0.f;
#pragma unroll
    for (int r = 0; r < 2; ++r) { int c = i + r * 64; float p = (c < nvalid) ? expf(lv[r] - mx) : 0.f; lv[r] = p; sm += p; }
    sm = wave_sum(sm); const float inv = 1.f / fmaxf(sm, 1e-30f);
#pragma unroll
    for (int r = 0; r < 2; ++r) pc[g][i + r * 64] = lv[r] * inv;
    __syncthreads();
    float o_cmp = 0.f;
    for (int c = 0; c < nvalid; ++c) o_cmp += pc[g][c] * vc[((size_t)(b * NCMP + c) * 2 + kvh) * 64 + i];
    if (threadIdx.x < 32) { int n = threadIdx.x; float im = 0.f;
        for (int gg = 0; gg < 4; ++gg) for (int c = 4 * n - 1; c <= 4 * n + 3; ++c) if (c >= 0 && c < NCMP) im += pc[gg][c];
        bool forced = (n == 0) || (n == blk) || (n == blk - 1);
        score_s[n] = forced ? 1e4f : ((n <= blk) ? im : -1.f); }
    __syncthreads();
    if (threadIdx.x == 0) { int ns = 0;
        for (int n = 0; n < 32; ++n) { float sn = score_s[n]; int rank = 0; for (int m = 0; m < 32; ++m) { float s2 = score_s[m]; if (s2 > sn || (s2 == sn && m < n)) ++rank; }
            if (rank < 16 && n <= blk) sellist[ns++] = n; }
        nsel_s = ns; }
    __syncthreads();
    const int nsel = nsel_s;
    float o_slc = 0.f;
    { const int nk = nsel * 64; float m2 = -1e30f;
      for (int kk = i; kk < nk; kk += 64) { int kp = sellist[kk >> 6] * 64 + (kk & 63); float l = -1e30f;
          if (kp <= t) { const float* kr = proj + (size_t)(b * S + kp) * INC + KVOFF + 2 * 128 + kvh * 64; float s = 0.f; for (int d = 0; d < 64; ++d) s += q_s[g][d] * kr[d];
              l = s * 0.125f + rel_bias[t5_bucket(t - kp) * 8 + head]; }
          lg[g][kk] = l; m2 = fmaxf(m2, l); }
      m2 = wave_max(m2); float s2 = 0.f;
      for (int kk = i; kk < nk; kk += 64) { int kp = sellist[kk >> 6] * 64 + (kk & 63); float p = (kp <= t) ? expf(lg[g][kk] - m2) : 0.f; lg[g][kk] = p; s2 += p; }
      s2 = wave_sum(s2); const float inv2 = 1.f / fmaxf(s2, 1e-30f);
      __syncthreads();
      for (int kk = 0; kk < nk; ++kk) { int kp = sellist[kk >> 6] * 64 + (kk & 63); if (kp <= t) o_slc += lg[g][kk] * proj[(size_t)(b * S + kp) * INC + KVOFF + 3 * 128 + kvh * 64 + i]; }
      o_slc *= inv2; }
    __syncthreads();
    float o_win = 0.f;
    { float m2 = -1e30f;
      for (int kk = i; kk < 512; kk += 64) { int kp = t - 511 + kk; float l = -1e30f;
          if (kp >= 0) { const float* kr = proj + (size_t)(b * S + kp) * INC + KVOFF + 4 * 128 + kvh * 64; float s = 0.f; for (int d = 0; d < 64; ++d) s += q_s[g][d] * kr[d];
              l = s * 0.125f + rel_bias[t5_bucket(t - kp) * 8 + head]; }
          lg[g][kk] = l; m2 = fmaxf(m2, l); }
      m2 = wave_max(m2); float s2 = 0.f;
      for (int kk = i; kk < 512; kk += 64) { int kp = t - 511 + kk; float p = (kp >= 0) ? expf(lg[g][kk] - m2) : 0.f; lg[g][kk] = p; s2 += p; }
      s2 = wave_sum(s2); const float inv2 = 1.f / fmaxf(s2, 1e-30f);
      __syncthreads();
      for (int kk = 0; kk < 512; ++kk) { int kp = t - 511 + kk; if (kp >= 0) o_win += lg[g][kk] * proj[(size_t)(b * S + kp) * INC + KVOFF + 5 * 128 + kvh * 64 + i]; }
      o_win *= inv2; }
    const float g0 = sigmf(pr[GOFF + 0 * 8 + head]), g1 = sigmf(pr[GOFF + 1 * 8 + head]), g2 = sigmf(pr[GOFF + 2 * 8 + head]);
    o_nsa[(size_t)row * 512 + head * 64 + i] = g0 * o_cmp + g1 * o_slc + g2 * o_win;
}

__global__ __launch_bounds__(256) void k_ssd_conv(const float* proj, const float* conv_w, const float* conv_b, const float* dt_bias, float* convx, float* dtv) {
    const int row = blockIdx.x, s = row % S;
    for (int ch = threadIdx.x; ch < 1024; ch += 256) { float a = conv_b[ch];
#pragma unroll
        for (int k = 0; k < 4; ++k) { int ss = s - 3 + k; if (ss >= 0) a += proj[(size_t)(row - 3 + k) * INC + XBCOFF + ch] * conv_w[k * 1024 + ch]; }
        convx[(size_t)row * 1024 + ch] = siluf(a); }
    if (threadIdx.x < 8) { float x = proj[(size_t)row * INC + DTOFF + threadIdx.x] + dt_bias[threadIdx.x]; dtv[row * 8 + threadIdx.x] = (x > 20.f) ? x : log1pf(expf(x)); }
}
__global__ __launch_bounds__(256) void k_ssd_scan(const float* proj, const float* convx, const float* dtv, const float* a_log, const float* d_skip, float* yssd) {
    const int b = blockIdx.x >> 3, h = blockIdx.x & 7, grp = h >> 2, p = threadIdx.x >> 2, nq = threadIdx.x & 3;
    const float A = -expf(a_log[h]), Dh = d_skip[h];
    float st[32];
#pragma unroll
    for (int j = 0; j < 32; ++j) st[j] = 0.f;
    for (int s = 0; s < S; ++s) { const size_t row = (size_t)b * S + s; const float* cx = convx + row * 1024;
        const float dt = dtv[row * 8 + h], xv = cx[h * 64 + p], dA = expf(dt * A), dx = dt * xv;
        const float* Bn = cx + 512 + grp * 128 + nq * 32; const float* Cn = cx + 768 + grp * 128 + nq * 32;
        float y = 0.f;
#pragma unroll
        for (int j = 0; j < 32; ++j) { st[j] = dA * st[j] + dx * Bn[j]; y += Cn[j] * st[j]; }
        y += __shfl_xor(y, 1); y += __shfl_xor(y, 2);
        if (nq == 0) { float z = proj[row * INC + ZOFF + h * 64 + p]; yssd[row * 512 + h * 64 + p] = (y + Dh * xv) * siluf(z); } }
}
__global__ __launch_bounds__(256) void k_route(const float* logits, int* cnt, int* list, float* topw) {
    const int t = blockIdx.x * 256 + threadIdx.x; if (t >= T) return;
    const float* lr = logits + (size_t)t * NE; unsigned used = 0u; float tv[4]; int ti[4];
#pragma unroll
    for (int k = 0; k < 4; ++k) { float best = -INFINITY; int bi = 0;
        for (int e = 0; e < NE; ++e) { float v = lr[e]; if (!((used >> e) & 1u) && v > best) { best = v; bi = e; } }
        used |= 1u << bi; tv[k] = best; ti[k] = bi; }
    float m = tv[0], sum = 0.f, w[4];
#pragma unroll
    for (int k = 0; k < 4; ++k) { w[k] = expf(tv[k] - m); sum += w[k]; }
#pragma unroll
    for (int k = 0; k < 4; ++k) { topw[t * 4 + k] = w[k] / sum; int pos = atomicAdd(&cnt[ti[k]], 1); list[(size_t)ti[k] * T + pos] = t * 4 + k; }
}
__global__ __launch_bounds__(256) void k_combine(const float* h1, const float* y, const float* topw, const float* g, float* out) {
    __shared__ float red[4];
    const int t = blockIdx.x; float v[4]; float s = 0.f;
#pragma unroll
    for (int r = 0; r < 4; ++r) { int i = threadIdx.x + r * 256; float a = h1[(size_t)t * D + i];
#pragma unroll
        for (int k = 0; k < 4; ++k) a += topw[t * 4 + k] * y[(size_t)(t * 4 + k) * D + i];
        v[r] = a; s += a * a; }
    s = wave_sum(s); if ((threadIdx.x & 63) == 0) red[threadIdx.x >> 6] = s; __syncthreads();
    s = red[0] + red[1] + red[2] + red[3]; const float rs = rsqrtf(s / (float)D + EPS);
#pragma unroll
    for (int r = 0; r < 4; ++r) { int i = threadIdx.x + r * 256; out[(size_t)t * D + i] = v[r] * rs * g[i]; }
}
}

namespace mk {
#define LAS __attribute__((address_space(3)))
typedef unsigned short bf16_t;
typedef short bf16x8 __attribute__((ext_vector_type(8)));
typedef float f32x4 __attribute__((ext_vector_type(4)));
typedef unsigned u32x4 __attribute__((ext_vector_type(4)));
typedef unsigned u32x2 __attribute__((ext_vector_type(2)));
constexpr int NB = 8, S = 2048, D = 1024, T = NB * S, NE = 32;
constexpr int BM = 256, BK = 64, HALF = 128, HTB = HALF * BK * 2, STAGE_BYTES = 8 * HTB, NXCD = 8, WGM = 8;
constexpr int KD = 1024;
constexpr int NPROJ = 3072;
constexpr int MAXSLOT = 65536 + 32 * 256;
constexpr int LDS_MISC = 131072, LDS_TILE_E = LDS_MISC + 64, LDS_TILE_M = LDS_TILE_E + 1536, LDS_ROWTAB = LDS_MISC + 4096, LDS_BYTES = LDS_ROWTAB + 12 * 1024;

__host__ __device__ __forceinline__ int lds_byte(int r, int c) { const int st = (r >> 4) * 2 + (c >> 5), rr = r & 15, cc = c & 31, ob = rr * 64 + cc * 2; return st * 1024 + (ob ^ (((ob >> 9) & 1) << 5)); }
__host__ __device__ __forceinline__ void stage_rc(int b, int& R, int& C) { const int st = b / 1024, sb = b % 1024, swz = sb ^ (((sb >> 9) & 1) << 5); R = (st >> 1) * 16 + swz / 64; C = (st & 1) * 32 + (swz % 64) / 2; }
__host__ __device__ __forceinline__ int perm32(int rho) { const int n = rho >> 4, i = rho & 15; return 8 * (i >> 2) + 4 * n + (i & 3); }
__device__ __forceinline__ unsigned cvt_pk_bf16(float lo, float hi) { unsigned r; asm volatile("v_cvt_pk_bf16_f32 %0, %1, %2" : "=v"(r) : "v"(lo), "v"(hi)); return r; }
__device__ __forceinline__ float bf2f(bf16_t b) { return __uint_as_float(((unsigned)b) << 16); }

struct Unit { int pm, pn, e, mt; };
struct StaticOrder {
    int nM, nN, nwg, G, c;
    __device__ void init(int M, int N, int G_, int c_) { nM = M / BM; nN = N / BM; nwg = nM * nN; G = G_; c = c_; }
    __device__ bool next(int i, Unit& u) const {
        const long L = (long)i * G + c; if (L >= nwg) return false;
        int wgid = (int)L; { const int q = nwg / NXCD, r = nwg % NXCD, xcd = wgid % NXCD, off = wgid / NXCD; wgid = (xcd < r ? xcd * (q + 1) : r * (q + 1) + (xcd - r) * q) + off; }
        const int nig = WGM * nN, gid = wgid / nig, fm = gid * WGM, gsz = (nM - fm) < WGM ? (nM - fm) : WGM;
        u.pm = fm + ((wgid % nig) % gsz); u.pn = (wgid % nig) / gsz; u.e = 0; u.mt = 0; return true;
    }
};
struct MoeOrder {
    int nN, G, c, RT; const LAS int* tile_e; const LAS int* tile_m;
    __device__ bool next(int i, Unit& u) const { const int L = i * G + c; if (L >= RT * nN) return false; const int rt = L / nN; u.pm = rt; u.pn = L - rt * nN; u.e = tile_e[rt]; u.mt = tile_m[rt]; return true; }
};

struct ProbProj {
    static constexpr bool PERM = true;
    StaticOrder S; const bf16_t* A; const bf16_t* Bt; bf16_t* O;
    __device__ __forceinline__ bool next(int i, Unit& u) const { return S.next(i, u); }
    __device__ __forceinline__ const char* a_base(const Unit& u) const { return (const char*)A + (size_t)u.pm * (BM * KD * 2); }
    __device__ __forceinline__ const char* b_base(const Unit& u) const { return (const char*)Bt + (size_t)u.pn * (BM * KD * 2); }
    __device__ __forceinline__ void a_offs(int, const Unit&, unsigned (&v0)[2], unsigned (&v1)[2], const int (&R)[2], const int (&C)[2]) const {
#pragma unroll
        for (int i = 0; i < 2; ++i) { v0[i] = (unsigned)(R[i] * KD + C[i]) * 2u; v1[i] = v0[i] + (unsigned)(HALF * KD * 2); } }
    __device__ __forceinline__ void epi(const f32x4 (&acc)[2][2][4][2], const Unit& u, int wr, int wc, int fr, int fq) const {
        const int row0 = u.pm * BM + wr * 64 + fr, col0 = u.pn * BM + wc * 32 + 8 * fq;
#pragma unroll
        for (int ai = 0; ai < 2; ++ai)
#pragma unroll
            for (int m = 0; m < 4; ++m) { bf16_t* rowp = O + (size_t)(row0 + ai * HALF + m * 16) * NPROJ + col0;
#pragma unroll
                for (int bj = 0; bj < 2; ++bj) { const f32x4 v0 = acc[ai][bj][m][0], v1 = acc[ai][bj][m][1]; u32x4 w;
                    w.x = cvt_pk_bf16(v0[0], v0[1]); w.y = cvt_pk_bf16(v0[2], v0[3]); w.z = cvt_pk_bf16(v1[0], v1[1]); w.w = cvt_pk_bf16(v1[2], v1[3]);
                    *(u32x4*)(rowp + bj * HALF) = w; } }
    }
};
struct ProbOut {
    static constexpr bool PERM = false;
    StaticOrder S; const bf16_t* A; const bf16_t* Bt; const float* R0; float* O;
    __device__ __forceinline__ bool next(int i, Unit& u) const { return S.next(i, u); }
    __device__ __forceinline__ const char* a_base(const Unit& u) const { return (const char*)A + (size_t)u.pm * (BM * KD * 2); }
    __device__ __forceinline__ const char* b_base(const Unit& u) const { return (const char*)Bt + (size_t)u.pn * (BM * KD * 2); }
    __device__ __forceinline__ void a_offs(int, const Unit&, unsigned (&v0)[2], unsigned (&v1)[2], const int (&R)[2], const int (&C)[2]) const {
#pragma unroll
        for (int i = 0; i < 2; ++i) { v0[i] = (unsigned)(R[i] * KD + C[i]) * 2u; v1[i] = v0[i] + (unsigned)(HALF * KD * 2); } }
    __device__ __forceinline__ void epi(const f32x4 (&acc)[2][2][4][2], const Unit& u, int wr, int wc, int fr, int fq) const {
        const int row0 = u.pm * BM + wr * 64 + fr, col0 = u.pn * BM + wc * 32 + 4 * fq;
#pragma unroll
        for (int ai = 0; ai < 2; ++ai)
#pragma unroll
            for (int m = 0; m < 4; ++m) { const size_t off = (size_t)(row0 + ai * HALF + m * 16) * D + col0;
#pragma unroll
                for (int bj = 0; bj < 2; ++bj)
#pragma unroll
                    for (int n = 0; n < 2; ++n) { const f32x4 r = *(const f32x4*)(R0 + off + bj * HALF + n * 16); *(f32x4*)(O + off + bj * HALF + n * 16) = acc[ai][bj][m][n] + r; }
                asm volatile("" ::: "memory"); }
    }
};
struct ProbMoe1 {
    static constexpr bool PERM = true;
    MoeOrder S; const bf16_t* A; const bf16_t* Bt; const float* bias; bf16_t* O; const LAS unsigned* rowtab;
    __device__ __forceinline__ bool next(int i, Unit& u) const { return S.next(i, u); }
    __device__ __forceinline__ const char* a_base(const Unit&) const { return (const char*)A; }
    __device__ __forceinline__ const char* b_base(const Unit& u) const { return (const char*)Bt + ((size_t)u.e * 2048 + (size_t)u.pn * BM) * (KD * 2); }
    __device__ __forceinline__ void a_offs(int i, const Unit&, unsigned (&v0)[2], unsigned (&v1)[2], const int (&R)[2], const int (&C)[2]) const {
#pragma unroll
        for (int j = 0; j < 2; ++j) { v0[j] = rowtab[i * 256 + R[j]] + (unsigned)C[j] * 2u; v1[j] = rowtab[i * 256 + HALF + R[j]] + (unsigned)C[j] * 2u; } }
    __device__ __forceinline__ void epi(const f32x4 (&acc)[2][2][4][2], const Unit& u, int wr, int wc, int fr, int fq) const {
        const int row0 = u.pm * BM + wr * 64 + fr, jg0 = u.pn * HALF + wc * 32 + 8 * fq;
        f32x4 bg[2], bu[2];
#pragma unroll
        for (int n = 0; n < 2; ++n) { bg[n] = *(const f32x4*)(bias + u.e * 2048 + jg0 + 4 * n); bu[n] = *(const f32x4*)(bias + u.e * 2048 + 1024 + jg0 + 4 * n); }
#pragma unroll
        for (int ai = 0; ai < 2; ++ai)
#pragma unroll
            for (int m = 0; m < 4; ++m) { float o[8];
#pragma unroll
                for (int n = 0; n < 2; ++n) { const f32x4 g4 = acc[ai][0][m][n] + bg[n], u4 = acc[ai][1][m][n] + bu[n];
#pragma unroll
                    for (int j = 0; j < 4; ++j) { const float g = fminf(g4[j], 7.f), uu = fminf(fmaxf(u4[j], -7.f), 7.f);
                        const float sg = __builtin_amdgcn_rcpf(1.f + __builtin_amdgcn_exp2f(-1.702f * 1.4426950408889634f * g)); o[n * 4 + j] = (uu + 1.f) * g * sg; } }
                u32x4 w; w.x = cvt_pk_bf16(o[0], o[1]); w.y = cvt_pk_bf16(o[2], o[3]); w.z = cvt_pk_bf16(o[4], o[5]); w.w = cvt_pk_bf16(o[6], o[7]);
                *(u32x4*)(O + (size_t)(row0 + ai * HALF + m * 16) * 1024 + jg0) = w; }
    }
};
struct ProbMoe2 {
    static constexpr bool PERM = true;
    MoeOrder S; const bf16_t* A; const bf16_t* Bt; const float* bias; const float* wlist; bf16_t* O;
    __device__ __forceinline__ bool next(int i, Unit& u) const { return S.next(i, u); }
    __device__ __forceinline__ const char* a_base(const Unit& u) const { return (const char*)A + (size_t)u.pm * (BM * KD * 2); }
    __device__ __forceinline__ const char* b_base(const Unit& u) const { return (const char*)Bt + ((size_t)u.e * 1024 + (size_t)u.pn * BM) * (KD * 2); }
    __device__ __forceinline__ void a_offs(int, const Unit&, unsigned (&v0)[2], unsigned (&v1)[2], const int (&R)[2], const int (&C)[2]) const {
#pragma unroll
        for (int i = 0; i < 2; ++i) { v0[i] = (unsigned)(R[i] * KD + C[i]) * 2u; v1[i] = v0[i] + (unsigned)(HALF * KD * 2); } }
    __device__ __forceinline__ void epi(const f32x4 (&acc)[2][2][4][2], const Unit& u, int wr, int wc, int fr, int fq) const {
        const int rl0 = wr * 64 + fr, col0 = u.pn * BM + wc * 32 + 8 * fq;
        f32x4 bv[2][2];
#pragma unroll
        for (int bj = 0; bj < 2; ++bj)
#pragma unroll
            for (int n = 0; n < 2; ++n) bv[bj][n] = *(const f32x4*)(bias + u.e * 1024 + col0 + bj * HALF + 4 * n);
#pragma unroll
        for (int ai = 0; ai < 2; ++ai)
#pragma unroll
            for (int m = 0; m < 4; ++m) { const int rl = rl0 + ai * HALF + m * 16; const float wt = wlist[(size_t)u.e * T + u.mt * BM + rl];
                bf16_t* rowp = O + (size_t)(u.pm * BM + rl) * 1024 + col0;
#pragma unroll
                for (int bj = 0; bj < 2; ++bj) { const f32x4 v0 = (acc[ai][bj][m][0] + bv[bj][0]) * wt, v1 = (acc[ai][bj][m][1] + bv[bj][1]) * wt; u32x4 w;
                    w.x = cvt_pk_bf16(v0[0], v0[1]); w.y = cvt_pk_bf16(v0[2], v0[3]); w.z = cvt_pk_bf16(v1[0], v1[1]); w.w = cvt_pk_bf16(v1[2], v1[3]);
                    *(u32x4*)(rowp + bj * HALF) = w; } }
    }
};

template <class P>
__device__ __forceinline__ void gemm_phase(LAS unsigned char* lds, const P& Pb) {
    const int tid = threadIdx.x, wid = __builtin_amdgcn_readfirstlane(tid >> 6), lane = tid & 63, wr = wid >> 2, wc = wid & 3, fr = lane & 15, fq = lane >> 4;
    constexpr int nt = KD / BK;
    int Rr[2], Cc[2]; unsigned voffB[2];
#pragma unroll
    for (int i = 0; i < 2; ++i) { int R, C; stage_rc(tid * 16 + i * 8192, R, C); const int Rb = P::PERM ? ((R & ~31) + perm32(R & 31)) : R; Rr[i] = R; Cc[i] = C; voffB[i] = (unsigned)(Rb * KD + C) * 2u; }
    constexpr size_t kstep = (size_t)(BK * 2);
    constexpr size_t hstep = (size_t)HALF * KD * 2;
    const unsigned ldsw = (unsigned)wid * 1024u;
    const int aoff = lds_byte(wr * 64 + fr, fq * 8), boff = lds_byte(wc * 32 + fr, fq * 8);
#define PG8_SA(b, h) (((b) * 2 + (h)) * HTB)
#define PG8_SB(b, h) ((4 + (b) * 2 + (h)) * HTB)
#define PG8_STAGE(bufoff, gbase, voff) do { _Pragma("unroll") for (int _i = 0; _i < 2; ++_i) \
        __builtin_amdgcn_global_load_lds((const unsigned*)((const char*)(gbase) + (voff)[_i]), (LAS unsigned*)(lds + (bufoff) + ldsw + _i * 8192), 16, 0, 0); } while (0)
#define PG8_LDA(dst, b, h) do { _Pragma("unroll") for (int m = 0; m < 4; ++m) _Pragma("unroll") for (int k = 0; k < 2; ++k) dst[m][k] = *(const LAS bf16x8*)(lds + PG8_SA(b, h) + aoff + m * 2048 + k * 1024); } while (0)
#define PG8_LDB(dst, b, h) do { _Pragma("unroll") for (int n = 0; n < 2; ++n) _Pragma("unroll") for (int k = 0; k < 2; ++k) dst[n][k] = *(const LAS bf16x8*)(lds + PG8_SB(b, h) + boff + n * 2048 + k * 1024); } while (0)
#define PG8_MMA(ai, bj, At, Bt) do { __builtin_amdgcn_s_setprio(1); _Pragma("unroll") for (int m = 0; m < 4; ++m) _Pragma("unroll") for (int n = 0; n < 2; ++n) _Pragma("unroll") for (int k = 0; k < 2; ++k) \
        acc[ai][bj][m][n] = __builtin_amdgcn_mfma_f32_16x16x32_bf16(Bt[n][k], At[m][k], acc[ai][bj][m][n], 0, 0, 0); __builtin_amdgcn_s_setprio(0); } while (0)
#define PG8_WAIT_V(n) asm volatile("s_waitcnt vmcnt(" #n ")" ::: "memory")
#define PG8_WAIT_L(n) asm volatile("s_waitcnt lgkmcnt(" #n ")" ::: "memory")
#define PG8_BAR __builtin_amdgcn_s_barrier()
#define PG8_SCHED __builtin_amdgcn_sched_barrier(0)
    Unit cur, nxt; int ui = 0;
    if (!Pb.next(0, cur)) return;
    f32x4 acc[2][2][4][2];
#pragma unroll
    for (int a = 0; a < 2; ++a)
#pragma unroll
        for (int b = 0; b < 2; ++b)
#pragma unroll
            for (int m = 0; m < 4; ++m)
#pragma unroll
                for (int n = 0; n < 2; ++n) acc[a][b][m][n] = (f32x4){0.f, 0.f, 0.f, 0.f};
    bf16x8 At[4][2], B0[2][2], B1[2][2];
    unsigned vA0[2], vA1[2];
    Pb.a_offs(0, cur, vA0, vA1, Rr, Cc);
    const char* cA = Pb.a_base(cur); const char* cB = Pb.b_base(cur);
    PG8_STAGE(PG8_SB(0, 0), cB, voffB); PG8_STAGE(PG8_SB(0, 1), cB + hstep, voffB); PG8_STAGE(PG8_SA(0, 0), cA, vA0); PG8_STAGE(PG8_SA(0, 1), cA, vA1);
    if (wr == 1) PG8_BAR;
    PG8_WAIT_V(2); PG8_BAR;
    PG8_STAGE(PG8_SB(1, 0), cB + kstep, voffB); PG8_STAGE(PG8_SA(1, 0), cA + kstep, vA0); PG8_STAGE(PG8_SB(1, 1), cB + hstep + kstep, voffB);
    PG8_WAIT_V(6); PG8_BAR;
    for (;;) {
        const bool has_next = Pb.next(ui + 1, nxt);
        const char* nA = has_next ? Pb.a_base(nxt) : cA; const char* nB = has_next ? Pb.b_base(nxt) : cB;
        for (int t = 0; t < nt; t += 2) {
            const bool last = (t == nt - 2);
            const char* a1 = cA + (size_t)(t + 1) * kstep;
            const char* a2 = last ? nA : cA + (size_t)(t + 2) * kstep; const char* b2 = last ? nB : cB + (size_t)(t + 2) * kstep;
            const char* a3 = a2 + kstep; const char* b3 = b2 + kstep;
            PG8_LDB(B0, 0, 0); PG8_LDB(B1, 0, 1); PG8_SCHED; PG8_LDA(At, 0, 0); PG8_STAGE(PG8_SA(1, 1), a1, vA1);
            PG8_WAIT_V(8); PG8_WAIT_L(0); PG8_BAR; PG8_MMA(0, 0, At, B0); PG8_MMA(0, 1, At, B1); PG8_BAR; PG8_SCHED;
            if (last && has_next) Pb.a_offs(ui + 1, nxt, vA0, vA1, Rr, Cc);
            PG8_LDA(At, 0, 1); PG8_STAGE(PG8_SB(0, 0), b2, voffB); PG8_STAGE(PG8_SB(0, 1), b2 + hstep, voffB); PG8_STAGE(PG8_SA(0, 0), a2, vA0);
            PG8_WAIT_V(8); PG8_WAIT_L(0); PG8_BAR; PG8_MMA(1, 0, At, B0); PG8_MMA(1, 1, At, B1); PG8_BAR; PG8_SCHED;
            PG8_LDB(B0, 1, 0); PG8_LDB(B1, 1, 1); PG8_SCHED; PG8_LDA(At, 1, 0); PG8_STAGE(PG8_SA(0, 1), a2, vA1);
            PG8_WAIT_V(8); PG8_WAIT_L(0); PG8_BAR; PG8_MMA(0, 0, At, B0); PG8_MMA(0, 1, At, B1); PG8_BAR; PG8_SCHED;
            PG8_LDA(At, 1, 1); PG8_STAGE(PG8_SB(1, 0), b3, voffB); PG8_STAGE(PG8_SB(1, 1), b3 + hstep, voffB); PG8_STAGE(PG8_SA(1, 0), a3, vA0);
            PG8_WAIT_V(8); PG8_WAIT_L(0); PG8_BAR; PG8_MMA(1, 0, At, B0); PG8_MMA(1, 1, At, B1); PG8_BAR; PG8_SCHED;
        }
        if (wr == 0) PG8_BAR;
        Pb.epi(acc, cur, wr, wc, fr, fq);
        if (!has_next) break;
#pragma unroll
        for (int a = 0; a < 2; ++a)
#pragma unroll
            for (int b = 0; b < 2; ++b)
#pragma unroll
                for (int m = 0; m < 4; ++m)
#pragma unroll
                    for (int n = 0; n < 2; ++n) acc[a][b][m][n] = (f32x4){0.f, 0.f, 0.f, 0.f};
        cur = nxt; cA = nA; cB = nB; ++ui;
        if (wr == 1) PG8_BAR;
    }
    PG8_WAIT_V(0);
    PG8_BAR;
#undef PG8_SA
#undef PG8_SB
#undef PG8_STAGE
#undef PG8_LDA
#undef PG8_LDB
#undef PG8_MMA
#undef PG8_WAIT_V
#undef PG8_WAIT_L
#undef PG8_BAR
#undef PG8_SCHED
}

__device__ __forceinline__ int moe_tables(LAS unsigned char* lds, const int* cnt) {
    LAS int* tile_e = (LAS int*)(lds + LDS_TILE_E); LAS int* tile_m = (LAS int*)(lds + LDS_TILE_M); LAS int* rts = (LAS int*)(lds + LDS_MISC + 32);
    if (threadIdx.x == 0) { int a = 0; for (int e = 0; e < NE; ++e) { const int n = (cnt[e] + 255) >> 8; for (int m = 0; m < n; ++m) { tile_e[a] = e; tile_m[a] = m; ++a; } } rts[0] = a; }
    __syncthreads();
    return rts[0];
}
}
namespace mk {
__device__ __forceinline__ float wsum(float v) {
#pragma unroll
    for (int o = 1; o < 64; o <<= 1) v += __shfl_xor(v, o);
    return v; }
__device__ __forceinline__ unsigned short f2bf(float f) { unsigned u = __float_as_uint(f); u += 0x7FFFu + ((u >> 16) & 1u); return (unsigned short)(u >> 16); }

__global__ __launch_bounds__(256) void k_rms_bf16(const float* in, int ldi, bf16_t* out, int ldo, int ng, int Dn, int nrows) {
    const int lane = threadIdx.x & 63; const int gw = blockIdx.x * 4 + (threadIdx.x >> 6), nw = gridDim.x * 4;
    for (int r = gw; r < nrows; r += nw) { const float* xr = in + (size_t)r * ldi; float s = 0.f;
        for (int i = lane * 4; i < Dn; i += 256) { const f32x4 v = *(const f32x4*)(xr + i); s += v[0] * v[0] + v[1] * v[1] + v[2] * v[2] + v[3] * v[3]; }
        s = wsum(s); const float rs = rsqrtf(s / (float)Dn + 1e-6f);
        bf16_t* o = out + (size_t)(r / ng) * ldo + (size_t)(r % ng) * Dn;
        for (int i = lane * 4; i < Dn; i += 256) { const f32x4 v = *(const f32x4*)(xr + i); u32x2 w; w.x = cvt_pk_bf16(v[0] * rs, v[1] * rs); w.y = cvt_pk_bf16(v[2] * rs, v[3] * rs); *(u32x2*)(o + i) = w; } }
}
__global__ __launch_bounds__(256) void k_wT(const float* W, bf16_t* WT, const float* gk1, const float* gk2, int ksplit, int K, int N, int NP, int mode, int nscale, float sc) {
    __shared__ float tile[64][65];
    const int z = blockIdx.z, n0 = blockIdx.x * 64, k0 = blockIdx.y * 64, tx = threadIdx.x & 63, ty = threadIdx.x >> 6;
    const float* Wz = W + (size_t)z * K * N; bf16_t* WTz = WT + (size_t)z * NP * K;
#pragma unroll
    for (int r = 0; r < 16; ++r) { const int kk = r * 4 + ty, k = k0 + kk, n = n0 + tx; float g = 1.f; if (gk1) g = (k < ksplit) ? gk1[k] : gk2[k - ksplit];
        tile[kk][tx] = (n < N) ? Wz[(size_t)k * N + n] * g : 0.f; }
    __syncthreads();
#pragma unroll
    for (int j = 0; j < 2; ++j) { const int id = threadIdx.x + 256 * j, nl = id >> 3, c = id & 7, n = n0 + nl; const float s = (n < nscale) ? sc : 1.f;
        int nm = n; if (mode == 1) { const int up = n >> 10, jj = n & 1023; nm = (jj >> 7) * 256 + up * 128 + (jj & 127); }
        u32x4 w; w.x = cvt_pk_bf16(tile[8 * c + 0][nl] * s, tile[8 * c + 1][nl] * s); w.y = cvt_pk_bf16(tile[8 * c + 2][nl] * s, tile[8 * c + 3][nl] * s);
        w.z = cvt_pk_bf16(tile[8 * c + 4][nl] * s, tile[8 * c + 5][nl] * s); w.w = cvt_pk_bf16(tile[8 * c + 6][nl] * s, tile[8 * c + 7][nl] * s);
        *(u32x4*)(WTz + (size_t)nm * K + k0 + 8 * c) = w; }
}
__global__ __launch_bounds__(256) void k_bf2f(const bf16_t* in, int ldi, float* out, int ldo, int ncols, int nrows) {
    for (size_t i = (size_t)blockIdx.x * 256 + threadIdx.x; i < (size_t)nrows * ncols; i += (size_t)gridDim.x * 256) { const size_t r = i / ncols, c = i % ncols; out[r * ldo + c] = bf2f(in[r * ldi + c]); }
}
__global__ __launch_bounds__(512, 2) void k_proj(const bf16_t* xb, const bf16_t* WinT, bf16_t* projb) {
    extern __shared__ __attribute__((aligned(16))) unsigned char dl[];
    ProbProj P; P.S.init(T, NPROJ, gridDim.x, blockIdx.x); P.A = xb; P.Bt = WinT; P.O = projb;
    gemm_phase(((LAS unsigned char*)dl), P);
}
__global__ __launch_bounds__(512, 2) void k_outp(const bf16_t* catb, const bf16_t* WoutT, const float* x, float* h1) {
    extern __shared__ __attribute__((aligned(16))) unsigned char dl[];
    ProbOut P; P.S.init(T, D, gridDim.x, blockIdx.x); P.A = catb; P.Bt = WoutT; P.R0 = x; P.O = h1;
    gemm_phase(((LAS unsigned char*)dl), P);
}
__global__ __launch_bounds__(512, 2) void k_moe1(const bf16_t* hnb, const bf16_t* WguT, const float* b_gu, const int* cnt, const int* list, bf16_t* act) {
    extern __shared__ __attribute__((aligned(16))) unsigned char dl[];
    LAS unsigned char* lds = (LAS unsigned char*)dl;
    const int RT = moe_tables(lds, cnt);
    ProbMoe1 P; P.S.nN = 8; P.S.G = gridDim.x; P.S.c = blockIdx.x; P.S.RT = RT; P.S.tile_e = (const LAS int*)(lds + LDS_TILE_E); P.S.tile_m = (const LAS int*)(lds + LDS_TILE_M);
    P.A = hnb; P.Bt = WguT; P.bias = b_gu; P.O = act; P.rowtab = (const LAS unsigned*)(lds + LDS_ROWTAB);
    LAS unsigned* rowtab = (LAS unsigned*)(lds + LDS_ROWTAB);
    for (int i = 0; i < 12; ++i) { Unit u; if (!P.S.next(i, u)) break; const int r = threadIdx.x; if (r < 256) { const int pos = u.mt * 256 + r; const int c = cnt[u.e];
        const int tok = (pos < c) ? (list[(size_t)u.e * T + pos] >> 2) : 0; rowtab[i * 256 + r] = (unsigned)tok * (KD * 2); } }
    __syncthreads();
    gemm_phase(lds, P);
}
__global__ __launch_bounds__(512, 2) void k_moe2(const bf16_t* act, const bf16_t* WdnT, const float* b_dn, const int* cnt, const float* wlist, bf16_t* y) {
    extern __shared__ __attribute__((aligned(16))) unsigned char dl[];
    LAS unsigned char* lds = (LAS unsigned char*)dl;
    const int RT = moe_tables(lds, cnt);
    ProbMoe2 P; P.S.nN = 4; P.S.G = gridDim.x; P.S.c = blockIdx.x; P.S.RT = RT; P.S.tile_e = (const LAS int*)(lds + LDS_TILE_E); P.S.tile_m = (const LAS int*)(lds + LDS_TILE_M);
    P.A = act; P.Bt = WdnT; P.bias = b_dn; P.wlist = wlist; P.O = y;
    gemm_phase(lds, P);
}
__global__ __launch_bounds__(256) void k_route2(const float* logits, int* cnt, int* list, float* wlist, int* tinfo) {
    const int t = blockIdx.x * 256 + threadIdx.x; if (t >= T) return;
    const float* lr = logits + (size_t)t * NE; unsigned used = 0u; float tv[4]; int ti[4];
#pragma unroll
    for (int k = 0; k < 4; ++k) { float best = -INFINITY; int bi = 0;
        for (int e = 0; e < NE; ++e) { float v = lr[e]; if (!((used >> e) & 1u) && v > best) { best = v; bi = e; } }
        used |= 1u << bi; tv[k] = best; ti[k] = bi; }
    float m = tv[0], sum = 0.f, w[4];
#pragma unroll
    for (int k = 0; k < 4; ++k) { w[k] = expf(tv[k] - m); sum += w[k]; }
#pragma unroll
    for (int k = 0; k < 4; ++k) { const int pos = atomicAdd(&cnt[ti[k]], 1); list[(size_t)ti[k] * T + pos] = t * 4 + k; wlist[(size_t)ti[k] * T + pos] = w[k] / sum; tinfo[t * 4 + k] = ti[k] | (pos << 8); }
}
__global__ __launch_bounds__(256) void k_combine2(const float* h1, const bf16_t* y, const int* tinfo, const int* cnt, const float* g, float* out) {
    __shared__ float red[4]; __shared__ int toff[NE];
    if (threadIdx.x == 0) { int a = 0; for (int e = 0; e < NE; ++e) { toff[e] = a; a += (cnt[e] + 255) >> 8; } }
    __syncthreads();
    const int t = blockIdx.x; float v[4]; float s = 0.f; size_t so[4];
#pragma unroll
    for (int k = 0; k < 4; ++k) { const int inf = tinfo[t * 4 + k]; so[k] = ((size_t)toff[inf & 255] * 256 + (inf >> 8)) * 1024; }
#pragma unroll
    for (int r = 0; r < 4; ++r) { const int i = threadIdx.x + r * 256; float a = h1[(size_t)t * D + i];
#pragma unroll
        for (int k = 0; k < 4; ++k) a += bf2f(y[so[k] + i]);
        v[r] = a; s += a * a; }
    s = wsum(s); if ((threadIdx.x & 63) == 0) red[threadIdx.x >> 6] = s; __syncthreads();
    s = red[0] + red[1] + red[2] + red[3]; const float rs = rsqrtf(s / (float)D + 1e-6f);
#pragma unroll
    for (int r = 0; r < 4; ++r) { const int i = threadIdx.x + r * 256; out[(size_t)t * D + i] = v[r] * rs * g[i]; }
}
}
namespace mk {
typedef float f32x16 __attribute__((ext_vector_type(16)));
typedef short s16x4 __attribute__((ext_vector_type(4)));
typedef __bf16 bf2_t __attribute__((ext_vector_type(2)));
typedef float f2_t __attribute__((ext_vector_type(2)));
#define MFMA32(a, b, c) __builtin_amdgcn_mfma_f32_32x32x16_bf16((a), (b), (c), 0, 0, 0)
constexpr float LOG2E = 1.4426950408889634f;
constexpr int PROJ_LD = NPROJ;
constexpr int AT_KBUF = 0, AT_VBUF = 16384, AT_IMPW = 32768, AT_SCORE = 65536, AT_OBUF = 73728, AT_OSTR = 1040, AT_BTAB = AT_OBUF + 64 * AT_OSTR  ,
              AT_SEL = AT_BTAB + 8 * 132 * 4  , AT_SSQ = AT_SEL + 512  , AT_END = AT_SSQ + 8 * 64 * 4  ;
struct AttnArgs { const bf16_t* projb; const bf16_t* kc; const bf16_t* vc; bf16_t* catb; };

__device__ __forceinline__ unsigned pk2(float a, float b) { f2_t v = {a, b}; return __builtin_bit_cast(unsigned, __builtin_convertvector(v, bf2_t)); }
__device__ __forceinline__ int t5_bucket(int n) { if (n < 0) n = 0; if (n < 16) return n; const float nf = (float)n; const int l = 16 + (int)(logf(nf / 16.f) / 2.0794415416798357f * 16.f); return l < 31 ? l : 31; }
__device__ __forceinline__ void stage_tile(LAS unsigned char* dst, const char* src, size_t row_stride, int wid, int lane, bool vswz) {
    const int row = 8 * wid + (lane >> 3), slot = lane & 7;
    const int f = vswz ? (((row >> 1) & 1) << 2) : ((row >> 1) & 7);
    __builtin_amdgcn_global_load_lds((const unsigned*)(src + (size_t)row * row_stride + ((slot ^ f) << 4)), (LAS unsigned*)(dst + wid * 1024), 16, 0, 0);
}
#define AT_CROW(r, h) (((r) & 3) + 8 * ((r) >> 2) + 4 * (h))
#define AT_PACK8(x, s) __builtin_bit_cast(bf16x8, (u32x4){pk2((x)[8 * (s)], (x)[8 * (s) + 1]), pk2((x)[8 * (s) + 2], (x)[8 * (s) + 3]), pk2((x)[8 * (s) + 4], (x)[8 * (s) + 5]), pk2((x)[8 * (s) + 6], (x)[8 * (s) + 7])})
__device__ __forceinline__ bf16x8 vt_frag(const LAS unsigned char* vt, unsigned vaddr, int rowoff) {
    const s16x4 lo = __builtin_amdgcn_ds_read_tr16_b64_v4i16((LAS s16x4*)(vt + vaddr + rowoff * 128));
    const s16x4 hi = __builtin_amdgcn_ds_read_tr16_b64_v4i16((LAS s16x4*)(vt + vaddr + (rowoff + 8) * 128));
    return __builtin_shufflevector(lo, hi, 0, 1, 2, 3, 4, 5, 6, 7);
}
template <bool FIRST>
__device__ __forceinline__ void obuf_acc(LAS unsigned char* lds, int tl, int hd, int h, float sc, const f32x16 (&oc)[2]) {
#pragma unroll
    for (int c = 0; c < 2; ++c)
#pragma unroll
        for (int qd = 0; qd < 4; ++qd) { LAS u32x2* p = (LAS u32x2*)(lds + AT_OBUF + tl * AT_OSTR + (hd * 64 + 32 * c + 8 * qd + 4 * h) * 2);
            float a0 = sc * oc[c][4 * qd], a1 = sc * oc[c][4 * qd + 1], a2 = sc * oc[c][4 * qd + 2], a3 = sc * oc[c][4 * qd + 3];
            if (!FIRST) { const u32x2 o = *p; a0 += __uint_as_float(o.x << 16); a1 += __uint_as_float(o.x & 0xffff0000u); a2 += __uint_as_float(o.y << 16); a3 += __uint_as_float(o.y & 0xffff0000u); }
            *p = (u32x2){pk2(a0, a1), pk2(a2, a3)}; }
}
template <int MODE>
__device__ __forceinline__ void attn_tile(const LAS unsigned char* Kt, const LAS unsigned char* Vt, int kbase, int tq, int t0, bool selbit, const bf16x8 (&qf)[4], const LAS float* bt, float cfar,
                                          f32x16 (&O)[2], float& m, float& l, int ql, int h, const unsigned (&vaddr)[2]) {
    f32x16 s0, s1;
#pragma unroll
    for (int r = 0; r < 16; ++r) { s0[r] = 0.f; s1[r] = 0.f; }
    const int fk = (ql >> 1) & 7;
#pragma unroll
    for (int s = 0; s < 4; ++s) { const int ch = ((2 * s + h) ^ fk) << 4;
        const bf16x8 k0 = *(const LAS bf16x8*)(Kt + ql * 128 + ch), k1 = *(const LAS bf16x8*)(Kt + (32 + ql) * 128 + ch);
        s0 = MFMA32(k0, qf[s], s0); s1 = MFMA32(k1, qf[s], s1); }
    const bool far = (kbase + 191 <= t0);
    float mx = -INFINITY;
#pragma unroll
    for (int r = 0; r < 16; ++r) {
        const int key0 = kbase + AT_CROW(r, h), key1 = key0 + 32;
        const int d0 = tq - key0, d1 = tq - key1;
        bool v0, v1;
        if (MODE == 0) { v0 = selbit && d0 >= 0; v1 = selbit && d1 >= 0; } else { v0 = d0 >= 0 && d0 < 512; v1 = d1 >= 0 && d1 < 512; }
        float b0, b1;
        if (far) { b0 = cfar; b1 = cfar; } else { b0 = bt[min(max(d0, 0), 128)]; b1 = bt[min(max(d1, 0), 128)]; }
        const float x0 = v0 ? s0[r] + b0 : -INFINITY, x1 = v1 ? s1[r] + b1 : -INFINITY;
        s0[r] = x0; s1[r] = x1; mx = fmaxf(mx, fmaxf(x0, x1));
    }
    mx = fmaxf(mx, __shfl_xor(mx, 32));
    const float mn = fmaxf(m, mx);
    const float alpha = __builtin_amdgcn_exp2f(m - mn);
    float ps = 0.f;
#pragma unroll
    for (int r = 0; r < 16; ++r) { const float p0 = __builtin_amdgcn_exp2f(s0[r] - mn), p1 = __builtin_amdgcn_exp2f(s1[r] - mn); s0[r] = p0; s1[r] = p1; ps += p0 + p1; }
    l = l * alpha + ps; m = mn;
    if (__any(alpha != 1.f)) {
#pragma unroll
        for (int r = 0; r < 16; ++r) { O[0][r] *= alpha; O[1][r] *= alpha; } }
#pragma unroll
    for (int sp = 0; sp < 2; ++sp) {
        const bf16x8 p0 = AT_PACK8(s0, sp), p1 = AT_PACK8(s1, sp);
#pragma unroll
        for (int c = 0; c < 2; ++c) { O[c] = MFMA32(vt_frag(Vt, vaddr[c], 16 * sp), p0, O[c]); O[c] = MFMA32(vt_frag(Vt, vaddr[c], 32 + 16 * sp), p1, O[c]); }
    }
}

__device__ __forceinline__ void attn_item(LAS unsigned char* lds, const AttnArgs& A, int b, int qt) {
    const int tid = threadIdx.x, wid = __builtin_amdgcn_readfirstlane(tid >> 6), lane = tid & 63;
    const int g = wid >> 1, th = wid & 1, ql = lane & 31, h = lane >> 5;
    const int t0 = qt * 64, tl = th * 32 + ql, tq = t0 + tl, blk = qt;
    const size_t rowq = (size_t)b * S + tq;
    const int qq = (lane & 15) >> 2, pp = lane & 3, lb = (lane >> 4) & 1;
    unsigned vaddr[2];
#pragma unroll
    for (int c = 0; c < 2; ++c) vaddr[c] = (unsigned)((4 * h + qq) * 128 + (((4 * (c ^ ((qq >> 1) & 1))) + 2 * lb + (pp >> 1)) << 4) + 8 * (pp & 1));
    LAS float* impw = (LAS float*)(lds + AT_IMPW); LAS float* score = (LAS float*)(lds + AT_SCORE); LAS unsigned* selm = (LAS unsigned*)(lds + AT_SEL);
    const char* prow0 = (const char*)(A.projb + (size_t)b * S * PROJ_LD);
    const size_t RS = (size_t)PROJ_LD * 2;
    for (int kvh = 0; kvh < 2; ++kvh) {
        const int hd = kvh * 4 + g;
        const LAS float* bt = (const LAS float*)(lds + AT_BTAB) + hd * 132;
        const float cfar = bt[128];
        bf16x8 qf[4];
#pragma unroll
        for (int s = 0; s < 4; ++s) qf[s] = *(const bf16x8*)(A.projb + rowq * PROJ_LD + hd * 64 + 16 * s + 8 * h);
        float gate[3];
#pragma unroll
        for (int j = 0; j < 3; ++j) { const float gv = bf2f(A.projb[rowq * PROJ_LD + 1280 + j * 8 + hd]); gate[j] = 1.f / (1.f + __expf(-gv)); }
        __syncthreads();
        { const char* kcb = (const char*)(A.kc + (size_t)(b * 2 + kvh) * 128 * 64); const char* vcb = (const char*)(A.vc + (size_t)(b * 2 + kvh) * 128 * 64);
          stage_tile(lds + AT_KBUF, kcb, 128, wid, lane, false); stage_tile(lds + AT_KBUF + 8192, kcb + 64 * 128, 128, wid, lane, false);
          stage_tile(lds + AT_VBUF, vcb, 128, wid, lane, true); stage_tile(lds + AT_VBUF + 8192, vcb + 64 * 128, 128, wid, lane, true); }
        asm volatile("s_waitcnt vmcnt(0)" ::: "memory"); __syncthreads();
        {
            f32x16 sc[4]; const int fk = (ql >> 1) & 7; int tqc = tq; asm volatile("" : "+v"(tqc));
#pragma unroll
            for (int kb = 0; kb < 4; ++kb) {
#pragma unroll
                for (int r = 0; r < 16; ++r) sc[kb][r] = 0.f;
#pragma unroll
                for (int s = 0; s < 4; ++s) { const bf16x8 kf = *(const LAS bf16x8*)(lds + AT_KBUF + (32 * kb + ql) * 128 + (((2 * s + h) ^ fk) << 4)); sc[kb] = MFMA32(kf, qf[s], sc[kb]); }
                __builtin_amdgcn_sched_barrier(0); }
            float mx = -INFINITY;
#pragma unroll
            for (int kb = 0; kb < 4; ++kb)
#pragma unroll
                for (int r = 0; r < 16; ++r) { const int c = 32 * kb + AT_CROW(r, h); const int dist = tqc - 16 * c - 31; const float bv = bt[min(max(dist, 0), 128)]; const float x = (dist >= 0) ? sc[kb][r] + bv : -INFINITY; sc[kb][r] = x; mx = fmaxf(mx, x);
                    if ((r & 7) == 7) __builtin_amdgcn_sched_barrier(0); }
            mx = fmaxf(mx, __shfl_xor(mx, 32));
            const float mref = (mx == -INFINITY) ? 0.f : mx;
            float ls = 0.f;
#pragma unroll
            for (int kb = 0; kb < 4; ++kb)
#pragma unroll
                for (int r = 0; r < 16; ++r) { const float p = __builtin_amdgcn_exp2f(sc[kb][r] - mref); sc[kb][r] = p; ls += p; }
            ls += __shfl_xor(ls, 32);
            const float inv = 1.f / fmaxf(ls, 1e-30f);
#pragma unroll
            for (int kb = 0; kb < 4; ++kb)
#pragma unroll
                for (int r = 0; r < 16; ++r) sc[kb][r] *= inv;
            { float carry = 0.f;
#pragma unroll
              for (int i = 0; i < 16; ++i) { const int kb = i >> 2, qd = i & 3;
                  const float s4 = (sc[kb][4 * qd] + sc[kb][4 * qd + 1]) + (sc[kb][4 * qd + 2] + sc[kb][4 * qd + 3]);
                  const float rv = __shfl_xor(sc[kb][4 * qd + 3], 32);
                  impw[(wid * 32 + ql) * 32 + 2 * i + h] = s4 + (h ? rv : carry); carry = rv; } }
            f32x16 oc[2];
#pragma unroll
            for (int r = 0; r < 16; ++r) { oc[0][r] = 0.f; oc[1][r] = 0.f; }
#pragma unroll
            for (int kb = 0; kb < 4; ++kb)
#pragma unroll
                for (int sp = 0; sp < 2; ++sp) { const bf16x8 pf = AT_PACK8(sc[kb], sp);
#pragma unroll
                    for (int c = 0; c < 2; ++c) oc[c] = MFMA32(vt_frag(lds + AT_VBUF, vaddr[c], 32 * kb + 16 * sp), pf, oc[c]);
                    __builtin_amdgcn_sched_barrier(0); }
            obuf_acc<true>(lds, tl, hd, h, gate[0], oc);
        }
        __syncthreads();
        int tids = tid; asm volatile("" : "+v"(tids));
#pragma unroll
        for (int i = 0; i < 4; ++i) { const int id = tids + 512 * i, tk = id >> 5, n = id & 31, w0 = tk >> 5, q = tk & 31;
            float v = 0.f;
#pragma unroll
            for (int gg = 0; gg < 4; ++gg) v += impw[((2 * gg + w0) * 32 + q) * 32 + n];
            const bool forced = (n == 0) || (n == blk) || (n == blk - 1);
            score[tk * 32 + n] = forced ? 1e4f : ((n <= blk) ? v : -1.f); }
        __syncthreads();
#pragma unroll
        for (int i = 0; i < 4; ++i) { const int id = tids + 512 * i, tk = id >> 5, n = id & 31;
            const float sn = score[tk * 32 + n]; int rank = 0;
            for (int mm = 0; mm < 32; ++mm) { const float s2 = score[tk * 32 + mm]; rank += (s2 > sn || (s2 == sn && mm < n)) ? 1 : 0; }
            const bool sel = (rank < 16) && (n <= blk);
            const unsigned long long bal = __ballot(sel);
            if (n == 0) selm[tk] = (unsigned)(bal >> (32 * (lane >> 5))); }
        __syncthreads();
        unsigned U = selm[lane];
#pragma unroll
        for (int o = 1; o < 64; o <<= 1) U |= (unsigned)__shfl_xor((int)U, o);
        U = (unsigned)__builtin_amdgcn_readfirstlane((int)U);
        const unsigned mysel = selm[tl];
        {
            f32x16 oc[2];
#pragma unroll
            for (int r = 0; r < 16; ++r) { oc[0][r] = 0.f; oc[1][r] = 0.f; }
            float m = -1e30f, l = 0.f;
            const char* kcol = prow0 + (512 + 2 * 128 + kvh * 64) * 2; const char* vcol = prow0 + (512 + 3 * 128 + kvh * 64) * 2;
            int n = __builtin_ctz(U | 0x80000000u), buf = 0;
            stage_tile(lds + AT_KBUF, kcol + (size_t)n * 64 * RS, RS, wid, lane, false); stage_tile(lds + AT_VBUF, vcol + (size_t)n * 64 * RS, RS, wid, lane, true);
            for (;;) {
                asm volatile("s_waitcnt vmcnt(0)" ::: "memory"); __syncthreads();
                const unsigned rest = (n >= 31) ? 0u : (U & ~((2u << n) - 1u));
                const int nn = rest ? __builtin_ctz(rest) : -1;
                if (nn >= 0) { stage_tile(lds + AT_KBUF + (buf ^ 1) * 8192, kcol + (size_t)nn * 64 * RS, RS, wid, lane, false); stage_tile(lds + AT_VBUF + (buf ^ 1) * 8192, vcol + (size_t)nn * 64 * RS, RS, wid, lane, true); }
                attn_tile<0>(lds + AT_KBUF + buf * 8192, lds + AT_VBUF + buf * 8192, n * 64, tq, t0, ((mysel >> n) & 1u) != 0u, qf, bt, cfar, oc, m, l, ql, h, vaddr);
                if (nn < 0) break;
                n = nn; buf ^= 1;
            }
            l += __shfl_xor(l, 32);
            const float sc1 = gate[1] / fmaxf(l, 1e-30f);
            obuf_acc<false>(lds, tl, hd, h, sc1, oc);
        }
        {
            f32x16 oc[2];
#pragma unroll
            for (int r = 0; r < 16; ++r) { oc[0][r] = 0.f; oc[1][r] = 0.f; }
            float m = -1e30f, l = 0.f;
            const char* kcol = prow0 + (512 + 4 * 128 + kvh * 64) * 2; const char* vcol = prow0 + (512 + 5 * 128 + kvh * 64) * 2;
            int n = (blk >= 8) ? blk - 8 : 0, buf = 0;
            __syncthreads();
            stage_tile(lds + AT_KBUF, kcol + (size_t)n * 64 * RS, RS, wid, lane, false); stage_tile(lds + AT_VBUF, vcol + (size_t)n * 64 * RS, RS, wid, lane, true);
            for (;;) {
                asm volatile("s_waitcnt vmcnt(0)" ::: "memory"); __syncthreads();
                const int nn = (n < blk) ? n + 1 : -1;
                if (nn >= 0) { stage_tile(lds + AT_KBUF + (buf ^ 1) * 8192, kcol + (size_t)nn * 64 * RS, RS, wid, lane, false); stage_tile(lds + AT_VBUF + (buf ^ 1) * 8192, vcol + (size_t)nn * 64 * RS, RS, wid, lane, true); }
                attn_tile<1>(lds + AT_KBUF + buf * 8192, lds + AT_VBUF + buf * 8192, n * 64, tq, t0, true, qf, bt, cfar, oc, m, l, ql, h, vaddr);
                if (nn < 0) break;
                n = nn; buf ^= 1;
            }
            l += __shfl_xor(l, 32);
            const float sc2 = gate[2] / fmaxf(l, 1e-30f);
            obuf_acc<false>(lds, tl, hd, h, sc2, oc);
        }
    }
    __syncthreads();
    int widn = wid; asm volatile("" : "+s"(widn));
#pragma unroll 1
    for (int i = 0; i < 8; ++i) { const int row = widn + 8 * i;
        const u32x4 v = *(const LAS u32x4*)(lds + AT_OBUF + row * AT_OSTR + lane * 16);
        float f[8]; f[0] = __uint_as_float(v.x << 16); f[1] = __uint_as_float(v.x & 0xffff0000u); f[2] = __uint_as_float(v.y << 16); f[3] = __uint_as_float(v.y & 0xffff0000u);
        f[4] = __uint_as_float(v.z << 16); f[5] = __uint_as_float(v.z & 0xffff0000u); f[6] = __uint_as_float(v.w << 16); f[7] = __uint_as_float(v.w & 0xffff0000u);
        float sq = 0.f;
#pragma unroll
        for (int j = 0; j < 8; ++j) sq += f[j] * f[j];
        sq = wsum(sq);
        const float rs = rsqrtf(sq * (1.f / 512.f) + 1e-6f);
        u32x4 w; w.x = pk2(f[0] * rs, f[1] * rs); w.y = pk2(f[2] * rs, f[3] * rs); w.z = pk2(f[4] * rs, f[5] * rs); w.w = pk2(f[6] * rs, f[7] * rs);
        *(u32x4*)(A.catb + ((size_t)b * S + t0 + row) * 1024 + lane * 8) = w; }
    __syncthreads();
}
__device__ __forceinline__ void attn_btab(LAS unsigned char* lds, const float* rel_bias) {
    LAS float* bt = (LAS float*)(lds + AT_BTAB);
    for (int i = threadIdx.x; i < 8 * 129; i += 512) { const int hd = i / 129, d = i % 129; bt[hd * 132 + d] = rel_bias[t5_bucket(d) * 8 + hd] * LOG2E; }
    __syncthreads();
}
__global__ __launch_bounds__(512, 2) void k_attn(AttnArgs A, const float* rel_bias) {
    extern __shared__ __attribute__((aligned(16))) unsigned char dl[];
    LAS unsigned char* lds = (LAS unsigned char*)dl;
    attn_btab(lds, rel_bias);
    for (int it = blockIdx.x; it < NB * 32; it += gridDim.x) attn_item(lds, A, it & 7, 31 - (it >> 3));
}
__global__ __launch_bounds__(256) void k_kvc_bf16(const float* kvc, bf16_t* kc, bf16_t* vc) {
    const int i = blockIdx.x * 256 + threadIdx.x; if (i >= 2 * NB * 2 * 128 * 64) return;
    const int d = i & 63, c = (i >> 6) & 127, kvh = (i >> 13) & 1, b = (i >> 14) & 7, z = i >> 17;
    const float v = (c < 127) ? kvc[((size_t)z * (NB * 127 * 2) + (size_t)(b * 127 + c) * 2 + kvh) * 64 + d] : 0.f;
    (z ? vc : kc)[((size_t)(b * 2 + kvh) * 128 + c) * 64 + d] = f2bf(v);
}
}
extern "C" void kernel_launch(void* const* d_in, const int* in_sizes, int n_in, void* d_out, int out_size, void* d_ws, size_t ws_size, hipStream_t stream) {
    using namespace nv;
    const float* x = (const float*)d_in[0]; const float* attn_norm = (const float*)d_in[1]; const float* w_in = (const float*)d_in[2];
    const float* rel_bias = (const float*)d_in[3]; const float* cmp_pos = (const float*)d_in[4]; const float* cmp_w1 = (const float*)d_in[5];
    const float* cmp_w2 = (const float*)d_in[6]; const float* attn_out_norm = (const float*)d_in[7]; const float* conv_w = (const float*)d_in[8];
    const float* conv_b = (const float*)d_in[9]; const float* dt_bias = (const float*)d_in[10]; const float* a_log = (const float*)d_in[11];
    const float* d_skip = (const float*)d_in[12]; const float* ssm_out_norm = (const float*)d_in[13]; const float* w_out = (const float*)d_in[14];
    const float* ffn_norm = (const float*)d_in[15]; const float* router_w = (const float*)d_in[16]; const float* router_b = (const float*)d_in[17];
    const float* w_gu = (const float*)d_in[18]; const float* b_gu = (const float*)d_in[19]; const float* w_dn = (const float*)d_in[20];
    const float* b_dn = (const float*)d_in[21]; const float* final_norm = (const float*)d_in[22];
    float* out = (float*)d_out;
    char* ws = (char*)d_ws; const size_t MB = 1u << 20;
    typedef mk::bf16_t bf;
    size_t o = 0; auto take = [&](size_t mb) { char* p = ws + o; o += mb * MB; return p; };
    int* cnt = (int*)take(1);
    bf* xb = (bf*)take(32); bf* WinT = (bf*)take(6); bf* WoutT = (bf*)take(2); bf* WguT = (bf*)take(128); bf* WdnT = (bf*)take(64);
    bf* projb = (bf*)take(96); bf* catb = (bf*)take(32); float* h1 = (float*)take(64); float* hn = (float*)take(64); bf* hnb = (bf*)take(32);
    float* rlog = (float*)take(2); int* list = (int*)take(2); float* wlist = (float*)take(2); int* tinfo = (int*)take(1);
    bf* kcb = (bf*)take(1); bf* vcb = (bf*)take(1); float* hid = (float*)take(2); float* kvc = (float*)take(2); float* dtv = (float*)take(1);
    char* E = take(0);
    float* proj = (float*)(E); float* convx = (float*)(E + 180 * MB); float* o_nsa = (float*)(E + 244 * MB); float* yssd = (float*)(E + 276 * MB);
    bf* act = (bf*)(E); bf* ymoe = (bf*)(E + 144 * MB);
    (void)hipMemsetAsync(cnt, 0, 256, stream);
    static bool attr = false;
    if (!attr) { attr = true;
        (void)hipFuncSetAttribute((const void*)mk::k_proj, hipFuncAttributeMaxDynamicSharedMemorySize, mk::LDS_BYTES);
        (void)hipFuncSetAttribute((const void*)mk::k_outp, hipFuncAttributeMaxDynamicSharedMemorySize, mk::LDS_BYTES);
        (void)hipFuncSetAttribute((const void*)mk::k_moe1, hipFuncAttributeMaxDynamicSharedMemorySize, mk::LDS_BYTES);
        (void)hipFuncSetAttribute((const void*)mk::k_attn, hipFuncAttributeMaxDynamicSharedMemorySize, mk::LDS_BYTES);
        (void)hipFuncSetAttribute((const void*)mk::k_moe2, hipFuncAttributeMaxDynamicSharedMemorySize, mk::LDS_BYTES); }
    mk::k_rms_bf16<<<1024, 256, 0, stream>>>(x, D, xb, D, 1, D, T);
    mk::k_wT<<<dim3(48, 16, 1), 256, 0, stream>>>(w_in, WinT, attn_norm, attn_norm, 1024, 1024, INC, 3072, 0, 512, 0.125f * mk::LOG2E);
    mk::k_wT<<<dim3(16, 16, 1), 256, 0, stream>>>(w_out, WoutT, attn_out_norm, ssm_out_norm, 512, 1024, 1024, 1024, 0, 0, 1.f);
    mk::k_wT<<<dim3(32, 16, 32), 256, 0, stream>>>(w_gu, WguT, ffn_norm, ffn_norm, 1024, 1024, 2048, 2048, 1, 0, 1.f);
    mk::k_wT<<<dim3(16, 16, 32), 256, 0, stream>>>(w_dn, WdnT, nullptr, nullptr, 0, 1024, 1024, 1024, 0, 0, 1.f);
    mk::k_proj<<<256, 512, mk::LDS_BYTES, stream>>>(xb, WinT, projb);
    mk::k_bf2f<<<2048, 256, 0, stream>>>(projb, 3072, proj, INC, INC, T);
    const int MC = NB * NCMP * 2;
    k_gemm<false><<<dim3(1, (MC + 63) / 64, 2), 256, 0, stream>>>(ACmp{proj, cmp_pos}, BCmp1{cmp_w1}, ECmp1{hid}, MConst{MC, 0}, 64, 2048);
    k_gemm<false><<<dim3(1, (MC + 63) / 64, 2), 256, 0, stream>>>(ACmp2{hid}, BCmp2{cmp_w2}, ECmp2{kvc}, MConst{MC, 0}, 64, 64);
    mk::k_kvc_bf16<<<(2 * NB * 2 * 128 * 64) / 256, 256, 0, stream>>>(kvc, kcb, vcb);
    mk::k_attn<<<256, 512, mk::LDS_BYTES, stream>>>(mk::AttnArgs{projb, kcb, vcb, catb}, rel_bias);
    k_ssd_conv<<<T, 256, 0, stream>>>(proj, conv_w, conv_b, dt_bias, convx, dtv);
    k_ssd_scan<<<NB * 8, 256, 0, stream>>>(proj, convx, dtv, a_log, d_skip, yssd);
    mk::k_rms_bf16<<<1024, 256, 0, stream>>>(yssd, 256, catb + 512, D, 2, 256, T * 2);
    mk::k_outp<<<256, 512, mk::LDS_BYTES, stream>>>(catb, WoutT, x, h1);
    k_rmsnorm<<<T, 256, 0, stream>>>(h1, D, ffn_norm, hn, D, 1, D);
    mk::k_rms_bf16<<<1024, 256, 0, stream>>>(h1, D, hnb, D, 1, D, T);
    k_gemm<false><<<dim3(1, T / 64, 1), 256, 0, stream>>>(ARow{hn, D, 0}, BRow{router_w, NE, 0}, EBias{router_b, rlog, NE, 0}, MConst{T, 0}, NE, D);
    mk::k_route2<<<T / 256, 256, 0, stream>>>(rlog, cnt, list, wlist, tinfo);
    mk::k_moe1<<<256, 512, mk::LDS_BYTES, stream>>>(hnb, WguT, b_gu, cnt, list, act);
    mk::k_moe2<<<256, 512, mk::LDS_BYTES, stream>>>(act, WdnT, b_dn, cnt, wlist, ymoe);
    mk::k_combine2<<<T, 256, 0, stream>>>(h1, ymoe, tinfo, cnt, final_norm, out);
}
```

```cpp
#include <hip/hip_runtime.h>
#include <stdint.h>
#include <math.h>

namespace nv {
constexpr int NB = 8, S = 2048, D = 1024, T = NB * S;
constexpr int INC = 2848;
constexpr int KVOFF = 512, GOFF = 1280, ZOFF = 1304, XBCOFF = 1816, DTOFF = 2840;
constexpr int NCMP = 127, NE = 32;
constexpr float EPS = 1e-6f;

__device__ __forceinline__ float wave_sum(float v) { for (int o = 32; o >= 1; o >>= 1) v += __shfl_xor(v, o); return v; }
__device__ __forceinline__ float wave_max(float v) { for (int o = 32; o >= 1; o >>= 1) v = fmaxf(v, __shfl_xor(v, o)); return v; }
__device__ __forceinline__ float siluf(float x) { return x / (1.f + expf(-x)); }
__device__ __forceinline__ float sigmf(float x) { return 1.f / (1.f + expf(-x)); }
__device__ __forceinline__ int t5_bucket(int n) {
    if (n < 0) n = 0;
    if (n < 16) return n;
    float nf = (float)n;
    int l = 16 + (int)(logf(nf / 16.f) / 2.0794415416798357f * 16.f);
    return l < 31 ? l : 31;
}

__global__ __launch_bounds__(256) void k_rmsnorm(const float* in, int ldi, const float* g, float* out, int ldo, int ng, int Dn) {
    __shared__ float red[4];
    const int r = blockIdx.x; const float* xr = in + (size_t)r * ldi;
    float s = 0.f; for (int i = threadIdx.x; i < Dn; i += 256) { float v = xr[i]; s += v * v; }
    s = wave_sum(s); if ((threadIdx.x & 63) == 0) red[threadIdx.x >> 6] = s; __syncthreads();
    s = red[0] + red[1] + red[2] + red[3];
    const float rs = rsqrtf(s / (float)Dn + EPS);
    float* o = out + (size_t)(r / ng) * ldo + (size_t)(r % ng) * Dn; const float* gg = g + (size_t)(r % ng) * Dn;
    for (int i = threadIdx.x; i < Dn; i += 256) o[i] = xr[i] * rs * gg[i];
}

template <bool DUAL, class AF, class BF, class EF, class MF>
__global__ __launch_bounds__(256) void k_gemm(AF af, BF bf, EF ef, MF mf, int N, int K) {
    __shared__ float sA[16][65]; __shared__ float sB[16][65]; __shared__ float sB2[16][65];
    const int z = blockIdx.z, M = mf(z);
    const int m0 = blockIdx.y * 64, n0 = blockIdx.x * 64;
    if (m0 >= M) return;
    const int tx = threadIdx.x & 15, ty = threadIdx.x >> 4;
    float acc[4][4], acc2[4][4];
#pragma unroll
    for (int i = 0; i < 4; ++i)
#pragma unroll
        for (int j = 0; j < 4; ++j) { acc[i][j] = 0.f; acc2[i][j] = 0.f; }
    for (int k0 = 0; k0 < K; k0 += 16) {
#pragma unroll
        for (int i = 0; i < 4; ++i) { int e = threadIdx.x + i * 256; int m = e >> 4, k = e & 15; sA[k][m] = (m0 + m < M) ? af(z, m0 + m, k0 + k) : 0.f; }
#pragma unroll
        for (int i = 0; i < 4; ++i) { int e = threadIdx.x + i * 256; int k = e >> 6, n = e & 63; sB[k][n] = (n0 + n < N) ? bf(z, k0 + k, n0 + n) : 0.f;
            if (DUAL) sB2[k][n] = (n0 + n < N) ? bf(z, k0 + k, n0 + n + N) : 0.f; }
        __syncthreads();
#pragma unroll
        for (int k = 0; k < 16; ++k) {
            float a[4], b[4], b2[4];
#pragma unroll
            for (int i = 0; i < 4; ++i) { a[i] = sA[k][ty * 4 + i]; b[i] = sB[k][tx * 4 + i]; b2[i] = DUAL ? sB2[k][tx * 4 + i] : 0.f; }
#pragma unroll
            for (int i = 0; i < 4; ++i)
#pragma unroll
                for (int j = 0; j < 4; ++j) { acc[i][j] += a[i] * b[j]; if (DUAL) acc2[i][j] += a[i] * b2[j]; }
        }
        __syncthreads();
    }
#pragma unroll
    for (int i = 0; i < 4; ++i)
#pragma unroll
        for (int j = 0; j < 4; ++j) { int m = m0 + ty * 4 + i, n = n0 + tx * 4 + j; if (m < M && n < N) ef(z, m, n, acc[i][j], acc2[i][j]); }
}
struct MConst { int M; int pad; __device__ int operator()(int) const { return M; } };
struct MCnt { const int* cnt; __device__ int operator()(int z) const { return cnt[z]; } };
struct ARow { const float* A; int lda; int pad; __device__ float operator()(int, int m, int k) const { return A[(size_t)m * lda + k]; } };
struct BRow { const float* B; int ldb; int pad; __device__ float operator()(int, int k, int n) const { return B[(size_t)k * ldb + n]; } };
struct EStore { float* C; int ldc; int pad; __device__ void operator()(int, int m, int n, float a, float) const { C[(size_t)m * ldc + n] = a; } };
struct EResid { const float* R; float* C; int ldc; int pad; __device__ void operator()(int, int m, int n, float a, float) const { C[(size_t)m * ldc + n] = R[(size_t)m * ldc + n] + a; } };
struct EBias { const float* bias; float* C; int ldc; int pad; __device__ void operator()(int, int m, int n, float a, float) const { C[(size_t)m * ldc + n] = a + bias[n]; } };
struct ACmp { const float* proj; const float* pos; __device__ float operator()(int z, int m, int k) const {
    int kvh = m & 1, bc = m >> 1, c = bc % NCMP, b = bc / NCMP, l = k >> 6, d = k & 63;
    return proj[(size_t)(b * S + c * 16 + l) * INC + KVOFF + z * 128 + kvh * 64 + d] + pos[(z * 32 + l) * 64 + d]; } };
struct BCmp1 { const float* w; __device__ float operator()(int z, int k, int n) const { return w[((size_t)z * 2048 + k) * 64 + n]; } };
struct ECmp1 { float* hid; __device__ void operator()(int z, int m, int n, float a, float) const { hid[((size_t)z * (NB * NCMP * 2) + m) * 64 + n] = siluf(a); } };
struct ACmp2 { const float* hid; __device__ float operator()(int z, int m, int k) const { return hid[((size_t)z * (NB * NCMP * 2) + m) * 64 + k]; } };
struct BCmp2 { const float* w; __device__ float operator()(int z, int k, int n) const { return w[((size_t)z * 64 + k) * 64 + n]; } };
struct ECmp2 { float* kvc; __device__ void operator()(int z, int m, int n, float a, float) const { kvc[((size_t)z * (NB * NCMP * 2) + m) * 64 + n] = a; } };
struct AMoe1 { const float* hn; const int* list; __device__ float operator()(int z, int m, int k) const { int tk = list[(size_t)z * T + m]; return hn[(size_t)(tk >> 2) * D + k]; } };
struct BMoe1 { const float* w; __device__ float operator()(int z, int k, int n) const { return w[((size_t)z * 1024 + k) * 2048 + n]; } };
struct EMoe1 { const float* bias; const int* list; float* act; __device__ void operator()(int z, int m, int n, float a, float a2) const {
    int tk = list[(size_t)z * T + m]; float g = a + bias[z * 2048 + n], u = a2 + bias[z * 2048 + 1024 + n];
    g = fminf(g, 7.f); u = fminf(fmaxf(u, -7.f), 7.f);
    act[(size_t)tk * 1024 + n] = (u + 1.f) * g * sigmf(1.702f * g); } };
struct AMoe2 { const float* act; const int* list; __device__ float operator()(int z, int m, int k) const { int tk = list[(size_t)z * T + m]; return act[(size_t)tk * 1024 + k]; } };
struct BMoe2 { const float* w; __device__ float operator()(int z, int k, int n) const { return w[((size_t)z * 1024 + k) * 1024 + n]; } };
struct EMoe2 { const float* bias; const int* list; float* y; __device__ void operator()(int z, int m, int n, float a, float) const {
    int tk = list[(size_t)z * T + m]; y[(size_t)tk * 1024 + n] = a + bias[z * 1024 + n]; } };

__global__ __launch_bounds__(256) void k_nsa(const float* proj, const float* kc, const float* vc, const float* rel_bias, float* o_nsa) {
    __shared__ float q_s[4][64]; __shared__ float pc[4][128]; __shared__ float lg[4][1024];
    __shared__ float score_s[32]; __shared__ int sellist[32]; __shared__ int nsel_s;
    const int row = blockIdx.x, kvh = blockIdx.y, b = row / S, t = row % S;
    const int g = threadIdx.x >> 6, i = threadIdx.x & 63, head = kvh * 4 + g, blk = t >> 6;
    const float* pr = proj + (size_t)row * INC;
    q_s[g][i] = pr[head * 64 + i];
    __syncthreads();
    const int nvalid = (t >= 31) ? ((t - 31) / 16 + 1) : 0;
    float lv[2]; float mx = -1e30f;
#pragma unroll
    for (int r = 0; r < 2; ++r) { int c = i + r * 64; float l = -1e30f;
        if (c < nvalid) { const float* kr = kc + ((size_t)(b * NCMP + c) * 2 + kvh) * 64; float s = 0.f; for (int d = 0; d < 64; ++d) s += q_s[g][d] * kr[d];
            l = s * 0.125f + rel_bias[t5_bucket(t - (c * 16 + 31)) * 8 + head]; }
        lv[r] = l; mx = fmaxf(mx, l); }
    mx = wave_max(mx);
    float sm = 0.f;
#pragma unroll
    for (int r = 0; r < 2; ++r) { int c = i + r * 64; float p = (c < nvalid) ? expf(lv[r] - mx) : 0.f; lv[r] = p; sm += p; }
    sm = wave_sum(sm); const float inv = 1.f / fmaxf(sm, 1e-30f);
#pragma unroll
    for (int r = 0; r < 2; ++r) pc[g][i + r * 64] = lv[r] * inv;
    __syncthreads();
    float o_cmp = 0.f;
    for (int c = 0; c < nvalid; ++c) o_cmp += pc[g][c] * vc[((size_t)(b * NCMP + c) * 2 + kvh) * 64 + i];
    if (threadIdx.x < 32) { int n = threadIdx.x; float im = 0.f;
        for (int gg = 0; gg < 4; ++gg) for (int c = 4 * n - 1; c <= 4 * n + 3; ++c) if (c >= 0 && c < NCMP) im += pc[gg][c];
        bool forced = (n == 0) || (n == blk) || (n == blk - 1);
        score_s[n] = forced ? 1e4f : ((n <= blk) ? im : -1.f); }
    __syncthreads();
    if (threadIdx.x == 0) { int ns = 0;
        for (int n = 0; n < 32; ++n) { float sn = score_s[n]; int rank = 0; for (int m = 0; m < 32; ++m) { float s2 = score_s[m]; if (s2 > sn || (s2 == sn && m < n)) ++rank; }
            if (rank < 16 && n <= blk) sellist[ns++] = n; }
        nsel_s = ns; }
    __syncthreads();
    const int nsel = nsel_s;
    float o_slc = 0.f;
    { const int nk = nsel * 64; float m2 = -1e30f;
      for (int kk = i; kk < nk; kk += 64) { int kp = sellist[kk >> 6] * 64 + (kk & 63); float l = -1e30f;
          if (kp <= t) { const float* kr = proj + (size_t)(b * S + kp) * INC + KVOFF + 2 * 128 + kvh * 64; float s = 0.f; for (int d = 0; d < 64; ++d) s += q_s[g][d] * kr[d];
              l = s * 0.125f + rel_bias[t5_bucket(t - kp) * 8 + head]; }
          lg[g][kk] = l; m2 = fmaxf(m2, l); }
      m2 = wave_max(m2); float s2 = 0.f;
      for (int kk = i; kk < nk; kk += 64) { int kp = sellist[kk >> 6] * 64 + (kk & 63); float p = (kp <= t) ? expf(lg[g][kk] - m2) : 0.f; lg[g][kk] = p; s2 += p; }
      s2 = wave_sum(s2); const float inv2 = 1.f / fmaxf(s2, 1e-30f);
      __syncthreads();
      for (int kk = 0; kk < nk; ++kk) { int kp = sellist[kk >> 6] * 64 + (kk & 63); if (kp <= t) o_slc += lg[g][kk] * proj[(size_t)(b * S + kp) * INC + KVOFF + 3 * 128 + kvh * 64 + i]; }
      o_slc *= inv2; }
    __syncthreads();
    float o_win = 0.f;
    { float m2 = -1e30f;
      for (int kk = i; kk < 512; kk += 64) { int kp = t - 511 + kk; float l = -1e30f;
          if (kp >= 0) { const float* kr = proj + (size_t)(b * S + kp) * INC + KVOFF + 4 * 128 + kvh * 64; float s = 0.f; for (int d = 0; d < 64; ++d) s += q_s[g][d] * kr[d];
              l = s * 0.125f + rel_bias[t5_bucket(t - kp) * 8 + head]; }
          lg[g][kk] = l; m2 = fmaxf(m2, l); }
      m2 = wave_max(m2); float s2 = 0.f;
      for (int kk = i; kk < 512; kk += 64) { int kp = t - 511 + kk; float p = (kp >= 0) ? expf(lg[g][kk] - m2) : 0.f; lg[g][kk] = p; s2 += p; }
      s2 = wave_sum(s2); const float inv2 = 1.f / fmaxf(s2, 1e-30f);
      __syncthreads();
      for (int kk = 0; kk < 512; ++kk) { int kp = t - 511 + kk; if (kp >= 0) o_win += lg[g][kk] * proj[(size_t)(b * S + kp) * INC + KVOFF + 5 * 128 + kvh * 64 + i]; }
      o_win *= inv2; }
    const float g0 = sigmf(pr[GOFF + 0 * 8 + head]), g1 = sigmf(pr[GOFF + 1 * 8 + head]), g2 = sigmf(pr[GOFF + 2 * 8 + head]);
    o_nsa[(size_t)row * 512 + head * 64 + i] = g0 * o_cmp + g1 * o_slc + g2 * o_win;
}

__global__ __launch_bounds__(256) void k_ssd_conv(const float* proj, const float* conv_w, const float* conv_b, const float* dt_bias, float* convx, float* dtv) {
    const int row = blockIdx.x, s = row % S;
    for (int ch = threadIdx.x; ch < 1024; ch += 256) { float a = conv_b[ch];
#pragma unroll
        for (int k = 0; k < 4; ++k) { int ss = s - 3 + k; if (ss >= 0) a += proj[(size_t)(row - 3 + k) * INC + XBCOFF + ch] * conv_w[k * 1024 + ch]; }
        convx[(size_t)row * 1024 + ch] = siluf(a); }
    if (threadIdx.x < 8) { float x = proj[(size_t)row * INC + DTOFF + threadIdx.x] + dt_bias[threadIdx.x]; dtv[row * 8 + threadIdx.x] = (x > 20.f) ? x : log1pf(expf(x)); }
}
__global__ __launch_bounds__(256) void k_ssd_scan(const float* proj, const float* convx, const float* dtv, const float* a_log, const float* d_skip, float* yssd) {
    const int b = blockIdx.x >> 3, h = blockIdx.x & 7, grp = h >> 2, p = threadIdx.x >> 2, nq = threadIdx.x & 3;
    const float A = -expf(a_log[h]), Dh = d_skip[h];
    float st[32];
#pragma unroll
    for (int j = 0; j < 32; ++j) st[j] = 0.f;
    for (int s = 0; s < S; ++s) { const size_t row = (size_t)b * S + s; const float* cx = convx + row * 1024;
        const float dt = dtv[row * 8 + h], xv = cx[h * 64 + p], dA = expf(dt * A), dx = dt * xv;
        const float* Bn = cx + 512 + grp * 128 + nq * 32; const float* Cn = cx + 768 + grp * 128 + nq * 32;
        float y = 0.f;
#pragma unroll
        for (int j = 0; j < 32; ++j) { st[j] = dA * st[j] + dx * Bn[j]; y += Cn[j] * st[j]; }
        y += __shfl_xor(y, 1); y += __shfl_xor(y, 2);
        if (nq == 0) { float z = proj[row * INC + ZOFF + h * 64 + p]; yssd[row * 512 + h * 64 + p] = (y + Dh * xv) * siluf(z); } }
}
__global__ __launch_bounds__(256) void k_route(const float* logits, int* cnt, int* list, float* topw) {
    const int t = blockIdx.x * 256 + threadIdx.x; if (t >= T) return;
    const float* lr = logits + (size_t)t * NE; unsigned used = 0u; float tv[4]; int ti[4];
#pragma unroll
    for (int k = 0; k < 4; ++k) { float best = -INFINITY; int bi = 0;
        for (int e = 0; e < NE; ++e) { float v = lr[e]; if (!((used >> e) & 1u) && v > best) { best = v; bi = e; } }
        used |= 1u << bi; tv[k] = best; ti[k] = bi; }
    float m = tv[0], sum = 0.f, w[4];
#pragma unroll
    for (int k = 0; k < 4; ++k) { w[k] = expf(tv[k] - m); sum += w[k]; }
#pragma unroll
    for (int k = 0; k < 4; ++k) { topw[t * 4 + k] = w[k] / sum; int pos = atomicAdd(&cnt[ti[k]], 1); list[(size_t)ti[k] * T + pos] = t * 4 + k; }
}
__global__ __launch_bounds__(256) void k_combine(const float* h1, const float* y, const float* topw, const float* g, float* out) {
    __shared__ float red[4];
    const int t = blockIdx.x; float v[4]; float s = 0.f;
#pragma unroll
    for (int r = 0; r < 4; ++r) { int i = threadIdx.x + r * 256; float a = h1[(size_t)t * D + i];
#pragma unroll
        for (int k = 0; k < 4; ++k) a += topw[t * 4 + k] * y[(size_t)(t * 4 + k) * D + i];
        v[r] = a; s += a * a; }
    s = wave_sum(s); if ((threadIdx.x & 63) == 0) red[threadIdx.x >> 6] = s; __syncthreads();
    s = red[0] + red[1] + red[2] + red[3]; const float rs = rsqrtf(s / (float)D + EPS);
#pragma unroll
    for (int r = 0; r < 4; ++r) { int i = threadIdx.x + r * 256; out[(size_t)t * D + i] = v[r] * rs * g[i]; }
}
}

namespace mk {
#define LAS __attribute__((address_space(3)))
typedef unsigned short bf16_t;
typedef short bf16x8 __attribute__((ext_vector_type(8)));
typedef float f32x4 __attribute__((ext_vector_type(4)));
typedef unsigned u32x4 __attribute__((ext_vector_type(4)));
typedef unsigned u32x2 __attribute__((ext_vector_type(2)));
constexpr int NB = 8, S = 2048, D = 1024, T = NB * S, NE = 32;
constexpr int BM = 256, BK = 64, HALF = 128, HTB = HALF * BK * 2, STAGE_BYTES = 8 * HTB, NXCD = 8, WGM = 8;
constexpr int KD = 1024;
constexpr int NPROJ = 3072;
constexpr int MAXSLOT = 65536 + 32 * 256;
constexpr int LDS_MISC = 131072, LDS_TILE_E = LDS_MISC + 64, LDS_TILE_M = LDS_TILE_E + 1536, LDS_ROWTAB = LDS_MISC + 4096, LDS_BYTES = LDS_ROWTAB + 12 * 1024;

__host__ __device__ __forceinline__ int lds_byte(int r, int c) { const int st = (r >> 4) * 2 + (c >> 5), rr = r & 15, cc = c & 31, ob = rr * 64 + cc * 2; return st * 1024 + (ob ^ (((ob >> 9) & 1) << 5)); }
__host__ __device__ __forceinline__ void stage_rc(int b, int& R, int& C) { const int st = b / 1024, sb = b % 1024, swz = sb ^ (((sb >> 9) & 1) << 5); R = (st >> 1) * 16 + swz / 64; C = (st & 1) * 32 + (swz % 64) / 2; }
__host__ __device__ __forceinline__ int perm32(int rho) { const int n = rho >> 4, i = rho & 15; return 8 * (i >> 2) + 4 * n + (i & 3); }
__device__ __forceinline__ unsigned cvt_pk_bf16(float lo, float hi) { unsigned r; asm volatile("v_cvt_pk_bf16_f32 %0, %1, %2" : "=v"(r) : "v"(lo), "v"(hi)); return r; }
__device__ __forceinline__ float bf2f(bf16_t b) { return __uint_as_float(((unsigned)b) << 16); }

struct Unit { int pm, pn, e, mt; };
struct StaticOrder {
    int nM, nN, nwg, G, c;
    __device__ void init(int M, int N, int G_, int c_) { nM = M / BM; nN = N / BM; nwg = nM * nN; G = G_; c = c_; }
    __device__ bool next(int i, Unit& u) const {
        const long L = (long)i * G + c; if (L >= nwg) return false;
        int wgid = (int)L; { const int q = nwg / NXCD, r = nwg % NXCD, xcd = wgid % NXCD, off = wgid / NXCD; wgid = (xcd < r ? xcd * (q + 1) : r * (q + 1) + (xcd - r) * q) + off; }
        const int nig = WGM * nN, gid = wgid / nig, fm = gid * WGM, gsz = (nM - fm) < WGM ? (nM - fm) : WGM;
        u.pm = fm + ((wgid % nig) % gsz); u.pn = (wgid % nig) / gsz; u.e = 0; u.mt = 0; return true;
    }
};
struct MoeOrder {
    int nN, G, c, RT; const LAS int* tile_e; const LAS int* tile_m;
    __device__ bool next(int i, Unit& u) const { const int L = i * G + c; if (L >= RT * nN) return false; const int rt = L / nN; u.pm = rt; u.pn = L - rt * nN; u.e = tile_e[rt]; u.mt = tile_m[rt]; return true; }
};

struct ProbProj {
    static constexpr bool PERM = true;
    StaticOrder S; const bf16_t* A; const bf16_t* Bt; bf16_t* O;
    __device__ __forceinline__ bool next(int i, Unit& u) const { return S.next(i, u); }
    __device__ __forceinline__ const char* a_base(const Unit& u) const { return (const char*)A + (size_t)u.pm * (BM * KD * 2); }
    __device__ __forceinline__ const char* b_base(const Unit& u) const { return (const char*)Bt + (size_t)u.pn * (BM * KD * 2); }
    __device__ __forceinline__ void a_offs(int, const Unit&, unsigned (&v0)[2], unsigned (&v1)[2], const int (&R)[2], const int (&C)[2]) const {
#pragma unroll
        for (int i = 0; i < 2; ++i) { v0[i] = (unsigned)(R[i] * KD + C[i]) * 2u; v1[i] = v0[i] + (unsigned)(HALF * KD * 2); } }
    __device__ __forceinline__ void epi(const f32x4 (&acc)[2][2][4][2], const Unit& u, int wr, int wc, int fr, int fq) const {
        const int row0 = u.pm * BM + wr * 64 + fr, col0 = u.pn * BM + wc * 32 + 8 * fq;
#pragma unroll
        for (int ai = 0; ai < 2; ++ai)
#pragma unroll
            for (int m = 0; m < 4; ++m) { bf16_t* rowp = O + (size_t)(row0 + ai * HALF + m * 16) * NPROJ + col0;
#pragma unroll
                for (int bj = 0; bj < 2; ++bj) { const f32x4 v0 = acc[ai][bj][m][0], v1 = acc[ai][bj][m][1]; u32x4 w;
                    w.x = cvt_pk_bf16(v0[0], v0[1]); w.y = cvt_pk_bf16(v0[2], v0[3]); w.z = cvt_pk_bf16(v1[0], v1[1]); w.w = cvt_pk_bf16(v1[2], v1[3]);
                    *(u32x4*)(rowp + bj * HALF) = w; } }
    }
};
struct ProbOut {
    static constexpr bool PERM = false;
    StaticOrder S; const bf16_t* A; const bf16_t* Bt; const float* R0; float* O;
    __device__ __forceinline__ bool next(int i, Unit& u) const { return S.next(i, u); }
    __device__ __forceinline__ const char* a_base(const Unit& u) const { return (const char*)A + (size_t)u.pm * (BM * KD * 2); }
    __device__ __forceinline__ const char* b_base(const Unit& u) const { return (const char*)Bt + (size_t)u.pn * (BM * KD * 2); }
    __device__ __forceinline__ void a_offs(int, const Unit&, unsigned (&v0)[2], unsigned (&v1)[2], const int (&R)[2], const int (&C)[2]) const {
#pragma unroll
        for (int i = 0; i < 2; ++i) { v0[i] = (unsigned)(R[i] * KD + C[i]) * 2u; v1[i] = v0[i] + (unsigned)(HALF * KD * 2); } }
    __device__ __forceinline__ void epi(const f32x4 (&acc)[2][2][4][2], const Unit& u, int wr, int wc, int fr, int fq) const {
        const int row0 = u.pm * BM + wr * 64 + fr, col0 = u.pn * BM + wc * 32 + 4 * fq;
#pragma unroll
        for (int ai = 0; ai < 2; ++ai)
#pragma unroll
            for (int m = 0; m < 4; ++m) { const size_t off = (size_t)(row0 + ai * HALF + m * 16) * D + col0;
#pragma unroll
                for (int bj = 0; bj < 2; ++bj)
#pragma unroll
                    for (int n = 0; n < 2; ++n) { const f32x4 r = *(const f32x4*)(R0 + off + bj * HALF + n * 16); *(f32x4*)(O + off + bj * HALF + n * 16) = acc[ai][bj][m][n] + r; }
                asm volatile("" ::: "memory"); }
    }
};
struct ProbMoe1 {
    static constexpr bool PERM = true;
    MoeOrder S; const bf16_t* A; const bf16_t* Bt; const float* bias; bf16_t* O; const LAS unsigned* rowtab;
    __device__ __forceinline__ bool next(int i, Unit& u) const { return S.next(i, u); }
    __device__ __forceinline__ const char* a_base(const Unit&) const { return (const char*)A; }
    __device__ __forceinline__ const char* b_base(const Unit& u) const { return (const char*)Bt + ((size_t)u.e * 2048 + (size_t)u.pn * BM) * (KD * 2); }
    __device__ __forceinline__ void a_offs(int i, const Unit&, unsigned (&v0)[2], unsigned (&v1)[2], const int (&R)[2], const int (&C)[2]) const {
#pragma unroll
        for (int j = 0; j < 2; ++j) { v0[j] = rowtab[i * 256 + R[j]] + (unsigned)C[j] * 2u; v1[j] = rowtab[i * 256 + HALF + R[j]] + (unsigned)C[j] * 2u; } }
    __device__ __forceinline__ void epi(const f32x4 (&acc)[2][2][4][2], const Unit& u, int wr, int wc, int fr, int fq) const {
        const int row0 = u.pm * BM + wr * 64 + fr, jg0 = u.pn * HALF + wc * 32 + 8 * fq;
        f32x4 bg[2], bu[2];
#pragma unroll
        for (int n = 0; n < 2; ++n) { bg[n] = *(const f32x4*)(bias + u.e * 2048 + jg0 + 4 * n); bu[n] = *(const f32x4*)(bias + u.e * 2048 + 1024 + jg0 + 4 * n); }
#pragma unroll
        for (int ai = 0; ai < 2; ++ai)
#pragma unroll
            for (int m = 0; m < 4; ++m) { float o[8];
#pragma unroll
                for (int n = 0; n < 2; ++n) { const f32x4 g4 = acc[ai][0][m][n] + bg[n], u4 = acc[ai][1][m][n] + bu[n];
#pragma unroll
                    for (int j = 0; j < 4; ++j) { const float g = fminf(g4[j], 7.f), uu = fminf(fmaxf(u4[j], -7.f), 7.f);
                        const float sg = __builtin_amdgcn_rcpf(1.f + __builtin_amdgcn_exp2f(-1.702f * 1.4426950408889634f * g)); o[n * 4 + j] = (uu + 1.f) * g * sg; } }
                u32x4 w; w.x = cvt_pk_bf16(o[0], o[1]); w.y = cvt_pk_bf16(o[2], o[3]); w.z = cvt_pk_bf16(o[4], o[5]); w.w = cvt_pk_bf16(o[6], o[7]);
                *(u32x4*)(O + (size_t)(row0 + ai * HALF + m * 16) * 1024 + jg0) = w; }
    }
};
struct ProbMoe2 {
    static constexpr bool PERM = true;
    MoeOrder S; const bf16_t* A; const bf16_t* Bt; const float* bias; const float* wlist; bf16_t* O;
    __device__ __forceinline__ bool next(int i, Unit& u) const { return S.next(i, u); }
    __device__ __forceinline__ const char* a_base(const Unit& u) const { return (const char*)A + (size_t)u.pm * (BM * KD * 2); }
    __device__ __forceinline__ const char* b_base(const Unit& u) const { return (const char*)Bt + ((size_t)u.e * 1024 + (size_t)u.pn * BM) * (KD * 2); }
    __device__ __forceinline__ void a_offs(int, const Unit&, unsigned (&v0)[2], unsigned (&v1)[2], const int (&R)[2], const int (&C)[2]) const {
#pragma unroll
        for (int i = 0; i < 2; ++i) { v0[i] = (unsigned)(R[i] * KD + C[i]) * 2u; v1[i] = v0[i] + (unsigned)(HALF * KD * 2); } }
    __device__ __forceinline__ void epi(const f32x4 (&acc)[2][2][4][2], const Unit& u, int wr, int wc, int fr, int fq) const {
        const int rl0 = wr * 64 + fr, col0 = u.pn * BM + wc * 32 + 8 * fq;
        f32x4 bv[2][2];
#pragma unroll
        for (int bj = 0; bj < 2; ++bj)
#pragma unroll
            for (int n = 0; n < 2; ++n) bv[bj][n] = *(const f32x4*)(bias + u.e * 1024 + col0 + bj * HALF + 4 * n);
#pragma unroll
        for (int ai = 0; ai < 2; ++ai)
#pragma unroll
            for (int m = 0; m < 4; ++m) { const int rl = rl0 + ai * HALF + m * 16; const float wt = wlist[(size_t)u.e * T + u.mt * BM + rl];
                bf16_t* rowp = O + (size_t)(u.pm * BM + rl) * 1024 + col0;
#pragma unroll
                for (int bj = 0; bj < 2; ++bj) { const f32x4 v0 = (acc[ai][bj][m][0] + bv[bj][0]) * wt, v1 = (acc[ai][bj][m][1] + bv[bj][1]) * wt; u32x4 w;
                    w.x = cvt_pk_bf16(v0[0], v0[1]); w.y = cvt_pk_bf16(v0[2], v0[3]); w.z = cvt_pk_bf16(v1[0], v1[1]); w.w = cvt_pk_bf16(v1[2], v1[3]);
                    *(u32x4*)(rowp + bj * HALF) = w; } }
    }
};

template <class P>
__device__ __forceinline__ void gemm_phase(LAS unsigned char* lds, const P& Pb) {
    const int tid = threadIdx.x, wid = __builtin_amdgcn_readfirstlane(tid >> 6), lane = tid & 63, wr = wid >> 2, wc = wid & 3, fr = lane & 15, fq = lane >> 4;
    constexpr int nt = KD / BK;
    int Rr[2], Cc[2]; unsigned voffB[2];
#pragma unroll
    for (int i = 0; i < 2; ++i) { int R, C; stage_rc(tid * 16 + i * 8192, R, C); const int Rb = P::PERM ? ((R & ~31) + perm32(R & 31)) : R; Rr[i] = R; Cc[i] = C; voffB[i] = (unsigned)(Rb * KD + C) * 2u; }
    constexpr size_t kstep = (size_t)(BK * 2);
    constexpr size_t hstep = (size_t)HALF * KD * 2;
    const unsigned ldsw = (unsigned)wid * 1024u;
    const int aoff = lds_byte(wr * 64 + fr, fq * 8), boff = lds_byte(wc * 32 + fr, fq * 8);
#define PG8_SA(b, h) (((b) * 2 + (h)) * HTB)
#define PG8_SB(b, h) ((4 + (b) * 2 + (h)) * HTB)
#define PG8_STAGE(bufoff, gbase, voff) do { _Pragma("unroll") for (int _i = 0; _i < 2; ++_i) \
        __builtin_amdgcn_global_load_lds((const unsigned*)((const char*)(gbase) + (voff)[_i]), (LAS unsigned*)(lds + (bufoff) + ldsw + _i * 8192), 16, 0, 0); } while (0)
#define PG8_LDA(dst, b, h) do { _Pragma("unroll") for (int m = 0; m < 4; ++m) _Pragma("unroll") for (int k = 0; k < 2; ++k) dst[m][k] = *(const LAS bf16x8*)(lds + PG8_SA(b, h) + aoff + m * 2048 + k * 1024); } while (0)
#define PG8_LDB(dst, b, h) do { _Pragma("unroll") for (int n = 0; n < 2; ++n) _Pragma("unroll") for (int k = 0; k < 2; ++k) dst[n][k] = *(const LAS bf16x8*)(lds + PG8_SB(b, h) + boff + n * 2048 + k * 1024); } while (0)
#define PG8_MMA(ai, bj, At, Bt) do { __builtin_amdgcn_s_setprio(1); _Pragma("unroll") for (int m = 0; m < 4; ++m) _Pragma("unroll") for (int n = 0; n < 2; ++n) _Pragma("unroll") for (int k = 0; k < 2; ++k) \
        acc[ai][bj][m][n] = __builtin_amdgcn_mfma_f32_16x16x32_bf16(Bt[n][k], At[m][k], acc[ai][bj][m][n], 0, 0, 0); __builtin_amdgcn_s_setprio(0); } while (0)
#define PG8_WAIT_V(n) asm volatile("s_waitcnt vmcnt(" #n ")" ::: "memory")
#define PG8_WAIT_L(n) asm volatile("s_waitcnt lgkmcnt(" #n ")" ::: "memory")
#define PG8_BAR __builtin_amdgcn_s_barrier()
#define PG8_SCHED __builtin_amdgcn_sched_barrier(0)
    Unit cur, nxt; int ui = 0;
    if (!Pb.next(0, cur)) return;
    f32x4 acc[2][2][4][2];
#pragma unroll
    for (int a = 0; a < 2; ++a)
#pragma unroll
        for (int b = 0; b < 2; ++b)
#pragma unroll
            for (int m = 0; m < 4; ++m)
#pragma unroll
                for (int n = 0; n < 2; ++n) acc[a][b][m][n] = (f32x4){0.f, 0.f, 0.f, 0.f};
    bf16x8 At[4][2], B0[2][2], B1[2][2];
    unsigned vA0[2], vA1[2];
    Pb.a_offs(0, cur, vA0, vA1, Rr, Cc);
    const char* cA = Pb.a_base(cur); const char* cB = Pb.b_base(cur);
    PG8_STAGE(PG8_SB(0, 0), cB, voffB); PG8_STAGE(PG8_SB(0, 1), cB + hstep, voffB); PG8_STAGE(PG8_SA(0, 0), cA, vA0); PG8_STAGE(PG8_SA(0, 1), cA, vA1);
    if (wr == 1) PG8_BAR;
    PG8_WAIT_V(2); PG8_BAR;
    PG8_STAGE(PG8_SB(1, 0), cB + kstep, voffB); PG8_STAGE(PG8_SA(1, 0), cA + kstep, vA0); PG8_STAGE(PG8_SB(1, 1), cB + hstep + kstep, voffB);
    PG8_WAIT_V(6); PG8_BAR;
    for (;;) {
        const bool has_next = Pb.next(ui + 1, nxt);
        const char* nA = has_next ? Pb.a_base(nxt) : cA; const char* nB = has_next ? Pb.b_base(nxt) : cB;
        for (int t = 0; t < nt; t += 2) {
            const bool last = (t == nt - 2);
            const char* a1 = cA + (size_t)(t + 1) * kstep;
            const char* a2 = last ? nA : cA + (size_t)(t + 2) * kstep; const char* b2 = last ? nB : cB + (size_t)(t + 2) * kstep;
            const char* a3 = a2 + kstep; const char* b3 = b2 + kstep;
            PG8_LDB(B0, 0, 0); PG8_LDB(B1, 0, 1); PG8_SCHED; PG8_LDA(At, 0, 0); PG8_STAGE(PG8_SA(1, 1), a1, vA1);
            PG8_WAIT_V(8); PG8_WAIT_L(0); PG8_BAR; PG8_MMA(0, 0, At, B0); PG8_MMA(0, 1, At, B1); PG8_BAR; PG8_SCHED;
            if (last && has_next) Pb.a_offs(ui + 1, nxt, vA0, vA1, Rr, Cc);
            PG8_LDA(At, 0, 1); PG8_STAGE(PG8_SB(0, 0), b2, voffB); PG8_STAGE(PG8_SB(0, 1), b2 + hstep, voffB); PG8_STAGE(PG8_SA(0, 0), a2, vA0);
            PG8_WAIT_V(8); PG8_WAIT_L(0); PG8_BAR; PG8_MMA(1, 0, At, B0); PG8_MMA(1, 1, At, B1); PG8_BAR; PG8_SCHED;
            PG8_LDB(B0, 1, 0); PG8_LDB(B1, 1, 1); PG8_SCHED; PG8_LDA(At, 1, 0); PG8_STAGE(PG8_SA(0, 1), a2, vA1);
            PG8_WAIT_V(8); PG8_WAIT_L(0); PG8_BAR; PG8_MMA(0, 0, At, B0); PG8_MMA(0, 1, At, B1); PG8_BAR; PG8_SCHED;
            PG8_LDA(At, 1, 1); PG8_STAGE(PG8_SB(1, 0), b3, voffB); PG8_STAGE(PG8_SB(1, 1), b3 + hstep, voffB); PG8_STAGE(PG8_SA(1, 0), a3, vA0);
            PG8_WAIT_V(8); PG8_WAIT_L(0); PG8_BAR; PG8_MMA(1, 0, At, B0); PG8_MMA(1, 1, At, B1); PG8_BAR; PG8_SCHED;
        }
        if (wr == 0) PG8_BAR;
        Pb.epi(acc, cur, wr, wc, fr, fq);
        if (!has_next) break;
#pragma unroll
        for (int a = 0; a < 2; ++a)
#pragma unroll
            for (int b = 0; b < 2; ++b)
#pragma unroll
                for (int m = 0; m < 4; ++m)
#pragma unroll
                    for (int n = 0; n < 2; ++n) acc[a][b][m][n] = (f32x4){0.f, 0.f, 0.f, 0.f};
        cur = nxt; cA = nA; cB = nB; ++ui;
        if (wr == 1) PG8_BAR;
    }
    PG8_WAIT_V(0);
    PG8_BAR;
#undef PG8_SA
#undef PG8_SB
#undef PG8_STAGE
#undef PG8_LDA
#undef PG8_LDB
#undef PG8_MMA
#undef PG8_WAIT_V
#undef PG8_WAIT_L
#undef PG8_BAR
#undef PG8_SCHED
}

__device__ __forceinline__ int moe_tables(LAS unsigned char* lds, const int* cnt) {
    LAS int* tile_e = (LAS int*)(lds + LDS_TILE_E); LAS int* tile_m = (LAS int*)(lds + LDS_TILE_M); LAS int* rts = (LAS int*)(lds + LDS_MISC + 32);
    if (threadIdx.x == 0) { int a = 0; for (int e = 0; e < NE; ++e) { const int n = (cnt[e] + 255) >> 8; for (int m = 0; m < n; ++m) { tile_e[a] = e; tile_m[a] = m; ++a; } } rts[0] = a; }
    __syncthreads();
    return rts[0];
}
}
namespace mk {
__device__ __forceinline__ float wsum(float v) {
#pragma unroll
    for (int o = 1; o < 64; o <<= 1) v += __shfl_xor(v, o);
    return v; }
__device__ __forceinline__ unsigned short f2bf(float f) { unsigned u = __float_as_uint(f); u += 0x7FFFu + ((u >> 16) & 1u); return (unsigned short)(u >> 16); }

__global__ __launch_bounds__(256) void k_rms_bf16(const float* in, int ldi, bf16_t* out, int ldo, int ng, int Dn, int nrows) {
    const int lane = threadIdx.x & 63; const int gw = blockIdx.x * 4 + (threadIdx.x >> 6), nw = gridDim.x * 4;
    for (int r = gw; r < nrows; r += nw) { const float* xr = in + (size_t)r * ldi; float s = 0.f;
        for (int i = lane * 4; i < Dn; i += 256) { const f32x4 v = *(const f32x4*)(xr + i); s += v[0] * v[0] + v[1] * v[1] + v[2] * v[2] + v[3] * v[3]; }
        s = wsum(s); const float rs = rsqrtf(s / (float)Dn + 1e-6f);
        bf16_t* o = out + (size_t)(r / ng) * ldo + (size_t)(r % ng) * Dn;
        for (int i = lane * 4; i < Dn; i += 256) { const f32x4 v = *(const f32x4*)(xr + i); u32x2 w; w.x = cvt_pk_bf16(v[0] * rs, v[1] * rs); w.y = cvt_pk_bf16(v[2] * rs, v[3] * rs); *(u32x2*)(o + i) = w; } }
}
__global__ __launch_bounds__(256) void k_wT(const float* W, bf16_t* WT, const float* gk1, const float* gk2, int ksplit, int K, int N, int NP, int mode, int nscale, float sc) {
    __shared__ float tile[64][65];
    const int z = blockIdx.z, n0 = blockIdx.x * 64, k0 = blockIdx.y * 64, tx = threadIdx.x & 63, ty = threadIdx.x >> 6;
    const float* Wz = W + (size_t)z * K * N; bf16_t* WTz = WT + (size_t)z * NP * K;
#pragma unroll
    for (int r = 0; r < 16; ++r) { const int kk = r * 4 + ty, k = k0 + kk, n = n0 + tx; float g = 1.f; if (gk1) g = (k < ksplit) ? gk1[k] : gk2[k - ksplit];
        tile[kk][tx] = (n < N) ? Wz[(size_t)k * N + n] * g : 0.f; }
    __syncthreads();
#pragma unroll
    for (int j = 0; j < 2; ++j) { const int id = threadIdx.x + 256 * j, nl = id >> 3, c = id & 7, n = n0 + nl; const float s = (n < nscale) ? sc : 1.f;
        int nm = n; if (mode == 1) { const int up = n >> 10, jj = n & 1023; nm = (jj >> 7) * 256 + up * 128 + (jj & 127); }
        u32x4 w; w.x = cvt_pk_bf16(tile[8 * c + 0][nl] * s, tile[8 * c + 1][nl] * s); w.y = cvt_pk_bf16(tile[8 * c + 2][nl] * s, tile[8 * c + 3][nl] * s);
        w.z = cvt_pk_bf16(tile[8 * c + 4][nl] * s, tile[8 * c + 5][nl] * s); w.w = cvt_pk_bf16(tile[8 * c + 6][nl] * s, tile[8 * c + 7][nl] * s);
        *(u32x4*)(WTz + (size_t)nm * K + k0 + 8 * c) = w; }
}
__global__ __launch_bounds__(256) void k_bf2f(const bf16_t* in, int ldi, float* out, int ldo, int ncols, int nrows) {
    for (size_t i = (size_t)blockIdx.x * 256 + threadIdx.x; i < (size_t)nrows * ncols; i += (size_t)gridDim.x * 256) { const size_t r = i / ncols, c = i % ncols; out[r * ldo + c] = bf2f(in[r * ldi + c]); }
}
__global__ __launch_bounds__(512, 2) void k_proj(const bf16_t* xb, const bf16_t* WinT, bf16_t* projb) {
    extern __shared__ __attribute__((aligned(16))) unsigned char dl[];
    ProbProj P; P.S.init(T, NPROJ, gridDim.x, blockIdx.x); P.A = xb; P.Bt = WinT; P.O = projb;
    gemm_phase(((LAS unsigned char*)dl), P);
}
__global__ __launch_bounds__(512, 2) void k_outp(const bf16_t* catb, const bf16_t* WoutT, const float* x, float* h1) {
    extern __shared__ __attribute__((aligned(16))) unsigned char dl[];
    ProbOut P; P.S.init(T, D, gridDim.x, blockIdx.x); P.A = catb; P.Bt = WoutT; P.R0 = x; P.O = h1;
    gemm_phase(((LAS unsigned char*)dl), P);
}
__global__ __launch_bounds__(512, 2) void k_moe1(const bf16_t* hnb, const bf16_t* WguT, const float* b_gu, const int* cnt, const int* list, bf16_t* act) {
    extern __shared__ __attribute__((aligned(16))) unsigned char dl[];
    LAS unsigned char* lds = (LAS unsigned char*)dl;
    const int RT = moe_tables(lds, cnt);
    ProbMoe1 P; P.S.nN = 8; P.S.G = gridDim.x; P.S.c = blockIdx.x; P.S.RT = RT; P.S.tile_e = (const LAS int*)(lds + LDS_TILE_E); P.S.tile_m = (const LAS int*)(lds + LDS_TILE_M);
    P.A = hnb; P.Bt = WguT; P.bias = b_gu; P.O = act; P.rowtab = (const LAS unsigned*)(lds + LDS_ROWTAB);
    LAS unsigned* rowtab = (LAS unsigned*)(lds + LDS_ROWTAB);
    for (int i = 0; i < 12; ++i) { Unit u; if (!P.S.next(i, u)) break; const int r = threadIdx.x; if (r < 256) { const int pos = u.mt * 256 + r; const int c = cnt[u.e];
        const int tok = (pos < c) ? (list[(size_t)u.e * T + pos] >> 2) : 0; rowtab[i * 256 + r] = (unsigned)tok * (KD * 2); } }
    __syncthreads();
    gemm_phase(lds, P);
}
__global__ __launch_bounds__(512, 2) void k_moe2(const bf16_t* act, const bf16_t* WdnT, const float* b_dn, const int* cnt, const float* wlist, bf16_t* y) {
    extern __shared__ __attribute__((aligned(16))) unsigned char dl[];
    LAS unsigned char* lds = (LAS unsigned char*)dl;
    const int RT = moe_tables(lds, cnt);
    ProbMoe2 P; P.S.nN = 4; P.S.G = gridDim.x; P.S.c = blockIdx.x; P.S.RT = RT; P.S.tile_e = (const LAS int*)(lds + LDS_TILE_E); P.S.tile_m = (const LAS int*)(lds + LDS_TILE_M);
    P.A = act; P.Bt = WdnT; P.bias = b_dn; P.wlist = wlist; P.O = y;
    gemm_phase(lds, P);
}
__global__ __launch_bounds__(256) void k_route2(const float* logits, int* cnt, int* list, float* wlist, int* tinfo) {
    const int t = blockIdx.x * 256 + threadIdx.x; if (t >= T) return;
    const float* lr = logits + (size_t)t * NE; unsigned used = 0u; float tv[4]; int ti[4];
#pragma unroll
    for (int k = 0; k < 4; ++k) { float best = -INFINITY; int bi = 0;
        for (int e = 0; e < NE; ++e) { float v = lr[e]; if (!((used >> e) & 1u) && v > best) { best = v; bi = e; } }
        used |= 1u << bi; tv[k] = best; ti[k] = bi; }
    float m = tv[0], sum = 0.f, w[4];
#pragma unroll
    for (int k = 0; k < 4; ++k) { w[k] = expf(tv[k] - m); sum += w[k]; }
#pragma unroll
    for (int k = 0; k < 4; ++k) { const int pos = atomicAdd(&cnt[ti[k]], 1); list[(size_t)ti[k] * T + pos] = t * 4 + k; wlist[(size_t)ti[k] * T + pos] = w[k] / sum; tinfo[t * 4 + k] = ti[k] | (pos << 8); }
}
__global__ __launch_bounds__(256) void k_combine2(const float* h1, const bf16_t* y, const int* tinfo, const int* cnt, const float* g, float* out) {
    __shared__ float red[4]; __shared__ int toff[NE];
    if (threadIdx.x == 0) { int a = 0; for (int e = 0; e < NE; ++e) { toff[e] = a; a += (cnt[e] + 255) >> 8; } }
    __syncthreads();
    const int t = blockIdx.x; float v[4]; float s = 0.f; size_t so[4];
#pragma unroll
    for (int k = 0; k < 4; ++k) { const int inf = tinfo[t * 4 + k]; so[k] = ((size_t)toff[inf & 255] * 256 + (inf >> 8)) * 1024; }
#pragma unroll
    for (int r = 0; r < 4; ++r) { const int i = threadIdx.x + r * 256; float a = h1[(size_t)t * D + i];
#pragma unroll
        for (int k = 0; k < 4; ++k) a += bf2f(y[so[k] + i]);
        v[r] = a; s += a * a; }
    s = wsum(s); if ((threadIdx.x & 63) == 0) red[threadIdx.x >> 6] = s; __syncthreads();
    s = red[0] + red[1] + red[2] + red[3]; const float rs = rsqrtf(s / (float)D + 1e-6f);
#pragma unroll
    for (int r = 0; r < 4; ++r) { const int i = threadIdx.x + r * 256; out[(size_t)t * D + i] = v[r] * rs * g[i]; }
}
}
namespace mk {
typedef float f32x16 __attribute__((ext_vector_type(16)));
typedef short s16x4 __attribute__((ext_vector_type(4)));
typedef __bf16 bf2_t __attribute__((ext_vector_type(2)));
typedef float f2_t __attribute__((ext_vector_type(2)));
#define MFMA32(a, b, c) __builtin_amdgcn_mfma_f32_32x32x16_bf16((a), (b), (c), 0, 0, 0)
constexpr float LOG2E = 1.4426950408889634f;
constexpr int PROJ_LD = NPROJ;
constexpr int AT_KBUF = 0, AT_VBUF = 16384, AT_IMPW = 32768, AT_SCORE = 65536, AT_OBUF = 73728, AT_OSTR = 1040, AT_BTAB = AT_OBUF + 64 * AT_OSTR  ,
              AT_SEL = AT_BTAB + 8 * 132 * 4  , AT_SSQ = AT_SEL + 512  , AT_END = AT_SSQ + 8 * 64 * 4  ;
struct AttnArgs { const bf16_t* projb; const bf16_t* kc; const bf16_t* vc; bf16_t* catb; };

__device__ __forceinline__ unsigned pk2(float a, float b) { f2_t v = {a, b}; return __builtin_bit_cast(unsigned, __builtin_convertvector(v, bf2_t)); }
__device__ __forceinline__ int t5_bucket(int n) { if (n < 0) n = 0; if (n < 16) return n; const float nf = (float)n; const int l = 16 + (int)(logf(nf / 16.f) / 2.0794415416798357f * 16.f); return l < 31 ? l : 31; }
__device__ __forceinline__ void stage_tile(LAS unsigned char* dst, const char* src, size_t row_stride, int wid, int lane, bool vswz) {
    const int row = 8 * wid + (lane >> 3), slot = lane & 7;
    const int f = vswz ? (((row >> 1) & 1) << 2) : ((row >> 1) & 7);
    __builtin_amdgcn_global_load_lds((const unsigned*)(src + (size_t)row * row_stride + ((slot ^ f) << 4)), (LAS unsigned*)(dst + wid * 1024), 16, 0, 0);
}
#define AT_CROW(r, h) (((r) & 3) + 8 * ((r) >> 2) + 4 * (h))
#define AT_PACK8(x, s) __builtin_bit_cast(bf16x8, (u32x4){pk2((x)[8 * (s)], (x)[8 * (s) + 1]), pk2((x)[8 * (s) + 2], (x)[8 * (s) + 3]), pk2((x)[8 * (s) + 4], (x)[8 * (s) + 5]), pk2((x)[8 * (s) + 6], (x)[8 * (s) + 7])})
__device__ __forceinline__ bf16x8 vt_frag(const LAS unsigned char* vt, unsigned vaddr, int rowoff) {
    const s16x4 lo = __builtin_amdgcn_ds_read_tr16_b64_v4i16((LAS s16x4*)(vt + vaddr + rowoff * 128));
    const s16x4 hi = __builtin_amdgcn_ds_read_tr16_b64_v4i16((LAS s16x4*)(vt + vaddr + (rowoff + 8) * 128));
    return __builtin_shufflevector(lo, hi, 0, 1, 2, 3, 4, 5, 6, 7);
}
template <bool FIRST>
__device__ __forceinline__ void obuf_acc(LAS unsigned char* lds, int tl, int hd, int h, float sc, const f32x16 (&oc)[2]) {
#pragma unroll
    for (int c = 0; c < 2; ++c)
#pragma unroll
        for (int qd = 0; qd < 4; ++qd) { LAS u32x2* p = (LAS u32x2*)(lds + AT_OBUF + tl * AT_OSTR + (hd * 64 + 32 * c + 8 * qd + 4 * h) * 2);
            float a0 = sc * oc[c][4 * qd], a1 = sc * oc[c][4 * qd + 1], a2 = sc * oc[c][4 * qd + 2], a3 = sc * oc[c][4 * qd + 3];
            if (!FIRST) { const u32x2 o = *p; a0 += __uint_as_float(o.x << 16); a1 += __uint_as_float(o.x & 0xffff0000u); a2 += __uint_as_float(o.y << 16); a3 += __uint_as_float(o.y & 0xffff0000u); }
            *p = (u32x2){pk2(a0, a1), pk2(a2, a3)}; }
}
template <int MODE>
__device__ __forceinline__ void attn_tile(const LAS unsigned char* Kt, const LAS unsigned char* Vt, int kbase, int tq, int t0, bool selbit, const bf16x8 (&qf)[4], const LAS float* bt, float cfar,
                                          f32x16 (&O)[2], float& m, float& l, int ql, int h, const unsigned (&vaddr)[2]) {
    f32x16 s0, s1;
#pragma unroll
    for (int r = 0; r < 16; ++r) { s0[r] = 0.f; s1[r] = 0.f; }
    const int fk = (ql >> 1) & 7;
#pragma unroll
    for (int s = 0; s < 4; ++s) { const int ch = ((2 * s + h) ^ fk) << 4;
        const bf16x8 k0 = *(const LAS bf16x8*)(Kt + ql * 128 + ch), k1 = *(const LAS bf16x8*)(Kt + (32 + ql) * 128 + ch);
        s0 = MFMA32(k0, qf[s], s0); s1 = MFMA32(k1, qf[s], s1); }
    const bool far = (kbase + 191 <= t0);
    float mx = -INFINITY;
#pragma unroll
    for (int r = 0; r < 16; ++r) {
        const int key0 = kbase + AT_CROW(r, h), key1 = key0 + 32;
        const int d0 = tq - key0, d1 = tq - key1;
        bool v0, v1;
        if (MODE == 0) { v0 = selbit && d0 >= 0; v1 = selbit && d1 >= 0; } else { v0 = d0 >= 0 && d0 < 512; v1 = d1 >= 0 && d1 < 512; }
        float b0, b1;
        if (far) { b0 = cfar; b1 = cfar; } else { b0 = bt[min(max(d0, 0), 128)]; b1 = bt[min(max(d1, 0), 128)]; }
        const float x0 = v0 ? s0[r] + b0 : -INFINITY, x1 = v1 ? s1[r] + b1 : -INFINITY;
        s0[r] = x0; s1[r] = x1; mx = fmaxf(mx, fmaxf(x0, x1));
    }
    mx = fmaxf(mx, __shfl_xor(mx, 32));
    const float mn = fmaxf(m, mx);
    const float alpha = __builtin_amdgcn_exp2f(m - mn);
    float ps = 0.f;
#pragma unroll
    for (int r = 0; r < 16; ++r) { const float p0 = __builtin_amdgcn_exp2f(s0[r] - mn), p1 = __builtin_amdgcn_exp2f(s1[r] - mn); s0[r] = p0; s1[r] = p1; ps += p0 + p1; }
    l = l * alpha + ps; m = mn;
    if (__any(alpha != 1.f)) {
#pragma unroll
        for (int r = 0; r < 16; ++r) { O[0][r] *= alpha; O[1][r] *= alpha; } }
#pragma unroll
    for (int sp = 0; sp < 2; ++sp) {
        const bf16x8 p0 = AT_PACK8(s0, sp), p1 = AT_PACK8(s1, sp);
#pragma unroll
        for (int c = 0; c < 2; ++c) { O[c] = MFMA32(vt_frag(Vt, vaddr[c], 16 * sp), p0, O[c]); O[c] = MFMA32(vt_frag(Vt, vaddr[c], 32 + 16 * sp), p1, O[c]); }
    }
}

__device__ __forceinline__ void attn_item(LAS unsigned char* lds, const AttnArgs& A, int b, int qt) {
    const int tid = threadIdx.x, wid = __builtin_amdgcn_readfirstlane(tid >> 6), lane = tid & 63;
    const int g = wid >> 1, th = wid & 1, ql = lane & 31, h = lane >> 5;
    const int t0 = qt * 64, tl = th * 32 + ql, tq = t0 + tl, blk = qt;
    const size_t rowq = (size_t)b * S + tq;
    const int qq = (lane & 15) >> 2, pp = lane & 3, lb = (lane >> 4) & 1;
    unsigned vaddr[2];
#pragma unroll
    for (int c = 0; c < 2; ++c) vaddr[c] = (unsigned)((4 * h + qq) * 128 + (((4 * (c ^ ((qq >> 1) & 1))) + 2 * lb + (pp >> 1)) << 4) + 8 * (pp & 1));
    LAS float* impw = (LAS float*)(lds + AT_IMPW); LAS float* score = (LAS float*)(lds + AT_SCORE); LAS unsigned* selm = (LAS unsigned*)(lds + AT_SEL);
    const char* prow0 = (const char*)(A.projb + (size_t)b * S * PROJ_LD);
    const size_t RS = (size_t)PROJ_LD * 2;
    for (int kvh = 0; kvh < 2; ++kvh) {
        const int hd = kvh * 4 + g;
        const LAS float* bt = (const LAS float*)(lds + AT_BTAB) + hd * 132;
        const float cfar = bt[128];
        bf16x8 qf[4];
#pragma unroll
        for (int s = 0; s < 4; ++s) qf[s] = *(const bf16x8*)(A.projb + rowq * PROJ_LD + hd * 64 + 16 * s + 8 * h);
        float gate[3];
#pragma unroll
        for (int j = 0; j < 3; ++j) { const float gv = bf2f(A.projb[rowq * PROJ_LD + 1280 + j * 8 + hd]); gate[j] = 1.f / (1.f + __expf(-gv)); }
        __syncthreads();
        { const char* kcb = (const char*)(A.kc + (size_t)(b * 2 + kvh) * 128 * 64); const char* vcb = (const char*)(A.vc + (size_t)(b * 2 + kvh) * 128 * 64);
          stage_tile(lds + AT_KBUF, kcb, 128, wid, lane, false); stage_tile(lds + AT_KBUF + 8192, kcb + 64 * 128, 128, wid, lane, false);
          stage_tile(lds + AT_VBUF, vcb, 128, wid, lane, true); stage_tile(lds + AT_VBUF + 8192, vcb + 64 * 128, 128, wid, lane, true); }
        asm volatile("s_waitcnt vmcnt(0)" ::: "memory"); __syncthreads();
        {
            f32x16 sc[4]; const int fk = (ql >> 1) & 7; int tqc = tq; asm volatile("" : "+v"(tqc));
#pragma unroll
            for (int kb = 0; kb < 4; ++kb) {
#pragma unroll
                for (int r = 0; r < 16; ++r) sc[kb][r] = 0.f;
#pragma unroll
                for (int s = 0; s < 4; ++s) { const bf16x8 kf = *(const LAS bf16x8*)(lds + AT_KBUF + (32 * kb + ql) * 128 + (((2 * s + h) ^ fk) << 4)); sc[kb] = MFMA32(kf, qf[s], sc[kb]); }
                __builtin_amdgcn_sched_barrier(0); }
            float mx = -INFINITY;
#pragma unroll
            for (int kb = 0; kb < 4; ++kb)
#pragma unroll
                for (int r = 0; r < 16; ++r) { const int c = 32 * kb + AT_CROW(r, h); const int dist = tqc - 16 * c - 31; const float bv = bt[min(max(dist, 0), 128)]; const float x = (dist >= 0) ? sc[kb][r] + bv : -INFINITY; sc[kb][r] = x; mx = fmaxf(mx, x);
                    if ((r & 7) == 7) __builtin_amdgcn_sched_barrier(0); }
            mx = fmaxf(mx, __shfl_xor(mx, 32));
            const float mref = (mx == -INFINITY) ? 0.f : mx;
            float ls = 0.f;
#pragma unroll
            for (int kb = 0; kb < 4; ++kb)
#pragma unroll
                for (int r = 0; r < 16; ++r) { const float p = __builtin_amdgcn_exp2f(sc[kb][r] - mref); sc[kb][r] = p; ls += p; }
            ls += __shfl_xor(ls, 32);
            const float inv = 1.f / fmaxf(ls, 1e-30f);
#pragma unroll
            for (int kb = 0; kb < 4; ++kb)
#pragma unroll
                for (int r = 0; r < 16; ++r) sc[kb][r] *= inv;
            { float carry = 0.f;
#pragma unroll
              for (int i = 0; i < 16; ++i) { const int kb = i >> 2, qd = i & 3;
                  const float s4 = (sc[kb][4 * qd] + sc[kb][4 * qd + 1]) + (sc[kb][4 * qd + 2] + sc[kb][4 * qd + 3]);
                  const float rv = __shfl_xor(sc[kb][4 * qd + 3], 32);
                  impw[(wid * 32 + ql) * 32 + 2 * i + h] = s4 + (h ? rv : carry); carry = rv; } }
            f32x16 oc[2];
#pragma unroll
            for (int r = 0; r < 16; ++r) { oc[0][r] = 0.f; oc[1][r] = 0.f; }
#pragma unroll
            for (int kb = 0; kb < 4; ++kb)
#pragma unroll
                for (int sp = 0; sp < 2; ++sp) { const bf16x8 pf = AT_PACK8(sc[kb], sp);
#pragma unroll
                    for (int c = 0; c < 2; ++c) oc[c] = MFMA32(vt_frag(lds + AT_VBUF, vaddr[c], 32 * kb + 16 * sp), pf, oc[c]);
                    __builtin_amdgcn_sched_barrier(0); }
            obuf_acc<true>(lds, tl, hd, h, gate[0], oc);
        }
        __syncthreads();
        int tids = tid; asm volatile("" : "+v"(tids));
#pragma unroll
        for (int i = 0; i < 4; ++i) { const int id = tids + 512 * i, tk = id >> 5, n = id & 31, w0 = tk >> 5, q = tk & 31;
            float v = 0.f;
#pragma unroll
            for (int gg = 0; gg < 4; ++gg) v += impw[((2 * gg + w0) * 32 + q) * 32 + n];
            const bool forced = (n == 0) || (n == blk) || (n == blk - 1);
            score[tk * 32 + n] = forced ? 1e4f : ((n <= blk) ? v : -1.f); }
        __syncthreads();
#pragma unroll
        for (int i = 0; i < 4; ++i) { const int id = tids + 512 * i, tk = id >> 5, n = id & 31;
            const float sn = score[tk * 32 + n]; int rank = 0;
            for (int mm = 0; mm < 32; ++mm) { const float s2 = score[tk * 32 + mm]; rank += (s2 > sn || (s2 == sn && mm < n)) ? 1 : 0; }
            const bool sel = (rank < 16) && (n <= blk);
            const unsigned long long bal = __ballot(sel);
            if (n == 0) selm[tk] = (unsigned)(bal >> (32 * (lane >> 5))); }
        __syncthreads();
        unsigned U = selm[lane];
#pragma unroll
        for (int o = 1; o < 64; o <<= 1) U |= (unsigned)__shfl_xor((int)U, o);
        U = (unsigned)__builtin_amdgcn_readfirstlane((int)U);
        const unsigned mysel = selm[tl];
        {
            f32x16 oc[2];
#pragma unroll
            for (int r = 0; r < 16; ++r) { oc[0][r] = 0.f; oc[1][r] = 0.f; }
            float m = -1e30f, l = 0.f;
            const char* kcol = prow0 + (512 + 2 * 128 + kvh * 64) * 2; const char* vcol = prow0 + (512 + 3 * 128 + kvh * 64) * 2;
            int n = __builtin_ctz(U | 0x80000000u), buf = 0;
            stage_tile(lds + AT_KBUF, kcol + (size_t)n * 64 * RS, RS, wid, lane, false); stage_tile(lds + AT_VBUF, vcol + (size_t)n * 64 * RS, RS, wid, lane, true);
            for (;;) {
                asm volatile("s_waitcnt vmcnt(0)" ::: "memory"); __syncthreads();
                const unsigned rest = (n >= 31) ? 0u : (U & ~((2u << n) - 1u));
                const int nn = rest ? __builtin_ctz(rest) : -1;
                if (nn >= 0) { stage_tile(lds + AT_KBUF + (buf ^ 1) * 8192, kcol + (size_t)nn * 64 * RS, RS, wid, lane, false); stage_tile(lds + AT_VBUF + (buf ^ 1) * 8192, vcol + (size_t)nn * 64 * RS, RS, wid, lane, true); }
                attn_tile<0>(lds + AT_KBUF + buf * 8192, lds + AT_VBUF + buf * 8192, n * 64, tq, t0, ((mysel >> n) & 1u) != 0u, qf, bt, cfar, oc, m, l, ql, h, vaddr);
                if (nn < 0) break;
                n = nn; buf ^= 1;
            }
            l += __shfl_xor(l, 32);
            const float sc1 = gate[1] / fmaxf(l, 1e-30f);
            obuf_acc<false>(lds, tl, hd, h, sc1, oc);
        }
        {
            f32x16 oc[2];
#pragma unroll
            for (int r = 0; r < 16; ++r) { oc[0][r] = 0.f; oc[1][r] = 0.f; }
            float m = -1e30f, l = 0.f;
            const char* kcol = prow0 + (512 + 4 * 128 + kvh * 64) * 2; const char* vcol = prow0 + (512 + 5 * 128 + kvh * 64) * 2;
            int n = (blk >= 8) ? blk - 8 : 0, buf = 0;
            __syncthreads();
            stage_tile(lds + AT_KBUF, kcol + (size_t)n * 64 * RS, RS, wid, lane, false); stage_tile(lds + AT_VBUF, vcol + (size_t)n * 64 * RS, RS, wid, lane, true);
            for (;;) {
                asm volatile("s_waitcnt vmcnt(0)" ::: "memory"); __syncthreads();
                const int nn = (n < blk) ? n + 1 : -1;
                if (nn >= 0) { stage_tile(lds + AT_KBUF + (buf ^ 1) * 8192, kcol + (size_t)nn * 64 * RS, RS, wid, lane, false); stage_tile(lds + AT_VBUF + (buf ^ 1) * 8192, vcol + (size_t)nn * 64 * RS, RS, wid, lane, true); }
                attn_tile<1>(lds + AT_KBUF + buf * 8192, lds + AT_VBUF + buf * 8192, n * 64, tq, t0, true, qf, bt, cfar, oc, m, l, ql, h, vaddr);
                if (nn < 0) break;
                n = nn; buf ^= 1;
            }
            l += __shfl_xor(l, 32);
            const float sc2 = gate[2] / fmaxf(l, 1e-30f);
            obuf_acc<false>(lds, tl, hd, h, sc2, oc);
        }
    }
    __syncthreads();
    int widn = wid; asm volatile("" : "+s"(widn));
#pragma unroll 1
    for (int i = 0; i < 8; ++i) { const int row = widn + 8 * i;
        const u32x4 v = *(const LAS u32x4*)(lds + AT_OBUF + row * AT_OSTR + lane * 16);
        float f[8]; f[0] = __uint_as_float(v.x << 16); f[1] = __uint_as_float(v.x & 0xffff0000u); f[2] = __uint_as_float(v.y << 16); f[3] = __uint_as_float(v.y & 0xffff0000u);
        f[4] = __uint_as_float(v.z << 16); f[5] = __uint_as_float(v.z & 0xffff0000u); f[6] = __uint_as_float(v.w << 16); f[7] = __uint_as_float(v.w & 0xffff0000u);
        float sq = 0.f;
#pragma unroll
        for (int j = 0; j < 8; ++j) sq += f[j] * f[j];
        sq = wsum(sq);
        const float rs = rsqrtf(sq * (1.f / 512.f) + 1e-6f);
        u32x4 w; w.x = pk2(f[0] * rs, f[1] * rs); w.y = pk2(f[2] * rs, f[3] * rs); w.z = pk2(f[4] * rs, f[5] * rs); w.w = pk2(f[6] * rs, f[7] * rs);
        *(u32x4*)(A.catb + ((size_t)b * S + t0 + row) * 1024 + lane * 8) = w; }
    __syncthreads();
}
__device__ __forceinline__ void attn_btab(LAS unsigned char* lds, const float* rel_bias) {
    LAS float* bt = (LAS float*)(lds + AT_BTAB);
    for (int i = threadIdx.x; i < 8 * 129; i += 512) { const int hd = i / 129, d = i % 129; bt[hd * 132 + d] = rel_bias[t5_bucket(d) * 8 + hd] * LOG2E; }
    __syncthreads();
}
__global__ __launch_bounds__(512, 2) void k_attn(AttnArgs A, const float* rel_bias) {
    extern __shared__ __attribute__((aligned(16))) unsigned char dl[];
    LAS unsigned char* lds = (LAS unsigned char*)dl;
    attn_btab(lds, rel_bias);
    for (int it = blockIdx.x; it < NB * 32; it += gridDim.x) attn_item(lds, A, it & 7, 31 - (it >> 3));
}
__global__ __launch_bounds__(256) void k_kvc_bf16(const float* kvc, bf16_t* kc, bf16_t* vc) {
    const int i = blockIdx.x * 256 + threadIdx.x; if (i >= 2 * NB * 2 * 128 * 64) return;
    const int d = i & 63, c = (i >> 6) & 127, kvh = (i >> 13) & 1, b = (i >> 14) & 7, z = i >> 17;
    const float v = (c < 127) ? kvc[((size_t)z * (NB * 127 * 2) + (size_t)(b * 127 + c) * 2 + kvh) * 64 + d] : 0.f;
    (z ? vc : kc)[((size_t)(b * 2 + kvh) * 128 + c) * 64 + d] = f2bf(v);
}
}
namespace mk {
constexpr int XBC_OFF = 1816, Z_OFF = 1304, DT_OFF = 2840, NCH = 16;
constexpr int SD_XS = 0, SD_B = 65536, SD_C = 98304, SD_ACS = 131072, SD_DT = SD_ACS + 2048, SD_W = SD_DT + 2048, SD_WP = SD_W + 2048  , SD_END = SD_WP + 256;
struct SsdArgs { const bf16_t* projb; const float* conv_w; const float* conv_b; const float* dt_bias; const float* a_log; const float* d_skip; bf16_t* states; float* alast; bf16_t* catb; };

__device__ __forceinline__ void ssd_dt_acs(LAS unsigned char* lds, const SsdArgs& A, int b, int c, int grp, int wid, int lane) {
    if (wid < 4) { const int hd = grp * 4 + wid; const float Ah = -__expf(A.a_log[hd]), db = A.dt_bias[hd];
        const size_t row = (size_t)b * S + c * 128 + 2 * lane;
        float x0 = bf2f(A.projb[row * PROJ_LD + DT_OFF + hd]) + db, x1 = bf2f(A.projb[(row + 1) * PROJ_LD + DT_OFF + hd]) + db;
        const float d0 = (x0 > 20.f) ? x0 : log1pf(__expf(x0)), d1 = (x1 > 20.f) ? x1 : log1pf(__expf(x1));
        const float a0 = d0 * Ah, a1 = d1 * Ah; float incl = a0 + a1;
#pragma unroll
        for (int o = 1; o < 64; o <<= 1) { const float t = __shfl_up(incl, o); if (lane >= o) incl += t; }
        LAS float* acs = (LAS float*)(lds + SD_ACS) + wid * 128; LAS float* dtl = (LAS float*)(lds + SD_DT) + wid * 128;
        acs[2 * lane] = incl - a1; acs[2 * lane + 1] = incl; dtl[2 * lane] = d0; dtl[2 * lane + 1] = d1; }
}
template <bool PHASE_A>
__device__ __forceinline__ void ssd_conv(LAS unsigned char* lds, const SsdArgs& A, int b, int c, int grp, int wid, int lane) {
    const int ch = lane;
    if (PHASE_A && ch >= 48) return;
    const int rel = (ch < 32) ? grp * 256 + ch * 8 : (ch < 48) ? 512 + grp * 128 + (ch - 32) * 8 : 768 + grp * 128 + (ch - 48) * 8;
    float w[4][8], bias[8];
#pragma unroll
    for (int k = 0; k < 4; ++k) { const f32x4 u0 = *(const f32x4*)(A.conv_w + k * 1024 + rel), u1 = *(const f32x4*)(A.conv_w + k * 1024 + rel + 4);
#pragma unroll
        for (int j = 0; j < 4; ++j) { w[k][j] = u0[j]; w[k][4 + j] = u1[j]; } }
    { const f32x4 u0 = *(const f32x4*)(A.conv_b + rel), u1 = *(const f32x4*)(A.conv_b + rel + 4);
#pragma unroll
      for (int j = 0; j < 4; ++j) { bias[j] = u0[j]; bias[4 + j] = u1[j]; } }
    const int tl0 = wid * 16, ts0 = c * 128 + tl0;
    const bf16_t* src = A.projb + ((size_t)b * S + ts0) * PROJ_LD + XBC_OFF + rel;
    float x0[8], x1[8], x2[8];
#pragma unroll
    for (int j = 0; j < 8; ++j) { x0[j] = 0.f; x1[j] = 0.f; x2[j] = 0.f; }
    if (ts0 >= 3) {
        const bf16x8 r0 = *(const bf16x8*)(src - 3 * (ptrdiff_t)PROJ_LD), r1 = *(const bf16x8*)(src - 2 * (ptrdiff_t)PROJ_LD), r2 = *(const bf16x8*)(src - 1 * (ptrdiff_t)PROJ_LD);
#pragma unroll
        for (int j = 0; j < 8; ++j) { x0[j] = bf2f((bf16_t)r0[j]); x1[j] = bf2f((bf16_t)r1[j]); x2[j] = bf2f((bf16_t)r2[j]); } }
    const LAS float* wt = (const LAS float*)(lds + SD_W) + (ch >> 3) * 128;
#pragma unroll 4
    for (int i = 0; i < 16; ++i) {
        const bf16x8 rv = *(const bf16x8*)(src + (size_t)i * PROJ_LD);
        float x3[8], o[8];
#pragma unroll
        for (int j = 0; j < 8; ++j) { x3[j] = bf2f((bf16_t)rv[j]); const float a = bias[j] + w[0][j] * x0[j] + w[1][j] * x1[j] + w[2][j] * x2[j] + w[3][j] * x3[j]; o[j] = a / (1.f + __expf(-a)); x0[j] = x1[j]; x1[j] = x2[j]; x2[j] = x3[j]; }
        const int row = tl0 + i;
        if (PHASE_A && ch < 32) { const float sc = wt[row];
#pragma unroll
            for (int j = 0; j < 8; ++j) o[j] *= sc; }
        u32x4 pk; pk.x = pk2(o[0], o[1]); pk.y = pk2(o[2], o[3]); pk.z = pk2(o[4], o[5]); pk.w = pk2(o[6], o[7]);
        if (ch < 32) *(LAS u32x4*)(lds + SD_XS + row * 512 + ((ch ^ ((row & 3) << 2)) << 4)) = pk;
        else if (ch < 48) { const int cc = ch - 32; *(LAS u32x4*)(lds + SD_B + row * 256 + ((PHASE_A ? (cc ^ ((row & 3) << 2)) : (cc ^ (row & 15))) << 4)) = pk; }
        else { const int cc = ch - 48; *(LAS u32x4*)(lds + SD_C + row * 256 + ((cc ^ (row & 15)) << 4)) = pk; }
    }
}
__device__ __forceinline__ bf16x8 tr_frag2(const LAS unsigned char* base, int stride, int r0, int r1, int chunk0, int qq, int pp) {
    const int cl = chunk0 + (pp >> 1);
    const s16x4 lo = __builtin_amdgcn_ds_read_tr16_b64_v4i16((LAS s16x4*)(base + (r0 + qq) * stride + ((cl ^ (qq << 2)) << 4) + 8 * (pp & 1)));
    const s16x4 hi = __builtin_amdgcn_ds_read_tr16_b64_v4i16((LAS s16x4*)(base + (r1 + qq) * stride + ((cl ^ (qq << 2)) << 4) + 8 * (pp & 1)));
    return __builtin_shufflevector(lo, hi, 0, 1, 2, 3, 4, 5, 6, 7);
}
__device__ __forceinline__ void ssd_a_item(LAS unsigned char* lds, const SsdArgs& A, int item) {
    const int tid = threadIdx.x, wid = __builtin_amdgcn_readfirstlane(tid >> 6), lane = tid & 63;
    const int grp = item & 1, c = (item >> 1) & 15, b = item >> 5;
    const int ql = lane & 31, h = lane >> 5, qq = (lane & 15) >> 2, pp = lane & 3, lb2 = (lane >> 4) & 1;
    __syncthreads();
    ssd_dt_acs(lds, A, b, c, grp, wid, lane);
    __syncthreads();
    { LAS float* acs = (LAS float*)(lds + SD_ACS); LAS float* dtl = (LAS float*)(lds + SD_DT); LAS float* wt = (LAS float*)(lds + SD_W);
      const int hh = tid >> 7, t = tid & 127; const float al = acs[hh * 128 + 127];
      wt[hh * 128 + t] = dtl[hh * 128 + t] * __expf(al - acs[hh * 128 + t]);
      if (t == 0) A.alast[(b * 8 + grp * 4 + hh) * NCH + c] = al; }
    __syncthreads();
    ssd_conv<true>(lds, A, b, c, grp, wid, lane);
    __syncthreads();
    const int pb = wid >> 2, nb = wid & 3;
#pragma unroll 1
    for (int hh = 0; hh < 4; ++hh) {
        f32x16 acc;
#pragma unroll
        for (int r = 0; r < 16; ++r) acc[r] = 0.f;
#pragma unroll
        for (int kk = 0; kk < 8; ++kk) {
            const bf16x8 af = tr_frag2(lds + SD_XS, 512, 16 * kk + 8 * h, 16 * kk + 8 * h + 4, hh * 8 + 4 * pb + 2 * lb2, qq, pp);
            const bf16x8 bf = tr_frag2(lds + SD_B, 256, 16 * kk + 8 * h, 16 * kk + 8 * h + 4, 4 * nb + 2 * lb2, qq, pp);
            acc = MFMA32(af, bf, acc); }
        bf16_t* st = A.states + ((size_t)((b * NCH + c) * 8 + grp * 4 + hh) * 64) * 128;
#pragma unroll
        for (int r = 0; r < 16; ++r) st[(32 * pb + AT_CROW(r, h)) * 128 + 32 * nb + ql] = f2bf(acc[r]);
    }
}
__device__ __forceinline__ void ssd_b_item(LAS unsigned char* lds, const SsdArgs& A, int item) {
    const int tid = threadIdx.x, wid = __builtin_amdgcn_readfirstlane(tid >> 6), lane = tid & 63;
    const int grp = item & 1, c = (item >> 1) & 15, b = item >> 5;
    const int ql = lane & 31, h = lane >> 5, qq = (lane & 15) >> 2, pp = lane & 3, lb2 = (lane >> 4) & 1;
    const int pb = wid >> 2, lb = wid & 3;
    LAS float* acs = (LAS float*)(lds + SD_ACS); LAS float* dtl = (LAS float*)(lds + SD_DT); LAS float* wp = (LAS float*)(lds + SD_WP);
    __syncthreads();
    ssd_dt_acs(lds, A, b, c, grp, wid, lane);
    if (tid >= 256 && tid < 320) { const int hh = (tid - 256) >> 4, cp = tid & 15; float s = 0.f;
        for (int c2 = cp + 1; c2 < c; ++c2) s += A.alast[(b * 8 + grp * 4 + hh) * NCH + c2];
        wp[hh * 16 + cp] = (cp < c) ? __expf(s) : 0.f; }
    ssd_conv<false>(lds, A, b, c, grp, wid, lane);
    __syncthreads();
    f32x16 X[4];
#pragma unroll
    for (int sb = 0; sb < 4; ++sb) {
#pragma unroll
        for (int r = 0; r < 16; ++r) X[sb][r] = 0.f;
        if (sb <= lb) {
#pragma unroll
            for (int kk = 0; kk < 8; ++kk) {
                const bf16x8 af = *(const LAS bf16x8*)(lds + SD_B + (32 * sb + ql) * 256 + (((2 * kk + h) ^ (ql & 15)) << 4));
                const bf16x8 bf = *(const LAS bf16x8*)(lds + SD_C + (32 * lb + ql) * 256 + (((2 * kk + h) ^ (ql & 15)) << 4));
                X[sb] = MFMA32(af, bf, X[sb]); } }
    }
    __syncthreads();
#pragma unroll 1
    for (int hh = 0; hh < 4; ++hh) {
        const int hd = grp * 4 + hh;
        { float pv[16];
#pragma unroll
          for (int j = 0; j < 16; ++j) pv[j] = 0.f;
          const int p = tid >> 3, n0 = (tid & 7) * 16;
          for (int cp = 0; cp < c; ++cp) { const float wgt = wp[hh * 16 + cp];
              const bf16_t* sp = A.states + ((size_t)((b * NCH + cp) * 8 + hd) * 64 + p) * 128 + n0;
              const bf16x8 s0 = *(const bf16x8*)sp, s1 = *(const bf16x8*)(sp + 8);
#pragma unroll
              for (int j = 0; j < 8; ++j) { pv[j] += wgt * bf2f((bf16_t)s0[j]); pv[8 + j] += wgt * bf2f((bf16_t)s1[j]); } }
          LAS unsigned char* pbuf = lds + SD_B + (hh & 1) * 16384 + p * 256;
          *(LAS u32x4*)(pbuf + ((((n0 >> 3)) ^ (p & 15)) << 4)) = (u32x4){pk2(pv[0], pv[1]), pk2(pv[2], pv[3]), pk2(pv[4], pv[5]), pk2(pv[6], pv[7])};
          *(LAS u32x4*)(pbuf + ((((n0 >> 3) + 1) ^ (p & 15)) << 4)) = (u32x4){pk2(pv[8], pv[9]), pk2(pv[10], pv[11]), pk2(pv[12], pv[13]), pk2(pv[14], pv[15])}; }
        __syncthreads();
        f32x16 acc;
#pragma unroll
        for (int r = 0; r < 16; ++r) acc[r] = 0.f;
#pragma unroll
        for (int kk = 0; kk < 8; ++kk) {
            const bf16x8 af = *(const LAS bf16x8*)(lds + SD_B + (hh & 1) * 16384 + (32 * pb + ql) * 256 + (((2 * kk + h) ^ (ql & 15)) << 4));
            const bf16x8 bf = *(const LAS bf16x8*)(lds + SD_C + (32 * lb + ql) * 256 + (((2 * kk + h) ^ (ql & 15)) << 4));
            acc = MFMA32(af, bf, acc); }
        const float al = acs[hh * 128 + 32 * lb + ql];
        { const float e = __expf(al);
#pragma unroll
          for (int r = 0; r < 16; ++r) acc[r] *= e; }
        const float Dh = A.d_skip[hd];
#pragma unroll
        for (int sb = 0; sb < 4; ++sb) {
            if (sb <= lb) {
                f32x16 Pm;
#pragma unroll
                for (int r = 0; r < 16; ++r) { const int sl = 32 * sb + AT_CROW(r, h), ll = 32 * lb + ql;
                    const float as = acs[hh * 128 + sl], ds = dtl[hh * 128 + sl];
                    float v = X[sb][r] * __expf(al - as) * ds; v = (sl <= ll) ? v : 0.f; v += (sl == ll) ? Dh : 0.f; Pm[r] = v; }
#pragma unroll
                for (int sp = 0; sp < 2; ++sp) { const bf16x8 pf = AT_PACK8(Pm, sp);
                    const bf16x8 af = tr_frag2(lds + SD_XS, 512, 32 * sb + 16 * sp + 4 * h, 32 * sb + 16 * sp + 8 + 4 * h, hh * 8 + 4 * pb + 2 * lb2, qq, pp);
                    acc = MFMA32(af, pf, acc); } }
        }
        { const bf16_t* zp = A.projb + ((size_t)b * S + c * 128 + 32 * lb + ql) * PROJ_LD + Z_OFF + hd * 64 + 32 * pb + 4 * h;
#pragma unroll
          for (int qd = 0; qd < 4; ++qd) { const u32x2 zz = *(const u32x2*)(zp + 8 * qd);
              const float z0 = __uint_as_float(zz.x << 16), z1 = __uint_as_float(zz.x & 0xffff0000u), z2 = __uint_as_float(zz.y << 16), z3 = __uint_as_float(zz.y & 0xffff0000u);
              acc[4 * qd] *= z0 / (1.f + __expf(-z0)); acc[4 * qd + 1] *= z1 / (1.f + __expf(-z1)); acc[4 * qd + 2] *= z2 / (1.f + __expf(-z2)); acc[4 * qd + 3] *= z3 / (1.f + __expf(-z3)); } }
        __syncthreads();
#pragma unroll
        for (int qd = 0; qd < 4; ++qd) { const int row = 32 * lb + ql, chn = hh * 8 + 4 * pb + qd;
            *(LAS u32x2*)(lds + SD_XS + row * 512 + ((chn ^ ((row & 3) << 2)) << 4) + 8 * h) = (u32x2){pk2(acc[4 * qd], acc[4 * qd + 1]), pk2(acc[4 * qd + 2], acc[4 * qd + 3])}; }
    }
    __syncthreads();
    int widn = wid; asm volatile("" : "+s"(widn));
#pragma unroll 1
    for (int i = 0; i < 16; ++i) { const int row = widn + 8 * i; const int chn = lane >> 1;
        const u32x2 v = *(const LAS u32x2*)(lds + SD_XS + row * 512 + ((chn ^ ((row & 3) << 2)) << 4) + 8 * (lane & 1));
        const float f0 = __uint_as_float(v.x << 16), f1 = __uint_as_float(v.x & 0xffff0000u), f2 = __uint_as_float(v.y << 16), f3 = __uint_as_float(v.y & 0xffff0000u);
        float sq = (f0 * f0 + f1 * f1) + (f2 * f2 + f3 * f3); sq = wsum(sq);
        const float rs = rsqrtf(sq * (1.f / 256.f) + 1e-6f);
        *(u32x2*)(A.catb + ((size_t)b * S + c * 128 + row) * 1024 + 512 + grp * 256 + lane * 4) = (u32x2){pk2(f0 * rs, f1 * rs), pk2(f2 * rs, f3 * rs)}; }
}
__global__ __launch_bounds__(512, 2) void k_ssd_a(SsdArgs A) {
    extern __shared__ __attribute__((aligned(16))) unsigned char dl[];
    for (int it = blockIdx.x; it < NB * NCH * 2; it += gridDim.x) ssd_a_item((LAS unsigned char*)dl, A, it);
}
__global__ __launch_bounds__(512, 2) void k_ssd_b(SsdArgs A) {
    extern __shared__ __attribute__((aligned(16))) unsigned char dl[];
    for (int it = blockIdx.x; it < NB * NCH * 2; it += gridDim.x) ssd_b_item((LAS unsigned char*)dl, A, it);
}
}
extern "C" void kernel_launch(void* const* d_in, const int* in_sizes, int n_in, void* d_out, int out_size, void* d_ws, size_t ws_size, hipStream_t stream) {
    using namespace nv;
    const float* x = (const float*)d_in[0]; const float* attn_norm = (const float*)d_in[1]; const float* w_in = (const float*)d_in[2];
    const float* rel_bias = (const float*)d_in[3]; const float* cmp_pos = (const float*)d_in[4]; const float* cmp_w1 = (const float*)d_in[5];
    const float* cmp_w2 = (const float*)d_in[6]; const float* attn_out_norm = (const float*)d_in[7]; const float* conv_w = (const float*)d_in[8];
    const float* conv_b = (const float*)d_in[9]; const float* dt_bias = (const float*)d_in[10]; const float* a_log = (const float*)d_in[11];
    const float* d_skip = (const float*)d_in[12]; const float* ssm_out_norm = (const float*)d_in[13]; const float* w_out = (const float*)d_in[14];
    const float* ffn_norm = (const float*)d_in[15]; const float* router_w = (const float*)d_in[16]; const float* router_b = (const float*)d_in[17];
    const float* w_gu = (const float*)d_in[18]; const float* b_gu = (const float*)d_in[19]; const float* w_dn = (const float*)d_in[20];
    const float* b_dn = (const float*)d_in[21]; const float* final_norm = (const float*)d_in[22];
    float* out = (float*)d_out;
    char* ws = (char*)d_ws; const size_t MB = 1u << 20;
    typedef mk::bf16_t bf;
    size_t o = 0; auto take = [&](size_t mb) { char* p = ws + o; o += mb * MB; return p; };
    int* cnt = (int*)take(1);
    bf* xb = (bf*)take(32); bf* WinT = (bf*)take(6); bf* WoutT = (bf*)take(2); bf* WguT = (bf*)take(128); bf* WdnT = (bf*)take(64);
    bf* projb = (bf*)take(96); bf* catb = (bf*)take(32); float* h1 = (float*)take(64); float* hn = (float*)take(64); bf* hnb = (bf*)take(32);
    float* rlog = (float*)take(2); int* list = (int*)take(2); float* wlist = (float*)take(2); int* tinfo = (int*)take(1);
    bf* kcb = (bf*)take(1); bf* vcb = (bf*)take(1); bf* states = (bf*)take(16); float* alast = (float*)take(1); float* hid = (float*)take(2); float* kvc = (float*)take(2); float* dtv = (float*)take(1);
    char* E = take(0);
    float* proj = (float*)(E); float* convx = (float*)(E + 180 * MB); float* o_nsa = (float*)(E + 244 * MB); float* yssd = (float*)(E + 276 * MB);
    bf* act = (bf*)(E); bf* ymoe = (bf*)(E + 144 * MB);
    (void)hipMemsetAsync(cnt, 0, 256, stream);
    static bool attr = false;
    if (!attr) { attr = true;
        (void)hipFuncSetAttribute((const void*)mk::k_proj, hipFuncAttributeMaxDynamicSharedMemorySize, mk::LDS_BYTES);
        (void)hipFuncSetAttribute((const void*)mk::k_outp, hipFuncAttributeMaxDynamicSharedMemorySize, mk::LDS_BYTES);
        (void)hipFuncSetAttribute((const void*)mk::k_moe1, hipFuncAttributeMaxDynamicSharedMemorySize, mk::LDS_BYTES);
        (void)hipFuncSetAttribute((const void*)mk::k_attn, hipFuncAttributeMaxDynamicSharedMemorySize, mk::LDS_BYTES);
        (void)hipFuncSetAttribute((const void*)mk::k_ssd_a, hipFuncAttributeMaxDynamicSharedMemorySize, mk::LDS_BYTES);
        (void)hipFuncSetAttribute((const void*)mk::k_ssd_b, hipFuncAttributeMaxDynamicSharedMemorySize, mk::LDS_BYTES);
        (void)hipFuncSetAttribute((const void*)mk::k_moe2, hipFuncAttributeMaxDynamicSharedMemorySize, mk::LDS_BYTES); }
    mk::k_rms_bf16<<<1024, 256, 0, stream>>>(x, D, xb, D, 1, D, T);
    mk::k_wT<<<dim3(48, 16, 1), 256, 0, stream>>>(w_in, WinT, attn_norm, attn_norm, 1024, 1024, INC, 3072, 0, 512, 0.125f * mk::LOG2E);
    mk::k_wT<<<dim3(16, 16, 1), 256, 0, stream>>>(w_out, WoutT, attn_out_norm, ssm_out_norm, 512, 1024, 1024, 1024, 0, 0, 1.f);
    mk::k_wT<<<dim3(32, 16, 32), 256, 0, stream>>>(w_gu, WguT, ffn_norm, ffn_norm, 1024, 1024, 2048, 2048, 1, 0, 1.f);
    mk::k_wT<<<dim3(16, 16, 32), 256, 0, stream>>>(w_dn, WdnT, nullptr, nullptr, 0, 1024, 1024, 1024, 0, 0, 1.f);
    mk::k_proj<<<256, 512, mk::LDS_BYTES, stream>>>(xb, WinT, projb);
    mk::k_bf2f<<<2048, 256, 0, stream>>>(projb, 3072, proj, INC, INC, T);
    const int MC = NB * NCMP * 2;
    k_gemm<false><<<dim3(1, (MC + 63) / 64, 2), 256, 0, stream>>>(ACmp{proj, cmp_pos}, BCmp1{cmp_w1}, ECmp1{hid}, MConst{MC, 0}, 64, 2048);
    k_gemm<false><<<dim3(1, (MC + 63) / 64, 2), 256, 0, stream>>>(ACmp2{hid}, BCmp2{cmp_w2}, ECmp2{kvc}, MConst{MC, 0}, 64, 64);
    mk::k_kvc_bf16<<<(2 * NB * 2 * 128 * 64) / 256, 256, 0, stream>>>(kvc, kcb, vcb);
    mk::k_attn<<<256, 512, mk::LDS_BYTES, stream>>>(mk::AttnArgs{projb, kcb, vcb, catb}, rel_bias);
    { mk::SsdArgs SA{projb, conv_w, conv_b, dt_bias, a_log, d_skip, states, alast, catb};
      mk::k_ssd_a<<<256, 512, mk::LDS_BYTES, stream>>>(SA);
      mk::k_ssd_b<<<256, 512, mk::LDS_BYTES, stream>>>(SA); }
    mk::k_outp<<<256, 512, mk::LDS_BYTES, stream>>>(catb, WoutT, x, h1);
    k_rmsnorm<<<T, 256, 0, stream>>>(h1, D, ffn_norm, hn, D, 1, D);
    mk::k_rms_bf16<<<1024, 256, 0, stream>>>(h1, D, hnb, D, 1, D, T);
    k_gemm<false><<<dim3(1, T / 64, 1), 256, 0, stream>>>(ARow{hn, D, 0}, BRow{router_w, NE, 0}, EBias{router_b, rlog, NE, 0}, MConst{T, 0}, NE, D);
    mk::k_route2<<<T / 256, 256, 0, stream>>>(rlog, cnt, list, wlist, tinfo);
    mk::k_moe1<<<256, 512, mk::LDS_BYTES, stream>>>(hnb, WguT, b_gu, cnt, list, act);
    mk::k_moe2<<<256, 512, mk::LDS_BYTES, stream>>>(act, WdnT, b_dn, cnt, wlist, ymoe);
    mk::k_combine2<<<T, 256, 0, stream>>>(h1, ymoe, tinfo, cnt, final_norm, out);
}
```

```cpp
#include <hip/hip_runtime.h>
#include <stdint.h>
#include <string.h>
#include <math.h>
namespace mk {
#define LAS __attribute__((address_space(3)))
typedef unsigned short bf16_t;
typedef short bf16x8 __attribute__((ext_vector_type(8)));
typedef float f32x4 __attribute__((ext_vector_type(4)));
typedef unsigned u32x4 __attribute__((ext_vector_type(4)));
typedef unsigned u32x2 __attribute__((ext_vector_type(2)));
constexpr int NB = 8, S = 2048, D = 1024, T = NB * S, NE = 32;
constexpr int BM = 256, BK = 64, HALF = 128, HTB = HALF * BK * 2, STAGE_BYTES = 8 * HTB, NXCD = 8, WGM = 8;
constexpr int KD = 1024;
constexpr int NPROJ = 3072;
constexpr int MAXSLOT = 65536 + 32 * 256;
constexpr int LDS_MISC = 131072, LDS_TILE_E = LDS_MISC + 64, LDS_TILE_M = LDS_TILE_E + 1536, LDS_ROWTAB = LDS_MISC + 4096, LDS_BYTES = LDS_ROWTAB + 12 * 1024;

__host__ __device__ __forceinline__ int lds_byte(int r, int c) { const int st = (r >> 4) * 2 + (c >> 5), rr = r & 15, cc = c & 31, ob = rr * 64 + cc * 2; return st * 1024 + (ob ^ (((ob >> 9) & 1) << 5)); }
__host__ __device__ __forceinline__ void stage_rc(int b, int& R, int& C) { const int st = b / 1024, sb = b % 1024, swz = sb ^ (((sb >> 9) & 1) << 5); R = (st >> 1) * 16 + swz / 64; C = (st & 1) * 32 + (swz % 64) / 2; }
__host__ __device__ __forceinline__ int perm32(int rho) { const int n = rho >> 4, i = rho & 15; return 8 * (i >> 2) + 4 * n + (i & 3); }
__device__ __forceinline__ unsigned cvt_pk_bf16(float lo, float hi) { unsigned r; asm volatile("v_cvt_pk_bf16_f32 %0, %1, %2" : "=v"(r) : "v"(lo), "v"(hi)); return r; }
__device__ __forceinline__ int tid_fresh() { int t = threadIdx.x; asm volatile("" : "+v"(t)); return t; }
__device__ __forceinline__ float bf2f(bf16_t b) { return __uint_as_float(((unsigned)b) << 16); }

struct Unit { int pm, pn, e, mt; };
struct StaticOrder {
    int nM, nN, nwg, G, c;
    __device__ void init(int M, int N, int G_, int c_) { nM = M / BM; nN = N / BM; nwg = nM * nN; G = G_; c = c_; }
    __device__ bool next(int i, Unit& u) const {
        const long L = (long)i * G + c; if (L >= nwg) return false;
        int wgid = (int)L; { const int q = nwg / NXCD, r = nwg % NXCD, xcd = wgid % NXCD, off = wgid / NXCD; wgid = (xcd < r ? xcd * (q + 1) : r * (q + 1) + (xcd - r) * q) + off; }
        const int nig = WGM * nN, gid = wgid / nig, fm = gid * WGM, gsz = (nM - fm) < WGM ? (nM - fm) : WGM;
        u.pm = fm + ((wgid % nig) % gsz); u.pn = (wgid % nig) / gsz; u.e = 0; u.mt = 0; return true;
    }
};
struct MoeOrder {
    int nN, G, c, RT; const LAS int* tile_e; const LAS int* tile_m;
    __device__ bool next(int i, Unit& u) const { const int L = i * G + c; if (L >= RT * nN) return false; const int rt = L / nN; u.pm = rt; u.pn = L - rt * nN; u.e = tile_e[rt]; u.mt = tile_m[rt]; return true; }
};

struct ProbProj {
    static constexpr bool PERM = true;
    StaticOrder S; const bf16_t* A; const bf16_t* Bt; bf16_t* O;
    __device__ __forceinline__ bool next(int i, Unit& u) const { return S.next(i, u); }
    __device__ __forceinline__ const char* a_base(const Unit& u) const { return (const char*)A + (size_t)u.pm * (BM * KD * 2); }
    __device__ __forceinline__ const char* b_base(const Unit& u) const { return (const char*)Bt + (size_t)u.pn * (BM * KD * 2); }
    __device__ __forceinline__ void a_offs(int, const Unit&, unsigned (&v0)[2], unsigned (&v1)[2], const int (&R)[2], const int (&C)[2]) const {
#pragma unroll
        for (int i = 0; i < 2; ++i) { v0[i] = (unsigned)(R[i] * KD + C[i]) * 2u; v1[i] = v0[i] + (unsigned)(HALF * KD * 2); } }
    __device__ __forceinline__ void epi(const f32x4 (&acc)[2][2][4][2], const Unit& u, int wr, int wc, int fr, int fq) const {
        const int row0 = u.pm * BM + wr * 64 + fr, col0 = u.pn * BM + wc * 32 + 8 * fq;
#pragma unroll
        for (int ai = 0; ai < 2; ++ai)
#pragma unroll
            for (int m = 0; m < 4; ++m) { bf16_t* rowp = O + (size_t)(row0 + ai * HALF + m * 16) * NPROJ + col0;
#pragma unroll
                for (int bj = 0; bj < 2; ++bj) { const f32x4 v0 = acc[ai][bj][m][0], v1 = acc[ai][bj][m][1]; u32x4 w;
                    w.x = cvt_pk_bf16(v0[0], v0[1]); w.y = cvt_pk_bf16(v0[2], v0[3]); w.z = cvt_pk_bf16(v1[0], v1[1]); w.w = cvt_pk_bf16(v1[2], v1[3]);
                    *(u32x4*)(rowp + bj * HALF) = w; } }
    }
};
struct ProbOut {
    static constexpr bool PERM = false;
    StaticOrder S; const bf16_t* A; const bf16_t* Bt; const float* R0; float* O;
    __device__ __forceinline__ bool next(int i, Unit& u) const { return S.next(i, u); }
    __device__ __forceinline__ const char* a_base(const Unit& u) const { return (const char*)A + (size_t)u.pm * (BM * KD * 2); }
    __device__ __forceinline__ const char* b_base(const Unit& u) const { return (const char*)Bt + (size_t)u.pn * (BM * KD * 2); }
    __device__ __forceinline__ void a_offs(int, const Unit&, unsigned (&v0)[2], unsigned (&v1)[2], const int (&R)[2], const int (&C)[2]) const {
#pragma unroll
        for (int i = 0; i < 2; ++i) { v0[i] = (unsigned)(R[i] * KD + C[i]) * 2u; v1[i] = v0[i] + (unsigned)(HALF * KD * 2); } }
    __device__ __forceinline__ void epi(const f32x4 (&acc)[2][2][4][2], const Unit& u, int wr, int wc, int fr, int fq) const {
        const int row0 = u.pm * BM + wr * 64 + fr, col0 = u.pn * BM + wc * 32 + 4 * fq;
#pragma unroll
        for (int ai = 0; ai < 2; ++ai)
#pragma unroll
            for (int m = 0; m < 4; ++m) { const size_t off = (size_t)(row0 + ai * HALF + m * 16) * D + col0;
#pragma unroll
                for (int bj = 0; bj < 2; ++bj)
#pragma unroll
                    for (int n = 0; n < 2; ++n) { const f32x4 r = *(const f32x4*)(R0 + off + bj * HALF + n * 16); *(f32x4*)(O + off + bj * HALF + n * 16) = acc[ai][bj][m][n] + r; }
                asm volatile("" ::: "memory"); }
    }
};
struct ProbMoe1 {
    static constexpr bool PERM = true;
    MoeOrder S; const bf16_t* A; const bf16_t* Bt; const float* bias; bf16_t* O; const LAS unsigned* rowtab;
    __device__ __forceinline__ bool next(int i, Unit& u) const { return S.next(i, u); }
    __device__ __forceinline__ const char* a_base(const Unit&) const { return (const char*)A; }
    __device__ __forceinline__ const char* b_base(const Unit& u) const { return (const char*)Bt + ((size_t)u.e * 2048 + (size_t)u.pn * BM) * (KD * 2); }
    __device__ __forceinline__ void a_offs(int i, const Unit&, unsigned (&v0)[2], unsigned (&v1)[2], const int (&R)[2], const int (&C)[2]) const {
#pragma unroll
        for (int j = 0; j < 2; ++j) { v0[j] = rowtab[i * 256 + R[j]] + (unsigned)C[j] * 2u; v1[j] = rowtab[i * 256 + HALF + R[j]] + (unsigned)C[j] * 2u; } }
    __device__ __forceinline__ void epi(const f32x4 (&acc)[2][2][4][2], const Unit& u, int wr, int wc, int fr, int fq) const {
        const int row0 = u.pm * BM + wr * 64 + fr, jg0 = u.pn * HALF + wc * 32 + 8 * fq;
        f32x4 bg[2], bu[2];
#pragma unroll
        for (int n = 0; n < 2; ++n) { bg[n] = *(const f32x4*)(bias + u.e * 2048 + jg0 + 4 * n); bu[n] = *(const f32x4*)(bias + u.e * 2048 + 1024 + jg0 + 4 * n); }
#pragma unroll
        for (int ai = 0; ai < 2; ++ai)
#pragma unroll
            for (int m = 0; m < 4; ++m) { float o[8];
#pragma unroll
                for (int n = 0; n < 2; ++n) { const f32x4 g4 = acc[ai][0][m][n] + bg[n], u4 = acc[ai][1][m][n] + bu[n];
#pragma unroll
                    for (int j = 0; j < 4; ++j) { const float g = fminf(g4[j], 7.f), uu = fminf(fmaxf(u4[j], -7.f), 7.f);
                        const float sg = __builtin_amdgcn_rcpf(1.f + __builtin_amdgcn_exp2f(-1.702f * 1.4426950408889634f * g)); o[n * 4 + j] = (uu + 1.f) * g * sg; } }
                u32x4 w; w.x = cvt_pk_bf16(o[0], o[1]); w.y = cvt_pk_bf16(o[2], o[3]); w.z = cvt_pk_bf16(o[4], o[5]); w.w = cvt_pk_bf16(o[6], o[7]);
                *(u32x4*)(O + (size_t)(row0 + ai * HALF + m * 16) * 1024 + jg0) = w; }
    }
};
struct ProbMoe2 {
    static constexpr bool PERM = true;
    MoeOrder S; const bf16_t* A; const bf16_t* Bt; const float* bias; const float* wlist; bf16_t* O;
    __device__ __forceinline__ bool next(int i, Unit& u) const { return S.next(i, u); }
    __device__ __forceinline__ const char* a_base(const Unit& u) const { return (const char*)A + (size_t)u.pm * (BM * KD * 2); }
    __device__ __forceinline__ const char* b_base(const Unit& u) const { return (const char*)Bt + ((size_t)u.e * 1024 + (size_t)u.pn * BM) * (KD * 2); }
    __device__ __forceinline__ void a_offs(int, const Unit&, unsigned (&v0)[2], unsigned (&v1)[2], const int (&R)[2], const int (&C)[2]) const {
#pragma unroll
        for (int i = 0; i < 2; ++i) { v0[i] = (unsigned)(R[i] * KD + C[i]) * 2u; v1[i] = v0[i] + (unsigned)(HALF * KD * 2); } }
    __device__ __forceinline__ void epi(const f32x4 (&acc)[2][2][4][2], const Unit& u, int wr, int wc, int fr, int fq) const {
        const int rl0 = wr * 64 + fr, col0 = u.pn * BM + wc * 32 + 8 * fq;
        f32x4 bv[2][2];
#pragma unroll
        for (int bj = 0; bj < 2; ++bj)
#pragma unroll
            for (int n = 0; n < 2; ++n) bv[bj][n] = *(const f32x4*)(bias + u.e * 1024 + col0 + bj * HALF + 4 * n);
#pragma unroll
        for (int ai = 0; ai < 2; ++ai)
#pragma unroll
            for (int m = 0; m < 4; ++m) { const int rl = rl0 + ai * HALF + m * 16; const float wt = wlist[(size_t)u.e * T + u.mt * BM + rl];
                bf16_t* rowp = O + (size_t)(u.pm * BM + rl) * 1024 + col0;
#pragma unroll
                for (int bj = 0; bj < 2; ++bj) { const f32x4 v0 = (acc[ai][bj][m][0] + bv[bj][0]) * wt, v1 = (acc[ai][bj][m][1] + bv[bj][1]) * wt; u32x4 w;
                    w.x = cvt_pk_bf16(v0[0], v0[1]); w.y = cvt_pk_bf16(v0[2], v0[3]); w.z = cvt_pk_bf16(v1[0], v1[1]); w.w = cvt_pk_bf16(v1[2], v1[3]);
                    *(u32x4*)(rowp + bj * HALF) = w; } }
    }
};

template <class P>
__device__ __forceinline__ void gemm_phase(LAS unsigned char* lds, const P& Pb) {
    const int tid = tid_fresh(), wid = __builtin_amdgcn_readfirstlane(tid >> 6), lane = tid & 63, wr = wid >> 2, wc = wid & 3, fr = lane & 15, fq = lane >> 4;
    constexpr int nt = KD / BK;
    int Rr[2], Cc[2]; unsigned voffB[2];
#pragma unroll
    for (int i = 0; i < 2; ++i) { int R, C; stage_rc(tid * 16 + i * 8192, R, C); const int Rb = P::PERM ? ((R & ~31) + perm32(R & 31)) : R; Rr[i] = R; Cc[i] = C; voffB[i] = (unsigned)(Rb * KD + C) * 2u; }
    constexpr size_t kstep = (size_t)(BK * 2);
    constexpr size_t hstep = (size_t)HALF * KD * 2;
    const unsigned ldsw = (unsigned)wid * 1024u;
    const int aoff = lds_byte(wr * 64 + fr, fq * 8), boff = lds_byte(wc * 32 + fr, fq * 8);
#define PG8_SA(b, h) (((b) * 2 + (h)) * HTB)
#define PG8_SB(b, h) ((4 + (b) * 2 + (h)) * HTB)
#define PG8_STAGE(bufoff, gbase, voff) do { _Pragma("unroll") for (int _i = 0; _i < 2; ++_i) \
        __builtin_amdgcn_global_load_lds((const unsigned*)((const char*)(gbase) + (voff)[_i]), (LAS unsigned*)(lds + (bufoff) + ldsw + _i * 8192), 16, 0, 0); } while (0)
#define PG8_LDA(dst, b, h) do { _Pragma("unroll") for (int m = 0; m < 4; ++m) _Pragma("unroll") for (int k = 0; k < 2; ++k) dst[m][k] = *(const LAS bf16x8*)(lds + PG8_SA(b, h) + aoff + m * 2048 + k * 1024); } while (0)
#define PG8_LDB(dst, b, h) do { _Pragma("unroll") for (int n = 0; n < 2; ++n) _Pragma("unroll") for (int k = 0; k < 2; ++k) dst[n][k] = *(const LAS bf16x8*)(lds + PG8_SB(b, h) + boff + n * 2048 + k * 1024); } while (0)
#define PG8_MMA(ai, bj, At, Bt) do { __builtin_amdgcn_s_setprio(1); _Pragma("unroll") for (int m = 0; m < 4; ++m) _Pragma("unroll") for (int n = 0; n < 2; ++n) _Pragma("unroll") for (int k = 0; k < 2; ++k) \
        acc[ai][bj][m][n] = __builtin_amdgcn_mfma_f32_16x16x32_bf16(Bt[n][k], At[m][k], acc[ai][bj][m][n], 0, 0, 0); __builtin_amdgcn_s_setprio(0); } while (0)
#define PG8_WAIT_V(n) asm volatile("s_waitcnt vmcnt(" #n ")" ::: "memory")
#define PG8_WAIT_L(n) asm volatile("s_waitcnt lgkmcnt(" #n ")" ::: "memory")
#define PG8_BAR __builtin_amdgcn_s_barrier()
#define PG8_SCHED __builtin_amdgcn_sched_barrier(0)
    Unit cur, nxt; int ui = 0;
    if (!Pb.next(0, cur)) return;
    f32x4 acc[2][2][4][2];
#pragma unroll
    for (int a = 0; a < 2; ++a)
#pragma unroll
        for (int b = 0; b < 2; ++b)
#pragma unroll
            for (int m = 0; m < 4; ++m)
#pragma unroll
                for (int n = 0; n < 2; ++n) acc[a][b][m][n] = (f32x4){0.f, 0.f, 0.f, 0.f};
    bf16x8 At[4][2], B0[2][2], B1[2][2];
    unsigned vA0[2], vA1[2];
    Pb.a_offs(0, cur, vA0, vA1, Rr, Cc);
    const char* cA = Pb.a_base(cur); const char* cB = Pb.b_base(cur);
    PG8_STAGE(PG8_SB(0, 0), cB, voffB); PG8_STAGE(PG8_SB(0, 1), cB + hstep, voffB); PG8_STAGE(PG8_SA(0, 0), cA, vA0); PG8_STAGE(PG8_SA(0, 1), cA, vA1);
    if (wr == 1) PG8_BAR;
    PG8_WAIT_V(2); PG8_BAR;
    PG8_STAGE(PG8_SB(1, 0), cB + kstep, voffB); PG8_STAGE(PG8_SA(1, 0), cA + kstep, vA0); PG8_STAGE(PG8_SB(1, 1), cB + hstep + kstep, voffB);
    PG8_WAIT_V(6); PG8_BAR;
    for (;;) {
        const bool has_next = Pb.next(ui + 1, nxt);
        const char* nA = has_next ? Pb.a_base(nxt) : cA; const char* nB = has_next ? Pb.b_base(nxt) : cB;
        for (int t = 0; t < nt; t += 2) {
            const bool last = (t == nt - 2);
            const char* a1 = cA + (size_t)(t + 1) * kstep;
            const char* a2 = last ? nA : cA + (size_t)(t + 2) * kstep; const char* b2 = last ? nB : cB + (size_t)(t + 2) * kstep;
            const char* a3 = a2 + kstep; const char* b3 = b2 + kstep;
            PG8_LDB(B0, 0, 0); PG8_LDB(B1, 0, 1); PG8_SCHED; PG8_LDA(At, 0, 0); PG8_STAGE(PG8_SA(1, 1), a1, vA1);
            PG8_WAIT_V(8); PG8_WAIT_L(0); PG8_BAR; PG8_MMA(0, 0, At, B0); PG8_MMA(0, 1, At, B1); PG8_BAR; PG8_SCHED;
            if (last && has_next) Pb.a_offs(ui + 1, nxt, vA0, vA1, Rr, Cc);
            PG8_LDA(At, 0, 1); PG8_STAGE(PG8_SB(0, 0), b2, voffB); PG8_STAGE(PG8_SB(0, 1), b2 + hstep, voffB); PG8_STAGE(PG8_SA(0, 0), a2, vA0);
            PG8_WAIT_V(8); PG8_WAIT_L(0); PG8_BAR; PG8_MMA(1, 0, At, B0); PG8_MMA(1, 1, At, B1); PG8_BAR; PG8_SCHED;
            PG8_LDB(B0, 1, 0); PG8_LDB(B1, 1, 1); PG8_SCHED; PG8_LDA(At, 1, 0); PG8_STAGE(PG8_SA(0, 1), a2, vA1);
            PG8_WAIT_V(8); PG8_WAIT_L(0); PG8_BAR; PG8_MMA(0, 0, At, B0); PG8_MMA(0, 1, At, B1); PG8_BAR; PG8_SCHED;
            PG8_LDA(At, 1, 1); PG8_STAGE(PG8_SB(1, 0), b3, voffB); PG8_STAGE(PG8_SB(1, 1), b3 + hstep, voffB); PG8_STAGE(PG8_SA(1, 0), a3, vA0);
            PG8_WAIT_V(8); PG8_WAIT_L(0); PG8_BAR; PG8_MMA(1, 0, At, B0); PG8_MMA(1, 1, At, B1); PG8_BAR; PG8_SCHED;
        }
        if (wr == 0) PG8_BAR;
        Pb.epi(acc, cur, wr, wc, fr, fq);
        if (!has_next) break;
#pragma unroll
        for (int a = 0; a < 2; ++a)
#pragma unroll
            for (int b = 0; b < 2; ++b)
#pragma unroll
                for (int m = 0; m < 4; ++m)
#pragma unroll
                    for (int n = 0; n < 2; ++n) acc[a][b][m][n] = (f32x4){0.f, 0.f, 0.f, 0.f};
        cur = nxt; cA = nA; cB = nB; ++ui;
        if (wr == 1) PG8_BAR;
    }
    PG8_WAIT_V(0);
    PG8_BAR;
#undef PG8_SA
#undef PG8_SB
#undef PG8_STAGE
#undef PG8_LDA
#undef PG8_LDB
#undef PG8_MMA
#undef PG8_WAIT_V
#undef PG8_WAIT_L
#undef PG8_BAR
#undef PG8_SCHED
}

__device__ __forceinline__ int moe_tables(LAS unsigned char* lds, const int* cnt) {
    LAS int* tile_e = (LAS int*)(lds + LDS_TILE_E); LAS int* tile_m = (LAS int*)(lds + LDS_TILE_M); LAS int* rts = (LAS int*)(lds + LDS_MISC + 32);
    if (tid_fresh() == 0) { int a = 0; for (int e = 0; e < NE; ++e) { const int n = (cnt[e] + 255) >> 8; for (int m = 0; m < n; ++m) { tile_e[a] = e; tile_m[a] = m; ++a; } } rts[0] = a; }
    __syncthreads();
    return rts[0];
}
}
namespace mk {
__device__ __forceinline__ float wsum(float v) {
#pragma unroll
    for (int o = 1; o < 64; o <<= 1) v += __shfl_xor(v, o);
    return v; }
__device__ __forceinline__ unsigned short f2bf(float f) { unsigned u = __float_as_uint(f); u += 0x7FFFu + ((u >> 16) & 1u); return (unsigned short)(u >> 16); }
}
namespace mk {
typedef float f32x16 __attribute__((ext_vector_type(16)));
typedef short s16x4 __attribute__((ext_vector_type(4)));
typedef __bf16 bf2_t __attribute__((ext_vector_type(2)));
typedef float f2_t __attribute__((ext_vector_type(2)));
#define MFMA32(a, b, c) __builtin_amdgcn_mfma_f32_32x32x16_bf16((a), (b), (c), 0, 0, 0)
constexpr float LOG2E = 1.4426950408889634f;
constexpr int PROJ_LD = NPROJ;
constexpr int AT_KBUF = 0, AT_VBUF = 16384, AT_IMPW = 32768, AT_SCORE = 65536, AT_OBUF = 73728, AT_OSTR = 1040, AT_BTAB = AT_OBUF + 64 * AT_OSTR  ,
              AT_SEL = AT_BTAB + 8 * 132 * 4  , AT_SSQ = AT_SEL + 512  , AT_END = AT_SSQ + 8 * 64 * 4  ;
struct AttnArgs { const bf16_t* projb; const bf16_t* kc; const bf16_t* vc; bf16_t* catb; };

__device__ __forceinline__ unsigned pk2(float a, float b) { f2_t v = {a, b}; return __builtin_bit_cast(unsigned, __builtin_convertvector(v, bf2_t)); }
__device__ __forceinline__ int t5_bucket(int n) { if (n < 0) n = 0; if (n < 16) return n; const float nf = (float)n; const int l = 16 + (int)(logf(nf / 16.f) / 2.0794415416798357f * 16.f); return l < 31 ? l : 31; }
__device__ __forceinline__ void stage_tile(LAS unsigned char* dst, const char* src, size_t row_stride, int wid, int lane, bool vswz) {
    const int row = 8 * wid + (lane >> 3), slot = lane & 7;
    const int f = vswz ? (((row >> 1) & 1) << 2) : ((row >> 1) & 7);
    __builtin_amdgcn_global_load_lds((const unsigned*)(src + (size_t)row * row_stride + ((slot ^ f) << 4)), (LAS unsigned*)(dst + wid * 1024), 16, 0, 0);
}
#define AT_CROW(r, h) (((r) & 3) + 8 * ((r) >> 2) + 4 * (h))
#define AT_PACK8(x, s) __builtin_bit_cast(bf16x8, (u32x4){pk2((x)[8 * (s)], (x)[8 * (s) + 1]), pk2((x)[8 * (s) + 2], (x)[8 * (s) + 3]), pk2((x)[8 * (s) + 4], (x)[8 * (s) + 5]), pk2((x)[8 * (s) + 6], (x)[8 * (s) + 7])})
__device__ __forceinline__ bf16x8 vt_frag(const LAS unsigned char* vt, unsigned vaddr, int rowoff) {
    const s16x4 lo = __builtin_amdgcn_ds_read_tr16_b64_v4i16((LAS s16x4*)(vt + vaddr + rowoff * 128));
    const s16x4 hi = __builtin_amdgcn_ds_read_tr16_b64_v4i16((LAS s16x4*)(vt + vaddr + (rowoff + 8) * 128));
    return __builtin_shufflevector(lo, hi, 0, 1, 2, 3, 4, 5, 6, 7);
}
template <bool FIRST>
__device__ __forceinline__ void obuf_acc(LAS unsigned char* lds, int tl, int hd, int h, float sc, const f32x16 (&oc)[2]) {
#pragma unroll
    for (int c = 0; c < 2; ++c)
#pragma unroll
        for (int qd = 0; qd < 4; ++qd) { LAS u32x2* p = (LAS u32x2*)(lds + AT_OBUF + tl * AT_OSTR + (hd * 64 + 32 * c + 8 * qd + 4 * h) * 2);
            float a0 = sc * oc[c][4 * qd], a1 = sc * oc[c][4 * qd + 1], a2 = sc * oc[c][4 * qd + 2], a3 = sc * oc[c][4 * qd + 3];
            if (!FIRST) { const u32x2 o = *p; a0 += __uint_as_float(o.x << 16); a1 += __uint_as_float(o.x & 0xffff0000u); a2 += __uint_as_float(o.y << 16); a3 += __uint_as_float(o.y & 0xffff0000u); }
            *p = (u32x2){pk2(a0, a1), pk2(a2, a3)}; }
}
template <int MODE>
__device__ __forceinline__ void attn_tile(const LAS unsigned char* Kt, const LAS unsigned char* Vt, int kbase, int tq, int t0, bool selbit, const bf16x8 (&qf)[4], const LAS float* bt, float cfar,
                                          f32x16 (&O)[2], float& m, float& l, int ql, int h, const unsigned (&vaddr)[2]) {
    f32x16 s0, s1;
#pragma unroll
    for (int r = 0; r < 16; ++r) { s0[r] = 0.f; s1[r] = 0.f; }
    const int fk = (ql >> 1) & 7;
#pragma unroll
    for (int s = 0; s < 4; ++s) { const int ch = ((2 * s + h) ^ fk) << 4;
        const bf16x8 k0 = *(const LAS bf16x8*)(Kt + ql * 128 + ch), k1 = *(const LAS bf16x8*)(Kt + (32 + ql) * 128 + ch);
        s0 = MFMA32(k0, qf[s], s0); s1 = MFMA32(k1, qf[s], s1); }
    const bool far = (kbase + 191 <= t0);
    float mx = -INFINITY;
#pragma unroll
    for (int r = 0; r < 16; ++r) {
        const int key0 = kbase + AT_CROW(r, h), key1 = key0 + 32;
        const int d0 = tq - key0, d1 = tq - key1;
        bool v0, v1;
        if (MODE == 0) { v0 = selbit && d0 >= 0; v1 = selbit && d1 >= 0; } else { v0 = d0 >= 0 && d0 < 512; v1 = d1 >= 0 && d1 < 512; }
        float b0, b1;
        if (far) { b0 = cfar; b1 = cfar; } else { b0 = bt[min(max(d0, 0), 128)]; b1 = bt[min(max(d1, 0), 128)]; }
        const float x0 = v0 ? s0[r] + b0 : -INFINITY, x1 = v1 ? s1[r] + b1 : -INFINITY;
        s0[r] = x0; s1[r] = x1; mx = fmaxf(mx, fmaxf(x0, x1));
    }
    mx = fmaxf(mx, __shfl_xor(mx, 32));
    const float mn = fmaxf(m, mx);
    const float alpha = __builtin_amdgcn_exp2f(m - mn);
    float ps = 0.f;
#pragma unroll
    for (int r = 0; r < 16; ++r) { const float p0 = __builtin_amdgcn_exp2f(s0[r] - mn), p1 = __builtin_amdgcn_exp2f(s1[r] - mn); s0[r] = p0; s1[r] = p1; ps += p0 + p1; }
    l = l * alpha + ps; m = mn;
    if (__any(alpha != 1.f)) {
#pragma unroll
        for (int r = 0; r < 16; ++r) { O[0][r] *= alpha; O[1][r] *= alpha; } }
#pragma unroll
    for (int sp = 0; sp < 2; ++sp) {
        const bf16x8 p0 = AT_PACK8(s0, sp), p1 = AT_PACK8(s1, sp);
#pragma unroll
        for (int c = 0; c < 2; ++c) { O[c] = MFMA32(vt_frag(Vt, vaddr[c], 16 * sp), p0, O[c]); O[c] = MFMA32(vt_frag(Vt, vaddr[c], 32 + 16 * sp), p1, O[c]); }
    }
}

__device__ __forceinline__ void attn_item(LAS unsigned char* lds, const AttnArgs& A, int b, int qt) {
    const int tid = tid_fresh(), wid = __builtin_amdgcn_readfirstlane(tid >> 6), lane = tid & 63;
    const int g = wid >> 1, th = wid & 1, ql = lane & 31, h = lane >> 5;
    const int t0 = qt * 64, tl = th * 32 + ql, tq = t0 + tl, blk = qt;
    const size_t rowq = (size_t)b * S + tq;
    const int qq = (lane & 15) >> 2, pp = lane & 3, lb = (lane >> 4) & 1;
    unsigned vaddr[2];
#pragma unroll
    for (int c = 0; c < 2; ++c) vaddr[c] = (unsigned)((4 * h + qq) * 128 + (((4 * (c ^ ((qq >> 1) & 1))) + 2 * lb + (pp >> 1)) << 4) + 8 * (pp & 1));
    LAS float* impw = (LAS float*)(lds + AT_IMPW); LAS float* score = (LAS float*)(lds + AT_SCORE); LAS unsigned* selm = (LAS unsigned*)(lds + AT_SEL);
    const char* prow0 = (const char*)(A.projb + (size_t)b * S * PROJ_LD);
    const size_t RS = (size_t)PROJ_LD * 2;
    for (int kvh = 0; kvh < 2; ++kvh) {
        const int hd = kvh * 4 + g;
        const LAS float* bt = (const LAS float*)(lds + AT_BTAB) + hd * 132;
        const float cfar = bt[128];
        bf16x8 qf[4];
#pragma unroll
        for (int s = 0; s < 4; ++s) qf[s] = *(const bf16x8*)(A.projb + rowq * PROJ_LD + hd * 64 + 16 * s + 8 * h);
        float gate[3];
#pragma unroll
        for (int j = 0; j < 3; ++j) { const float gv = bf2f(A.projb[rowq * PROJ_LD + 1280 + j * 8 + hd]); gate[j] = 1.f / (1.f + __expf(-gv)); }
        __syncthreads();
        { const char* kcb = (const char*)(A.kc + (size_t)(b * 2 + kvh) * 128 * 64); const char* vcb = (const char*)(A.vc + (size_t)(b * 2 + kvh) * 128 * 64);
          stage_tile(lds + AT_KBUF, kcb, 128, wid, lane, false); stage_tile(lds + AT_KBUF + 8192, kcb + 64 * 128, 128, wid, lane, false);
          stage_tile(lds + AT_VBUF, vcb, 128, wid, lane, true); stage_tile(lds + AT_VBUF + 8192, vcb + 64 * 128, 128, wid, lane, true); }
        asm volatile("s_waitcnt vmcnt(0)" ::: "memory"); __syncthreads();
        {
            f32x16 sc[4]; const int fk = (ql >> 1) & 7; int tqc = tq; asm volatile("" : "+v"(tqc));
#pragma unroll
            for (int kb = 0; kb < 4; ++kb) {
#pragma unroll
                for (int r = 0; r < 16; ++r) sc[kb][r] = 0.f;
#pragma unroll
                for (int s = 0; s < 4; ++s) { const bf16x8 kf = *(const LAS bf16x8*)(lds + AT_KBUF + (32 * kb + ql) * 128 + (((2 * s + h) ^ fk) << 4)); sc[kb] = MFMA32(kf, qf[s], sc[kb]); }
                __builtin_amdgcn_sched_barrier(0); }
            float mx = -INFINITY;
#pragma unroll
            for (int kb = 0; kb < 4; ++kb)
#pragma unroll
                for (int r = 0; r < 16; ++r) { const int c = 32 * kb + AT_CROW(r, h); const int dist = tqc - 16 * c - 31; const float bv = bt[min(max(dist, 0), 128)]; const float x = (dist >= 0) ? sc[kb][r] + bv : -INFINITY; sc[kb][r] = x; mx = fmaxf(mx, x);
                    if ((r & 7) == 7) __builtin_amdgcn_sched_barrier(0); }
            mx = fmaxf(mx, __shfl_xor(mx, 32));
            const float mref = (mx == -INFINITY) ? 0.f : mx;
            float ls = 0.f;
#pragma unroll
            for (int kb = 0; kb < 4; ++kb)
#pragma unroll
                for (int r = 0; r < 16; ++r) { const float p = __builtin_amdgcn_exp2f(sc[kb][r] - mref); sc[kb][r] = p; ls += p; }
            ls += __shfl_xor(ls, 32);
            const float inv = 1.f / fmaxf(ls, 1e-30f);
#pragma unroll
            for (int kb = 0; kb < 4; ++kb)
#pragma unroll
                for (int r = 0; r < 16; ++r) sc[kb][r] *= inv;
            { float carry = 0.f;
#pragma unroll
              for (int i = 0; i < 16; ++i) { const int kb = i >> 2, qd = i & 3;
                  const float s4 = (sc[kb][4 * qd] + sc[kb][4 * qd + 1]) + (sc[kb][4 * qd + 2] + sc[kb][4 * qd + 3]);
                  const float rv = __shfl_xor(sc[kb][4 * qd + 3], 32);
                  impw[(wid * 32 + ql) * 32 + 2 * i + h] = s4 + (h ? rv : carry); carry = rv; } }
            f32x16 oc[2];
#pragma unroll
            for (int r = 0; r < 16; ++r) { oc[0][r] = 0.f; oc[1][r] = 0.f; }
#pragma unroll
            for (int kb = 0; kb < 4; ++kb)
#pragma unroll
                for (int sp = 0; sp < 2; ++sp) { const bf16x8 pf = AT_PACK8(sc[kb], sp);
#pragma unroll
                    for (int c = 0; c < 2; ++c) oc[c] = MFMA32(vt_frag(lds + AT_VBUF, vaddr[c], 32 * kb + 16 * sp), pf, oc[c]);
                    __builtin_amdgcn_sched_barrier(0); }
            obuf_acc<true>(lds, tl, hd, h, gate[0], oc);
        }
        __syncthreads();
        int tids = tid; asm volatile("" : "+v"(tids));
#pragma unroll
        for (int i = 0; i < 4; ++i) { const int id = tids + 512 * i, tk = id >> 5, n = id & 31, w0 = tk >> 5, q = tk & 31;
            float v = 0.f;
#pragma unroll
            for (int gg = 0; gg < 4; ++gg) v += impw[((2 * gg + w0) * 32 + q) * 32 + n];
            const bool forced = (n == 0) || (n == blk) || (n == blk - 1);
            score[tk * 32 + n] = forced ? 1e4f : ((n <= blk) ? v : -1.f); }
        __syncthreads();
#pragma unroll
        for (int i = 0; i < 4; ++i) { const int id = tids + 512 * i, tk = id >> 5, n = id & 31;
            const float sn = score[tk * 32 + n]; int rank = 0;
            for (int mm = 0; mm < 32; ++mm) { const float s2 = score[tk * 32 + mm]; rank += (s2 > sn || (s2 == sn && mm < n)) ? 1 : 0; }
            const bool sel = (rank < 16) && (n <= blk);
            const unsigned long long bal = __ballot(sel);
            if (n == 0) selm[tk] = (unsigned)(bal >> (32 * (lane >> 5))); }
        __syncthreads();
        unsigned U = selm[lane];
#pragma unroll
        for (int o = 1; o < 64; o <<= 1) U |= (unsigned)__shfl_xor((int)U, o);
        U = (unsigned)__builtin_amdgcn_readfirstlane((int)U);
        const unsigned mysel = selm[tl];
        {
            f32x16 oc[2];
#pragma unroll
            for (int r = 0; r < 16; ++r) { oc[0][r] = 0.f; oc[1][r] = 0.f; }
            float m = -1e30f, l = 0.f;
            const char* kcol = prow0 + (512 + 2 * 128 + kvh * 64) * 2; const char* vcol = prow0 + (512 + 3 * 128 + kvh * 64) * 2;
            int n = __builtin_ctz(U | 0x80000000u), buf = 0;
            stage_tile(lds + AT_KBUF, kcol + (size_t)n * 64 * RS, RS, wid, lane, false); stage_tile(lds + AT_VBUF, vcol + (size_t)n * 64 * RS, RS, wid, lane, true);
            for (;;) {
                asm volatile("s_waitcnt vmcnt(0)" ::: "memory"); __syncthreads();
                const unsigned rest = (n >= 31) ? 0u : (U & ~((2u << n) - 1u));
                const int nn = rest ? __builtin_ctz(rest) : -1;
                if (nn >= 0) { stage_tile(lds + AT_KBUF + (buf ^ 1) * 8192, kcol + (size_t)nn * 64 * RS, RS, wid, lane, false); stage_tile(lds + AT_VBUF + (buf ^ 1) * 8192, vcol + (size_t)nn * 64 * RS, RS, wid, lane, true); }
                attn_tile<0>(lds + AT_KBUF + buf * 8192, lds + AT_VBUF + buf * 8192, n * 64, tq, t0, ((mysel >> n) & 1u) != 0u, qf, bt, cfar, oc, m, l, ql, h, vaddr);
                if (nn < 0) break;
                n = nn; buf ^= 1;
            }
            l += __shfl_xor(l, 32);
            const float sc1 = gate[1] / fmaxf(l, 1e-30f);
            obuf_acc<false>(lds, tl, hd, h, sc1, oc);
        }
        {
            f32x16 oc[2];
#pragma unroll
            for (int r = 0; r < 16; ++r) { oc[0][r] = 0.f; oc[1][r] = 0.f; }
            float m = -1e30f, l = 0.f;
            const char* kcol = prow0 + (512 + 4 * 128 + kvh * 64) * 2; const char* vcol = prow0 + (512 + 5 * 128 + kvh * 64) * 2;
            int n = (blk >= 8) ? blk - 8 : 0, buf = 0;
            __syncthreads();
            stage_tile(lds + AT_KBUF, kcol + (size_t)n * 64 * RS, RS, wid, lane, false); stage_tile(lds + AT_VBUF, vcol + (size_t)n * 64 * RS, RS, wid, lane, true);
            for (;;) {
                asm volatile("s_waitcnt vmcnt(0)" ::: "memory"); __syncthreads();
                const int nn = (n < blk) ? n + 1 : -1;
                if (nn >= 0) { stage_tile(lds + AT_KBUF + (buf ^ 1) * 8192, kcol + (size_t)nn * 64 * RS, RS, wid, lane, false); stage_tile(lds + AT_VBUF + (buf ^ 1) * 8192, vcol + (size_t)nn * 64 * RS, RS, wid, lane, true); }
                attn_tile<1>(lds + AT_KBUF + buf * 8192, lds + AT_VBUF + buf * 8192, n * 64, tq, t0, true, qf, bt, cfar, oc, m, l, ql, h, vaddr);
                if (nn < 0) break;
                n = nn; buf ^= 1;
            }
            l += __shfl_xor(l, 32);
            const float sc2 = gate[2] / fmaxf(l, 1e-30f);
            obuf_acc<false>(lds, tl, hd, h, sc2, oc);
        }
    }
    __syncthreads();
    int widn = wid; asm volatile("" : "+s"(widn));
#pragma unroll 1
    for (int i = 0; i < 8; ++i) { const int row = widn + 8 * i;
        const u32x4 v = *(const LAS u32x4*)(lds + AT_OBUF + row * AT_OSTR + lane * 16);
        float f[8]; f[0] = __uint_as_float(v.x << 16); f[1] = __uint_as_float(v.x & 0xffff0000u); f[2] = __uint_as_float(v.y << 16); f[3] = __uint_as_float(v.y & 0xffff0000u);
        f[4] = __uint_as_float(v.z << 16); f[5] = __uint_as_float(v.z & 0xffff0000u); f[6] = __uint_as_float(v.w << 16); f[7] = __uint_as_float(v.w & 0xffff0000u);
        float sq = 0.f;
#pragma unroll
        for (int j = 0; j < 8; ++j) sq += f[j] * f[j];
        sq = wsum(sq);
        const float rs = rsqrtf(sq * (1.f / 512.f) + 1e-6f);
        u32x4 w; w.x = pk2(f[0] * rs, f[1] * rs); w.y = pk2(f[2] * rs, f[3] * rs); w.z = pk2(f[4] * rs, f[5] * rs); w.w = pk2(f[6] * rs, f[7] * rs);
        *(u32x4*)(A.catb + ((size_t)b * S + t0 + row) * 1024 + lane * 8) = w; }
    __syncthreads();
}
__device__ __forceinline__ void attn_btab(LAS unsigned char* lds, const float* rel_bias) {
    LAS float* bt = (LAS float*)(lds + AT_BTAB);
    for (int i = threadIdx.x; i < 8 * 129; i += 512) { const int hd = i / 129, d = i % 129; bt[hd * 132 + d] = rel_bias[t5_bucket(d) * 8 + hd] * LOG2E; }
    __syncthreads();
}
__global__ __launch_bounds__(512, 2) void k_attn(AttnArgs A, const float* rel_bias) {
    extern __shared__ __attribute__((aligned(16))) unsigned char dl[];
    LAS unsigned char* lds = (LAS unsigned char*)dl;
    attn_btab(lds, rel_bias);
    for (int it = blockIdx.x; it < NB * 32; it += gridDim.x) attn_item(lds, A, it & 7, 31 - (it >> 3));
}
__global__ __launch_bounds__(256) void k_kvc_bf16(const float* kvc, bf16_t* kc, bf16_t* vc) {
    const int i = blockIdx.x * 256 + threadIdx.x; if (i >= 2 * NB * 2 * 128 * 64) return;
    const int d = i & 63, c = (i >> 6) & 127, kvh = (i >> 13) & 1, b = (i >> 14) & 7, z = i >> 17;
    const float v = (c < 127) ? kvc[((size_t)z * (NB * 127 * 2) + (size_t)(b * 127 + c) * 2 + kvh) * 64 + d] : 0.f;
    (z ? vc : kc)[((size_t)(b * 2 + kvh) * 128 + c) * 64 + d] = f2bf(v);
}
}
namespace mk {
constexpr int XBC_OFF = 1816, Z_OFF = 1304, DT_OFF = 2840, NCH = 16;
constexpr int SD_XS = 0, SD_B = 65536, SD_C = 98304, SD_ACS = 131072, SD_DT = SD_ACS + 2048, SD_W = SD_DT + 2048, SD_WP = SD_W + 2048  , SD_END = SD_WP + 256;
struct SsdArgs { const bf16_t* projb; const float* conv_w; const float* conv_b; const float* dt_bias; const float* a_log; const float* d_skip; bf16_t* states; float* alast; bf16_t* catb; };

__device__ __forceinline__ void ssd_dt_acs(LAS unsigned char* lds, const SsdArgs& A, int b, int c, int grp, int wid, int lane) {
    if (wid < 4) { const int hd = grp * 4 + wid; const float Ah = -__expf(A.a_log[hd]), db = A.dt_bias[hd];
        const size_t row = (size_t)b * S + c * 128 + 2 * lane;
        float x0 = bf2f(A.projb[row * PROJ_LD + DT_OFF + hd]) + db, x1 = bf2f(A.projb[(row + 1) * PROJ_LD + DT_OFF + hd]) + db;
        const float d0 = (x0 > 20.f) ? x0 : log1pf(__expf(x0)), d1 = (x1 > 20.f) ? x1 : log1pf(__expf(x1));
        const float a0 = d0 * Ah, a1 = d1 * Ah; float incl = a0 + a1;
#pragma unroll
        for (int o = 1; o < 64; o <<= 1) { const float t = __shfl_up(incl, o); if (lane >= o) incl += t; }
        LAS float* acs = (LAS float*)(lds + SD_ACS) + wid * 128; LAS float* dtl = (LAS float*)(lds + SD_DT) + wid * 128;
        acs[2 * lane] = incl - a1; acs[2 * lane + 1] = incl; dtl[2 * lane] = d0; dtl[2 * lane + 1] = d1; }
}
template <bool PHASE_A>
__device__ __forceinline__ void ssd_conv(LAS unsigned char* lds, const SsdArgs& A, int b, int c, int grp, int wid, int lane) {
    const int ch = lane;
    if (PHASE_A && ch >= 48) return;
    const int rel = (ch < 32) ? grp * 256 + ch * 8 : (ch < 48) ? 512 + grp * 128 + (ch - 32) * 8 : 768 + grp * 128 + (ch - 48) * 8;
    float w[4][8], bias[8];
#pragma unroll
    for (int k = 0; k < 4; ++k) { const f32x4 u0 = *(const f32x4*)(A.conv_w + k * 1024 + rel), u1 = *(const f32x4*)(A.conv_w + k * 1024 + rel + 4);
#pragma unroll
        for (int j = 0; j < 4; ++j) { w[k][j] = u0[j]; w[k][4 + j] = u1[j]; } }
    { const f32x4 u0 = *(const f32x4*)(A.conv_b + rel), u1 = *(const f32x4*)(A.conv_b + rel + 4);
#pragma unroll
      for (int j = 0; j < 4; ++j) { bias[j] = u0[j]; bias[4 + j] = u1[j]; } }
    const int tl0 = wid * 16, ts0 = c * 128 + tl0;
    const bf16_t* src = A.projb + ((size_t)b * S + ts0) * PROJ_LD + XBC_OFF + rel;
    float x0[8], x1[8], x2[8];
#pragma unroll
    for (int j = 0; j < 8; ++j) { x0[j] = 0.f; x1[j] = 0.f; x2[j] = 0.f; }
    if (ts0 >= 3) {
        const bf16x8 r0 = *(const bf16x8*)(src - 3 * (ptrdiff_t)PROJ_LD), r1 = *(const bf16x8*)(src - 2 * (ptrdiff_t)PROJ_LD), r2 = *(const bf16x8*)(src - 1 * (ptrdiff_t)PROJ_LD);
#pragma unroll
        for (int j = 0; j < 8; ++j) { x0[j] = bf2f((bf16_t)r0[j]); x1[j] = bf2f((bf16_t)r1[j]); x2[j] = bf2f((bf16_t)r2[j]); } }
    const LAS float* wt = (const LAS float*)(lds + SD_W) + (ch >> 3) * 128;
#pragma unroll 4
    for (int i = 0; i < 16; ++i) {
        const bf16x8 rv = *(const bf16x8*)(src + (size_t)i * PROJ_LD);
        float x3[8], o[8];
#pragma unroll
        for (int j = 0; j < 8; ++j) { x3[j] = bf2f((bf16_t)rv[j]); const float a = bias[j] + w[0][j] * x0[j] + w[1][j] * x1[j] + w[2][j] * x2[j] + w[3][j] * x3[j]; o[j] = a / (1.f + __expf(-a)); x0[j] = x1[j]; x1[j] = x2[j]; x2[j] = x3[j]; }
        const int row = tl0 + i;
        if (PHASE_A && ch < 32) { const float sc = wt[row];
#pragma unroll
            for (int j = 0; j < 8; ++j) o[j] *= sc; }
        u32x4 pk; pk.x = pk2(o[0], o[1]); pk.y = pk2(o[2], o[3]); pk.z = pk2(o[4], o[5]); pk.w = pk2(o[6], o[7]);
        if (ch < 32) *(LAS u32x4*)(lds + SD_XS + row * 512 + ((ch ^ ((row & 3) << 2)) << 4)) = pk;
        else if (ch < 48) { const int cc = ch - 32; *(LAS u32x4*)(lds + SD_B + row * 256 + ((PHASE_A ? (cc ^ ((row & 3) << 2)) : (cc ^ (row & 15))) << 4)) = pk; }
        else { const int cc = ch - 48; *(LAS u32x4*)(lds + SD_C + row * 256 + ((cc ^ (row & 15)) << 4)) = pk; }
    }
}
__device__ __forceinline__ bf16x8 tr_frag2(const LAS unsigned char* base, int stride, int r0, int r1, int chunk0, int qq, int pp) {
    const int cl = chunk0 + (pp >> 1);
    const s16x4 lo = __builtin_amdgcn_ds_read_tr16_b64_v4i16((LAS s16x4*)(base + (r0 + qq) * stride + ((cl ^ (qq << 2)) << 4) + 8 * (pp & 1)));
    const s16x4 hi = __builtin_amdgcn_ds_read_tr16_b64_v4i16((LAS s16x4*)(base + (r1 + qq) * stride + ((cl ^ (qq << 2)) << 4) + 8 * (pp & 1)));
    return __builtin_shufflevector(lo, hi, 0, 1, 2, 3, 4, 5, 6, 7);
}
__device__ __forceinline__ void ssd_a_item(LAS unsigned char* lds, const SsdArgs& A, int item) {
    const int tid = tid_fresh(), wid = __builtin_amdgcn_readfirstlane(tid >> 6), lane = tid & 63;
    const int grp = item & 1, c = (item >> 1) & 15, b = item >> 5;
    const int ql = lane & 31, h = lane >> 5, qq = (lane & 15) >> 2, pp = lane & 3, lb2 = (lane >> 4) & 1;
    __syncthreads();
    ssd_dt_acs(lds, A, b, c, grp, wid, lane);
    __syncthreads();
    { LAS float* acs = (LAS float*)(lds + SD_ACS); LAS float* dtl = (LAS float*)(lds + SD_DT); LAS float* wt = (LAS float*)(lds + SD_W);
      const int hh = tid >> 7, t = tid & 127; const float al = acs[hh * 128 + 127];
      wt[hh * 128 + t] = dtl[hh * 128 + t] * __expf(al - acs[hh * 128 + t]);
      if (t == 0) A.alast[(b * 8 + grp * 4 + hh) * NCH + c] = al; }
    __syncthreads();
    ssd_conv<true>(lds, A, b, c, grp, wid, lane);
    __syncthreads();
    const int pb = wid >> 2, nb = wid & 3;
#pragma unroll 1
    for (int hh = 0; hh < 4; ++hh) {
        f32x16 acc;
#pragma unroll
        for (int r = 0; r < 16; ++r) acc[r] = 0.f;
#pragma unroll
        for (int kk = 0; kk < 8; ++kk) {
            const bf16x8 af = tr_frag2(lds + SD_XS, 512, 16 * kk + 8 * h, 16 * kk + 8 * h + 4, hh * 8 + 4 * pb + 2 * lb2, qq, pp);
            const bf16x8 bf = tr_frag2(lds + SD_B, 256, 16 * kk + 8 * h, 16 * kk + 8 * h + 4, 4 * nb + 2 * lb2, qq, pp);
            acc = MFMA32(af, bf, acc); }
        bf16_t* st = A.states + ((size_t)((b * NCH + c) * 8 + grp * 4 + hh) * 64) * 128;
#pragma unroll
        for (int r = 0; r < 16; ++r) st[(32 * pb + AT_CROW(r, h)) * 128 + 32 * nb + ql] = f2bf(acc[r]);
    }
}
__device__ __forceinline__ void ssd_b_item(LAS unsigned char* lds, const SsdArgs& A, int item) {
    const int tid = tid_fresh(), wid = __builtin_amdgcn_readfirstlane(tid >> 6), lane = tid & 63;
    const int grp = item & 1, c = (item >> 1) & 15, b = item >> 5;
    const int ql = lane & 31, h = lane >> 5, qq = (lane & 15) >> 2, pp = lane & 3, lb2 = (lane >> 4) & 1;
    const int pb = wid >> 2, lb = wid & 3;
    LAS float* acs = (LAS float*)(lds + SD_ACS); LAS float* dtl = (LAS float*)(lds + SD_DT); LAS float* wp = (LAS float*)(lds + SD_WP);
    __syncthreads();
    ssd_dt_acs(lds, A, b, c, grp, wid, lane);
    if (tid >= 256 && tid < 320) { const int hh = (tid - 256) >> 4, cp = tid & 15; float s = 0.f;
        for (int c2 = cp + 1; c2 < c; ++c2) s += A.alast[(b * 8 + grp * 4 + hh) * NCH + c2];
        wp[hh * 16 + cp] = (cp < c) ? __expf(s) : 0.f; }
    ssd_conv<false>(lds, A, b, c, grp, wid, lane);
    __syncthreads();
    f32x16 X[4];
#pragma unroll
    for (int sb = 0; sb < 4; ++sb) {
#pragma unroll
        for (int r = 0; r < 16; ++r) X[sb][r] = 0.f;
        if (sb <= lb) {
#pragma unroll
            for (int kk = 0; kk < 8; ++kk) {
                const bf16x8 af = *(const LAS bf16x8*)(lds + SD_B + (32 * sb + ql) * 256 + (((2 * kk + h) ^ (ql & 15)) << 4));
                const bf16x8 bf = *(const LAS bf16x8*)(lds + SD_C + (32 * lb + ql) * 256 + (((2 * kk + h) ^ (ql & 15)) << 4));
                X[sb] = MFMA32(af, bf, X[sb]); } }
    }
    __syncthreads();
#pragma unroll 1
    for (int hh = 0; hh < 4; ++hh) {
        const int hd = grp * 4 + hh;
        { float pv[16];
#pragma unroll
          for (int j = 0; j < 16; ++j) pv[j] = 0.f;
          const int p = tid >> 3, n0 = (tid & 7) * 16;
          for (int cp = 0; cp < c; ++cp) { const float wgt = wp[hh * 16 + cp];
              const bf16_t* sp = A.states + ((size_t)((b * NCH + cp) * 8 + hd) * 64 + p) * 128 + n0;
              const bf16x8 s0 = *(const bf16x8*)sp, s1 = *(const bf16x8*)(sp + 8);
#pragma unroll
              for (int j = 0; j < 8; ++j) { pv[j] += wgt * bf2f((bf16_t)s0[j]); pv[8 + j] += wgt * bf2f((bf16_t)s1[j]); } }
          LAS unsigned char* pbuf = lds + SD_B + (hh & 1) * 16384 + p * 256;
          *(LAS u32x4*)(pbuf + ((((n0 >> 3)) ^ (p & 15)) << 4)) = (u32x4){pk2(pv[0], pv[1]), pk2(pv[2], pv[3]), pk2(pv[4], pv[5]), pk2(pv[6], pv[7])};
          *(LAS u32x4*)(pbuf + ((((n0 >> 3) + 1) ^ (p & 15)) << 4)) = (u32x4){pk2(pv[8], pv[9]), pk2(pv[10], pv[11]), pk2(pv[12], pv[13]), pk2(pv[14], pv[15])}; }
        __syncthreads();
        f32x16 acc;
#pragma unroll
        for (int r = 0; r < 16; ++r) acc[r] = 0.f;
#pragma unroll
        for (int kk = 0; kk < 8; ++kk) {
            const bf16x8 af = *(const LAS bf16x8*)(lds + SD_B + (hh & 1) * 16384 + (32 * pb + ql) * 256 + (((2 * kk + h) ^ (ql & 15)) << 4));
            const bf16x8 bf = *(const LAS bf16x8*)(lds + SD_C + (32 * lb + ql) * 256 + (((2 * kk + h) ^ (ql & 15)) << 4));
            acc = MFMA32(af, bf, acc); }
        const float al = acs[hh * 128 + 32 * lb + ql];
        { const float e = __expf(al);
#pragma unroll
          for (int r = 0; r < 16; ++r) acc[r] *= e; }
        const float Dh = A.d_skip[hd];
#pragma unroll
        for (int sb = 0; sb < 4; ++sb) {
            if (sb <= lb) {
                f32x16 Pm;
#pragma unroll
                for (int r = 0; r < 16; ++r) { const int sl = 32 * sb + AT_CROW(r, h), ll = 32 * lb + ql;
                    const float as = acs[hh * 128 + sl], ds = dtl[hh * 128 + sl];
                    float v = X[sb][r] * __expf(al - as) * ds; v = (sl <= ll) ? v : 0.f; v += (sl == ll) ? Dh : 0.f; Pm[r] = v; }
#pragma unroll
                for (int sp = 0; sp < 2; ++sp) { const bf16x8 pf = AT_PACK8(Pm, sp);
                    const bf16x8 af = tr_frag2(lds + SD_XS, 512, 32 * sb + 16 * sp + 4 * h, 32 * sb + 16 * sp + 8 + 4 * h, hh * 8 + 4 * pb + 2 * lb2, qq, pp);
                    acc = MFMA32(af, pf, acc); } }
        }
        { const bf16_t* zp = A.projb + ((size_t)b * S + c * 128 + 32 * lb + ql) * PROJ_LD + Z_OFF + hd * 64 + 32 * pb + 4 * h;
#pragma unroll
          for (int qd = 0; qd < 4; ++qd) { const u32x2 zz = *(const u32x2*)(zp + 8 * qd);
              const float z0 = __uint_as_float(zz.x << 16), z1 = __uint_as_float(zz.x & 0xffff0000u), z2 = __uint_as_float(zz.y << 16), z3 = __uint_as_float(zz.y & 0xffff0000u);
              acc[4 * qd] *= z0 / (1.f + __expf(-z0)); acc[4 * qd + 1] *= z1 / (1.f + __expf(-z1)); acc[4 * qd + 2] *= z2 / (1.f + __expf(-z2)); acc[4 * qd + 3] *= z3 / (1.f + __expf(-z3)); } }
        __syncthreads();
#pragma unroll
        for (int qd = 0; qd < 4; ++qd) { const int row = 32 * lb + ql, chn = hh * 8 + 4 * pb + qd;
            *(LAS u32x2*)(lds + SD_XS + row * 512 + ((chn ^ ((row & 3) << 2)) << 4) + 8 * h) = (u32x2){pk2(acc[4 * qd], acc[4 * qd + 1]), pk2(acc[4 * qd + 2], acc[4 * qd + 3])}; }
    }
    __syncthreads();
    int widn = wid; asm volatile("" : "+s"(widn));
#pragma unroll 1
    for (int i = 0; i < 16; ++i) { const int row = widn + 8 * i; const int chn = lane >> 1;
        const u32x2 v = *(const LAS u32x2*)(lds + SD_XS + row * 512 + ((chn ^ ((row & 3) << 2)) << 4) + 8 * (lane & 1));
        const float f0 = __uint_as_float(v.x << 16), f1 = __uint_as_float(v.x & 0xffff0000u), f2 = __uint_as_float(v.y << 16), f3 = __uint_as_float(v.y & 0xffff0000u);
        float sq = (f0 * f0 + f1 * f1) + (f2 * f2 + f3 * f3); sq = wsum(sq);
        const float rs = rsqrtf(sq * (1.f / 256.f) + 1e-6f);
        *(u32x2*)(A.catb + ((size_t)b * S + c * 128 + row) * 1024 + 512 + grp * 256 + lane * 4) = (u32x2){pk2(f0 * rs, f1 * rs), pk2(f2 * rs, f3 * rs)}; }
}
__global__ __launch_bounds__(512, 2) void k_ssd_a(SsdArgs A) {
    extern __shared__ __attribute__((aligned(16))) unsigned char dl[];
    for (int it = blockIdx.x; it < NB * NCH * 2; it += gridDim.x) ssd_a_item((LAS unsigned char*)dl, A, it);
}
__global__ __launch_bounds__(512, 2) void k_ssd_b(SsdArgs A) {
    extern __shared__ __attribute__((aligned(16))) unsigned char dl[];
    for (int it = blockIdx.x; it < NB * NCH * 2; it += gridDim.x) ssd_b_item((LAS unsigned char*)dl, A, it);
}
}
namespace mk {
__device__ __forceinline__ void rms_row_bf16(const float* xr, bf16_t* o, int lane) {
    f32x4 v[4]; float s = 0.f;
#pragma unroll
    for (int j = 0; j < 4; ++j) { v[j] = *(const f32x4*)(xr + lane * 4 + 256 * j); s += (v[j][0] * v[j][0] + v[j][1] * v[j][1]) + (v[j][2] * v[j][2] + v[j][3] * v[j][3]); }
    s = wsum(s); const float rs = rsqrtf(s * (1.f / 1024.f) + 1e-6f);
#pragma unroll
    for (int j = 0; j < 4; ++j) *(u32x2*)(o + lane * 4 + 256 * j) = (u32x2){pk2(v[j][0] * rs, v[j][1] * rs), pk2(v[j][2] * rs, v[j][3] * rs)};
}
struct WtJob { const float* W; bf16_t* WT; const float* gk1; const float* gk2; int ksplit, K, N, NP, mode, nscale; float sc; int ntn, ntk, nz; };
__device__ __forceinline__ void wt_load(const WtJob& J, int tileidx, LAS float* tile, int t) {
    const int per = J.ntn * J.ntk, z = tileidx / per, rem = tileidx % per, n0 = (rem % J.ntn) * 64, k0 = (rem / J.ntn) * 64, tx = t & 63, ty = t >> 6;
    const float* Wz = J.W + (size_t)z * J.K * J.N;
#pragma unroll 4
    for (int r = 0; r < 16; ++r) { const int kk = r * 4 + ty, k = k0 + kk, n = n0 + tx; float g = 1.f; if (J.gk1) g = (k < J.ksplit) ? J.gk1[k] : J.gk2[k - J.ksplit];
        tile[kk * 65 + tx] = (n < J.N) ? Wz[(size_t)k * J.N + n] * g : 0.f; }
}
__device__ __forceinline__ void wt_store(const WtJob& J, int tileidx, const LAS float* tile, int t) {
    const int per = J.ntn * J.ntk, z = tileidx / per, rem = tileidx % per, n0 = (rem % J.ntn) * 64, k0 = (rem / J.ntn) * 64;
    bf16_t* WTz = J.WT + (size_t)z * J.NP * J.K;
#pragma unroll
    for (int j = 0; j < 2; ++j) { const int id = t + 256 * j, nl = id >> 3, c = id & 7, n = n0 + nl; const float s = (n < J.nscale) ? J.sc : 1.f;
        int nm = n; if (J.mode == 1) { const int up = n >> 10, jj = n & 1023; nm = (jj >> 7) * 256 + up * 128 + (jj & 127); }
        u32x4 w; w.x = pk2(tile[(8 * c + 0) * 65 + nl] * s, tile[(8 * c + 1) * 65 + nl] * s); w.y = pk2(tile[(8 * c + 2) * 65 + nl] * s, tile[(8 * c + 3) * 65 + nl] * s);
        w.z = pk2(tile[(8 * c + 4) * 65 + nl] * s, tile[(8 * c + 5) * 65 + nl] * s); w.w = pk2(tile[(8 * c + 6) * 65 + nl] * s, tile[(8 * c + 7) * 65 + nl] * s);
        *(u32x4*)(WTz + (size_t)nm * J.K + k0 + 8 * c) = w; }
}
constexpr int CP_KX = 0  , CP_RED = 69632  , CP_HID = CP_RED + 32768  , CP_END = CP_HID + 8192;
struct CmpArgs { const bf16_t* projb; const bf16_t* w1T; const float* posb; const float* w2; bf16_t* kc; bf16_t* vc; };
__device__ __forceinline__ void cmp_item(LAS unsigned char* lds, const CmpArgs& A, int item) {
    const int tid = tid_fresh(), wid = __builtin_amdgcn_readfirstlane(tid >> 6), lane = tid & 63, ql = lane & 31, h = lane >> 5;
    const int cblk = item & 3, kvh = (item >> 2) & 1, b = (item >> 3) & 7, j = item >> 6;
    __syncthreads();
    { const int tok0 = 512 * cblk; const bf16_t* src = A.projb + ((size_t)b * S + tok0) * PROJ_LD + 512 + j * 128 + kvh * 64;
      for (int i = tid; i < 528 * 8; i += 512) { const int r = i >> 3, ch = i & 7; u32x4 v = (u32x4){0u, 0u, 0u, 0u};
          if (tok0 + r < S) v = *(const u32x4*)(src + (size_t)r * PROJ_LD + ch * 8);
          *(LAS u32x4*)(lds + CP_KX + r * 128 + ((ch ^ ((r >> 4) & 7)) << 4)) = v; } }
    __syncthreads();
    const int nb = wid & 1, kq = wid >> 1;
    f32x16 acc;
#pragma unroll
    for (int r = 0; r < 16; ++r) acc[r] = 0.f;
    const bf16_t* wrow = A.w1T + ((size_t)j * 64 + 32 * nb + ql) * 2048;
#pragma unroll 2
    for (int li = 0; li < 8; ++li) { const int l = 8 * kq + li;
#pragma unroll
        for (int s = 0; s < 4; ++s) {
            const int row = 16 * ql + l;
            const bf16x8 af = *(const LAS bf16x8*)(lds + CP_KX + row * 128 + (((2 * s + h) ^ ((row >> 4) & 7)) << 4));
            const bf16x8 bf = *(const bf16x8*)(wrow + l * 64 + 16 * s + 8 * h);
            acc = MFMA32(af, bf, acc); } }
    { LAS float* red = (LAS float*)(lds + CP_RED) + kq * 2048;
#pragma unroll
      for (int r = 0; r < 16; ++r) red[AT_CROW(r, h) * 64 + 32 * nb + ql] = acc[r]; }
    __syncthreads();
    { LAS float* red = (LAS float*)(lds + CP_RED); LAS float* hid = (LAS float*)(lds + CP_HID);
      for (int i = tid; i < 2048; i += 512) { const float a = (red[i] + red[2048 + i]) + (red[4096 + i] + red[6144 + i]) + A.posb[j * 64 + (i & 63)]; hid[i] = a / (1.f + __expf(-a)); } }
    __syncthreads();
    { const LAS float* hid = (const LAS float*)(lds + CP_HID); bf16_t* out = (j ? A.vc : A.kc) + (size_t)(b * 2 + kvh) * 128 * 64;
      for (int i = tid; i < 2048; i += 512) { const int cl = i >> 6, n2 = i & 63; float a = 0.f;
#pragma unroll 8
          for (int n = 0; n < 64; ++n) a += hid[cl * 64 + n] * A.w2[(j * 64 + n) * 64 + n2];
          const int c = 32 * cblk + cl; out[c * 64 + n2] = (c < 127) ? f2bf(a) : (bf16_t)0; } }
}
constexpr int RT_RW = 0;
struct RouteArgs { const float* h1; const float* ffn_norm; const float* router_w; const float* router_b; bf16_t* hnb; int* cnt; int* list; float* wlist; int* tinfo; };
__device__ __forceinline__ void route_phase(LAS unsigned char* lds, const RouteArgs& A, int wg, int nwg) {
    const int tid = tid_fresh(), wid = __builtin_amdgcn_readfirstlane(tid >> 6), lane = tid & 63;
    LAS float* rw = (LAS float*)(lds + RT_RW);
    __syncthreads();
    for (int i = tid; i < 1024 * 32; i += 512) rw[i] = A.router_w[i] * A.ffn_norm[i >> 5];
    __syncthreads();
    for (int t = wg * 8 + wid; t < T; t += nwg * 8) {
        const float* xr = A.h1 + (size_t)t * D;
        f32x4 v[4]; float s = 0.f;
#pragma unroll
        for (int j = 0; j < 4; ++j) { v[j] = *(const f32x4*)(xr + lane * 4 + 256 * j); s += (v[j][0] * v[j][0] + v[j][1] * v[j][1]) + (v[j][2] * v[j][2] + v[j][3] * v[j][3]); }
        s = wsum(s); const float rs = rsqrtf(s * (1.f / 1024.f) + 1e-6f);
#pragma unroll
        for (int j = 0; j < 4; ++j) { v[j] = v[j] * rs; *(u32x2*)(A.hnb + (size_t)t * D + lane * 4 + 256 * j) = (u32x2){pk2(v[j][0], v[j][1]), pk2(v[j][2], v[j][3])}; }
        float pl[32];
#pragma unroll
        for (int e = 0; e < 32; ++e) pl[e] = 0.f;
#pragma unroll
        for (int j = 0; j < 4; ++j)
#pragma unroll
            for (int i = 0; i < 4; ++i) { const int k = lane * 4 + 256 * j + i; const float xv = v[j][i];
#pragma unroll
                for (int e4 = 0; e4 < 8; ++e4) { const f32x4 w4 = *(const LAS f32x4*)(rw + k * 32 + e4 * 4); pl[e4 * 4] += xv * w4[0]; pl[e4 * 4 + 1] += xv * w4[1]; pl[e4 * 4 + 2] += xv * w4[2]; pl[e4 * 4 + 3] += xv * w4[3]; }
                __builtin_amdgcn_sched_barrier(0); }
        float r16[16];
#pragma unroll
        for (int e = 0; e < 16; ++e) { const bool up = (lane & 32) != 0; const float keep = up ? pl[16 + e] : pl[e], send = up ? pl[e] : pl[16 + e]; r16[e] = keep + __shfl_xor(send, 32); }
        float r8[8];
#pragma unroll
        for (int e = 0; e < 8; ++e) { const bool up = (lane & 16) != 0; const float keep = up ? r16[8 + e] : r16[e], send = up ? r16[e] : r16[8 + e]; r8[e] = keep + __shfl_xor(send, 16); }
        float r4[4];
#pragma unroll
        for (int e = 0; e < 4; ++e) { const bool up = (lane & 8) != 0; const float keep = up ? r8[4 + e] : r8[e], send = up ? r8[e] : r8[4 + e]; r4[e] = keep + __shfl_xor(send, 8); }
        float r2[2];
#pragma unroll
        for (int e = 0; e < 2; ++e) { const bool up = (lane & 4) != 0; const float keep = up ? r4[2 + e] : r4[e], send = up ? r4[e] : r4[2 + e]; r2[e] = keep + __shfl_xor(send, 4); }
        float r1; { const bool up = (lane & 2) != 0; const float keep = up ? r2[1] : r2[0], send = up ? r2[0] : r2[1]; r1 = keep + __shfl_xor(send, 2); }
        r1 += __shfl_xor(r1, 1);
        const int ex = ((lane >> 5) & 1) * 16 + ((lane >> 4) & 1) * 8 + ((lane >> 3) & 1) * 4 + ((lane >> 2) & 1) * 2 + ((lane >> 1) & 1);
        float lg = r1 + A.router_b[ex];
        float tv[4]; int te[4];
#pragma unroll
        for (int k = 0; k < 4; ++k) { float m = lg;
#pragma unroll
            for (int o = 1; o < 64; o <<= 1) m = fmaxf(m, __shfl_xor(m, o));
            int cand = (lg == m) ? ex : 64;
#pragma unroll
            for (int o = 1; o < 64; o <<= 1) cand = min(cand, __shfl_xor(cand, o));
            tv[k] = m; te[k] = cand; if (ex == cand) lg = -INFINITY; }
        const float e1 = __expf(tv[1] - tv[0]), e2 = __expf(tv[2] - tv[0]), e3 = __expf(tv[3] - tv[0]); const float inv = 1.f / (1.f + e1 + e2 + e3);
        if (lane < 4) { const int ek = lane == 0 ? te[0] : lane == 1 ? te[1] : lane == 2 ? te[2] : te[3]; const float wk = (lane == 0 ? 1.f : lane == 1 ? e1 : lane == 2 ? e2 : e3) * inv;
            const int pos = atomicAdd(A.cnt + ek, 1); A.list[(size_t)ek * T + pos] = t * 4 + lane; A.wlist[(size_t)ek * T + pos] = wk; A.tinfo[t * 4 + lane] = ek | (pos << 8); }
    }
}
struct CombArgs { const float* h1; const bf16_t* y; const int* tinfo; const int* cnt; const float* g; float* out; };
__device__ __forceinline__ void combine_phase(LAS unsigned char* lds, const CombArgs& A, int wg, int nwg) {
    const int tid = tid_fresh(), wid = __builtin_amdgcn_readfirstlane(tid >> 6), lane = tid & 63;
    LAS int* toff = (LAS int*)(lds + LDS_MISC + 64);
    __syncthreads();
    if (tid == 0) { int a = 0; for (int e = 0; e < NE; ++e) { toff[e] = a; a += (A.cnt[e] + 255) >> 8; } }
    __syncthreads();
    f32x4 gv[4];
#pragma unroll
    for (int j = 0; j < 4; ++j) gv[j] = *(const f32x4*)(A.g + lane * 4 + 256 * j);
    for (int t = wg * 8 + wid; t < T; t += nwg * 8) {
        size_t so[4];
#pragma unroll
        for (int k = 0; k < 4; ++k) { const int inf = A.tinfo[t * 4 + k]; so[k] = ((size_t)toff[inf & 255] * 256 + (inf >> 8)) * 1024; }
        f32x4 v[4]; float s = 0.f;
#pragma unroll
        for (int j = 0; j < 4; ++j) { v[j] = *(const f32x4*)(A.h1 + (size_t)t * D + lane * 4 + 256 * j);
#pragma unroll
            for (int k = 0; k < 4; ++k) { const u32x2 yy = *(const u32x2*)(A.y + so[k] + lane * 4 + 256 * j);
                v[j][0] += __uint_as_float(yy.x << 16); v[j][1] += __uint_as_float(yy.x & 0xffff0000u); v[j][2] += __uint_as_float(yy.y << 16); v[j][3] += __uint_as_float(yy.y & 0xffff0000u); }
            s += (v[j][0] * v[j][0] + v[j][1] * v[j][1]) + (v[j][2] * v[j][2] + v[j][3] * v[j][3]); }
        s = wsum(s); const float rs = rsqrtf(s * (1.f / 1024.f) + 1e-6f);
#pragma unroll
        for (int j = 0; j < 4; ++j) *(f32x4*)(A.out + (size_t)t * D + lane * 4 + 256 * j) = v[j] * rs * gv[j];
    }
}
}
#define XB_TMO      128
#define XB_XCNT(j)  (256  + 64 * (j))
#define XB_XSUB(j)  (1280 + 64 * (j))
#define XB_XGEN(j)  (2304 + 64 * (j))
#define XB_TOP      3328
#define XB_TOPGEN   3392
#define XCD_BAR_WORDS 3456
#define XB_SPIN_CAP (1u << 18)
__device__ __forceinline__ unsigned xb_ld(unsigned* p)              { return __hip_atomic_load(p, __ATOMIC_RELAXED, __HIP_MEMORY_SCOPE_AGENT); }
__device__ __forceinline__ unsigned xb_add(unsigned* p, unsigned v) { return __hip_atomic_fetch_add(p, v, __ATOMIC_RELAXED, __HIP_MEMORY_SCOPE_AGENT); }
__device__ __forceinline__ unsigned xb_xcc_id() { return (unsigned)__builtin_amdgcn_s_getreg((3 << 11) | 20) & 0xFu; }
#define XB_SPIN(cond, bar) do { unsigned _sp = 0; while (cond) { __builtin_amdgcn_s_sleep(1); \
    if ((++_sp & 255u) == 0u) { if (xb_ld(&(bar)[XB_TMO])) break; if (_sp > XB_SPIN_CAP) { atomicAdd(&(bar)[XB_TMO], 1u); break; } } } } while (0)
struct XcdBarrier { unsigned* bar; unsigned x; volatile LAS unsigned* st; };
__device__ __forceinline__ XcdBarrier xcd_barrier_post(unsigned* bar, volatile LAS unsigned* st) {
    XcdBarrier b; b.bar = bar; b.x = xb_xcc_id(); b.st = st;
    if (threadIdx.x == 0) (void)xb_add(&bar[XB_XCNT(b.x)], 1u);
    return b;
}
__device__ __forceinline__ void xcd_barrier_complete(unsigned* bar, unsigned x, unsigned& nloc, unsigned& nx) {
    const unsigned G = gridDim.x * gridDim.y * gridDim.z;
    unsigned sum, cnt, mine, sp = 0u;
    for (;;) {
        sum = 0u; cnt = 0u; mine = 0u;
#pragma unroll
        for (unsigned j = 0; j < 16; ++j) { const unsigned c = xb_ld(&bar[XB_XCNT(j)]); sum += c; cnt += (c > 0u) ? 1u : 0u; mine = (j == x) ? c : mine; }
        if (sum == G) break;
        __builtin_amdgcn_s_sleep(1);
        if ((++sp & 255u) == 0u) { if (xb_ld(&bar[XB_TMO])) break; if (sp > XB_SPIN_CAP) { atomicAdd(&bar[XB_TMO], 1u); break; } }
    }
    nloc = mine > 0u ? mine : 1u; nx = cnt > 0u ? cnt : 1u;
}
__device__ __forceinline__ void xcd_barrier(const XcdBarrier& b) {
    asm volatile("s_waitcnt vmcnt(0)" ::: "memory");
    __syncthreads();
    if (threadIdx.x == 0) {
        unsigned* bar = b.bar;
        __builtin_amdgcn_s_waitcnt(0);
        unsigned nloc = b.st[0], nx = b.st[1];
        if (nloc == 0u) { xcd_barrier_complete(bar, b.x, nloc, nx); b.st[0] = nloc; b.st[1] = nx; }
        const unsigned old = xb_add(&bar[XB_XSUB(b.x)], 1u);
        const unsigned gen = old / nloc;
        if (old + 1u == (gen + 1u) * nloc) {
            __builtin_amdgcn_fence(__ATOMIC_RELEASE, "agent");
            asm volatile("s_waitcnt vmcnt(0)" ::: "memory");
            const unsigned og = xb_add(&bar[XB_TOP], 1u);
            const unsigned tg = og / nx;
            if (og + 1u == (tg + 1u) * nx) xb_add(&bar[XB_TOPGEN], 1u);
            else XB_SPIN(xb_ld(&bar[XB_TOPGEN]) == tg, bar);
            __builtin_amdgcn_fence(__ATOMIC_ACQUIRE, "agent");
            xb_add(&bar[XB_XGEN(b.x)], 1u);
            asm volatile("s_waitcnt vmcnt(0)" ::: "memory");
        } else {
            XB_SPIN(xb_ld(&bar[XB_XGEN(b.x)]) == gen, bar);
            __builtin_amdgcn_fence(__ATOMIC_ACQUIRE, "agent");
            asm volatile("s_waitcnt vmcnt(0)" ::: "memory");
        }
    }
    __syncthreads();
}

namespace mk {
constexpr int LDS_BAR = 147456, LDS_FUSED = LDS_BAR + 256;
constexpr int CTL_QUEUE = 4096;
struct Params {
    const float *x, *attn_norm, *w_in, *rel_bias, *cmp_pos, *cmp_w1, *cmp_w2, *attn_out_norm, *conv_w, *conv_b, *dt_bias, *a_log, *d_skip, *ssm_out_norm, *w_out, *ffn_norm,
                *router_w, *router_b, *w_gu, *b_gu, *w_dn, *b_dn, *final_norm;
    float* out; unsigned* ctl; int* cnt;
    bf16_t *xb, *WinT, *WoutT, *WguT, *WdnT, *w1T, *projb, *catb, *hnb, *kc, *vc, *states, *act, *ymoe;
    float *posb, *alast, *h1, *wlist; int *list, *tinfo;
    int ph_lo, ph_hi;
};
constexpr int NT_WIN = 48 * 16, NT_WOUT = 16 * 16, NT_WGU = 32 * 32 * 16, NT_WDN = 32 * 16 * 16, NT_W1 = 2 * 32, NT_ALL = NT_WIN + NT_WOUT + NT_WGU + NT_WDN + NT_W1;
__device__ __forceinline__ WtJob wt_job(const Params& p, int& idx) {
    WtJob J;
    if (idx < NT_WIN) { J = WtJob{p.w_in, p.WinT, p.attn_norm, p.attn_norm, 1024, 1024, 2848, 3072, 0, 512, 0.125f * LOG2E, 48, 16, 1}; return J; } idx -= NT_WIN;
    if (idx < NT_WOUT) { J = WtJob{p.w_out, p.WoutT, p.attn_out_norm, p.ssm_out_norm, 512, 1024, 1024, 1024, 0, 0, 1.f, 16, 16, 1}; return J; } idx -= NT_WOUT;
    if (idx < NT_WGU) { J = WtJob{p.w_gu, p.WguT, p.ffn_norm, p.ffn_norm, 1024, 1024, 2048, 2048, 1, 0, 1.f, 32, 16, 32}; return J; } idx -= NT_WGU;
    if (idx < NT_WDN) { J = WtJob{p.w_dn, p.WdnT, nullptr, nullptr, 0, 1024, 1024, 1024, 0, 0, 1.f, 16, 16, 32}; return J; } idx -= NT_WDN;
    J = WtJob{p.cmp_w1, p.w1T, nullptr, nullptr, 0, 2048, 64, 64, 0, 0, 1.f, 1, 32, 2}; return J;
}
__device__ __forceinline__ void p0_prologue(LAS unsigned char* lds, const Params& p, int wg, int nwg) {
    const int tid = tid_fresh(), wid = __builtin_amdgcn_readfirstlane(tid >> 6), lane = tid & 63, half = tid >> 8, t = tid & 255;
    for (int r = wg * 8 + wid; r < T; r += nwg * 8) rms_row_bf16(p.x + (size_t)r * D, p.xb + (size_t)r * D, lane);
    for (int o = wg * 8 + wid; o < 128; o += nwg * 8) { const int j = o >> 6, n = o & 63; float s = 0.f;
        for (int k = lane; k < 2048; k += 64) s += p.cmp_pos[j * 2048 + k] * p.cmp_w1[((size_t)j * 2048 + k) * 64 + n];
        s = wsum(s); if (lane == 0) p.posb[o] = s; }
    LAS float* tile = (LAS float*)(lds + half * 16640);
    __syncthreads();
    for (int base = wg * 2; base < NT_ALL; base += nwg * 2) {
        int idx = base + half; const bool on = idx < NT_ALL; WtJob J; if (on) J = wt_job(p, idx);
        if (on) wt_load(J, idx, tile, t);
        __syncthreads();
        if (on) wt_store(J, idx, tile, t);
        __syncthreads();
    }
}
__global__ void __launch_bounds__(512, 2) k_fused(Params p) {
    extern __shared__ __attribute__((aligned(16))) unsigned char dl[];
    LAS unsigned char* lds = (LAS unsigned char*)dl;
    const int wg = blockIdx.x, nwg = gridDim.x; int tid = tid_fresh();
    if (tid < 64) ((LAS unsigned*)(lds + LDS_BAR))[tid] = 0u;
    __syncthreads();
    XcdBarrier bar = xcd_barrier_post(p.ctl, (volatile LAS unsigned*)(lds + LDS_BAR));
#ifdef MK_ONLY
#define PH(k) ((k) == MK_ONLY && p.ph_lo <= (k) && (k) < p.ph_hi)
#else
#define PH(k) (p.ph_lo <= (k) && (k) < p.ph_hi)
#endif
#define SEAM(k) do { if (PH(k) && PH((k) + 1)) xcd_barrier(bar); } while (0)
    if (PH(0)) p0_prologue(lds, p, wg, nwg);
    SEAM(0);
    if (PH(1)) { ProbProj P; P.S.init(T, NPROJ, nwg, wg); P.A = p.xb; P.Bt = p.WinT; P.O = p.projb; gemm_phase(lds, P); }
    SEAM(1);
    if (PH(2)) {
        const SsdArgs SA{p.projb, p.conv_w, p.conv_b, p.dt_bias, p.a_log, p.d_skip, p.states, p.alast, p.catb};
        const CmpArgs CA{p.projb, p.w1T, p.posb, p.cmp_w2, p.kc, p.vc};
        for (int it = wg; it < 384; it += nwg) { const int v = 383 - it; if (v < 128) cmp_item(lds, CA, v); else ssd_a_item(lds, SA, v - 128); }
    }
    SEAM(2);
    if (PH(3)) {
        tid = tid_fresh();
        const SsdArgs SA{p.projb, p.conv_w, p.conv_b, p.dt_bias, p.a_log, p.d_skip, p.states, p.alast, p.catb};
        const AttnArgs AA{p.projb, p.kc, p.vc, p.catb};
        attn_btab(lds, p.rel_bias);
        LAS int* qslot = (LAS int*)(lds + LDS_BAR + 64);
        for (;;) {
            __syncthreads();
            if (tid == 0) qslot[0] = (int)__hip_atomic_fetch_add(p.ctl + CTL_QUEUE, 1u, __ATOMIC_RELAXED, __HIP_MEMORY_SCOPE_AGENT);
            __syncthreads();
            const int it = qslot[0];
            if (it >= 512) break;
            if (it < 256) attn_item(lds, AA, it & 7, 31 - (it >> 3)); else ssd_b_item(lds, SA, it - 256);
        }
    }
    SEAM(3);
    if (PH(4)) { ProbOut P; P.S.init(T, D, nwg, wg); P.A = p.catb; P.Bt = p.WoutT; P.R0 = p.x; P.O = p.h1; gemm_phase(lds, P); }
    SEAM(4);
    if (PH(5)) { const RouteArgs RA{p.h1, p.ffn_norm, p.router_w, p.router_b, p.hnb, p.cnt, p.list, p.wlist, p.tinfo}; route_phase(lds, RA, wg, nwg); }
    SEAM(5);
    if (PH(6)) {
        tid = tid_fresh();
        __syncthreads();
        const int RT = moe_tables(lds, p.cnt);
        ProbMoe1 P; P.S.nN = 8; P.S.G = nwg; P.S.c = wg; P.S.RT = RT; P.S.tile_e = (const LAS int*)(lds + LDS_TILE_E); P.S.tile_m = (const LAS int*)(lds + LDS_TILE_M);
        P.A = p.hnb; P.Bt = p.WguT; P.bias = p.b_gu; P.O = p.act; P.rowtab = (const LAS unsigned*)(lds + LDS_ROWTAB);
        LAS unsigned* rowtab = (LAS unsigned*)(lds + LDS_ROWTAB);
#pragma unroll 1
        for (int i = 0; i < 12; ++i) { Unit u; if (!P.S.next(i, u)) break; if (tid < 256) { const int pos = u.mt * 256 + tid; const int c = p.cnt[u.e];
            const int tok = (pos < c) ? (p.list[(size_t)u.e * T + pos] >> 2) : 0; rowtab[i * 256 + tid] = (unsigned)tok * (KD * 2); } }
        __syncthreads();
        gemm_phase(lds, P);
    }
    SEAM(6);
    if (PH(7)) {
        __syncthreads();
        const int RT = moe_tables(lds, p.cnt);
        ProbMoe2 P; P.S.nN = 4; P.S.G = nwg; P.S.c = wg; P.S.RT = RT; P.S.tile_e = (const LAS int*)(lds + LDS_TILE_E); P.S.tile_m = (const LAS int*)(lds + LDS_TILE_M);
        P.A = p.act; P.Bt = p.WdnT; P.bias = p.b_dn; P.wlist = p.wlist; P.O = p.ymoe;
        gemm_phase(lds, P);
    }
    SEAM(7);
    if (PH(8)) { const CombArgs CA{p.h1, p.ymoe, p.tinfo, p.cnt, p.final_norm, p.out}; combine_phase(lds, CA, wg, nwg); }
#undef PH
#undef SEAM
}
}

extern "C" void kernel_launch(void* const* d_in, const int* in_sizes, int n_in, void* d_out, int out_size, void* d_ws, size_t ws_size, hipStream_t stream) {
    using namespace mk;
    char* ws = (char*)d_ws; const size_t MB = 1u << 20;
    size_t o = 0; auto take = [&](size_t mb) { char* q = ws + o; o += mb * MB; return q; };
    Params p;
    memset(&p, 0, sizeof(p));
    const float** fin = (const float**)&p.x;
    for (int i = 0; i < 23; ++i) fin[i] = (const float*)d_in[i];
    p.out = (float*)d_out;
    p.ctl = (unsigned*)take(1); p.cnt = (int*)(p.ctl + 8192);
    p.xb = (bf16_t*)take(32); p.WinT = (bf16_t*)take(6); p.WoutT = (bf16_t*)take(2); p.WguT = (bf16_t*)take(128); p.WdnT = (bf16_t*)take(64); p.w1T = (bf16_t*)take(1);
    p.projb = (bf16_t*)take(96); p.catb = (bf16_t*)take(32); p.hnb = (bf16_t*)take(32); p.kc = (bf16_t*)take(1); p.vc = (bf16_t*)take(1); p.states = (bf16_t*)take(16);
    p.act = (bf16_t*)take(144); p.ymoe = (bf16_t*)take(144);
    p.posb = (float*)take(1); p.alast = (float*)take(1); p.h1 = (float*)take(64); p.wlist = (float*)take(2); p.list = (int*)take(2); p.tinfo = (int*)take(1);
    static int grid = 0;
    if (!grid) {
        int dev = 0, cus = 0, per_cu = 0;
        (void)hipGetDevice(&dev); (void)hipDeviceGetAttribute(&cus, hipDeviceAttributeMultiprocessorCount, dev);
        (void)hipFuncSetAttribute((const void*)k_fused, hipFuncAttributeMaxDynamicSharedMemorySize, LDS_FUSED);
        (void)hipOccupancyMaxActiveBlocksPerMultiprocessor(&per_cu, (const void*)k_fused, 512, LDS_FUSED);
        (void)hipGetLastError();
        grid = cus > 0 ? cus : 256;
    }
    (void)hipMemsetAsync(p.ctl, 0, 65536, stream);
#ifndef MK_SPLIT
    p.ph_lo = 0; p.ph_hi = 9;
    hipLaunchKernelGGL(k_fused, dim3(grid), dim3(512), LDS_FUSED, stream, p);
#else
    for (int k = 0; k < 9; ++k) { p.ph_lo = k; p.ph_hi = k + 1; hipLaunchKernelGGL(k_fused, dim3(grid), dim3(512), LDS_FUSED, stream, p); }
#endif
}
```

```cpp
#include <hip/hip_runtime.h>
#include <stdint.h>
#include <string.h>
#include <math.h>
namespace mk {
#define LAS __attribute__((address_space(3)))
typedef unsigned short bf16_t;
typedef short bf16x8 __attribute__((ext_vector_type(8)));
typedef float f32x4 __attribute__((ext_vector_type(4)));
typedef unsigned u32x4 __attribute__((ext_vector_type(4)));
typedef unsigned u32x2 __attribute__((ext_vector_type(2)));
constexpr int NB = 8, S = 2048, D = 1024, T = NB * S, NE = 32;
constexpr int BM = 256, BK = 64, HALF = 128, HTB = HALF * BK * 2, STAGE_BYTES = 8 * HTB, NXCD = 8, WGM = 8;
constexpr int KD = 1024;
constexpr int NPROJ = 3072;
constexpr int MAXSLOT = 65536 + 32 * 256;
constexpr int LDS_MISC = 131072, LDS_TILE_E = LDS_MISC + 64, LDS_TILE_M = LDS_TILE_E + 1536, LDS_ROWTAB = LDS_MISC + 4096, LDS_BYTES = LDS_ROWTAB + 12 * 1024;

__host__ __device__ __forceinline__ int lds_byte(int r, int c) { const int st = (r >> 4) * 2 + (c >> 5), rr = r & 15, cc = c & 31, ob = rr * 64 + cc * 2; return st * 1024 + (ob ^ (((ob >> 9) & 1) << 5)); }
__host__ __device__ __forceinline__ void stage_rc(int b, int& R, int& C) { const int st = b / 1024, sb = b % 1024, swz = sb ^ (((sb >> 9) & 1) << 5); R = (st >> 1) * 16 + swz / 64; C = (st & 1) * 32 + (swz % 64) / 2; }
__host__ __device__ __forceinline__ int perm32(int rho) { const int n = rho >> 4, i = rho & 15; return 8 * (i >> 2) + 4 * n + (i & 3); }
__device__ __forceinline__ unsigned cvt_pk_bf16(float lo, float hi) { unsigned r; asm volatile("v_cvt_pk_bf16_f32 %0, %1, %2" : "=v"(r) : "v"(lo), "v"(hi)); return r; }
__device__ __forceinline__ int tid_fresh() { int t = threadIdx.x; asm volatile("" : "+v"(t)); return t; }
__device__ __forceinline__ float bf2f(bf16_t b) { return __uint_as_float(((unsigned)b) << 16); }

struct Unit { int pm, pn, e, mt; };
struct StaticOrder {
    int nM, nN, nwg, G, c;
    __device__ void init(int M, int N, int G_, int c_) { nM = M / BM; nN = N / BM; nwg = nM * nN; G = G_; c = c_; }
    __device__ bool next(int i, Unit& u) const {
        const long L = (long)i * G + c; if (L >= nwg) return false;
        int wgid = (int)L; { const int q = nwg / NXCD, r = nwg % NXCD, xcd = wgid % NXCD, off = wgid / NXCD; wgid = (xcd < r ? xcd * (q + 1) : r * (q + 1) + (xcd - r) * q) + off; }
        const int nig = WGM * nN, gid = wgid / nig, fm = gid * WGM, gsz = (nM - fm) < WGM ? (nM - fm) : WGM;
        u.pm = fm + ((wgid % nig) % gsz); u.pn = (wgid % nig) / gsz; u.e = 0; u.mt = 0; return true;
    }
};
struct MoeOrder {
    int nN, G, c, RT; const LAS int* tile_e; const LAS int* tile_m;
    __device__ bool next(int i, Unit& u) const { const int L = i * G + c; if (L >= RT * nN) return false; const int rt = L / nN; u.pm = rt; u.pn = L - rt * nN; u.e = tile_e[rt]; u.mt = tile_m[rt]; return true; }
};

struct ProbProj {
    static constexpr bool PERM = true;
    StaticOrder S; const bf16_t* A; const bf16_t* Bt; bf16_t* O;
    __device__ __forceinline__ bool next(int i, Unit& u) const { return S.next(i, u); }
    __device__ __forceinline__ const char* a_base(const Unit& u) const { return (const char*)A + (size_t)u.pm * (BM * KD * 2); }
    __device__ __forceinline__ const char* b_base(const Unit& u) const { return (const char*)Bt + (size_t)u.pn * (BM * KD * 2); }
    __device__ __forceinline__ void a_offs(int, const Unit&, unsigned (&v0)[2], unsigned (&v1)[2], const int (&R)[2], const int (&C)[2]) const {
#pragma unroll
        for (int i = 0; i < 2; ++i) { v0[i] = (unsigned)(R[i] * KD + C[i]) * 2u; v1[i] = v0[i] + (unsigned)(HALF * KD * 2); } }
    __device__ __forceinline__ void epi(const f32x4 (&acc)[2][2][4][2], const Unit& u, int wr, int wc, int fr, int fq) const {
        const int row0 = u.pm * BM + wr * 64 + fr, col0 = u.pn * BM + wc * 32 + 8 * fq;
#pragma unroll
        for (int ai = 0; ai < 2; ++ai)
#pragma unroll
            for (int m = 0; m < 4; ++m) { bf16_t* rowp = O + (size_t)(row0 + ai * HALF + m * 16) * NPROJ + col0;
#pragma unroll
                for (int bj = 0; bj < 2; ++bj) { const f32x4 v0 = acc[ai][bj][m][0], v1 = acc[ai][bj][m][1]; u32x4 w;
                    w.x = cvt_pk_bf16(v0[0], v0[1]); w.y = cvt_pk_bf16(v0[2], v0[3]); w.z = cvt_pk_bf16(v1[0], v1[1]); w.w = cvt_pk_bf16(v1[2], v1[3]);
                    *(u32x4*)(rowp + bj * HALF) = w; } }
    }
};
struct ProbOut {
    static constexpr bool PERM = false;
    StaticOrder S; const bf16_t* A; const bf16_t* Bt; const float* R0; float* O;
    __device__ __forceinline__ bool next(int i, Unit& u) const { return S.next(i, u); }
    __device__ __forceinline__ const char* a_base(const Unit& u) const { return (const char*)A + (size_t)u.pm * (BM * KD * 2); }
    __device__ __forceinline__ const char* b_base(const Unit& u) const { return (const char*)Bt + (size_t)u.pn * (BM * KD * 2); }
    __device__ __forceinline__ void a_offs(int, const Unit&, unsigned (&v0)[2], unsigned (&v1)[2], const int (&R)[2], const int (&C)[2]) const {
#pragma unroll
        for (int i = 0; i < 2; ++i) { v0[i] = (unsigned)(R[i] * KD + C[i]) * 2u; v1[i] = v0[i] + (unsigned)(HALF * KD * 2); } }
    __device__ __forceinline__ void epi(const f32x4 (&acc)[2][2][4][2], const Unit& u, int wr, int wc, int fr, int fq) const {
        const int row0 = u.pm * BM + wr * 64 + fr, col0 = u.pn * BM + wc * 32 + 4 * fq;
#pragma unroll
        for (int ai = 0; ai < 2; ++ai)
#pragma unroll
            for (int m = 0; m < 4; ++m) { const size_t off = (size_t)(row0 + ai * HALF + m * 16) * D + col0;
#pragma unroll
                for (int bj = 0; bj < 2; ++bj)
#pragma unroll
                    for (int n = 0; n < 2; ++n) { const f32x4 r = *(const f32x4*)(R0 + off + bj * HALF + n * 16); *(f32x4*)(O + off + bj * HALF + n * 16) = acc[ai][bj][m][n] + r; }
                asm volatile("" ::: "memory"); }
    }
};
struct ProbMoe1 {
    static constexpr bool PERM = true;
    MoeOrder S; const bf16_t* A; const bf16_t* Bt; const float* bias; bf16_t* O; const LAS unsigned* rowtab;
    __device__ __forceinline__ bool next(int i, Unit& u) const { return S.next(i, u); }
    __device__ __forceinline__ const char* a_base(const Unit&) const { return (const char*)A; }
    __device__ __forceinline__ const char* b_base(const Unit& u) const { return (const char*)Bt + ((size_t)u.e * 2048 + (size_t)u.pn * BM) * (KD * 2); }
    __device__ __forceinline__ void a_offs(int i, const Unit&, unsigned (&v0)[2], unsigned (&v1)[2], const int (&R)[2], const int (&C)[2]) const {
#pragma unroll
        for (int j = 0; j < 2; ++j) { v0[j] = rowtab[i * 256 + R[j]] + (unsigned)C[j] * 2u; v1[j] = rowtab[i * 256 + HALF + R[j]] + (unsigned)C[j] * 2u; } }
    __device__ __forceinline__ void epi(const f32x4 (&acc)[2][2][4][2], const Unit& u, int wr, int wc, int fr, int fq) const {
        const int row0 = u.pm * BM + wr * 64 + fr, jg0 = u.pn * HALF + wc * 32 + 8 * fq;
        f32x4 bg[2], bu[2];
#pragma unroll
        for (int n = 0; n < 2; ++n) { bg[n] = *(const f32x4*)(bias + u.e * 2048 + jg0 + 4 * n); bu[n] = *(const f32x4*)(bias + u.e * 2048 + 1024 + jg0 + 4 * n); }
#pragma unroll
        for (int ai = 0; ai < 2; ++ai)
#pragma unroll
            for (int m = 0; m < 4; ++m) { float o[8];
#pragma unroll
                for (int n = 0; n < 2; ++n) { const f32x4 g4 = acc[ai][0][m][n] + bg[n], u4 = acc[ai][1][m][n] + bu[n];
#pragma unroll
                    for (int j = 0; j < 4; ++j) { const float g = fminf(g4[j], 7.f), uu = fminf(fmaxf(u4[j], -7.f), 7.f);
                        const float sg = __builtin_amdgcn_rcpf(1.f + __builtin_amdgcn_exp2f(-1.702f * 1.4426950408889634f * g)); o[n * 4 + j] = (uu + 1.f) * g * sg; } }
                u32x4 w; w.x = cvt_pk_bf16(o[0], o[1]); w.y = cvt_pk_bf16(o[2], o[3]); w.z = cvt_pk_bf16(o[4], o[5]); w.w = cvt_pk_bf16(o[6], o[7]);
                *(u32x4*)(O + (size_t)(row0 + ai * HALF + m * 16) * 1024 + jg0) = w; }
    }
};
struct ProbMoe2 {
    static constexpr bool PERM = true;
    MoeOrder S; const bf16_t* A; const bf16_t* Bt; const float* bias; const float* wlist; bf16_t* O;
    __device__ __forceinline__ bool next(int i, Unit& u) const { return S.next(i, u); }
    __device__ __forceinline__ const char* a_base(const Unit& u) const { return (const char*)A + (size_t)u.pm * (BM * KD * 2); }
    __device__ __forceinline__ const char* b_base(const Unit& u) const { return (const char*)Bt + ((size_t)u.e * 1024 + (size_t)u.pn * BM) * (KD * 2); }
    __device__ __forceinline__ void a_offs(int, const Unit&, unsigned (&v0)[2], unsigned (&v1)[2], const int (&R)[2], const int (&C)[2]) const {
#pragma unroll
        for (int i = 0; i < 2; ++i) { v0[i] = (unsigned)(R[i] * KD + C[i]) * 2u; v1[i] = v0[i] + (unsigned)(HALF * KD * 2); } }
    __device__ __forceinline__ void epi(const f32x4 (&acc)[2][2][4][2], const Unit& u, int wr, int wc, int fr, int fq) const {
        const int rl0 = wr * 64 + fr, col0 = u.pn * BM + wc * 32 + 8 * fq;
        f32x4 bv[2][2];
#pragma unroll
        for (int bj = 0; bj < 2; ++bj)
#pragma unroll
            for (int n = 0; n < 2; ++n) bv[bj][n] = *(const f32x4*)(bias + u.e * 1024 + col0 + bj * HALF + 4 * n);
#pragma unroll
        for (int ai = 0; ai < 2; ++ai)
#pragma unroll
            for (int m = 0; m < 4; ++m) { const int rl = rl0 + ai * HALF + m * 16; const float wt = wlist[(size_t)u.e * T + u.mt * BM + rl];
                bf16_t* rowp = O + (size_t)(u.pm * BM + rl) * 1024 + col0;
#pragma unroll
                for (int bj = 0; bj < 2; ++bj) { const f32x4 v0 = (acc[ai][bj][m][0] + bv[bj][0]) * wt, v1 = (acc[ai][bj][m][1] + bv[bj][1]) * wt; u32x4 w;
                    w.x = cvt_pk_bf16(v0[0], v0[1]); w.y = cvt_pk_bf16(v0[2], v0[3]); w.z = cvt_pk_bf16(v1[0], v1[1]); w.w = cvt_pk_bf16(v1[2], v1[3]);
                    *(u32x4*)(rowp + bj * HALF) = w; } }
    }
};

template <class P>
__device__ __forceinline__ void gemm_phase(LAS unsigned char* lds, const P& Pb) {
    const int tid = tid_fresh(), wid = __builtin_amdgcn_readfirstlane(tid >> 6), lane = tid & 63, wr = wid >> 2, wc = wid & 3, fr = lane & 15, fq = lane >> 4;
    constexpr int nt = KD / BK;
    int Rr[2], Cc[2]; unsigned voffB[2];
#pragma unroll
    for (int i = 0; i < 2; ++i) { int R, C; stage_rc(tid * 16 + i * 8192, R, C); const int Rb = P::PERM ? ((R & ~31) + perm32(R & 31)) : R; Rr[i] = R; Cc[i] = C; voffB[i] = (unsigned)(Rb * KD + C) * 2u; }
    constexpr size_t kstep = (size_t)(BK * 2);
    constexpr size_t hstep = (size_t)HALF * KD * 2;
    const unsigned ldsw = (unsigned)wid * 1024u;
    const int aoff = lds_byte(wr * 64 + fr, fq * 8), boff = lds_byte(wc * 32 + fr, fq * 8);
#define PG8_SA(b, h) (((b) * 2 + (h)) * HTB)
#define PG8_SB(b, h) ((4 + (b) * 2 + (h)) * HTB)
#define PG8_STAGE(bufoff, gbase, voff) do { _Pragma("unroll") for (int _i = 0; _i < 2; ++_i) \
        __builtin_amdgcn_global_load_lds((const unsigned*)((const char*)(gbase) + (voff)[_i]), (LAS unsigned*)(lds + (bufoff) + ldsw + _i * 8192), 16, 0, 0); } while (0)
#define PG8_LDA(dst, b, h) do { _Pragma("unroll") for (int m = 0; m < 4; ++m) _Pragma("unroll") for (int k = 0; k < 2; ++k) dst[m][k] = *(const LAS bf16x8*)(lds + PG8_SA(b, h) + aoff + m * 2048 + k * 1024); } while (0)
#define PG8_LDB(dst, b, h) do { _Pragma("unroll") for (int n = 0; n < 2; ++n) _Pragma("unroll") for (int k = 0; k < 2; ++k) dst[n][k] = *(const LAS bf16x8*)(lds + PG8_SB(b, h) + boff + n * 2048 + k * 1024); } while (0)
#define PG8_MMA(ai, bj, At, Bt) do { __builtin_amdgcn_s_setprio(1); _Pragma("unroll") for (int m = 0; m < 4; ++m) _Pragma("unroll") for (int n = 0; n < 2; ++n) _Pragma("unroll") for (int k = 0; k < 2; ++k) \
        acc[ai][bj][m][n] = __builtin_amdgcn_mfma_f32_16x16x32_bf16(Bt[n][k], At[m][k], acc[ai][bj][m][n], 0, 0, 0); __builtin_amdgcn_s_setprio(0); } while (0)
#define PG8_WAIT_V(n) asm volatile("s_waitcnt vmcnt(" #n ")" ::: "memory")
#define PG8_WAIT_L(n) asm volatile("s_waitcnt lgkmcnt(" #n ")" ::: "memory")
#define PG8_BAR __builtin_amdgcn_s_barrier()
#define PG8_SCHED __builtin_amdgcn_sched_barrier(0)
    Unit cur, nxt; int ui = 0;
    if (!Pb.next(0, cur)) return;
    f32x4 acc[2][2][4][2];
#pragma unroll
    for (int a = 0; a < 2; ++a)
#pragma unroll
        for (int b = 0; b < 2; ++b)
#pragma unroll
            for (int m = 0; m < 4; ++m)
#pragma unroll
                for (int n = 0; n < 2; ++n) acc[a][b][m][n] = (f32x4){0.f, 0.f, 0.f, 0.f};
    bf16x8 At[4][2], B0[2][2], B1[2][2];
    unsigned vA0[2], vA1[2];
    Pb.a_offs(0, cur, vA0, vA1, Rr, Cc);
    const char* cA = Pb.a_base(cur); const char* cB = Pb.b_base(cur);
    PG8_STAGE(PG8_SB(0, 0), cB, voffB); PG8_STAGE(PG8_SB(0, 1), cB + hstep, voffB); PG8_STAGE(PG8_SA(0, 0), cA, vA0); PG8_STAGE(PG8_SA(0, 1), cA, vA1);
    if (wr == 1) PG8_BAR;
    PG8_WAIT_V(2); PG8_BAR;
    PG8_STAGE(PG8_SB(1, 0), cB + kstep, voffB); PG8_STAGE(PG8_SA(1, 0), cA + kstep, vA0); PG8_STAGE(PG8_SB(1, 1), cB + hstep + kstep, voffB);
    PG8_WAIT_V(6); PG8_BAR;
    for (;;) {
        const bool has_next = Pb.next(ui + 1, nxt);
        const char* nA = has_next ? Pb.a_base(nxt) : cA; const char* nB = has_next ? Pb.b_base(nxt) : cB;
        for (int t = 0; t < nt; t += 2) {
            const bool last = (t == nt - 2);
            const char* a1 = cA + (size_t)(t + 1) * kstep;
            const char* a2 = last ? nA : cA + (size_t)(t + 2) * kstep; const char* b2 = last ? nB : cB + (size_t)(t + 2) * kstep;
            const char* a3 = a2 + kstep; const char* b3 = b2 + kstep;
            PG8_LDB(B0, 0, 0); PG8_LDB(B1, 0, 1); PG8_SCHED; PG8_LDA(At, 0, 0); PG8_STAGE(PG8_SA(1, 1), a1, vA1);
            PG8_WAIT_V(8); PG8_WAIT_L(0); PG8_BAR; PG8_MMA(0, 0, At, B0); PG8_MMA(0, 1, At, B1); PG8_BAR; PG8_SCHED;
            if (last && has_next) Pb.a_offs(ui + 1, nxt, vA0, vA1, Rr, Cc);
            PG8_LDA(At, 0, 1); PG8_STAGE(PG8_SB(0, 0), b2, voffB); PG8_STAGE(PG8_SB(0, 1), b2 + hstep, voffB); PG8_STAGE(PG8_SA(0, 0), a2, vA0);
            PG8_WAIT_V(8); PG8_WAIT_L(0); PG8_BAR; PG8_MMA(1, 0, At, B0); PG8_MMA(1, 1, At, B1); PG8_BAR; PG8_SCHED;
            PG8_LDB(B0, 1, 0); PG8_LDB(B1, 1, 1); PG8_SCHED; PG8_LDA(At, 1, 0); PG8_STAGE(PG8_SA(0, 1), a2, vA1);
            PG8_WAIT_V(8); PG8_WAIT_L(0); PG8_BAR; PG8_MMA(0, 0, At, B0); PG8_MMA(0, 1, At, B1); PG8_BAR; PG8_SCHED;
            PG8_LDA(At, 1, 1); PG8_STAGE(PG8_SB(1, 0), b3, voffB); PG8_STAGE(PG8_SB(1, 1), b3 + hstep, voffB); PG8_STAGE(PG8_SA(1, 0), a3, vA0);
            PG8_WAIT_V(8); PG8_WAIT_L(0); PG8_BAR; PG8_MMA(1, 0, At, B0); PG8_MMA(1, 1, At, B1); PG8_BAR; PG8_SCHED;
        }
        if (wr == 0) PG8_BAR;
        Pb.epi(acc, cur, wr, wc, fr, fq);
        if (!has_next) break;
#pragma unroll
        for (int a = 0; a < 2; ++a)
#pragma unroll
            for (int b = 0; b < 2; ++b)
#pragma unroll
                for (int m = 0; m < 4; ++m)
#pragma unroll
                    for (int n = 0; n < 2; ++n) acc[a][b][m][n] = (f32x4){0.f, 0.f, 0.f, 0.f};
        cur = nxt; cA = nA; cB = nB; ++ui;
        if (wr == 1) PG8_BAR;
    }
    PG8_WAIT_V(0);
    PG8_BAR;
#undef PG8_SA
#undef PG8_SB
#undef PG8_STAGE
#undef PG8_LDA
#undef PG8_LDB
#undef PG8_MMA
#undef PG8_WAIT_V
#undef PG8_WAIT_L
#undef PG8_BAR
#undef PG8_SCHED
}

__device__ __forceinline__ int moe_tables(LAS unsigned char* lds, const int* cnt) {
    LAS int* tile_e = (LAS int*)(lds + LDS_TILE_E); LAS int* tile_m = (LAS int*)(lds + LDS_TILE_M); LAS int* rts = (LAS int*)(lds + LDS_MISC + 32);
    if (tid_fresh() == 0) { int a = 0; for (int e = 0; e < NE; ++e) { const int n = (cnt[e] + 255) >> 8; for (int m = 0; m < n; ++m) { tile_e[a] = e; tile_m[a] = m; ++a; } } rts[0] = a; }
    __syncthreads();
    return rts[0];
}
}
namespace mk {
__device__ __forceinline__ float wsum(float v) {
#pragma unroll
    for (int o = 1; o < 64; o <<= 1) v += __shfl_xor(v, o);
    return v; }
__device__ __forceinline__ unsigned short f2bf(float f) { unsigned u = __float_as_uint(f); u += 0x7FFFu + ((u >> 16) & 1u); return (unsigned short)(u >> 16); }
}
namespace mk {
typedef float f32x16 __attribute__((ext_vector_type(16)));
typedef short s16x4 __attribute__((ext_vector_type(4)));
typedef __bf16 bf2_t __attribute__((ext_vector_type(2)));
typedef float f2_t __attribute__((ext_vector_type(2)));
#define MFMA32(a, b, c) __builtin_amdgcn_mfma_f32_32x32x16_bf16((a), (b), (c), 0, 0, 0)
constexpr float LOG2E = 1.4426950408889634f;
constexpr int PROJ_LD = NPROJ;
constexpr int AT_KBUF = 0, AT_VBUF = 16384, AT_IMPW = 32768, AT_SCORE = 65536, AT_OBUF = 73728, AT_OSTR = 1040, AT_BTAB = AT_OBUF + 64 * AT_OSTR  ,
              AT_SEL = AT_BTAB + 8 * 132 * 4  , AT_SSQ = AT_SEL + 512  , AT_END = AT_SSQ + 8 * 64 * 4  ;
struct AttnArgs { const bf16_t* projb; const bf16_t* kc; const bf16_t* vc; bf16_t* catb; };

__device__ __forceinline__ unsigned pk2(float a, float b) { f2_t v = {a, b}; return __builtin_bit_cast(unsigned, __builtin_convertvector(v, bf2_t)); }
__device__ __forceinline__ int t5_bucket(int n) { if (n < 0) n = 0; if (n < 16) return n; const float nf = (float)n; const int l = 16 + (int)(logf(nf / 16.f) / 2.0794415416798357f * 16.f); return l < 31 ? l : 31; }
__device__ __forceinline__ void stage_tile(LAS unsigned char* dst, const char* src, size_t row_stride, int wid, int lane, bool vswz) {
    const int row = 8 * wid + (lane >> 3), slot = lane & 7;
    const int f = vswz ? (((row >> 1) & 1) << 2) : ((row >> 1) & 7);
    __builtin_amdgcn_global_load_lds((const unsigned*)(src + (size_t)row * row_stride + ((slot ^ f) << 4)), (LAS unsigned*)(dst + wid * 1024), 16, 0, 0);
}
#define AT_CROW(r, h) (((r) & 3) + 8 * ((r) >> 2) + 4 * (h))
#define AT_PACK8(x, s) __builtin_bit_cast(bf16x8, (u32x4){pk2((x)[8 * (s)], (x)[8 * (s) + 1]), pk2((x)[8 * (s) + 2], (x)[8 * (s) + 3]), pk2((x)[8 * (s) + 4], (x)[8 * (s) + 5]), pk2((x)[8 * (s) + 6], (x)[8 * (s) + 7])})
__device__ __forceinline__ bf16x8 vt_frag(const LAS unsigned char* vt, unsigned vaddr, int rowoff) {
    const s16x4 lo = __builtin_amdgcn_ds_read_tr16_b64_v4i16((LAS s16x4*)(vt + vaddr + rowoff * 128));
    const s16x4 hi = __builtin_amdgcn_ds_read_tr16_b64_v4i16((LAS s16x4*)(vt + vaddr + (rowoff + 8) * 128));
    return __builtin_shufflevector(lo, hi, 0, 1, 2, 3, 4, 5, 6, 7);
}
template <bool FIRST>
__device__ __forceinline__ void obuf_acc(LAS unsigned char* lds, int tl, int hd, int h, float sc, const f32x16 (&oc)[2]) {
#pragma unroll
    for (int c = 0; c < 2; ++c)
#pragma unroll
        for (int qd = 0; qd < 4; ++qd) { LAS u32x2* p = (LAS u32x2*)(lds + AT_OBUF + tl * AT_OSTR + (hd * 64 + 32 * c + 8 * qd + 4 * h) * 2);
            float a0 = sc * oc[c][4 * qd], a1 = sc * oc[c][4 * qd + 1], a2 = sc * oc[c][4 * qd + 2], a3 = sc * oc[c][4 * qd + 3];
            if (!FIRST) { const u32x2 o = *p; a0 += __uint_as_float(o.x << 16); a1 += __uint_as_float(o.x & 0xffff0000u); a2 += __uint_as_float(o.y << 16); a3 += __uint_as_float(o.y & 0xffff0000u); }
            *p = (u32x2){pk2(a0, a1), pk2(a2, a3)}; }
}
template <int MODE>
__device__ __forceinline__ void attn_tile(const LAS unsigned char* Kt, const LAS unsigned char* Vt, int kbase, int tq, int t0, bool selbit, const bf16x8 (&qf)[4], const LAS float* bt, float cfar,
                                          f32x16 (&O)[2], float& m, float& l, int ql, int h, const unsigned (&vaddr)[2]) {
    f32x16 s0, s1;
#pragma unroll
    for (int r = 0; r < 16; ++r) { s0[r] = 0.f; s1[r] = 0.f; }
    const int fk = (ql >> 1) & 7;
#pragma unroll
    for (int s = 0; s < 4; ++s) { const int ch = ((2 * s + h) ^ fk) << 4;
        const bf16x8 k0 = *(const LAS bf16x8*)(Kt + ql * 128 + ch), k1 = *(const LAS bf16x8*)(Kt + (32 + ql) * 128 + ch);
        s0 = MFMA32(k0, qf[s], s0); s1 = MFMA32(k1, qf[s], s1); }
    const bool far = (kbase + 191 <= t0);
    float mx = -INFINITY;
#pragma unroll
    for (int r = 0; r < 16; ++r) {
        const int key0 = kbase + AT_CROW(r, h), key1 = key0 + 32;
        const int d0 = tq - key0, d1 = tq - key1;
        bool v0, v1;
        if (MODE == 0) { v0 = selbit && d0 >= 0; v1 = selbit && d1 >= 0; } else { v0 = d0 >= 0 && d0 < 512; v1 = d1 >= 0 && d1 < 512; }
        float b0, b1;
        if (far) { b0 = cfar; b1 = cfar; } else { b0 = bt[min(max(d0, 0), 128)]; b1 = bt[min(max(d1, 0), 128)]; }
        const float x0 = v0 ? s0[r] + b0 : -INFINITY, x1 = v1 ? s1[r] + b1 : -INFINITY;
        s0[r] = x0; s1[r] = x1; mx = fmaxf(mx, fmaxf(x0, x1));
    }
    mx = fmaxf(mx, __shfl_xor(mx, 32));
    const float mn = fmaxf(m, mx);
    const float alpha = __builtin_amdgcn_exp2f(m - mn);
    float ps = 0.f;
#pragma unroll
    for (int r = 0; r < 16; ++r) { const float p0 = __builtin_amdgcn_exp2f(s0[r] - mn), p1 = __builtin_amdgcn_exp2f(s1[r] - mn); s0[r] = p0; s1[r] = p1; ps += p0 + p1; }
    l = l * alpha + ps; m = mn;
    if (__any(alpha != 1.f)) {
#pragma unroll
        for (int r = 0; r < 16; ++r) { O[0][r] *= alpha; O[1][r] *= alpha; } }
#pragma unroll
    for (int sp = 0; sp < 2; ++sp) {
        const bf16x8 p0 = AT_PACK8(s0, sp), p1 = AT_PACK8(s1, sp);
#pragma unroll
        for (int c = 0; c < 2; ++c) { O[c] = MFMA32(vt_frag(Vt, vaddr[c], 16 * sp), p0, O[c]); O[c] = MFMA32(vt_frag(Vt, vaddr[c], 32 + 16 * sp), p1, O[c]); }
    }
}

__device__ __forceinline__ void attn_item(LAS unsigned char* lds, const AttnArgs& A, int b, int qt) {
    const int tid = tid_fresh(), wid = __builtin_amdgcn_readfirstlane(tid >> 6), lane = tid & 63;
    const int g = wid >> 1, th = wid & 1, ql = lane & 31, h = lane >> 5;
    const int t0 = qt * 64, tl = th * 32 + ql, tq = t0 + tl, blk = qt;
    const size_t rowq = (size_t)b * S + tq;
    const int qq = (lane & 15) >> 2, pp = lane & 3, lb = (lane >> 4) & 1;
    unsigned vaddr[2];
#pragma unroll
    for (int c = 0; c < 2; ++c) vaddr[c] = (unsigned)((4 * h + qq) * 128 + (((4 * (c ^ ((qq >> 1) & 1))) + 2 * lb + (pp >> 1)) << 4) + 8 * (pp & 1));
    LAS float* impw = (LAS float*)(lds + AT_IMPW); LAS float* score = (LAS float*)(lds + AT_SCORE); LAS unsigned* selm = (LAS unsigned*)(lds + AT_SEL);
    const char* prow0 = (const char*)(A.projb + (size_t)b * S * PROJ_LD);
    const size_t RS = (size_t)PROJ_LD * 2;
    for (int kvh = 0; kvh < 2; ++kvh) {
        const int hd = kvh * 4 + g;
        const LAS float* bt = (const LAS float*)(lds + AT_BTAB) + hd * 132;
        const float cfar = bt[128];
        bf16x8 qf[4];
#pragma unroll
        for (int s = 0; s < 4; ++s) qf[s] = *(const bf16x8*)(A.projb + rowq * PROJ_LD + hd * 64 + 16 * s + 8 * h);
        float gate[3];
#pragma unroll
        for (int j = 0; j < 3; ++j) { const float gv = bf2f(A.projb[rowq * PROJ_LD + 1280 + j * 8 + hd]); gate[j] = 1.f / (1.f + __expf(-gv)); }
        __syncthreads();
        { const char* kcb = (const char*)(A.kc + (size_t)(b * 2 + kvh) * 128 * 64); const char* vcb = (const char*)(A.vc + (size_t)(b * 2 + kvh) * 128 * 64);
          stage_tile(lds + AT_KBUF, kcb, 128, wid, lane, false); stage_tile(lds + AT_KBUF + 8192, kcb + 64 * 128, 128, wid, lane, false);
          stage_tile(lds + AT_VBUF, vcb, 128, wid, lane, true); stage_tile(lds + AT_VBUF + 8192, vcb + 64 * 128, 128, wid, lane, true); }
        asm volatile("s_waitcnt vmcnt(0)" ::: "memory"); __syncthreads();
        {
            f32x16 sc[4]; const int fk = (ql >> 1) & 7; int tqc = tq; asm volatile("" : "+v"(tqc));
#pragma unroll
            for (int kb = 0; kb < 4; ++kb) {
#pragma unroll
                for (int r = 0; r < 16; ++r) sc[kb][r] = 0.f;
#pragma unroll
                for (int s = 0; s < 4; ++s) { const bf16x8 kf = *(const LAS bf16x8*)(lds + AT_KBUF + (32 * kb + ql) * 128 + (((2 * s + h) ^ fk) << 4)); sc[kb] = MFMA32(kf, qf[s], sc[kb]); }
                __builtin_amdgcn_sched_barrier(0); }
            float mx = -INFINITY;
#pragma unroll
            for (int kb = 0; kb < 4; ++kb)
#pragma unroll
                for (int r = 0; r < 16; ++r) { const int c = 32 * kb + AT_CROW(r, h); const int dist = tqc - 16 * c - 31; const float bv = bt[min(max(dist, 0), 128)]; const float x = (dist >= 0) ? sc[kb][r] + bv : -INFINITY; sc[kb][r] = x; mx = fmaxf(mx, x);
                    if ((r & 7) == 7) __builtin_amdgcn_sched_barrier(0); }
            mx = fmaxf(mx, __shfl_xor(mx, 32));
            const float mref = (mx == -INFINITY) ? 0.f : mx;
            float ls = 0.f;
#pragma unroll
            for (int kb = 0; kb < 4; ++kb)
#pragma unroll
                for (int r = 0; r < 16; ++r) { const float p = __builtin_amdgcn_exp2f(sc[kb][r] - mref); sc[kb][r] = p; ls += p; }
            ls += __shfl_xor(ls, 32);
            const float inv = 1.f / fmaxf(ls, 1e-30f);
#pragma unroll
            for (int kb = 0; kb < 4; ++kb)
#pragma unroll
                for (int r = 0; r < 16; ++r) sc[kb][r] *= inv;
            { float carry = 0.f;
#pragma unroll
              for (int i = 0; i < 16; ++i) { const int kb = i >> 2, qd = i & 3;
                  const float s4 = (sc[kb][4 * qd] + sc[kb][4 * qd + 1]) + (sc[kb][4 * qd + 2] + sc[kb][4 * qd + 3]);
                  const float rv = __shfl_xor(sc[kb][4 * qd + 3], 32);
                  impw[(wid * 32 + ql) * 32 + 2 * i + h] = s4 + (h ? rv : carry); carry = rv; } }
            f32x16 oc[2];
#pragma unroll
            for (int r = 0; r < 16; ++r) { oc[0][r] = 0.f; oc[1][r] = 0.f; }
#pragma unroll
            for (int kb = 0; kb < 4; ++kb)
#pragma unroll
                for (int sp = 0; sp < 2; ++sp) { const bf16x8 pf = AT_PACK8(sc[kb], sp);
#pragma unroll
                    for (int c = 0; c < 2; ++c) oc[c] = MFMA32(vt_frag(lds + AT_VBUF, vaddr[c], 32 * kb + 16 * sp), pf, oc[c]);
                    __builtin_amdgcn_sched_barrier(0); }
            obuf_acc<true>(lds, tl, hd, h, gate[0], oc);
        }
        __syncthreads();
        int tids = tid; asm volatile("" : "+v"(tids));
#pragma unroll
        for (int i = 0; i < 4; ++i) { const int id = tids + 512 * i, tk = id >> 5, n = id & 31, w0 = tk >> 5, q = tk & 31;
            float v = 0.f;
#pragma unroll
            for (int gg = 0; gg < 4; ++gg) v += impw[((2 * gg + w0) * 32 + q) * 32 + n];
            const bool forced = (n == 0) || (n == blk) || (n == blk - 1);
            score[tk * 32 + n] = forced ? 1e4f : ((n <= blk) ? v : -1.f); }
        __syncthreads();
#pragma unroll
        for (int i = 0; i < 4; ++i) { const int id = tids + 512 * i, tk = id >> 5, n = id & 31;
            const float sn = score[tk * 32 + n]; int rank = 0;
            for (int mm = 0; mm < 32; ++mm) { const float s2 = score[tk * 32 + mm]; rank += (s2 > sn || (s2 == sn && mm < n)) ? 1 : 0; }
            const bool sel = (rank < 16) && (n <= blk);
            const unsigned long long bal = __ballot(sel);
            if (n == 0) selm[tk] = (unsigned)(bal >> (32 * (lane >> 5))); }
        __syncthreads();
        unsigned U = selm[lane];
#pragma unroll
        for (int o = 1; o < 64; o <<= 1) U |= (unsigned)__shfl_xor((int)U, o);
        U = (unsigned)__builtin_amdgcn_readfirstlane((int)U);
        const unsigned mysel = selm[tl];
        {
            f32x16 oc[2];
#pragma unroll
            for (int r = 0; r < 16; ++r) { oc[0][r] = 0.f; oc[1][r] = 0.f; }
            float m = -1e30f, l = 0.f;
            const char* kcol = prow0 + (512 + 2 * 128 + kvh * 64) * 2; const char* vcol = prow0 + (512 + 3 * 128 + kvh * 64) * 2;
            int n = __builtin_ctz(U | 0x80000000u), buf = 0;
            stage_tile(lds + AT_KBUF, kcol + (size_t)n * 64 * RS, RS, wid, lane, false); stage_tile(lds + AT_VBUF, vcol + (size_t)n * 64 * RS, RS, wid, lane, true);
            for (;;) {
                asm volatile("s_waitcnt vmcnt(0)" ::: "memory"); __syncthreads();
                const unsigned rest = (n >= 31) ? 0u : (U & ~((2u << n) - 1u));
                const int nn = rest ? __builtin_ctz(rest) : -1;
                if (nn >= 0) { stage_tile(lds + AT_KBUF + (buf ^ 1) * 8192, kcol + (size_t)nn * 64 * RS, RS, wid, lane, false); stage_tile(lds + AT_VBUF + (buf ^ 1) * 8192, vcol + (size_t)nn * 64 * RS, RS, wid, lane, true); }
                attn_tile<0>(lds + AT_KBUF + buf * 8192, lds + AT_VBUF + buf * 8192, n * 64, tq, t0, ((mysel >> n) & 1u) != 0u, qf, bt, cfar, oc, m, l, ql, h, vaddr);
                if (nn < 0) break;
                n = nn; buf ^= 1;
            }
            l += __shfl_xor(l, 32);
            const float sc1 = gate[1] / fmaxf(l, 1e-30f);
            obuf_acc<false>(lds, tl, hd, h, sc1, oc);
        }
        {
            f32x16 oc[2];
#pragma unroll
            for (int r = 0; r < 16; ++r) { oc[0][r] = 0.f; oc[1][r] = 0.f; }
            float m = -1e30f, l = 0.f;
            const char* kcol = prow0 + (512 + 4 * 128 + kvh * 64) * 2; const char* vcol = prow0 + (512 + 5 * 128 + kvh * 64) * 2;
            int n = (blk >= 8) ? blk - 8 : 0, buf = 0;
            __syncthreads();
            stage_tile(lds + AT_KBUF, kcol + (size_t)n * 64 * RS, RS, wid, lane, false); stage_tile(lds + AT_VBUF, vcol + (size_t)n * 64 * RS, RS, wid, lane, true);
            for (;;) {
                asm volatile("s_waitcnt vmcnt(0)" ::: "memory"); __syncthreads();
                const int nn = (n < blk) ? n + 1 : -1;
                if (nn >= 0) { stage_tile(lds + AT_KBUF + (buf ^ 1) * 8192, kcol + (size_t)nn * 64 * RS, RS, wid, lane, false); stage_tile(lds + AT_VBUF + (buf ^ 1) * 8192, vcol + (size_t)nn * 64 * RS, RS, wid, lane, true); }
                attn_tile<1>(lds + AT_KBUF + buf * 8192, lds + AT_VBUF + buf * 8192, n * 64, tq, t0, true, qf, bt, cfar, oc, m, l, ql, h, vaddr);
                if (nn < 0) break;
                n = nn; buf ^= 1;
            }
            l += __shfl_xor(l, 32);
            const float sc2 = gate[2] / fmaxf(l, 1e-30f);
            obuf_acc<false>(lds, tl, hd, h, sc2, oc);
        }
    }
    __syncthreads();
    int widn = wid; asm volatile("" : "+s"(widn));
#pragma unroll 1
    for (int i = 0; i < 8; ++i) { const int row = widn + 8 * i;
        const u32x4 v = *(const LAS u32x4*)(lds + AT_OBUF + row * AT_OSTR + lane * 16);
        float f[8]; f[0] = __uint_as_float(v.x << 16); f[1] = __uint_as_float(v.x & 0xffff0000u); f[2] = __uint_as_float(v.y << 16); f[3] = __uint_as_float(v.y & 0xffff0000u);
        f[4] = __uint_as_float(v.z << 16); f[5] = __uint_as_float(v.z & 0xffff0000u); f[6] = __uint_as_float(v.w << 16); f[7] = __uint_as_float(v.w & 0xffff0000u);
        float sq = 0.f;
#pragma unroll
        for (int j = 0; j < 8; ++j) sq += f[j] * f[j];
        sq = wsum(sq);
        const float rs = rsqrtf(sq * (1.f / 512.f) + 1e-6f);
        u32x4 w; w.x = pk2(f[0] * rs, f[1] * rs); w.y = pk2(f[2] * rs, f[3] * rs); w.z = pk2(f[4] * rs, f[5] * rs); w.w = pk2(f[6] * rs, f[7] * rs);
        *(u32x4*)(A.catb + ((size_t)b * S + t0 + row) * 1024 + lane * 8) = w; }
    __syncthreads();
}
__device__ __forceinline__ void attn_btab(LAS unsigned char* lds, const float* rel_bias) {
    LAS float* bt = (LAS float*)(lds + AT_BTAB);
    for (int i = threadIdx.x; i < 8 * 129; i += 512) { const int hd = i / 129, d = i % 129; bt[hd * 132 + d] = rel_bias[t5_bucket(d) * 8 + hd] * LOG2E; }
    __syncthreads();
}
__global__ __launch_bounds__(512, 2) void k_attn(AttnArgs A, const float* rel_bias) {
    extern __shared__ __attribute__((aligned(16))) unsigned char dl[];
    LAS unsigned char* lds = (LAS unsigned char*)dl;
    attn_btab(lds, rel_bias);
    for (int it = blockIdx.x; it < NB * 32; it += gridDim.x) attn_item(lds, A, it & 7, 31 - (it >> 3));
}
__global__ __launch_bounds__(256) void k_kvc_bf16(const float* kvc, bf16_t* kc, bf16_t* vc) {
    const int i = blockIdx.x * 256 + threadIdx.x; if (i >= 2 * NB * 2 * 128 * 64) return;
    const int d = i & 63, c = (i >> 6) & 127, kvh = (i >> 13) & 1, b = (i >> 14) & 7, z = i >> 17;
    const float v = (c < 127) ? kvc[((size_t)z * (NB * 127 * 2) + (size_t)(b * 127 + c) * 2 + kvh) * 64 + d] : 0.f;
    (z ? vc : kc)[((size_t)(b * 2 + kvh) * 128 + c) * 64 + d] = f2bf(v);
}
}
namespace mk {
constexpr int XBC_OFF = 1816, Z_OFF = 1304, DT_OFF = 2840, NCH = 16;
constexpr int SD_XS = 0, SD_B = 65536, SD_C = 98304, SD_ACS = 131072, SD_DT = SD_ACS + 2048, SD_W = SD_DT + 2048, SD_WP = SD_W + 2048  , SD_END = SD_WP + 256;
struct SsdArgs { const bf16_t* projb; const float* conv_w; const float* conv_b; const float* dt_bias; const float* a_log; const float* d_skip; bf16_t* states; float* alast; bf16_t* catb; };

__device__ __forceinline__ void ssd_dt_acs(LAS unsigned char* lds, const SsdArgs& A, int b, int c, int grp, int wid, int lane) {
    if (wid < 4) { const int hd = grp * 4 + wid; const float Ah = -__expf(A.a_log[hd]), db = A.dt_bias[hd];
        const size_t row = (size_t)b * S + c * 128 + 2 * lane;
        float x0 = bf2f(A.projb[row * PROJ_LD + DT_OFF + hd]) + db, x1 = bf2f(A.projb[(row + 1) * PROJ_LD + DT_OFF + hd]) + db;
        const float d0 = (x0 > 20.f) ? x0 : log1pf(__expf(x0)), d1 = (x1 > 20.f) ? x1 : log1pf(__expf(x1));
        const float a0 = d0 * Ah, a1 = d1 * Ah; float incl = a0 + a1;
#pragma unroll
        for (int o = 1; o < 64; o <<= 1) { const float t = __shfl_up(incl, o); if (lane >= o) incl += t; }
        LAS float* acs = (LAS float*)(lds + SD_ACS) + wid * 128; LAS float* dtl = (LAS float*)(lds + SD_DT) + wid * 128;
        acs[2 * lane] = incl - a1; acs[2 * lane + 1] = incl; dtl[2 * lane] = d0; dtl[2 * lane + 1] = d1; }
}
template <bool PHASE_A>
__device__ __forceinline__ void ssd_conv(LAS unsigned char* lds, const SsdArgs& A, int b, int c, int grp, int wid, int lane) {
    const int ch = lane;
    if (PHASE_A && ch >= 48) return;
    const int rel = (ch < 32) ? grp * 256 + ch * 8 : (ch < 48) ? 512 + grp * 128 + (ch - 32) * 8 : 768 + grp * 128 + (ch - 48) * 8;
    float w[4][8], bias[8];
#pragma unroll
    for (int k = 0; k < 4; ++k) { const f32x4 u0 = *(const f32x4*)(A.conv_w + k * 1024 + rel), u1 = *(const f32x4*)(A.conv_w + k * 1024 + rel + 4);
#pragma unroll
        for (int j = 0; j < 4; ++j) { w[k][j] = u0[j]; w[k][4 + j] = u1[j]; } }
    { const f32x4 u0 = *(const f32x4*)(A.conv_b + rel), u1 = *(const f32x4*)(A.conv_b + rel + 4);
#pragma unroll
      for (int j = 0; j < 4; ++j) { bias[j] = u0[j]; bias[4 + j] = u1[j]; } }
    const int tl0 = wid * 16, ts0 = c * 128 + tl0;
    const bf16_t* src = A.projb + ((size_t)b * S + ts0) * PROJ_LD + XBC_OFF + rel;
    float x0[8], x1[8], x2[8];
#pragma unroll
    for (int j = 0; j < 8; ++j) { x0[j] = 0.f; x1[j] = 0.f; x2[j] = 0.f; }
    if (ts0 >= 3) {
        const bf16x8 r0 = *(const bf16x8*)(src - 3 * (ptrdiff_t)PROJ_LD), r1 = *(const bf16x8*)(src - 2 * (ptrdiff_t)PROJ_LD), r2 = *(const bf16x8*)(src - 1 * (ptrdiff_t)PROJ_LD);
#pragma unroll
        for (int j = 0; j < 8; ++j) { x0[j] = bf2f((bf16_t)r0[j]); x1[j] = bf2f((bf16_t)r1[j]); x2[j] = bf2f((bf16_t)r2[j]); } }
    const LAS float* wt = (const LAS float*)(lds + SD_W) + (ch >> 3) * 128;
#pragma unroll 4
    for (int i = 0; i < 16; ++i) {
        const bf16x8 rv = *(const bf16x8*)(src + (size_t)i * PROJ_LD);
        float x3[8], o[8];
#pragma unroll
        for (int j = 0; j < 8; ++j) { x3[j] = bf2f((bf16_t)rv[j]); const float a = bias[j] + w[0][j] * x0[j] + w[1][j] * x1[j] + w[2][j] * x2[j] + w[3][j] * x3[j]; o[j] = a / (1.f + __expf(-a)); x0[j] = x1[j]; x1[j] = x2[j]; x2[j] = x3[j]; }
        const int row = tl0 + i;
        if (PHASE_A && ch < 32) { const float sc = wt[row];
#pragma unroll
            for (int j = 0; j < 8; ++j) o[j] *= sc; }
        u32x4 pk; pk.x = pk2(o[0], o[1]); pk.y = pk2(o[2], o[3]); pk.z = pk2(o[4], o[5]); pk.w = pk2(o[6], o[7]);
        if (ch < 32) *(LAS u32x4*)(lds + SD_XS + row * 512 + ((ch ^ ((row & 3) << 2)) << 4)) = pk;
        else if (ch < 48) { const int cc = ch - 32; *(LAS u32x4*)(lds + SD_B + row * 256 + ((PHASE_A ? (cc ^ ((row & 3) << 2)) : (cc ^ (row & 15))) << 4)) = pk; }
        else { const int cc = ch - 48; *(LAS u32x4*)(lds + SD_C + row * 256 + ((cc ^ (row & 15)) << 4)) = pk; }
    }
}
__device__ __forceinline__ bf16x8 tr_frag2(const LAS unsigned char* base, int stride, int r0, int r1, int chunk0, int qq, int pp) {
    const int cl = chunk0 + (pp >> 1);
    const s16x4 lo = __builtin_amdgcn_ds_read_tr16_b64_v4i16((LAS s16x4*)(base + (r0 + qq) * stride + ((cl ^ (qq << 2)) << 4) + 8 * (pp & 1)));
    const s16x4 hi = __builtin_amdgcn_ds_read_tr16_b64_v4i16((LAS s16x4*)(base + (r1 + qq) * stride + ((cl ^ (qq << 2)) << 4) + 8 * (pp & 1)));
    return __builtin_shufflevector(lo, hi, 0, 1, 2, 3, 4, 5, 6, 7);
}
__device__ __forceinline__ void ssd_a_item(LAS unsigned char* lds, const SsdArgs& A, int item) {
    const int tid = tid_fresh(), wid = __builtin_amdgcn_readfirstlane(tid >> 6), lane = tid & 63;
    const int grp = item & 1, c = (item >> 1) & 15, b = item >> 5;
    const int ql = lane & 31, h = lane >> 5, qq = (lane & 15) >> 2, pp = lane & 3, lb2 = (lane >> 4) & 1;
    __syncthreads();
    ssd_dt_acs(lds, A, b, c, grp, wid, lane);
    __syncthreads();
    { LAS float* acs = (LAS float*)(lds + SD_ACS); LAS float* dtl = (LAS float*)(lds + SD_DT); LAS float* wt = (LAS float*)(lds + SD_W);
      const int hh = tid >> 7, t = tid & 127; const float al = acs[hh * 128 + 127];
      wt[hh * 128 + t] = dtl[hh * 128 + t] * __expf(al - acs[hh * 128 + t]);
      if (t == 0) A.alast[(b * 8 + grp * 4 + hh) * NCH + c] = al; }
    __syncthreads();
    ssd_conv<true>(lds, A, b, c, grp, wid, lane);
    __syncthreads();
    const int pb = wid >> 2, nb = wid & 3;
#pragma unroll 1
    for (int hh = 0; hh < 4; ++hh) {
        f32x16 acc;
#pragma unroll
        for (int r = 0; r < 16; ++r) acc[r] = 0.f;
#pragma unroll
        for (int kk = 0; kk < 8; ++kk) {
            const bf16x8 af = tr_frag2(lds + SD_XS, 512, 16 * kk + 8 * h, 16 * kk + 8 * h + 4, hh * 8 + 4 * pb + 2 * lb2, qq, pp);
            const bf16x8 bf = tr_frag2(lds + SD_B, 256, 16 * kk + 8 * h, 16 * kk + 8 * h + 4, 4 * nb + 2 * lb2, qq, pp);
            acc = MFMA32(af, bf, acc); }
        bf16_t* st = A.states + ((size_t)((b * NCH + c) * 8 + grp * 4 + hh) * 64) * 128;
#pragma unroll
        for (int r = 0; r < 16; ++r) st[(32 * pb + AT_CROW(r, h)) * 128 + 32 * nb + ql] = f2bf(acc[r]);
    }
}
__device__ __forceinline__ void ssd_b_item(LAS unsigned char* lds, const SsdArgs& A, int item) {
    const int tid = tid_fresh(), wid = __builtin_amdgcn_readfirstlane(tid >> 6), lane = tid & 63;
    const int grp = item & 1, c = (item >> 1) & 15, b = item >> 5;
    const int ql = lane & 31, h = lane >> 5, qq = (lane & 15) >> 2, pp = lane & 3, lb2 = (lane >> 4) & 1;
    const int pb = wid >> 2, lb = wid & 3;
    LAS float* acs = (LAS float*)(lds + SD_ACS); LAS float* dtl = (LAS float*)(lds + SD_DT); LAS float* wp = (LAS float*)(lds + SD_WP);
    __syncthreads();
    ssd_dt_acs(lds, A, b, c, grp, wid, lane);
    if (tid >= 256 && tid < 320) { const int hh = (tid - 256) >> 4, cp = tid & 15; float s = 0.f;
        for (int c2 = cp + 1; c2 < c; ++c2) s += A.alast[(b * 8 + grp * 4 + hh) * NCH + c2];
        wp[hh * 16 + cp] = (cp < c) ? __expf(s) : 0.f; }
    ssd_conv<false>(lds, A, b, c, grp, wid, lane);
    __syncthreads();
    f32x16 X[4];
#pragma unroll
    for (int sb = 0; sb < 4; ++sb) {
#pragma unroll
        for (int r = 0; r < 16; ++r) X[sb][r] = 0.f;
        if (sb <= lb) {
#pragma unroll
            for (int kk = 0; kk < 8; ++kk) {
                const bf16x8 af = *(const LAS bf16x8*)(lds + SD_B + (32 * sb + ql) * 256 + (((2 * kk + h) ^ (ql & 15)) << 4));
                const bf16x8 bf = *(const LAS bf16x8*)(lds + SD_C + (32 * lb + ql) * 256 + (((2 * kk + h) ^ (ql & 15)) << 4));
                X[sb] = MFMA32(af, bf, X[sb]); } }
    }
    __syncthreads();
#pragma unroll 1
    for (int hh = 0; hh < 4; ++hh) {
        const int hd = grp * 4 + hh;
        { float pv[16];
#pragma unroll
          for (int j = 0; j < 16; ++j) pv[j] = 0.f;
          const int p = tid >> 3, n0 = (tid & 7) * 16;
          for (int cp = 0; cp < c; ++cp) { const float wgt = wp[hh * 16 + cp];
              const bf16_t* sp = A.states + ((size_t)((b * NCH + cp) * 8 + hd) * 64 + p) * 128 + n0;
              const bf16x8 s0 = *(const bf16x8*)sp, s1 = *(const bf16x8*)(sp + 8);
#pragma unroll
              for (int j = 0; j < 8; ++j) { pv[j] += wgt * bf2f((bf16_t)s0[j]); pv[8 + j] += wgt * bf2f((bf16_t)s1[j]); } }
          LAS unsigned char* pbuf = lds + SD_B + (hh & 1) * 16384 + p * 256;
          *(LAS u32x4*)(pbuf + ((((n0 >> 3)) ^ (p & 15)) << 4)) = (u32x4){pk2(pv[0], pv[1]), pk2(pv[2], pv[3]), pk2(pv[4], pv[5]), pk2(pv[6], pv[7])};
          *(LAS u32x4*)(pbuf + ((((n0 >> 3) + 1) ^ (p & 15)) << 4)) = (u32x4){pk2(pv[8], pv[9]), pk2(pv[10], pv[11]), pk2(pv[12], pv[13]), pk2(pv[14], pv[15])}; }
        __syncthreads();
        f32x16 acc;
#pragma unroll
        for (int r = 0; r < 16; ++r) acc[r] = 0.f;
#pragma unroll
        for (int kk = 0; kk < 8; ++kk) {
            const bf16x8 af = *(const LAS bf16x8*)(lds + SD_B + (hh & 1) * 16384 + (32 * pb + ql) * 256 + (((2 * kk + h) ^ (ql & 15)) << 4));
            const bf16x8 bf = *(const LAS bf16x8*)(lds + SD_C + (32 * lb + ql) * 256 + (((2 * kk + h) ^ (ql & 15)) << 4));
            acc = MFMA32(af, bf, acc); }
        const float al = acs[hh * 128 + 32 * lb + ql];
        { const float e = __expf(al);
#pragma unroll
          for (int r = 0; r < 16; ++r) acc[r] *= e; }
        const float Dh = A.d_skip[hd];
#pragma unroll
        for (int sb = 0; sb < 4; ++sb) {
            if (sb <= lb) {
                f32x16 Pm;
#pragma unroll
                for (int r = 0; r < 16; ++r) { const int sl = 32 * sb + AT_CROW(r, h), ll = 32 * lb + ql;
                    const float as = acs[hh * 128 + sl], ds = dtl[hh * 128 + sl];
                    float v = X[sb][r] * __expf(al - as) * ds; v = (sl <= ll) ? v : 0.f; v += (sl == ll) ? Dh : 0.f; Pm[r] = v; }
#pragma unroll
                for (int sp = 0; sp < 2; ++sp) { const bf16x8 pf = AT_PACK8(Pm, sp);
                    const bf16x8 af = tr_frag2(lds + SD_XS, 512, 32 * sb + 16 * sp + 4 * h, 32 * sb + 16 * sp + 8 + 4 * h, hh * 8 + 4 * pb + 2 * lb2, qq, pp);
                    acc = MFMA32(af, pf, acc); } }
        }
        { const bf16_t* zp = A.projb + ((size_t)b * S + c * 128 + 32 * lb + ql) * PROJ_LD + Z_OFF + hd * 64 + 32 * pb + 4 * h;
#pragma unroll
          for (int qd = 0; qd < 4; ++qd) { const u32x2 zz = *(const u32x2*)(zp + 8 * qd);
              const float z0 = __uint_as_float(zz.x << 16), z1 = __uint_as_float(zz.x & 0xffff0000u), z2 = __uint_as_float(zz.y << 16), z3 = __uint_as_float(zz.y & 0xffff0000u);
              acc[4 * qd] *= z0 / (1.f + __expf(-z0)); acc[4 * qd + 1] *= z1 / (1.f + __expf(-z1)); acc[4 * qd + 2] *= z2 / (1.f + __expf(-z2)); acc[4 * qd + 3] *= z3 / (1.f + __expf(-z3)); } }
        __syncthreads();
#pragma unroll
        for (int qd = 0; qd < 4; ++qd) { const int row = 32 * lb + ql, chn = hh * 8 + 4 * pb + qd;
            *(LAS u32x2*)(lds + SD_XS + row * 512 + ((chn ^ ((row & 3) << 2)) << 4) + 8 * h) = (u32x2){pk2(acc[4 * qd], acc[4 * qd + 1]), pk2(acc[4 * qd + 2], acc[4 * qd + 3])}; }
    }
    __syncthreads();
    int widn = wid; asm volatile("" : "+s"(widn));
#pragma unroll 1
    for (int i = 0; i < 16; ++i) { const int row = widn + 8 * i; const int chn = lane >> 1;
        const u32x2 v = *(const LAS u32x2*)(lds + SD_XS + row * 512 + ((chn ^ ((row & 3) << 2)) << 4) + 8 * (lane & 1));
        const float f0 = __uint_as_float(v.x << 16), f1 = __uint_as_float(v.x & 0xffff0000u), f2 = __uint_as_float(v.y << 16), f3 = __uint_as_float(v.y & 0xffff0000u);
        float sq = (f0 * f0 + f1 * f1) + (f2 * f2 + f3 * f3); sq = wsum(sq);
        const float rs = rsqrtf(sq * (1.f / 256.f) + 1e-6f);
        *(u32x2*)(A.catb + ((size_t)b * S + c * 128 + row) * 1024 + 512 + grp * 256 + lane * 4) = (u32x2){pk2(f0 * rs, f1 * rs), pk2(f2 * rs, f3 * rs)}; }
}
__global__ __launch_bounds__(512, 2) void k_ssd_a(SsdArgs A) {
    extern __shared__ __attribute__((aligned(16))) unsigned char dl[];
    for (int it = blockIdx.x; it < NB * NCH * 2; it += gridDim.x) ssd_a_item((LAS unsigned char*)dl, A, it);
}
__global__ __launch_bounds__(512, 2) void k_ssd_b(SsdArgs A) {
    extern __shared__ __attribute__((aligned(16))) unsigned char dl[];
    for (int it = blockIdx.x; it < NB * NCH * 2; it += gridDim.x) ssd_b_item((LAS unsigned char*)dl, A, it);
}
}
namespace mk {
__device__ __forceinline__ void rms_row_bf16(const float* xr, bf16_t* o, int lane) {
    f32x4 v[4]; float s = 0.f;
#pragma unroll
    for (int j = 0; j < 4; ++j) { v[j] = *(const f32x4*)(xr + lane * 4 + 256 * j); s += (v[j][0] * v[j][0] + v[j][1] * v[j][1]) + (v[j][2] * v[j][2] + v[j][3] * v[j][3]); }
    s = wsum(s); const float rs = rsqrtf(s * (1.f / 1024.f) + 1e-6f);
#pragma unroll
    for (int j = 0; j < 4; ++j) *(u32x2*)(o + lane * 4 + 256 * j) = (u32x2){pk2(v[j][0] * rs, v[j][1] * rs), pk2(v[j][2] * rs, v[j][3] * rs)};
}
constexpr int WT_PITCH = 68, WT_TILE_BYTES = 64 * WT_PITCH * 4;
__device__ __forceinline__ void wt_tile(const float* W, bf16_t* WT, const float* gk1, const float* gk2, int ksplit, int K, int N, int NP, int mode, int nscale, float sc, int ntn, int ntk,
                                        int tile, LAS float* tl, int lane) {
    const int per = ntn * ntk, z = tile / per, rem = tile % per, n0 = (rem % ntn) * 64, k0 = (rem / ntn) * 64;
    const float* Wz = W + (size_t)z * K * N; bf16_t* WTz = WT + (size_t)z * NP * K;
    const int lr = lane >> 4, lc = (lane & 15) * 4;
    f32x4 v[16];
#pragma unroll
    for (int i = 0; i < 16; ++i) { const int k = k0 + 4 * i + lr, n = n0 + lc; v[i] = (n < N) ? *(const f32x4*)(Wz + (size_t)k * N + n) : (f32x4){0.f, 0.f, 0.f, 0.f}; }
    if (gk1) {
#pragma unroll
        for (int i = 0; i < 16; ++i) { const int k = k0 + 4 * i + lr; const float g = (k < ksplit) ? gk1[k] : gk2[k - ksplit]; v[i] = v[i] * g; } }
#pragma unroll
    for (int i = 0; i < 16; ++i) *(LAS f32x4*)(tl + (4 * i + lr) * WT_PITCH + lc) = v[i];
    asm volatile("s_waitcnt lgkmcnt(0)" ::: "memory");
    const int nl = lane & 31, ch = lane >> 5;
#pragma unroll
    for (int half = 0; half < 2; ++half) { const int n = n0 + nl + 32 * half; const float s = (n < nscale) ? sc : 1.f;
        int nm = n; if (mode == 1) { const int up = n >> 10, jj = n & 1023; nm = (jj >> 7) * 256 + up * 128 + (jj & 127); }
#pragma unroll
        for (int cp = 0; cp < 4; ++cp) { const int c = 2 * cp + ch; const LAS float* src = tl + (8 * c) * WT_PITCH + nl + 32 * half;
            u32x4 w; w.x = pk2(src[0] * s, src[WT_PITCH] * s); w.y = pk2(src[2 * WT_PITCH] * s, src[3 * WT_PITCH] * s); w.z = pk2(src[4 * WT_PITCH] * s, src[5 * WT_PITCH] * s); w.w = pk2(src[6 * WT_PITCH] * s, src[7 * WT_PITCH] * s);
            *(u32x4*)(WTz + (size_t)nm * K + k0 + 8 * c) = w; } }
    asm volatile("s_waitcnt lgkmcnt(0)" ::: "memory");
}
constexpr int CP_KX = 0  , CP_RED = 69632  , CP_HID = CP_RED + 32768  , CP_END = CP_HID + 8192;
struct CmpArgs { const bf16_t* projb; const bf16_t* w1T; const float* posb; const float* w2; bf16_t* kc; bf16_t* vc; };
__device__ __forceinline__ void cmp_item(LAS unsigned char* lds, const CmpArgs& A, int item) {
    const int tid = tid_fresh(), wid = __builtin_amdgcn_readfirstlane(tid >> 6), lane = tid & 63, ql = lane & 31, h = lane >> 5;
    const int cblk = item & 3, kvh = (item >> 2) & 1, b = (item >> 3) & 7, j = item >> 6;
    __syncthreads();
    { const int tok0 = 512 * cblk; const bf16_t* src = A.projb + ((size_t)b * S + tok0) * PROJ_LD + 512 + j * 128 + kvh * 64;
      for (int i = tid; i < 528 * 8; i += 512) { const int r = i >> 3, ch = i & 7; u32x4 v = (u32x4){0u, 0u, 0u, 0u};
          if (tok0 + r < S) v = *(const u32x4*)(src + (size_t)r * PROJ_LD + ch * 8);
          *(LAS u32x4*)(lds + CP_KX + r * 128 + ((ch ^ ((r >> 4) & 7)) << 4)) = v; } }
    __syncthreads();
    const int nb = wid & 1, kq = wid >> 1;
    f32x16 acc;
#pragma unroll
    for (int r = 0; r < 16; ++r) acc[r] = 0.f;
    const bf16_t* wrow = A.w1T + ((size_t)j * 64 + 32 * nb + ql) * 2048;
#pragma unroll 2
    for (int li = 0; li < 8; ++li) { const int l = 8 * kq + li;
#pragma unroll
        for (int s = 0; s < 4; ++s) {
            const int row = 16 * ql + l;
            const bf16x8 af = *(const LAS bf16x8*)(lds + CP_KX + row * 128 + (((2 * s + h) ^ ((row >> 4) & 7)) << 4));
            const bf16x8 bf = *(const bf16x8*)(wrow + l * 64 + 16 * s + 8 * h);
            acc = MFMA32(af, bf, acc); } }
    { LAS float* red = (LAS float*)(lds + CP_RED) + kq * 2048;
#pragma unroll
      for (int r = 0; r < 16; ++r) red[AT_CROW(r, h) * 64 + 32 * nb + ql] = acc[r]; }
    __syncthreads();
    { LAS float* red = (LAS float*)(lds + CP_RED); LAS float* hid = (LAS float*)(lds + CP_HID);
      for (int i = tid; i < 2048; i += 512) { const float a = (red[i] + red[2048 + i]) + (red[4096 + i] + red[6144 + i]) + A.posb[j * 64 + (i & 63)]; hid[i] = a / (1.f + __expf(-a)); } }
    __syncthreads();
    { const LAS float* hid = (const LAS float*)(lds + CP_HID); bf16_t* out = (j ? A.vc : A.kc) + (size_t)(b * 2 + kvh) * 128 * 64;
      for (int i = tid; i < 2048; i += 512) { const int cl = i >> 6, n2 = i & 63; float a = 0.f;
#pragma unroll 8
          for (int n = 0; n < 64; ++n) a += hid[cl * 64 + n] * A.w2[(j * 64 + n) * 64 + n2];
          const int c = 32 * cblk + cl; out[c * 64 + n2] = (c < 127) ? f2bf(a) : (bf16_t)0; } }
}
constexpr int RT_RW = 0;
struct RouteArgs { const float* h1; const float* ffn_norm; const float* router_w; const float* router_b; bf16_t* hnb; int* cnt; int* list; float* wlist; int* tinfo; };
__device__ __forceinline__ void route_phase(LAS unsigned char* lds, const RouteArgs& A, int wg, int nwg) {
    const int tid = tid_fresh(), wid = __builtin_amdgcn_readfirstlane(tid >> 6), lane = tid & 63;
    LAS float* rw = (LAS float*)(lds + RT_RW);
    LAS int* lcnt = (LAS int*)(lds + 131072); LAS int* gbase = lcnt + 32; LAS int* nrec = lcnt + 64; LAS int* rec = (LAS int*)(lds + 131072 + 512);
    __syncthreads();
    { f32x4 t4[16];
#pragma unroll
      for (int i = 0; i < 16; ++i) t4[i] = *(const f32x4*)(A.router_w + (size_t)(tid + 512 * i) * 4);
#pragma unroll
      for (int i = 0; i < 16; ++i) { const int k = (tid + 512 * i) >> 3; *(LAS f32x4*)(rw + (size_t)(tid + 512 * i) * 4) = t4[i] * A.ffn_norm[k]; } }
    if (tid < 32) lcnt[tid] = 0;
    __syncthreads();
    int it = 0;
    for (int t = wg * 8 + wid; t < T; t += nwg * 8, ++it) {
        const float* xr = A.h1 + (size_t)t * D;
        f32x4 v[4]; float s = 0.f;
#pragma unroll
        for (int j = 0; j < 4; ++j) { v[j] = *(const f32x4*)(xr + lane * 4 + 256 * j); s += (v[j][0] * v[j][0] + v[j][1] * v[j][1]) + (v[j][2] * v[j][2] + v[j][3] * v[j][3]); }
        s = wsum(s); const float rs = rsqrtf(s * (1.f / 1024.f) + 1e-6f);
#pragma unroll
        for (int j = 0; j < 4; ++j) { v[j] = v[j] * rs; *(u32x2*)(A.hnb + (size_t)t * D + lane * 4 + 256 * j) = (u32x2){pk2(v[j][0], v[j][1]), pk2(v[j][2], v[j][3])}; }
        float pl[32];
#pragma unroll
        for (int e = 0; e < 32; ++e) pl[e] = 0.f;
#pragma unroll
        for (int j = 0; j < 4; ++j)
#pragma unroll
            for (int i = 0; i < 4; ++i) { const int k = lane * 4 + 256 * j + i; const float xv = v[j][i];
#pragma unroll
                for (int e4 = 0; e4 < 8; ++e4) { const f32x4 w4 = *(const LAS f32x4*)(rw + k * 32 + e4 * 4); pl[e4 * 4] += xv * w4[0]; pl[e4 * 4 + 1] += xv * w4[1]; pl[e4 * 4 + 2] += xv * w4[2]; pl[e4 * 4 + 3] += xv * w4[3]; }
                __builtin_amdgcn_sched_barrier(0); }
        float r16[16];
#pragma unroll
        for (int e = 0; e < 16; ++e) { const bool up = (lane & 32) != 0; const float keep = up ? pl[16 + e] : pl[e], send = up ? pl[e] : pl[16 + e]; r16[e] = keep + __shfl_xor(send, 32); }
        float r8[8];
#pragma unroll
        for (int e = 0; e < 8; ++e) { const bool up = (lane & 16) != 0; const float keep = up ? r16[8 + e] : r16[e], send = up ? r16[e] : r16[8 + e]; r8[e] = keep + __shfl_xor(send, 16); }
        float r4[4];
#pragma unroll
        for (int e = 0; e < 4; ++e) { const bool up = (lane & 8) != 0; const float keep = up ? r8[4 + e] : r8[e], send = up ? r8[e] : r8[4 + e]; r4[e] = keep + __shfl_xor(send, 8); }
        float r2[2];
#pragma unroll
        for (int e = 0; e < 2; ++e) { const bool up = (lane & 4) != 0; const float keep = up ? r4[2 + e] : r4[e], send = up ? r4[e] : r4[2 + e]; r2[e] = keep + __shfl_xor(send, 4); }
        float r1; { const bool up = (lane & 2) != 0; const float keep = up ? r2[1] : r2[0], send = up ? r2[0] : r2[1]; r1 = keep + __shfl_xor(send, 2); }
        r1 += __shfl_xor(r1, 1);
        const int ex = ((lane >> 5) & 1) * 16 + ((lane >> 4) & 1) * 8 + ((lane >> 3) & 1) * 4 + ((lane >> 2) & 1) * 2 + ((lane >> 1) & 1);
        float lg = r1 + A.router_b[ex];
        float tv[4]; int te[4];
#pragma unroll
        for (int k = 0; k < 4; ++k) { float m = lg;
#pragma unroll
            for (int o = 1; o < 64; o <<= 1) m = fmaxf(m, __shfl_xor(m, o));
            int cand = (lg == m) ? ex : 64;
#pragma unroll
            for (int o = 1; o < 64; o <<= 1) cand = min(cand, __shfl_xor(cand, o));
            tv[k] = m; te[k] = cand; if (ex == cand) lg = -INFINITY; }
        const float e1 = __expf(tv[1] - tv[0]), e2 = __expf(tv[2] - tv[0]), e3 = __expf(tv[3] - tv[0]); const float inv = 1.f / (1.f + e1 + e2 + e3);
        if (lane < 4) { const int ek = lane == 0 ? te[0] : lane == 1 ? te[1] : lane == 2 ? te[2] : te[3]; const float wk = (lane == 0 ? 1.f : lane == 1 ? e1 : lane == 2 ? e2 : e3) * inv;
            const int lp = __hip_atomic_fetch_add(lcnt + ek, 1, __ATOMIC_RELAXED, __HIP_MEMORY_SCOPE_WORKGROUP);
            const int n = (it * 8 + wid) * 4 + lane; if (n < 1024) { rec[n * 4] = t * 4 + lane; rec[n * 4 + 1] = ek; rec[n * 4 + 2] = lp; rec[n * 4 + 3] = (int)__float_as_uint(wk); } }
    }
    if (tid == 0) nrec[0] = 0;
    __syncthreads();
    if (tid < 32) gbase[tid] = (int)__hip_atomic_fetch_add((unsigned*)A.cnt + tid, (unsigned)lcnt[tid], __ATOMIC_RELAXED, __HIP_MEMORY_SCOPE_AGENT);
    if (lane == 0) __hip_atomic_fetch_max(nrec, it * 32, __ATOMIC_RELAXED, __HIP_MEMORY_SCOPE_WORKGROUP);
    __syncthreads();
    const int nr = nrec[0] < 1024 ? nrec[0] : 1024;
    for (int n = tid; n < nr; n += 512) { const int i2 = n >> 5, w2 = (n >> 2) & 7; const int t2 = wg * 8 + w2 + i2 * nwg * 8; if (t2 >= T) continue;
        const int tk = rec[n * 4], e = rec[n * 4 + 1], pos = gbase[e] + rec[n * 4 + 2];
        A.list[(size_t)e * T + pos] = tk; A.wlist[(size_t)e * T + pos] = __uint_as_float((unsigned)rec[n * 4 + 3]); A.tinfo[tk] = e | (pos << 8); }
}
struct CombArgs { const float* h1; const bf16_t* y; const int* tinfo; const int* cnt; const float* g; float* out; };
__device__ __forceinline__ void combine_phase(LAS unsigned char* lds, const CombArgs& A, int wg, int nwg) {
    const int tid = tid_fresh(), wid = __builtin_amdgcn_readfirstlane(tid >> 6), lane = tid & 63;
    LAS int* toff = (LAS int*)(lds + LDS_MISC + 64);
    __syncthreads();
    if (tid == 0) { int a = 0; for (int e = 0; e < NE; ++e) { toff[e] = a; a += (A.cnt[e] + 255) >> 8; } }
    __syncthreads();
    f32x4 gv[4];
#pragma unroll
    for (int j = 0; j < 4; ++j) gv[j] = *(const f32x4*)(A.g + lane * 4 + 256 * j);
    for (int t = wg * 8 + wid; t < T; t += nwg * 8) {
        size_t so[4];
#pragma unroll
        for (int k = 0; k < 4; ++k) { const int inf = A.tinfo[t * 4 + k]; so[k] = ((size_t)toff[inf & 255] * 256 + (inf >> 8)) * 1024; }
        f32x4 v[4]; float s = 0.f;
#pragma unroll
        for (int j = 0; j < 4; ++j) { v[j] = *(const f32x4*)(A.h1 + (size_t)t * D + lane * 4 + 256 * j);
#pragma unroll
            for (int k = 0; k < 4; ++k) { const u32x2 yy = *(const u32x2*)(A.y + so[k] + lane * 4 + 256 * j);
                v[j][0] += __uint_as_float(yy.x << 16); v[j][1] += __uint_as_float(yy.x & 0xffff0000u); v[j][2] += __uint_as_float(yy.y << 16); v[j][3] += __uint_as_float(yy.y & 0xffff0000u); }
            s += (v[j][0] * v[j][0] + v[j][1] * v[j][1]) + (v[j][2] * v[j][2] + v[j][3] * v[j][3]); }
        s = wsum(s); const float rs = rsqrtf(s * (1.f / 1024.f) + 1e-6f);
#pragma unroll
        for (int j = 0; j < 4; ++j) *(f32x4*)(A.out + (size_t)t * D + lane * 4 + 256 * j) = v[j] * rs * gv[j];
    }
}
}
#define XB_TMO      128
#define XB_XCNT(j)  (256  + 64 * (j))
#define XB_XSUB(j)  (1280 + 64 * (j))
#define XB_XGEN(j)  (2304 + 64 * (j))
#define XB_TOP      3328
#define XB_TOPGEN   3392
#define XCD_BAR_WORDS 3456
#define XB_SPIN_CAP (1u << 18)
__device__ __forceinline__ unsigned xb_ld(unsigned* p)              { return __hip_atomic_load(p, __ATOMIC_RELAXED, __HIP_MEMORY_SCOPE_AGENT); }
__device__ __forceinline__ unsigned xb_add(unsigned* p, unsigned v) { return __hip_atomic_fetch_add(p, v, __ATOMIC_RELAXED, __HIP_MEMORY_SCOPE_AGENT); }
__device__ __forceinline__ unsigned xb_xcc_id() { return (unsigned)__builtin_amdgcn_s_getreg((3 << 11) | 20) & 0xFu; }
#define XB_SPIN(cond, bar) do { unsigned _sp = 0; while (cond) { __builtin_amdgcn_s_sleep(1); \
    if ((++_sp & 255u) == 0u) { if (xb_ld(&(bar)[XB_TMO])) break; if (_sp > XB_SPIN_CAP) { atomicAdd(&(bar)[XB_TMO], 1u); break; } } } } while (0)
struct XcdBarrier { unsigned* bar; unsigned x; volatile LAS unsigned* st; };
__device__ __forceinline__ XcdBarrier xcd_barrier_post(unsigned* bar, volatile LAS unsigned* st) {
    XcdBarrier b; b.bar = bar; b.x = xb_xcc_id(); b.st = st;
    if (threadIdx.x == 0) (void)xb_add(&bar[XB_XCNT(b.x)], 1u);
    return b;
}
__device__ __forceinline__ void xcd_barrier_complete(unsigned* bar, unsigned x, unsigned& nloc, unsigned& nx) {
    const unsigned G = gridDim.x * gridDim.y * gridDim.z;
    unsigned sum, cnt, mine, sp = 0u;
    for (;;) {
        sum = 0u; cnt = 0u; mine = 0u;
#pragma unroll
        for (unsigned j = 0; j < 16; ++j) { const unsigned c = xb_ld(&bar[XB_XCNT(j)]); sum += c; cnt += (c > 0u) ? 1u : 0u; mine = (j == x) ? c : mine; }
        if (sum == G) break;
        __builtin_amdgcn_s_sleep(1);
        if ((++sp & 255u) == 0u) { if (xb_ld(&bar[XB_TMO])) break; if (sp > XB_SPIN_CAP) { atomicAdd(&bar[XB_TMO], 1u); break; } }
    }
    nloc = mine > 0u ? mine : 1u; nx = cnt > 0u ? cnt : 1u;
}
__device__ __forceinline__ void xcd_barrier(const XcdBarrier& b) {
    asm volatile("s_waitcnt vmcnt(0)" ::: "memory");
    __syncthreads();
    if (threadIdx.x == 0) {
        unsigned* bar = b.bar;
        __builtin_amdgcn_s_waitcnt(0);
        unsigned nloc = b.st[0], nx = b.st[1];
        if (nloc == 0u) { xcd_barrier_complete(bar, b.x, nloc, nx); b.st[0] = nloc; b.st[1] = nx; }
        const unsigned old = xb_add(&bar[XB_XSUB(b.x)], 1u);
        const unsigned gen = old / nloc;
        if (old + 1u == (gen + 1u) * nloc) {
            __builtin_amdgcn_fence(__ATOMIC_RELEASE, "agent");
            asm volatile("s_waitcnt vmcnt(0)" ::: "memory");
            const unsigned og = xb_add(&bar[XB_TOP], 1u);
            const unsigned tg = og / nx;
            if (og + 1u == (tg + 1u) * nx) xb_add(&bar[XB_TOPGEN], 1u);
            else XB_SPIN(xb_ld(&bar[XB_TOPGEN]) == tg, bar);
            __builtin_amdgcn_fence(__ATOMIC_ACQUIRE, "agent");
            xb_add(&bar[XB_XGEN(b.x)], 1u);
            asm volatile("s_waitcnt vmcnt(0)" ::: "memory");
        } else {
            XB_SPIN(xb_ld(&bar[XB_XGEN(b.x)]) == gen, bar);
            __builtin_amdgcn_fence(__ATOMIC_ACQUIRE, "agent");
            asm volatile("s_waitcnt vmcnt(0)" ::: "memory");
        }
    }
    __syncthreads();
}

namespace mk {
constexpr int LDS_BAR = 147456, LDS_FUSED = LDS_BAR + 256;
constexpr int CTL_QUEUE = 4096;
struct Params {
    const float *x, *attn_norm, *w_in, *rel_bias, *cmp_pos, *cmp_w1, *cmp_w2, *attn_out_norm, *conv_w, *conv_b, *dt_bias, *a_log, *d_skip, *ssm_out_norm, *w_out, *ffn_norm,
                *router_w, *router_b, *w_gu, *b_gu, *w_dn, *b_dn, *final_norm;
    float* out; unsigned* ctl; int* cnt;
    bf16_t *xb, *WinT, *WoutT, *WguT, *WdnT, *w1T, *projb, *catb, *hnb, *kc, *vc, *states, *act, *ymoe;
    float *posb, *alast, *h1, *wlist; int *list, *tinfo;
    int ph_lo, ph_hi;
};
constexpr int NT_WIN = 48 * 16, NT_WOUT = 16 * 16, NT_WGU = 32 * 32 * 16, NT_WDN = 32 * 16 * 16, NT_W1 = 2 * 32, NT_ALL = NT_WIN + NT_WOUT + NT_WGU + NT_WDN + NT_W1;
__device__ __forceinline__ void p0_prologue(LAS unsigned char* lds, const Params& p, int wg, int nwg) {
    const int tid = tid_fresh(), wid = __builtin_amdgcn_readfirstlane(tid >> 6), lane = tid & 63;
    for (int r = wg * 8 + wid; r < T; r += nwg * 8) rms_row_bf16(p.x + (size_t)r * D, p.xb + (size_t)r * D, lane);
    for (int o = wg * 8 + wid; o < 128; o += nwg * 8) { const int j = o >> 6, n = o & 63; float s = 0.f;
        for (int k = lane; k < 2048; k += 64) s += p.cmp_pos[j * 2048 + k] * p.cmp_w1[((size_t)j * 2048 + k) * 64 + n];
        s = wsum(s); if (lane == 0) p.posb[o] = s; }
    LAS float* tl = (LAS float*)(lds + wid * WT_TILE_BYTES);
    __syncthreads();
    for (int task = wg * 8 + wid; task < NT_ALL; task += nwg * 8) { int idx = task;
        if (idx < NT_WIN) { wt_tile(p.w_in, p.WinT, p.attn_norm, p.attn_norm, 1024, 1024, 2848, 3072, 0, 512, 0.125f * LOG2E, 48, 16, idx, tl, lane); continue; } idx -= NT_WIN;
        if (idx < NT_WOUT) { wt_tile(p.w_out, p.WoutT, p.attn_out_norm, p.ssm_out_norm, 512, 1024, 1024, 1024, 0, 0, 1.f, 16, 16, idx, tl, lane); continue; } idx -= NT_WOUT;
        if (idx < NT_WGU) { wt_tile(p.w_gu, p.WguT, p.ffn_norm, p.ffn_norm, 1024, 1024, 2048, 2048, 1, 0, 1.f, 32, 16, idx, tl, lane); continue; } idx -= NT_WGU;
        if (idx < NT_WDN) { wt_tile(p.w_dn, p.WdnT, nullptr, nullptr, 0, 1024, 1024, 1024, 0, 0, 1.f, 16, 16, idx, tl, lane); continue; } idx -= NT_WDN;
        wt_tile(p.cmp_w1, p.w1T, nullptr, nullptr, 0, 2048, 64, 64, 0, 0, 1.f, 1, 32, idx, tl, lane); }
}
__global__ void __launch_bounds__(512, 2) k_fused(Params p) {
    extern __shared__ __attribute__((aligned(16))) unsigned char dl[];
    LAS unsigned char* lds = (LAS unsigned char*)dl;
    const int wg = blockIdx.x, nwg = gridDim.x; int tid = tid_fresh();
    if (tid < 64) ((LAS unsigned*)(lds + LDS_BAR))[tid] = 0u;
    __syncthreads();
    XcdBarrier bar = xcd_barrier_post(p.ctl, (volatile LAS unsigned*)(lds + LDS_BAR));
#ifdef MK_ONLY
#define PH(k) ((k) == MK_ONLY && p.ph_lo <= (k) && (k) < p.ph_hi)
#else
#define PH(k) (p.ph_lo <= (k) && (k) < p.ph_hi)
#endif
#ifdef MK_REPEAT
#define REP(k) for (int _rep = 0; _rep < ((k) == MK_REPEAT ? 2 : 1); ++_rep)
#else
#define REP(k)
#endif
#ifdef MK_REPEAT
#define QREP _rep
#else
#define QREP 0
#endif
#define SEAM(k) do { if (PH(k) && PH((k) + 1)) xcd_barrier(bar); } while (0)
    REP(0) if (PH(0)) p0_prologue(lds, p, wg, nwg);
    SEAM(0);
    REP(1) if (PH(1)) { ProbProj P; P.S.init(T, NPROJ, nwg, wg); P.A = p.xb; P.Bt = p.WinT; P.O = p.projb; gemm_phase(lds, P); }
    SEAM(1);
    REP(2) if (PH(2)) {
        const SsdArgs SA{p.projb, p.conv_w, p.conv_b, p.dt_bias, p.a_log, p.d_skip, p.states, p.alast, p.catb};
        const CmpArgs CA{p.projb, p.w1T, p.posb, p.cmp_w2, p.kc, p.vc};
        for (int it = wg; it < 384; it += nwg) { const int v = 383 - it; if (v < 128) cmp_item(lds, CA, v); else ssd_a_item(lds, SA, v - 128); }
    }
    SEAM(2);
    REP(3) if (PH(3)) {
        tid = tid_fresh();
        const SsdArgs SA{p.projb, p.conv_w, p.conv_b, p.dt_bias, p.a_log, p.d_skip, p.states, p.alast, p.catb};
        const AttnArgs AA{p.projb, p.kc, p.vc, p.catb};
        attn_btab(lds, p.rel_bias);
        LAS int* qslot = (LAS int*)(lds + LDS_BAR + 64);
        for (;;) {
            __syncthreads();
            if (tid == 0) qslot[0] = (int)__hip_atomic_fetch_add(p.ctl + CTL_QUEUE + 64 * QREP, 1u, __ATOMIC_RELAXED, __HIP_MEMORY_SCOPE_AGENT);
            __syncthreads();
            const int it = qslot[0];
            if (it >= 512) break;
            if (it < 256) attn_item(lds, AA, it & 7, 31 - (it >> 3)); else ssd_b_item(lds, SA, it - 256);
        }
    }
    SEAM(3);
    REP(4) if (PH(4)) { ProbOut P; P.S.init(T, D, nwg, wg); P.A = p.catb; P.Bt = p.WoutT; P.R0 = p.x; P.O = p.h1; gemm_phase(lds, P); }
    SEAM(4);
    REP(5) if (PH(5)) { const bool dm = QREP != 0; const RouteArgs RA{p.h1, p.ffn_norm, p.router_w, p.router_b, p.hnb, dm ? p.cnt + 64 : p.cnt, dm ? (int*)p.act : p.list, dm ? (float*)p.act + (4u << 20) : p.wlist, dm ? (int*)p.act + (8u << 20) : p.tinfo}; route_phase(lds, RA, wg, nwg); }
    SEAM(5);
    REP(6) if (PH(6)) {
        tid = tid_fresh();
        __syncthreads();
        const int RT = moe_tables(lds, p.cnt);
        ProbMoe1 P; P.S.nN = 8; P.S.G = nwg; P.S.c = wg; P.S.RT = RT; P.S.tile_e = (const LAS int*)(lds + LDS_TILE_E); P.S.tile_m = (const LAS int*)(lds + LDS_TILE_M);
        P.A = p.hnb; P.Bt = p.WguT; P.bias = p.b_gu; P.O = p.act; P.rowtab = (const LAS unsigned*)(lds + LDS_ROWTAB);
        LAS unsigned* rowtab = (LAS unsigned*)(lds + LDS_ROWTAB);
#pragma unroll 1
        for (int i = 0; i < 12; ++i) { Unit u; if (!P.S.next(i, u)) break; if (tid < 256) { const int pos = u.mt * 256 + tid; const int c = p.cnt[u.e];
            const int tok = (pos < c) ? (p.list[(size_t)u.e * T + pos] >> 2) : 0; rowtab[i * 256 + tid] = (unsigned)tok * (KD * 2); } }
        __syncthreads();
        gemm_phase(lds, P);
    }
    SEAM(6);
    REP(7) if (PH(7)) {
        __syncthreads();
        const int RT = moe_tables(lds, p.cnt);
        ProbMoe2 P; P.S.nN = 4; P.S.G = nwg; P.S.c = wg; P.S.RT = RT; P.S.tile_e = (const LAS int*)(lds + LDS_TILE_E); P.S.tile_m = (const LAS int*)(lds + LDS_TILE_M);
        P.A = p.act; P.Bt = p.WdnT; P.bias = p.b_dn; P.wlist = p.wlist; P.O = p.ymoe;
        gemm_phase(lds, P);
    }
    SEAM(7);
    REP(8) if (PH(8)) { const CombArgs CA{p.h1, p.ymoe, p.tinfo, p.cnt, p.final_norm, p.out}; combine_phase(lds, CA, wg, nwg); }
#undef PH
#undef SEAM
}
}

extern "C" void kernel_launch(void* const* d_in, const int* in_sizes, int n_in, void* d_out, int out_size, void* d_ws, size_t ws_size, hipStream_t stream) {
    using namespace mk;
    char* ws = (char*)d_ws; const size_t MB = 1u << 20;
    size_t o = 0; auto take = [&](size_t mb) { char* q = ws + o; o += mb * MB; return q; };
    Params p;
    memset(&p, 0, sizeof(p));
    const float** fin = (const float**)&p.x;
    for (int i = 0; i < 23; ++i) fin[i] = (const float*)d_in[i];
    p.out = (float*)d_out;
    p.ctl = (unsigned*)take(1); p.cnt = (int*)(p.ctl + 8192);
    p.xb = (bf16_t*)take(32); p.WinT = (bf16_t*)take(6); p.WoutT = (bf16_t*)take(2); p.WguT = (bf16_t*)take(128); p.WdnT = (bf16_t*)take(64); p.w1T = (bf16_t*)take(1);
    p.projb = (bf16_t*)take(96); p.catb = (bf16_t*)take(32); p.hnb = (bf16_t*)take(32); p.kc = (bf16_t*)take(1); p.vc = (bf16_t*)take(1); p.states = (bf16_t*)take(16);
    p.act = (bf16_t*)take(144); p.ymoe = (bf16_t*)take(144);
    p.posb = (float*)take(1); p.alast = (float*)take(1); p.h1 = (float*)take(64); p.wlist = (float*)take(2); p.list = (int*)take(2); p.tinfo = (int*)take(1);
    static int grid = 0;
    if (!grid) {
        int dev = 0, cus = 0, per_cu = 0;
        (void)hipGetDevice(&dev); (void)hipDeviceGetAttribute(&cus, hipDeviceAttributeMultiprocessorCount, dev);
        (void)hipFuncSetAttribute((const void*)k_fused, hipFuncAttributeMaxDynamicSharedMemorySize, LDS_FUSED);
        (void)hipOccupancyMaxActiveBlocksPerMultiprocessor(&per_cu, (const void*)k_fused, 512, LDS_FUSED);
        (void)hipGetLastError();
        grid = cus > 0 ? cus : 256;
    }
    (void)hipMemsetAsync(p.ctl, 0, 65536, stream);
#ifndef MK_SPLIT
    p.ph_lo = 0; p.ph_hi = 9;
    hipLaunchKernelGGL(k_fused, dim3(grid), dim3(512), LDS_FUSED, stream, p);
#else
    for (int k = 0; k < 9; ++k) { p.ph_lo = k; p.ph_hi = k + 1; hipLaunchKernelGGL(k_fused, dim3(grid), dim3(512), LDS_FUSED, stream, p); }
#endif
}
```

```cpp
#include <hip/hip_runtime.h>
#include <stdint.h>
#include <string.h>
#include <math.h>
namespace mk {
#define LAS __attribute__((address_space(3)))
typedef unsigned short bf16_t;
typedef short bf16x8 __attribute__((ext_vector_type(8)));
typedef float f32x4 __attribute__((ext_vector_type(4)));
typedef unsigned u32x4 __attribute__((ext_vector_type(4)));
typedef unsigned u32x2 __attribute__((ext_vector_type(2)));
constexpr int NB = 8, S = 2048, D = 1024, T = NB * S, NE = 32;
constexpr int BM = 256, BK = 64, HALF = 128, HTB = HALF * BK * 2, STAGE_BYTES = 8 * HTB, NXCD = 8, WGM = 8;
constexpr int KD = 1024;
constexpr int NPROJ = 3072;
constexpr int MAXSLOT = 65536 + 32 * 256;
constexpr int LDS_MISC = 131072, LDS_TILE_E = LDS_MISC + 64, LDS_TILE_M = LDS_TILE_E + 1536, LDS_ROWTAB = LDS_MISC + 4096, LDS_BYTES = LDS_ROWTAB + 12 * 1024;

__host__ __device__ __forceinline__ int lds_byte(int r, int c) { const int st = (r >> 4) * 2 + (c >> 5), rr = r & 15, cc = c & 31, ob = rr * 64 + cc * 2; return st * 1024 + (ob ^ (((ob >> 9) & 1) << 5)); }
__host__ __device__ __forceinline__ void stage_rc(int b, int& R, int& C) { const int st = b / 1024, sb = b % 1024, swz = sb ^ (((sb >> 9) & 1) << 5); R = (st >> 1) * 16 + swz / 64; C = (st & 1) * 32 + (swz % 64) / 2; }
__host__ __device__ __forceinline__ int perm32(int rho) { const int n = rho >> 4, i = rho & 15; return 8 * (i >> 2) + 4 * n + (i & 3); }
__device__ __forceinline__ unsigned cvt_pk_bf16(float lo, float hi) { unsigned r; asm volatile("v_cvt_pk_bf16_f32 %0, %1, %2" : "=v"(r) : "v"(lo), "v"(hi)); return r; }
__device__ __forceinline__ int tid_fresh() { int t = threadIdx.x; asm volatile("" : "+v"(t)); return t; }
__device__ __forceinline__ float bf2f(bf16_t b) { return __uint_as_float(((unsigned)b) << 16); }

struct Unit { int pm, pn, e, mt; };
struct StaticOrder {
    int nM, nN, nwg, G, c;
    __device__ void init(int M, int N, int G_, int c_) { nM = M / BM; nN = N / BM; nwg = nM * nN; G = G_; c = c_; }
    __device__ bool next(int i, Unit& u) const {
        const long L = (long)i * G + c; if (L >= nwg) return false;
        int wgid = (int)L; { const int q = nwg / NXCD, r = nwg % NXCD, xcd = wgid % NXCD, off = wgid / NXCD; wgid = (xcd < r ? xcd * (q + 1) : r * (q + 1) + (xcd - r) * q) + off; }
        const int nig = WGM * nN, gid = wgid / nig, fm = gid * WGM, gsz = (nM - fm) < WGM ? (nM - fm) : WGM;
        u.pm = fm + ((wgid % nig) % gsz); u.pn = (wgid % nig) / gsz; u.e = 0; u.mt = 0; return true;
    }
};
struct MoeOrder {
    int nN, G, c, RT; const LAS int* tile_e; const LAS int* tile_m;
    __device__ bool next(int i, Unit& u) const { const int L = i * G + c; if (L >= RT * nN) return false; const int rt = L / nN; u.pm = rt; u.pn = L - rt * nN; u.e = tile_e[rt]; u.mt = tile_m[rt]; return true; }
};

struct ProbProj {
    static constexpr bool PERM = true, F8 = false; static constexpr int ROWB = KD * 2;
    StaticOrder S; const bf16_t* A; const bf16_t* Bt; bf16_t* O;
    __device__ __forceinline__ bool next(int i, Unit& u) const { return S.next(i, u); }
    __device__ __forceinline__ const char* a_base(const Unit& u) const { return (const char*)A + (size_t)u.pm * (BM * KD * 2); }
    __device__ __forceinline__ const char* b_base(const Unit& u) const { return (const char*)Bt + (size_t)u.pn * (BM * KD * 2); }
    __device__ __forceinline__ void a_offs(int, const Unit&, unsigned (&v0)[2], unsigned (&v1)[2], const int (&R)[2], const int (&C)[2]) const {
#pragma unroll
        for (int i = 0; i < 2; ++i) { v0[i] = (unsigned)(R[i] * KD + C[i]) * 2u; v1[i] = v0[i] + (unsigned)(HALF * KD * 2); } }
    __device__ __forceinline__ void epi(const f32x4 (&acc)[2][2][4][2], const Unit& u, int wr, int wc, int fr, int fq) const {
        const int row0 = u.pm * BM + wr * 64 + fr, col0 = u.pn * BM + wc * 32 + 8 * fq;
#pragma unroll
        for (int ai = 0; ai < 2; ++ai)
#pragma unroll
            for (int m = 0; m < 4; ++m) { bf16_t* rowp = O + (size_t)(row0 + ai * HALF + m * 16) * NPROJ + col0;
#pragma unroll
                for (int bj = 0; bj < 2; ++bj) { const f32x4 v0 = acc[ai][bj][m][0], v1 = acc[ai][bj][m][1]; u32x4 w;
                    w.x = cvt_pk_bf16(v0[0], v0[1]); w.y = cvt_pk_bf16(v0[2], v0[3]); w.z = cvt_pk_bf16(v1[0], v1[1]); w.w = cvt_pk_bf16(v1[2], v1[3]);
                    *(u32x4*)(rowp + bj * HALF) = w; } }
    }
};
struct ProbOut {
    static constexpr bool PERM = false, F8 = false; static constexpr int ROWB = KD * 2;
    StaticOrder S; const bf16_t* A; const bf16_t* Bt; const float* R0; float* O;
    __device__ __forceinline__ bool next(int i, Unit& u) const { return S.next(i, u); }
    __device__ __forceinline__ const char* a_base(const Unit& u) const { return (const char*)A + (size_t)u.pm * (BM * KD * 2); }
    __device__ __forceinline__ const char* b_base(const Unit& u) const { return (const char*)Bt + (size_t)u.pn * (BM * KD * 2); }
    __device__ __forceinline__ void a_offs(int, const Unit&, unsigned (&v0)[2], unsigned (&v1)[2], const int (&R)[2], const int (&C)[2]) const {
#pragma unroll
        for (int i = 0; i < 2; ++i) { v0[i] = (unsigned)(R[i] * KD + C[i]) * 2u; v1[i] = v0[i] + (unsigned)(HALF * KD * 2); } }
    __device__ __forceinline__ void epi(const f32x4 (&acc)[2][2][4][2], const Unit& u, int wr, int wc, int fr, int fq) const {
        const int row0 = u.pm * BM + wr * 64 + fr, col0 = u.pn * BM + wc * 32 + 4 * fq;
#pragma unroll
        for (int ai = 0; ai < 2; ++ai)
#pragma unroll
            for (int m = 0; m < 4; ++m) { const size_t off = (size_t)(row0 + ai * HALF + m * 16) * D + col0;
#pragma unroll
                for (int bj = 0; bj < 2; ++bj)
#pragma unroll
                    for (int n = 0; n < 2; ++n) { const f32x4 r = *(const f32x4*)(R0 + off + bj * HALF + n * 16); *(f32x4*)(O + off + bj * HALF + n * 16) = acc[ai][bj][m][n] + r; }
                asm volatile("" ::: "memory"); }
    }
};
typedef unsigned char f8_t;
typedef int i32x8 __attribute__((ext_vector_type(8)));
typedef int i32x4 __attribute__((ext_vector_type(4)));
constexpr float W8_SCALE = 32.f, W8_INV = 1.f / 32.f;
__device__ __forceinline__ unsigned pk4_fp8(float a, float b, float c, float d) { int r = __builtin_amdgcn_cvt_pk_fp8_f32(a, b, 0, false); r = __builtin_amdgcn_cvt_pk_fp8_f32(c, d, r, true); return (unsigned)r; }
struct ProbMoe1 {
    static constexpr bool PERM = true, F8 = true; static constexpr int ROWB = KD;
    MoeOrder S; const f8_t* A; const f8_t* Bt; const float* bias; f8_t* O; const LAS unsigned* rowtab;
    __device__ __forceinline__ bool next(int i, Unit& u) const { return S.next(i, u); }
    __device__ __forceinline__ const char* a_base(const Unit&) const { return (const char*)A; }
    __device__ __forceinline__ const char* b_base(const Unit& u) const { return (const char*)Bt + ((size_t)u.e * 2048 + (size_t)u.pn * BM) * ROWB; }
    __device__ __forceinline__ void a_offs(int i, const Unit&, unsigned (&v0)[2], unsigned (&v1)[2], const int (&R)[2], const int (&C)[2]) const {
#pragma unroll
        for (int j = 0; j < 2; ++j) { v0[j] = rowtab[i * 256 + R[j]] + (unsigned)C[j] * 2u; v1[j] = rowtab[i * 256 + HALF + R[j]] + (unsigned)C[j] * 2u; } }
    __device__ __forceinline__ void epi(const f32x4 (&acc)[2][2][4][2], const Unit& u, int wr, int wc, int fr, int fq) const {
        const int row0 = u.pm * BM + wr * 64 + fr, jg0 = u.pn * HALF + wc * 32 + 8 * fq;
        f32x4 bg[2], bu[2];
#pragma unroll
        for (int n = 0; n < 2; ++n) { bg[n] = *(const f32x4*)(bias + u.e * 2048 + jg0 + 4 * n); bu[n] = *(const f32x4*)(bias + u.e * 2048 + 1024 + jg0 + 4 * n); }
#pragma unroll
        for (int ai = 0; ai < 2; ++ai)
#pragma unroll
            for (int m = 0; m < 4; ++m) { float o[8];
#pragma unroll
                for (int n = 0; n < 2; ++n) { const f32x4 g4 = acc[ai][0][m][n] * W8_INV + bg[n], u4 = acc[ai][1][m][n] * W8_INV + bu[n];
#pragma unroll
                    for (int j = 0; j < 4; ++j) { const float g = fminf(g4[j], 7.f), uu = fminf(fmaxf(u4[j], -7.f), 7.f);
                        const float sg = __builtin_amdgcn_rcpf(1.f + __builtin_amdgcn_exp2f(-1.702f * 1.4426950408889634f * g)); o[n * 4 + j] = (uu + 1.f) * g * sg; } }
                *(u32x2*)(O + (size_t)(row0 + ai * HALF + m * 16) * 1024 + jg0) = (u32x2){pk4_fp8(o[0], o[1], o[2], o[3]), pk4_fp8(o[4], o[5], o[6], o[7])}; }
    }
};
struct ProbMoe2 {
    static constexpr bool PERM = true, F8 = true; static constexpr int ROWB = KD;
    MoeOrder S; const f8_t* A; const f8_t* Bt; const float* bias; bf16_t* O;
    __device__ __forceinline__ bool next(int i, Unit& u) const { return S.next(i, u); }
    __device__ __forceinline__ const char* a_base(const Unit& u) const { return (const char*)A + (size_t)u.pm * (BM * ROWB); }
    __device__ __forceinline__ const char* b_base(const Unit& u) const { return (const char*)Bt + ((size_t)u.e * 1024 + (size_t)u.pn * BM) * ROWB; }
    __device__ __forceinline__ void a_offs(int, const Unit&, unsigned (&v0)[2], unsigned (&v1)[2], const int (&R)[2], const int (&C)[2]) const {
#pragma unroll
        for (int i = 0; i < 2; ++i) { v0[i] = (unsigned)(R[i] * ROWB + C[i] * 2); v1[i] = v0[i] + (unsigned)(HALF * ROWB); } }
    __device__ __forceinline__ void epi(const f32x4 (&acc)[2][2][4][2], const Unit& u, int wr, int wc, int fr, int fq) const {
        const int rl0 = wr * 64 + fr, col0 = u.pn * BM + wc * 32 + 8 * fq;
#pragma unroll
        for (int ai = 0; ai < 2; ++ai)
#pragma unroll
            for (int m = 0; m < 4; ++m) { const int rl = rl0 + ai * HALF + m * 16;
                bf16_t* rowp = O + (size_t)(u.pm * BM + rl) * 1024 + col0;
#pragma unroll
                for (int bj = 0; bj < 2; ++bj) { const f32x4 b0 = *(const f32x4*)(bias + u.e * 1024 + col0 + bj * HALF), b1 = *(const f32x4*)(bias + u.e * 1024 + col0 + bj * HALF + 4);
                    const f32x4 v0 = acc[ai][bj][m][0] * W8_INV + b0, v1 = acc[ai][bj][m][1] * W8_INV + b1; u32x4 w;
                    w.x = cvt_pk_bf16(v0[0], v0[1]); w.y = cvt_pk_bf16(v0[2], v0[3]); w.z = cvt_pk_bf16(v1[0], v1[1]); w.w = cvt_pk_bf16(v1[2], v1[3]);
                    *(u32x4*)(rowp + bj * HALF) = w; }
                asm volatile("" ::: "memory"); }
    }
};

template <int N> struct FragBf { bf16x8 v[N][2];
    __device__ __forceinline__ void set(int i, int k, i32x4 x) { v[i][k] = __builtin_bit_cast(bf16x8, x); }
    __device__ __forceinline__ bf16x8 get(int i, int k) const { return v[i][k]; } };
template <int N> struct FragF8 { i32x8 v[N];
    __device__ __forceinline__ void set(int i, int k, i32x4 x) { if (k == 0) v[i].lo = x; else v[i].hi = x; }
    __device__ __forceinline__ bf16x8 get(int, int) const { return bf16x8{}; } };
template <bool F8> struct FragT { typedef FragBf<4> A_t; typedef FragBf<2> B_t; };
template <> struct FragT<true> { typedef FragF8<4> A_t; typedef FragF8<2> B_t; };
template <class P>
__device__ __forceinline__ void gemm_phase(LAS unsigned char* lds, const P& Pb) {
    const int tid = tid_fresh(), wid = __builtin_amdgcn_readfirstlane(tid >> 6), lane = tid & 63, wr = wid >> 2, wc = wid & 3, fr = lane & 15, fq = lane >> 4;
    constexpr int nt = P::ROWB / 128;
    int Rr[2], Cc[2]; unsigned voffB[2];
#pragma unroll
    for (int i = 0; i < 2; ++i) { int R, C; stage_rc(tid * 16 + i * 8192, R, C); const int Rb = P::PERM ? ((R & ~31) + perm32(R & 31)) : R; Rr[i] = R; Cc[i] = C; voffB[i] = (unsigned)(Rb * P::ROWB + C * 2); }
    constexpr size_t kstep = (size_t)(BK * 2);
    constexpr size_t hstep = (size_t)HALF * P::ROWB;
    const unsigned ldsw = (unsigned)wid * 1024u;
    const int aoff = lds_byte(wr * 64 + fr, fq * 8), boff = lds_byte(wc * 32 + fr, fq * 8);
#define PG8_SA(b, h) (((b) * 2 + (h)) * HTB)
#define PG8_SB(b, h) ((4 + (b) * 2 + (h)) * HTB)
#define PG8_STAGE(bufoff, gbase, voff) do { _Pragma("unroll") for (int _i = 0; _i < 2; ++_i) \
        __builtin_amdgcn_global_load_lds((const unsigned*)((const char*)(gbase) + (voff)[_i]), (LAS unsigned*)(lds + (bufoff) + ldsw + _i * 8192), 16, 0, 0); } while (0)
#define PG8_LDA(dst, b, h) do { _Pragma("unroll") for (int m = 0; m < 4; ++m) _Pragma("unroll") for (int k = 0; k < 2; ++k) dst.set(m, k, *(const LAS i32x4*)(lds + PG8_SA(b, h) + aoff + m * 2048 + k * 1024)); } while (0)
#define PG8_LDB(dst, b, h) do { _Pragma("unroll") for (int n = 0; n < 2; ++n) _Pragma("unroll") for (int k = 0; k < 2; ++k) dst.set(n, k, *(const LAS i32x4*)(lds + PG8_SB(b, h) + boff + n * 2048 + k * 1024)); } while (0)
#define PG8_MMA(ai, bj, At, Bt) do { __builtin_amdgcn_s_setprio(1); _Pragma("unroll") for (int m = 0; m < 4; ++m) _Pragma("unroll") for (int n = 0; n < 2; ++n) { \
        if constexpr (P::F8) acc[ai][bj][m][n] = __builtin_amdgcn_mfma_scale_f32_16x16x128_f8f6f4(Bt.v[n], At.v[m], acc[ai][bj][m][n], 0, 0, 0, 0x7f7f7f7f, 0, 0x7f7f7f7f); \
        else { _Pragma("unroll") for (int k = 0; k < 2; ++k) acc[ai][bj][m][n] = __builtin_amdgcn_mfma_f32_16x16x32_bf16(Bt.get(n, k), At.get(m, k), acc[ai][bj][m][n], 0, 0, 0); } } \
        __builtin_amdgcn_s_setprio(0); } while (0)
#define PG8_WAIT_V(n) asm volatile("s_waitcnt vmcnt(" #n ")" ::: "memory")
#define PG8_WAIT_L(n) asm volatile("s_waitcnt lgkmcnt(" #n ")" ::: "memory")
#define PG8_BAR __builtin_amdgcn_s_barrier()
#define PG8_SCHED __builtin_amdgcn_sched_barrier(0)
    Unit cur, nxt; int ui = 0;
    if (!Pb.next(0, cur)) return;
    f32x4 acc[2][2][4][2];
#pragma unroll
    for (int a = 0; a < 2; ++a)
#pragma unroll
        for (int b = 0; b < 2; ++b)
#pragma unroll
            for (int m = 0; m < 4; ++m)
#pragma unroll
                for (int n = 0; n < 2; ++n) acc[a][b][m][n] = (f32x4){0.f, 0.f, 0.f, 0.f};
    typedef typename FragT<P::F8>::A_t AFr; typedef typename FragT<P::F8>::B_t BFr;
    AFr At; BFr B0, B1;
    unsigned vA0[2], vA1[2];
    Pb.a_offs(0, cur, vA0, vA1, Rr, Cc);
    const char* cA = Pb.a_base(cur); const char* cB = Pb.b_base(cur);
    PG8_STAGE(PG8_SB(0, 0), cB, voffB); PG8_STAGE(PG8_SB(0, 1), cB + hstep, voffB); PG8_STAGE(PG8_SA(0, 0), cA, vA0); PG8_STAGE(PG8_SA(0, 1), cA, vA1);
    if (wr == 1) PG8_BAR;
    PG8_WAIT_V(2); PG8_BAR;
    PG8_STAGE(PG8_SB(1, 0), cB + kstep, voffB); PG8_STAGE(PG8_SA(1, 0), cA + kstep, vA0); PG8_STAGE(PG8_SB(1, 1), cB + hstep + kstep, voffB);
    PG8_WAIT_V(6); PG8_BAR;
    for (;;) {
        const bool has_next = Pb.next(ui + 1, nxt);
        const char* nA = has_next ? Pb.a_base(nxt) : cA; const char* nB = has_next ? Pb.b_base(nxt) : cB;
#pragma unroll 1
        for (int t = 0; t < nt; t += 2) {
            const bool last = (t == nt - 2);
            const char* a1 = cA + (size_t)(t + 1) * kstep;
            const char* a2 = last ? nA : cA + (size_t)(t + 2) * kstep; const char* b2 = last ? nB : cB + (size_t)(t + 2) * kstep;
            const char* a3 = a2 + kstep; const char* b3 = b2 + kstep;
            PG8_LDB(B0, 0, 0); PG8_LDB(B1, 0, 1); PG8_SCHED; PG8_LDA(At, 0, 0); PG8_STAGE(PG8_SA(1, 1), a1, vA1);
            PG8_WAIT_V(8); PG8_WAIT_L(0); PG8_BAR; PG8_MMA(0, 0, At, B0); PG8_MMA(0, 1, At, B1); PG8_BAR; PG8_SCHED;
            if (last && has_next) { int R2[2], C2[2]; int t2 = tid; asm volatile("" : "+v"(t2));
#pragma unroll
                for (int i = 0; i < 2; ++i) stage_rc(t2 * 16 + i * 8192, R2[i], C2[i]);
                Pb.a_offs(ui + 1, nxt, vA0, vA1, R2, C2); }
            PG8_LDA(At, 0, 1); PG8_STAGE(PG8_SB(0, 0), b2, voffB); PG8_STAGE(PG8_SB(0, 1), b2 + hstep, voffB); PG8_STAGE(PG8_SA(0, 0), a2, vA0);
            PG8_WAIT_V(8); PG8_WAIT_L(0); PG8_BAR; PG8_MMA(1, 0, At, B0); PG8_MMA(1, 1, At, B1); PG8_BAR; PG8_SCHED;
            PG8_LDB(B0, 1, 0); PG8_LDB(B1, 1, 1); PG8_SCHED; PG8_LDA(At, 1, 0); PG8_STAGE(PG8_SA(0, 1), a2, vA1);
            PG8_WAIT_V(8); PG8_WAIT_L(0); PG8_BAR; PG8_MMA(0, 0, At, B0); PG8_MMA(0, 1, At, B1); PG8_BAR; PG8_SCHED;
            PG8_LDA(At, 1, 1); PG8_STAGE(PG8_SB(1, 0), b3, voffB); PG8_STAGE(PG8_SB(1, 1), b3 + hstep, voffB); PG8_STAGE(PG8_SA(1, 0), a3, vA0);
            PG8_WAIT_V(8); PG8_WAIT_L(0); PG8_BAR; PG8_MMA(1, 0, At, B0); PG8_MMA(1, 1, At, B1); PG8_BAR; PG8_SCHED;
        }
        if (wr == 0) PG8_BAR;
        { int ln2 = lane; asm volatile("" : "+v"(ln2)); Pb.epi(acc, cur, wr, wc, ln2 & 15, ln2 >> 4); }
        if (!has_next) break;
#pragma unroll
        for (int a = 0; a < 2; ++a)
#pragma unroll
            for (int b = 0; b < 2; ++b)
#pragma unroll
                for (int m = 0; m < 4; ++m)
#pragma unroll
                    for (int n = 0; n < 2; ++n) acc[a][b][m][n] = (f32x4){0.f, 0.f, 0.f, 0.f};
        cur = nxt; cA = nA; cB = nB; ++ui;
        if (wr == 1) PG8_BAR;
    }
    PG8_WAIT_V(0);
    PG8_BAR;
#undef PG8_SA
#undef PG8_SB
#undef PG8_STAGE
#undef PG8_LDA
#undef PG8_LDB
#undef PG8_MMA
#undef PG8_WAIT_V
#undef PG8_WAIT_L
#undef PG8_BAR
#undef PG8_SCHED
}

__device__ __forceinline__ int moe_tables(LAS unsigned char* lds, const int* cnt) {
    LAS int* tile_e = (LAS int*)(lds + LDS_TILE_E); LAS int* tile_m = (LAS int*)(lds + LDS_TILE_M); LAS int* rts = (LAS int*)(lds + LDS_MISC + 32);
    if (tid_fresh() == 0) { int a = 0; for (int e = 0; e < NE; ++e) { const int n = (cnt[e] + 255) >> 8; for (int m = 0; m < n; ++m) { tile_e[a] = e; tile_m[a] = m; ++a; } } rts[0] = a; }
    __syncthreads();
    return rts[0];
}
}
namespace mk {
__device__ __forceinline__ float wsum(float v) {
#pragma unroll
    for (int o = 1; o < 64; o <<= 1) v += __shfl_xor(v, o);
    return v; }
__device__ __forceinline__ unsigned short f2bf(float f) { unsigned u = __float_as_uint(f); u += 0x7FFFu + ((u >> 16) & 1u); return (unsigned short)(u >> 16); }
}
namespace mk {
typedef float f32x16 __attribute__((ext_vector_type(16)));
typedef short s16x4 __attribute__((ext_vector_type(4)));
typedef __bf16 bf2_t __attribute__((ext_vector_type(2)));
typedef float f2_t __attribute__((ext_vector_type(2)));
#define MFMA32(a, b, c) __builtin_amdgcn_mfma_f32_32x32x16_bf16((a), (b), (c), 0, 0, 0)
constexpr float LOG2E = 1.4426950408889634f;
constexpr int PROJ_LD = NPROJ;
constexpr int AT_KBUF = 0, AT_VBUF = 16384, AT_IMPW = 32768, AT_SCORE = 65536, AT_OBUF = 73728, AT_OSTR = 1040, AT_BTAB = AT_OBUF + 64 * AT_OSTR  ,
              AT_SEL = AT_BTAB + 8 * 132 * 4  , AT_SSQ = AT_SEL + 512  , AT_END = AT_SSQ + 8 * 64 * 4  ;
struct AttnArgs { const bf16_t* projb; const bf16_t* kc; const bf16_t* vc; bf16_t* catb; };

__device__ __forceinline__ unsigned pk2(float a, float b) { f2_t v = {a, b}; return __builtin_bit_cast(unsigned, __builtin_convertvector(v, bf2_t)); }
__device__ __forceinline__ int t5_bucket(int n) { if (n < 0) n = 0; if (n < 16) return n; const float nf = (float)n; const int l = 16 + (int)(logf(nf / 16.f) / 2.0794415416798357f * 16.f); return l < 31 ? l : 31; }
__device__ __forceinline__ void stage_tile(LAS unsigned char* dst, const char* src, size_t row_stride, int wid, int lane, bool vswz) {
    const int row = 8 * wid + (lane >> 3), slot = lane & 7;
    const int f = vswz ? (((row >> 1) & 1) << 2) : ((row >> 1) & 7);
    __builtin_amdgcn_global_load_lds((const unsigned*)(src + (size_t)row * row_stride + ((slot ^ f) << 4)), (LAS unsigned*)(dst + wid * 1024), 16, 0, 0);
}
#define AT_CROW(r, h) (((r) & 3) + 8 * ((r) >> 2) + 4 * (h))
#define AT_PACK8(x, s) __builtin_bit_cast(bf16x8, (u32x4){pk2((x)[8 * (s)], (x)[8 * (s) + 1]), pk2((x)[8 * (s) + 2], (x)[8 * (s) + 3]), pk2((x)[8 * (s) + 4], (x)[8 * (s) + 5]), pk2((x)[8 * (s) + 6], (x)[8 * (s) + 7])})
__device__ __forceinline__ bf16x8 vt_frag(const LAS unsigned char* vt, unsigned vaddr, int rowoff) {
    const s16x4 lo = __builtin_amdgcn_ds_read_tr16_b64_v4i16((LAS s16x4*)(vt + vaddr + rowoff * 128));
    const s16x4 hi = __builtin_amdgcn_ds_read_tr16_b64_v4i16((LAS s16x4*)(vt + vaddr + (rowoff + 8) * 128));
    return __builtin_shufflevector(lo, hi, 0, 1, 2, 3, 4, 5, 6, 7);
}
template <bool FIRST>
__device__ __forceinline__ void obuf_acc(LAS unsigned char* lds, int tl, int hd, int h, float sc, const f32x16 (&oc)[2]) {
#pragma unroll
    for (int c = 0; c < 2; ++c)
#pragma unroll
        for (int qd = 0; qd < 4; ++qd) { LAS u32x2* p = (LAS u32x2*)(lds + AT_OBUF + tl * AT_OSTR + (hd * 64 + 32 * c + 8 * qd + 4 * h) * 2);
            float a0 = sc * oc[c][4 * qd], a1 = sc * oc[c][4 * qd + 1], a2 = sc * oc[c][4 * qd + 2], a3 = sc * oc[c][4 * qd + 3];
            if (!FIRST) { const u32x2 o = *p; a0 += __uint_as_float(o.x << 16); a1 += __uint_as_float(o.x & 0xffff0000u); a2 += __uint_as_float(o.y << 16); a3 += __uint_as_float(o.y & 0xffff0000u); }
            *p = (u32x2){pk2(a0, a1), pk2(a2, a3)}; }
}
template <int MODE>
__device__ __forceinline__ void attn_tile(const LAS unsigned char* Kt, const LAS unsigned char* Vt, int kbase, int tq, int t0, bool selbit, const bf16x8 (&qf)[4], const LAS float* bt, float cfar,
                                          f32x16 (&O)[2], float& m, float& l, int ql, int h, const unsigned (&vaddr)[2]) {
    f32x16 s0, s1;
#pragma unroll
    for (int r = 0; r < 16; ++r) { s0[r] = 0.f; s1[r] = 0.f; }
    const int fk = (ql >> 1) & 7;
#pragma unroll
    for (int s = 0; s < 4; ++s) { const int ch = ((2 * s + h) ^ fk) << 4;
        const bf16x8 k0 = *(const LAS bf16x8*)(Kt + ql * 128 + ch), k1 = *(const LAS bf16x8*)(Kt + (32 + ql) * 128 + ch);
        s0 = MFMA32(k0, qf[s], s0); s1 = MFMA32(k1, qf[s], s1); }
    const bool far = (kbase + 191 <= t0);
    float mx = -INFINITY;
#pragma unroll
    for (int r = 0; r < 16; ++r) {
        const int key0 = kbase + AT_CROW(r, h), key1 = key0 + 32;
        const int d0 = tq - key0, d1 = tq - key1;
        bool v0, v1;
        if (MODE == 0) { v0 = selbit && d0 >= 0; v1 = selbit && d1 >= 0; } else { v0 = d0 >= 0 && d0 < 512; v1 = d1 >= 0 && d1 < 512; }
        float b0, b1;
        if (far) { b0 = cfar; b1 = cfar; } else { b0 = bt[min(max(d0, 0), 128)]; b1 = bt[min(max(d1, 0), 128)]; }
        const float x0 = v0 ? s0[r] + b0 : -INFINITY, x1 = v1 ? s1[r] + b1 : -INFINITY;
        s0[r] = x0; s1[r] = x1; mx = fmaxf(mx, fmaxf(x0, x1));
    }
    mx = fmaxf(mx, __shfl_xor(mx, 32));
    const float mn = fmaxf(m, mx);
    const float alpha = __builtin_amdgcn_exp2f(m - mn);
    float ps = 0.f;
#pragma unroll
    for (int r = 0; r < 16; ++r) { const float p0 = __builtin_amdgcn_exp2f(s0[r] - mn), p1 = __builtin_amdgcn_exp2f(s1[r] - mn); s0[r] = p0; s1[r] = p1; ps += p0 + p1; }
    l = l * alpha + ps; m = mn;
    if (__any(alpha != 1.f)) {
#pragma unroll
        for (int r = 0; r < 16; ++r) { O[0][r] *= alpha; O[1][r] *= alpha; } }
#pragma unroll
    for (int sp = 0; sp < 2; ++sp) {
        const bf16x8 p0 = AT_PACK8(s0, sp), p1 = AT_PACK8(s1, sp);
#pragma unroll
        for (int c = 0; c < 2; ++c) { O[c] = MFMA32(vt_frag(Vt, vaddr[c], 16 * sp), p0, O[c]); O[c] = MFMA32(vt_frag(Vt, vaddr[c], 32 + 16 * sp), p1, O[c]); }
    }
}

__device__ __forceinline__ void attn_item(LAS unsigned char* lds, const AttnArgs& A, int b, int qt) {
    const int tid = tid_fresh(), wid = __builtin_amdgcn_readfirstlane(tid >> 6), lane = tid & 63;
    const int g = wid >> 1, th = wid & 1, ql = lane & 31, h = lane >> 5;
    const int t0 = qt * 64, tl = th * 32 + ql, tq = t0 + tl, blk = qt;
    const size_t rowq = (size_t)b * S + tq;
    const int qq = (lane & 15) >> 2, pp = lane & 3, lb = (lane >> 4) & 1;
    unsigned vaddr[2];
#pragma unroll
    for (int c = 0; c < 2; ++c) vaddr[c] = (unsigned)((4 * h + qq) * 128 + (((4 * (c ^ ((qq >> 1) & 1))) + 2 * lb + (pp >> 1)) << 4) + 8 * (pp & 1));
    LAS float* impw = (LAS float*)(lds + AT_IMPW); LAS float* score = (LAS float*)(lds + AT_SCORE); LAS unsigned* selm = (LAS unsigned*)(lds + AT_SEL);
    const char* prow0 = (const char*)(A.projb + (size_t)b * S * PROJ_LD);
    const size_t RS = (size_t)PROJ_LD * 2;
    for (int kvh = 0; kvh < 2; ++kvh) {
        const int hd = kvh * 4 + g;
        const LAS float* bt = (const LAS float*)(lds + AT_BTAB) + hd * 132;
        const float cfar = bt[128];
        bf16x8 qf[4];
#pragma unroll
        for (int s = 0; s < 4; ++s) qf[s] = *(const bf16x8*)(A.projb + rowq * PROJ_LD + hd * 64 + 16 * s + 8 * h);
        float gate[3];
#pragma unroll
        for (int j = 0; j < 3; ++j) { const float gv = bf2f(A.projb[rowq * PROJ_LD + 1280 + j * 8 + hd]); gate[j] = 1.f / (1.f + __expf(-gv)); }
        __syncthreads();
        { const char* kcb = (const char*)(A.kc + (size_t)(b * 2 + kvh) * 128 * 64); const char* vcb = (const char*)(A.vc + (size_t)(b * 2 + kvh) * 128 * 64);
          stage_tile(lds + AT_KBUF, kcb, 128, wid, lane, false); stage_tile(lds + AT_KBUF + 8192, kcb + 64 * 128, 128, wid, lane, false);
          stage_tile(lds + AT_VBUF, vcb, 128, wid, lane, true); stage_tile(lds + AT_VBUF + 8192, vcb + 64 * 128, 128, wid, lane, true); }
        asm volatile("s_waitcnt vmcnt(0)" ::: "memory"); __syncthreads();
        {
            f32x16 sc[4]; const int fk = (ql >> 1) & 7; int tqc = tq; asm volatile("" : "+v"(tqc));
#pragma unroll
            for (int kb = 0; kb < 4; ++kb) {
#pragma unroll
                for (int r = 0; r < 16; ++r) sc[kb][r] = 0.f;
#pragma unroll
                for (int s = 0; s < 4; ++s) { const bf16x8 kf = *(const LAS bf16x8*)(lds + AT_KBUF + (32 * kb + ql) * 128 + (((2 * s + h) ^ fk) << 4)); sc[kb] = MFMA32(kf, qf[s], sc[kb]); }
                __builtin_amdgcn_sched_barrier(0); }
            float mx = -INFINITY;
#pragma unroll
            for (int kb = 0; kb < 4; ++kb)
#pragma unroll
                for (int r = 0; r < 16; ++r) { const int c = 32 * kb + AT_CROW(r, h); const int dist = tqc - 16 * c - 31; const float bv = bt[min(max(dist, 0), 128)]; const float x = (dist >= 0) ? sc[kb][r] + bv : -INFINITY; sc[kb][r] = x; mx = fmaxf(mx, x);
                    if ((r & 7) == 7) __builtin_amdgcn_sched_barrier(0); }
            mx = fmaxf(mx, __shfl_xor(mx, 32));
            const float mref = (mx == -INFINITY) ? 0.f : mx;
            float ls = 0.f;
#pragma unroll
            for (int kb = 0; kb < 4; ++kb)
#pragma unroll
                for (int r = 0; r < 16; ++r) { const float p = __builtin_amdgcn_exp2f(sc[kb][r] - mref); sc[kb][r] = p; ls += p; }
            ls += __shfl_xor(ls, 32);
            const float inv = 1.f / fmaxf(ls, 1e-30f);
#pragma unroll
            for (int kb = 0; kb < 4; ++kb)
#pragma unroll
                for (int r = 0; r < 16; ++r) sc[kb][r] *= inv;
            { float carry = 0.f;
#pragma unroll
              for (int i = 0; i < 16; ++i) { const int kb = i >> 2, qd = i & 3;
                  const float s4 = (sc[kb][4 * qd] + sc[kb][4 * qd + 1]) + (sc[kb][4 * qd + 2] + sc[kb][4 * qd + 3]);
                  const float rv = __shfl_xor(sc[kb][4 * qd + 3], 32);
                  impw[(wid * 32 + ql) * 32 + 2 * i + h] = s4 + (h ? rv : carry); carry = rv; } }
            f32x16 oc[2];
#pragma unroll
            for (int r = 0; r < 16; ++r) { oc[0][r] = 0.f; oc[1][r] = 0.f; }
#pragma unroll
            for (int kb = 0; kb < 4; ++kb)
#pragma unroll
                for (int sp = 0; sp < 2; ++sp) { const bf16x8 pf = AT_PACK8(sc[kb], sp);
#pragma unroll
                    for (int c = 0; c < 2; ++c) oc[c] = MFMA32(vt_frag(lds + AT_VBUF, vaddr[c], 32 * kb + 16 * sp), pf, oc[c]);
                    __builtin_amdgcn_sched_barrier(0); }
            obuf_acc<true>(lds, tl, hd, h, gate[0], oc);
        }
        __syncthreads();
        int tids = tid; asm volatile("" : "+v"(tids));
#pragma unroll
        for (int i = 0; i < 4; ++i) { const int id = tids + 512 * i, tk = id >> 5, n = id & 31, w0 = tk >> 5, q = tk & 31;
            float v = 0.f;
#pragma unroll
            for (int gg = 0; gg < 4; ++gg) v += impw[((2 * gg + w0) * 32 + q) * 32 + n];
            const bool forced = (n == 0) || (n == blk) || (n == blk - 1);
            score[tk * 32 + n] = forced ? 1e4f : ((n <= blk) ? v : -1.f); }
        __syncthreads();
#pragma unroll
        for (int i = 0; i < 4; ++i) { const int id = tids + 512 * i, tk = id >> 5, n = id & 31;
            const float sn = score[tk * 32 + n]; int rank = 0;
            for (int mm = 0; mm < 32; ++mm) { const float s2 = score[tk * 32 + mm]; rank += (s2 > sn || (s2 == sn && mm < n)) ? 1 : 0; }
            const bool sel = (rank < 16) && (n <= blk);
            const unsigned long long bal = __ballot(sel);
            if (n == 0) selm[tk] = (unsigned)(bal >> (32 * (lane >> 5))); }
        __syncthreads();
        unsigned U = selm[lane];
#pragma unroll
        for (int o = 1; o < 64; o <<= 1) U |= (unsigned)__shfl_xor((int)U, o);
        U = (unsigned)__builtin_amdgcn_readfirstlane((int)U);
        const unsigned mysel = selm[tl];
        {
            f32x16 oc[2];
#pragma unroll
            for (int r = 0; r < 16; ++r) { oc[0][r] = 0.f; oc[1][r] = 0.f; }
            float m = -1e30f, l = 0.f;
            const char* kcol = prow0 + (512 + 2 * 128 + kvh * 64) * 2; const char* vcol = prow0 + (512 + 3 * 128 + kvh * 64) * 2;
            int n = __builtin_ctz(U | 0x80000000u), buf = 0;
            stage_tile(lds + AT_KBUF, kcol + (size_t)n * 64 * RS, RS, wid, lane, false); stage_tile(lds + AT_VBUF, vcol + (size_t)n * 64 * RS, RS, wid, lane, true);
            for (;;) {
                asm volatile("s_waitcnt vmcnt(0)" ::: "memory"); __syncthreads();
                const unsigned rest = (n >= 31) ? 0u : (U & ~((2u << n) - 1u));
                const int nn = rest ? __builtin_ctz(rest) : -1;
                if (nn >= 0) { stage_tile(lds + AT_KBUF + (buf ^ 1) * 8192, kcol + (size_t)nn * 64 * RS, RS, wid, lane, false); stage_tile(lds + AT_VBUF + (buf ^ 1) * 8192, vcol + (size_t)nn * 64 * RS, RS, wid, lane, true); }
                attn_tile<0>(lds + AT_KBUF + buf * 8192, lds + AT_VBUF + buf * 8192, n * 64, tq, t0, ((mysel >> n) & 1u) != 0u, qf, bt, cfar, oc, m, l, ql, h, vaddr);
                if (nn < 0) break;
                n = nn; buf ^= 1;
            }
            l += __shfl_xor(l, 32);
            const float sc1 = gate[1] / fmaxf(l, 1e-30f);
            obuf_acc<false>(lds, tl, hd, h, sc1, oc);
        }
        {
            f32x16 oc[2];
#pragma unroll
            for (int r = 0; r < 16; ++r) { oc[0][r] = 0.f; oc[1][r] = 0.f; }
            float m = -1e30f, l = 0.f;
            const char* kcol = prow0 + (512 + 4 * 128 + kvh * 64) * 2; const char* vcol = prow0 + (512 + 5 * 128 + kvh * 64) * 2;
            int n = (blk >= 8) ? blk - 8 : 0, buf = 0;
            __syncthreads();
            stage_tile(lds + AT_KBUF, kcol + (size_t)n * 64 * RS, RS, wid, lane, false); stage_tile(lds + AT_VBUF, vcol + (size_t)n * 64 * RS, RS, wid, lane, true);
            for (;;) {
                asm volatile("s_waitcnt vmcnt(0)" ::: "memory"); __syncthreads();
                const int nn = (n < blk) ? n + 1 : -1;
                if (nn >= 0) { stage_tile(lds + AT_KBUF + (buf ^ 1) * 8192, kcol + (size_t)nn * 64 * RS, RS, wid, lane, false); stage_tile(lds + AT_VBUF + (buf ^ 1) * 8192, vcol + (size_t)nn * 64 * RS, RS, wid, lane, true); }
                attn_tile<1>(lds + AT_KBUF + buf * 8192, lds + AT_VBUF + buf * 8192, n * 64, tq, t0, true, qf, bt, cfar, oc, m, l, ql, h, vaddr);
                if (nn < 0) break;
                n = nn; buf ^= 1;
            }
            l += __shfl_xor(l, 32);
            const float sc2 = gate[2] / fmaxf(l, 1e-30f);
            obuf_acc<false>(lds, tl, hd, h, sc2, oc);
        }
    }
    __syncthreads();
    int widn = wid; asm volatile("" : "+s"(widn));
#pragma unroll 1
    for (int i = 0; i < 8; ++i) { const int row = widn + 8 * i;
        const u32x4 v = *(const LAS u32x4*)(lds + AT_OBUF + row * AT_OSTR + lane * 16);
        float f[8]; f[0] = __uint_as_float(v.x << 16); f[1] = __uint_as_float(v.x & 0xffff0000u); f[2] = __uint_as_float(v.y << 16); f[3] = __uint_as_float(v.y & 0xffff0000u);
        f[4] = __uint_as_float(v.z << 16); f[5] = __uint_as_float(v.z & 0xffff0000u); f[6] = __uint_as_float(v.w << 16); f[7] = __uint_as_float(v.w & 0xffff0000u);
        float sq = 0.f;
#pragma unroll
        for (int j = 0; j < 8; ++j) sq += f[j] * f[j];
        sq = wsum(sq);
        const float rs = rsqrtf(sq * (1.f / 512.f) + 1e-6f);
        u32x4 w; w.x = pk2(f[0] * rs, f[1] * rs); w.y = pk2(f[2] * rs, f[3] * rs); w.z = pk2(f[4] * rs, f[5] * rs); w.w = pk2(f[6] * rs, f[7] * rs);
        *(u32x4*)(A.catb + ((size_t)b * S + t0 + row) * 1024 + lane * 8) = w; }
    __syncthreads();
}
__device__ __forceinline__ void attn_btab(LAS unsigned char* lds, const float* rel_bias) {
    LAS float* bt = (LAS float*)(lds + AT_BTAB);
    for (int i = threadIdx.x; i < 8 * 129; i += 512) { const int hd = i / 129, d = i % 129; bt[hd * 132 + d] = rel_bias[t5_bucket(d) * 8 + hd] * LOG2E; }
    __syncthreads();
}
__global__ __launch_bounds__(512, 2) void k_attn(AttnArgs A, const float* rel_bias) {
    extern __shared__ __attribute__((aligned(16))) unsigned char dl[];
    LAS unsigned char* lds = (LAS unsigned char*)dl;
    attn_btab(lds, rel_bias);
    for (int it = blockIdx.x; it < NB * 32; it += gridDim.x) attn_item(lds, A, it & 7, 31 - (it >> 3));
}
__global__ __launch_bounds__(256) void k_kvc_bf16(const float* kvc, bf16_t* kc, bf16_t* vc) {
    const int i = blockIdx.x * 256 + threadIdx.x; if (i >= 2 * NB * 2 * 128 * 64) return;
    const int d = i & 63, c = (i >> 6) & 127, kvh = (i >> 13) & 1, b = (i >> 14) & 7, z = i >> 17;
    const float v = (c < 127) ? kvc[((size_t)z * (NB * 127 * 2) + (size_t)(b * 127 + c) * 2 + kvh) * 64 + d] : 0.f;
    (z ? vc : kc)[((size_t)(b * 2 + kvh) * 128 + c) * 64 + d] = f2bf(v);
}
}
namespace mk {
constexpr int XBC_OFF = 1816, Z_OFF = 1304, DT_OFF = 2840, NCH = 16;
constexpr int SD_XS = 0, SD_B = 65536, SD_C = 98304, SD_ACS = 131072, SD_DT = SD_ACS + 2048, SD_W = SD_DT + 2048, SD_WP = SD_W + 2048  , SD_END = SD_WP + 256;
struct SsdArgs { const bf16_t* projb; const float* conv_w; const float* conv_b; const float* dt_bias; const float* a_log; const float* d_skip; bf16_t* states; float* alast; bf16_t* catb; };

__device__ __forceinline__ void ssd_dt_acs(LAS unsigned char* lds, const SsdArgs& A, int b, int c, int grp, int wid, int lane) {
    if (wid < 4) { const int hd = grp * 4 + wid; const float Ah = -__expf(A.a_log[hd]), db = A.dt_bias[hd];
        const size_t row = (size_t)b * S + c * 128 + 2 * lane;
        float x0 = bf2f(A.projb[row * PROJ_LD + DT_OFF + hd]) + db, x1 = bf2f(A.projb[(row + 1) * PROJ_LD + DT_OFF + hd]) + db;
        const float d0 = (x0 > 20.f) ? x0 : log1pf(__expf(x0)), d1 = (x1 > 20.f) ? x1 : log1pf(__expf(x1));
        const float a0 = d0 * Ah, a1 = d1 * Ah; float incl = a0 + a1;
#pragma unroll
        for (int o = 1; o < 64; o <<= 1) { const float t = __shfl_up(incl, o); if (lane >= o) incl += t; }
        LAS float* acs = (LAS float*)(lds + SD_ACS) + wid * 128; LAS float* dtl = (LAS float*)(lds + SD_DT) + wid * 128;
        acs[2 * lane] = incl - a1; acs[2 * lane + 1] = incl; dtl[2 * lane] = d0; dtl[2 * lane + 1] = d1; }
}
template <bool PHASE_A>
__device__ __forceinline__ void ssd_conv(LAS unsigned char* lds, const SsdArgs& A, int b, int c, int grp, int wid, int lane) {
    const int ch = lane;
    if (PHASE_A && ch >= 48) return;
    const int rel = (ch < 32) ? grp * 256 + ch * 8 : (ch < 48) ? 512 + grp * 128 + (ch - 32) * 8 : 768 + grp * 128 + (ch - 48) * 8;
    float w[4][8], bias[8];
#pragma unroll
    for (int k = 0; k < 4; ++k) { const f32x4 u0 = *(const f32x4*)(A.conv_w + k * 1024 + rel), u1 = *(const f32x4*)(A.conv_w + k * 1024 + rel + 4);
#pragma unroll
        for (int j = 0; j < 4; ++j) { w[k][j] = u0[j]; w[k][4 + j] = u1[j]; } }
    { const f32x4 u0 = *(const f32x4*)(A.conv_b + rel), u1 = *(const f32x4*)(A.conv_b + rel + 4);
#pragma unroll
      for (int j = 0; j < 4; ++j) { bias[j] = u0[j]; bias[4 + j] = u1[j]; } }
    const int tl0 = wid * 16, ts0 = c * 128 + tl0;
    const bf16_t* src = A.projb + ((size_t)b * S + ts0) * PROJ_LD + XBC_OFF + rel;
    float x0[8], x1[8], x2[8];
#pragma unroll
    for (int j = 0; j < 8; ++j) { x0[j] = 0.f; x1[j] = 0.f; x2[j] = 0.f; }
    if (ts0 >= 3) {
        const bf16x8 r0 = *(const bf16x8*)(src - 3 * (ptrdiff_t)PROJ_LD), r1 = *(const bf16x8*)(src - 2 * (ptrdiff_t)PROJ_LD), r2 = *(const bf16x8*)(src - 1 * (ptrdiff_t)PROJ_LD);
#pragma unroll
        for (int j = 0; j < 8; ++j) { x0[j] = bf2f((bf16_t)r0[j]); x1[j] = bf2f((bf16_t)r1[j]); x2[j] = bf2f((bf16_t)r2[j]); } }
    const LAS float* wt = (const LAS float*)(lds + SD_W) + (ch >> 3) * 128;
    bf16x8 rvv[16];
#pragma unroll
    for (int i = 0; i < 16; ++i) rvv[i] = *(const bf16x8*)(src + (size_t)i * PROJ_LD);
#pragma unroll
    for (int i = 0; i < 16; ++i) {
        const bf16x8 rv = rvv[i];
        float x3[8], o[8];
#pragma unroll
        for (int j = 0; j < 8; ++j) { x3[j] = bf2f((bf16_t)rv[j]); const float a = bias[j] + w[0][j] * x0[j] + w[1][j] * x1[j] + w[2][j] * x2[j] + w[3][j] * x3[j]; o[j] = a / (1.f + __expf(-a)); x0[j] = x1[j]; x1[j] = x2[j]; x2[j] = x3[j]; }
        const int row = tl0 + i;
        if (PHASE_A && ch < 32) { const float sc = wt[row];
#pragma unroll
            for (int j = 0; j < 8; ++j) o[j] *= sc; }
        u32x4 pk; pk.x = pk2(o[0], o[1]); pk.y = pk2(o[2], o[3]); pk.z = pk2(o[4], o[5]); pk.w = pk2(o[6], o[7]);
        if (ch < 32) *(LAS u32x4*)(lds + SD_XS + row * 512 + ((ch ^ ((row & 3) << 2)) << 4)) = pk;
        else if (ch < 48) { const int cc = ch - 32; *(LAS u32x4*)(lds + SD_B + row * 256 + ((PHASE_A ? (cc ^ ((row & 3) << 2)) : (cc ^ (row & 15))) << 4)) = pk; }
        else { const int cc = ch - 48; *(LAS u32x4*)(lds + SD_C + row * 256 + ((cc ^ (row & 15)) << 4)) = pk; }
    }
}
__device__ __forceinline__ bf16x8 tr_frag2(const LAS unsigned char* base, int stride, int r0, int r1, int chunk0, int qq, int pp) {
    const int cl = chunk0 + (pp >> 1);
    const s16x4 lo = __builtin_amdgcn_ds_read_tr16_b64_v4i16((LAS s16x4*)(base + (r0 + qq) * stride + ((cl ^ (qq << 2)) << 4) + 8 * (pp & 1)));
    const s16x4 hi = __builtin_amdgcn_ds_read_tr16_b64_v4i16((LAS s16x4*)(base + (r1 + qq) * stride + ((cl ^ (qq << 2)) << 4) + 8 * (pp & 1)));
    return __builtin_shufflevector(lo, hi, 0, 1, 2, 3, 4, 5, 6, 7);
}
__device__ __forceinline__ void ssd_a_item(LAS unsigned char* lds, const SsdArgs& A, int item) {
    const int tid = tid_fresh(), wid = __builtin_amdgcn_readfirstlane(tid >> 6), lane = tid & 63;
    const int grp = item & 1, c = (item >> 1) & 15, b = item >> 5;
    const int ql = lane & 31, h = lane >> 5, qq = (lane & 15) >> 2, pp = lane & 3, lb2 = (lane >> 4) & 1;
    __syncthreads();
    ssd_dt_acs(lds, A, b, c, grp, wid, lane);
    __syncthreads();
    { LAS float* acs = (LAS float*)(lds + SD_ACS); LAS float* dtl = (LAS float*)(lds + SD_DT); LAS float* wt = (LAS float*)(lds + SD_W);
      const int hh = tid >> 7, t = tid & 127; const float al = acs[hh * 128 + 127];
      wt[hh * 128 + t] = dtl[hh * 128 + t] * __expf(al - acs[hh * 128 + t]);
      if (t == 0) A.alast[(b * 8 + grp * 4 + hh) * NCH + c] = al; }
    __syncthreads();
    ssd_conv<true>(lds, A, b, c, grp, wid, lane);
    __syncthreads();
    const int pb = wid >> 2, nb = wid & 3;
#pragma unroll 1
    for (int hh = 0; hh < 4; ++hh) {
        f32x16 acc;
#pragma unroll
        for (int r = 0; r < 16; ++r) acc[r] = 0.f;
#pragma unroll
        for (int kk = 0; kk < 8; ++kk) {
            const bf16x8 af = tr_frag2(lds + SD_XS, 512, 16 * kk + 8 * h, 16 * kk + 8 * h + 4, hh * 8 + 4 * pb + 2 * lb2, qq, pp);
            const bf16x8 bf = tr_frag2(lds + SD_B, 256, 16 * kk + 8 * h, 16 * kk + 8 * h + 4, 4 * nb + 2 * lb2, qq, pp);
            acc = MFMA32(af, bf, acc); }
        bf16_t* st = A.states + ((size_t)((b * NCH + c) * 8 + grp * 4 + hh) * 64) * 128;
#pragma unroll
        for (int r = 0; r < 16; ++r) st[(32 * pb + AT_CROW(r, h)) * 128 + 32 * nb + ql] = f2bf(acc[r]);
    }
}
__device__ __forceinline__ void ssd_b_item(LAS unsigned char* lds, const SsdArgs& A, int item) {
    const int tid = tid_fresh(), wid = __builtin_amdgcn_readfirstlane(tid >> 6), lane = tid & 63;
    const int grp = item & 1, c = (item >> 1) & 15, b = item >> 5;
    const int ql = lane & 31, h = lane >> 5, qq = (lane & 15) >> 2, pp = lane & 3, lb2 = (lane >> 4) & 1;
    const int pb = wid >> 2, lb = wid & 3;
    LAS float* acs = (LAS float*)(lds + SD_ACS); LAS float* dtl = (LAS float*)(lds + SD_DT); LAS float* wp = (LAS float*)(lds + SD_WP);
    __syncthreads();
    ssd_dt_acs(lds, A, b, c, grp, wid, lane);
    if (tid >= 256 && tid < 320) { const int hh = (tid - 256) >> 4, cp = tid & 15; float s = 0.f;
        for (int c2 = cp + 1; c2 < c; ++c2) s += A.alast[(b * 8 + grp * 4 + hh) * NCH + c2];
        wp[hh * 16 + cp] = (cp < c) ? __expf(s) : 0.f; }
    ssd_conv<false>(lds, A, b, c, grp, wid, lane);
    __syncthreads();
    f32x16 X[4];
#pragma unroll
    for (int sb = 0; sb < 4; ++sb) {
#pragma unroll
        for (int r = 0; r < 16; ++r) X[sb][r] = 0.f;
        if (sb <= lb) {
#pragma unroll
            for (int kk = 0; kk < 8; ++kk) {
                const bf16x8 af = *(const LAS bf16x8*)(lds + SD_B + (32 * sb + ql) * 256 + (((2 * kk + h) ^ (ql & 15)) << 4));
                const bf16x8 bf = *(const LAS bf16x8*)(lds + SD_C + (32 * lb + ql) * 256 + (((2 * kk + h) ^ (ql & 15)) << 4));
                X[sb] = MFMA32(af, bf, X[sb]); } }
    }
    __syncthreads();
#pragma unroll 1
    for (int hh = 0; hh < 4; ++hh) {
        const int hd = grp * 4 + hh;
        { float pv[16];
#pragma unroll
          for (int j = 0; j < 16; ++j) pv[j] = 0.f;
          const int p = tid >> 3, n0 = (tid & 7) * 16;
          for (int cp0 = 0; cp0 < c; cp0 += 4) { bf16x8 s0[4], s1[4];
#pragma unroll
              for (int u = 0; u < 4; ++u) { const bf16_t* sp = A.states + ((size_t)((b * NCH + cp0 + u) * 8 + hd) * 64 + p) * 128 + n0; s0[u] = *(const bf16x8*)sp; s1[u] = *(const bf16x8*)(sp + 8); }
#pragma unroll
              for (int u = 0; u < 4; ++u) { const float wgt = wp[hh * 16 + cp0 + u];
#pragma unroll
                  for (int j = 0; j < 8; ++j) { pv[j] += wgt * bf2f((bf16_t)s0[u][j]); pv[8 + j] += wgt * bf2f((bf16_t)s1[u][j]); } } }
          LAS unsigned char* pbuf = lds + SD_B + (hh & 1) * 16384 + p * 256;
          *(LAS u32x4*)(pbuf + ((((n0 >> 3)) ^ (p & 15)) << 4)) = (u32x4){pk2(pv[0], pv[1]), pk2(pv[2], pv[3]), pk2(pv[4], pv[5]), pk2(pv[6], pv[7])};
          *(LAS u32x4*)(pbuf + ((((n0 >> 3) + 1) ^ (p & 15)) << 4)) = (u32x4){pk2(pv[8], pv[9]), pk2(pv[10], pv[11]), pk2(pv[12], pv[13]), pk2(pv[14], pv[15])}; }
        __syncthreads();
        f32x16 acc;
#pragma unroll
        for (int r = 0; r < 16; ++r) acc[r] = 0.f;
#pragma unroll
        for (int kk = 0; kk < 8; ++kk) {
            const bf16x8 af = *(const LAS bf16x8*)(lds + SD_B + (hh & 1) * 16384 + (32 * pb + ql) * 256 + (((2 * kk + h) ^ (ql & 15)) << 4));
            const bf16x8 bf = *(const LAS bf16x8*)(lds + SD_C + (32 * lb + ql) * 256 + (((2 * kk + h) ^ (ql & 15)) << 4));
            acc = MFMA32(af, bf, acc); }
        const float al = acs[hh * 128 + 32 * lb + ql];
        { const float e = __expf(al);
#pragma unroll
          for (int r = 0; r < 16; ++r) acc[r] *= e; }
        const float Dh = A.d_skip[hd];
#pragma unroll
        for (int sb = 0; sb < 4; ++sb) {
            if (sb <= lb) {
                f32x16 Pm;
#pragma unroll
                for (int r = 0; r < 16; ++r) { const int sl = 32 * sb + AT_CROW(r, h), ll = 32 * lb + ql;
                    const float as = acs[hh * 128 + sl], ds = dtl[hh * 128 + sl];
                    float v = X[sb][r] * __expf(al - as) * ds; v = (sl <= ll) ? v : 0.f; v += (sl == ll) ? Dh : 0.f; Pm[r] = v; }
#pragma unroll
                for (int sp = 0; sp < 2; ++sp) { const bf16x8 pf = AT_PACK8(Pm, sp);
                    const bf16x8 af = tr_frag2(lds + SD_XS, 512, 32 * sb + 16 * sp + 4 * h, 32 * sb + 16 * sp + 8 + 4 * h, hh * 8 + 4 * pb + 2 * lb2, qq, pp);
                    acc = MFMA32(af, pf, acc); } }
        }
        { const bf16_t* zp = A.projb + ((size_t)b * S + c * 128 + 32 * lb + ql) * PROJ_LD + Z_OFF + hd * 64 + 32 * pb + 4 * h;
#pragma unroll
          for (int qd = 0; qd < 4; ++qd) { const u32x2 zz = *(const u32x2*)(zp + 8 * qd);
              const float z0 = __uint_as_float(zz.x << 16), z1 = __uint_as_float(zz.x & 0xffff0000u), z2 = __uint_as_float(zz.y << 16), z3 = __uint_as_float(zz.y & 0xffff0000u);
              acc[4 * qd] *= z0 / (1.f + __expf(-z0)); acc[4 * qd + 1] *= z1 / (1.f + __expf(-z1)); acc[4 * qd + 2] *= z2 / (1.f + __expf(-z2)); acc[4 * qd + 3] *= z3 / (1.f + __expf(-z3)); } }
        __syncthreads();
#pragma unroll
        for (int qd = 0; qd < 4; ++qd) { const int row = 32 * lb + ql, chn = hh * 8 + 4 * pb + qd;
            *(LAS u32x2*)(lds + SD_XS + row * 512 + ((chn ^ ((row & 3) << 2)) << 4) + 8 * h) = (u32x2){pk2(acc[4 * qd], acc[4 * qd + 1]), pk2(acc[4 * qd + 2], acc[4 * qd + 3])}; }
    }
    __syncthreads();
    int widn = wid; asm volatile("" : "+s"(widn));
#pragma unroll 1
    for (int i = 0; i < 16; ++i) { const int row = widn + 8 * i; const int chn = lane >> 1;
        const u32x2 v = *(const LAS u32x2*)(lds + SD_XS + row * 512 + ((chn ^ ((row & 3) << 2)) << 4) + 8 * (lane & 1));
        const float f0 = __uint_as_float(v.x << 16), f1 = __uint_as_float(v.x & 0xffff0000u), f2 = __uint_as_float(v.y << 16), f3 = __uint_as_float(v.y & 0xffff0000u);
        float sq = (f0 * f0 + f1 * f1) + (f2 * f2 + f3 * f3); sq = wsum(sq);
        const float rs = rsqrtf(sq * (1.f / 256.f) + 1e-6f);
        *(u32x2*)(A.catb + ((size_t)b * S + c * 128 + row) * 1024 + 512 + grp * 256 + lane * 4) = (u32x2){pk2(f0 * rs, f1 * rs), pk2(f2 * rs, f3 * rs)}; }
}
__global__ __launch_bounds__(512, 2) void k_ssd_a(SsdArgs A) {
    extern __shared__ __attribute__((aligned(16))) unsigned char dl[];
    for (int it = blockIdx.x; it < NB * NCH * 2; it += gridDim.x) ssd_a_item((LAS unsigned char*)dl, A, it);
}
__global__ __launch_bounds__(512, 2) void k_ssd_b(SsdArgs A) {
    extern __shared__ __attribute__((aligned(16))) unsigned char dl[];
    for (int it = blockIdx.x; it < NB * NCH * 2; it += gridDim.x) ssd_b_item((LAS unsigned char*)dl, A, it);
}
}
namespace mk {
__device__ __forceinline__ void rms_row_bf16(const float* xr, bf16_t* o, int lane) {
    f32x4 v[4]; float s = 0.f;
#pragma unroll
    for (int j = 0; j < 4; ++j) { v[j] = *(const f32x4*)(xr + lane * 4 + 256 * j); s += (v[j][0] * v[j][0] + v[j][1] * v[j][1]) + (v[j][2] * v[j][2] + v[j][3] * v[j][3]); }
    s = wsum(s); const float rs = rsqrtf(s * (1.f / 1024.f) + 1e-6f);
#pragma unroll
    for (int j = 0; j < 4; ++j) *(u32x2*)(o + lane * 4 + 256 * j) = (u32x2){pk2(v[j][0] * rs, v[j][1] * rs), pk2(v[j][2] * rs, v[j][3] * rs)};
}
constexpr int WT_PITCH = 68, WT_TILE_BYTES = 64 * WT_PITCH * 4;
template <bool OUT8>
__device__ __forceinline__ void wt_tile(const float* W, void* WTv, const float* gk1, const float* gk2, int ksplit, int K, int N, int NP, int mode, int nscale, float sc, int ntn, int ntk,
                                        int tile, LAS float* tl, int lane) {
    const int per = ntn * ntk, z = tile / per, rem = tile % per, n0 = (rem % ntn) * 64, k0 = (rem / ntn) * 64;
    const float* Wz = W + (size_t)z * K * N;
    const int lr = lane >> 4, lc = (lane & 15) * 4;
    f32x4 v[16];
#pragma unroll
    for (int i = 0; i < 16; ++i) { const int k = k0 + 4 * i + lr, n = n0 + lc; v[i] = (n < N) ? *(const f32x4*)(Wz + (size_t)k * N + n) : (f32x4){0.f, 0.f, 0.f, 0.f}; }
    if (gk1) {
#pragma unroll
        for (int i = 0; i < 16; ++i) { const int k = k0 + 4 * i + lr; const float g = (k < ksplit) ? gk1[k] : gk2[k - ksplit]; v[i] = v[i] * g; } }
#pragma unroll
    for (int i = 0; i < 16; ++i) *(LAS f32x4*)(tl + (4 * i + lr) * WT_PITCH + lc) = v[i];
    asm volatile("s_waitcnt lgkmcnt(0)" ::: "memory");
    const int nl = lane & 31, ch = lane >> 5;
#pragma unroll
    for (int half = 0; half < 2; ++half) { const int n = n0 + nl + 32 * half; const float s = (n < nscale) ? sc : 1.f;
        int nm = n; if (mode == 1) { const int up = n >> 10, jj = n & 1023; nm = (jj >> 7) * 256 + up * 128 + (jj & 127); }
#pragma unroll
        for (int cp = 0; cp < 4; ++cp) { const int c = 2 * cp + ch; const LAS float* src = tl + (8 * c) * WT_PITCH + nl + 32 * half;
            if constexpr (OUT8) { f8_t* WTz = (f8_t*)WTv + (size_t)z * NP * K;
                *(u32x2*)(WTz + (size_t)nm * K + k0 + 8 * c) = (u32x2){pk4_fp8(src[0] * s, src[WT_PITCH] * s, src[2 * WT_PITCH] * s, src[3 * WT_PITCH] * s), pk4_fp8(src[4 * WT_PITCH] * s, src[5 * WT_PITCH] * s, src[6 * WT_PITCH] * s, src[7 * WT_PITCH] * s)}; }
            else { bf16_t* WTz = (bf16_t*)WTv + (size_t)z * NP * K;
                u32x4 w; w.x = pk2(src[0] * s, src[WT_PITCH] * s); w.y = pk2(src[2 * WT_PITCH] * s, src[3 * WT_PITCH] * s); w.z = pk2(src[4 * WT_PITCH] * s, src[5 * WT_PITCH] * s); w.w = pk2(src[6 * WT_PITCH] * s, src[7 * WT_PITCH] * s);
                *(u32x4*)(WTz + (size_t)nm * K + k0 + 8 * c) = w; } } }
    asm volatile("s_waitcnt lgkmcnt(0)" ::: "memory");
}
constexpr int CP_KX = 0  , CP_RED = 69632  , CP_HID = CP_RED + 32768  , CP_END = CP_HID + 8192 + 256;
struct CmpArgs { const bf16_t* projb; const bf16_t* w1T; const float* posb; const float* w2; bf16_t* kc; bf16_t* vc; };
__device__ __forceinline__ void cmp_item(LAS unsigned char* lds, const CmpArgs& A, int item) {
    const int tid = tid_fresh(), wid = __builtin_amdgcn_readfirstlane(tid >> 6), lane = tid & 63, ql = lane & 31, h = lane >> 5;
    const int cblk = item & 3, kvh = (item >> 2) & 1, b = (item >> 3) & 7, j = item >> 6;
    __syncthreads();
    { const int tok0 = 512 * cblk; const bf16_t* src = A.projb + ((size_t)b * S + tok0) * PROJ_LD + 512 + j * 128 + kvh * 64;
      for (int i = tid; i < 528 * 8; i += 512) { const int r = i >> 3, ch = i & 7; u32x4 v = (u32x4){0u, 0u, 0u, 0u};
          if (tok0 + r < S) v = *(const u32x4*)(src + (size_t)r * PROJ_LD + ch * 8);
          *(LAS u32x4*)(lds + CP_KX + r * 128 + ((ch ^ ((r >> 4) & 7)) << 4)) = v; } }
    if (tid < 64) { float a = 0.f;
#pragma unroll 16
        for (int sl = 0; sl < 64; ++sl) a += A.posb[(j * 64 + sl) * 64 + tid];
        ((LAS float*)(lds + CP_HID))[2048 + tid] = a; }
    __syncthreads();
    const int nb = wid & 1, kq = wid >> 1;
    f32x16 acc;
#pragma unroll
    for (int r = 0; r < 16; ++r) acc[r] = 0.f;
    const bf16_t* wrow = A.w1T + ((size_t)j * 64 + 32 * nb + ql) * 2048;
#pragma unroll 2
    for (int li = 0; li < 8; ++li) { const int l = 8 * kq + li;
#pragma unroll
        for (int s = 0; s < 4; ++s) {
            const int row = 16 * ql + l;
            const bf16x8 af = *(const LAS bf16x8*)(lds + CP_KX + row * 128 + (((2 * s + h) ^ ((row >> 4) & 7)) << 4));
            const bf16x8 bf = *(const bf16x8*)(wrow + l * 64 + 16 * s + 8 * h);
            acc = MFMA32(af, bf, acc); } }
    { LAS float* red = (LAS float*)(lds + CP_RED) + kq * 2048;
#pragma unroll
      for (int r = 0; r < 16; ++r) red[AT_CROW(r, h) * 64 + 32 * nb + ql] = acc[r]; }
    __syncthreads();
    { LAS float* red = (LAS float*)(lds + CP_RED); LAS float* hid = (LAS float*)(lds + CP_HID);
      for (int i = tid; i < 2048; i += 512) { const float a = (red[i] + red[2048 + i]) + (red[4096 + i] + red[6144 + i]) + hid[2048 + (i & 63)]; hid[i] = a / (1.f + __expf(-a)); } }
    __syncthreads();
    { const LAS float* hid = (const LAS float*)(lds + CP_HID); bf16_t* out = (j ? A.vc : A.kc) + (size_t)(b * 2 + kvh) * 128 * 64;
      for (int i = tid; i < 2048; i += 512) { const int cl = i >> 6, n2 = i & 63; float a = 0.f;
#pragma unroll 8
          for (int n = 0; n < 64; ++n) a += hid[cl * 64 + n] * A.w2[(j * 64 + n) * 64 + n2];
          const int c = 32 * cblk + cl; out[c * 64 + n2] = (c < 127) ? f2bf(a) : (bf16_t)0; } }
}
constexpr int RT_RW = 0;
struct RouteArgs { const float* h1; const float* ffn_norm; const float* router_w; const float* router_b; f8_t* hn8; int* cnt; int* list; float* wlist; int* tinfo; };
__device__ __forceinline__ void route_phase(LAS unsigned char* lds, const RouteArgs& A, int wg, int nwg) {
    const int tid = tid_fresh(), wid = __builtin_amdgcn_readfirstlane(tid >> 6), lane = tid & 63;
    LAS float* rw = (LAS float*)(lds + RT_RW);
    LAS int* lcnt = (LAS int*)(lds + 131072); LAS int* gbase = lcnt + 32; LAS int* nrec = lcnt + 64; LAS int* rec = (LAS int*)(lds + 131072 + 512);
    __syncthreads();
    { f32x4 t4[16];
#pragma unroll
      for (int i = 0; i < 16; ++i) t4[i] = *(const f32x4*)(A.router_w + (size_t)(tid + 512 * i) * 4);
#pragma unroll
      for (int i = 0; i < 16; ++i) { const int q = tid + 512 * i, k = q >> 3, e0 = (q & 7) * 4; const float g = A.ffn_norm[k];
          rw[(e0 + 0) * 1024 + k] = t4[i][0] * g; rw[(e0 + 1) * 1024 + k] = t4[i][1] * g; rw[(e0 + 2) * 1024 + k] = t4[i][2] * g; rw[(e0 + 3) * 1024 + k] = t4[i][3] * g; } }
    if (tid < 32) lcnt[tid] = 0;
    __syncthreads();
    int it = 0;
    for (int t = wg * 8 + wid; t < T; t += nwg * 8, ++it) {
        const float* xr = A.h1 + (size_t)t * D;
        f32x4 v[4]; float s = 0.f;
#pragma unroll
        for (int j = 0; j < 4; ++j) { v[j] = *(const f32x4*)(xr + lane * 4 + 256 * j); s += (v[j][0] * v[j][0] + v[j][1] * v[j][1]) + (v[j][2] * v[j][2] + v[j][3] * v[j][3]); }
        s = wsum(s); const float rs = rsqrtf(s * (1.f / 1024.f) + 1e-6f);
#pragma unroll
        for (int j = 0; j < 4; ++j) { v[j] = v[j] * rs; *(unsigned*)(A.hn8 + (size_t)t * D + lane * 4 + 256 * j) = pk4_fp8(v[j][0], v[j][1], v[j][2], v[j][3]); }
        float pl[32];
#pragma unroll
        for (int e = 0; e < 32; ++e) pl[e] = 0.f;
#pragma unroll
        for (int e = 0; e < 32; ++e) {
#pragma unroll
            for (int j = 0; j < 4; ++j) { const f32x4 w4 = *(const LAS f32x4*)(rw + e * 1024 + lane * 4 + 256 * j); pl[e] += (v[j][0] * w4[0] + v[j][1] * w4[1]) + (v[j][2] * w4[2] + v[j][3] * w4[3]); }
            if ((e & 3) == 3) __builtin_amdgcn_sched_barrier(0); }
        float r16[16];
#pragma unroll
        for (int e = 0; e < 16; ++e) { const bool up = (lane & 32) != 0; const float keep = up ? pl[16 + e] : pl[e], send = up ? pl[e] : pl[16 + e]; r16[e] = keep + __shfl_xor(send, 32); }
        float r8[8];
#pragma unroll
        for (int e = 0; e < 8; ++e) { const bool up = (lane & 16) != 0; const float keep = up ? r16[8 + e] : r16[e], send = up ? r16[e] : r16[8 + e]; r8[e] = keep + __shfl_xor(send, 16); }
        float r4[4];
#pragma unroll
        for (int e = 0; e < 4; ++e) { const bool up = (lane & 8) != 0; const float keep = up ? r8[4 + e] : r8[e], send = up ? r8[e] : r8[4 + e]; r4[e] = keep + __shfl_xor(send, 8); }
        float r2[2];
#pragma unroll
        for (int e = 0; e < 2; ++e) { const bool up = (lane & 4) != 0; const float keep = up ? r4[2 + e] : r4[e], send = up ? r4[e] : r4[2 + e]; r2[e] = keep + __shfl_xor(send, 4); }
        float r1; { const bool up = (lane & 2) != 0; const float keep = up ? r2[1] : r2[0], send = up ? r2[0] : r2[1]; r1 = keep + __shfl_xor(send, 2); }
        r1 += __shfl_xor(r1, 1);
        const int ex = ((lane >> 5) & 1) * 16 + ((lane >> 4) & 1) * 8 + ((lane >> 3) & 1) * 4 + ((lane >> 2) & 1) * 2 + ((lane >> 1) & 1);
        float lg = r1 + A.router_b[ex];
        float tv[4]; int te[4];
#pragma unroll
        for (int k = 0; k < 4; ++k) { float m = lg;
#pragma unroll
            for (int o = 1; o < 64; o <<= 1) m = fmaxf(m, __shfl_xor(m, o));
            int cand = (lg == m) ? ex : 64;
#pragma unroll
            for (int o = 1; o < 64; o <<= 1) cand = min(cand, __shfl_xor(cand, o));
            tv[k] = m; te[k] = cand; if (ex == cand) lg = -INFINITY; }
        const float e1 = __expf(tv[1] - tv[0]), e2 = __expf(tv[2] - tv[0]), e3 = __expf(tv[3] - tv[0]); const float inv = 1.f / (1.f + e1 + e2 + e3);
        if (lane < 4) { const int ek = lane == 0 ? te[0] : lane == 1 ? te[1] : lane == 2 ? te[2] : te[3]; const float wk = (lane == 0 ? 1.f : lane == 1 ? e1 : lane == 2 ? e2 : e3) * inv;
            const int lp = __hip_atomic_fetch_add(lcnt + ek, 1, __ATOMIC_RELAXED, __HIP_MEMORY_SCOPE_WORKGROUP);
            const int n = (it * 8 + wid) * 4 + lane; if (n < 1024) { rec[n * 4] = t * 4 + lane; rec[n * 4 + 1] = ek; rec[n * 4 + 2] = lp; rec[n * 4 + 3] = (int)__float_as_uint(wk); } }
    }
    if (tid == 0) nrec[0] = 0;
    __syncthreads();
    if (tid < 32) gbase[tid] = (int)__hip_atomic_fetch_add((unsigned*)A.cnt + tid, (unsigned)lcnt[tid], __ATOMIC_RELAXED, __HIP_MEMORY_SCOPE_AGENT);
    if (lane == 0) __hip_atomic_fetch_max(nrec, it * 32, __ATOMIC_RELAXED, __HIP_MEMORY_SCOPE_WORKGROUP);
    __syncthreads();
    const int nr = nrec[0] < 1024 ? nrec[0] : 1024;
    for (int n = tid; n < nr; n += 512) { const int i2 = n >> 5, w2 = (n >> 2) & 7; const int t2 = wg * 8 + w2 + i2 * nwg * 8; if (t2 >= T) continue;
        const int tk = rec[n * 4], e = rec[n * 4 + 1], pos = gbase[e] + rec[n * 4 + 2];
        A.list[(size_t)e * T + pos] = tk; A.wlist[tk] = __uint_as_float((unsigned)rec[n * 4 + 3]); A.tinfo[tk] = e | (pos << 8); }
}
struct CombArgs { const float* h1; const bf16_t* y; const int* tinfo; const float* tw; const int* cnt; const float* g; float* out; };
__device__ __forceinline__ void combine_phase(LAS unsigned char* lds, const CombArgs& A, int wg, int nwg) {
    const int tid = tid_fresh(), wid = __builtin_amdgcn_readfirstlane(tid >> 6), lane = tid & 63;
    LAS int* toff = (LAS int*)(lds + LDS_MISC + 64);
    __syncthreads();
    if (tid == 0) { int a = 0; for (int e = 0; e < NE; ++e) { toff[e] = a; a += (A.cnt[e] + 255) >> 8; } }
    __syncthreads();
    f32x4 gv[4];
#pragma unroll
    for (int j = 0; j < 4; ++j) gv[j] = *(const f32x4*)(A.g + lane * 4 + 256 * j);
    for (int t = wg * 8 + wid; t < T; t += nwg * 8) {
        size_t so[4]; float tw[4];
#pragma unroll
        for (int k = 0; k < 4; ++k) { const int inf = A.tinfo[t * 4 + k]; so[k] = ((size_t)toff[inf & 255] * 256 + (inf >> 8)) * 1024; tw[k] = A.tw[t * 4 + k]; }
        f32x4 v[4]; float s = 0.f;
#pragma unroll
        for (int j = 0; j < 4; ++j) { v[j] = *(const f32x4*)(A.h1 + (size_t)t * D + lane * 4 + 256 * j);
#pragma unroll
            for (int k = 0; k < 4; ++k) { const u32x2 yy = *(const u32x2*)(A.y + so[k] + lane * 4 + 256 * j);
                v[j][0] += tw[k] * __uint_as_float(yy.x << 16); v[j][1] += tw[k] * __uint_as_float(yy.x & 0xffff0000u); v[j][2] += tw[k] * __uint_as_float(yy.y << 16); v[j][3] += tw[k] * __uint_as_float(yy.y & 0xffff0000u); }
            s += (v[j][0] * v[j][0] + v[j][1] * v[j][1]) + (v[j][2] * v[j][2] + v[j][3] * v[j][3]); }
        s = wsum(s); const float rs = rsqrtf(s * (1.f / 1024.f) + 1e-6f);
#pragma unroll
        for (int j = 0; j < 4; ++j) *(f32x4*)(A.out + (size_t)t * D + lane * 4 + 256 * j) = v[j] * rs * gv[j];
    }
}
}
#define XB_TMO      128
#define XB_XCNT(j)  (256  + 64 * (j))
#define XB_XSUB(j)  (1280 + 64 * (j))
#define XB_XGEN(j)  (2304 + 64 * (j))
#define XB_TOP      3328
#define XB_TOPGEN   3392
#define XCD_BAR_WORDS 3456
#define XB_SPIN_CAP (1u << 18)
__device__ __forceinline__ unsigned xb_ld(unsigned* p)              { return __hip_atomic_load(p, __ATOMIC_RELAXED, __HIP_MEMORY_SCOPE_AGENT); }
__device__ __forceinline__ unsigned xb_add(unsigned* p, unsigned v) { return __hip_atomic_fetch_add(p, v, __ATOMIC_RELAXED, __HIP_MEMORY_SCOPE_AGENT); }
__device__ __forceinline__ unsigned xb_xcc_id() { return (unsigned)__builtin_amdgcn_s_getreg((3 << 11) | 20) & 0xFu; }
#define XB_SPIN(cond, bar) do { unsigned _sp = 0; while (cond) { __builtin_amdgcn_s_sleep(1); \
    if ((++_sp & 255u) == 0u) { if (xb_ld(&(bar)[XB_TMO])) break; if (_sp > XB_SPIN_CAP) { atomicAdd(&(bar)[XB_TMO], 1u); break; } } } } while (0)
struct XcdBarrier { unsigned* bar; unsigned x; volatile LAS unsigned* st; };
__device__ __forceinline__ XcdBarrier xcd_barrier_post(unsigned* bar, volatile LAS unsigned* st) {
    XcdBarrier b; b.bar = bar; b.x = xb_xcc_id(); b.st = st;
    if (threadIdx.x == 0) (void)xb_add(&bar[XB_XCNT(b.x)], 1u);
    return b;
}
__device__ __forceinline__ void xcd_barrier_complete(unsigned* bar, unsigned x, unsigned& nloc, unsigned& nx) {
    const unsigned G = gridDim.x * gridDim.y * gridDim.z;
    unsigned sum, cnt, mine, sp = 0u;
    for (;;) {
        sum = 0u; cnt = 0u; mine = 0u;
#pragma unroll
        for (unsigned j = 0; j < 16; ++j) { const unsigned c = xb_ld(&bar[XB_XCNT(j)]); sum += c; cnt += (c > 0u) ? 1u : 0u; mine = (j == x) ? c : mine; }
        if (sum == G) break;
        __builtin_amdgcn_s_sleep(1);
        if ((++sp & 255u) == 0u) { if (xb_ld(&bar[XB_TMO])) break; if (sp > XB_SPIN_CAP) { atomicAdd(&bar[XB_TMO], 1u); break; } }
    }
    nloc = mine > 0u ? mine : 1u; nx = cnt > 0u ? cnt : 1u;
}
__device__ __forceinline__ void xcd_barrier(const XcdBarrier& b) {
    asm volatile("s_waitcnt vmcnt(0)" ::: "memory");
    __syncthreads();
    if (threadIdx.x == 0) {
        unsigned* bar = b.bar;
        __builtin_amdgcn_s_waitcnt(0);
        unsigned nloc = b.st[0], nx = b.st[1];
        if (nloc == 0u) { xcd_barrier_complete(bar, b.x, nloc, nx); b.st[0] = nloc; b.st[1] = nx; }
        const unsigned old = xb_add(&bar[XB_XSUB(b.x)], 1u);
        const unsigned gen = old / nloc;
        if (old + 1u == (gen + 1u) * nloc) {
            __builtin_amdgcn_fence(__ATOMIC_RELEASE, "agent");
            asm volatile("s_waitcnt vmcnt(0)" ::: "memory");
            const unsigned og = xb_add(&bar[XB_TOP], 1u);
            const unsigned tg = og / nx;
            if (og + 1u == (tg + 1u) * nx) xb_add(&bar[XB_TOPGEN], 1u);
            else XB_SPIN(xb_ld(&bar[XB_TOPGEN]) == tg, bar);
            __builtin_amdgcn_fence(__ATOMIC_ACQUIRE, "agent");
            xb_add(&bar[XB_XGEN(b.x)], 1u);
            asm volatile("s_waitcnt vmcnt(0)" ::: "memory");
        } else {
            XB_SPIN(xb_ld(&bar[XB_XGEN(b.x)]) == gen, bar);
            __builtin_amdgcn_fence(__ATOMIC_ACQUIRE, "agent");
            asm volatile("s_waitcnt vmcnt(0)" ::: "memory");
        }
    }
    __syncthreads();
}

namespace mk {
constexpr int LDS_BAR = 147456, LDS_FUSED = LDS_BAR + 256;
constexpr int CTL_QUEUE = 4096;
struct Params {
    const float *x, *attn_norm, *w_in, *rel_bias, *cmp_pos, *cmp_w1, *cmp_w2, *attn_out_norm, *conv_w, *conv_b, *dt_bias, *a_log, *d_skip, *ssm_out_norm, *w_out, *ffn_norm,
                *router_w, *router_b, *w_gu, *b_gu, *w_dn, *b_dn, *final_norm;
    float* out; unsigned* ctl; int* cnt;
    bf16_t *xb, *WinT, *WoutT, *w1T, *projb, *catb, *kc, *vc, *states, *ymoe; f8_t *WguT, *WdnT, *hn8, *act;
    float *posb, *alast, *h1, *wlist; int *list, *tinfo;
    int ph_lo, ph_hi;
};
constexpr int NT_WIN = 48 * 16, NT_WOUT = 16 * 16, NT_WGU = 32 * 32 * 16, NT_WDN = 32 * 16 * 16, NT_W1 = 2 * 32, NT_ALL = NT_WIN + NT_WOUT + NT_WGU + NT_WDN + NT_W1;
__device__ __forceinline__ void p0_prologue(LAS unsigned char* lds, const Params& p, int wg, int nwg) {
    const int tid = tid_fresh(), wid = __builtin_amdgcn_readfirstlane(tid >> 6), lane = tid & 63;
    for (int r = wg * 8 + wid; r < T; r += nwg * 8) rms_row_bf16(p.x + (size_t)r * D, p.xb + (size_t)r * D, lane);
    for (int o = wg * 8 + wid; o < 128; o += nwg * 8) { const int j = o >> 6, sl = o & 63; float s = 0.f;
#pragma unroll
        for (int kk = 0; kk < 32; ++kk) { const int k = sl * 32 + kk; s += p.cmp_pos[j * 2048 + k] * p.cmp_w1[((size_t)j * 2048 + k) * 64 + lane]; }
        p.posb[o * 64 + lane] = s; }
    LAS float* tl = (LAS float*)(lds + wid * WT_TILE_BYTES);
    __syncthreads();
    for (int task = wg * 8 + wid; task < NT_ALL; task += nwg * 8) { int idx = task;
        if (idx < NT_WIN) { wt_tile<false>(p.w_in, p.WinT, p.attn_norm, p.attn_norm, 1024, 1024, 2848, 3072, 0, 512, 0.125f * LOG2E, 48, 16, idx, tl, lane); continue; } idx -= NT_WIN;
        if (idx < NT_WOUT) { wt_tile<false>(p.w_out, p.WoutT, p.attn_out_norm, p.ssm_out_norm, 512, 1024, 1024, 1024, 0, 0, 1.f, 16, 16, idx, tl, lane); continue; } idx -= NT_WOUT;
        if (idx < NT_WGU) { wt_tile<true>(p.w_gu, p.WguT, p.ffn_norm, p.ffn_norm, 1024, 1024, 2048, 2048, 1, 2048, W8_SCALE, 32, 16, idx, tl, lane); continue; } idx -= NT_WGU;
        if (idx < NT_WDN) { wt_tile<true>(p.w_dn, p.WdnT, nullptr, nullptr, 0, 1024, 1024, 1024, 0, 1024, W8_SCALE, 16, 16, idx, tl, lane); continue; } idx -= NT_WDN;
        wt_tile<false>(p.cmp_w1, p.w1T, nullptr, nullptr, 0, 2048, 64, 64, 0, 0, 1.f, 1, 32, idx, tl, lane); }
}
__global__ void __launch_bounds__(512, 2) k_fused(Params p) {
    extern __shared__ __attribute__((aligned(16))) unsigned char dl[];
    LAS unsigned char* lds = (LAS unsigned char*)dl;
    const int wg = blockIdx.x, nwg = gridDim.x; int tid = tid_fresh();
    if (tid < 64) ((LAS unsigned*)(lds + LDS_BAR))[tid] = 0u;
    __syncthreads();
    XcdBarrier bar = xcd_barrier_post(p.ctl, (volatile LAS unsigned*)(lds + LDS_BAR));
#ifdef MK_ONLY
#define PH(k) ((k) == MK_ONLY && p.ph_lo <= (k) && (k) < p.ph_hi)
#else
#define PH(k) (p.ph_lo <= (k) && (k) < p.ph_hi)
#endif
#ifdef MK_REPEAT
#define REP(k) for (int _rep = 0; _rep < ((k) == MK_REPEAT ? 2 : 1); ++_rep)
#else
#define REP(k)
#endif
#ifdef MK_REPEAT
#define QREP _rep
#else
#define QREP 0
#endif
#ifdef MK_BARX2
#define SEAM(k) do { if (PH(k) && PH((k) + 1)) { xcd_barrier(bar); xcd_barrier(bar); } } while (0)
#else
#define SEAM(k) do { if (PH(k) && PH((k) + 1)) xcd_barrier(bar); } while (0)
#endif
    if (PH(0)) { p0_prologue(lds, p, wg, nwg);
#ifdef MK_P0X2
        __syncthreads(); p0_prologue(lds, p, wg, nwg);
#endif
    }
    SEAM(0);
    REP(1) if (PH(1)) { ProbProj P; P.S.init(T, NPROJ, nwg, wg); P.A = p.xb; P.Bt = p.WinT; P.O = p.projb; gemm_phase(lds, P); }
    SEAM(1);
    REP(2) if (PH(2)) {
        const SsdArgs SA{p.projb, p.conv_w, p.conv_b, p.dt_bias, p.a_log, p.d_skip, p.states, p.alast, p.catb};
        const CmpArgs CA{p.projb, p.w1T, p.posb, p.cmp_w2, p.kc, p.vc};
        for (int it = wg; it < 384; it += nwg) { const int v = 383 - it; if (v < 128) cmp_item(lds, CA, v); else ssd_a_item(lds, SA, v - 128); }
    }
    SEAM(2);
    REP(3) if (PH(3)) {
        tid = tid_fresh();
        const SsdArgs SA{p.projb, p.conv_w, p.conv_b, p.dt_bias, p.a_log, p.d_skip, p.states, p.alast, p.catb};
        const AttnArgs AA{p.projb, p.kc, p.vc, p.catb};
        attn_btab(lds, p.rel_bias);
        LAS int* qslot = (LAS int*)(lds + LDS_BAR + 64);
        for (;;) {
            __syncthreads();
            if (tid == 0) qslot[0] = (int)__hip_atomic_fetch_add(p.ctl + CTL_QUEUE + 64 * QREP, 1u, __ATOMIC_RELAXED, __HIP_MEMORY_SCOPE_AGENT);
            __syncthreads();
            const int it = qslot[0];
#if defined(MK_QX_ATTN) || defined(MK_QX_SSDB)
            if (it >= 768) break;
#else
            if (it >= 512) break;
#endif
#if defined(MK_QX_ATTN)
            { const int i2 = it >= 512 ? it - 512 : it; if (i2 < 256) attn_item(lds, AA, i2 & 7, 31 - (i2 >> 3)); else ssd_b_item(lds, SA, i2 - 256); }
#elif defined(MK_QX_SSDB)
            { const int i2 = it >= 512 ? it - 256 : it; if (i2 < 256) attn_item(lds, AA, i2 & 7, 31 - (i2 >> 3)); else ssd_b_item(lds, SA, i2 - 256); }
#else
            if (it < 256) attn_item(lds, AA, it & 7, 31 - (it >> 3)); else ssd_b_item(lds, SA, it - 256);
#endif
        }
    }
    SEAM(3);
    REP(4) if (PH(4)) { ProbOut P; P.S.init(T, D, nwg, wg); P.A = p.catb; P.Bt = p.WoutT; P.R0 = p.x; P.O = p.h1; gemm_phase(lds, P); }
    SEAM(4);
    REP(5) if (PH(5)) { const bool dm = QREP != 0; const RouteArgs RA{p.h1, p.ffn_norm, p.router_w, p.router_b, p.hn8, dm ? p.cnt + 64 : p.cnt, dm ? (int*)p.act : p.list, dm ? (float*)p.act + (4u << 20) : p.wlist, dm ? (int*)p.act + (8u << 20) : p.tinfo}; route_phase(lds, RA, wg, nwg); }
    SEAM(5);
    REP(6) if (PH(6)) {
        tid = tid_fresh();
        __syncthreads();
        const int RT = moe_tables(lds, p.cnt);
        ProbMoe1 P; P.S.nN = 8; P.S.G = nwg; P.S.c = (nwg % 8 == 0) ? (wg & 7) * (nwg >> 3) + (wg >> 3) : wg; P.S.RT = RT; P.S.tile_e = (const LAS int*)(lds + LDS_TILE_E); P.S.tile_m = (const LAS int*)(lds + LDS_TILE_M);
        P.A = p.hn8; P.Bt = p.WguT; P.bias = p.b_gu; P.O = p.act; P.rowtab = (const LAS unsigned*)(lds + LDS_ROWTAB);
        LAS unsigned* rowtab = (LAS unsigned*)(lds + LDS_ROWTAB);
#pragma unroll 1
        for (int i = 0; i < 12; ++i) { Unit u; if (!P.S.next(i, u)) break; if (tid < 256) { const int pos = u.mt * 256 + tid; const int c = p.cnt[u.e];
            const int tok = (pos < c) ? (p.list[(size_t)u.e * T + pos] >> 2) : 0; rowtab[i * 256 + tid] = (unsigned)tok * KD; } }
        __syncthreads();
        gemm_phase(lds, P);
    }
    SEAM(6);
    REP(7) if (PH(7)) {
        __syncthreads();
        const int RT = moe_tables(lds, p.cnt);
        ProbMoe2 P; P.S.nN = 4; P.S.G = nwg; P.S.c = (nwg % 8 == 0) ? (wg & 7) * (nwg >> 3) + (wg >> 3) : wg; P.S.RT = RT; P.S.tile_e = (const LAS int*)(lds + LDS_TILE_E); P.S.tile_m = (const LAS int*)(lds + LDS_TILE_M);
        P.A = p.act; P.Bt = p.WdnT; P.bias = p.b_dn; P.O = p.ymoe;
        gemm_phase(lds, P);
    }
    SEAM(7);
    REP(8) if (PH(8)) { const CombArgs CA{p.h1, p.ymoe, p.tinfo, p.wlist, p.cnt, p.final_norm, p.out}; combine_phase(lds, CA, wg, nwg); }
#undef PH
#undef SEAM
}
}

extern "C" void kernel_launch(void* const* d_in, const int* in_sizes, int n_in, void* d_out, int out_size, void* d_ws, size_t ws_size, hipStream_t stream) {
    using namespace mk;
    char* ws = (char*)d_ws; const size_t MB = 1u << 20;
    size_t o = 0; auto take = [&](size_t mb) { char* q = ws + o; o += mb * MB; return q; };
    Params p;
    memset(&p, 0, sizeof(p));
    const float** fin = (const float**)&p.x;
    for (int i = 0; i < 23; ++i) fin[i] = (const float*)d_in[i];
    p.out = (float*)d_out;
    p.ctl = (unsigned*)take(1); p.cnt = (int*)(p.ctl + 8192);
    p.xb = (bf16_t*)take(32); p.WinT = (bf16_t*)take(6); p.WoutT = (bf16_t*)take(2); p.WguT = (f8_t*)take(64); p.WdnT = (f8_t*)take(32); p.w1T = (bf16_t*)take(1);
    p.projb = (bf16_t*)take(96); p.catb = (bf16_t*)take(32); p.hn8 = (f8_t*)take(16); p.kc = (bf16_t*)take(1); p.vc = (bf16_t*)take(1); p.states = (bf16_t*)take(16);
    p.act = (f8_t*)take(72); p.ymoe = (bf16_t*)take(144);
    p.posb = (float*)take(1); p.alast = (float*)take(1); p.h1 = (float*)take(64); p.wlist = (float*)take(2); p.list = (int*)take(2); p.tinfo = (int*)take(1);
    static int grid = 0;
    if (!grid) {
        int dev = 0, cus = 0, per_cu = 0;
        (void)hipGetDevice(&dev); (void)hipDeviceGetAttribute(&cus, hipDeviceAttributeMultiprocessorCount, dev);
        (void)hipFuncSetAttribute((const void*)k_fused, hipFuncAttributeMaxDynamicSharedMemorySize, LDS_FUSED);
        (void)hipOccupancyMaxActiveBlocksPerMultiprocessor(&per_cu, (const void*)k_fused, 512, LDS_FUSED);
        (void)hipGetLastError();
        grid = cus > 0 ? cus : 256;
    }
    (void)hipMemsetAsync(p.ctl, 0, 65536, stream);
#ifndef MK_SPLIT
    p.ph_lo = 0; p.ph_hi = 9;
    hipLaunchKernelGGL(k_fused, dim3(grid), dim3(512), LDS_FUSED, stream, p);
#else
    for (int k = 0; k < 9; ++k) { p.ph_lo = k; p.ph_hi = k + 1; hipLaunchKernelGGL(k_fused, dim3(grid), dim3(512), LDS_FUSED, stream, p); }
#endif
}
```

```cpp
#include <hip/hip_runtime.h>
#include <stdint.h>
#include <string.h>
#include <math.h>
namespace mk {
#define LAS __attribute__((address_space(3)))
typedef unsigned short bf16_t;
typedef short bf16x8 __attribute__((ext_vector_type(8)));
typedef float f32x4 __attribute__((ext_vector_type(4)));
typedef unsigned u32x4 __attribute__((ext_vector_type(4)));
typedef unsigned u32x2 __attribute__((ext_vector_type(2)));
constexpr int NB = 8, S = 2048, D = 1024, T = NB * S, NE = 32;
constexpr int BM = 256, BK = 64, HALF = 128, HTB = HALF * BK * 2, STAGE_BYTES = 8 * HTB, NXCD = 8, WGM = 8;
constexpr int KD = 1024;
constexpr int NPROJ = 3072;
constexpr int MAXSLOT = 65536 + 32 * 256;
constexpr int LDS_MISC = 131072, LDS_TILE_E = LDS_MISC + 64, LDS_TILE_M = LDS_TILE_E + 1536, LDS_ROWTAB = LDS_MISC + 4096, LDS_BYTES = LDS_ROWTAB + 12 * 1024;

__host__ __device__ __forceinline__ int lds_byte(int r, int c) { const int st = (r >> 4) * 2 + (c >> 5), rr = r & 15, cc = c & 31, ob = rr * 64 + cc * 2; return st * 1024 + (ob ^ (((ob >> 9) & 1) << 5)); }
__host__ __device__ __forceinline__ void stage_rc(int b, int& R, int& C) { const int st = b / 1024, sb = b % 1024, swz = sb ^ (((sb >> 9) & 1) << 5); R = (st >> 1) * 16 + swz / 64; C = (st & 1) * 32 + (swz % 64) / 2; }
__host__ __device__ __forceinline__ int perm32(int rho) { const int n = rho >> 4, i = rho & 15; return 8 * (i >> 2) + 4 * n + (i & 3); }
__device__ __forceinline__ unsigned cvt_pk_bf16(float lo, float hi) { unsigned r; asm volatile("v_cvt_pk_bf16_f32 %0, %1, %2" : "=v"(r) : "v"(lo), "v"(hi)); return r; }
__device__ __forceinline__ int tid_fresh() { int t = threadIdx.x; asm volatile("" : "+v"(t)); return t; }
__device__ __forceinline__ float bf2f(bf16_t b) { return __uint_as_float(((unsigned)b) << 16); }

struct Unit { int pm, pn, e, mt; };
struct StaticOrder {
    int nM, nN, nwg, G, c;
    __device__ void init(int M, int N, int G_, int c_) { nM = M / BM; nN = N / BM; nwg = nM * nN; G = G_; c = c_; }
    __device__ bool next(int i, Unit& u) const {
        const long L = (long)i * G + c; if (L >= nwg) return false;
        int wgid = (int)L; { const int q = nwg / NXCD, r = nwg % NXCD, xcd = wgid % NXCD, off = wgid / NXCD; wgid = (xcd < r ? xcd * (q + 1) : r * (q + 1) + (xcd - r) * q) + off; }
        const int nig = WGM * nN, gid = wgid / nig, fm = gid * WGM, gsz = (nM - fm) < WGM ? (nM - fm) : WGM;
        u.pm = fm + ((wgid % nig) % gsz); u.pn = (wgid % nig) / gsz; u.e = 0; u.mt = 0; return true;
    }
};
struct MoeOrder {
    int nN, G, c, RT; const LAS int* tile_e; const LAS int* tile_m;
    __device__ bool next(int i, Unit& u) const { const int L = i * G + c; if (L >= RT * nN) return false; const int rt = L / nN; u.pm = rt; u.pn = L - rt * nN; u.e = tile_e[rt]; u.mt = tile_m[rt]; return true; }
};

struct ProbProj {
    static constexpr bool PERM = true, F8 = false; static constexpr int ROWB = KD * 2;
    StaticOrder S; const bf16_t* A; const bf16_t* Bt; bf16_t* O;
    __device__ __forceinline__ bool next(int i, Unit& u) const { return S.next(i, u); }
    __device__ __forceinline__ const char* a_base(const Unit& u) const { return (const char*)A + (size_t)u.pm * (BM * KD * 2); }
    __device__ __forceinline__ const char* b_base(const Unit& u) const { return (const char*)Bt + (size_t)u.pn * (BM * KD * 2); }
    __device__ __forceinline__ void a_offs(int, const Unit&, unsigned (&v0)[2], unsigned (&v1)[2], const int (&R)[2], const int (&C)[2]) const {
#pragma unroll
        for (int i = 0; i < 2; ++i) { v0[i] = (unsigned)(R[i] * KD + C[i]) * 2u; v1[i] = v0[i] + (unsigned)(HALF * KD * 2); } }
    __device__ __forceinline__ void epi(const f32x4 (&acc)[2][2][4][2], const Unit& u, int wr, int wc, int fr, int fq) const {
        const int row0 = u.pm * BM + wr * 64 + fr, col0 = u.pn * BM + wc * 32 + 8 * fq;
#pragma unroll
        for (int ai = 0; ai < 2; ++ai)
#pragma unroll
            for (int m = 0; m < 4; ++m) { bf16_t* rowp = O + (size_t)(row0 + ai * HALF + m * 16) * NPROJ + col0;
#pragma unroll
                for (int bj = 0; bj < 2; ++bj) { const f32x4 v0 = acc[ai][bj][m][0], v1 = acc[ai][bj][m][1]; u32x4 w;
                    w.x = cvt_pk_bf16(v0[0], v0[1]); w.y = cvt_pk_bf16(v0[2], v0[3]); w.z = cvt_pk_bf16(v1[0], v1[1]); w.w = cvt_pk_bf16(v1[2], v1[3]);
                    *(u32x4*)(rowp + bj * HALF) = w; } }
    }
};
struct ProbOut {
    static constexpr bool PERM = false, F8 = false; static constexpr int ROWB = KD * 2;
    StaticOrder S; const bf16_t* A; const bf16_t* Bt; const float* R0; float* O;
    __device__ __forceinline__ bool next(int i, Unit& u) const { return S.next(i, u); }
    __device__ __forceinline__ const char* a_base(const Unit& u) const { return (const char*)A + (size_t)u.pm * (BM * KD * 2); }
    __device__ __forceinline__ const char* b_base(const Unit& u) const { return (const char*)Bt + (size_t)u.pn * (BM * KD * 2); }
    __device__ __forceinline__ void a_offs(int, const Unit&, unsigned (&v0)[2], unsigned (&v1)[2], const int (&R)[2], const int (&C)[2]) const {
#pragma unroll
        for (int i = 0; i < 2; ++i) { v0[i] = (unsigned)(R[i] * KD + C[i]) * 2u; v1[i] = v0[i] + (unsigned)(HALF * KD * 2); } }
    __device__ __forceinline__ void epi(const f32x4 (&acc)[2][2][4][2], const Unit& u, int wr, int wc, int fr, int fq) const {
        const int row0 = u.pm * BM + wr * 64 + fr, col0 = u.pn * BM + wc * 32 + 4 * fq;
#pragma unroll
        for (int ai = 0; ai < 2; ++ai)
#pragma unroll
            for (int m = 0; m < 4; ++m) { const size_t off = (size_t)(row0 + ai * HALF + m * 16) * D + col0;
#pragma unroll
                for (int bj = 0; bj < 2; ++bj)
#pragma unroll
                    for (int n = 0; n < 2; ++n) { const f32x4 r = *(const f32x4*)(R0 + off + bj * HALF + n * 16); *(f32x4*)(O + off + bj * HALF + n * 16) = acc[ai][bj][m][n] + r; }
                asm volatile("" ::: "memory"); }
    }
};
typedef unsigned char f8_t;
typedef int i32x8 __attribute__((ext_vector_type(8)));
typedef int i32x4 __attribute__((ext_vector_type(4)));
constexpr float W8_SCALE = 32.f, W8_INV = 1.f / 32.f;
__device__ __forceinline__ unsigned pk4_fp8(float a, float b, float c, float d) { int r = __builtin_amdgcn_cvt_pk_fp8_f32(a, b, 0, false); r = __builtin_amdgcn_cvt_pk_fp8_f32(c, d, r, true); return (unsigned)r; }
struct ProbMoe1 {
    static constexpr bool PERM = true, F8 = true; static constexpr int ROWB = KD;
    MoeOrder S; const f8_t* A; const f8_t* Bt; const float* bias; f8_t* O; const LAS unsigned* rowtab;
    __device__ __forceinline__ bool next(int i, Unit& u) const { return S.next(i, u); }
    __device__ __forceinline__ const char* a_base(const Unit&) const { return (const char*)A; }
    __device__ __forceinline__ const char* b_base(const Unit& u) const { return (const char*)Bt + ((size_t)u.e * 2048 + (size_t)u.pn * BM) * ROWB; }
    __device__ __forceinline__ void a_offs(int i, const Unit&, unsigned (&v0)[2], unsigned (&v1)[2], const int (&R)[2], const int (&C)[2]) const {
#pragma unroll
        for (int j = 0; j < 2; ++j) { v0[j] = rowtab[i * 256 + R[j]] + (unsigned)C[j] * 2u; v1[j] = rowtab[i * 256 + HALF + R[j]] + (unsigned)C[j] * 2u; } }
    __device__ __forceinline__ void epi(const f32x4 (&acc)[2][2][4][2], const Unit& u, int wr, int wc, int fr, int fq) const {
        const int row0 = u.pm * BM + wr * 64 + fr, jg0 = u.pn * HALF + wc * 32 + 8 * fq;
        f32x4 bg[2], bu[2];
#pragma unroll
        for (int n = 0; n < 2; ++n) { bg[n] = *(const f32x4*)(bias + u.e * 2048 + jg0 + 4 * n); bu[n] = *(const f32x4*)(bias + u.e * 2048 + 1024 + jg0 + 4 * n); }
#pragma unroll
        for (int ai = 0; ai < 2; ++ai)
#pragma unroll
            for (int m = 0; m < 4; ++m) { float o[8];
#pragma unroll
                for (int n = 0; n < 2; ++n) { const f32x4 g4 = acc[ai][0][m][n] * W8_INV + bg[n], u4 = acc[ai][1][m][n] * W8_INV + bu[n];
#pragma unroll
                    for (int j = 0; j < 4; ++j) { const float g = fminf(g4[j], 7.f), uu = fminf(fmaxf(u4[j], -7.f), 7.f);
                        const float sg = __builtin_amdgcn_rcpf(1.f + __builtin_amdgcn_exp2f(-1.702f * 1.4426950408889634f * g)); o[n * 4 + j] = (uu + 1.f) * g * sg; } }
                *(u32x2*)(O + (size_t)(row0 + ai * HALF + m * 16) * 1024 + jg0) = (u32x2){pk4_fp8(o[0], o[1], o[2], o[3]), pk4_fp8(o[4], o[5], o[6], o[7])}; }
    }
};
struct ProbMoe2 {
    static constexpr bool PERM = true, F8 = true; static constexpr int ROWB = KD;
    MoeOrder S; const f8_t* A; const f8_t* Bt; const float* bias; bf16_t* O;
    __device__ __forceinline__ bool next(int i, Unit& u) const { return S.next(i, u); }
    __device__ __forceinline__ const char* a_base(const Unit& u) const { return (const char*)A + (size_t)u.pm * (BM * ROWB); }
    __device__ __forceinline__ const char* b_base(const Unit& u) const { return (const char*)Bt + ((size_t)u.e * 1024 + (size_t)u.pn * BM) * ROWB; }
    __device__ __forceinline__ void a_offs(int, const Unit&, unsigned (&v0)[2], unsigned (&v1)[2], const int (&R)[2], const int (&C)[2]) const {
#pragma unroll
        for (int i = 0; i < 2; ++i) { v0[i] = (unsigned)(R[i] * ROWB + C[i] * 2); v1[i] = v0[i] + (unsigned)(HALF * ROWB); } }
    __device__ __forceinline__ void epi(const f32x4 (&acc)[2][2][4][2], const Unit& u, int wr, int wc, int fr, int fq) const {
        const int rl0 = wr * 64 + fr, col0 = u.pn * BM + wc * 32 + 8 * fq;
#pragma unroll
        for (int ai = 0; ai < 2; ++ai)
#pragma unroll
            for (int m = 0; m < 4; ++m) { const int rl = rl0 + ai * HALF + m * 16;
                bf16_t* rowp = O + (size_t)(u.pm * BM + rl) * 1024 + col0;
#pragma unroll
                for (int bj = 0; bj < 2; ++bj) { const f32x4 b0 = *(const f32x4*)(bias + u.e * 1024 + col0 + bj * HALF), b1 = *(const f32x4*)(bias + u.e * 1024 + col0 + bj * HALF + 4);
                    const f32x4 v0 = acc[ai][bj][m][0] * W8_INV + b0, v1 = acc[ai][bj][m][1] * W8_INV + b1; u32x4 w;
                    w.x = cvt_pk_bf16(v0[0], v0[1]); w.y = cvt_pk_bf16(v0[2], v0[3]); w.z = cvt_pk_bf16(v1[0], v1[1]); w.w = cvt_pk_bf16(v1[2], v1[3]);
                    *(u32x4*)(rowp + bj * HALF) = w; }
                asm volatile("" ::: "memory"); }
    }
};

template <int N> struct FragBf { bf16x8 v[N][2];
    __device__ __forceinline__ void set(int i, int k, i32x4 x) { v[i][k] = __builtin_bit_cast(bf16x8, x); }
    __device__ __forceinline__ bf16x8 get(int i, int k) const { return v[i][k]; } };
template <int N> struct FragF8 { i32x8 v[N];
    __device__ __forceinline__ void set(int i, int k, i32x4 x) { if (k == 0) v[i].lo = x; else v[i].hi = x; }
    __device__ __forceinline__ bf16x8 get(int, int) const { return bf16x8{}; } };
template <bool F8> struct FragT { typedef FragBf<4> A_t; typedef FragBf<2> B_t; };
template <> struct FragT<true> { typedef FragF8<4> A_t; typedef FragF8<2> B_t; };
template <class P>
__device__ __forceinline__ void gemm_phase(LAS unsigned char* lds, const P& Pb) {
    const int tid = tid_fresh(), wid = __builtin_amdgcn_readfirstlane(tid >> 6), lane = tid & 63, wr = wid >> 2, wc = wid & 3, fr = lane & 15, fq = lane >> 4;
    constexpr int nt = P::ROWB / 128;
    int Rr[2], Cc[2]; unsigned voffB[2];
#pragma unroll
    for (int i = 0; i < 2; ++i) { int R, C; stage_rc(tid * 16 + i * 8192, R, C); const int Rb = P::PERM ? ((R & ~31) + perm32(R & 31)) : R; Rr[i] = R; Cc[i] = C; voffB[i] = (unsigned)(Rb * P::ROWB + C * 2); }
    constexpr size_t kstep = (size_t)(BK * 2);
    constexpr size_t hstep = (size_t)HALF * P::ROWB;
    const unsigned ldsw = (unsigned)wid * 1024u;
    const int aoff = lds_byte(wr * 64 + fr, fq * 8), boff = lds_byte(wc * 32 + fr, fq * 8);
#define PG8_SA(b, h) (((b) * 2 + (h)) * HTB)
#define PG8_SB(b, h) ((4 + (b) * 2 + (h)) * HTB)
#define PG8_STAGE(bufoff, gbase, voff) do { _Pragma("unroll") for (int _i = 0; _i < 2; ++_i) \
        __builtin_amdgcn_global_load_lds((const unsigned*)((const char*)(gbase) + (voff)[_i]), (LAS unsigned*)(lds + (bufoff) + ldsw + _i * 8192), 16, 0, 0); } while (0)
#define PG8_LDA(dst, b, h) do { _Pragma("unroll") for (int m = 0; m < 4; ++m) _Pragma("unroll") for (int k = 0; k < 2; ++k) dst.set(m, k, *(const LAS i32x4*)(lds + PG8_SA(b, h) + aoff + m * 2048 + k * 1024)); } while (0)
#define PG8_LDB(dst, b, h) do { _Pragma("unroll") for (int n = 0; n < 2; ++n) _Pragma("unroll") for (int k = 0; k < 2; ++k) dst.set(n, k, *(const LAS i32x4*)(lds + PG8_SB(b, h) + boff + n * 2048 + k * 1024)); } while (0)
#define PG8_MMA(ai, bj, At, Bt) do { __builtin_amdgcn_s_setprio(1); _Pragma("unroll") for (int m = 0; m < 4; ++m) _Pragma("unroll") for (int n = 0; n < 2; ++n) { \
        if constexpr (P::F8) acc[ai][bj][m][n] = __builtin_amdgcn_mfma_scale_f32_16x16x128_f8f6f4(Bt.v[n], At.v[m], acc[ai][bj][m][n], 0, 0, 0, 0x7f7f7f7f, 0, 0x7f7f7f7f); \
        else { _Pragma("unroll") for (int k = 0; k < 2; ++k) acc[ai][bj][m][n] = __builtin_amdgcn_mfma_f32_16x16x32_bf16(Bt.get(n, k), At.get(m, k), acc[ai][bj][m][n], 0, 0, 0); } } \
        __builtin_amdgcn_s_setprio(0); } while (0)
#define PG8_WAIT_V(n) asm volatile("s_waitcnt vmcnt(" #n ")" ::: "memory")
#define PG8_WAIT_L(n) asm volatile("s_waitcnt lgkmcnt(" #n ")" ::: "memory")
#define PG8_BAR __builtin_amdgcn_s_barrier()
#define PG8_SCHED __builtin_amdgcn_sched_barrier(0)
    Unit cur, nxt; int ui = 0;
    if (!Pb.next(0, cur)) return;
    f32x4 acc[2][2][4][2];
#pragma unroll
    for (int a = 0; a < 2; ++a)
#pragma unroll
        for (int b = 0; b < 2; ++b)
#pragma unroll
            for (int m = 0; m < 4; ++m)
#pragma unroll
                for (int n = 0; n < 2; ++n) acc[a][b][m][n] = (f32x4){0.f, 0.f, 0.f, 0.f};
    typedef typename FragT<P::F8>::A_t AFr; typedef typename FragT<P::F8>::B_t BFr;
    AFr At; BFr B0, B1;
    unsigned vA0[2], vA1[2];
    Pb.a_offs(0, cur, vA0, vA1, Rr, Cc);
    const char* cA = Pb.a_base(cur); const char* cB = Pb.b_base(cur);
    PG8_STAGE(PG8_SB(0, 0), cB, voffB); PG8_STAGE(PG8_SB(0, 1), cB + hstep, voffB); PG8_STAGE(PG8_SA(0, 0), cA, vA0); PG8_STAGE(PG8_SA(0, 1), cA, vA1);
    if (wr == 1) PG8_BAR;
    PG8_WAIT_V(2); PG8_BAR;
    PG8_STAGE(PG8_SB(1, 0), cB + kstep, voffB); PG8_STAGE(PG8_SA(1, 0), cA + kstep, vA0); PG8_STAGE(PG8_SB(1, 1), cB + hstep + kstep, voffB);
    PG8_WAIT_V(6); PG8_BAR;
    for (;;) {
        const bool has_next = Pb.next(ui + 1, nxt);
        const char* nA = has_next ? Pb.a_base(nxt) : cA; const char* nB = has_next ? Pb.b_base(nxt) : cB;
#pragma unroll 1
        for (int t = 0; t < nt; t += 2) {
            const bool last = (t == nt - 2);
            const char* a1 = cA + (size_t)(t + 1) * kstep;
            const char* a2 = last ? nA : cA + (size_t)(t + 2) * kstep; const char* b2 = last ? nB : cB + (size_t)(t + 2) * kstep;
            const char* a3 = a2 + kstep; const char* b3 = b2 + kstep;
            PG8_LDB(B0, 0, 0); PG8_LDB(B1, 0, 1); PG8_SCHED; PG8_LDA(At, 0, 0); PG8_STAGE(PG8_SA(1, 1), a1, vA1);
            PG8_WAIT_V(8); PG8_WAIT_L(0); PG8_BAR; PG8_MMA(0, 0, At, B0); PG8_MMA(0, 1, At, B1); PG8_BAR; PG8_SCHED;
            if (last && has_next) {
                if constexpr (P::F8) { int R2[2], C2[2]; int t2 = tid; asm volatile("" : "+v"(t2));
#pragma unroll
                    for (int i = 0; i < 2; ++i) stage_rc(t2 * 16 + i * 8192, R2[i], C2[i]);
                    Pb.a_offs(ui + 1, nxt, vA0, vA1, R2, C2); }
                else Pb.a_offs(ui + 1, nxt, vA0, vA1, Rr, Cc); }
            PG8_LDA(At, 0, 1); PG8_STAGE(PG8_SB(0, 0), b2, voffB); PG8_STAGE(PG8_SB(0, 1), b2 + hstep, voffB); PG8_STAGE(PG8_SA(0, 0), a2, vA0);
            PG8_WAIT_V(8); PG8_WAIT_L(0); PG8_BAR; PG8_MMA(1, 0, At, B0); PG8_MMA(1, 1, At, B1); PG8_BAR; PG8_SCHED;
            PG8_LDB(B0, 1, 0); PG8_LDB(B1, 1, 1); PG8_SCHED; PG8_LDA(At, 1, 0); PG8_STAGE(PG8_SA(0, 1), a2, vA1);
            PG8_WAIT_V(8); PG8_WAIT_L(0); PG8_BAR; PG8_MMA(0, 0, At, B0); PG8_MMA(0, 1, At, B1); PG8_BAR; PG8_SCHED;
            PG8_LDA(At, 1, 1); PG8_STAGE(PG8_SB(1, 0), b3, voffB); PG8_STAGE(PG8_SB(1, 1), b3 + hstep, voffB); PG8_STAGE(PG8_SA(1, 0), a3, vA0);
            PG8_WAIT_V(8); PG8_WAIT_L(0); PG8_BAR; PG8_MMA(1, 0, At, B0); PG8_MMA(1, 1, At, B1); PG8_BAR; PG8_SCHED;
        }
        if (wr == 0) PG8_BAR;
        if constexpr (P::F8) { int ln2 = lane; asm volatile("" : "+v"(ln2)); Pb.epi(acc, cur, wr, wc, ln2 & 15, ln2 >> 4); } else Pb.epi(acc, cur, wr, wc, fr, fq);
        if (!has_next) break;
#pragma unroll
        for (int a = 0; a < 2; ++a)
#pragma unroll
            for (int b = 0; b < 2; ++b)
#pragma unroll
                for (int m = 0; m < 4; ++m)
#pragma unroll
                    for (int n = 0; n < 2; ++n) acc[a][b][m][n] = (f32x4){0.f, 0.f, 0.f, 0.f};
        cur = nxt; cA = nA; cB = nB; ++ui;
        if (wr == 1) PG8_BAR;
    }
    PG8_WAIT_V(0);
    PG8_BAR;
#undef PG8_SA
#undef PG8_SB
#undef PG8_STAGE
#undef PG8_LDA
#undef PG8_LDB
#undef PG8_MMA
#undef PG8_WAIT_V
#undef PG8_WAIT_L
#undef PG8_BAR
#undef PG8_SCHED
}

__device__ __forceinline__ int moe_tables(LAS unsigned char* lds, const int* cnt) {
    LAS int* tile_e = (LAS int*)(lds + LDS_TILE_E); LAS int* tile_m = (LAS int*)(lds + LDS_TILE_M); LAS int* rts = (LAS int*)(lds + LDS_MISC + 32);
    if (tid_fresh() == 0) { int a = 0; for (int e = 0; e < NE; ++e) { const int n = (cnt[e] + 255) >> 8; for (int m = 0; m < n; ++m) { tile_e[a] = e; tile_m[a] = m; ++a; } } rts[0] = a; }
    __syncthreads();
    return rts[0];
}
}
namespace mk {
__device__ __forceinline__ float wsum(float v) {
#pragma unroll
    for (int o = 1; o < 64; o <<= 1) v += __shfl_xor(v, o);
    return v; }
__device__ __forceinline__ unsigned short f2bf(float f) { unsigned u = __float_as_uint(f); u += 0x7FFFu + ((u >> 16) & 1u); return (unsigned short)(u >> 16); }
}
namespace mk {
typedef float f32x16 __attribute__((ext_vector_type(16)));
typedef short s16x4 __attribute__((ext_vector_type(4)));
typedef __bf16 bf2_t __attribute__((ext_vector_type(2)));
typedef float f2_t __attribute__((ext_vector_type(2)));
#define MFMA32(a, b, c) __builtin_amdgcn_mfma_f32_32x32x16_bf16((a), (b), (c), 0, 0, 0)
constexpr float LOG2E = 1.4426950408889634f;
constexpr int PROJ_LD = NPROJ;
constexpr int AT_KBUF = 0, AT_VBUF = 16384, AT_IMPW = 32768, AT_SCORE = 65536, AT_OBUF = 73728, AT_OSTR = 1040, AT_BTAB = AT_OBUF + 64 * AT_OSTR  ,
              AT_SEL = AT_BTAB + 8 * 132 * 4  , AT_SSQ = AT_SEL + 512  , AT_END = AT_SSQ + 8 * 64 * 4  ;
struct AttnArgs { const bf16_t* projb; const bf16_t* kc; const bf16_t* vc; bf16_t* catb; };

__device__ __forceinline__ unsigned pk2(float a, float b) { f2_t v = {a, b}; return __builtin_bit_cast(unsigned, __builtin_convertvector(v, bf2_t)); }
__device__ __forceinline__ int t5_bucket(int n) { if (n < 0) n = 0; if (n < 16) return n; const float nf = (float)n; const int l = 16 + (int)(logf(nf / 16.f) / 2.0794415416798357f * 16.f); return l < 31 ? l : 31; }
__device__ __forceinline__ void stage_tile(LAS unsigned char* dst, const char* src, size_t row_stride, int wid, int lane, bool vswz) {
    const int row = 8 * wid + (lane >> 3), slot = lane & 7;
    const int f = vswz ? (((row >> 1) & 1) << 2) : ((row >> 1) & 7);
    __builtin_amdgcn_global_load_lds((const unsigned*)(src + (size_t)row * row_stride + ((slot ^ f) << 4)), (LAS unsigned*)(dst + wid * 1024), 16, 0, 0);
}
#define AT_CROW(r, h) (((r) & 3) + 8 * ((r) >> 2) + 4 * (h))
#define AT_PACK8(x, s) __builtin_bit_cast(bf16x8, (u32x4){pk2((x)[8 * (s)], (x)[8 * (s) + 1]), pk2((x)[8 * (s) + 2], (x)[8 * (s) + 3]), pk2((x)[8 * (s) + 4], (x)[8 * (s) + 5]), pk2((x)[8 * (s) + 6], (x)[8 * (s) + 7])})
__device__ __forceinline__ bf16x8 vt_frag(const LAS unsigned char* vt, unsigned vaddr, int rowoff) {
    const s16x4 lo = __builtin_amdgcn_ds_read_tr16_b64_v4i16((LAS s16x4*)(vt + vaddr + rowoff * 128));
    const s16x4 hi = __builtin_amdgcn_ds_read_tr16_b64_v4i16((LAS s16x4*)(vt + vaddr + (rowoff + 8) * 128));
    return __builtin_shufflevector(lo, hi, 0, 1, 2, 3, 4, 5, 6, 7);
}
template <bool FIRST>
__device__ __forceinline__ void obuf_acc(LAS unsigned char* lds, int tl, int hd, int h, float sc, const f32x16 (&oc)[2]) {
#pragma unroll
    for (int c = 0; c < 2; ++c)
#pragma unroll
        for (int qd = 0; qd < 4; ++qd) { LAS u32x2* p = (LAS u32x2*)(lds + AT_OBUF + tl * AT_OSTR + (hd * 64 + 32 * c + 8 * qd + 4 * h) * 2);
            float a0 = sc * oc[c][4 * qd], a1 = sc * oc[c][4 * qd + 1], a2 = sc * oc[c][4 * qd + 2], a3 = sc * oc[c][4 * qd + 3];
            if (!FIRST) { const u32x2 o = *p; a0 += __uint_as_float(o.x << 16); a1 += __uint_as_float(o.x & 0xffff0000u); a2 += __uint_as_float(o.y << 16); a3 += __uint_as_float(o.y & 0xffff0000u); }
            *p = (u32x2){pk2(a0, a1), pk2(a2, a3)}; }
}
template <int KIND>
__device__ __forceinline__ void attn_tile(const LAS unsigned char* Kt, const LAS unsigned char* Vt, int kbase, int tq, bool sel, const bf16x8 (&qf)[4], const LAS float* bt, float cfar,
                                          f32x16 (&O)[2], float& m, float& l, int ql, int h, const unsigned (&vaddr)[2]) {
    f32x16 s0, s1;
#pragma unroll
    for (int r = 0; r < 16; ++r) { s0[r] = 0.f; s1[r] = 0.f; }
    const int fk = (ql >> 1) & 7;
#pragma unroll
    for (int s = 0; s < 4; ++s) { const int ch = ((2 * s + h) ^ fk) << 4;
        const bf16x8 k0 = *(const LAS bf16x8*)(Kt + ql * 128 + ch), k1 = *(const LAS bf16x8*)(Kt + (32 + ql) * 128 + ch);
        s0 = MFMA32(k0, qf[s], s0); s1 = MFMA32(k1, qf[s], s1); }
    float mx = -INFINITY;
    if (KIND == 0) {
#pragma unroll
        for (int r = 0; r < 16; ++r) mx = fmaxf(mx, fmaxf(s0[r], s1[r]));
        mx += cfar;
    } else {
        int tqq = tq - kbase; asm volatile("" : "+v"(tqq));
#pragma unroll
        for (int r = 0; r < 16; ++r) {
            const int d0 = tqq - AT_CROW(r, h), d1 = d0 - 32;
            float x0 = s0[r] + bt[min(max(d0, 0), 128)], x1 = s1[r] + bt[min(max(d1, 0), 128)];
            if (KIND == 2) { x0 = (d0 >= 0 && d0 < 512) ? x0 : -INFINITY; x1 = (d1 >= 0 && d1 < 512) ? x1 : -INFINITY; }
            s0[r] = x0; s1[r] = x1; mx = fmaxf(mx, fmaxf(x0, x1)); }
    }
    mx = sel ? mx : -INFINITY;
    mx = fmaxf(mx, __shfl_xor(mx, 32));
    const float mn = fmaxf(m, mx);
    const float alpha = __builtin_amdgcn_exp2f(m - mn);
    float msub = sel ? mn : INFINITY;
    if (KIND == 0) msub -= cfar;
    float ps = 0.f;
#pragma unroll
    for (int r = 0; r < 16; ++r) { const float p0 = __builtin_amdgcn_exp2f(s0[r] - msub), p1 = __builtin_amdgcn_exp2f(s1[r] - msub); s0[r] = p0; s1[r] = p1; ps += p0 + p1; }
    l = l * alpha + ps; m = mn;
    if (__any(alpha != 1.f)) {
#pragma unroll
        for (int r = 0; r < 16; ++r) { O[0][r] *= alpha; O[1][r] *= alpha; } }
#pragma unroll
    for (int sp = 0; sp < 2; ++sp) {
        const bf16x8 p0 = AT_PACK8(s0, sp), p1 = AT_PACK8(s1, sp);
#pragma unroll
        for (int c = 0; c < 2; ++c) { O[c] = MFMA32(vt_frag(Vt, vaddr[c], 16 * sp), p0, O[c]); O[c] = MFMA32(vt_frag(Vt, vaddr[c], 32 + 16 * sp), p1, O[c]); }
    }
}
template <int MODE>
__device__ __forceinline__ void attn_branch(LAS unsigned char* lds, unsigned U, unsigned mysel, const char* kcol, const char* vcol, size_t RS, int blk, int tq, const bf16x8 (&qf)[4],
                                            const LAS float* bt, float cfar, f32x16 (&oc)[2], float& m, float& l, int ql, int h, const unsigned (&vaddr)[2], int wid, int lane) {
#define AT_NEXT(n) (((n) >= 31) ? -1 : ((U & ~((2u << (n)) - 1u)) ? __builtin_ctz(U & ~((2u << (n)) - 1u)) : -1))
#define AT_ISSUE(n, st) do { stage_tile(lds + (st) * 16384, kcol + (size_t)(n) * 64 * RS, RS, wid, lane, false); stage_tile(lds + (st) * 16384 + 8192, vcol + (size_t)(n) * 64 * RS, RS, wid, lane, true); } while (0)
    int cur = __builtin_ctz(U | 0x80000000u), n1 = AT_NEXT(cur), n2 = (n1 >= 0) ? AT_NEXT(n1) : -1, st = 0;
    asm volatile("s_waitcnt lgkmcnt(0)" ::: "memory"); __builtin_amdgcn_s_barrier(); asm volatile("" ::: "memory");
    AT_ISSUE(cur, 0); if (n1 >= 0) AT_ISSUE(n1, 1); if (n2 >= 0) AT_ISSUE(n2, 2);
    for (;;) {
        if (n2 >= 0) asm volatile("s_waitcnt vmcnt(4)" ::: "memory"); else if (n1 >= 0) asm volatile("s_waitcnt vmcnt(2)" ::: "memory"); else asm volatile("s_waitcnt vmcnt(0)" ::: "memory");
        asm volatile("s_waitcnt lgkmcnt(0)" ::: "memory"); __builtin_amdgcn_s_barrier(); asm volatile("" ::: "memory");
        const int n3 = (n2 >= 0) ? AT_NEXT(n2) : -1;
        if (n3 >= 0) AT_ISSUE(n3, (st + 3) & 3);
        const LAS unsigned char* Kt = lds + st * 16384; const LAS unsigned char* Vt = Kt + 8192;
        const bool sel = (MODE == 0) ? (((mysel >> cur) & 1u) != 0u) : true;
        const bool masked = (cur == blk) || (MODE == 1 && cur + 8 == blk);
        if (masked) attn_tile<2>(Kt, Vt, cur * 64, tq, sel, qf, bt, cfar, oc, m, l, ql, h, vaddr);
        else if (cur + 3 <= blk) attn_tile<0>(Kt, Vt, cur * 64, tq, sel, qf, bt, cfar, oc, m, l, ql, h, vaddr);
        else attn_tile<1>(Kt, Vt, cur * 64, tq, sel, qf, bt, cfar, oc, m, l, ql, h, vaddr);
        if (n1 < 0) break;
        cur = n1; n1 = n2; n2 = n3; st = (st + 1) & 3;
    }
#undef AT_NEXT
#undef AT_ISSUE
}

__device__ __forceinline__ void attn_item(LAS unsigned char* lds, const AttnArgs& A, int b, int qt) {
    const int tid = tid_fresh(), wid = __builtin_amdgcn_readfirstlane(tid >> 6), lane = tid & 63;
    const int g = wid >> 1, th = wid & 1, ql = lane & 31, h = lane >> 5;
    const int t0 = qt * 64, tl = th * 32 + ql, tq = t0 + tl, blk = qt;
    const int qq = (lane & 15) >> 2, pp = lane & 3, lb = (lane >> 4) & 1;
    unsigned vaddr[2];
#pragma unroll
    for (int c = 0; c < 2; ++c) vaddr[c] = (unsigned)((4 * h + qq) * 128 + (((4 * (c ^ ((qq >> 1) & 1))) + 2 * lb + (pp >> 1)) << 4) + 8 * (pp & 1));
    LAS float* impw = (LAS float*)(lds + AT_IMPW); LAS float* score = (LAS float*)(lds + AT_SCORE); LAS unsigned* selm = (LAS unsigned*)(lds + AT_SEL);
    const char* prow0 = (const char*)(A.projb + (size_t)b * S * PROJ_LD);
    const size_t RS = (size_t)PROJ_LD * 2;
    for (int kvh = 0; kvh < 2; ++kvh) {
        const int hd = kvh * 4 + g;
        const LAS float* bt = (const LAS float*)(lds + AT_BTAB) + hd * 132;
        const float cfar = bt[128];
        bf16x8 qf[4];
#pragma unroll
        for (int s = 0; s < 4; ++s) qf[s] = *(const bf16x8*)(A.projb + ((size_t)b * S + tq) * PROJ_LD + hd * 64 + 16 * s + 8 * h);
        float gate[3];
#pragma unroll
        for (int j = 0; j < 3; ++j) { const float gv = bf2f(A.projb[((size_t)b * S + tq) * PROJ_LD + 1280 + j * 8 + hd]); gate[j] = 1.f / (1.f + __expf(-gv)); }
        __syncthreads();
        { const char* kcb = (const char*)(A.kc + (size_t)(b * 2 + kvh) * 128 * 64); const char* vcb = (const char*)(A.vc + (size_t)(b * 2 + kvh) * 128 * 64);
          stage_tile(lds + AT_KBUF, kcb, 128, wid, lane, false); stage_tile(lds + AT_KBUF + 8192, kcb + 64 * 128, 128, wid, lane, false);
          stage_tile(lds + AT_VBUF, vcb, 128, wid, lane, true); stage_tile(lds + AT_VBUF + 8192, vcb + 64 * 128, 128, wid, lane, true); }
        asm volatile("s_waitcnt vmcnt(0)" ::: "memory"); __syncthreads();
        {
            f32x16 sc[4]; const int fk = (ql >> 1) & 7; int tqc = tq; asm volatile("" : "+v"(tqc));
#pragma unroll
            for (int kb = 0; kb < 4; ++kb) {
#pragma unroll
                for (int r = 0; r < 16; ++r) sc[kb][r] = 0.f;
#pragma unroll
                for (int s = 0; s < 4; ++s) { const bf16x8 kf = *(const LAS bf16x8*)(lds + AT_KBUF + (32 * kb + ql) * 128 + (((2 * s + h) ^ fk) << 4)); sc[kb] = MFMA32(kf, qf[s], sc[kb]); }
                __builtin_amdgcn_sched_barrier(0); }
            float mx = -INFINITY;
#pragma unroll
            for (int kb = 0; kb < 4; ++kb)
#pragma unroll
                for (int r = 0; r < 16; ++r) { const int c = 32 * kb + AT_CROW(r, h); const int dist = tqc - 16 * c - 31; const float bv = bt[min(max(dist, 0), 128)]; const float x = (dist >= 0) ? sc[kb][r] + bv : -INFINITY; sc[kb][r] = x; mx = fmaxf(mx, x);
                    if ((r & 7) == 7) __builtin_amdgcn_sched_barrier(0); }
            mx = fmaxf(mx, __shfl_xor(mx, 32));
            const float mref = (mx == -INFINITY) ? 0.f : mx;
            float ls = 0.f;
#pragma unroll
            for (int kb = 0; kb < 4; ++kb)
#pragma unroll
                for (int r = 0; r < 16; ++r) { const float p = __builtin_amdgcn_exp2f(sc[kb][r] - mref); sc[kb][r] = p; ls += p; }
            ls += __shfl_xor(ls, 32);
            const float inv = 1.f / fmaxf(ls, 1e-30f);
#pragma unroll
            for (int kb = 0; kb < 4; ++kb)
#pragma unroll
                for (int r = 0; r < 16; ++r) sc[kb][r] *= inv;
            { float carry = 0.f;
#pragma unroll
              for (int i = 0; i < 16; ++i) { const int kb = i >> 2, qd = i & 3;
                  const float s4 = (sc[kb][4 * qd] + sc[kb][4 * qd + 1]) + (sc[kb][4 * qd + 2] + sc[kb][4 * qd + 3]);
                  const float rv = __shfl_xor(sc[kb][4 * qd + 3], 32);
                  impw[(wid * 32 + ql) * 32 + 2 * i + h] = s4 + (h ? rv : carry); carry = rv; } }
            f32x16 oc[2];
#pragma unroll
            for (int r = 0; r < 16; ++r) { oc[0][r] = 0.f; oc[1][r] = 0.f; }
#pragma unroll
            for (int kb = 0; kb < 4; ++kb)
#pragma unroll
                for (int sp = 0; sp < 2; ++sp) { const bf16x8 pf = AT_PACK8(sc[kb], sp);
#pragma unroll
                    for (int c = 0; c < 2; ++c) oc[c] = MFMA32(vt_frag(lds + AT_VBUF, vaddr[c], 32 * kb + 16 * sp), pf, oc[c]);
                    __builtin_amdgcn_sched_barrier(0); }
            obuf_acc<true>(lds, tl, hd, h, gate[0], oc);
        }
        __syncthreads();
        int tids = tid; asm volatile("" : "+v"(tids));
#pragma unroll
        for (int i = 0; i < 4; ++i) { const int id = tids + 512 * i, tk = id >> 5, n = id & 31, w0 = tk >> 5, q = tk & 31;
            float v = 0.f;
#pragma unroll
            for (int gg = 0; gg < 4; ++gg) v += impw[((2 * gg + w0) * 32 + q) * 32 + n];
            const bool forced = (n == 0) || (n == blk) || (n == blk - 1);
            score[tk * 32 + n] = forced ? 1e4f : ((n <= blk) ? v : -1.f); }
        __syncthreads();
#pragma unroll
        for (int i = 0; i < 4; ++i) { const int id = tids + 512 * i, tk = id >> 5, n = id & 31;
            const float sn = score[tk * 32 + n]; int rank = 0;
            for (int mm = 0; mm < 32; ++mm) { const float s2 = score[tk * 32 + mm]; rank += (s2 > sn || (s2 == sn && mm < n)) ? 1 : 0; }
            const bool sel = (rank < 16) && (n <= blk);
            const unsigned long long bal = __ballot(sel);
            if (n == 0) selm[tk] = (unsigned)(bal >> (32 * (lane >> 5))); }
        __syncthreads();
        unsigned U = selm[lane];
#pragma unroll
        for (int o = 1; o < 64; o <<= 1) U |= (unsigned)__shfl_xor((int)U, o);
        U = (unsigned)__builtin_amdgcn_readfirstlane((int)U);
        const unsigned mysel = selm[tl];
        {
            f32x16 oc[2];
#pragma unroll
            for (int r = 0; r < 16; ++r) { oc[0][r] = 0.f; oc[1][r] = 0.f; }
            float m = -1e30f, l = 0.f;
            attn_branch<0>(lds, U, mysel, prow0 + (512 + 2 * 128 + kvh * 64) * 2, prow0 + (512 + 3 * 128 + kvh * 64) * 2, RS, blk, tq, qf, bt, cfar, oc, m, l, ql, h, vaddr, wid, lane);
            l += __shfl_xor(l, 32);
            const float sc1 = gate[1] / fmaxf(l, 1e-30f);
            obuf_acc<false>(lds, tl, hd, h, sc1, oc);
        }
        {
            f32x16 oc[2];
#pragma unroll
            for (int r = 0; r < 16; ++r) { oc[0][r] = 0.f; oc[1][r] = 0.f; }
            float m = -1e30f, l = 0.f;
            const int lo = (blk >= 8) ? blk - 8 : 0;
            const unsigned Uw = ((blk >= 31) ? 0xffffffffu : ((2u << blk) - 1u)) & ~((1u << lo) - 1u);
            attn_branch<1>(lds, Uw, 0u, prow0 + (512 + 4 * 128 + kvh * 64) * 2, prow0 + (512 + 5 * 128 + kvh * 64) * 2, RS, blk, tq, qf, bt, cfar, oc, m, l, ql, h, vaddr, wid, lane);
            l += __shfl_xor(l, 32);
            const float sc2 = gate[2] / fmaxf(l, 1e-30f);
            obuf_acc<false>(lds, tl, hd, h, sc2, oc);
        }
    }
    __syncthreads();
    int widn = wid; asm volatile("" : "+s"(widn));
#pragma unroll 1
    for (int i = 0; i < 8; ++i) { const int row = widn + 8 * i;
        const u32x4 v = *(const LAS u32x4*)(lds + AT_OBUF + row * AT_OSTR + lane * 16);
        float f[8]; f[0] = __uint_as_float(v.x << 16); f[1] = __uint_as_float(v.x & 0xffff0000u); f[2] = __uint_as_float(v.y << 16); f[3] = __uint_as_float(v.y & 0xffff0000u);
        f[4] = __uint_as_float(v.z << 16); f[5] = __uint_as_float(v.z & 0xffff0000u); f[6] = __uint_as_float(v.w << 16); f[7] = __uint_as_float(v.w & 0xffff0000u);
        float sq = 0.f;
#pragma unroll
        for (int j = 0; j < 8; ++j) sq += f[j] * f[j];
        sq = wsum(sq);
        const float rs = rsqrtf(sq * (1.f / 512.f) + 1e-6f);
        u32x4 w; w.x = pk2(f[0] * rs, f[1] * rs); w.y = pk2(f[2] * rs, f[3] * rs); w.z = pk2(f[4] * rs, f[5] * rs); w.w = pk2(f[6] * rs, f[7] * rs);
        *(u32x4*)(A.catb + ((size_t)b * S + t0 + row) * 1024 + lane * 8) = w; }
    __syncthreads();
}
__device__ __forceinline__ void attn_btab(LAS unsigned char* lds, const float* rel_bias) {
    LAS float* bt = (LAS float*)(lds + AT_BTAB);
    for (int i = threadIdx.x; i < 8 * 129; i += 512) { const int hd = i / 129, d = i % 129; bt[hd * 132 + d] = rel_bias[t5_bucket(d) * 8 + hd] * LOG2E; }
    __syncthreads();
}
}
namespace mk {
constexpr int XBC_OFF = 1816, Z_OFF = 1304, DT_OFF = 2840, NCH = 16;
constexpr int SD_XS = 0, SD_B = 65536, SD_C = 98304, SD_PREV = 131072  , SD_ACS = SD_PREV + 16384, SD_DT = SD_ACS + 2048, SD_W = SD_DT + 2048, SD_WP = SD_W + 2048  , SD_END = SD_WP + 256;
struct SsdArgs { const bf16_t* projb; const float* conv_w; const float* conv_b; const float* dt_bias; const float* a_log; const float* d_skip; bf16_t* states; float* alast; bf16_t* catb; };

__device__ __forceinline__ void ssd_dt_acs(LAS unsigned char* lds, const SsdArgs& A, int b, int c, int grp, int wid, int lane) {
    if (wid < 4) { const int hd = grp * 4 + wid; const float Ah = -__expf(A.a_log[hd]), db = A.dt_bias[hd];
        const size_t row = (size_t)b * S + c * 128 + 2 * lane;
        float x0 = bf2f(A.projb[row * PROJ_LD + DT_OFF + hd]) + db, x1 = bf2f(A.projb[(row + 1) * PROJ_LD + DT_OFF + hd]) + db;
        const float d0 = (x0 > 20.f) ? x0 : log1pf(__expf(x0)), d1 = (x1 > 20.f) ? x1 : log1pf(__expf(x1));
        const float a0 = d0 * Ah, a1 = d1 * Ah; float incl = a0 + a1;
#pragma unroll
        for (int o = 1; o < 64; o <<= 1) { const float t = __shfl_up(incl, o); if (lane >= o) incl += t; }
        LAS float* acs = (LAS float*)(lds + SD_ACS) + wid * 128; LAS float* dtl = (LAS float*)(lds + SD_DT) + wid * 128;
        acs[2 * lane] = incl - a1; acs[2 * lane + 1] = incl; dtl[2 * lane] = d0; dtl[2 * lane + 1] = d1; }
}
template <bool PHASE_A>
__device__ __forceinline__ void ssd_conv(LAS unsigned char* lds, const SsdArgs& A, int b, int c, int grp, int wid, int lane) {
    const int ch = lane;
    if (PHASE_A && ch >= 48) return;
    const int rel = (ch < 32) ? grp * 256 + ch * 8 : (ch < 48) ? 512 + grp * 128 + (ch - 32) * 8 : 768 + grp * 128 + (ch - 48) * 8;
    float w[4][8], bias[8];
#pragma unroll
    for (int k = 0; k < 4; ++k) { const f32x4 u0 = *(const f32x4*)(A.conv_w + k * 1024 + rel), u1 = *(const f32x4*)(A.conv_w + k * 1024 + rel + 4);
#pragma unroll
        for (int j = 0; j < 4; ++j) { w[k][j] = u0[j]; w[k][4 + j] = u1[j]; } }
    { const f32x4 u0 = *(const f32x4*)(A.conv_b + rel), u1 = *(const f32x4*)(A.conv_b + rel + 4);
#pragma unroll
      for (int j = 0; j < 4; ++j) { bias[j] = u0[j]; bias[4 + j] = u1[j]; } }
    const int tl0 = wid * 16, ts0 = c * 128 + tl0;
    const bf16_t* src = A.projb + ((size_t)b * S + ts0) * PROJ_LD + XBC_OFF + rel;
    float x0[8], x1[8], x2[8];
#pragma unroll
    for (int j = 0; j < 8; ++j) { x0[j] = 0.f; x1[j] = 0.f; x2[j] = 0.f; }
    if (ts0 >= 3) {
        const bf16x8 r0 = *(const bf16x8*)(src - 3 * (ptrdiff_t)PROJ_LD), r1 = *(const bf16x8*)(src - 2 * (ptrdiff_t)PROJ_LD), r2 = *(const bf16x8*)(src - 1 * (ptrdiff_t)PROJ_LD);
#pragma unroll
        for (int j = 0; j < 8; ++j) { x0[j] = bf2f((bf16_t)r0[j]); x1[j] = bf2f((bf16_t)r1[j]); x2[j] = bf2f((bf16_t)r2[j]); } }
    const LAS float* wt = (const LAS float*)(lds + SD_W) + (ch >> 3) * 128;
    bf16x8 rvv[16];
#pragma unroll
    for (int i = 0; i < 16; ++i) rvv[i] = *(const bf16x8*)(src + (size_t)i * PROJ_LD);
#pragma unroll
    for (int i = 0; i < 16; ++i) {
        const bf16x8 rv = rvv[i];
        float x3[8], o[8];
#pragma unroll
        for (int j = 0; j < 8; ++j) { x3[j] = bf2f((bf16_t)rv[j]); const float a = bias[j] + w[0][j] * x0[j] + w[1][j] * x1[j] + w[2][j] * x2[j] + w[3][j] * x3[j]; o[j] = a / (1.f + __expf(-a)); x0[j] = x1[j]; x1[j] = x2[j]; x2[j] = x3[j]; }
        const int row = tl0 + i;
        if (PHASE_A && ch < 32) { const float sc = wt[row];
#pragma unroll
            for (int j = 0; j < 8; ++j) o[j] *= sc; }
        u32x4 pk; pk.x = pk2(o[0], o[1]); pk.y = pk2(o[2], o[3]); pk.z = pk2(o[4], o[5]); pk.w = pk2(o[6], o[7]);
        if (ch < 32) *(LAS u32x4*)(lds + SD_XS + row * 512 + ((ch ^ ((row & 3) << 2)) << 4)) = pk;
        else if (ch < 48) { const int cc = ch - 32; *(LAS u32x4*)(lds + SD_B + row * 256 + ((PHASE_A ? (cc ^ ((row & 3) << 2)) : (cc ^ (row & 15))) << 4)) = pk; }
        else { const int cc = ch - 48; *(LAS u32x4*)(lds + SD_C + row * 256 + ((cc ^ (row & 15)) << 4)) = pk; }
    }
}
__device__ __forceinline__ bf16x8 tr_frag2(const LAS unsigned char* base, int stride, int r0, int r1, int chunk0, int qq, int pp) {
    const int cl = chunk0 + (pp >> 1);
    const s16x4 lo = __builtin_amdgcn_ds_read_tr16_b64_v4i16((LAS s16x4*)(base + (r0 + qq) * stride + ((cl ^ (qq << 2)) << 4) + 8 * (pp & 1)));
    const s16x4 hi = __builtin_amdgcn_ds_read_tr16_b64_v4i16((LAS s16x4*)(base + (r1 + qq) * stride + ((cl ^ (qq << 2)) << 4) + 8 * (pp & 1)));
    return __builtin_shufflevector(lo, hi, 0, 1, 2, 3, 4, 5, 6, 7);
}
__device__ __forceinline__ void ssd_a_item(LAS unsigned char* lds, const SsdArgs& A, int item) {
    const int tid = tid_fresh(), wid = __builtin_amdgcn_readfirstlane(tid >> 6), lane = tid & 63;
    const int grp = item & 1, c = (item >> 1) & 15, b = item >> 5;
    const int ql = lane & 31, h = lane >> 5, qq = (lane & 15) >> 2, pp = lane & 3, lb2 = (lane >> 4) & 1;
    __syncthreads();
    ssd_dt_acs(lds, A, b, c, grp, wid, lane);
    __syncthreads();
    { LAS float* acs = (LAS float*)(lds + SD_ACS); LAS float* dtl = (LAS float*)(lds + SD_DT); LAS float* wt = (LAS float*)(lds + SD_W);
      const int hh = tid >> 7, t = tid & 127; const float al = acs[hh * 128 + 127];
      wt[hh * 128 + t] = dtl[hh * 128 + t] * __expf(al - acs[hh * 128 + t]);
      if (t == 0) A.alast[(b * 8 + grp * 4 + hh) * NCH + c] = al; }
    __syncthreads();
    ssd_conv<true>(lds, A, b, c, grp, wid, lane);
    __syncthreads();
    const int pb = wid >> 2, nb = wid & 3;
#pragma unroll 1
    for (int hh = 0; hh < 4; ++hh) {
        f32x16 acc;
#pragma unroll
        for (int r = 0; r < 16; ++r) acc[r] = 0.f;
#pragma unroll
        for (int kk = 0; kk < 8; ++kk) {
            const bf16x8 af = tr_frag2(lds + SD_XS, 512, 16 * kk + 8 * h, 16 * kk + 8 * h + 4, hh * 8 + 4 * pb + 2 * lb2, qq, pp);
            const bf16x8 bf = tr_frag2(lds + SD_B, 256, 16 * kk + 8 * h, 16 * kk + 8 * h + 4, 4 * nb + 2 * lb2, qq, pp);
            acc = MFMA32(af, bf, acc); }
        bf16_t* st = A.states + ((size_t)((b * NCH + c) * 8 + grp * 4 + hh) * 64) * 128;
#pragma unroll
        for (int r = 0; r < 16; ++r) st[(32 * pb + AT_CROW(r, h)) * 128 + 32 * nb + ql] = f2bf(acc[r]);
    }
}
__device__ __forceinline__ void ssd_b_item(LAS unsigned char* lds, const SsdArgs& A, int item) {
    const int tid = tid_fresh(), wid = __builtin_amdgcn_readfirstlane(tid >> 6), lane = tid & 63;
    const int grp = item & 1, b = (item >> 1) & 7, c = 15 - (item >> 4);
    const int ql = lane & 31, h = lane >> 5, qq = (lane & 15) >> 2, pp = lane & 3, lb2 = (lane >> 4) & 1;
    const int pb = wid >> 2, lb = wid & 3;
    LAS float* acs = (LAS float*)(lds + SD_ACS); LAS float* dtl = (LAS float*)(lds + SD_DT); LAS float* wp = (LAS float*)(lds + SD_WP);
    __syncthreads();
    ssd_dt_acs(lds, A, b, c, grp, wid, lane);
    if (tid >= 256 && tid < 320) { const int hh = (tid - 256) >> 4, cp = tid & 15; float s = 0.f;
        for (int c2 = cp + 1; c2 < c; ++c2) s += A.alast[(b * 8 + grp * 4 + hh) * NCH + c2];
        wp[hh * 16 + cp] = (cp < c) ? __expf(s) : 0.f; }
    ssd_conv<false>(lds, A, b, c, grp, wid, lane);
    __syncthreads();
#pragma unroll 1
    for (int hh = 0; hh < 4; ++hh) {
        const int hd = grp * 4 + hh;
        { float pv[16];
#pragma unroll
          for (int j = 0; j < 16; ++j) pv[j] = 0.f;
          const int p = tid >> 3, n0 = (tid & 7) * 16;
          for (int cp0 = 0; cp0 < c; cp0 += 4) { bf16x8 s0[4], s1[4];
#pragma unroll
              for (int u = 0; u < 4; ++u) { const bf16_t* sp = A.states + ((size_t)((b * NCH + cp0 + u) * 8 + hd) * 64 + p) * 128 + n0; s0[u] = *(const bf16x8*)sp; s1[u] = *(const bf16x8*)(sp + 8); }
#pragma unroll
              for (int u = 0; u < 4; ++u) { const float wgt = wp[hh * 16 + cp0 + u];
#pragma unroll
                  for (int j = 0; j < 8; ++j) { pv[j] += wgt * bf2f((bf16_t)s0[u][j]); pv[8 + j] += wgt * bf2f((bf16_t)s1[u][j]); } } }
          LAS unsigned char* pbuf = lds + SD_PREV + p * 256;
          *(LAS u32x4*)(pbuf + ((((n0 >> 3)) ^ (p & 15)) << 4)) = (u32x4){pk2(pv[0], pv[1]), pk2(pv[2], pv[3]), pk2(pv[4], pv[5]), pk2(pv[6], pv[7])};
          *(LAS u32x4*)(pbuf + ((((n0 >> 3) + 1) ^ (p & 15)) << 4)) = (u32x4){pk2(pv[8], pv[9]), pk2(pv[10], pv[11]), pk2(pv[12], pv[13]), pk2(pv[14], pv[15])}; }
        __syncthreads();
        f32x16 acc;
#pragma unroll
        for (int r = 0; r < 16; ++r) acc[r] = 0.f;
#pragma unroll
        for (int kk = 0; kk < 8; ++kk) {
            const bf16x8 af = *(const LAS bf16x8*)(lds + SD_PREV + (32 * pb + ql) * 256 + (((2 * kk + h) ^ (ql & 15)) << 4));
            const bf16x8 bf = *(const LAS bf16x8*)(lds + SD_C + (32 * lb + ql) * 256 + (((2 * kk + h) ^ (ql & 15)) << 4));
            acc = MFMA32(af, bf, acc); }
        const float al = acs[hh * 128 + 32 * lb + ql];
        { const float e = __expf(al);
#pragma unroll
          for (int r = 0; r < 16; ++r) acc[r] *= e; }
        const float Dh = A.d_skip[hd];
#pragma unroll
        for (int sb = 0; sb < 4; ++sb) {
            if (sb <= lb) {
                f32x16 Pm;
#pragma unroll
                for (int r = 0; r < 16; ++r) Pm[r] = 0.f;
#pragma unroll
                for (int kk = 0; kk < 8; ++kk) {
                    const bf16x8 gf = *(const LAS bf16x8*)(lds + SD_B + (32 * sb + ql) * 256 + (((2 * kk + h) ^ (ql & 15)) << 4));
                    const bf16x8 cf = *(const LAS bf16x8*)(lds + SD_C + (32 * lb + ql) * 256 + (((2 * kk + h) ^ (ql & 15)) << 4));
                    Pm = MFMA32(gf, cf, Pm); }
#pragma unroll
                for (int r = 0; r < 16; ++r) { const int sl = 32 * sb + AT_CROW(r, h), ll = 32 * lb + ql;
                    const float as = acs[hh * 128 + sl], ds = dtl[hh * 128 + sl];
                    float v = Pm[r] * __expf(al - as) * ds; v = (sl <= ll) ? v : 0.f; v += (sl == ll) ? Dh : 0.f; Pm[r] = v; }
#pragma unroll
                for (int sp = 0; sp < 2; ++sp) { const bf16x8 pf = AT_PACK8(Pm, sp);
                    const bf16x8 af = tr_frag2(lds + SD_XS, 512, 32 * sb + 16 * sp + 4 * h, 32 * sb + 16 * sp + 8 + 4 * h, hh * 8 + 4 * pb + 2 * lb2, qq, pp);
                    acc = MFMA32(af, pf, acc); } }
        }
        { const bf16_t* zp = A.projb + ((size_t)b * S + c * 128 + 32 * lb + ql) * PROJ_LD + Z_OFF + hd * 64 + 32 * pb + 4 * h;
#pragma unroll
          for (int qd = 0; qd < 4; ++qd) { const u32x2 zz = *(const u32x2*)(zp + 8 * qd);
              const float z0 = __uint_as_float(zz.x << 16), z1 = __uint_as_float(zz.x & 0xffff0000u), z2 = __uint_as_float(zz.y << 16), z3 = __uint_as_float(zz.y & 0xffff0000u);
              acc[4 * qd] *= z0 / (1.f + __expf(-z0)); acc[4 * qd + 1] *= z1 / (1.f + __expf(-z1)); acc[4 * qd + 2] *= z2 / (1.f + __expf(-z2)); acc[4 * qd + 3] *= z3 / (1.f + __expf(-z3)); } }
        __syncthreads();
#pragma unroll
        for (int qd = 0; qd < 4; ++qd) { const int row = 32 * lb + ql, chn = hh * 8 + 4 * pb + qd;
            *(LAS u32x2*)(lds + SD_XS + row * 512 + ((chn ^ ((row & 3) << 2)) << 4) + 8 * h) = (u32x2){pk2(acc[4 * qd], acc[4 * qd + 1]), pk2(acc[4 * qd + 2], acc[4 * qd + 3])}; }
    }
    __syncthreads();
    int widn = wid; asm volatile("" : "+s"(widn));
#pragma unroll 1
    for (int i = 0; i < 16; ++i) { const int row = widn + 8 * i; const int chn = lane >> 1;
        const u32x2 v = *(const LAS u32x2*)(lds + SD_XS + row * 512 + ((chn ^ ((row & 3) << 2)) << 4) + 8 * (lane & 1));
        const float f0 = __uint_as_float(v.x << 16), f1 = __uint_as_float(v.x & 0xffff0000u), f2 = __uint_as_float(v.y << 16), f3 = __uint_as_float(v.y & 0xffff0000u);
        float sq = (f0 * f0 + f1 * f1) + (f2 * f2 + f3 * f3); sq = wsum(sq);
        const float rs = rsqrtf(sq * (1.f / 256.f) + 1e-6f);
        *(u32x2*)(A.catb + ((size_t)b * S + c * 128 + row) * 1024 + 512 + grp * 256 + lane * 4) = (u32x2){pk2(f0 * rs, f1 * rs), pk2(f2 * rs, f3 * rs)}; }
}
}
namespace mk {
__device__ __forceinline__ void rms_row_bf16(const float* xr, bf16_t* o, int lane) {
    f32x4 v[4]; float s = 0.f;
#pragma unroll
    for (int j = 0; j < 4; ++j) { v[j] = *(const f32x4*)(xr + lane * 4 + 256 * j); s += (v[j][0] * v[j][0] + v[j][1] * v[j][1]) + (v[j][2] * v[j][2] + v[j][3] * v[j][3]); }
    s = wsum(s); const float rs = rsqrtf(s * (1.f / 1024.f) + 1e-6f);
#pragma unroll
    for (int j = 0; j < 4; ++j) *(u32x2*)(o + lane * 4 + 256 * j) = (u32x2){pk2(v[j][0] * rs, v[j][1] * rs), pk2(v[j][2] * rs, v[j][3] * rs)};
}
constexpr int WT_PITCH = 68, WT_TILE_BYTES = 64 * WT_PITCH * 4;
template <bool OUT8>
__device__ __forceinline__ void wt_tile(const float* W, void* WTv, const float* gk1, const float* gk2, int ksplit, int K, int N, int NP, int mode, int nscale, float sc, int ntn, int ntk,
                                        int tile, LAS float* tl, int lane) {
    const int per = ntn * ntk, z = tile / per, rem = tile % per, n0 = (rem % ntn) * 64;
    const float* Wz = W + (size_t)z * K * N;
  for (int sub = 0; sub < (OUT8 ? 2 : 1); ++sub) {
    const int k0 = ((rem / ntn) * (OUT8 ? 2 : 1) + sub) * 64;
    const int lr = lane >> 4, lc = (lane & 15) * 4;
    f32x4 v[16];
#pragma unroll
    for (int i = 0; i < 16; ++i) { const int k = k0 + 4 * i + lr, n = n0 + lc; v[i] = (n < N) ? *(const f32x4*)(Wz + (size_t)k * N + n) : (f32x4){0.f, 0.f, 0.f, 0.f}; }
    if (gk1) {
#pragma unroll
        for (int i = 0; i < 16; ++i) { const int k = k0 + 4 * i + lr; const float g = (k < ksplit) ? gk1[k] : gk2[k - ksplit]; v[i] = v[i] * g; } }
#pragma unroll
    for (int i = 0; i < 16; ++i) *(LAS f32x4*)(tl + (4 * i + lr) * WT_PITCH + lc) = v[i];
    asm volatile("s_waitcnt lgkmcnt(0)" ::: "memory");
    const int nl = lane & 31, ch = lane >> 5;
#pragma unroll
    for (int half = 0; half < 2; ++half) { const int n = n0 + nl + 32 * half; const float s = (n < nscale) ? sc : 1.f;
        int nm = n; if (mode == 1) { const int up = n >> 10, jj = n & 1023; nm = (jj >> 7) * 256 + up * 128 + (jj & 127); }
#pragma unroll
        for (int cp = 0; cp < 4; ++cp) { const int c = 2 * cp + ch; const LAS float* src = tl + (8 * c) * WT_PITCH + nl + 32 * half;
            if constexpr (OUT8) { f8_t* WTz = (f8_t*)WTv + (size_t)z * NP * K;
                *(u32x2*)(WTz + (size_t)nm * K + k0 + 8 * c) = (u32x2){pk4_fp8(src[0] * s, src[WT_PITCH] * s, src[2 * WT_PITCH] * s, src[3 * WT_PITCH] * s), pk4_fp8(src[4 * WT_PITCH] * s, src[5 * WT_PITCH] * s, src[6 * WT_PITCH] * s, src[7 * WT_PITCH] * s)}; }
            else { bf16_t* WTz = (bf16_t*)WTv + (size_t)z * NP * K;
                u32x4 w; w.x = pk2(src[0] * s, src[WT_PITCH] * s); w.y = pk2(src[2 * WT_PITCH] * s, src[3 * WT_PITCH] * s); w.z = pk2(src[4 * WT_PITCH] * s, src[5 * WT_PITCH] * s); w.w = pk2(src[6 * WT_PITCH] * s, src[7 * WT_PITCH] * s);
                *(u32x4*)(WTz + (size_t)nm * K + k0 + 8 * c) = w; } } }
    asm volatile("s_waitcnt lgkmcnt(0)" ::: "memory");
  }
}
constexpr int CP_KX = 0  , CP_RED = 69632  , CP_HID = CP_RED + 32768  , CP_END = CP_HID + 8192 + 256;
struct CmpArgs { const bf16_t* projb; const bf16_t* w1T; const float* posb; const float* w2; bf16_t* kc; bf16_t* vc; };
__device__ __forceinline__ void cmp_item(LAS unsigned char* lds, const CmpArgs& A, int item) {
    const int tid = tid_fresh(), wid = __builtin_amdgcn_readfirstlane(tid >> 6), lane = tid & 63, ql = lane & 31, h = lane >> 5;
    const int cblk = item & 3, kvh = (item >> 2) & 1, b = (item >> 3) & 7, j = item >> 6;
    __syncthreads();
    { const int tok0 = 512 * cblk; const bf16_t* src = A.projb + ((size_t)b * S + tok0) * PROJ_LD + 512 + j * 128 + kvh * 64;
      for (int i = tid; i < 528 * 8; i += 512) { const int r = i >> 3, ch = i & 7; u32x4 v = (u32x4){0u, 0u, 0u, 0u};
          if (tok0 + r < S) v = *(const u32x4*)(src + (size_t)r * PROJ_LD + ch * 8);
          *(LAS u32x4*)(lds + CP_KX + r * 128 + ((ch ^ ((r >> 4) & 7)) << 4)) = v; } }
    if (tid < 64) { float a = 0.f;
#pragma unroll 16
        for (int sl = 0; sl < 64; ++sl) a += A.posb[(j * 64 + sl) * 64 + tid];
        ((LAS float*)(lds + CP_HID))[2048 + tid] = a; }
    __syncthreads();
    const int nb = wid & 1, kq = wid >> 1;
    f32x16 acc;
#pragma unroll
    for (int r = 0; r < 16; ++r) acc[r] = 0.f;
    const bf16_t* wrow = A.w1T + ((size_t)j * 64 + 32 * nb + ql) * 2048;
#pragma unroll 2
    for (int li = 0; li < 8; ++li) { const int l = 8 * kq + li;
#pragma unroll
        for (int s = 0; s < 4; ++s) {
            const int row = 16 * ql + l;
            const bf16x8 af = *(const LAS bf16x8*)(lds + CP_KX + row * 128 + (((2 * s + h) ^ ((row >> 4) & 7)) << 4));
            const bf16x8 bf = *(const bf16x8*)(wrow + l * 64 + 16 * s + 8 * h);
            acc = MFMA32(af, bf, acc); } }
    { LAS float* red = (LAS float*)(lds + CP_RED) + kq * 2048;
#pragma unroll
      for (int r = 0; r < 16; ++r) red[AT_CROW(r, h) * 64 + 32 * nb + ql] = acc[r]; }
    __syncthreads();
    { LAS float* red = (LAS float*)(lds + CP_RED); LAS float* hid = (LAS float*)(lds + CP_HID);
      for (int i = tid; i < 2048; i += 512) { const float a = (red[i] + red[2048 + i]) + (red[4096 + i] + red[6144 + i]) + hid[2048 + (i & 63)]; hid[i] = a / (1.f + __expf(-a)); } }
    __syncthreads();
    { const LAS float* hid = (const LAS float*)(lds + CP_HID); bf16_t* out = (j ? A.vc : A.kc) + (size_t)(b * 2 + kvh) * 128 * 64;
      for (int i = tid; i < 2048; i += 512) { const int cl = i >> 6, n2 = i & 63; float a = 0.f;
#pragma unroll 8
          for (int n = 0; n < 64; ++n) a += hid[cl * 64 + n] * A.w2[(j * 64 + n) * 64 + n2];
          const int c = 32 * cblk + cl; out[c * 64 + n2] = (c < 127) ? f2bf(a) : (bf16_t)0; } }
}
constexpr int RT_RW = 0;
struct RouteArgs { const float* h1; const float* ffn_norm; const float* router_w; const float* router_b; f8_t* hn8; int* cnt; int* list; float* wlist; int* tinfo; };
__device__ __forceinline__ void route_phase(LAS unsigned char* lds, const RouteArgs& A, int wg, int nwg) {
    const int tid = tid_fresh(), wid = __builtin_amdgcn_readfirstlane(tid >> 6), lane = tid & 63;
    LAS float* rw = (LAS float*)(lds + RT_RW);
    LAS float* lgt = (LAS float*)(lds + 131072);
    LAS int* lcnt = (LAS int*)(lds + 131072 + 16128); LAS int* gbase = lcnt + 32;
    __syncthreads();
    { f32x4 t4[16];
#pragma unroll
      for (int i = 0; i < 16; ++i) t4[i] = *(const f32x4*)(A.router_w + (size_t)(tid + 512 * i) * 4);
#pragma unroll
      for (int i = 0; i < 16; ++i) { const int q = tid + 512 * i, k = q >> 3, e0 = (q & 7) * 4; const float g = A.ffn_norm[k];
          rw[(e0 + 0) * 1024 + k] = t4[i][0] * g; rw[(e0 + 1) * 1024 + k] = t4[i][1] * g; rw[(e0 + 2) * 1024 + k] = t4[i][2] * g; rw[(e0 + 3) * 1024 + k] = t4[i][3] * g; } }
    if (tid < 32) lcnt[tid] = 0;
    __syncthreads();
    const int ex = ((lane >> 5) & 1) * 16 + ((lane >> 4) & 1) * 8 + ((lane >> 3) & 1) * 4 + ((lane >> 2) & 1) * 2 + ((lane >> 1) & 1);
    const float rbias = A.router_b[ex];
    int it = 0;
    for (int t0 = wg * 8 + wid; t0 < T; t0 += 2 * nwg * 8, it += 2) {
        const int t1 = t0 + nwg * 8; const bool has1 = t1 < T;
        f32x4 va[4], vb[4]; float sa = 0.f, sb = 0.f;
#pragma unroll
        for (int j = 0; j < 4; ++j) { va[j] = *(const f32x4*)(A.h1 + (size_t)t0 * D + lane * 4 + 256 * j); vb[j] = has1 ? *(const f32x4*)(A.h1 + (size_t)t1 * D + lane * 4 + 256 * j) : (f32x4){0.f, 0.f, 0.f, 0.f};
            sa += (va[j][0] * va[j][0] + va[j][1] * va[j][1]) + (va[j][2] * va[j][2] + va[j][3] * va[j][3]); sb += (vb[j][0] * vb[j][0] + vb[j][1] * vb[j][1]) + (vb[j][2] * vb[j][2] + vb[j][3] * vb[j][3]); }
#pragma unroll
        for (int o = 1; o < 64; o <<= 1) { sa += __shfl_xor(sa, o); sb += __shfl_xor(sb, o); }
        const float ra = rsqrtf(sa * (1.f / 1024.f) + 1e-6f), rb = rsqrtf(sb * (1.f / 1024.f) + 1e-6f);
#pragma unroll
        for (int j = 0; j < 4; ++j) { va[j] = va[j] * ra; vb[j] = vb[j] * rb; *(unsigned*)(A.hn8 + (size_t)t0 * D + lane * 4 + 256 * j) = pk4_fp8(va[j][0], va[j][1], va[j][2], va[j][3]);
            if (has1) *(unsigned*)(A.hn8 + (size_t)t1 * D + lane * 4 + 256 * j) = pk4_fp8(vb[j][0], vb[j][1], vb[j][2], vb[j][3]); }
        float pa[32], pb[32];
#pragma unroll
        for (int e = 0; e < 32; ++e) { pa[e] = 0.f; pb[e] = 0.f; }
#pragma unroll
        for (int e = 0; e < 32; ++e) {
#pragma unroll
            for (int j = 0; j < 4; ++j) { const f32x4 w4 = *(const LAS f32x4*)(rw + e * 1024 + lane * 4 + 256 * j);
                pa[e] += (va[j][0] * w4[0] + va[j][1] * w4[1]) + (va[j][2] * w4[2] + va[j][3] * w4[3]); pb[e] += (vb[j][0] * w4[0] + vb[j][1] * w4[1]) + (vb[j][2] * w4[2] + vb[j][3] * w4[3]); }
            if ((e & 3) == 3) __builtin_amdgcn_sched_barrier(0); }
        float r16a[16], r16b[16];
#pragma unroll
        for (int e = 0; e < 16; ++e) { const bool up = (lane & 32) != 0; r16a[e] = (up ? pa[16 + e] : pa[e]) + __shfl_xor(up ? pa[e] : pa[16 + e], 32); r16b[e] = (up ? pb[16 + e] : pb[e]) + __shfl_xor(up ? pb[e] : pb[16 + e], 32); }
        float r8a[8], r8b[8];
#pragma unroll
        for (int e = 0; e < 8; ++e) { const bool up = (lane & 16) != 0; r8a[e] = (up ? r16a[8 + e] : r16a[e]) + __shfl_xor(up ? r16a[e] : r16a[8 + e], 16); r8b[e] = (up ? r16b[8 + e] : r16b[e]) + __shfl_xor(up ? r16b[e] : r16b[8 + e], 16); }
        float r4a[4], r4b[4];
#pragma unroll
        for (int e = 0; e < 4; ++e) { const bool up = (lane & 8) != 0; r4a[e] = (up ? r8a[4 + e] : r8a[e]) + __shfl_xor(up ? r8a[e] : r8a[4 + e], 8); r4b[e] = (up ? r8b[4 + e] : r8b[e]) + __shfl_xor(up ? r8b[e] : r8b[4 + e], 8); }
        float r2a[2], r2b[2];
#pragma unroll
        for (int e = 0; e < 2; ++e) { const bool up = (lane & 4) != 0; r2a[e] = (up ? r4a[2 + e] : r4a[e]) + __shfl_xor(up ? r4a[e] : r4a[2 + e], 4); r2b[e] = (up ? r4b[2 + e] : r4b[e]) + __shfl_xor(up ? r4b[e] : r4b[2 + e], 4); }
        float r1a, r1b; { const bool up = (lane & 2) != 0; r1a = (up ? r2a[1] : r2a[0]) + __shfl_xor(up ? r2a[0] : r2a[1], 2); r1b = (up ? r2b[1] : r2b[0]) + __shfl_xor(up ? r2b[0] : r2b[1], 2); }
        r1a += __shfl_xor(r1a, 1); r1b += __shfl_xor(r1b, 1);
        if ((lane & 1) == 0) { const int l0 = it * 8 + wid; if (l0 < 112) lgt[l0 * 36 + ex] = r1a + rbias; if (has1 && l0 + 8 < 112) lgt[(l0 + 8) * 36 + ex] = r1b + rbias; }
    }
    __syncthreads();
    const int ntl = (T - wg * 8 + nwg * 8 - 1) / (nwg * 8) * 8;
    int te[4] = {0, 0, 0, 0}, lp[4] = {0, 0, 0, 0}; float tw[4] = {0.f, 0.f, 0.f, 0.f};
    const int tmine = wg * 8 + (tid & 7) + (tid >> 3) * nwg * 8; const bool mine = tid < 112 && tid < ntl && tmine < T;
    if (mine) { float v[32];
#pragma unroll
        for (int e4 = 0; e4 < 8; ++e4) { const f32x4 q4 = *(const LAS f32x4*)(lgt + tid * 36 + e4 * 4); v[e4 * 4] = q4[0]; v[e4 * 4 + 1] = q4[1]; v[e4 * 4 + 2] = q4[2]; v[e4 * 4 + 3] = q4[3]; }
        float tv[4];
#pragma unroll
        for (int k = 0; k < 4; ++k) { float best = -INFINITY; int bi = 0;
#pragma unroll
            for (int e = 0; e < 32; ++e) { const bool bt = v[e] > best; best = bt ? v[e] : best; bi = bt ? e : bi; }
#pragma unroll
            for (int e = 0; e < 32; ++e) v[e] = (e == bi) ? -INFINITY : v[e];
            tv[k] = best; te[k] = bi; }
        const float e1 = __expf(tv[1] - tv[0]), e2 = __expf(tv[2] - tv[0]), e3 = __expf(tv[3] - tv[0]); const float inv = 1.f / (1.f + e1 + e2 + e3);
        tw[0] = inv; tw[1] = e1 * inv; tw[2] = e2 * inv; tw[3] = e3 * inv;
#pragma unroll
        for (int k = 0; k < 4; ++k) lp[k] = __hip_atomic_fetch_add(lcnt + te[k], 1, __ATOMIC_RELAXED, __HIP_MEMORY_SCOPE_WORKGROUP); }
    __syncthreads();
    if (tid < 32) gbase[tid] = (int)__hip_atomic_fetch_add((unsigned*)A.cnt + tid, (unsigned)lcnt[tid], __ATOMIC_RELAXED, __HIP_MEMORY_SCOPE_AGENT);
    __syncthreads();
    if (mine) {
#pragma unroll
        for (int k = 0; k < 4; ++k) { const int e = te[k], pos = gbase[e] + lp[k], tk = tmine * 4 + k;
            A.list[(size_t)e * T + pos] = tk; A.wlist[tk] = tw[k]; A.tinfo[tk] = e | (pos << 8); } }
}
struct CombArgs { const float* h1; const bf16_t* y; const int* tinfo; const float* tw; const int* cnt; const float* g; float* out; };
__device__ __forceinline__ void combine_phase(LAS unsigned char* lds, const CombArgs& A, int wg, int nwg) {
    const int tid = tid_fresh(), wid = __builtin_amdgcn_readfirstlane(tid >> 6), lane = tid & 63;
    LAS int* toff = (LAS int*)(lds + LDS_MISC + 64);
    __syncthreads();
    if (tid == 0) { int a = 0; for (int e = 0; e < NE; ++e) { toff[e] = a; a += (A.cnt[e] + 255) >> 8; } }
    __syncthreads();
    f32x4 gv[4];
#pragma unroll
    for (int j = 0; j < 4; ++j) gv[j] = *(const f32x4*)(A.g + lane * 4 + 256 * j);
    for (int t = wg * 8 + wid; t < T; t += nwg * 8) {
        size_t so[4]; float tw[4];
#pragma unroll
        for (int k = 0; k < 4; ++k) { const int inf = A.tinfo[t * 4 + k]; so[k] = ((size_t)toff[inf & 255] * 256 + (inf >> 8)) * 1024; tw[k] = A.tw[t * 4 + k]; }
        f32x4 v[4]; float s = 0.f;
#pragma unroll
        for (int j = 0; j < 4; ++j) { v[j] = *(const f32x4*)(A.h1 + (size_t)t * D + lane * 4 + 256 * j);
#pragma unroll
            for (int k = 0; k < 4; ++k) { const u32x2 yy = *(const u32x2*)(A.y + so[k] + lane * 4 + 256 * j);
                v[j][0] += tw[k] * __uint_as_float(yy.x << 16); v[j][1] += tw[k] * __uint_as_float(yy.x & 0xffff0000u); v[j][2] += tw[k] * __uint_as_float(yy.y << 16); v[j][3] += tw[k] * __uint_as_float(yy.y & 0xffff0000u); }
            s += (v[j][0] * v[j][0] + v[j][1] * v[j][1]) + (v[j][2] * v[j][2] + v[j][3] * v[j][3]); }
        s = wsum(s); const float rs = rsqrtf(s * (1.f / 1024.f) + 1e-6f);
#pragma unroll
        for (int j = 0; j < 4; ++j) *(f32x4*)(A.out + (size_t)t * D + lane * 4 + 256 * j) = v[j] * rs * gv[j];
    }
}
}
#define XB_TMO      128
#define XB_XCNT(j)  (256  + 64 * (j))
#define XB_XSUB(j)  (1280 + 64 * (j))
#define XB_XGEN(j)  (2304 + 64 * (j))
#define XB_TOP      3328
#define XB_TOPGEN   3392
#define XCD_BAR_WORDS 3456
#define XB_SPIN_CAP (1u << 18)
__device__ __forceinline__ unsigned xb_ld(unsigned* p)              { return __hip_atomic_load(p, __ATOMIC_RELAXED, __HIP_MEMORY_SCOPE_AGENT); }
__device__ __forceinline__ unsigned xb_add(unsigned* p, unsigned v) { return __hip_atomic_fetch_add(p, v, __ATOMIC_RELAXED, __HIP_MEMORY_SCOPE_AGENT); }
__device__ __forceinline__ unsigned xb_xcc_id() { return (unsigned)__builtin_amdgcn_s_getreg((3 << 11) | 20) & 0xFu; }
#define XB_SPIN(cond, bar) do { unsigned _sp = 0; while (cond) { __builtin_amdgcn_s_sleep(1); \
    if ((++_sp & 255u) == 0u) { if (xb_ld(&(bar)[XB_TMO])) break; if (_sp > XB_SPIN_CAP) { atomicAdd(&(bar)[XB_TMO], 1u); break; } } } } while (0)
struct XcdBarrier { unsigned* bar; unsigned x; volatile LAS unsigned* st; };
__device__ __forceinline__ XcdBarrier xcd_barrier_post(unsigned* bar, volatile LAS unsigned* st) {
    XcdBarrier b; b.bar = bar; b.x = xb_xcc_id(); b.st = st;
    if (threadIdx.x == 0) (void)xb_add(&bar[XB_XCNT(b.x)], 1u);
    return b;
}
__device__ __forceinline__ void xcd_barrier_complete(unsigned* bar, unsigned x, unsigned& nloc, unsigned& nx) {
    const unsigned G = gridDim.x * gridDim.y * gridDim.z;
    unsigned sum, cnt, mine, sp = 0u;
    for (;;) {
        sum = 0u; cnt = 0u; mine = 0u;
#pragma unroll
        for (unsigned j = 0; j < 16; ++j) { const unsigned c = xb_ld(&bar[XB_XCNT(j)]); sum += c; cnt += (c > 0u) ? 1u : 0u; mine = (j == x) ? c : mine; }
        if (sum == G) break;
        __builtin_amdgcn_s_sleep(1);
        if ((++sp & 255u) == 0u) { if (xb_ld(&bar[XB_TMO])) break; if (sp > XB_SPIN_CAP) { atomicAdd(&bar[XB_TMO], 1u); break; } }
    }
    nloc = mine > 0u ? mine : 1u; nx = cnt > 0u ? cnt : 1u;
}
__device__ __forceinline__ void xcd_barrier(const XcdBarrier& b) {
    asm volatile("s_waitcnt vmcnt(0)" ::: "memory");
    __syncthreads();
    if (threadIdx.x == 0) {
        unsigned* bar = b.bar;
        __builtin_amdgcn_s_waitcnt(0);
        unsigned nloc = b.st[0], nx = b.st[1];
        if (nloc == 0u) { xcd_barrier_complete(bar, b.x, nloc, nx); b.st[0] = nloc; b.st[1] = nx; }
        const unsigned old = xb_add(&bar[XB_XSUB(b.x)], 1u);
        const unsigned gen = old / nloc;
        if (old + 1u == (gen + 1u) * nloc) {
            __builtin_amdgcn_fence(__ATOMIC_RELEASE, "agent");
            asm volatile("s_waitcnt vmcnt(0)" ::: "memory");
            const unsigned og = xb_add(&bar[XB_TOP], 1u);
            const unsigned tg = og / nx;
            if (og + 1u == (tg + 1u) * nx) xb_add(&bar[XB_TOPGEN], 1u);
            else XB_SPIN(xb_ld(&bar[XB_TOPGEN]) == tg, bar);
            __builtin_amdgcn_fence(__ATOMIC_ACQUIRE, "agent");
            xb_add(&bar[XB_XGEN(b.x)], 1u);
            asm volatile("s_waitcnt vmcnt(0)" ::: "memory");
        } else {
            XB_SPIN(xb_ld(&bar[XB_XGEN(b.x)]) == gen, bar);
            __builtin_amdgcn_fence(__ATOMIC_ACQUIRE, "agent");
            asm volatile("s_waitcnt vmcnt(0)" ::: "memory");
        }
    }
    __syncthreads();
}

namespace mk {
constexpr int LDS_BAR = 155648, LDS_FUSED = LDS_BAR + 256;
constexpr int CTL_QUEUE = 4096;
struct Params {
    const float *x, *attn_norm, *w_in, *rel_bias, *cmp_pos, *cmp_w1, *cmp_w2, *attn_out_norm, *conv_w, *conv_b, *dt_bias, *a_log, *d_skip, *ssm_out_norm, *w_out, *ffn_norm,
                *router_w, *router_b, *w_gu, *b_gu, *w_dn, *b_dn, *final_norm;
    float* out; unsigned* ctl; int* cnt;
    bf16_t *xb, *WinT, *WoutT, *w1T, *projb, *catb, *kc, *vc, *states, *ymoe; f8_t *WguT, *WdnT, *hn8, *act;
    float *posb, *alast, *h1, *wlist; int *list, *tinfo;
    int ph_lo, ph_hi;
};
constexpr int NT_WIN = 48 * 16, NT_WOUT = 16 * 16, NT_WGU = 32 * 32 * 8, NT_WDN = 32 * 16 * 8, NT_W1 = 2 * 32, NT_ALL = NT_WIN + NT_WOUT + NT_WGU + NT_WDN + NT_W1;
__device__ __forceinline__ void p0_prologue(LAS unsigned char* lds, const Params& p, int wg, int nwg) {
    const int tid = tid_fresh(), wid = __builtin_amdgcn_readfirstlane(tid >> 6), lane = tid & 63;
    for (int r = wg * 8 + wid; r < T; r += nwg * 8) rms_row_bf16(p.x + (size_t)r * D, p.xb + (size_t)r * D, lane);
    for (int o = wg * 8 + wid; o < 128; o += nwg * 8) { const int j = o >> 6, sl = o & 63; float s = 0.f;
#pragma unroll
        for (int kk = 0; kk < 32; ++kk) { const int k = sl * 32 + kk; s += p.cmp_pos[j * 2048 + k] * p.cmp_w1[((size_t)j * 2048 + k) * 64 + lane]; }
        p.posb[o * 64 + lane] = s; }
    LAS float* tl = (LAS float*)(lds + wid * WT_TILE_BYTES);
    __syncthreads();
    for (int task = wg * 8 + wid; task < NT_ALL; task += nwg * 8) { int idx = task;
        if (idx < NT_WIN) { wt_tile<false>(p.w_in, p.WinT, p.attn_norm, p.attn_norm, 1024, 1024, 2848, 3072, 0, 512, 0.125f * LOG2E, 48, 16, idx, tl, lane); continue; } idx -= NT_WIN;
        if (idx < NT_WOUT) { wt_tile<false>(p.w_out, p.WoutT, p.attn_out_norm, p.ssm_out_norm, 512, 1024, 1024, 1024, 0, 0, 1.f, 16, 16, idx, tl, lane); continue; } idx -= NT_WOUT;
        if (idx < NT_WGU) { wt_tile<true>(p.w_gu, p.WguT, p.ffn_norm, p.ffn_norm, 1024, 1024, 2048, 2048, 1, 2048, W8_SCALE, 32, 8, idx, tl, lane); continue; } idx -= NT_WGU;
        if (idx < NT_WDN) { wt_tile<true>(p.w_dn, p.WdnT, nullptr, nullptr, 0, 1024, 1024, 1024, 0, 1024, W8_SCALE, 16, 8, idx, tl, lane); continue; } idx -= NT_WDN;
        wt_tile<false>(p.cmp_w1, p.w1T, nullptr, nullptr, 0, 2048, 64, 64, 0, 0, 1.f, 1, 32, idx, tl, lane); }
}
__global__ void __launch_bounds__(512, 2) k_fused(Params p) {
    extern __shared__ __attribute__((aligned(16))) unsigned char dl[];
    LAS unsigned char* lds = (LAS unsigned char*)dl;
    const int wg = blockIdx.x, nwg = gridDim.x; int tid = tid_fresh();
    if (tid < 64) ((LAS unsigned*)(lds + LDS_BAR))[tid] = 0u;
    __syncthreads();
    XcdBarrier bar = xcd_barrier_post(p.ctl, (volatile LAS unsigned*)(lds + LDS_BAR));
#ifdef MK_ONLY
#define PH(k) ((k) == MK_ONLY && p.ph_lo <= (k) && (k) < p.ph_hi)
#else
#define PH(k) (p.ph_lo <= (k) && (k) < p.ph_hi)
#endif
#ifdef MK_REPEAT
#define REP(k) for (int _rep = 0; _rep < ((k) == MK_REPEAT ? 2 : 1); ++_rep)
#else
#define REP(k)
#endif
#ifdef MK_REPEAT
#define QREP _rep
#else
#define QREP 0
#endif
#ifdef MK_BARX2
#define SEAM(k) do { if (PH(k) && PH((k) + 1)) { xcd_barrier(bar); xcd_barrier(bar); } } while (0)
#else
#define SEAM(k) do { if (PH(k) && PH((k) + 1)) xcd_barrier(bar); } while (0)
#endif
    if (PH(0)) { p0_prologue(lds, p, wg, nwg);
#ifdef MK_P0X2
        __syncthreads(); p0_prologue(lds, p, wg, nwg);
#endif
    }
    SEAM(0);
    REP(1) if (PH(1)) { ProbProj P; P.S.init(T, NPROJ, nwg, wg); P.A = p.xb; P.Bt = p.WinT; P.O = p.projb; gemm_phase(lds, P); }
    SEAM(1);
    REP(2) if (PH(2)) {
        const SsdArgs SA{p.projb, p.conv_w, p.conv_b, p.dt_bias, p.a_log, p.d_skip, p.states, p.alast, p.catb};
        const CmpArgs CA{p.projb, p.w1T, p.posb, p.cmp_w2, p.kc, p.vc};
        for (int it = wg; it < 384; it += nwg) { const int v = 383 - it; if (v < 128) cmp_item(lds, CA, v); else ssd_a_item(lds, SA, v - 128); }
    }
    SEAM(2);
    REP(3) if (PH(3)) {
        const SsdArgs SA{p.projb, p.conv_w, p.conv_b, p.dt_bias, p.a_log, p.d_skip, p.states, p.alast, p.catb};
        const AttnArgs AA{p.projb, p.kc, p.vc, p.catb};
        attn_btab(lds, p.rel_bias);
        LAS int* qslot = (LAS int*)(lds + LDS_BAR + 64);
        for (;;) {
            __syncthreads();
            if (tid_fresh() == 0) qslot[0] = (int)__hip_atomic_fetch_add(p.ctl + CTL_QUEUE + 64 * QREP, 1u, __ATOMIC_RELAXED, __HIP_MEMORY_SCOPE_AGENT);
            __syncthreads();
            const int it = qslot[0];
#if defined(MK_QX_ATTN) || defined(MK_QX_SSDB)
            if (it >= 768) break;
#else
            if (it >= 512) break;
#endif
#if defined(MK_QX_ATTN)
            { const int i2 = it >= 512 ? it - 512 : it; if (i2 < 256) attn_item(lds, AA, i2 & 7, 31 - (i2 >> 3)); else ssd_b_item(lds, SA, i2 - 256); }
#elif defined(MK_QX_SSDB)
            { const int i2 = it >= 512 ? it - 256 : it; if (i2 < 256) attn_item(lds, AA, i2 & 7, 31 - (i2 >> 3)); else ssd_b_item(lds, SA, i2 - 256); }
#else
            if (it < 256) attn_item(lds, AA, it & 7, 31 - (it >> 3)); else ssd_b_item(lds, SA, it - 256);
#endif
        }
    }
    SEAM(3);
    REP(4) if (PH(4)) { ProbOut P; P.S.init(T, D, nwg, wg); P.A = p.catb; P.Bt = p.WoutT; P.R0 = p.x; P.O = p.h1; gemm_phase(lds, P); }
    SEAM(4);
    REP(5) if (PH(5)) { const bool dm = QREP != 0; const RouteArgs RA{p.h1, p.ffn_norm, p.router_w, p.router_b, p.hn8, dm ? p.cnt + 64 : p.cnt, dm ? (int*)p.act : p.list, dm ? (float*)p.act + (4u << 20) : p.wlist, dm ? (int*)p.act + (8u << 20) : p.tinfo}; route_phase(lds, RA, wg, nwg); }
    SEAM(5);
    REP(6) if (PH(6)) {
        tid = tid_fresh();
        __syncthreads();
        const int RT = moe_tables(lds, p.cnt);
        ProbMoe1 P; P.S.nN = 8; P.S.G = nwg; P.S.c = (nwg % 8 == 0) ? (wg & 7) * (nwg >> 3) + (wg >> 3) : wg; P.S.RT = RT; P.S.tile_e = (const LAS int*)(lds + LDS_TILE_E); P.S.tile_m = (const LAS int*)(lds + LDS_TILE_M);
        P.A = p.hn8; P.Bt = p.WguT; P.bias = p.b_gu; P.O = p.act; P.rowtab = (const LAS unsigned*)(lds + LDS_ROWTAB);
        LAS unsigned* rowtab = (LAS unsigned*)(lds + LDS_ROWTAB);
#pragma unroll 1
        for (int i = 0; i < 12; ++i) { Unit u; if (!P.S.next(i, u)) break; if (tid < 256) { const int pos = u.mt * 256 + tid; const int c = p.cnt[u.e];
            const int tok = (pos < c) ? (p.list[(size_t)u.e * T + pos] >> 2) : 0; rowtab[i * 256 + tid] = (unsigned)tok * KD; } }
        __syncthreads();
        gemm_phase(lds, P);
    }
    SEAM(6);
    REP(7) if (PH(7)) {
        __syncthreads();
        const int RT = moe_tables(lds, p.cnt);
        ProbMoe2 P; P.S.nN = 4; P.S.G = nwg; P.S.c = (nwg % 8 == 0) ? (wg & 7) * (nwg >> 3) + (wg >> 3) : wg; P.S.RT = RT; P.S.tile_e = (const LAS int*)(lds + LDS_TILE_E); P.S.tile_m = (const LAS int*)(lds + LDS_TILE_M);
        P.A = p.act; P.Bt = p.WdnT; P.bias = p.b_dn; P.O = p.ymoe;
        gemm_phase(lds, P);
    }
    SEAM(7);
    REP(8) if (PH(8)) { const CombArgs CA{p.h1, p.ymoe, p.tinfo, p.wlist, p.cnt, p.final_norm, p.out}; combine_phase(lds, CA, wg, nwg); }
#undef PH
#undef SEAM
}
}

extern "C" void kernel_launch(void* const* d_in, const int* in_sizes, int n_in, void* d_out, int out_size, void* d_ws, size_t ws_size, hipStream_t stream) {
    using namespace mk;
    char* ws = (char*)d_ws; const size_t MB = 1u << 20;
    size_t o = 0; auto take = [&](size_t mb) { char* q = ws + o; o += mb * MB; return q; };
    Params p;
    memset(&p, 0, sizeof(p));
    const float** fin = (const float**)&p.x;
    for (int i = 0; i < 23; ++i) fin[i] = (const float*)d_in[i];
    p.out = (float*)d_out;
    p.ctl = (unsigned*)take(1); p.cnt = (int*)(p.ctl + 8192);
    p.xb = (bf16_t*)take(32); p.WinT = (bf16_t*)take(6); p.WoutT = (bf16_t*)take(2); p.WguT = (f8_t*)take(64); p.WdnT = (f8_t*)take(32); p.w1T = (bf16_t*)take(1);
    p.projb = (bf16_t*)take(96); p.catb = (bf16_t*)take(32); p.hn8 = (f8_t*)take(16); p.kc = (bf16_t*)take(1); p.vc = (bf16_t*)take(1); p.states = (bf16_t*)take(16);
    p.act = (f8_t*)take(72); p.ymoe = (bf16_t*)take(144);
    p.posb = (float*)take(1); p.alast = (float*)take(1); p.h1 = (float*)take(64); p.wlist = (float*)take(2); p.list = (int*)take(2); p.tinfo = (int*)take(1);
    static int grid = 0;
    if (!grid) {
        int dev = 0, cus = 0, per_cu = 0;
        (void)hipGetDevice(&dev); (void)hipDeviceGetAttribute(&cus, hipDeviceAttributeMultiprocessorCount, dev);
        (void)hipFuncSetAttribute((const void*)k_fused, hipFuncAttributeMaxDynamicSharedMemorySize, LDS_FUSED);
        (void)hipOccupancyMaxActiveBlocksPerMultiprocessor(&per_cu, (const void*)k_fused, 512, LDS_FUSED);
        (void)hipGetLastError();
        grid = cus > 0 ? cus : 256;
    }
    (void)hipMemsetAsync(p.ctl, 0, 65536, stream);
#ifndef MK_SPLIT
    p.ph_lo = 0; p.ph_hi = 9;
    hipLaunchKernelGGL(k_fused, dim3(grid), dim3(512), LDS_FUSED, stream, p);
#else
    for (int k = 0; k < 9; ++k) { p.ph_lo = k; p.ph_hi = k + 1; hipLaunchKernelGGL(k_fused, dim3(grid), dim3(512), LDS_FUSED, stream, p); }
#endif
}
```

```cpp
#include <hip/hip_runtime.h>
#include <stdint.h>
#include <string.h>
#include <math.h>
namespace mk {
#define LAS __attribute__((address_space(3)))
typedef unsigned short bf16_t;
typedef short bf16x8 __attribute__((ext_vector_type(8)));
typedef float f32x4 __attribute__((ext_vector_type(4)));
typedef unsigned u32x4 __attribute__((ext_vector_type(4)));
typedef unsigned u32x2 __attribute__((ext_vector_type(2)));
constexpr int NB = 8, S = 2048, D = 1024, T = NB * S, NE = 32;
constexpr int BM = 256, BK = 64, HALF = 128, HTB = HALF * BK * 2, STAGE_BYTES = 8 * HTB, NXCD = 8, WGM = 8;
constexpr int KD = 1024;
constexpr int NPROJ = 3072;
constexpr int MAXSLOT = 65536 + 32 * 256;
constexpr int LDS_MISC = 131072, LDS_TILE_E = LDS_MISC + 64, LDS_TILE_M = LDS_TILE_E + 1536, LDS_ROWTAB = LDS_MISC + 4096, LDS_BIASTAB = LDS_ROWTAB + 12 * 1024, LDS_BYTES = LDS_BIASTAB + 12 * 1024;

__host__ __device__ __forceinline__ int lds_byte(int r, int c) { const int st = (r >> 4) * 2 + (c >> 5), rr = r & 15, cc = c & 31, ob = rr * 64 + cc * 2; return st * 1024 + (ob ^ (((ob >> 9) & 1) << 5)); }
__host__ __device__ __forceinline__ void stage_rc(int b, int& R, int& C) { const int st = b / 1024, sb = b % 1024, swz = sb ^ (((sb >> 9) & 1) << 5); R = (st >> 1) * 16 + swz / 64; C = (st & 1) * 32 + (swz % 64) / 2; }
__host__ __device__ __forceinline__ int perm32(int rho) { const int n = rho >> 4, i = rho & 15; return 8 * (i >> 2) + 4 * n + (i & 3); }
__device__ __forceinline__ unsigned cvt_pk_bf16(float lo, float hi) { unsigned r; asm volatile("v_cvt_pk_bf16_f32 %0, %1, %2" : "=v"(r) : "v"(lo), "v"(hi)); return r; }
__device__ __forceinline__ int tid_fresh() { int t = threadIdx.x; asm volatile("" : "+v"(t)); return t; }
__device__ __forceinline__ float bf2f(bf16_t b) { return __uint_as_float(((unsigned)b) << 16); }

struct Unit { int pm, pn, e, mt, li; };
struct StaticOrder {
    int nM, nN, nwg, G, c;
    __device__ void init(int M, int N, int G_, int c_) { nM = M / BM; nN = N / BM; nwg = nM * nN; G = G_; c = c_; }
    __device__ bool next(int i, Unit& u) const {
        const long L = (long)i * G + c; if (L >= nwg) return false;
        int wgid = (int)L; { const int q = nwg / NXCD, r = nwg % NXCD, xcd = wgid % NXCD, off = wgid / NXCD; wgid = (xcd < r ? xcd * (q + 1) : r * (q + 1) + (xcd - r) * q) + off; }
        const int nig = WGM * nN, gid = wgid / nig, fm = gid * WGM, gsz = (nM - fm) < WGM ? (nM - fm) : WGM;
        u.pm = fm + ((wgid % nig) % gsz); u.pn = (wgid % nig) / gsz; u.e = 0; u.mt = 0; u.li = i; return true;
    }
};
struct MoeOrder {
    int nN, G, c, RT; const LAS int* tile_e; const LAS int* tile_m;
    __device__ bool next(int i, Unit& u) const { const int L = i * G + c; if (L >= RT * nN) return false; const int rt = L / nN; u.pm = rt; u.pn = L - rt * nN; u.e = tile_e[rt]; u.mt = tile_m[rt]; u.li = i; return true; }
};

struct ProbProj {
    static constexpr bool PERM = true, F8 = false; static constexpr int ROWB = KD * 2;
    StaticOrder S; const bf16_t* A; const bf16_t* Bt; bf16_t* O;
    __device__ __forceinline__ bool next(int i, Unit& u) const { return S.next(i, u); }
    __device__ __forceinline__ const char* a_base(const Unit& u) const { return (const char*)A + (size_t)u.pm * (BM * KD * 2); }
    __device__ __forceinline__ const char* b_base(const Unit& u) const { return (const char*)Bt + (size_t)u.pn * (BM * KD * 2); }
    __device__ __forceinline__ void a_offs(int, const Unit&, unsigned (&v0)[2], unsigned (&v1)[2], const int (&R)[2], const int (&C)[2]) const {
#pragma unroll
        for (int i = 0; i < 2; ++i) { v0[i] = (unsigned)(R[i] * KD + C[i]) * 2u; v1[i] = v0[i] + (unsigned)(HALF * KD * 2); } }
    __device__ __forceinline__ void epi(const f32x4 (&acc)[2][2][4][2], const Unit& u, int wr, int wc, int fr, int fq) const {
        const int row0 = u.pm * BM + wr * 64 + fr, col0 = u.pn * BM + wc * 32 + 8 * fq;
#pragma unroll
        for (int ai = 0; ai < 2; ++ai)
#pragma unroll
            for (int m = 0; m < 4; ++m) { bf16_t* rowp = O + (size_t)(row0 + ai * HALF + m * 16) * NPROJ + col0;
#pragma unroll
                for (int bj = 0; bj < 2; ++bj) { const f32x4 v0 = acc[ai][bj][m][0], v1 = acc[ai][bj][m][1]; u32x4 w;
                    w.x = cvt_pk_bf16(v0[0], v0[1]); w.y = cvt_pk_bf16(v0[2], v0[3]); w.z = cvt_pk_bf16(v1[0], v1[1]); w.w = cvt_pk_bf16(v1[2], v1[3]);
                    *(u32x4*)(rowp + bj * HALF) = w; } }
    }
};
struct ProbOut {
    static constexpr bool PERM = false, F8 = false; static constexpr int ROWB = KD * 2;
    StaticOrder S; const bf16_t* A; const bf16_t* Bt; const float* R0; float* O;
    __device__ __forceinline__ bool next(int i, Unit& u) const { return S.next(i, u); }
    __device__ __forceinline__ const char* a_base(const Unit& u) const { return (const char*)A + (size_t)u.pm * (BM * KD * 2); }
    __device__ __forceinline__ const char* b_base(const Unit& u) const { return (const char*)Bt + (size_t)u.pn * (BM * KD * 2); }
    __device__ __forceinline__ void a_offs(int, const Unit&, unsigned (&v0)[2], unsigned (&v1)[2], const int (&R)[2], const int (&C)[2]) const {
#pragma unroll
        for (int i = 0; i < 2; ++i) { v0[i] = (unsigned)(R[i] * KD + C[i]) * 2u; v1[i] = v0[i] + (unsigned)(HALF * KD * 2); } }
    __device__ __forceinline__ void epi(const f32x4 (&acc)[2][2][4][2], const Unit& u, int wr, int wc, int fr, int fq) const {
        const int row0 = u.pm * BM + wr * 64 + fr, col0 = u.pn * BM + wc * 32 + 4 * fq;
#pragma unroll
        for (int ai = 0; ai < 2; ++ai)
#pragma unroll
            for (int m = 0; m < 4; ++m) { const size_t off = (size_t)(row0 + ai * HALF + m * 16) * D + col0;
#pragma unroll
                for (int bj = 0; bj < 2; ++bj)
#pragma unroll
                    for (int n = 0; n < 2; ++n) { const f32x4 r = *(const f32x4*)(R0 + off + bj * HALF + n * 16); *(f32x4*)(O + off + bj * HALF + n * 16) = acc[ai][bj][m][n] + r; }
                asm volatile("" ::: "memory"); }
    }
};
typedef unsigned char f8_t;
typedef int i32x8 __attribute__((ext_vector_type(8)));
typedef int i32x4 __attribute__((ext_vector_type(4)));
constexpr float W8_SCALE = 32.f, W8_INV = 1.f / 32.f;
__device__ __forceinline__ unsigned pk4_fp8(float a, float b, float c, float d) { int r = __builtin_amdgcn_cvt_pk_fp8_f32(a, b, 0, false); r = __builtin_amdgcn_cvt_pk_fp8_f32(c, d, r, true); return (unsigned)r; }
struct ProbMoe1 {
    static constexpr bool PERM = true, F8 = true; static constexpr int ROWB = KD;
    MoeOrder S; const f8_t* A; const f8_t* Bt; const LAS float* btab; f8_t* O; const LAS unsigned* rowtab;
    __device__ __forceinline__ bool next(int i, Unit& u) const { return S.next(i, u); }
    __device__ __forceinline__ const char* a_base(const Unit&) const { return (const char*)A; }
    __device__ __forceinline__ const char* b_base(const Unit& u) const { return (const char*)Bt + ((size_t)u.e * 2048 + (size_t)u.pn * BM) * ROWB; }
    __device__ __forceinline__ void a_offs(int i, const Unit&, unsigned (&v0)[2], unsigned (&v1)[2], const int (&R)[2], const int (&C)[2]) const {
#pragma unroll
        for (int j = 0; j < 2; ++j) { v0[j] = rowtab[i * 256 + R[j]] + (unsigned)C[j] * 2u; v1[j] = rowtab[i * 256 + HALF + R[j]] + (unsigned)C[j] * 2u; } }
    __device__ __forceinline__ void epi(const f32x4 (&acc)[2][2][4][2], const Unit& u, int wr, int wc, int fr, int fq) const {
        const int row0 = u.pm * BM + wr * 64 + fr, jg0 = u.pn * HALF + wc * 32 + 8 * fq;
        f32x4 bg[2], bu[2];
#pragma unroll
        for (int n = 0; n < 2; ++n) { bg[n] = *(const LAS f32x4*)(btab + u.li * 256 + wc * 32 + 8 * fq + 4 * n); bu[n] = *(const LAS f32x4*)(btab + u.li * 256 + 128 + wc * 32 + 8 * fq + 4 * n); }
#pragma unroll
        for (int ai = 0; ai < 2; ++ai)
#pragma unroll
            for (int m = 0; m < 4; ++m) { float o[8];
#pragma unroll
                for (int n = 0; n < 2; ++n) { const f32x4 g4 = acc[ai][0][m][n] * W8_INV + bg[n], u4 = acc[ai][1][m][n] * W8_INV + bu[n];
#pragma unroll
                    for (int j = 0; j < 4; ++j) { const float g = fminf(g4[j], 7.f), uu = fminf(fmaxf(u4[j], -7.f), 7.f);
                        const float sg = __builtin_amdgcn_rcpf(1.f + __builtin_amdgcn_exp2f(-1.702f * 1.4426950408889634f * g)); o[n * 4 + j] = (uu + 1.f) * g * sg; } }
                *(u32x2*)(O + (size_t)(row0 + ai * HALF + m * 16) * 1024 + jg0) = (u32x2){pk4_fp8(o[0], o[1], o[2], o[3]), pk4_fp8(o[4], o[5], o[6], o[7])}; }
    }
};
struct ProbMoe2 {
    static constexpr bool PERM = true, F8 = true; static constexpr int ROWB = KD;
    MoeOrder S; const f8_t* A; const f8_t* Bt; const LAS float* btab; f8_t* O;
    __device__ __forceinline__ bool next(int i, Unit& u) const { return S.next(i, u); }
    __device__ __forceinline__ const char* a_base(const Unit& u) const { return (const char*)A + (size_t)u.pm * (BM * ROWB); }
    __device__ __forceinline__ const char* b_base(const Unit& u) const { return (const char*)Bt + ((size_t)u.e * 1024 + (size_t)u.pn * BM) * ROWB; }
    __device__ __forceinline__ void a_offs(int, const Unit&, unsigned (&v0)[2], unsigned (&v1)[2], const int (&R)[2], const int (&C)[2]) const {
#pragma unroll
        for (int i = 0; i < 2; ++i) { v0[i] = (unsigned)(R[i] * ROWB + C[i] * 2); v1[i] = v0[i] + (unsigned)(HALF * ROWB); } }
    __device__ __forceinline__ void epi(const f32x4 (&acc)[2][2][4][2], const Unit& u, int wr, int wc, int fr, int fq) const {
        const int rl0 = wr * 64 + fr, col0 = u.pn * BM + wc * 32 + 8 * fq;
#pragma unroll
        for (int ai = 0; ai < 2; ++ai)
#pragma unroll
            for (int m = 0; m < 4; ++m) { const int rl = rl0 + ai * HALF + m * 16;
                f8_t* rowp = O + (size_t)(u.pm * BM + rl) * 1024 + col0;
#pragma unroll
                for (int bj = 0; bj < 2; ++bj) { const f32x4 b0 = *(const LAS f32x4*)(btab + u.li * 256 + bj * HALF + wc * 32 + 8 * fq), b1 = *(const LAS f32x4*)(btab + u.li * 256 + bj * HALF + wc * 32 + 8 * fq + 4);
                    const f32x4 v0 = acc[ai][bj][m][0] * W8_INV + b0, v1 = acc[ai][bj][m][1] * W8_INV + b1;
                    *(u32x2*)(rowp + bj * HALF) = (u32x2){pk4_fp8(v0[0], v0[1], v0[2], v0[3]), pk4_fp8(v1[0], v1[1], v1[2], v1[3])}; }
                asm volatile("" ::: "memory"); }
    }
};

template <int N> struct FragBf { bf16x8 v[N][2];
    __device__ __forceinline__ void set(int i, int k, i32x4 x) { v[i][k] = __builtin_bit_cast(bf16x8, x); }
    __device__ __forceinline__ bf16x8 get(int i, int k) const { return v[i][k]; } };
template <int N> struct FragF8 { i32x8 v[N];
    __device__ __forceinline__ void set(int i, int k, i32x4 x) { if (k == 0) v[i].lo = x; else v[i].hi = x; }
    __device__ __forceinline__ bf16x8 get(int, int) const { return bf16x8{}; } };
template <bool F8> struct FragT { typedef FragBf<4> A_t; typedef FragBf<2> B_t; };
template <> struct FragT<true> { typedef FragF8<4> A_t; typedef FragF8<2> B_t; };
template <class P>
__device__ __forceinline__ void gemm_phase(LAS unsigned char* lds, const P& Pb) {
    const int tid = tid_fresh(), wid = __builtin_amdgcn_readfirstlane(tid >> 6), lane = tid & 63, wr = wid >> 2, wc = wid & 3, fr = lane & 15, fq = lane >> 4;
    constexpr int nt = P::ROWB / 128;
    int Rr[2], Cc[2]; unsigned voffB[2];
#pragma unroll
    for (int i = 0; i < 2; ++i) { int R, C; stage_rc(tid * 16 + i * 8192, R, C); const int Rb = P::PERM ? ((R & ~31) + perm32(R & 31)) : R; Rr[i] = R; Cc[i] = C; voffB[i] = (unsigned)(Rb * P::ROWB + C * 2); }
    constexpr size_t kstep = (size_t)(BK * 2);
    constexpr size_t hstep = (size_t)HALF * P::ROWB;
    const unsigned ldsw = (unsigned)wid * 1024u;
    const int aoff = lds_byte(wr * 64 + fr, fq * 8), boff = lds_byte(wc * 32 + fr, fq * 8);
#define PG8_SA(b, h) (((b) * 2 + (h)) * HTB)
#define PG8_SB(b, h) ((4 + (b) * 2 + (h)) * HTB)
#define PG8_STAGE(bufoff, gbase, voff) do { _Pragma("unroll") for (int _i = 0; _i < 2; ++_i) \
        __builtin_amdgcn_global_load_lds((const unsigned*)((const char*)(gbase) + (voff)[_i]), (LAS unsigned*)(lds + (bufoff) + ldsw + _i * 8192), 16, 0, 0); } while (0)
#define PG8_LDA(dst, b, h) do { _Pragma("unroll") for (int m = 0; m < 4; ++m) _Pragma("unroll") for (int k = 0; k < 2; ++k) dst.set(m, k, *(const LAS i32x4*)(lds + PG8_SA(b, h) + aoff + m * 2048 + k * 1024)); } while (0)
#define PG8_LDB(dst, b, h) do { _Pragma("unroll") for (int n = 0; n < 2; ++n) _Pragma("unroll") for (int k = 0; k < 2; ++k) dst.set(n, k, *(const LAS i32x4*)(lds + PG8_SB(b, h) + boff + n * 2048 + k * 1024)); } while (0)
#define PG8_MMA(ai, bj, At, Bt) do { __builtin_amdgcn_s_setprio(1); _Pragma("unroll") for (int m = 0; m < 4; ++m) _Pragma("unroll") for (int n = 0; n < 2; ++n) { \
        if constexpr (P::F8) acc[ai][bj][m][n] = __builtin_amdgcn_mfma_scale_f32_16x16x128_f8f6f4(Bt.v[n], At.v[m], acc[ai][bj][m][n], 0, 0, 0, 0x7f7f7f7f, 0, 0x7f7f7f7f); \
        else { _Pragma("unroll") for (int k = 0; k < 2; ++k) acc[ai][bj][m][n] = __builtin_amdgcn_mfma_f32_16x16x32_bf16(Bt.get(n, k), At.get(m, k), acc[ai][bj][m][n], 0, 0, 0); } } \
        __builtin_amdgcn_s_setprio(0); } while (0)
#define PG8_WAIT_V(n) asm volatile("s_waitcnt vmcnt(" #n ")" ::: "memory")
#define PG8_WAIT_L(n) asm volatile("s_waitcnt lgkmcnt(" #n ")" ::: "memory")
#define PG8_BAR __builtin_amdgcn_s_barrier()
#define PG8_SCHED __builtin_amdgcn_sched_barrier(0)
    Unit cur, nxt; int ui = 0;
    if (!Pb.next(0, cur)) return;
    f32x4 acc[2][2][4][2];
#pragma unroll
    for (int a = 0; a < 2; ++a)
#pragma unroll
        for (int b = 0; b < 2; ++b)
#pragma unroll
            for (int m = 0; m < 4; ++m)
#pragma unroll
                for (int n = 0; n < 2; ++n) acc[a][b][m][n] = (f32x4){0.f, 0.f, 0.f, 0.f};
    typedef typename FragT<P::F8>::A_t AFr; typedef typename FragT<P::F8>::B_t BFr;
    AFr At; BFr B0, B1;
    unsigned vA0[2], vA1[2];
    Pb.a_offs(0, cur, vA0, vA1, Rr, Cc);
    const char* cA = Pb.a_base(cur); const char* cB = Pb.b_base(cur);
    PG8_STAGE(PG8_SB(0, 0), cB, voffB); PG8_STAGE(PG8_SB(0, 1), cB + hstep, voffB); PG8_STAGE(PG8_SA(0, 0), cA, vA0); PG8_STAGE(PG8_SA(0, 1), cA, vA1);
    if (wr == 1) PG8_BAR;
    PG8_WAIT_V(2); PG8_BAR;
    PG8_STAGE(PG8_SB(1, 0), cB + kstep, voffB); PG8_STAGE(PG8_SA(1, 0), cA + kstep, vA0); PG8_STAGE(PG8_SB(1, 1), cB + hstep + kstep, voffB);
    PG8_WAIT_V(6); PG8_BAR;
    for (;;) {
        const bool has_next = Pb.next(ui + 1, nxt);
        const char* nA = has_next ? Pb.a_base(nxt) : cA; const char* nB = has_next ? Pb.b_base(nxt) : cB;
#pragma unroll 1
        for (int t = 0; t < nt; t += 2) {
            const bool last = (t == nt - 2);
            const char* a1 = cA + (size_t)(t + 1) * kstep;
            const char* a2 = last ? nA : cA + (size_t)(t + 2) * kstep; const char* b2 = last ? nB : cB + (size_t)(t + 2) * kstep;
            const char* a3 = a2 + kstep; const char* b3 = b2 + kstep;
            PG8_LDB(B0, 0, 0); PG8_LDB(B1, 0, 1); PG8_SCHED; PG8_LDA(At, 0, 0); PG8_STAGE(PG8_SA(1, 1), a1, vA1);
            PG8_WAIT_V(8); PG8_WAIT_L(0); PG8_BAR; PG8_MMA(0, 0, At, B0); PG8_MMA(0, 1, At, B1); PG8_BAR; PG8_SCHED;
            if (last && has_next) {
                if constexpr (P::F8) { int R2[2], C2[2]; int t2 = tid; asm volatile("" : "+v"(t2));
#pragma unroll
                    for (int i = 0; i < 2; ++i) stage_rc(t2 * 16 + i * 8192, R2[i], C2[i]);
                    Pb.a_offs(ui + 1, nxt, vA0, vA1, R2, C2); }
                else Pb.a_offs(ui + 1, nxt, vA0, vA1, Rr, Cc); }
            PG8_LDA(At, 0, 1); PG8_STAGE(PG8_SB(0, 0), b2, voffB); PG8_STAGE(PG8_SB(0, 1), b2 + hstep, voffB); PG8_STAGE(PG8_SA(0, 0), a2, vA0);
            PG8_WAIT_V(8); PG8_WAIT_L(0); PG8_BAR; PG8_MMA(1, 0, At, B0); PG8_MMA(1, 1, At, B1); PG8_BAR; PG8_SCHED;
            PG8_LDB(B0, 1, 0); PG8_LDB(B1, 1, 1); PG8_SCHED; PG8_LDA(At, 1, 0); PG8_STAGE(PG8_SA(0, 1), a2, vA1);
            PG8_WAIT_V(8); PG8_WAIT_L(0); PG8_BAR; PG8_MMA(0, 0, At, B0); PG8_MMA(0, 1, At, B1); PG8_BAR; PG8_SCHED;
            PG8_LDA(At, 1, 1); PG8_STAGE(PG8_SB(1, 0), b3, voffB); PG8_STAGE(PG8_SB(1, 1), b3 + hstep, voffB); PG8_STAGE(PG8_SA(1, 0), a3, vA0);
            PG8_WAIT_V(8); PG8_WAIT_L(0); PG8_BAR; PG8_MMA(1, 0, At, B0); PG8_MMA(1, 1, At, B1); PG8_BAR; PG8_SCHED;
        }
        if (wr == 0) PG8_BAR;
        if constexpr (P::F8) { int ln2 = lane; asm volatile("" : "+v"(ln2)); Pb.epi(acc, cur, wr, wc, ln2 & 15, ln2 >> 4); } else Pb.epi(acc, cur, wr, wc, fr, fq);
        if (!has_next) break;
#pragma unroll
        for (int a = 0; a < 2; ++a)
#pragma unroll
            for (int b = 0; b < 2; ++b)
#pragma unroll
                for (int m = 0; m < 4; ++m)
#pragma unroll
                    for (int n = 0; n < 2; ++n) acc[a][b][m][n] = (f32x4){0.f, 0.f, 0.f, 0.f};
        cur = nxt; cA = nA; cB = nB; ++ui;
        if (wr == 1) PG8_BAR;
    }
    PG8_WAIT_V(0);
    PG8_BAR;
#undef PG8_SA
#undef PG8_SB
#undef PG8_STAGE
#undef PG8_LDA
#undef PG8_LDB
#undef PG8_MMA
#undef PG8_WAIT_V
#undef PG8_WAIT_L
#undef PG8_BAR
#undef PG8_SCHED
}

__device__ __forceinline__ int moe_tables(LAS unsigned char* lds, const int* cnt) {
    LAS int* tile_e = (LAS int*)(lds + LDS_TILE_E); LAS int* tile_m = (LAS int*)(lds + LDS_TILE_M); LAS int* rts = (LAS int*)(lds + LDS_MISC + 32);
    if (tid_fresh() == 0) { int a = 0; for (int e = 0; e < NE; ++e) { const int n = (cnt[e] + 255) >> 8; for (int m = 0; m < n; ++m) { tile_e[a] = e; tile_m[a] = m; ++a; } } rts[0] = a; }
    __syncthreads();
    return rts[0];
}
}
namespace mk {
__device__ __forceinline__ float wsum(float v) {
#pragma unroll
    for (int o = 1; o < 64; o <<= 1) v += __shfl_xor(v, o);
    return v; }
__device__ __forceinline__ unsigned short f2bf(float f) { unsigned u = __float_as_uint(f); u += 0x7FFFu + ((u >> 16) & 1u); return (unsigned short)(u >> 16); }
}
namespace mk {
typedef float f32x16 __attribute__((ext_vector_type(16)));
typedef short s16x4 __attribute__((ext_vector_type(4)));
typedef __bf16 bf2_t __attribute__((ext_vector_type(2)));
typedef float f2_t __attribute__((ext_vector_type(2)));
#define MFMA32(a, b, c) __builtin_amdgcn_mfma_f32_32x32x16_bf16((a), (b), (c), 0, 0, 0)
constexpr float LOG2E = 1.4426950408889634f;
constexpr int PROJ_LD = NPROJ;
constexpr int AT_KBUF = 0, AT_VBUF = 16384, AT_IMPW = 32768, AT_SCORE = 65536, AT_OBUF = 73728, AT_OSTR = 1040, AT_BTAB = AT_OBUF + 64 * AT_OSTR  ,
              AT_SEL = AT_BTAB + 8 * 132 * 4  , AT_SSQ = AT_SEL + 512  , AT_END = AT_SSQ + 8 * 64 * 4  ;
struct AttnArgs { const bf16_t* projb; const bf16_t* kc; const bf16_t* vc; bf16_t* catb; };

__device__ __forceinline__ unsigned pk2(float a, float b) { f2_t v = {a, b}; return __builtin_bit_cast(unsigned, __builtin_convertvector(v, bf2_t)); }
__device__ __forceinline__ int t5_bucket(int n) { if (n < 0) n = 0; if (n < 16) return n; const float nf = (float)n; const int l = 16 + (int)(logf(nf / 16.f) / 2.0794415416798357f * 16.f); return l < 31 ? l : 31; }
__device__ __forceinline__ void stage_tile(LAS unsigned char* dst, const char* src, size_t row_stride, int wid, int lane, bool vswz) {
    const int row = 8 * wid + (lane >> 3), slot = lane & 7;
    const int f = vswz ? (((row >> 1) & 1) << 2) : ((row >> 1) & 7);
    __builtin_amdgcn_global_load_lds((const unsigned*)(src + (size_t)row * row_stride + ((slot ^ f) << 4)), (LAS unsigned*)(dst + wid * 1024), 16, 0, 0);
}
#define AT_CROW(r, h) (((r) & 3) + 8 * ((r) >> 2) + 4 * (h))
#define AT_PACK8(x, s) __builtin_bit_cast(bf16x8, (u32x4){pk2((x)[8 * (s)], (x)[8 * (s) + 1]), pk2((x)[8 * (s) + 2], (x)[8 * (s) + 3]), pk2((x)[8 * (s) + 4], (x)[8 * (s) + 5]), pk2((x)[8 * (s) + 6], (x)[8 * (s) + 7])})
__device__ __forceinline__ bf16x8 vt_frag(const LAS unsigned char* vt, unsigned vaddr, int rowoff) {
    const s16x4 lo = __builtin_amdgcn_ds_read_tr16_b64_v4i16((LAS s16x4*)(vt + vaddr + rowoff * 128));
    const s16x4 hi = __builtin_amdgcn_ds_read_tr16_b64_v4i16((LAS s16x4*)(vt + vaddr + (rowoff + 8) * 128));
    return __builtin_shufflevector(lo, hi, 0, 1, 2, 3, 4, 5, 6, 7);
}
template <bool FIRST>
__device__ __forceinline__ void obuf_acc(LAS unsigned char* lds, int tl, int hd, int h, float sc, const f32x16 (&oc)[2]) {
#pragma unroll
    for (int c = 0; c < 2; ++c)
#pragma unroll
        for (int qd = 0; qd < 4; ++qd) { LAS u32x2* p = (LAS u32x2*)(lds + AT_OBUF + tl * AT_OSTR + (hd * 64 + 32 * c + 8 * qd + 4 * h) * 2);
            float a0 = sc * oc[c][4 * qd], a1 = sc * oc[c][4 * qd + 1], a2 = sc * oc[c][4 * qd + 2], a3 = sc * oc[c][4 * qd + 3];
            if (!FIRST) { const u32x2 o = *p; a0 += __uint_as_float(o.x << 16); a1 += __uint_as_float(o.x & 0xffff0000u); a2 += __uint_as_float(o.y << 16); a3 += __uint_as_float(o.y & 0xffff0000u); }
            *p = (u32x2){pk2(a0, a1), pk2(a2, a3)}; }
}
template <int KIND>
__device__ __forceinline__ void attn_tile(const LAS unsigned char* Kt, const LAS unsigned char* Vt, int kbase, int tq, bool sel, const bf16x8 (&qf)[4], const LAS float* bt, float cfar,
                                          f32x16 (&O)[2], float& m, float& l, int ql, int h, const unsigned (&vaddr)[2]) {
    f32x16 s0, s1;
#pragma unroll
    for (int r = 0; r < 16; ++r) { s0[r] = 0.f; s1[r] = 0.f; }
    const int fk = (ql >> 1) & 7;
#pragma unroll
    for (int s = 0; s < 4; ++s) { const int ch = ((2 * s + h) ^ fk) << 4;
        const bf16x8 k0 = *(const LAS bf16x8*)(Kt + ql * 128 + ch), k1 = *(const LAS bf16x8*)(Kt + (32 + ql) * 128 + ch);
        s0 = MFMA32(k0, qf[s], s0); s1 = MFMA32(k1, qf[s], s1); }
    float mx = -INFINITY;
    if (KIND == 0) {
#pragma unroll
        for (int r = 0; r < 16; ++r) mx = fmaxf(mx, fmaxf(s0[r], s1[r]));
        mx += cfar;
    } else {
        int tqq = tq - kbase; asm volatile("" : "+v"(tqq));
#pragma unroll
        for (int r = 0; r < 16; ++r) {
            const int d0 = tqq - AT_CROW(r, h), d1 = d0 - 32;
            float x0 = s0[r] + bt[min(max(d0, 0), 128)], x1 = s1[r] + bt[min(max(d1, 0), 128)];
            if (KIND == 2) { x0 = (d0 >= 0 && d0 < 512) ? x0 : -INFINITY; x1 = (d1 >= 0 && d1 < 512) ? x1 : -INFINITY; }
            s0[r] = x0; s1[r] = x1; mx = fmaxf(mx, fmaxf(x0, x1)); }
    }
    mx = sel ? mx : -INFINITY;
    mx = fmaxf(mx, __shfl_xor(mx, 32));
    const float mn = fmaxf(m, mx);
    const float alpha = __builtin_amdgcn_exp2f(m - mn);
    float msub = sel ? mn : INFINITY;
    if (KIND == 0) msub -= cfar;
    float ps = 0.f;
#pragma unroll
    for (int r = 0; r < 16; ++r) { const float p0 = __builtin_amdgcn_exp2f(s0[r] - msub), p1 = __builtin_amdgcn_exp2f(s1[r] - msub); s0[r] = p0; s1[r] = p1; ps += p0 + p1; }
    l = l * alpha + ps; m = mn;
    if (__any(alpha != 1.f)) {
#pragma unroll
        for (int r = 0; r < 16; ++r) { O[0][r] *= alpha; O[1][r] *= alpha; } }
#pragma unroll
    for (int sp = 0; sp < 2; ++sp) {
        const bf16x8 p0 = AT_PACK8(s0, sp), p1 = AT_PACK8(s1, sp);
#pragma unroll
        for (int c = 0; c < 2; ++c) { O[c] = MFMA32(vt_frag(Vt, vaddr[c], 16 * sp), p0, O[c]); O[c] = MFMA32(vt_frag(Vt, vaddr[c], 32 + 16 * sp), p1, O[c]); }
    }
}
template <int MODE>
__device__ __forceinline__ void attn_branch(LAS unsigned char* lds, unsigned U, unsigned mysel, const char* kcol, const char* vcol, size_t RS, int blk, int tq, const bf16x8 (&qf)[4],
                                            const LAS float* bt, float cfar, f32x16 (&oc)[2], float& m, float& l, int ql, int h, const unsigned (&vaddr)[2], int wid, int lane) {
#define AT_NEXT(n) (((n) >= 31) ? -1 : ((U & ~((2u << (n)) - 1u)) ? __builtin_ctz(U & ~((2u << (n)) - 1u)) : -1))
#define AT_ISSUE(n, st) do { stage_tile(lds + (st) * 16384, kcol + (size_t)(n) * 64 * RS, RS, wid, lane, false); stage_tile(lds + (st) * 16384 + 8192, vcol + (size_t)(n) * 64 * RS, RS, wid, lane, true); } while (0)
    int cur = __builtin_ctz(U | 0x80000000u), n1 = AT_NEXT(cur), n2 = (n1 >= 0) ? AT_NEXT(n1) : -1, st = 0;
    asm volatile("s_waitcnt lgkmcnt(0)" ::: "memory"); __builtin_amdgcn_s_barrier(); asm volatile("" ::: "memory");
    AT_ISSUE(cur, 0); if (n1 >= 0) AT_ISSUE(n1, 1); if (n2 >= 0) AT_ISSUE(n2, 2);
    for (;;) {
        if (n2 >= 0) asm volatile("s_waitcnt vmcnt(4)" ::: "memory"); else if (n1 >= 0) asm volatile("s_waitcnt vmcnt(2)" ::: "memory"); else asm volatile("s_waitcnt vmcnt(0)" ::: "memory");
        asm volatile("s_waitcnt lgkmcnt(0)" ::: "memory"); __builtin_amdgcn_s_barrier(); asm volatile("" ::: "memory");
        const int n3 = (n2 >= 0) ? AT_NEXT(n2) : -1;
        if (n3 >= 0) AT_ISSUE(n3, (st + 3) & 3);
        const LAS unsigned char* Kt = lds + st * 16384; const LAS unsigned char* Vt = Kt + 8192;
        const bool sel = (MODE == 0) ? (((mysel >> cur) & 1u) != 0u) : true;
        const bool masked = (cur == blk) || (MODE == 1 && cur + 8 == blk);
        if (masked) attn_tile<2>(Kt, Vt, cur * 64, tq, sel, qf, bt, cfar, oc, m, l, ql, h, vaddr);
        else if (cur + 3 <= blk) attn_tile<0>(Kt, Vt, cur * 64, tq, sel, qf, bt, cfar, oc, m, l, ql, h, vaddr);
        else attn_tile<1>(Kt, Vt, cur * 64, tq, sel, qf, bt, cfar, oc, m, l, ql, h, vaddr);
        if (n1 < 0) break;
        cur = n1; n1 = n2; n2 = n3; st = (st + 1) & 3;
    }
#undef AT_NEXT
#undef AT_ISSUE
}

__device__ __forceinline__ void attn_item(LAS unsigned char* lds, const AttnArgs& A, int b, int qt) {
    const int tid = tid_fresh(), wid = __builtin_amdgcn_readfirstlane(tid >> 6), lane = tid & 63;
    const int g = wid >> 1, th = wid & 1, ql = lane & 31, h = lane >> 5;
    const int t0 = qt * 64, tl = th * 32 + ql, tq = t0 + tl, blk = qt;
    const int qq = (lane & 15) >> 2, pp = lane & 3, lb = (lane >> 4) & 1;
    unsigned vaddr[2];
#pragma unroll
    for (int c = 0; c < 2; ++c) vaddr[c] = (unsigned)((4 * h + qq) * 128 + (((4 * (c ^ ((qq >> 1) & 1))) + 2 * lb + (pp >> 1)) << 4) + 8 * (pp & 1));
    LAS float* impw = (LAS float*)(lds + AT_IMPW); LAS float* score = (LAS float*)(lds + AT_SCORE); LAS unsigned* selm = (LAS unsigned*)(lds + AT_SEL);
    const char* prow0 = (const char*)(A.projb + (size_t)b * S * PROJ_LD);
    const size_t RS = (size_t)PROJ_LD * 2;
    for (int kvh = 0; kvh < 2; ++kvh) {
        const int hd = kvh * 4 + g;
        const LAS float* bt = (const LAS float*)(lds + AT_BTAB) + hd * 132;
        const float cfar = bt[128];
        bf16x8 qf[4];
#pragma unroll
        for (int s = 0; s < 4; ++s) qf[s] = *(const bf16x8*)(A.projb + ((size_t)b * S + tq) * PROJ_LD + hd * 64 + 16 * s + 8 * h);
        float gate[3];
#pragma unroll
        for (int j = 0; j < 3; ++j) { const float gv = bf2f(A.projb[((size_t)b * S + tq) * PROJ_LD + 1280 + j * 8 + hd]); gate[j] = 1.f / (1.f + __expf(-gv)); }
        __syncthreads();
        { const char* kcb = (const char*)(A.kc + (size_t)(b * 2 + kvh) * 128 * 64); const char* vcb = (const char*)(A.vc + (size_t)(b * 2 + kvh) * 128 * 64);
          stage_tile(lds + AT_KBUF, kcb, 128, wid, lane, false); stage_tile(lds + AT_KBUF + 8192, kcb + 64 * 128, 128, wid, lane, false);
          stage_tile(lds + AT_VBUF, vcb, 128, wid, lane, true); stage_tile(lds + AT_VBUF + 8192, vcb + 64 * 128, 128, wid, lane, true); }
        asm volatile("s_waitcnt vmcnt(0)" ::: "memory"); __syncthreads();
        {
            f32x16 sc[4]; const int fk = (ql >> 1) & 7; int tqc = tq; asm volatile("" : "+v"(tqc));
#pragma unroll
            for (int kb = 0; kb < 4; ++kb) {
#pragma unroll
                for (int r = 0; r < 16; ++r) sc[kb][r] = 0.f;
#pragma unroll
                for (int s = 0; s < 4; ++s) { const bf16x8 kf = *(const LAS bf16x8*)(lds + AT_KBUF + (32 * kb + ql) * 128 + (((2 * s + h) ^ fk) << 4)); sc[kb] = MFMA32(kf, qf[s], sc[kb]); }
                __builtin_amdgcn_sched_barrier(0); }
            float mx = -INFINITY;
#pragma unroll
            for (int kb = 0; kb < 4; ++kb)
#pragma unroll
                for (int r = 0; r < 16; ++r) { const int c = 32 * kb + AT_CROW(r, h); const int dist = tqc - 16 * c - 31; const float bv = bt[min(max(dist, 0), 128)]; const float x = (dist >= 0) ? sc[kb][r] + bv : -INFINITY; sc[kb][r] = x; mx = fmaxf(mx, x);
                    if ((r & 7) == 7) __builtin_amdgcn_sched_barrier(0); }
            mx = fmaxf(mx, __shfl_xor(mx, 32));
            const float mref = (mx == -INFINITY) ? 0.f : mx;
            float ls = 0.f;
#pragma unroll
            for (int kb = 0; kb < 4; ++kb)
#pragma unroll
                for (int r = 0; r < 16; ++r) { const float p = __builtin_amdgcn_exp2f(sc[kb][r] - mref); sc[kb][r] = p; ls += p; }
            ls += __shfl_xor(ls, 32);
            const float inv = 1.f / fmaxf(ls, 1e-30f);
#pragma unroll
            for (int kb = 0; kb < 4; ++kb)
#pragma unroll
                for (int r = 0; r < 16; ++r) sc[kb][r] *= inv;
            { float carry = 0.f;
#pragma unroll
              for (int i = 0; i < 16; ++i) { const int kb = i >> 2, qd = i & 3;
                  const float s4 = (sc[kb][4 * qd] + sc[kb][4 * qd + 1]) + (sc[kb][4 * qd + 2] + sc[kb][4 * qd + 3]);
                  const float rv = __shfl_xor(sc[kb][4 * qd + 3], 32);
                  impw[(wid * 32 + ql) * 32 + 2 * i + h] = s4 + (h ? rv : carry); carry = rv; } }
            f32x16 oc[2];
#pragma unroll
            for (int r = 0; r < 16; ++r) { oc[0][r] = 0.f; oc[1][r] = 0.f; }
#pragma unroll
            for (int kb = 0; kb < 4; ++kb)
#pragma unroll
                for (int sp = 0; sp < 2; ++sp) { const bf16x8 pf = AT_PACK8(sc[kb], sp);
#pragma unroll
                    for (int c = 0; c < 2; ++c) oc[c] = MFMA32(vt_frag(lds + AT_VBUF, vaddr[c], 32 * kb + 16 * sp), pf, oc[c]);
                    __builtin_amdgcn_sched_barrier(0); }
            obuf_acc<true>(lds, tl, hd, h, gate[0], oc);
        }
        __syncthreads();
        int tids = tid; asm volatile("" : "+v"(tids));
#pragma unroll
        for (int i = 0; i < 4; ++i) { const int id = tids + 512 * i, tk = id >> 5, n = id & 31, w0 = tk >> 5, q = tk & 31;
            float v = 0.f;
#pragma unroll
            for (int gg = 0; gg < 4; ++gg) v += impw[((2 * gg + w0) * 32 + q) * 32 + n];
            const bool forced = (n == 0) || (n == blk) || (n == blk - 1);
            score[tk * 32 + n] = forced ? 1e4f : ((n <= blk) ? v : -1.f); }
        __syncthreads();
#pragma unroll
        for (int i = 0; i < 4; ++i) { const int id = tids + 512 * i, tk = id >> 5, n = id & 31;
            const float sn = score[tk * 32 + n]; int rank = 0;
            for (int mm = 0; mm < 32; ++mm) { const float s2 = score[tk * 32 + mm]; rank += (s2 > sn || (s2 == sn && mm < n)) ? 1 : 0; }
            const bool sel = (rank < 16) && (n <= blk);
            const unsigned long long bal = __ballot(sel);
            if (n == 0) selm[tk] = (unsigned)(bal >> (32 * (lane >> 5))); }
        __syncthreads();
        unsigned U = selm[lane];
#pragma unroll
        for (int o = 1; o < 64; o <<= 1) U |= (unsigned)__shfl_xor((int)U, o);
        U = (unsigned)__builtin_amdgcn_readfirstlane((int)U);
        const unsigned mysel = selm[tl];
        {
            f32x16 oc[2];
#pragma unroll
            for (int r = 0; r < 16; ++r) { oc[0][r] = 0.f; oc[1][r] = 0.f; }
            float m = -1e30f, l = 0.f;
            attn_branch<0>(lds, U, mysel, prow0 + (512 + 2 * 128 + kvh * 64) * 2, prow0 + (512 + 3 * 128 + kvh * 64) * 2, RS, blk, tq, qf, bt, cfar, oc, m, l, ql, h, vaddr, wid, lane);
            l += __shfl_xor(l, 32);
            const float sc1 = gate[1] / fmaxf(l, 1e-30f);
            obuf_acc<false>(lds, tl, hd, h, sc1, oc);
        }
        {
            f32x16 oc[2];
#pragma unroll
            for (int r = 0; r < 16; ++r) { oc[0][r] = 0.f; oc[1][r] = 0.f; }
            float m = -1e30f, l = 0.f;
            const int lo = (blk >= 8) ? blk - 8 : 0;
            const unsigned Uw = ((blk >= 31) ? 0xffffffffu : ((2u << blk) - 1u)) & ~((1u << lo) - 1u);
            attn_branch<1>(lds, Uw, 0u, prow0 + (512 + 4 * 128 + kvh * 64) * 2, prow0 + (512 + 5 * 128 + kvh * 64) * 2, RS, blk, tq, qf, bt, cfar, oc, m, l, ql, h, vaddr, wid, lane);
            l += __shfl_xor(l, 32);
            const float sc2 = gate[2] / fmaxf(l, 1e-30f);
            obuf_acc<false>(lds, tl, hd, h, sc2, oc);
        }
    }
    __syncthreads();
    int widn = wid; asm volatile("" : "+s"(widn));
#pragma unroll 1
    for (int i = 0; i < 8; ++i) { const int row = widn + 8 * i;
        const u32x4 v = *(const LAS u32x4*)(lds + AT_OBUF + row * AT_OSTR + lane * 16);
        float f[8]; f[0] = __uint_as_float(v.x << 16); f[1] = __uint_as_float(v.x & 0xffff0000u); f[2] = __uint_as_float(v.y << 16); f[3] = __uint_as_float(v.y & 0xffff0000u);
        f[4] = __uint_as_float(v.z << 16); f[5] = __uint_as_float(v.z & 0xffff0000u); f[6] = __uint_as_float(v.w << 16); f[7] = __uint_as_float(v.w & 0xffff0000u);
        float sq = 0.f;
#pragma unroll
        for (int j = 0; j < 8; ++j) sq += f[j] * f[j];
        sq = wsum(sq);
        const float rs = rsqrtf(sq * (1.f / 512.f) + 1e-6f);
        u32x4 w; w.x = pk2(f[0] * rs, f[1] * rs); w.y = pk2(f[2] * rs, f[3] * rs); w.z = pk2(f[4] * rs, f[5] * rs); w.w = pk2(f[6] * rs, f[7] * rs);
        *(u32x4*)(A.catb + ((size_t)b * S + t0 + row) * 1024 + lane * 8) = w; }
    __syncthreads();
}
__device__ __forceinline__ void attn_btab(LAS unsigned char* lds, const float* rel_bias) {
    LAS float* bt = (LAS float*)(lds + AT_BTAB);
    for (int i = threadIdx.x; i < 8 * 129; i += 512) { const int hd = i / 129, d = i % 129; bt[hd * 132 + d] = rel_bias[t5_bucket(d) * 8 + hd] * LOG2E; }
    __syncthreads();
}
}
namespace mk {
constexpr int XBC_OFF = 1816, Z_OFF = 1304, DT_OFF = 2840, NCH = 16;
constexpr int SD_XS = 0, SD_B = 65536, SD_C = 98304, SD_PREV = 131072  , SD_ACS = SD_PREV + 16384, SD_DT = SD_ACS + 2048, SD_W = SD_DT + 2048, SD_WP = SD_W + 2048  , SD_END = SD_WP + 256;
struct SsdArgs { const bf16_t* projb; const float* conv_w; const float* conv_b; const float* dt_bias; const float* a_log; const float* d_skip; bf16_t* states; float* alast; bf16_t* catb; };

__device__ __forceinline__ void ssd_dt_acs(LAS unsigned char* lds, const SsdArgs& A, int b, int c, int grp, int wid, int lane) {
    if (wid < 4) { const int hd = grp * 4 + wid; const float Ah = -__expf(A.a_log[hd]), db = A.dt_bias[hd];
        const size_t row = (size_t)b * S + c * 128 + 2 * lane;
        float x0 = bf2f(A.projb[row * PROJ_LD + DT_OFF + hd]) + db, x1 = bf2f(A.projb[(row + 1) * PROJ_LD + DT_OFF + hd]) + db;
        const float d0 = (x0 > 20.f) ? x0 : log1pf(__expf(x0)), d1 = (x1 > 20.f) ? x1 : log1pf(__expf(x1));
        const float a0 = d0 * Ah, a1 = d1 * Ah; float incl = a0 + a1;
#pragma unroll
        for (int o = 1; o < 64; o <<= 1) { const float t = __shfl_up(incl, o); if (lane >= o) incl += t; }
        LAS float* acs = (LAS float*)(lds + SD_ACS) + wid * 128; LAS float* dtl = (LAS float*)(lds + SD_DT) + wid * 128;
        acs[2 * lane] = incl - a1; acs[2 * lane + 1] = incl; dtl[2 * lane] = d0; dtl[2 * lane + 1] = d1; }
}
template <bool PHASE_A>
__device__ __forceinline__ void ssd_conv(LAS unsigned char* lds, const SsdArgs& A, int b, int c, int grp, int wid, int lane) {
    const int ch = lane;
    if (PHASE_A && ch >= 48) return;
    const int rel = (ch < 32) ? grp * 256 + ch * 8 : (ch < 48) ? 512 + grp * 128 + (ch - 32) * 8 : 768 + grp * 128 + (ch - 48) * 8;
    float w[4][8], bias[8];
#pragma unroll
    for (int k = 0; k < 4; ++k) { const f32x4 u0 = *(const f32x4*)(A.conv_w + k * 1024 + rel), u1 = *(const f32x4*)(A.conv_w + k * 1024 + rel + 4);
#pragma unroll
        for (int j = 0; j < 4; ++j) { w[k][j] = u0[j]; w[k][4 + j] = u1[j]; } }
    { const f32x4 u0 = *(const f32x4*)(A.conv_b + rel), u1 = *(const f32x4*)(A.conv_b + rel + 4);
#pragma unroll
      for (int j = 0; j < 4; ++j) { bias[j] = u0[j]; bias[4 + j] = u1[j]; } }
    const int tl0 = wid * 16, ts0 = c * 128 + tl0;
    const bf16_t* src = A.projb + ((size_t)b * S + ts0) * PROJ_LD + XBC_OFF + rel;
    float x0[8], x1[8], x2[8];
#pragma unroll
    for (int j = 0; j < 8; ++j) { x0[j] = 0.f; x1[j] = 0.f; x2[j] = 0.f; }
    if (ts0 >= 3) {
        const bf16x8 r0 = *(const bf16x8*)(src - 3 * (ptrdiff_t)PROJ_LD), r1 = *(const bf16x8*)(src - 2 * (ptrdiff_t)PROJ_LD), r2 = *(const bf16x8*)(src - 1 * (ptrdiff_t)PROJ_LD);
#pragma unroll
        for (int j = 0; j < 8; ++j) { x0[j] = bf2f((bf16_t)r0[j]); x1[j] = bf2f((bf16_t)r1[j]); x2[j] = bf2f((bf16_t)r2[j]); } }
    const LAS float* wt = (const LAS float*)(lds + SD_W) + (ch >> 3) * 128;
    bf16x8 rvv[16];
#pragma unroll
    for (int i = 0; i < 16; ++i) rvv[i] = *(const bf16x8*)(src + (size_t)i * PROJ_LD);
#pragma unroll
    for (int i = 0; i < 16; ++i) {
        const bf16x8 rv = rvv[i];
        float x3[8], o[8];
#pragma unroll
        for (int j = 0; j < 8; ++j) { x3[j] = bf2f((bf16_t)rv[j]); const float a = bias[j] + w[0][j] * x0[j] + w[1][j] * x1[j] + w[2][j] * x2[j] + w[3][j] * x3[j]; o[j] = a / (1.f + __expf(-a)); x0[j] = x1[j]; x1[j] = x2[j]; x2[j] = x3[j]; }
        const int row = tl0 + i;
        if (PHASE_A && ch < 32) { const float sc = wt[row];
#pragma unroll
            for (int j = 0; j < 8; ++j) o[j] *= sc; }
        u32x4 pk; pk.x = pk2(o[0], o[1]); pk.y = pk2(o[2], o[3]); pk.z = pk2(o[4], o[5]); pk.w = pk2(o[6], o[7]);
        if (ch < 32) *(LAS u32x4*)(lds + SD_XS + row * 512 + ((ch ^ ((row & 3) << 2)) << 4)) = pk;
        else if (ch < 48) { const int cc = ch - 32; *(LAS u32x4*)(lds + SD_B + row * 256 + ((PHASE_A ? (cc ^ ((row & 3) << 2)) : (cc ^ (row & 15))) << 4)) = pk; }
        else { const int cc = ch - 48; *(LAS u32x4*)(lds + SD_C + row * 256 + ((cc ^ (row & 15)) << 4)) = pk; }
    }
}
__device__ __forceinline__ bf16x8 tr_frag2(const LAS unsigned char* base, int stride, int r0, int r1, int chunk0, int qq, int pp) {
    const int cl = chunk0 + (pp >> 1);
    const s16x4 lo = __builtin_amdgcn_ds_read_tr16_b64_v4i16((LAS s16x4*)(base + (r0 + qq) * stride + ((cl ^ (qq << 2)) << 4) + 8 * (pp & 1)));
    const s16x4 hi = __builtin_amdgcn_ds_read_tr16_b64_v4i16((LAS s16x4*)(base + (r1 + qq) * stride + ((cl ^ (qq << 2)) << 4) + 8 * (pp & 1)));
    return __builtin_shufflevector(lo, hi, 0, 1, 2, 3, 4, 5, 6, 7);
}
__device__ __forceinline__ void ssd_a_item(LAS unsigned char* lds, const SsdArgs& A, int item) {
    const int tid = tid_fresh(), wid = __builtin_amdgcn_readfirstlane(tid >> 6), lane = tid & 63;
    const int grp = item & 1, c = (item >> 1) & 15, b = item >> 5;
    const int ql = lane & 31, h = lane >> 5, qq = (lane & 15) >> 2, pp = lane & 3, lb2 = (lane >> 4) & 1;
    __syncthreads();
    ssd_dt_acs(lds, A, b, c, grp, wid, lane);
    __syncthreads();
    { LAS float* acs = (LAS float*)(lds + SD_ACS); LAS float* dtl = (LAS float*)(lds + SD_DT); LAS float* wt = (LAS float*)(lds + SD_W);
      const int hh = tid >> 7, t = tid & 127; const float al = acs[hh * 128 + 127];
      wt[hh * 128 + t] = dtl[hh * 128 + t] * __expf(al - acs[hh * 128 + t]);
      if (t == 0) A.alast[(b * 8 + grp * 4 + hh) * NCH + c] = al; }
    __syncthreads();
    ssd_conv<true>(lds, A, b, c, grp, wid, lane);
    __syncthreads();
    const int pb = wid >> 2, nb = wid & 3;
#pragma unroll 1
    for (int hh = 0; hh < 4; ++hh) {
        f32x16 acc;
#pragma unroll
        for (int r = 0; r < 16; ++r) acc[r] = 0.f;
#pragma unroll
        for (int kk = 0; kk < 8; ++kk) {
            const bf16x8 af = tr_frag2(lds + SD_XS, 512, 16 * kk + 8 * h, 16 * kk + 8 * h + 4, hh * 8 + 4 * pb + 2 * lb2, qq, pp);
            const bf16x8 bf = tr_frag2(lds + SD_B, 256, 16 * kk + 8 * h, 16 * kk + 8 * h + 4, 4 * nb + 2 * lb2, qq, pp);
            acc = MFMA32(af, bf, acc); }
        bf16_t* st = A.states + ((size_t)((b * NCH + c) * 8 + grp * 4 + hh) * 64) * 128;
#pragma unroll
        for (int r = 0; r < 16; ++r) st[(32 * pb + AT_CROW(r, h)) * 128 + 32 * nb + ql] = f2bf(acc[r]);
    }
}
__device__ __forceinline__ void ssd_b_item(LAS unsigned char* lds, const SsdArgs& A, int item) {
    const int tid = tid_fresh(), wid = __builtin_amdgcn_readfirstlane(tid >> 6), lane = tid & 63;
    const int grp = item & 1, b = (item >> 1) & 7, c = 15 - (item >> 4);
    const int ql = lane & 31, h = lane >> 5, qq = (lane & 15) >> 2, pp = lane & 3, lb2 = (lane >> 4) & 1;
    const int pb = wid >> 2, lb = wid & 3;
    LAS float* acs = (LAS float*)(lds + SD_ACS); LAS float* dtl = (LAS float*)(lds + SD_DT); LAS float* wp = (LAS float*)(lds + SD_WP);
    __syncthreads();
    ssd_dt_acs(lds, A, b, c, grp, wid, lane);
    if (tid >= 256 && tid < 320) { const int hh = (tid - 256) >> 4, cp = tid & 15; float s = 0.f;
        for (int c2 = cp + 1; c2 < c; ++c2) s += A.alast[(b * 8 + grp * 4 + hh) * NCH + c2];
        wp[hh * 16 + cp] = (cp < c) ? __expf(s) : 0.f; }
    ssd_conv<false>(lds, A, b, c, grp, wid, lane);
    __syncthreads();
#pragma unroll 1
    for (int hh = 0; hh < 4; ++hh) {
        const int hd = grp * 4 + hh;
        { float pv[16];
#pragma unroll
          for (int j = 0; j < 16; ++j) pv[j] = 0.f;
          const int p = tid >> 3, n0 = (tid & 7) * 16;
          for (int cp0 = 0; cp0 < c; cp0 += 4) { bf16x8 s0[4], s1[4];
#pragma unroll
              for (int u = 0; u < 4; ++u) { const bf16_t* sp = A.states + ((size_t)((b * NCH + cp0 + u) * 8 + hd) * 64 + p) * 128 + n0; s0[u] = *(const bf16x8*)sp; s1[u] = *(const bf16x8*)(sp + 8); }
#pragma unroll
              for (int u = 0; u < 4; ++u) { const float wgt = wp[hh * 16 + cp0 + u];
#pragma unroll
                  for (int j = 0; j < 8; ++j) { pv[j] += wgt * bf2f((bf16_t)s0[u][j]); pv[8 + j] += wgt * bf2f((bf16_t)s1[u][j]); } } }
          LAS unsigned char* pbuf = lds + SD_PREV + p * 256;
          *(LAS u32x4*)(pbuf + ((((n0 >> 3)) ^ (p & 15)) << 4)) = (u32x4){pk2(pv[0], pv[1]), pk2(pv[2], pv[3]), pk2(pv[4], pv[5]), pk2(pv[6], pv[7])};
          *(LAS u32x4*)(pbuf + ((((n0 >> 3) + 1) ^ (p & 15)) << 4)) = (u32x4){pk2(pv[8], pv[9]), pk2(pv[10], pv[11]), pk2(pv[12], pv[13]), pk2(pv[14], pv[15])}; }
        __syncthreads();
        f32x16 acc;
#pragma unroll
        for (int r = 0; r < 16; ++r) acc[r] = 0.f;
#pragma unroll
        for (int kk = 0; kk < 8; ++kk) {
            const bf16x8 af = *(const LAS bf16x8*)(lds + SD_PREV + (32 * pb + ql) * 256 + (((2 * kk + h) ^ (ql & 15)) << 4));
            const bf16x8 bf = *(const LAS bf16x8*)(lds + SD_C + (32 * lb + ql) * 256 + (((2 * kk + h) ^ (ql & 15)) << 4));
            acc = MFMA32(af, bf, acc); }
        const float al = acs[hh * 128 + 32 * lb + ql];
        { const float e = __expf(al);
#pragma unroll
          for (int r = 0; r < 16; ++r) acc[r] *= e; }
        const float Dh = A.d_skip[hd];
#pragma unroll
        for (int sb = 0; sb < 4; ++sb) {
            if (sb <= lb) {
                f32x16 Pm;
#pragma unroll
                for (int r = 0; r < 16; ++r) Pm[r] = 0.f;
#pragma unroll
                for (int kk = 0; kk < 8; ++kk) {
                    const bf16x8 gf = *(const LAS bf16x8*)(lds + SD_B + (32 * sb + ql) * 256 + (((2 * kk + h) ^ (ql & 15)) << 4));
                    const bf16x8 cf = *(const LAS bf16x8*)(lds + SD_C + (32 * lb + ql) * 256 + (((2 * kk + h) ^ (ql & 15)) << 4));
                    Pm = MFMA32(gf, cf, Pm); }
#pragma unroll
                for (int r = 0; r < 16; ++r) { const int sl = 32 * sb + AT_CROW(r, h), ll = 32 * lb + ql;
                    const float as = acs[hh * 128 + sl], ds = dtl[hh * 128 + sl];
                    float v = Pm[r] * __expf(al - as) * ds; v = (sl <= ll) ? v : 0.f; v += (sl == ll) ? Dh : 0.f; Pm[r] = v; }
#pragma unroll
                for (int sp = 0; sp < 2; ++sp) { const bf16x8 pf = AT_PACK8(Pm, sp);
                    const bf16x8 af = tr_frag2(lds + SD_XS, 512, 32 * sb + 16 * sp + 4 * h, 32 * sb + 16 * sp + 8 + 4 * h, hh * 8 + 4 * pb + 2 * lb2, qq, pp);
                    acc = MFMA32(af, pf, acc); } }
        }
        { const bf16_t* zp = A.projb + ((size_t)b * S + c * 128 + 32 * lb + ql) * PROJ_LD + Z_OFF + hd * 64 + 32 * pb + 4 * h;
#pragma unroll
          for (int qd = 0; qd < 4; ++qd) { const u32x2 zz = *(const u32x2*)(zp + 8 * qd);
              const float z0 = __uint_as_float(zz.x << 16), z1 = __uint_as_float(zz.x & 0xffff0000u), z2 = __uint_as_float(zz.y << 16), z3 = __uint_as_float(zz.y & 0xffff0000u);
              acc[4 * qd] *= z0 / (1.f + __expf(-z0)); acc[4 * qd + 1] *= z1 / (1.f + __expf(-z1)); acc[4 * qd + 2] *= z2 / (1.f + __expf(-z2)); acc[4 * qd + 3] *= z3 / (1.f + __expf(-z3)); } }
        __syncthreads();
#pragma unroll
        for (int qd = 0; qd < 4; ++qd) { const int row = 32 * lb + ql, chn = hh * 8 + 4 * pb + qd;
            *(LAS u32x2*)(lds + SD_XS + row * 512 + ((chn ^ ((row & 3) << 2)) << 4) + 8 * h) = (u32x2){pk2(acc[4 * qd], acc[4 * qd + 1]), pk2(acc[4 * qd + 2], acc[4 * qd + 3])}; }
    }
    __syncthreads();
    int widn = wid; asm volatile("" : "+s"(widn));
#pragma unroll 1
    for (int i = 0; i < 16; ++i) { const int row = widn + 8 * i; const int chn = lane >> 1;
        const u32x2 v = *(const LAS u32x2*)(lds + SD_XS + row * 512 + ((chn ^ ((row & 3) << 2)) << 4) + 8 * (lane & 1));
        const float f0 = __uint_as_float(v.x << 16), f1 = __uint_as_float(v.x & 0xffff0000u), f2 = __uint_as_float(v.y << 16), f3 = __uint_as_float(v.y & 0xffff0000u);
        float sq = (f0 * f0 + f1 * f1) + (f2 * f2 + f3 * f3); sq = wsum(sq);
        const float rs = rsqrtf(sq * (1.f / 256.f) + 1e-6f);
        *(u32x2*)(A.catb + ((size_t)b * S + c * 128 + row) * 1024 + 512 + grp * 256 + lane * 4) = (u32x2){pk2(f0 * rs, f1 * rs), pk2(f2 * rs, f3 * rs)}; }
}
}
namespace mk {
__device__ __forceinline__ void rms_row_bf16(const float* xr, bf16_t* o, int lane) {
    f32x4 v[4]; float s = 0.f;
#pragma unroll
    for (int j = 0; j < 4; ++j) { v[j] = *(const f32x4*)(xr + lane * 4 + 256 * j); s += (v[j][0] * v[j][0] + v[j][1] * v[j][1]) + (v[j][2] * v[j][2] + v[j][3] * v[j][3]); }
    s = wsum(s); const float rs = rsqrtf(s * (1.f / 1024.f) + 1e-6f);
#pragma unroll
    for (int j = 0; j < 4; ++j) *(u32x2*)(o + lane * 4 + 256 * j) = (u32x2){pk2(v[j][0] * rs, v[j][1] * rs), pk2(v[j][2] * rs, v[j][3] * rs)};
}
constexpr int WT_PITCH = 68, WT_TILE_BYTES = 64 * WT_PITCH * 4;
template <bool OUT8>
__device__ __forceinline__ void wt_tile(const float* W, void* WTv, const float* gk1, const float* gk2, int ksplit, int K, int N, int NP, int mode, int nscale, float sc, int ntn, int ntk,
                                        int tile, LAS float* tl, int lane) {
    const int per = ntn * ntk, z = tile / per, rem = tile % per, n0 = (rem % ntn) * 64;
    const float* Wz = W + (size_t)z * K * N;
  for (int sub = 0; sub < (OUT8 ? 2 : 1); ++sub) {
    const int k0 = ((rem / ntn) * (OUT8 ? 2 : 1) + sub) * 64;
    const int lr = lane >> 4, lc = (lane & 15) * 4;
    f32x4 v[16];
#pragma unroll
    for (int i = 0; i < 16; ++i) { const int k = k0 + 4 * i + lr, n = n0 + lc; v[i] = (n < N) ? *(const f32x4*)(Wz + (size_t)k * N + n) : (f32x4){0.f, 0.f, 0.f, 0.f}; }
    if (gk1) {
#pragma unroll
        for (int i = 0; i < 16; ++i) { const int k = k0 + 4 * i + lr; const float g = (k < ksplit) ? gk1[k] : gk2[k - ksplit]; v[i] = v[i] * g; } }
#pragma unroll
    for (int i = 0; i < 16; ++i) *(LAS f32x4*)(tl + (4 * i + lr) * WT_PITCH + lc) = v[i];
    asm volatile("s_waitcnt lgkmcnt(0)" ::: "memory");
    const int nl = lane & 31, ch = lane >> 5;
#pragma unroll
    for (int half = 0; half < 2; ++half) { const int n = n0 + nl + 32 * half; const float s = (n < nscale) ? sc : 1.f;
        int nm = n; if (mode == 1) { const int up = n >> 10, jj = n & 1023; nm = (jj >> 7) * 256 + up * 128 + (jj & 127); }
#pragma unroll
        for (int cp = 0; cp < 4; ++cp) { const int c = 2 * cp + ch; const LAS float* src = tl + (8 * c) * WT_PITCH + nl + 32 * half;
            if constexpr (OUT8) { f8_t* WTz = (f8_t*)WTv + (size_t)z * NP * K;
                *(u32x2*)(WTz + (size_t)nm * K + k0 + 8 * c) = (u32x2){pk4_fp8(src[0] * s, src[WT_PITCH] * s, src[2 * WT_PITCH] * s, src[3 * WT_PITCH] * s), pk4_fp8(src[4 * WT_PITCH] * s, src[5 * WT_PITCH] * s, src[6 * WT_PITCH] * s, src[7 * WT_PITCH] * s)}; }
            else { bf16_t* WTz = (bf16_t*)WTv + (size_t)z * NP * K;
                u32x4 w; w.x = pk2(src[0] * s, src[WT_PITCH] * s); w.y = pk2(src[2 * WT_PITCH] * s, src[3 * WT_PITCH] * s); w.z = pk2(src[4 * WT_PITCH] * s, src[5 * WT_PITCH] * s); w.w = pk2(src[6 * WT_PITCH] * s, src[7 * WT_PITCH] * s);
                *(u32x4*)(WTz + (size_t)nm * K + k0 + 8 * c) = w; } } }
    asm volatile("s_waitcnt lgkmcnt(0)" ::: "memory");
  }
}
constexpr int CP_KX = 0  , CP_RED = 69632  , CP_HID = CP_RED + 32768  , CP_END = CP_HID + 8192 + 256;
struct CmpArgs { const bf16_t* projb; const bf16_t* w1T; const float* posb; const float* w2; bf16_t* kc; bf16_t* vc; };
__device__ __forceinline__ void cmp_item(LAS unsigned char* lds, const CmpArgs& A, int item) {
    const int tid = tid_fresh(), wid = __builtin_amdgcn_readfirstlane(tid >> 6), lane = tid & 63, ql = lane & 31, h = lane >> 5;
    const int cblk = item & 3, kvh = (item >> 2) & 1, b = (item >> 3) & 7, j = item >> 6;
    __syncthreads();
    { const int tok0 = 512 * cblk; const bf16_t* src = A.projb + ((size_t)b * S + tok0) * PROJ_LD + 512 + j * 128 + kvh * 64;
      for (int i = tid; i < 528 * 8; i += 512) { const int r = i >> 3, ch = i & 7; u32x4 v = (u32x4){0u, 0u, 0u, 0u};
          if (tok0 + r < S) v = *(const u32x4*)(src + (size_t)r * PROJ_LD + ch * 8);
          *(LAS u32x4*)(lds + CP_KX + r * 128 + ((ch ^ ((r >> 4) & 7)) << 4)) = v; } }
    if (tid < 64) { float a = 0.f;
#pragma unroll 16
        for (int sl = 0; sl < 64; ++sl) a += A.posb[(j * 64 + sl) * 64 + tid];
        ((LAS float*)(lds + CP_HID))[2048 + tid] = a; }
    __syncthreads();
    const int nb = wid & 1, kq = wid >> 1;
    f32x16 acc;
#pragma unroll
    for (int r = 0; r < 16; ++r) acc[r] = 0.f;
    const bf16_t* wrow = A.w1T + ((size_t)j * 64 + 32 * nb + ql) * 2048;
#pragma unroll 2
    for (int li = 0; li < 8; ++li) { const int l = 8 * kq + li;
#pragma unroll
        for (int s = 0; s < 4; ++s) {
            const int row = 16 * ql + l;
            const bf16x8 af = *(const LAS bf16x8*)(lds + CP_KX + row * 128 + (((2 * s + h) ^ ((row >> 4) & 7)) << 4));
            const bf16x8 bf = *(const bf16x8*)(wrow + l * 64 + 16 * s + 8 * h);
            acc = MFMA32(af, bf, acc); } }
    { LAS float* red = (LAS float*)(lds + CP_RED) + kq * 2048;
#pragma unroll
      for (int r = 0; r < 16; ++r) red[AT_CROW(r, h) * 64 + 32 * nb + ql] = acc[r]; }
    __syncthreads();
    { LAS float* red = (LAS float*)(lds + CP_RED); LAS float* hid = (LAS float*)(lds + CP_HID);
      for (int i = tid; i < 2048; i += 512) { const float a = (red[i] + red[2048 + i]) + (red[4096 + i] + red[6144 + i]) + hid[2048 + (i & 63)]; hid[i] = a / (1.f + __expf(-a)); } }
    __syncthreads();
    { const LAS float* hid = (const LAS float*)(lds + CP_HID); bf16_t* out = (j ? A.vc : A.kc) + (size_t)(b * 2 + kvh) * 128 * 64;
      for (int i = tid; i < 2048; i += 512) { const int cl = i >> 6, n2 = i & 63; float a = 0.f;
#pragma unroll 8
          for (int n = 0; n < 64; ++n) a += hid[cl * 64 + n] * A.w2[(j * 64 + n) * 64 + n2];
          const int c = 32 * cblk + cl; out[c * 64 + n2] = (c < 127) ? f2bf(a) : (bf16_t)0; } }
}
constexpr int RT_RW = 0;
struct RouteArgs { const float* h1; const float* ffn_norm; const float* router_w; const float* router_b; f8_t* hn8; int* cnt; int* list; float* wlist; int* tinfo; };
__device__ __forceinline__ void route_phase(LAS unsigned char* lds, const RouteArgs& A, int wg, int nwg) {
    const int tid = tid_fresh(), wid = __builtin_amdgcn_readfirstlane(tid >> 6), lane = tid & 63;
    LAS float* rw = (LAS float*)(lds + RT_RW);
    LAS float* lgt = (LAS float*)(lds + 131072);
    LAS int* lcnt = (LAS int*)(lds + 131072 + 16128); LAS int* gbase = lcnt + 32;
    __syncthreads();
    { f32x4 t4[16];
#pragma unroll
      for (int i = 0; i < 16; ++i) t4[i] = *(const f32x4*)(A.router_w + (size_t)(tid + 512 * i) * 4);
#pragma unroll
      for (int i = 0; i < 16; ++i) { const int q = tid + 512 * i, k = q >> 3, e0 = (q & 7) * 4; const float g = A.ffn_norm[k];
          rw[(e0 + 0) * 1024 + k] = t4[i][0] * g; rw[(e0 + 1) * 1024 + k] = t4[i][1] * g; rw[(e0 + 2) * 1024 + k] = t4[i][2] * g; rw[(e0 + 3) * 1024 + k] = t4[i][3] * g; } }
    if (tid < 32) lcnt[tid] = 0;
    __syncthreads();
    const int ex = ((lane >> 5) & 1) * 16 + ((lane >> 4) & 1) * 8 + ((lane >> 3) & 1) * 4 + ((lane >> 2) & 1) * 2 + ((lane >> 1) & 1);
    const float rbias = A.router_b[ex];
    int it = 0;
    for (int t0 = wg * 8 + wid; t0 < T; t0 += 2 * nwg * 8, it += 2) {
        const int t1 = t0 + nwg * 8; const bool has1 = t1 < T;
        f32x4 va[4], vb[4]; float sa = 0.f, sb = 0.f;
#pragma unroll
        for (int j = 0; j < 4; ++j) { va[j] = *(const f32x4*)(A.h1 + (size_t)t0 * D + lane * 4 + 256 * j); vb[j] = has1 ? *(const f32x4*)(A.h1 + (size_t)t1 * D + lane * 4 + 256 * j) : (f32x4){0.f, 0.f, 0.f, 0.f};
            sa += (va[j][0] * va[j][0] + va[j][1] * va[j][1]) + (va[j][2] * va[j][2] + va[j][3] * va[j][3]); sb += (vb[j][0] * vb[j][0] + vb[j][1] * vb[j][1]) + (vb[j][2] * vb[j][2] + vb[j][3] * vb[j][3]); }
#pragma unroll
        for (int o = 1; o < 64; o <<= 1) { sa += __shfl_xor(sa, o); sb += __shfl_xor(sb, o); }
        const float ra = rsqrtf(sa * (1.f / 1024.f) + 1e-6f), rb = rsqrtf(sb * (1.f / 1024.f) + 1e-6f);
#pragma unroll
        for (int j = 0; j < 4; ++j) { va[j] = va[j] * ra; vb[j] = vb[j] * rb; *(unsigned*)(A.hn8 + (size_t)t0 * D + lane * 4 + 256 * j) = pk4_fp8(va[j][0], va[j][1], va[j][2], va[j][3]);
            if (has1) *(unsigned*)(A.hn8 + (size_t)t1 * D + lane * 4 + 256 * j) = pk4_fp8(vb[j][0], vb[j][1], vb[j][2], vb[j][3]); }
        float pa[32], pb[32];
#pragma unroll
        for (int e = 0; e < 32; ++e) { pa[e] = 0.f; pb[e] = 0.f; }
#pragma unroll
        for (int e = 0; e < 32; ++e) {
#pragma unroll
            for (int j = 0; j < 4; ++j) { const f32x4 w4 = *(const LAS f32x4*)(rw + e * 1024 + lane * 4 + 256 * j);
                pa[e] += (va[j][0] * w4[0] + va[j][1] * w4[1]) + (va[j][2] * w4[2] + va[j][3] * w4[3]); pb[e] += (vb[j][0] * w4[0] + vb[j][1] * w4[1]) + (vb[j][2] * w4[2] + vb[j][3] * w4[3]); }
            if ((e & 3) == 3) __builtin_amdgcn_sched_barrier(0); }
        float r16a[16], r16b[16];
#pragma unroll
        for (int e = 0; e < 16; ++e) { const bool up = (lane & 32) != 0; r16a[e] = (up ? pa[16 + e] : pa[e]) + __shfl_xor(up ? pa[e] : pa[16 + e], 32); r16b[e] = (up ? pb[16 + e] : pb[e]) + __shfl_xor(up ? pb[e] : pb[16 + e], 32); }
        float r8a[8], r8b[8];
#pragma unroll
        for (int e = 0; e < 8; ++e) { const bool up = (lane & 16) != 0; r8a[e] = (up ? r16a[8 + e] : r16a[e]) + __shfl_xor(up ? r16a[e] : r16a[8 + e], 16); r8b[e] = (up ? r16b[8 + e] : r16b[e]) + __shfl_xor(up ? r16b[e] : r16b[8 + e], 16); }
        float r4a[4], r4b[4];
#pragma unroll
        for (int e = 0; e < 4; ++e) { const bool up = (lane & 8) != 0; r4a[e] = (up ? r8a[4 + e] : r8a[e]) + __shfl_xor(up ? r8a[e] : r8a[4 + e], 8); r4b[e] = (up ? r8b[4 + e] : r8b[e]) + __shfl_xor(up ? r8b[e] : r8b[4 + e], 8); }
        float r2a[2], r2b[2];
#pragma unroll
        for (int e = 0; e < 2; ++e) { const bool up = (lane & 4) != 0; r2a[e] = (up ? r4a[2 + e] : r4a[e]) + __shfl_xor(up ? r4a[e] : r4a[2 + e], 4); r2b[e] = (up ? r4b[2 + e] : r4b[e]) + __shfl_xor(up ? r4b[e] : r4b[2 + e], 4); }
        float r1a, r1b; { const bool up = (lane & 2) != 0; r1a = (up ? r2a[1] : r2a[0]) + __shfl_xor(up ? r2a[0] : r2a[1], 2); r1b = (up ? r2b[1] : r2b[0]) + __shfl_xor(up ? r2b[0] : r2b[1], 2); }
        r1a += __shfl_xor(r1a, 1); r1b += __shfl_xor(r1b, 1);
        if ((lane & 1) == 0) { const int l0 = it * 8 + wid; if (l0 < 112) lgt[l0 * 36 + ex] = r1a + rbias; if (has1 && l0 + 8 < 112) lgt[(l0 + 8) * 36 + ex] = r1b + rbias; }
    }
    __syncthreads();
    const int ntl = (T - wg * 8 + nwg * 8 - 1) / (nwg * 8) * 8;
    int te[4] = {0, 0, 0, 0}, lp[4] = {0, 0, 0, 0}; float tw[4] = {0.f, 0.f, 0.f, 0.f};
    const int tmine = wg * 8 + (tid & 7) + (tid >> 3) * nwg * 8; const bool mine = tid < 112 && tid < ntl && tmine < T;
    if (mine) { float v[32];
#pragma unroll
        for (int e4 = 0; e4 < 8; ++e4) { const f32x4 q4 = *(const LAS f32x4*)(lgt + tid * 36 + e4 * 4); v[e4 * 4] = q4[0]; v[e4 * 4 + 1] = q4[1]; v[e4 * 4 + 2] = q4[2]; v[e4 * 4 + 3] = q4[3]; }
        float tv[4];
#pragma unroll
        for (int k = 0; k < 4; ++k) { float best = -INFINITY; int bi = 0;
#pragma unroll
            for (int e = 0; e < 32; ++e) { const bool bt = v[e] > best; best = bt ? v[e] : best; bi = bt ? e : bi; }
#pragma unroll
            for (int e = 0; e < 32; ++e) v[e] = (e == bi) ? -INFINITY : v[e];
            tv[k] = best; te[k] = bi; }
        const float e1 = __expf(tv[1] - tv[0]), e2 = __expf(tv[2] - tv[0]), e3 = __expf(tv[3] - tv[0]); const float inv = 1.f / (1.f + e1 + e2 + e3);
        tw[0] = inv; tw[1] = e1 * inv; tw[2] = e2 * inv; tw[3] = e3 * inv;
#pragma unroll
        for (int k = 0; k < 4; ++k) lp[k] = __hip_atomic_fetch_add(lcnt + te[k], 1, __ATOMIC_RELAXED, __HIP_MEMORY_SCOPE_WORKGROUP); }
    __syncthreads();
    if (tid < 32) gbase[tid] = (int)__hip_atomic_fetch_add((unsigned*)A.cnt + tid, (unsigned)lcnt[tid], __ATOMIC_RELAXED, __HIP_MEMORY_SCOPE_AGENT);
    __syncthreads();
    if (mine) {
#pragma unroll
        for (int k = 0; k < 4; ++k) { const int e = te[k], pos = gbase[e] + lp[k], tk = tmine * 4 + k;
            A.list[(size_t)e * T + pos] = tk; A.wlist[tk] = tw[k]; A.tinfo[tk] = e | (pos << 8); } }
}
struct CombArgs { const float* h1; const f8_t* y; const int* tinfo; const float* tw; const int* cnt; const float* g; float* out; };
__device__ __forceinline__ void combine_phase(LAS unsigned char* lds, const CombArgs& A, int wg, int nwg) {
    const int tid = tid_fresh(), wid = __builtin_amdgcn_readfirstlane(tid >> 6), lane = tid & 63;
    LAS int* toff = (LAS int*)(lds + LDS_MISC + 64);
    __syncthreads();
    if (tid == 0) { int a = 0; for (int e = 0; e < NE; ++e) { toff[e] = a; a += (A.cnt[e] + 255) >> 8; } }
    __syncthreads();
    f32x4 gv[4];
#pragma unroll
    for (int j = 0; j < 4; ++j) gv[j] = *(const f32x4*)(A.g + lane * 4 + 256 * j);
    for (int t = wg * 8 + wid; t < T; t += nwg * 8) {
        size_t so[4]; float tw[4];
#pragma unroll
        for (int k = 0; k < 4; ++k) { const int inf = A.tinfo[t * 4 + k]; so[k] = ((size_t)toff[inf & 255] * 256 + (inf >> 8)) * 1024; tw[k] = A.tw[t * 4 + k]; }
        f32x4 v[4]; float s = 0.f;
#pragma unroll
        for (int j = 0; j < 4; ++j) { v[j] = *(const f32x4*)(A.h1 + (size_t)t * D + lane * 4 + 256 * j);
#pragma unroll
            for (int k = 0; k < 4; ++k) { const unsigned yy = *(const unsigned*)(A.y + so[k] + lane * 4 + 256 * j);
                const f2_t lo = __builtin_amdgcn_cvt_pk_f32_fp8((int)yy, false), hi = __builtin_amdgcn_cvt_pk_f32_fp8((int)yy, true);
                v[j][0] += tw[k] * lo[0]; v[j][1] += tw[k] * lo[1]; v[j][2] += tw[k] * hi[0]; v[j][3] += tw[k] * hi[1]; }
            s += (v[j][0] * v[j][0] + v[j][1] * v[j][1]) + (v[j][2] * v[j][2] + v[j][3] * v[j][3]); }
        s = wsum(s); const float rs = rsqrtf(s * (1.f / 1024.f) + 1e-6f);
#pragma unroll
        for (int j = 0; j < 4; ++j) *(f32x4*)(A.out + (size_t)t * D + lane * 4 + 256 * j) = v[j] * rs * gv[j];
    }
}
}
#define XB_TMO      128
#define XB_XCNT(j)  (256  + 64 * (j))
#define XB_XSUB(j)  (1280 + 64 * (j))
#define XB_XGEN(j)  (2304 + 64 * (j))
#define XB_TOP      3328
#define XB_TOPGEN   3392
#define XCD_BAR_WORDS 3456
#define XB_SPIN_CAP (1u << 18)
__device__ __forceinline__ unsigned xb_ld(unsigned* p)              { return __hip_atomic_load(p, __ATOMIC_RELAXED, __HIP_MEMORY_SCOPE_AGENT); }
__device__ __forceinline__ unsigned xb_add(unsigned* p, unsigned v) { return __hip_atomic_fetch_add(p, v, __ATOMIC_RELAXED, __HIP_MEMORY_SCOPE_AGENT); }
__device__ __forceinline__ unsigned xb_xcc_id() { return (unsigned)__builtin_amdgcn_s_getreg((3 << 11) | 20) & 0xFu; }
#define XB_SPIN(cond, bar) do { unsigned _sp = 0; while (cond) { __builtin_amdgcn_s_sleep(1); \
    if ((++_sp & 255u) == 0u) { if (xb_ld(&(bar)[XB_TMO])) break; if (_sp > XB_SPIN_CAP) { atomicAdd(&(bar)[XB_TMO], 1u); break; } } } } while (0)
struct XcdBarrier { unsigned* bar; unsigned x; volatile LAS unsigned* st; };
__device__ __forceinline__ XcdBarrier xcd_barrier_post(unsigned* bar, volatile LAS unsigned* st) {
    XcdBarrier b; b.bar = bar; b.x = xb_xcc_id(); b.st = st;
    if (threadIdx.x == 0) (void)xb_add(&bar[XB_XCNT(b.x)], 1u);
    return b;
}
__device__ __forceinline__ void xcd_barrier_complete(unsigned* bar, unsigned x, unsigned& nloc, unsigned& nx) {
    const unsigned G = gridDim.x * gridDim.y * gridDim.z;
    unsigned sum, cnt, mine, sp = 0u;
    for (;;) {
        sum = 0u; cnt = 0u; mine = 0u;
#pragma unroll
        for (unsigned j = 0; j < 16; ++j) { const unsigned c = xb_ld(&bar[XB_XCNT(j)]); sum += c; cnt += (c > 0u) ? 1u : 0u; mine = (j == x) ? c : mine; }
        if (sum == G) break;
        __builtin_amdgcn_s_sleep(1);
        if ((++sp & 255u) == 0u) { if (xb_ld(&bar[XB_TMO])) break; if (sp > XB_SPIN_CAP) { atomicAdd(&bar[XB_TMO], 1u); break; } }
    }
    nloc = mine > 0u ? mine : 1u; nx = cnt > 0u ? cnt : 1u;
}
__device__ __forceinline__ void xcd_barrier(const XcdBarrier& b) {
    asm volatile("s_waitcnt vmcnt(0)" ::: "memory");
    __syncthreads();
    if (threadIdx.x == 0) {
        unsigned* bar = b.bar;
        __builtin_amdgcn_s_waitcnt(0);
        unsigned nloc = b.st[0], nx = b.st[1];
        if (nloc == 0u) { xcd_barrier_complete(bar, b.x, nloc, nx); b.st[0] = nloc; b.st[1] = nx; }
        const unsigned old = xb_add(&bar[XB_XSUB(b.x)], 1u);
        const unsigned gen = old / nloc;
        if (old + 1u == (gen + 1u) * nloc) {
            __builtin_amdgcn_fence(__ATOMIC_RELEASE, "agent");
            asm volatile("s_waitcnt vmcnt(0)" ::: "memory");
            const unsigned og = xb_add(&bar[XB_TOP], 1u);
            const unsigned tg = og / nx;
            if (og + 1u == (tg + 1u) * nx) xb_add(&bar[XB_TOPGEN], 1u);
            else XB_SPIN(xb_ld(&bar[XB_TOPGEN]) == tg, bar);
            __builtin_amdgcn_fence(__ATOMIC_ACQUIRE, "agent");
            xb_add(&bar[XB_XGEN(b.x)], 1u);
            asm volatile("s_waitcnt vmcnt(0)" ::: "memory");
        } else {
            XB_SPIN(xb_ld(&bar[XB_XGEN(b.x)]) == gen, bar);
            __builtin_amdgcn_fence(__ATOMIC_ACQUIRE, "agent");
            asm volatile("s_waitcnt vmcnt(0)" ::: "memory");
        }
    }
    __syncthreads();
}

namespace mk {
constexpr int LDS_BAR = 159744, LDS_FUSED = LDS_BAR + 256;
constexpr int CTL_QUEUE = 4096;
struct Params {
    const float *x, *attn_norm, *w_in, *rel_bias, *cmp_pos, *cmp_w1, *cmp_w2, *attn_out_norm, *conv_w, *conv_b, *dt_bias, *a_log, *d_skip, *ssm_out_norm, *w_out, *ffn_norm,
                *router_w, *router_b, *w_gu, *b_gu, *w_dn, *b_dn, *final_norm;
    float* out; unsigned* ctl; int* cnt;
    bf16_t *xb, *WinT, *WoutT, *w1T, *projb, *catb, *kc, *vc, *states; f8_t *WguT, *WdnT, *hn8, *act, *ymoe;
    float *posb, *alast, *h1, *wlist; int *list, *tinfo;
    int ph_lo, ph_hi;
};
constexpr int NT_WIN = 48 * 16, NT_WOUT = 16 * 16, NT_WGU = 32 * 32 * 8, NT_WDN = 32 * 16 * 8, NT_W1 = 2 * 32, NT_ALL = NT_WIN + NT_WOUT + NT_WGU + NT_WDN + NT_W1;
__device__ __forceinline__ void p0_prologue(LAS unsigned char* lds, const Params& p, int wg, int nwg) {
    const int tid = tid_fresh(), wid = __builtin_amdgcn_readfirstlane(tid >> 6), lane = tid & 63;
    for (int r = wg * 8 + wid; r < T; r += nwg * 8) rms_row_bf16(p.x + (size_t)r * D, p.xb + (size_t)r * D, lane);
    for (int o = wg * 8 + wid; o < 128; o += nwg * 8) { const int j = o >> 6, sl = o & 63; float s = 0.f;
#pragma unroll
        for (int kk = 0; kk < 32; ++kk) { const int k = sl * 32 + kk; s += p.cmp_pos[j * 2048 + k] * p.cmp_w1[((size_t)j * 2048 + k) * 64 + lane]; }
        p.posb[o * 64 + lane] = s; }
    LAS float* tl = (LAS float*)(lds + wid * WT_TILE_BYTES);
    __syncthreads();
    for (int task = wg * 8 + wid; task < NT_ALL; task += nwg * 8) { int idx = task;
        if (idx < NT_WIN) { wt_tile<false>(p.w_in, p.WinT, p.attn_norm, p.attn_norm, 1024, 1024, 2848, 3072, 0, 512, 0.125f * LOG2E, 48, 16, idx, tl, lane); continue; } idx -= NT_WIN;
        if (idx < NT_WOUT) { wt_tile<false>(p.w_out, p.WoutT, p.attn_out_norm, p.ssm_out_norm, 512, 1024, 1024, 1024, 0, 0, 1.f, 16, 16, idx, tl, lane); continue; } idx -= NT_WOUT;
        if (idx < NT_WGU) { wt_tile<true>(p.w_gu, p.WguT, p.ffn_norm, p.ffn_norm, 1024, 1024, 2048, 2048, 1, 2048, W8_SCALE, 32, 8, idx, tl, lane); continue; } idx -= NT_WGU;
        if (idx < NT_WDN) { wt_tile<true>(p.w_dn, p.WdnT, nullptr, nullptr, 0, 1024, 1024, 1024, 0, 1024, W8_SCALE, 16, 8, idx, tl, lane); continue; } idx -= NT_WDN;
        wt_tile<false>(p.cmp_w1, p.w1T, nullptr, nullptr, 0, 2048, 64, 64, 0, 0, 1.f, 1, 32, idx, tl, lane); }
}
__global__ void __launch_bounds__(512, 2) k_fused(Params p) {
    extern __shared__ __attribute__((aligned(16))) unsigned char dl[];
    LAS unsigned char* lds = (LAS unsigned char*)dl;
    const int wg = blockIdx.x, nwg = gridDim.x; int tid = tid_fresh();
    if (tid < 64) ((LAS unsigned*)(lds + LDS_BAR))[tid] = 0u;
    __syncthreads();
    XcdBarrier bar = xcd_barrier_post(p.ctl, (volatile LAS unsigned*)(lds + LDS_BAR));
#ifdef MK_ONLY
#define PH(k) ((k) == MK_ONLY && p.ph_lo <= (k) && (k) < p.ph_hi)
#else
#define PH(k) (p.ph_lo <= (k) && (k) < p.ph_hi)
#endif
#ifdef MK_REPEAT
#define REP(k) for (int _rep = 0; _rep < ((k) == MK_REPEAT ? 2 : 1); ++_rep)
#else
#define REP(k)
#endif
#ifdef MK_REPEAT
#define QREP _rep
#else
#define QREP 0
#endif
#ifdef MK_BARX2
#define SEAM(k) do { if (PH(k) && PH((k) + 1)) { xcd_barrier(bar); xcd_barrier(bar); } } while (0)
#else
#define SEAM(k) do { if (PH(k) && PH((k) + 1)) xcd_barrier(bar); } while (0)
#endif
    if (PH(0)) { p0_prologue(lds, p, wg, nwg);
#ifdef MK_P0X2
        __syncthreads(); p0_prologue(lds, p, wg, nwg);
#endif
    }
    SEAM(0);
    REP(1) if (PH(1)) { ProbProj P; P.S.init(T, NPROJ, nwg, wg); P.A = p.xb; P.Bt = p.WinT; P.O = p.projb; gemm_phase(lds, P); }
    SEAM(1);
    REP(2) if (PH(2)) {
        const SsdArgs SA{p.projb, p.conv_w, p.conv_b, p.dt_bias, p.a_log, p.d_skip, p.states, p.alast, p.catb};
        const CmpArgs CA{p.projb, p.w1T, p.posb, p.cmp_w2, p.kc, p.vc};
        for (int it = wg; it < 384; it += nwg) { const int v = 383 - it; if (v < 128) cmp_item(lds, CA, v); else ssd_a_item(lds, SA, v - 128); }
    }
    SEAM(2);
    REP(3) if (PH(3)) {
        const SsdArgs SA{p.projb, p.conv_w, p.conv_b, p.dt_bias, p.a_log, p.d_skip, p.states, p.alast, p.catb};
        const AttnArgs AA{p.projb, p.kc, p.vc, p.catb};
        attn_btab(lds, p.rel_bias);
        LAS int* qslot = (LAS int*)(lds + LDS_BAR + 64);
        for (;;) {
            __syncthreads();
            if (tid_fresh() == 0) qslot[0] = (int)__hip_atomic_fetch_add(p.ctl + CTL_QUEUE + 64 * QREP, 1u, __ATOMIC_RELAXED, __HIP_MEMORY_SCOPE_AGENT);
            __syncthreads();
            const int it = qslot[0];
#if defined(MK_QX_ATTN) || defined(MK_QX_SSDB)
            if (it >= 768) break;
#else
            if (it >= 512) break;
#endif
#if defined(MK_QX_ATTN)
            { const int i2 = it >= 512 ? it - 512 : it; if (i2 < 256) attn_item(lds, AA, i2 & 7, 31 - (i2 >> 3)); else ssd_b_item(lds, SA, i2 - 256); }
#elif defined(MK_QX_SSDB)
            { const int i2 = it >= 512 ? it - 256 : it; if (i2 < 256) attn_item(lds, AA, i2 & 7, 31 - (i2 >> 3)); else ssd_b_item(lds, SA, i2 - 256); }
#else
            if (it < 256) attn_item(lds, AA, it & 7, 31 - (it >> 3)); else ssd_b_item(lds, SA, it - 256);
#endif
        }
    }
    SEAM(3);
    REP(4) if (PH(4)) { ProbOut P; P.S.init(T, D, nwg, wg); P.A = p.catb; P.Bt = p.WoutT; P.R0 = p.x; P.O = p.h1; gemm_phase(lds, P); }
    SEAM(4);
    REP(5) if (PH(5)) { const bool dm = QREP != 0; const RouteArgs RA{p.h1, p.ffn_norm, p.router_w, p.router_b, p.hn8, dm ? p.cnt + 64 : p.cnt, dm ? (int*)p.act : p.list, dm ? (float*)p.act + (4u << 20) : p.wlist, dm ? (int*)p.act + (8u << 20) : p.tinfo}; route_phase(lds, RA, wg, nwg); }
    SEAM(5);
    REP(6) if (PH(6)) {
        tid = tid_fresh();
        __syncthreads();
        const int RT = moe_tables(lds, p.cnt);
        ProbMoe1 P; P.S.nN = 8; P.S.G = nwg; P.S.c = (nwg % 8 == 0) ? (wg & 7) * (nwg >> 3) + (wg >> 3) : wg; P.S.RT = RT; P.S.tile_e = (const LAS int*)(lds + LDS_TILE_E); P.S.tile_m = (const LAS int*)(lds + LDS_TILE_M);
        P.A = p.hn8; P.Bt = p.WguT; P.btab = (const LAS float*)(lds + LDS_BIASTAB); P.O = p.act; P.rowtab = (const LAS unsigned*)(lds + LDS_ROWTAB);
        LAS unsigned* rowtab = (LAS unsigned*)(lds + LDS_ROWTAB);
#pragma unroll 1
        for (int i = 0; i < 12; ++i) { Unit u; if (!P.S.next(i, u)) break; if (tid < 256) { const int pos = u.mt * 256 + tid; const int c = p.cnt[u.e];
            const int tok = (pos < c) ? (p.list[(size_t)u.e * T + pos] >> 2) : 0; rowtab[i * 256 + tid] = (unsigned)tok * KD; }
            else { const int j = tid - 256; ((LAS float*)(lds + LDS_BIASTAB))[i * 256 + j] = p.b_gu[u.e * 2048 + (j >> 7) * 1024 + u.pn * 128 + (j & 127)]; } }
        __syncthreads();
        gemm_phase(lds, P);
    }
    SEAM(6);
    REP(7) if (PH(7)) {
        __syncthreads();
        const int RT = moe_tables(lds, p.cnt);
        ProbMoe2 P; P.S.nN = 4; P.S.G = nwg; P.S.c = (nwg % 8 == 0) ? (wg & 7) * (nwg >> 3) + (wg >> 3) : wg; P.S.RT = RT; P.S.tile_e = (const LAS int*)(lds + LDS_TILE_E); P.S.tile_m = (const LAS int*)(lds + LDS_TILE_M);
        P.A = p.act; P.Bt = p.WdnT; P.btab = (const LAS float*)(lds + LDS_BIASTAB); P.O = p.ymoe;
#pragma unroll 1
        for (int i = 0; i < 12; ++i) { Unit u; if (!P.S.next(i, u)) break; if (tid_fresh() < 256) ((LAS float*)(lds + LDS_BIASTAB))[i * 256 + tid_fresh()] = p.b_dn[u.e * 1024 + u.pn * 256 + tid_fresh()]; }
        __syncthreads();
        gemm_phase(lds, P);
    }
    SEAM(7);
    REP(8) if (PH(8)) { const CombArgs CA{p.h1, p.ymoe, p.tinfo, p.wlist, p.cnt, p.final_norm, p.out}; combine_phase(lds, CA, wg, nwg); }
#undef PH
#undef SEAM
}
}

extern "C" void kernel_launch(void* const* d_in, const int* in_sizes, int n_in, void* d_out, int out_size, void* d_ws, size_t ws_size, hipStream_t stream) {
    using namespace mk;
    char* ws = (char*)d_ws; const size_t MB = 1u << 20;
    size_t o = 0; auto take = [&](size_t mb) { char* q = ws + o; o += mb * MB; return q; };
    Params p;
    memset(&p, 0, sizeof(p));
    const float** fin = (const float**)&p.x;
    for (int i = 0; i < 23; ++i) fin[i] = (const float*)d_in[i];
    p.out = (float*)d_out;
    p.ctl = (unsigned*)take(1); p.cnt = (int*)(p.ctl + 8192);
    p.xb = (bf16_t*)take(32); p.WinT = (bf16_t*)take(6); p.WoutT = (bf16_t*)take(2); p.WguT = (f8_t*)take(64); p.WdnT = (f8_t*)take(32); p.w1T = (bf16_t*)take(1);
    p.projb = (bf16_t*)take(96); p.catb = (bf16_t*)take(32); p.hn8 = (f8_t*)take(16); p.kc = (bf16_t*)take(1); p.vc = (bf16_t*)take(1); p.states = (bf16_t*)take(16);
    p.act = (f8_t*)take(72); p.ymoe = (f8_t*)take(72);
    p.posb = (float*)take(1); p.alast = (float*)take(1); p.h1 = (float*)take(64); p.wlist = (float*)take(2); p.list = (int*)take(2); p.tinfo = (int*)take(1);
    static int grid = 0;
    if (!grid) {
        int dev = 0, cus = 0, per_cu = 0;
        (void)hipGetDevice(&dev); (void)hipDeviceGetAttribute(&cus, hipDeviceAttributeMultiprocessorCount, dev);
        (void)hipFuncSetAttribute((const void*)k_fused, hipFuncAttributeMaxDynamicSharedMemorySize, LDS_FUSED);
        (void)hipOccupancyMaxActiveBlocksPerMultiprocessor(&per_cu, (const void*)k_fused, 512, LDS_FUSED);
        (void)hipGetLastError();
        grid = cus > 0 ? cus : 256;
    }
    (void)hipMemsetAsync(p.ctl, 0, 65536, stream);
#ifndef MK_SPLIT
    p.ph_lo = 0; p.ph_hi = 9;
    hipLaunchKernelGGL(k_fused, dim3(grid), dim3(512), LDS_FUSED, stream, p);
#else
    for (int k = 0; k < 9; ++k) { p.ph_lo = k; p.ph_hi = k + 1; hipLaunchKernelGGL(k_fused, dim3(grid), dim3(512), LDS_FUSED, stream, p); }
#endif
}
```

```cpp
#include <hip/hip_runtime.h>
#include <stdint.h>
#include <string.h>
#include <math.h>
namespace mk {
#define LAS __attribute__((address_space(3)))
typedef unsigned short bf16_t;
typedef short bf16x8 __attribute__((ext_vector_type(8)));
typedef float f32x4 __attribute__((ext_vector_type(4)));
typedef unsigned u32x4 __attribute__((ext_vector_type(4)));
typedef unsigned u32x2 __attribute__((ext_vector_type(2)));
typedef float f2_t __attribute__((ext_vector_type(2)));
constexpr int NB = 8, S = 2048, D = 1024, T = NB * S, NE = 32;
constexpr int BM = 256, BK = 64, HALF = 128, HTB = HALF * BK * 2, STAGE_BYTES = 8 * HTB, NXCD = 8, WGM = 8;
constexpr int KD = 1024;
constexpr int NPROJ = 3072;
constexpr int MAXSLOT = 65536 + 32 * 256;
constexpr int LDS_MISC = 131072, LDS_TILE_E = LDS_MISC + 64, LDS_TILE_M = LDS_TILE_E + 1536, LDS_ROWTAB = LDS_MISC + 4096, LDS_BIASTAB = LDS_ROWTAB + 12 * 1024, LDS_BYTES = LDS_BIASTAB + 12 * 1024;

__host__ __device__ __forceinline__ int lds_byte(int r, int c) { const int st = (r >> 4) * 2 + (c >> 5), rr = r & 15, cc = c & 31, ob = rr * 64 + cc * 2; return st * 1024 + (ob ^ (((ob >> 9) & 1) << 5)); }
__host__ __device__ __forceinline__ void stage_rc(int b, int& R, int& C) { const int st = b / 1024, sb = b % 1024, swz = sb ^ (((sb >> 9) & 1) << 5); R = (st >> 1) * 16 + swz / 64; C = (st & 1) * 32 + (swz % 64) / 2; }
__host__ __device__ __forceinline__ int perm32(int rho) { const int n = rho >> 4, i = rho & 15; return 8 * (i >> 2) + 4 * n + (i & 3); }
__device__ __forceinline__ unsigned cvt_pk_bf16(float lo, float hi) { unsigned r; asm volatile("v_cvt_pk_bf16_f32 %0, %1, %2" : "=v"(r) : "v"(lo), "v"(hi)); return r; }
__device__ __forceinline__ int tid_fresh() { int t = threadIdx.x; asm volatile("" : "+v"(t)); return t; }
__device__ __forceinline__ float bf2f(bf16_t b) { return __uint_as_float(((unsigned)b) << 16); }

struct Unit { int pm, pn, e, mt, li; };
struct StaticOrder {
    int nM, nN, nwg, G, c;
    __device__ void init(int M, int N, int G_, int c_) { nM = M / BM; nN = N / BM; nwg = nM * nN; G = G_; c = c_; }
    __device__ bool next(int i, Unit& u) const {
        const long L = (long)i * G + c; if (L >= nwg) return false;
        int wgid = (int)L; { const int q = nwg / NXCD, r = nwg % NXCD, xcd = wgid % NXCD, off = wgid / NXCD; wgid = (xcd < r ? xcd * (q + 1) : r * (q + 1) + (xcd - r) * q) + off; }
        const int nig = WGM * nN, gid = wgid / nig, fm = gid * WGM, gsz = (nM - fm) < WGM ? (nM - fm) : WGM;
        u.pm = fm + ((wgid % nig) % gsz); u.pn = (wgid % nig) / gsz; u.e = 0; u.mt = 0; u.li = i; return true;
    }
};
struct MoeOrder {
    int nN, G, c, RT; const LAS int* tile_e; const LAS int* tile_m;
    __device__ bool next(int i, Unit& u) const { const int L = i * G + c; if (L >= RT * nN) return false; const int rt = L / nN; u.pm = rt; u.pn = L - rt * nN; u.e = tile_e[rt]; u.mt = tile_m[rt]; u.li = i; return true; }
};

struct ProbProj {
    static constexpr bool PERM = true, F8 = false, MIDSCALE = false; static constexpr int ROWB = KD * 2;
    StaticOrder S; const bf16_t* A; const bf16_t* Bt; bf16_t* O;
    __device__ __forceinline__ bool next(int i, Unit& u) const { return S.next(i, u); }
    __device__ __forceinline__ const char* a_base(const Unit& u) const { return (const char*)A + (size_t)u.pm * (BM * KD * 2); }
    __device__ __forceinline__ const char* b_base(const Unit& u) const { return (const char*)Bt + (size_t)u.pn * (BM * KD * 2); }
    __device__ __forceinline__ void a_offs(int, const Unit&, unsigned (&v0)[2], unsigned (&v1)[2], const int (&R)[2], const int (&C)[2]) const {
#pragma unroll
        for (int i = 0; i < 2; ++i) { v0[i] = (unsigned)(R[i] * KD + C[i]) * 2u; v1[i] = v0[i] + (unsigned)(HALF * KD * 2); } }
    __device__ __forceinline__ void epi(const f32x4 (&acc)[2][2][4][2], const Unit& u, int wr, int wc, int fr, int fq) const {
        const int row0 = u.pm * BM + wr * 64 + fr, col0 = u.pn * BM + wc * 32 + 8 * fq;
#pragma unroll
        for (int ai = 0; ai < 2; ++ai)
#pragma unroll
            for (int m = 0; m < 4; ++m) { bf16_t* rowp = O + (size_t)(row0 + ai * HALF + m * 16) * NPROJ + col0;
#pragma unroll
                for (int bj = 0; bj < 2; ++bj) { const f32x4 v0 = acc[ai][bj][m][0], v1 = acc[ai][bj][m][1]; u32x4 w;
                    w.x = cvt_pk_bf16(v0[0], v0[1]); w.y = cvt_pk_bf16(v0[2], v0[3]); w.z = cvt_pk_bf16(v1[0], v1[1]); w.w = cvt_pk_bf16(v1[2], v1[3]);
                    *(u32x4*)(rowp + bj * HALF) = w; } }
    }
};
struct ProbOut {
    static constexpr bool PERM = false, F8 = false, MIDSCALE = true; static constexpr int ROWB = KD * 2;
    StaticOrder S; const bf16_t* A; const bf16_t* Bt; const float* R0; bf16_t* O; const float* ssq;
    __device__ __forceinline__ void midscale(f32x4 (&acc)[2][2][4][2], const Unit& u, int wr, int fr) const {
        asm volatile("" : "+v"(fr));
#pragma unroll
        for (int ai = 0; ai < 2; ++ai)
#pragma unroll
            for (int m = 0; m < 4; ++m) { const int row = u.pm * BM + ai * HALF + wr * 64 + m * 16 + fr; const f2_t q = *(const f2_t*)(ssq + (size_t)row * 2);
                const float rs = rsqrtf((q[0] + q[1]) * (1.f / 512.f) + 1e-6f);
#pragma unroll
                for (int bj = 0; bj < 2; ++bj)
#pragma unroll
                    for (int n = 0; n < 2; ++n) acc[ai][bj][m][n] = acc[ai][bj][m][n] * rs;
                asm volatile("" ::: "memory"); } }
    __device__ __forceinline__ bool next(int i, Unit& u) const { return S.next(i, u); }
    __device__ __forceinline__ const char* a_base(const Unit& u) const { return (const char*)A + (size_t)u.pm * (BM * KD * 2); }
    __device__ __forceinline__ const char* b_base(const Unit& u) const { return (const char*)Bt + (size_t)u.pn * (BM * KD * 2); }
    __device__ __forceinline__ void a_offs(int, const Unit&, unsigned (&v0)[2], unsigned (&v1)[2], const int (&R)[2], const int (&C)[2]) const {
#pragma unroll
        for (int i = 0; i < 2; ++i) { v0[i] = (unsigned)(R[i] * KD + C[i]) * 2u; v1[i] = v0[i] + (unsigned)(HALF * KD * 2); } }
    __device__ __forceinline__ void epi(const f32x4 (&acc)[2][2][4][2], const Unit& u, int wr, int wc, int fr, int fq) const {
        const int row0 = u.pm * BM + wr * 64 + fr, col0 = u.pn * BM + wc * 32 + 4 * fq;
#pragma unroll
        for (int ai = 0; ai < 2; ++ai)
#pragma unroll
            for (int m = 0; m < 4; ++m) { const size_t off = (size_t)(row0 + ai * HALF + m * 16) * D + col0;
#pragma unroll
                for (int bj = 0; bj < 2; ++bj)
#pragma unroll
                    for (int n = 0; n < 2; ++n) { const f32x4 r = *(const f32x4*)(R0 + off + bj * HALF + n * 16); const f32x4 o = acc[ai][bj][m][n] + r; *(u32x2*)(O + off + bj * HALF + n * 16) = (u32x2){cvt_pk_bf16(o[0], o[1]), cvt_pk_bf16(o[2], o[3])}; }
                asm volatile("" ::: "memory"); }
    }
};
typedef unsigned char f8_t;
typedef int i32x8 __attribute__((ext_vector_type(8)));
typedef int i32x4 __attribute__((ext_vector_type(4)));
constexpr float W8_SCALE = 32.f, W8_INV = 1.f / 32.f;
__device__ __forceinline__ unsigned pk4_fp8(float a, float b, float c, float d) { int r = __builtin_amdgcn_cvt_pk_fp8_f32(a, b, 0, false); r = __builtin_amdgcn_cvt_pk_fp8_f32(c, d, r, true); return (unsigned)r; }
struct ProbMoe1 {
    static constexpr bool PERM = true, F8 = true, MIDSCALE = false; static constexpr int ROWB = KD;
    MoeOrder S; const f8_t* A; const f8_t* Bt; const LAS float* btab; f8_t* O; const LAS unsigned* rowtab;
    __device__ __forceinline__ bool next(int i, Unit& u) const { return S.next(i, u); }
    __device__ __forceinline__ const char* a_base(const Unit&) const { return (const char*)A; }
    __device__ __forceinline__ const char* b_base(const Unit& u) const { return (const char*)Bt + ((size_t)u.e * 2048 + (size_t)u.pn * BM) * ROWB; }
    __device__ __forceinline__ void a_offs(int i, const Unit&, unsigned (&v0)[2], unsigned (&v1)[2], const int (&R)[2], const int (&C)[2]) const {
#pragma unroll
        for (int j = 0; j < 2; ++j) { v0[j] = rowtab[i * 256 + R[j]] + (unsigned)C[j] * 2u; v1[j] = rowtab[i * 256 + HALF + R[j]] + (unsigned)C[j] * 2u; } }
    __device__ __forceinline__ void epi(const f32x4 (&acc)[2][2][4][2], const Unit& u, int wr, int wc, int fr, int fq) const {
        const int row0 = u.pm * BM + wr * 64 + fr, jg0 = u.pn * HALF + wc * 32 + 8 * fq;
        f32x4 bg[2], bu[2];
#pragma unroll
        for (int n = 0; n < 2; ++n) { bg[n] = *(const LAS f32x4*)(btab + u.li * 256 + wc * 32 + 8 * fq + 4 * n); bu[n] = *(const LAS f32x4*)(btab + u.li * 256 + 128 + wc * 32 + 8 * fq + 4 * n); }
#pragma unroll
        for (int ai = 0; ai < 2; ++ai)
#pragma unroll
            for (int m = 0; m < 4; ++m) { float o[8];
#pragma unroll
                for (int n = 0; n < 2; ++n) { const f32x4 g4 = acc[ai][0][m][n] * W8_INV + bg[n], u4 = acc[ai][1][m][n] * W8_INV + bu[n];
#pragma unroll
                    for (int j = 0; j < 4; ++j) { const float g = fminf(g4[j], 7.f), uu = fminf(fmaxf(u4[j], -7.f), 7.f);
                        const float sg = __builtin_amdgcn_rcpf(1.f + __builtin_amdgcn_exp2f(-1.702f * 1.4426950408889634f * g)); o[n * 4 + j] = (uu + 1.f) * g * sg; } }
                *(u32x2*)(O + (size_t)(row0 + ai * HALF + m * 16) * 1024 + jg0) = (u32x2){pk4_fp8(o[0], o[1], o[2], o[3]), pk4_fp8(o[4], o[5], o[6], o[7])}; }
    }
};
struct ProbMoe2 {
    static constexpr bool PERM = true, F8 = true, MIDSCALE = false; static constexpr int ROWB = KD;
    MoeOrder S; const f8_t* A; const f8_t* Bt; const LAS float* btab; f8_t* O;
    __device__ __forceinline__ bool next(int i, Unit& u) const { return S.next(i, u); }
    __device__ __forceinline__ const char* a_base(const Unit& u) const { return (const char*)A + (size_t)u.pm * (BM * ROWB); }
    __device__ __forceinline__ const char* b_base(const Unit& u) const { return (const char*)Bt + ((size_t)u.e * 1024 + (size_t)u.pn * BM) * ROWB; }
    __device__ __forceinline__ void a_offs(int, const Unit&, unsigned (&v0)[2], unsigned (&v1)[2], const int (&R)[2], const int (&C)[2]) const {
#pragma unroll
        for (int i = 0; i < 2; ++i) { v0[i] = (unsigned)(R[i] * ROWB + C[i] * 2); v1[i] = v0[i] + (unsigned)(HALF * ROWB); } }
    __device__ __forceinline__ void epi(const f32x4 (&acc)[2][2][4][2], const Unit& u, int wr, int wc, int fr, int fq) const {
        const int rl0 = wr * 64 + fr, col0 = u.pn * BM + wc * 32 + 8 * fq;
#pragma unroll
        for (int ai = 0; ai < 2; ++ai)
#pragma unroll
            for (int m = 0; m < 4; ++m) { const int rl = rl0 + ai * HALF + m * 16;
                f8_t* rowp = O + (size_t)(u.pm * BM + rl) * 1024 + col0;
#pragma unroll
                for (int bj = 0; bj < 2; ++bj) { const f32x4 b0 = *(const LAS f32x4*)(btab + u.li * 256 + bj * HALF + wc * 32 + 8 * fq), b1 = *(const LAS f32x4*)(btab + u.li * 256 + bj * HALF + wc * 32 + 8 * fq + 4);
                    const f32x4 v0 = acc[ai][bj][m][0] * W8_INV + b0, v1 = acc[ai][bj][m][1] * W8_INV + b1;
                    *(u32x2*)(rowp + bj * HALF) = (u32x2){pk4_fp8(v0[0], v0[1], v0[2], v0[3]), pk4_fp8(v1[0], v1[1], v1[2], v1[3])}; }
                asm volatile("" ::: "memory"); }
    }
};

template <int N> struct FragBf { bf16x8 v[N][2];
    __device__ __forceinline__ void set(int i, int k, i32x4 x) { v[i][k] = __builtin_bit_cast(bf16x8, x); }
    __device__ __forceinline__ bf16x8 get(int i, int k) const { return v[i][k]; } };
template <int N> struct FragF8 { i32x8 v[N];
    __device__ __forceinline__ void set(int i, int k, i32x4 x) { if (k == 0) v[i].lo = x; else v[i].hi = x; }
    __device__ __forceinline__ bf16x8 get(int, int) const { return bf16x8{}; } };
template <bool F8> struct FragT { typedef FragBf<4> A_t; typedef FragBf<2> B_t; };
template <> struct FragT<true> { typedef FragF8<4> A_t; typedef FragF8<2> B_t; };
template <class P>
__device__ __forceinline__ void gemm_phase(LAS unsigned char* lds, const P& Pb) {
    const int tid = tid_fresh(), wid = __builtin_amdgcn_readfirstlane(tid >> 6), lane = tid & 63, wr = wid >> 2, wc = wid & 3, fr = lane & 15, fq = lane >> 4;
    constexpr int nt = P::ROWB / 128;
    int Rr[2], Cc[2]; unsigned voffB[2];
#pragma unroll
    for (int i = 0; i < 2; ++i) { int R, C; stage_rc(tid * 16 + i * 8192, R, C); const int Rb = P::PERM ? ((R & ~31) + perm32(R & 31)) : R; Rr[i] = R; Cc[i] = C; voffB[i] = (unsigned)(Rb * P::ROWB + C * 2); }
    constexpr size_t kstep = (size_t)(BK * 2);
    constexpr size_t hstep = (size_t)HALF * P::ROWB;
    const unsigned ldsw = (unsigned)wid * 1024u;
    const int aoff = lds_byte(wr * 64 + fr, fq * 8), boff = lds_byte(wc * 32 + fr, fq * 8);
#define PG8_SA(b, h) (((b) * 2 + (h)) * HTB)
#define PG8_SB(b, h) ((4 + (b) * 2 + (h)) * HTB)
#define PG8_STAGE(bufoff, gbase, voff) do { _Pragma("unroll") for (int _i = 0; _i < 2; ++_i) \
        __builtin_amdgcn_global_load_lds((const unsigned*)((const char*)(gbase) + (voff)[_i]), (LAS unsigned*)(lds + (bufoff) + ldsw + _i * 8192), 16, 0, 0); } while (0)
#define PG8_LDA(dst, b, h) do { _Pragma("unroll") for (int m = 0; m < 4; ++m) _Pragma("unroll") for (int k = 0; k < 2; ++k) dst.set(m, k, *(const LAS i32x4*)(lds + PG8_SA(b, h) + aoff + m * 2048 + k * 1024)); } while (0)
#define PG8_LDB(dst, b, h) do { _Pragma("unroll") for (int n = 0; n < 2; ++n) _Pragma("unroll") for (int k = 0; k < 2; ++k) dst.set(n, k, *(const LAS i32x4*)(lds + PG8_SB(b, h) + boff + n * 2048 + k * 1024)); } while (0)
#define PG8_MMA(ai, bj, At, Bt) do { __builtin_amdgcn_s_setprio(1); _Pragma("unroll") for (int m = 0; m < 4; ++m) _Pragma("unroll") for (int n = 0; n < 2; ++n) { \
        if constexpr (P::F8) acc[ai][bj][m][n] = __builtin_amdgcn_mfma_scale_f32_16x16x128_f8f6f4(Bt.v[n], At.v[m], acc[ai][bj][m][n], 0, 0, 0, 0x7f7f7f7f, 0, 0x7f7f7f7f); \
        else { _Pragma("unroll") for (int k = 0; k < 2; ++k) acc[ai][bj][m][n] = __builtin_amdgcn_mfma_f32_16x16x32_bf16(Bt.get(n, k), At.get(m, k), acc[ai][bj][m][n], 0, 0, 0); } } \
        __builtin_amdgcn_s_setprio(0); } while (0)
#define PG8_WAIT_V(n) asm volatile("s_waitcnt vmcnt(" #n ")" ::: "memory")
#define PG8_WAIT_L(n) asm volatile("s_waitcnt lgkmcnt(" #n ")" ::: "memory")
#define PG8_BAR __builtin_amdgcn_s_barrier()
#define PG8_SCHED __builtin_amdgcn_sched_barrier(0)
    Unit cur, nxt; int ui = 0;
    if (!Pb.next(0, cur)) return;
    f32x4 acc[2][2][4][2];
#pragma unroll
    for (int a = 0; a < 2; ++a)
#pragma unroll
        for (int b = 0; b < 2; ++b)
#pragma unroll
            for (int m = 0; m < 4; ++m)
#pragma unroll
                for (int n = 0; n < 2; ++n) acc[a][b][m][n] = (f32x4){0.f, 0.f, 0.f, 0.f};
    typedef typename FragT<P::F8>::A_t AFr; typedef typename FragT<P::F8>::B_t BFr;
    AFr At; BFr B0, B1;
    unsigned vA0[2], vA1[2];
    Pb.a_offs(0, cur, vA0, vA1, Rr, Cc);
    const char* cA = Pb.a_base(cur); const char* cB = Pb.b_base(cur);
    PG8_STAGE(PG8_SB(0, 0), cB, voffB); PG8_STAGE(PG8_SB(0, 1), cB + hstep, voffB); PG8_STAGE(PG8_SA(0, 0), cA, vA0); PG8_STAGE(PG8_SA(0, 1), cA, vA1);
    if (wr == 1) PG8_BAR;
    PG8_WAIT_V(2); PG8_BAR;
    PG8_STAGE(PG8_SB(1, 0), cB + kstep, voffB); PG8_STAGE(PG8_SA(1, 0), cA + kstep, vA0); PG8_STAGE(PG8_SB(1, 1), cB + hstep + kstep, voffB);
    PG8_WAIT_V(6); PG8_BAR;
    for (;;) {
        const bool has_next = Pb.next(ui + 1, nxt);
        const char* nA = has_next ? Pb.a_base(nxt) : cA; const char* nB = has_next ? Pb.b_base(nxt) : cB;
#define PG8_KITER \
            const bool last = (t == nt - 2); \
            if constexpr (P::MIDSCALE) { if (t == 8) Pb.midscale(acc, cur, wr, fr); } \
            const char* a1 = cA + (size_t)(t + 1) * kstep; \
            const char* a2 = last ? nA : cA + (size_t)(t + 2) * kstep; const char* b2 = last ? nB : cB + (size_t)(t + 2) * kstep; \
            const char* a3 = a2 + kstep; const char* b3 = b2 + kstep; \
            PG8_LDB(B0, 0, 0); PG8_LDB(B1, 0, 1); PG8_SCHED; PG8_LDA(At, 0, 0); PG8_STAGE(PG8_SA(1, 1), a1, vA1); \
            PG8_WAIT_V(8); PG8_WAIT_L(0); PG8_BAR; PG8_MMA(0, 0, At, B0); PG8_MMA(0, 1, At, B1); PG8_BAR; PG8_SCHED; \
            if (last && has_next) { \
                if constexpr (P::F8) { int R2[2], C2[2]; int t2 = tid; asm volatile("" : "+v"(t2)); \
_Pragma("unroll") \
                    for (int i = 0; i < 2; ++i) stage_rc(t2 * 16 + i * 8192, R2[i], C2[i]); \
                    Pb.a_offs(ui + 1, nxt, vA0, vA1, R2, C2); } \
                else Pb.a_offs(ui + 1, nxt, vA0, vA1, Rr, Cc); } \
            PG8_LDA(At, 0, 1); PG8_STAGE(PG8_SB(0, 0), b2, voffB); PG8_STAGE(PG8_SB(0, 1), b2 + hstep, voffB); PG8_STAGE(PG8_SA(0, 0), a2, vA0); \
            PG8_WAIT_V(8); PG8_WAIT_L(0); PG8_BAR; PG8_MMA(1, 0, At, B0); PG8_MMA(1, 1, At, B1); PG8_BAR; PG8_SCHED; \
            PG8_LDB(B0, 1, 0); PG8_LDB(B1, 1, 1); PG8_SCHED; PG8_LDA(At, 1, 0); PG8_STAGE(PG8_SA(0, 1), a2, vA1); \
            PG8_WAIT_V(8); PG8_WAIT_L(0); PG8_BAR; PG8_MMA(0, 0, At, B0); PG8_MMA(0, 1, At, B1); PG8_BAR; PG8_SCHED; \
            PG8_LDA(At, 1, 1); PG8_STAGE(PG8_SB(1, 0), b3, voffB); PG8_STAGE(PG8_SB(1, 1), b3 + hstep, voffB); PG8_STAGE(PG8_SA(1, 0), a3, vA0); \
            PG8_WAIT_V(8); PG8_WAIT_L(0); PG8_BAR; PG8_MMA(1, 0, At, B0); PG8_MMA(1, 1, At, B1); PG8_BAR; PG8_SCHED;
        if constexpr (P::F8) {
#pragma unroll 1
            for (int t = 0; t < nt; t += 2) { PG8_KITER }
        } else {
            for (int t = 0; t < nt; t += 2) { PG8_KITER }
        }
#undef PG8_KITER
        if (wr == 0) PG8_BAR;
        if constexpr (P::F8) { int ln2 = lane; asm volatile("" : "+v"(ln2)); Pb.epi(acc, cur, wr, wc, ln2 & 15, ln2 >> 4); } else Pb.epi(acc, cur, wr, wc, fr, fq);
        if (!has_next) break;
#pragma unroll
        for (int a = 0; a < 2; ++a)
#pragma unroll
            for (int b = 0; b < 2; ++b)
#pragma unroll
                for (int m = 0; m < 4; ++m)
#pragma unroll
                    for (int n = 0; n < 2; ++n) acc[a][b][m][n] = (f32x4){0.f, 0.f, 0.f, 0.f};
        cur = nxt; cA = nA; cB = nB; ++ui;
        if (wr == 1) PG8_BAR;
    }
    PG8_WAIT_V(0);
    PG8_BAR;
#undef PG8_SA
#undef PG8_SB
#undef PG8_STAGE
#undef PG8_LDA
#undef PG8_LDB
#undef PG8_MMA
#undef PG8_WAIT_V
#undef PG8_WAIT_L
#undef PG8_BAR
#undef PG8_SCHED
}

__device__ __forceinline__ int moe_tables(LAS unsigned char* lds, const int* cnt) {
    LAS int* tile_e = (LAS int*)(lds + LDS_TILE_E); LAS int* tile_m = (LAS int*)(lds + LDS_TILE_M); LAS int* rts = (LAS int*)(lds + LDS_MISC + 32);
    if (tid_fresh() == 0) { int a = 0; for (int e = 0; e < NE; ++e) { const int n = (cnt[e] + 255) >> 8; for (int m = 0; m < n; ++m) { tile_e[a] = e; tile_m[a] = m; ++a; } } rts[0] = a; }
    __syncthreads();
    return rts[0];
}
}
namespace mk {
__device__ __forceinline__ float wsum(float v) {
#pragma unroll
    for (int o = 1; o < 64; o <<= 1) v += __shfl_xor(v, o);
    return v; }
__device__ __forceinline__ unsigned short f2bf(float f) { unsigned u = __float_as_uint(f); u += 0x7FFFu + ((u >> 16) & 1u); return (unsigned short)(u >> 16); }
}
namespace mk {
typedef float f32x16 __attribute__((ext_vector_type(16)));
typedef short s16x4 __attribute__((ext_vector_type(4)));
typedef __bf16 bf2_t __attribute__((ext_vector_type(2)));
#define MFMA32(a, b, c) __builtin_amdgcn_mfma_f32_32x32x16_bf16((a), (b), (c), 0, 0, 0)
constexpr float LOG2E = 1.4426950408889634f;
constexpr int PROJ_LD = NPROJ;
constexpr int AT_KBUF = 0, AT_VBUF = 16384, AT_IMPW = 32768, AT_SCORE = 65536, AT_OBUF = 73728, AT_OSTR = 528, AT_BTAB = AT_OBUF + 64 * AT_OSTR  ,
              AT_SEL = AT_BTAB + 8 * 132 * 4  , AT_SSQ = AT_SEL + 512  , AT_END = AT_SSQ + 8 * 64 * 4  ;
struct AttnArgs { const bf16_t* projb; const bf16_t* kc; const bf16_t* vc; bf16_t* catb; float* ssq; };

__device__ __forceinline__ unsigned pk2(float a, float b) { f2_t v = {a, b}; return __builtin_bit_cast(unsigned, __builtin_convertvector(v, bf2_t)); }
__device__ __forceinline__ int t5_bucket(int n) { if (n < 0) n = 0; if (n < 16) return n; const float nf = (float)n; const int l = 16 + (int)(logf(nf / 16.f) / 2.0794415416798357f * 16.f); return l < 31 ? l : 31; }
__device__ __forceinline__ void stage_tile(LAS unsigned char* dst, const char* src, size_t row_stride, int wid, int lane, bool vswz) {
    const int row = 8 * wid + (lane >> 3), slot = lane & 7;
    const int f = vswz ? (((row >> 1) & 1) << 2) : ((row >> 1) & 7);
    __builtin_amdgcn_global_load_lds((const unsigned*)(src + (size_t)row * row_stride + ((slot ^ f) << 4)), (LAS unsigned*)(dst + wid * 1024), 16, 0, 0);
}
#define AT_CROW(r, h) (((r) & 3) + 8 * ((r) >> 2) + 4 * (h))
#define AT_PACK8(x, s) __builtin_bit_cast(bf16x8, (u32x4){pk2((x)[8 * (s)], (x)[8 * (s) + 1]), pk2((x)[8 * (s) + 2], (x)[8 * (s) + 3]), pk2((x)[8 * (s) + 4], (x)[8 * (s) + 5]), pk2((x)[8 * (s) + 6], (x)[8 * (s) + 7])})
__device__ __forceinline__ bf16x8 vt_frag(const LAS unsigned char* vt, unsigned vaddr, int rowoff) {
    const s16x4 lo = __builtin_amdgcn_ds_read_tr16_b64_v4i16((LAS s16x4*)(vt + vaddr + rowoff * 128));
    const s16x4 hi = __builtin_amdgcn_ds_read_tr16_b64_v4i16((LAS s16x4*)(vt + vaddr + (rowoff + 8) * 128));
    return __builtin_shufflevector(lo, hi, 0, 1, 2, 3, 4, 5, 6, 7);
}
template <bool FIRST>
__device__ __forceinline__ void obuf_acc(LAS unsigned char* lds, int tl, int hd, int h, float sc, const f32x16 (&oc)[2]) {
#pragma unroll
    for (int c = 0; c < 2; ++c)
#pragma unroll
        for (int qd = 0; qd < 4; ++qd) { LAS u32x2* p = (LAS u32x2*)(lds + AT_OBUF + tl * AT_OSTR + ((hd & 3) * 64 + 32 * c + 8 * qd + 4 * h) * 2);
            float a0 = sc * oc[c][4 * qd], a1 = sc * oc[c][4 * qd + 1], a2 = sc * oc[c][4 * qd + 2], a3 = sc * oc[c][4 * qd + 3];
            if (!FIRST) { const u32x2 o = *p; a0 += __uint_as_float(o.x << 16); a1 += __uint_as_float(o.x & 0xffff0000u); a2 += __uint_as_float(o.y << 16); a3 += __uint_as_float(o.y & 0xffff0000u); }
            *p = (u32x2){pk2(a0, a1), pk2(a2, a3)}; }
}
template <int KIND>
__device__ __forceinline__ void attn_tile(const LAS unsigned char* Kt, const LAS unsigned char* Vt, int kbase, int tq, bool sel, const bf16x8 (&qf)[4], const LAS float* bt, float cfar,
                                          f32x16 (&O)[2], float& m, float& l, int ql, int h, const unsigned (&vaddr)[2]) {
    f32x16 s0, s1;
#pragma unroll
    for (int r = 0; r < 16; ++r) { s0[r] = 0.f; s1[r] = 0.f; }
    const int fk = (ql >> 1) & 7;
#pragma unroll
    for (int s = 0; s < 4; ++s) { const int ch = ((2 * s + h) ^ fk) << 4;
        const bf16x8 k0 = *(const LAS bf16x8*)(Kt + ql * 128 + ch), k1 = *(const LAS bf16x8*)(Kt + (32 + ql) * 128 + ch);
        s0 = MFMA32(k0, qf[s], s0); s1 = MFMA32(k1, qf[s], s1); }
    float mx = -INFINITY;
    if (KIND == 0) {
#pragma unroll
        for (int r = 0; r < 16; ++r) mx = fmaxf(mx, fmaxf(s0[r], s1[r]));
        mx += cfar;
    } else {
        int tqq = tq - kbase; asm volatile("" : "+v"(tqq));
#pragma unroll
        for (int r = 0; r < 16; ++r) {
            const int d0 = tqq - AT_CROW(r, h), d1 = d0 - 32;
            float x0 = s0[r] + bt[min(max(d0, 0), 128)], x1 = s1[r] + bt[min(max(d1, 0), 128)];
            if (KIND == 2) { x0 = (d0 >= 0 && d0 < 512) ? x0 : -INFINITY; x1 = (d1 >= 0 && d1 < 512) ? x1 : -INFINITY; }
            s0[r] = x0; s1[r] = x1; mx = fmaxf(mx, fmaxf(x0, x1)); }
    }
    mx = sel ? mx : -INFINITY;
    mx = fmaxf(mx, __shfl_xor(mx, 32));
    const float mn = fmaxf(m, mx);
    const float alpha = __builtin_amdgcn_exp2f(m - mn);
    float msub = sel ? mn : INFINITY;
    if (KIND == 0) msub -= cfar;
    float ps = 0.f;
#pragma unroll
    for (int r = 0; r < 16; ++r) { const float p0 = __builtin_amdgcn_exp2f(s0[r] - msub), p1 = __builtin_amdgcn_exp2f(s1[r] - msub); s0[r] = p0; s1[r] = p1; ps += p0 + p1; }
    l = l * alpha + ps; m = mn;
    if (__any(alpha != 1.f)) {
#pragma unroll
        for (int r = 0; r < 16; ++r) { O[0][r] *= alpha; O[1][r] *= alpha; } }
#pragma unroll
    for (int sp = 0; sp < 2; ++sp) {
        const bf16x8 p0 = AT_PACK8(s0, sp), p1 = AT_PACK8(s1, sp);
#pragma unroll
        for (int c = 0; c < 2; ++c) { O[c] = MFMA32(vt_frag(Vt, vaddr[c], 16 * sp), p0, O[c]); O[c] = MFMA32(vt_frag(Vt, vaddr[c], 32 + 16 * sp), p1, O[c]); }
    }
}
template <int MODE>
__device__ __forceinline__ void attn_branch(LAS unsigned char* lds, unsigned U, unsigned mysel, const char* kcol, const char* vcol, size_t RS, int blk, int tq, const bf16x8 (&qf)[4],
                                            const LAS float* bt, float cfar, f32x16 (&oc)[2], float& m, float& l, int ql, int h, const unsigned (&vaddr)[2], int wid, int lane) {
#define AT_NEXT(n) (((n) >= 31) ? -1 : ((U & ~((2u << (n)) - 1u)) ? __builtin_ctz(U & ~((2u << (n)) - 1u)) : -1))
#define AT_ISSUE(n, st) do { stage_tile(lds + (st) * 16384, kcol + (size_t)(n) * 64 * RS, RS, wid, lane, false); stage_tile(lds + (st) * 16384 + 8192, vcol + (size_t)(n) * 64 * RS, RS, wid, lane, true); } while (0)
    int cur = __builtin_ctz(U | 0x80000000u), n1 = AT_NEXT(cur), n2 = (n1 >= 0) ? AT_NEXT(n1) : -1, st = 0;
    asm volatile("s_waitcnt lgkmcnt(0)" ::: "memory"); __builtin_amdgcn_s_barrier(); asm volatile("" ::: "memory");
    AT_ISSUE(cur, 0); if (n1 >= 0) AT_ISSUE(n1, 1); if (n2 >= 0) AT_ISSUE(n2, 2);
    for (;;) {
        if (n2 >= 0) asm volatile("s_waitcnt vmcnt(4)" ::: "memory"); else if (n1 >= 0) asm volatile("s_waitcnt vmcnt(2)" ::: "memory"); else asm volatile("s_waitcnt vmcnt(0)" ::: "memory");
        asm volatile("s_waitcnt lgkmcnt(0)" ::: "memory"); __builtin_amdgcn_s_barrier(); asm volatile("" ::: "memory");
        const int n3 = (n2 >= 0) ? AT_NEXT(n2) : -1;
        if (n3 >= 0) AT_ISSUE(n3, (st + 3) & 3);
        const LAS unsigned char* Kt = lds + st * 16384; const LAS unsigned char* Vt = Kt + 8192;
        const bool sel = (MODE == 0) ? (((mysel >> cur) & 1u) != 0u) : true;
        const bool masked = (cur == blk) || (MODE == 1 && cur + 8 == blk);
#ifdef MK_TILEX2
        { f32x16 od[2] = {oc[0], oc[1]}; float md = m, ld = l;
          attn_tile<0>(Kt, Vt, cur * 64, tq, sel, qf, bt, cfar, od, md, ld, ql, h, vaddr);
          asm volatile("" :: "v"(od[0]), "v"(od[1]), "v"(md), "v"(ld)); }
#endif
        if (masked) attn_tile<2>(Kt, Vt, cur * 64, tq, sel, qf, bt, cfar, oc, m, l, ql, h, vaddr);
        else if (cur + 3 <= blk) attn_tile<0>(Kt, Vt, cur * 64, tq, sel, qf, bt, cfar, oc, m, l, ql, h, vaddr);
        else attn_tile<1>(Kt, Vt, cur * 64, tq, sel, qf, bt, cfar, oc, m, l, ql, h, vaddr);
        if (n1 < 0) break;
        cur = n1; n1 = n2; n2 = n3; st = (st + 1) & 3;
    }
#undef AT_NEXT
#undef AT_ISSUE
}

__device__ __forceinline__ void attn_item(LAS unsigned char* lds, const AttnArgs& A, int b, int qt, int kvh) {
    const int tid = tid_fresh(), wid = __builtin_amdgcn_readfirstlane(tid >> 6), lane = tid & 63;
    const int g = wid >> 1, th = wid & 1, ql = lane & 31, h = lane >> 5;
    const int t0 = qt * 64, tl = th * 32 + ql, tq = t0 + tl, blk = qt;
    const int qq = (lane & 15) >> 2, pp = lane & 3, lb = (lane >> 4) & 1;
    unsigned vaddr[2];
#pragma unroll
    for (int c = 0; c < 2; ++c) vaddr[c] = (unsigned)((4 * h + qq) * 128 + (((4 * (c ^ ((qq >> 1) & 1))) + 2 * lb + (pp >> 1)) << 4) + 8 * (pp & 1));
    LAS float* impw = (LAS float*)(lds + AT_IMPW); LAS float* score = (LAS float*)(lds + AT_SCORE); LAS unsigned* selm = (LAS unsigned*)(lds + AT_SEL);
    const char* prow0 = (const char*)(A.projb + (size_t)b * S * PROJ_LD);
    const size_t RS = (size_t)PROJ_LD * 2;
    {
        const int hd = kvh * 4 + g;
        const LAS float* bt = (const LAS float*)(lds + AT_BTAB) + hd * 132;
        const float cfar = bt[128];
        bf16x8 qf[4];
#pragma unroll
        for (int s = 0; s < 4; ++s) qf[s] = *(const bf16x8*)(A.projb + ((size_t)b * S + tq) * PROJ_LD + hd * 64 + 16 * s + 8 * h);
        float gate[3];
#pragma unroll
        for (int j = 0; j < 3; ++j) { const float gv = bf2f(A.projb[((size_t)b * S + tq) * PROJ_LD + 1280 + j * 8 + hd]); gate[j] = 1.f / (1.f + __expf(-gv)); }
        __syncthreads();
        { const char* kcb = (const char*)(A.kc + (size_t)(b * 2 + kvh) * 128 * 64); const char* vcb = (const char*)(A.vc + (size_t)(b * 2 + kvh) * 128 * 64);
          stage_tile(lds + AT_KBUF, kcb, 128, wid, lane, false); stage_tile(lds + AT_KBUF + 8192, kcb + 64 * 128, 128, wid, lane, false);
          stage_tile(lds + AT_VBUF, vcb, 128, wid, lane, true); stage_tile(lds + AT_VBUF + 8192, vcb + 64 * 128, 128, wid, lane, true); }
        asm volatile("s_waitcnt vmcnt(0)" ::: "memory"); __syncthreads();
        {
            f32x16 sc[4]; const int fk = (ql >> 1) & 7; int tqc = tq; asm volatile("" : "+v"(tqc));
#pragma unroll
            for (int kb = 0; kb < 4; ++kb) {
#pragma unroll
                for (int r = 0; r < 16; ++r) sc[kb][r] = 0.f;
#pragma unroll
                for (int s = 0; s < 4; ++s) { const bf16x8 kf = *(const LAS bf16x8*)(lds + AT_KBUF + (32 * kb + ql) * 128 + (((2 * s + h) ^ fk) << 4)); sc[kb] = MFMA32(kf, qf[s], sc[kb]); }
                __builtin_amdgcn_sched_barrier(0); }
            float mx = -INFINITY;
#pragma unroll
            for (int kb = 0; kb < 4; ++kb)
#pragma unroll
                for (int r = 0; r < 16; ++r) { const int c = 32 * kb + AT_CROW(r, h); const int dist = tqc - 16 * c - 31; const float bv = bt[min(max(dist, 0), 128)]; const float x = (dist >= 0) ? sc[kb][r] + bv : -INFINITY; sc[kb][r] = x; mx = fmaxf(mx, x);
                    if ((r & 7) == 7) __builtin_amdgcn_sched_barrier(0); }
            mx = fmaxf(mx, __shfl_xor(mx, 32));
            const float mref = (mx == -INFINITY) ? 0.f : mx;
            float ls = 0.f;
#pragma unroll
            for (int kb = 0; kb < 4; ++kb)
#pragma unroll
                for (int r = 0; r < 16; ++r) { const float p = __builtin_amdgcn_exp2f(sc[kb][r] - mref); sc[kb][r] = p; ls += p; }
            ls += __shfl_xor(ls, 32);
            const float inv = 1.f / fmaxf(ls, 1e-30f);
#pragma unroll
            for (int kb = 0; kb < 4; ++kb)
#pragma unroll
                for (int r = 0; r < 16; ++r) sc[kb][r] *= inv;
            { float carry = 0.f;
#pragma unroll
              for (int i = 0; i < 16; ++i) { const int kb = i >> 2, qd = i & 3;
                  const float s4 = (sc[kb][4 * qd] + sc[kb][4 * qd + 1]) + (sc[kb][4 * qd + 2] + sc[kb][4 * qd + 3]);
                  const float rv = __shfl_xor(sc[kb][4 * qd + 3], 32);
                  impw[(wid * 32 + ql) * 32 + 2 * i + h] = s4 + (h ? rv : carry); carry = rv; } }
            f32x16 oc[2];
#pragma unroll
            for (int r = 0; r < 16; ++r) { oc[0][r] = 0.f; oc[1][r] = 0.f; }
#pragma unroll
            for (int kb = 0; kb < 4; ++kb)
#pragma unroll
                for (int sp = 0; sp < 2; ++sp) { const bf16x8 pf = AT_PACK8(sc[kb], sp);
#pragma unroll
                    for (int c = 0; c < 2; ++c) oc[c] = MFMA32(vt_frag(lds + AT_VBUF, vaddr[c], 32 * kb + 16 * sp), pf, oc[c]);
                    __builtin_amdgcn_sched_barrier(0); }
            obuf_acc<true>(lds, tl, hd, h, gate[0], oc);
        }
        __syncthreads();
        int tids = tid; asm volatile("" : "+v"(tids));
#pragma unroll
        for (int i = 0; i < 4; ++i) { const int id = tids + 512 * i, tk = id >> 5, n = id & 31, w0 = tk >> 5, q = tk & 31;
            float v = 0.f;
#pragma unroll
            for (int gg = 0; gg < 4; ++gg) v += impw[((2 * gg + w0) * 32 + q) * 32 + n];
            const bool forced = (n == 0) || (n == blk) || (n == blk - 1);
            score[tk * 32 + n] = forced ? 1e4f : ((n <= blk) ? v : -1.f); }
        __syncthreads();
        { const int tk = tids >> 3, part = tids & 7;
          float sv[32];
#pragma unroll
          for (int e4 = 0; e4 < 8; ++e4) { const f32x4 q4 = *(const LAS f32x4*)(score + tk * 32 + e4 * 4); sv[e4 * 4] = q4[0]; sv[e4 * 4 + 1] = q4[1]; sv[e4 * 4 + 2] = q4[2]; sv[e4 * 4 + 3] = q4[3]; }
          unsigned bits = 0u;
#pragma unroll
          for (int j = 0; j < 4; ++j) { const int n = 4 * part + j; const float sn = score[tk * 32 + n];
              int rank = 0;
#pragma unroll
              for (int mm = 0; mm < 32; ++mm) rank += (sv[mm] > sn || (sv[mm] == sn && mm < n)) ? 1 : 0;
              bits |= ((rank < 16) && (n <= blk)) ? (1u << n) : 0u; }
          bits |= (unsigned)__shfl_xor((int)bits, 1); bits |= (unsigned)__shfl_xor((int)bits, 2); bits |= (unsigned)__shfl_xor((int)bits, 4);
          if (part == 0) selm[tk] = bits; }
        __syncthreads();
        unsigned U = selm[lane];
#pragma unroll
        for (int o = 1; o < 64; o <<= 1) U |= (unsigned)__shfl_xor((int)U, o);
        U = (unsigned)__builtin_amdgcn_readfirstlane((int)U);
        const unsigned mysel = selm[tl];
        {
            f32x16 oc[2];
#pragma unroll
            for (int r = 0; r < 16; ++r) { oc[0][r] = 0.f; oc[1][r] = 0.f; }
            float m = -1e30f, l = 0.f;
            attn_branch<0>(lds, U, mysel, prow0 + (512 + 2 * 128 + kvh * 64) * 2, prow0 + (512 + 3 * 128 + kvh * 64) * 2, RS, blk, tq, qf, bt, cfar, oc, m, l, ql, h, vaddr, wid, lane);
            l += __shfl_xor(l, 32);
            const float sc1 = gate[1] / fmaxf(l, 1e-30f);
            obuf_acc<false>(lds, tl, hd, h, sc1, oc);
        }
        {
            f32x16 oc[2];
#pragma unroll
            for (int r = 0; r < 16; ++r) { oc[0][r] = 0.f; oc[1][r] = 0.f; }
            float m = -1e30f, l = 0.f;
            const int lo = (blk >= 8) ? blk - 8 : 0;
            const unsigned Uw = ((blk >= 31) ? 0xffffffffu : ((2u << blk) - 1u)) & ~((1u << lo) - 1u);
            attn_branch<1>(lds, Uw, 0u, prow0 + (512 + 4 * 128 + kvh * 64) * 2, prow0 + (512 + 5 * 128 + kvh * 64) * 2, RS, blk, tq, qf, bt, cfar, oc, m, l, ql, h, vaddr, wid, lane);
            l += __shfl_xor(l, 32);
            const float sc2 = gate[2] / fmaxf(l, 1e-30f);
            obuf_acc<false>(lds, tl, hd, h, sc2, oc);
        }
    }
    __syncthreads();
    int widn = wid; asm volatile("" : "+s"(widn));
    { u32x2 v[8]; float sq[8];
#pragma unroll
      for (int i = 0; i < 8; ++i) { v[i] = *(const LAS u32x2*)(lds + AT_OBUF + (widn + 8 * i) * AT_OSTR + lane * 8);
          const float f0 = __uint_as_float(v[i].x << 16), f1 = __uint_as_float(v[i].x & 0xffff0000u), f2 = __uint_as_float(v[i].y << 16), f3 = __uint_as_float(v[i].y & 0xffff0000u);
          sq[i] = (f0 * f0 + f1 * f1) + (f2 * f2 + f3 * f3); }
#pragma unroll
      for (int o = 1; o < 64; o <<= 1) {
#pragma unroll
          for (int i = 0; i < 8; ++i) sq[i] += __shfl_xor(sq[i], o); }
#pragma unroll
      for (int i = 0; i < 8; ++i) { const int row = widn + 8 * i;
          *(u32x2*)(A.catb + ((size_t)b * S + t0 + row) * 1024 + kvh * 256 + lane * 4) = v[i];
          if (lane == 0) A.ssq[((size_t)b * S + t0 + row) * 2 + kvh] = sq[i]; } }
    __syncthreads();
}
__device__ __forceinline__ void attn_btab(LAS unsigned char* lds, const float* rel_bias) {
    LAS float* bt = (LAS float*)(lds + AT_BTAB);
    for (int i = threadIdx.x; i < 8 * 129; i += 512) { const int hd = i / 129, d = i % 129; bt[hd * 132 + d] = rel_bias[t5_bucket(d) * 8 + hd] * LOG2E; }
    __syncthreads();
}
}
namespace mk {
constexpr int XBC_OFF = 1816, Z_OFF = 1304, DT_OFF = 2840, NCH = 16;
constexpr int SD_XS = 0, SD_B = 65536, SD_C = 98304, SD_PREV = 131072  , SD_ACS = SD_PREV + 16384, SD_DT = SD_ACS + 2048, SD_W = SD_DT + 2048, SD_WP = SD_W + 2048  , SD_END = SD_WP + 256;
struct SsdArgs { const bf16_t* projb; const float* conv_w; const float* conv_b; const float* dt_bias; const float* a_log; const float* d_skip; bf16_t* states; float* alast; bf16_t* catb; };

__device__ __forceinline__ void ssd_dt_acs(LAS unsigned char* lds, const SsdArgs& A, int b, int c, int grp, int wid, int lane) {
    if (wid < 4) { const int hd = grp * 4 + wid; const float Ah = -__expf(A.a_log[hd]), db = A.dt_bias[hd];
        const size_t row = (size_t)b * S + c * 128 + 2 * lane;
        float x0 = bf2f(A.projb[row * PROJ_LD + DT_OFF + hd]) + db, x1 = bf2f(A.projb[(row + 1) * PROJ_LD + DT_OFF + hd]) + db;
        const float d0 = (x0 > 20.f) ? x0 : log1pf(__expf(x0)), d1 = (x1 > 20.f) ? x1 : log1pf(__expf(x1));
        const float a0 = d0 * Ah, a1 = d1 * Ah; float incl = a0 + a1;
#pragma unroll
        for (int o = 1; o < 64; o <<= 1) { const float t = __shfl_up(incl, o); if (lane >= o) incl += t; }
        LAS float* acs = (LAS float*)(lds + SD_ACS) + wid * 128; LAS float* dtl = (LAS float*)(lds + SD_DT) + wid * 128;
        acs[2 * lane] = incl - a1; acs[2 * lane + 1] = incl; dtl[2 * lane] = d0; dtl[2 * lane + 1] = d1; }
}
template <bool PHASE_A>
__device__ __forceinline__ void ssd_conv(LAS unsigned char* lds, const SsdArgs& A, int b, int c, int grp, int wid, int lane) {
    const int ch = lane;
    if (PHASE_A && ch >= 48) return;
    const int rel = (ch < 32) ? grp * 256 + ch * 8 : (ch < 48) ? 512 + grp * 128 + (ch - 32) * 8 : 768 + grp * 128 + (ch - 48) * 8;
    float w[4][8], bias[8];
#pragma unroll
    for (int k = 0; k < 4; ++k) { const f32x4 u0 = *(const f32x4*)(A.conv_w + k * 1024 + rel), u1 = *(const f32x4*)(A.conv_w + k * 1024 + rel + 4);
#pragma unroll
        for (int j = 0; j < 4; ++j) { w[k][j] = u0[j]; w[k][4 + j] = u1[j]; } }
    { const f32x4 u0 = *(const f32x4*)(A.conv_b + rel), u1 = *(const f32x4*)(A.conv_b + rel + 4);
#pragma unroll
      for (int j = 0; j < 4; ++j) { bias[j] = u0[j]; bias[4 + j] = u1[j]; } }
    const int tl0 = wid * 16, ts0 = c * 128 + tl0;
    const bf16_t* src = A.projb + ((size_t)b * S + ts0) * PROJ_LD + XBC_OFF + rel;
    float x0[8], x1[8], x2[8];
#pragma unroll
    for (int j = 0; j < 8; ++j) { x0[j] = 0.f; x1[j] = 0.f; x2[j] = 0.f; }
    if (ts0 >= 3) {
        const bf16x8 r0 = *(const bf16x8*)(src - 3 * (ptrdiff_t)PROJ_LD), r1 = *(const bf16x8*)(src - 2 * (ptrdiff_t)PROJ_LD), r2 = *(const bf16x8*)(src - 1 * (ptrdiff_t)PROJ_LD);
#pragma unroll
        for (int j = 0; j < 8; ++j) { x0[j] = bf2f((bf16_t)r0[j]); x1[j] = bf2f((bf16_t)r1[j]); x2[j] = bf2f((bf16_t)r2[j]); } }
    const LAS float* wt = (const LAS float*)(lds + SD_W) + (ch >> 3) * 128;
    bf16x8 rvv[16];
#pragma unroll
    for (int i = 0; i < 16; ++i) rvv[i] = *(const bf16x8*)(src + (size_t)i * PROJ_LD);
#pragma unroll
    for (int i = 0; i < 16; ++i) {
        const bf16x8 rv = rvv[i];
        float x3[8], o[8];
#pragma unroll
        for (int j = 0; j < 8; ++j) { x3[j] = bf2f((bf16_t)rv[j]); const float a = bias[j] + w[0][j] * x0[j] + w[1][j] * x1[j] + w[2][j] * x2[j] + w[3][j] * x3[j]; o[j] = a / (1.f + __expf(-a)); x0[j] = x1[j]; x1[j] = x2[j]; x2[j] = x3[j]; }
        const int row = tl0 + i;
        if (PHASE_A && ch < 32) { const float sc = wt[row];
#pragma unroll
            for (int j = 0; j < 8; ++j) o[j] *= sc; }
        u32x4 pk; pk.x = pk2(o[0], o[1]); pk.y = pk2(o[2], o[3]); pk.z = pk2(o[4], o[5]); pk.w = pk2(o[6], o[7]);
        if (ch < 32) *(LAS u32x4*)(lds + SD_XS + row * 512 + ((ch ^ ((row & 3) << 2)) << 4)) = pk;
        else if (ch < 48) { const int cc = ch - 32; *(LAS u32x4*)(lds + SD_B + row * 256 + ((PHASE_A ? (cc ^ ((row & 3) << 2)) : (cc ^ (row & 15))) << 4)) = pk; }
        else { const int cc = ch - 48; *(LAS u32x4*)(lds + SD_C + row * 256 + ((cc ^ (row & 15)) << 4)) = pk; }
    }
}
__device__ __forceinline__ bf16x8 tr_frag2(const LAS unsigned char* base, int stride, int r0, int r1, int chunk0, int qq, int pp) {
    const int cl = chunk0 + (pp >> 1);
    const s16x4 lo = __builtin_amdgcn_ds_read_tr16_b64_v4i16((LAS s16x4*)(base + (r0 + qq) * stride + ((cl ^ (qq << 2)) << 4) + 8 * (pp & 1)));
    const s16x4 hi = __builtin_amdgcn_ds_read_tr16_b64_v4i16((LAS s16x4*)(base + (r1 + qq) * stride + ((cl ^ (qq << 2)) << 4) + 8 * (pp & 1)));
    return __builtin_shufflevector(lo, hi, 0, 1, 2, 3, 4, 5, 6, 7);
}
__device__ __forceinline__ void ssd_a_item(LAS unsigned char* lds, const SsdArgs& A, int item) {
    const int tid = tid_fresh(), wid = __builtin_amdgcn_readfirstlane(tid >> 6), lane = tid & 63;
    const int grp = item & 1, c = (item >> 1) & 15, b = item >> 5;
    const int ql = lane & 31, h = lane >> 5, qq = (lane & 15) >> 2, pp = lane & 3, lb2 = (lane >> 4) & 1;
    __syncthreads();
    ssd_dt_acs(lds, A, b, c, grp, wid, lane);
    __syncthreads();
    { LAS float* acs = (LAS float*)(lds + SD_ACS); LAS float* dtl = (LAS float*)(lds + SD_DT); LAS float* wt = (LAS float*)(lds + SD_W);
      const int hh = tid >> 7, t = tid & 127; const float al = acs[hh * 128 + 127];
      wt[hh * 128 + t] = dtl[hh * 128 + t] * __expf(al - acs[hh * 128 + t]);
      if (t == 0) A.alast[(b * 8 + grp * 4 + hh) * NCH + c] = al; }
    __syncthreads();
    ssd_conv<true>(lds, A, b, c, grp, wid, lane);
    __syncthreads();
    const int pb = wid >> 2, nb = wid & 3;
#pragma unroll 1
    for (int hh = 0; hh < 4; ++hh) {
        f32x16 acc;
#pragma unroll
        for (int r = 0; r < 16; ++r) acc[r] = 0.f;
#pragma unroll
        for (int kk = 0; kk < 8; ++kk) {
            const bf16x8 af = tr_frag2(lds + SD_XS, 512, 16 * kk + 8 * h, 16 * kk + 8 * h + 4, hh * 8 + 4 * pb + 2 * lb2, qq, pp);
            const bf16x8 bf = tr_frag2(lds + SD_B, 256, 16 * kk + 8 * h, 16 * kk + 8 * h + 4, 4 * nb + 2 * lb2, qq, pp);
            acc = MFMA32(af, bf, acc); }
        bf16_t* st = A.states + ((size_t)((b * NCH + c) * 8 + grp * 4 + hh) * 64) * 128;
#pragma unroll
        for (int r = 0; r < 16; ++r) st[(32 * pb + AT_CROW(r, h)) * 128 + 32 * nb + ql] = f2bf(acc[r]);
    }
}
__device__ __forceinline__ void ssd_b_item(LAS unsigned char* lds, const SsdArgs& A, int item) {
    const int tid = tid_fresh(), wid = __builtin_amdgcn_readfirstlane(tid >> 6), lane = tid & 63;
    const int grp = item & 1, b = (item >> 1) & 7, c = 15 - (item >> 4);
    const int ql = lane & 31, h = lane >> 5, qq = (lane & 15) >> 2, pp = lane & 3, lb2 = (lane >> 4) & 1;
    const int pb = wid >> 2, lb = wid & 3;
    LAS float* acs = (LAS float*)(lds + SD_ACS); LAS float* dtl = (LAS float*)(lds + SD_DT); LAS float* wp = (LAS float*)(lds + SD_WP);
    __syncthreads();
    ssd_dt_acs(lds, A, b, c, grp, wid, lane);
    if (tid >= 256 && tid < 320) { const int hh = (tid - 256) >> 4, cp = tid & 15; float s = 0.f;
        float al[16];
#pragma unroll
        for (int c2 = 0; c2 < 16; ++c2) al[c2] = A.alast[(b * 8 + grp * 4 + hh) * NCH + c2];
#pragma unroll
        for (int c2 = 0; c2 < 16; ++c2) s += (c2 > cp && c2 < c) ? al[c2] : 0.f;
        wp[hh * 16 + cp] = (cp < c) ? __expf(s) : 0.f; }
    ssd_conv<false>(lds, A, b, c, grp, wid, lane);
    __syncthreads();
#pragma unroll 1
    for (int hh = 0; hh < 4; ++hh) {
        const int hd = grp * 4 + hh;
        { float pv[16];
#pragma unroll
          for (int j = 0; j < 16; ++j) pv[j] = 0.f;
          const int p = tid >> 3, n0 = (tid & 7) * 16;
          const bf16_t* sp0 = A.states + ((size_t)((b * NCH) * 8 + hd) * 64 + p) * 128 + n0;
#pragma unroll
          for (int g8 = 0; g8 < 2; ++g8) {
              if (g8 * 8 < c) { bf16x8 s0[8], s1[8];
#pragma unroll
                  for (int u = 0; u < 8; ++u) { const bf16_t* sp = sp0 + (size_t)(g8 * 8 + u) * (8 * 64 * 128); s0[u] = *(const bf16x8*)sp; s1[u] = *(const bf16x8*)(sp + 8); }
#pragma unroll
                  for (int u = 0; u < 8; ++u) { const float wgt = wp[hh * 16 + g8 * 8 + u];
#pragma unroll
                      for (int j = 0; j < 8; ++j) { pv[j] += wgt * bf2f((bf16_t)s0[u][j]); pv[8 + j] += wgt * bf2f((bf16_t)s1[u][j]); } } } }
          LAS unsigned char* pbuf = lds + SD_PREV + p * 256;
          *(LAS u32x4*)(pbuf + ((((n0 >> 3)) ^ (p & 15)) << 4)) = (u32x4){pk2(pv[0], pv[1]), pk2(pv[2], pv[3]), pk2(pv[4], pv[5]), pk2(pv[6], pv[7])};
          *(LAS u32x4*)(pbuf + ((((n0 >> 3) + 1) ^ (p & 15)) << 4)) = (u32x4){pk2(pv[8], pv[9]), pk2(pv[10], pv[11]), pk2(pv[12], pv[13]), pk2(pv[14], pv[15])}; }
        __syncthreads();
        f32x16 acc;
#pragma unroll
        for (int r = 0; r < 16; ++r) acc[r] = 0.f;
#pragma unroll
        for (int kk = 0; kk < 8; ++kk) {
            const bf16x8 af = *(const LAS bf16x8*)(lds + SD_PREV + (32 * pb + ql) * 256 + (((2 * kk + h) ^ (ql & 15)) << 4));
            const bf16x8 bf = *(const LAS bf16x8*)(lds + SD_C + (32 * lb + ql) * 256 + (((2 * kk + h) ^ (ql & 15)) << 4));
            acc = MFMA32(af, bf, acc); }
        const float al = acs[hh * 128 + 32 * lb + ql];
        { const float e = __expf(al);
#pragma unroll
          for (int r = 0; r < 16; ++r) acc[r] *= e; }
        const float Dh = A.d_skip[hd];
#pragma unroll
        for (int sb = 0; sb < 4; ++sb) {
            if (sb <= lb) {
                f32x16 Pm;
#pragma unroll
                for (int r = 0; r < 16; ++r) Pm[r] = 0.f;
#pragma unroll
                for (int kk = 0; kk < 8; ++kk) {
                    const bf16x8 gf = *(const LAS bf16x8*)(lds + SD_B + (32 * sb + ql) * 256 + (((2 * kk + h) ^ (ql & 15)) << 4));
                    const bf16x8 cf = *(const LAS bf16x8*)(lds + SD_C + (32 * lb + ql) * 256 + (((2 * kk + h) ^ (ql & 15)) << 4));
                    Pm = MFMA32(gf, cf, Pm); }
#pragma unroll
                for (int r = 0; r < 16; ++r) { const int sl = 32 * sb + AT_CROW(r, h), ll = 32 * lb + ql;
                    const float as = acs[hh * 128 + sl], ds = dtl[hh * 128 + sl];
                    float v = Pm[r] * __expf(al - as) * ds; v = (sl <= ll) ? v : 0.f; v += (sl == ll) ? Dh : 0.f; Pm[r] = v; }
#pragma unroll
                for (int sp = 0; sp < 2; ++sp) { const bf16x8 pf = AT_PACK8(Pm, sp);
                    const bf16x8 af = tr_frag2(lds + SD_XS, 512, 32 * sb + 16 * sp + 4 * h, 32 * sb + 16 * sp + 8 + 4 * h, hh * 8 + 4 * pb + 2 * lb2, qq, pp);
                    acc = MFMA32(af, pf, acc); } }
        }
        { const bf16_t* zp = A.projb + ((size_t)b * S + c * 128 + 32 * lb + ql) * PROJ_LD + Z_OFF + hd * 64 + 32 * pb + 4 * h;
#pragma unroll
          for (int qd = 0; qd < 4; ++qd) { const u32x2 zz = *(const u32x2*)(zp + 8 * qd);
              const float z0 = __uint_as_float(zz.x << 16), z1 = __uint_as_float(zz.x & 0xffff0000u), z2 = __uint_as_float(zz.y << 16), z3 = __uint_as_float(zz.y & 0xffff0000u);
              acc[4 * qd] *= z0 / (1.f + __expf(-z0)); acc[4 * qd + 1] *= z1 / (1.f + __expf(-z1)); acc[4 * qd + 2] *= z2 / (1.f + __expf(-z2)); acc[4 * qd + 3] *= z3 / (1.f + __expf(-z3)); } }
        __syncthreads();
#pragma unroll
        for (int qd = 0; qd < 4; ++qd) { const int row = 32 * lb + ql, chn = hh * 8 + 4 * pb + qd;
            *(LAS u32x2*)(lds + SD_XS + row * 512 + ((chn ^ ((row & 3) << 2)) << 4) + 8 * h) = (u32x2){pk2(acc[4 * qd], acc[4 * qd + 1]), pk2(acc[4 * qd + 2], acc[4 * qd + 3])}; }
    }
    __syncthreads();
    int widn = wid; asm volatile("" : "+s"(widn));
#pragma unroll 1
    for (int i0 = 0; i0 < 16; i0 += 8) { u32x2 v[8]; float sq[8]; const int chn = lane >> 1;
#pragma unroll
        for (int i = 0; i < 8; ++i) { const int row = widn + 8 * (i0 + i);
            v[i] = *(const LAS u32x2*)(lds + SD_XS + row * 512 + ((chn ^ ((row & 3) << 2)) << 4) + 8 * (lane & 1));
            const float f0 = __uint_as_float(v[i].x << 16), f1 = __uint_as_float(v[i].x & 0xffff0000u), f2 = __uint_as_float(v[i].y << 16), f3 = __uint_as_float(v[i].y & 0xffff0000u);
            sq[i] = (f0 * f0 + f1 * f1) + (f2 * f2 + f3 * f3); }
#pragma unroll
        for (int o = 1; o < 64; o <<= 1) {
#pragma unroll
            for (int i = 0; i < 8; ++i) sq[i] += __shfl_xor(sq[i], o); }
#pragma unroll
        for (int i = 0; i < 8; ++i) { const int row = widn + 8 * (i0 + i); const float rs = rsqrtf(sq[i] * (1.f / 256.f) + 1e-6f);
            const float f0 = __uint_as_float(v[i].x << 16), f1 = __uint_as_float(v[i].x & 0xffff0000u), f2 = __uint_as_float(v[i].y << 16), f3 = __uint_as_float(v[i].y & 0xffff0000u);
            *(u32x2*)(A.catb + ((size_t)b * S + c * 128 + row) * 1024 + 512 + grp * 256 + lane * 4) = (u32x2){pk2(f0 * rs, f1 * rs), pk2(f2 * rs, f3 * rs)}; } }
}
}
namespace mk {
__device__ __forceinline__ void rms_row_bf16(const float* xr, bf16_t* o, int lane) {
    f32x4 v[4]; float s = 0.f;
#pragma unroll
    for (int j = 0; j < 4; ++j) { v[j] = *(const f32x4*)(xr + lane * 4 + 256 * j); s += (v[j][0] * v[j][0] + v[j][1] * v[j][1]) + (v[j][2] * v[j][2] + v[j][3] * v[j][3]); }
    s = wsum(s); const float rs = rsqrtf(s * (1.f / 1024.f) + 1e-6f);
#pragma unroll
    for (int j = 0; j < 4; ++j) *(u32x2*)(o + lane * 4 + 256 * j) = (u32x2){pk2(v[j][0] * rs, v[j][1] * rs), pk2(v[j][2] * rs, v[j][3] * rs)};
}
constexpr int WT_PITCH = 68, WT_TILE_BYTES = 64 * WT_PITCH * 4;
template <bool OUT8>
__device__ __forceinline__ void wt_tile(const float* W, void* WTv, const float* gk1, const float* gk2, int ksplit, int K, int N, int NP, int mode, int nscale, float sc, int ntn, int ntk,
                                        int tile, LAS float* tl, int lane) {
    const int per = ntn * ntk, z = tile / per, rem = tile % per, n0 = (rem % ntn) * 64;
    const float* Wz = W + (size_t)z * K * N;
  for (int sub = 0; sub < (OUT8 ? 2 : 1); ++sub) {
    const int k0 = ((rem / ntn) * (OUT8 ? 2 : 1) + sub) * 64;
    const int lr = lane >> 4, lc = (lane & 15) * 4;
    f32x4 v[16];
#pragma unroll
    for (int i = 0; i < 16; ++i) { const int k = k0 + 4 * i + lr, n = n0 + lc; v[i] = (n < N) ? *(const f32x4*)(Wz + (size_t)k * N + n) : (f32x4){0.f, 0.f, 0.f, 0.f}; }
    if (gk1) {
#pragma unroll
        for (int i = 0; i < 16; ++i) { const int k = k0 + 4 * i + lr; const float g = (k < ksplit) ? gk1[k] : gk2[k - ksplit]; v[i] = v[i] * g; } }
#pragma unroll
    for (int i = 0; i < 16; ++i) *(LAS f32x4*)(tl + (4 * i + lr) * WT_PITCH + lc) = v[i];
    asm volatile("s_waitcnt lgkmcnt(0)" ::: "memory");
    const int nl = lane & 31, ch = lane >> 5;
#pragma unroll
    for (int half = 0; half < 2; ++half) { const int n = n0 + nl + 32 * half; const float s = (n < nscale) ? sc : 1.f;
        int nm = n; if (mode == 1) { const int up = n >> 10, jj = n & 1023; nm = (jj >> 7) * 256 + up * 128 + (jj & 127); }
#pragma unroll
        for (int cp = 0; cp < 4; ++cp) { const int c = 2 * cp + ch; const LAS float* src = tl + (8 * c) * WT_PITCH + nl + 32 * half;
            if constexpr (OUT8) { f8_t* WTz = (f8_t*)WTv + (size_t)z * NP * K;
                *(u32x2*)(WTz + (size_t)nm * K + k0 + 8 * c) = (u32x2){pk4_fp8(src[0] * s, src[WT_PITCH] * s, src[2 * WT_PITCH] * s, src[3 * WT_PITCH] * s), pk4_fp8(src[4 * WT_PITCH] * s, src[5 * WT_PITCH] * s, src[6 * WT_PITCH] * s, src[7 * WT_PITCH] * s)}; }
            else { bf16_t* WTz = (bf16_t*)WTv + (size_t)z * NP * K;
                u32x4 w; w.x = pk2(src[0] * s, src[WT_PITCH] * s); w.y = pk2(src[2 * WT_PITCH] * s, src[3 * WT_PITCH] * s); w.z = pk2(src[4 * WT_PITCH] * s, src[5 * WT_PITCH] * s); w.w = pk2(src[6 * WT_PITCH] * s, src[7 * WT_PITCH] * s);
                *(u32x4*)(WTz + (size_t)nm * K + k0 + 8 * c) = w; } } }
    asm volatile("s_waitcnt lgkmcnt(0)" ::: "memory");
  }
}
constexpr int CP_KX = 0  , CP_RED = 69632  , CP_HID = CP_RED + 32768  , CP_END = CP_HID + 8192 + 256;
struct CmpArgs { const bf16_t* projb; const bf16_t* w1T; const float* posb; const float* w2; bf16_t* kc; bf16_t* vc; };
__device__ __forceinline__ void cmp_item(LAS unsigned char* lds, const CmpArgs& A, int item) {
    const int tid = tid_fresh(), wid = __builtin_amdgcn_readfirstlane(tid >> 6), lane = tid & 63, ql = lane & 31, h = lane >> 5;
    const int cblk = item & 3, kvh = (item >> 2) & 1, b = (item >> 3) & 7, j = item >> 6;
    __syncthreads();
    { const int tok0 = 512 * cblk; const bf16_t* src = A.projb + ((size_t)b * S + tok0) * PROJ_LD + 512 + j * 128 + kvh * 64;
      for (int i = tid; i < 528 * 8; i += 512) { const int r = i >> 3, ch = i & 7; u32x4 v = (u32x4){0u, 0u, 0u, 0u};
          if (tok0 + r < S) v = *(const u32x4*)(src + (size_t)r * PROJ_LD + ch * 8);
          *(LAS u32x4*)(lds + CP_KX + r * 128 + ((ch ^ ((r >> 4) & 7)) << 4)) = v; } }
    if (tid < 64) { float a = 0.f;
#pragma unroll 16
        for (int sl = 0; sl < 64; ++sl) a += A.posb[(j * 64 + sl) * 64 + tid];
        ((LAS float*)(lds + CP_HID))[2048 + tid] = a; }
    __syncthreads();
    const int nb = wid & 1, kq = wid >> 1;
    f32x16 acc;
#pragma unroll
    for (int r = 0; r < 16; ++r) acc[r] = 0.f;
    const bf16_t* wrow = A.w1T + ((size_t)j * 64 + 32 * nb + ql) * 2048;
#pragma unroll 2
    for (int li = 0; li < 8; ++li) { const int l = 8 * kq + li;
#pragma unroll
        for (int s = 0; s < 4; ++s) {
            const int row = 16 * ql + l;
            const bf16x8 af = *(const LAS bf16x8*)(lds + CP_KX + row * 128 + (((2 * s + h) ^ ((row >> 4) & 7)) << 4));
            const bf16x8 bf = *(const bf16x8*)(wrow + l * 64 + 16 * s + 8 * h);
            acc = MFMA32(af, bf, acc); } }
    { LAS float* red = (LAS float*)(lds + CP_RED) + kq * 2048;
#pragma unroll
      for (int r = 0; r < 16; ++r) red[AT_CROW(r, h) * 64 + 32 * nb + ql] = acc[r]; }
    __syncthreads();
    { LAS float* red = (LAS float*)(lds + CP_RED); LAS float* hid = (LAS float*)(lds + CP_HID);
      for (int i = tid; i < 2048; i += 512) { const float a = (red[i] + red[2048 + i]) + (red[4096 + i] + red[6144 + i]) + hid[2048 + (i & 63)]; hid[i] = a / (1.f + __expf(-a)); } }
    __syncthreads();
    { const LAS float* hid = (const LAS float*)(lds + CP_HID); bf16_t* out = (j ? A.vc : A.kc) + (size_t)(b * 2 + kvh) * 128 * 64;
      for (int i = tid; i < 2048; i += 512) { const int cl = i >> 6, n2 = i & 63; float a = 0.f;
#pragma unroll 8
          for (int n = 0; n < 64; ++n) a += hid[cl * 64 + n] * A.w2[(j * 64 + n) * 64 + n2];
          const int c = 32 * cblk + cl; out[c * 64 + n2] = (c < 127) ? f2bf(a) : (bf16_t)0; } }
}
constexpr int RT_RW = 0;
struct RouteArgs { const bf16_t* h1; const float* ffn_norm; const float* router_w; const float* router_b; f8_t* hn8; int* cnt; int* list; float* wlist; int* tinfo; };
__device__ __forceinline__ void route_phase(LAS unsigned char* lds, const RouteArgs& A, int wg, int nwg) {
    const int tid = tid_fresh(), wid = __builtin_amdgcn_readfirstlane(tid >> 6), lane = tid & 63;
    LAS float* rw = (LAS float*)(lds + RT_RW);
    LAS float* lgt = (LAS float*)(lds + 131072);
    LAS int* lcnt = (LAS int*)(lds + 131072 + 16128); LAS int* gbase = lcnt + 32;
    __syncthreads();
    { f32x4 t4[16];
#pragma unroll
      for (int i = 0; i < 16; ++i) t4[i] = *(const f32x4*)(A.router_w + (size_t)(tid + 512 * i) * 4);
#pragma unroll
      for (int i = 0; i < 16; ++i) { const int q = tid + 512 * i, k = q >> 3, e0 = (q & 7) * 4; const float g = A.ffn_norm[k];
          rw[(e0 + 0) * 1024 + k] = t4[i][0] * g; rw[(e0 + 1) * 1024 + k] = t4[i][1] * g; rw[(e0 + 2) * 1024 + k] = t4[i][2] * g; rw[(e0 + 3) * 1024 + k] = t4[i][3] * g; } }
    if (tid < 32) lcnt[tid] = 0;
    __syncthreads();
    const int ex = ((lane >> 5) & 1) * 16 + ((lane >> 4) & 1) * 8 + ((lane >> 3) & 1) * 4 + ((lane >> 2) & 1) * 2 + ((lane >> 1) & 1);
    const float rbias = A.router_b[ex];
    int it = 0;
    for (int t0 = wg * 8 + wid; t0 < T; t0 += 2 * nwg * 8, it += 2) {
        const int t1 = t0 + nwg * 8; const bool has1 = t1 < T;
        f32x4 va[4], vb[4]; float sa = 0.f, sb = 0.f;
#pragma unroll
        for (int j = 0; j < 4; ++j) { const u32x2 ua = *(const u32x2*)(A.h1 + (size_t)t0 * D + lane * 4 + 256 * j); const u32x2 ub = has1 ? *(const u32x2*)(A.h1 + (size_t)t1 * D + lane * 4 + 256 * j) : (u32x2){0u, 0u};
            va[j] = (f32x4){__uint_as_float(ua.x << 16), __uint_as_float(ua.x & 0xffff0000u), __uint_as_float(ua.y << 16), __uint_as_float(ua.y & 0xffff0000u)};
            vb[j] = (f32x4){__uint_as_float(ub.x << 16), __uint_as_float(ub.x & 0xffff0000u), __uint_as_float(ub.y << 16), __uint_as_float(ub.y & 0xffff0000u)};
            sa += (va[j][0] * va[j][0] + va[j][1] * va[j][1]) + (va[j][2] * va[j][2] + va[j][3] * va[j][3]); sb += (vb[j][0] * vb[j][0] + vb[j][1] * vb[j][1]) + (vb[j][2] * vb[j][2] + vb[j][3] * vb[j][3]); }
#pragma unroll
        for (int o = 1; o < 64; o <<= 1) { sa += __shfl_xor(sa, o); sb += __shfl_xor(sb, o); }
        const float ra = rsqrtf(sa * (1.f / 1024.f) + 1e-6f), rb = rsqrtf(sb * (1.f / 1024.f) + 1e-6f);
#pragma unroll
        for (int j = 0; j < 4; ++j) { va[j] = va[j] * ra; vb[j] = vb[j] * rb; *(unsigned*)(A.hn8 + (size_t)t0 * D + lane * 4 + 256 * j) = pk4_fp8(va[j][0], va[j][1], va[j][2], va[j][3]);
            if (has1) *(unsigned*)(A.hn8 + (size_t)t1 * D + lane * 4 + 256 * j) = pk4_fp8(vb[j][0], vb[j][1], vb[j][2], vb[j][3]); }
        float pa[32], pb[32];
#pragma unroll
        for (int e = 0; e < 32; ++e) { pa[e] = 0.f; pb[e] = 0.f; }
#pragma unroll
        for (int e = 0; e < 32; ++e) {
#pragma unroll
            for (int j = 0; j < 4; ++j) { const f32x4 w4 = *(const LAS f32x4*)(rw + e * 1024 + lane * 4 + 256 * j);
                pa[e] += (va[j][0] * w4[0] + va[j][1] * w4[1]) + (va[j][2] * w4[2] + va[j][3] * w4[3]); pb[e] += (vb[j][0] * w4[0] + vb[j][1] * w4[1]) + (vb[j][2] * w4[2] + vb[j][3] * w4[3]); }
            if ((e & 3) == 3) __builtin_amdgcn_sched_barrier(0); }
        float r16a[16], r16b[16];
#pragma unroll
        for (int e = 0; e < 16; ++e) { const bool up = (lane & 32) != 0; r16a[e] = (up ? pa[16 + e] : pa[e]) + __shfl_xor(up ? pa[e] : pa[16 + e], 32); r16b[e] = (up ? pb[16 + e] : pb[e]) + __shfl_xor(up ? pb[e] : pb[16 + e], 32); }
        float r8a[8], r8b[8];
#pragma unroll
        for (int e = 0; e < 8; ++e) { const bool up = (lane & 16) != 0; r8a[e] = (up ? r16a[8 + e] : r16a[e]) + __shfl_xor(up ? r16a[e] : r16a[8 + e], 16); r8b[e] = (up ? r16b[8 + e] : r16b[e]) + __shfl_xor(up ? r16b[e] : r16b[8 + e], 16); }
        float r4a[4], r4b[4];
#pragma unroll
        for (int e = 0; e < 4; ++e) { const bool up = (lane & 8) != 0; r4a[e] = (up ? r8a[4 + e] : r8a[e]) + __shfl_xor(up ? r8a[e] : r8a[4 + e], 8); r4b[e] = (up ? r8b[4 + e] : r8b[e]) + __shfl_xor(up ? r8b[e] : r8b[4 + e], 8); }
        float r2a[2], r2b[2];
#pragma unroll
        for (int e = 0; e < 2; ++e) { const bool up = (lane & 4) != 0; r2a[e] = (up ? r4a[2 + e] : r4a[e]) + __shfl_xor(up ? r4a[e] : r4a[2 + e], 4); r2b[e] = (up ? r4b[2 + e] : r4b[e]) + __shfl_xor(up ? r4b[e] : r4b[2 + e], 4); }
        float r1a, r1b; { const bool up = (lane & 2) != 0; r1a = (up ? r2a[1] : r2a[0]) + __shfl_xor(up ? r2a[0] : r2a[1], 2); r1b = (up ? r2b[1] : r2b[0]) + __shfl_xor(up ? r2b[0] : r2b[1], 2); }
        r1a += __shfl_xor(r1a, 1); r1b += __shfl_xor(r1b, 1);
        if ((lane & 1) == 0) { const int l0 = it * 8 + wid; if (l0 < 112) lgt[l0 * 36 + ex] = r1a + rbias; if (has1 && l0 + 8 < 112) lgt[(l0 + 8) * 36 + ex] = r1b + rbias; }
    }
    __syncthreads();
    const int ntl = (T - wg * 8 + nwg * 8 - 1) / (nwg * 8) * 8;
    int te[4] = {0, 0, 0, 0}, lp[4] = {0, 0, 0, 0}; float tw[4] = {0.f, 0.f, 0.f, 0.f};
    const int tmine = wg * 8 + (tid & 7) + (tid >> 3) * nwg * 8; const bool mine = tid < 112 && tid < ntl && tmine < T;
    if (mine) { float v[32];
#pragma unroll
        for (int e4 = 0; e4 < 8; ++e4) { const f32x4 q4 = *(const LAS f32x4*)(lgt + tid * 36 + e4 * 4); v[e4 * 4] = q4[0]; v[e4 * 4 + 1] = q4[1]; v[e4 * 4 + 2] = q4[2]; v[e4 * 4 + 3] = q4[3]; }
        float tv[4];
#pragma unroll
        for (int k = 0; k < 4; ++k) { float best = -INFINITY; int bi = 0;
#pragma unroll
            for (int e = 0; e < 32; ++e) { const bool bt = v[e] > best; best = bt ? v[e] : best; bi = bt ? e : bi; }
#pragma unroll
            for (int e = 0; e < 32; ++e) v[e] = (e == bi) ? -INFINITY : v[e];
            tv[k] = best; te[k] = bi; }
        const float e1 = __expf(tv[1] - tv[0]), e2 = __expf(tv[2] - tv[0]), e3 = __expf(tv[3] - tv[0]); const float inv = 1.f / (1.f + e1 + e2 + e3);
        tw[0] = inv; tw[1] = e1 * inv; tw[2] = e2 * inv; tw[3] = e3 * inv;
#pragma unroll
        for (int k = 0; k < 4; ++k) lp[k] = __hip_atomic_fetch_add(lcnt + te[k], 1, __ATOMIC_RELAXED, __HIP_MEMORY_SCOPE_WORKGROUP); }
    __syncthreads();
    if (tid < 32) gbase[tid] = (int)__hip_atomic_fetch_add((unsigned*)A.cnt + tid, (unsigned)lcnt[tid], __ATOMIC_RELAXED, __HIP_MEMORY_SCOPE_AGENT);
    __syncthreads();
    if (mine) {
#pragma unroll
        for (int k = 0; k < 4; ++k) { const int e = te[k], pos = gbase[e] + lp[k], tk = tmine * 4 + k;
            A.list[(size_t)e * T + pos] = tk; A.wlist[tk] = tw[k]; A.tinfo[tk] = e | (pos << 8); } }
}
struct CombArgs { const bf16_t* h1; const f8_t* y; const int* tinfo; const float* tw; const int* cnt; const float* g; float* out; };
__device__ __forceinline__ void combine_phase(LAS unsigned char* lds, const CombArgs& A, int wg, int nwg) {
    const int tid = tid_fresh(), wid = __builtin_amdgcn_readfirstlane(tid >> 6), lane = tid & 63;
    LAS int* toff = (LAS int*)(lds + LDS_MISC + 64);
    __syncthreads();
    if (tid == 0) { int a = 0; for (int e = 0; e < NE; ++e) { toff[e] = a; a += (A.cnt[e] + 255) >> 8; } }
    __syncthreads();
    f32x4 gv[4];
#pragma unroll
    for (int j = 0; j < 4; ++j) gv[j] = *(const f32x4*)(A.g + lane * 4 + 256 * j);
    for (int t = wg * 8 + wid; t < T; t += nwg * 8) {
        size_t so[4]; float tw[4];
#pragma unroll
        for (int k = 0; k < 4; ++k) { const int inf = A.tinfo[t * 4 + k]; so[k] = ((size_t)toff[inf & 255] * 256 + (inf >> 8)) * 1024; tw[k] = A.tw[t * 4 + k]; }
        f32x4 v[4]; float s = 0.f;
#pragma unroll
        for (int j = 0; j < 4; ++j) { { const u32x2 uh = *(const u32x2*)(A.h1 + (size_t)t * D + lane * 4 + 256 * j); v[j] = (f32x4){__uint_as_float(uh.x << 16), __uint_as_float(uh.x & 0xffff0000u), __uint_as_float(uh.y << 16), __uint_as_float(uh.y & 0xffff0000u)}; }
#pragma unroll
            for (int k = 0; k < 4; ++k) { const unsigned yy = *(const unsigned*)(A.y + so[k] + lane * 4 + 256 * j);
                const f2_t lo = __builtin_amdgcn_cvt_pk_f32_fp8((int)yy, false), hi = __builtin_amdgcn_cvt_pk_f32_fp8((int)yy, true);
                v[j][0] += tw[k] * lo[0]; v[j][1] += tw[k] * lo[1]; v[j][2] += tw[k] * hi[0]; v[j][3] += tw[k] * hi[1]; }
            s += (v[j][0] * v[j][0] + v[j][1] * v[j][1]) + (v[j][2] * v[j][2] + v[j][3] * v[j][3]); }
        s = wsum(s); const float rs = rsqrtf(s * (1.f / 1024.f) + 1e-6f);
#pragma unroll
        for (int j = 0; j < 4; ++j) *(f32x4*)(A.out + (size_t)t * D + lane * 4 + 256 * j) = v[j] * rs * gv[j];
    }
}
}
#define XB_TMO      128
#define XB_XCNT(j)  (256  + 64 * (j))
#define XB_XSUB(j)  (1280 + 64 * (j))
#define XB_XGEN(j)  (2304 + 64 * (j))
#define XB_TOP      3328
#define XB_TOPGEN   3392
#define XCD_BAR_WORDS 3456
#define XB_SPIN_CAP (1u << 18)
__device__ __forceinline__ unsigned xb_ld(unsigned* p)              { return __hip_atomic_load(p, __ATOMIC_RELAXED, __HIP_MEMORY_SCOPE_AGENT); }
__device__ __forceinline__ unsigned xb_add(unsigned* p, unsigned v) { return __hip_atomic_fetch_add(p, v, __ATOMIC_RELAXED, __HIP_MEMORY_SCOPE_AGENT); }
__device__ __forceinline__ unsigned xb_xcc_id() { return (unsigned)__builtin_amdgcn_s_getreg((3 << 11) | 20) & 0xFu; }
#define XB_SPIN(cond, bar) do { unsigned _sp = 0; while (cond) { __builtin_amdgcn_s_sleep(1); \
    if ((++_sp & 255u) == 0u) { if (xb_ld(&(bar)[XB_TMO])) break; if (_sp > XB_SPIN_CAP) { atomicAdd(&(bar)[XB_TMO], 1u); break; } } } } while (0)
struct XcdBarrier { unsigned* bar; unsigned x; volatile LAS unsigned* st; };
__device__ __forceinline__ XcdBarrier xcd_barrier_post(unsigned* bar, volatile LAS unsigned* st) {
    XcdBarrier b; b.bar = bar; b.x = xb_xcc_id(); b.st = st;
    if (threadIdx.x == 0) (void)xb_add(&bar[XB_XCNT(b.x)], 1u);
    return b;
}
__device__ __forceinline__ void xcd_barrier_complete(unsigned* bar, unsigned x, unsigned& nloc, unsigned& nx) {
    const unsigned G = gridDim.x * gridDim.y * gridDim.z;
    unsigned sum, cnt, mine, sp = 0u;
    for (;;) {
        sum = 0u; cnt = 0u; mine = 0u;
#pragma unroll
        for (unsigned j = 0; j < 16; ++j) { const unsigned c = xb_ld(&bar[XB_XCNT(j)]); sum += c; cnt += (c > 0u) ? 1u : 0u; mine = (j == x) ? c : mine; }
        if (sum == G) break;
        __builtin_amdgcn_s_sleep(1);
        if ((++sp & 255u) == 0u) { if (xb_ld(&bar[XB_TMO])) break; if (sp > XB_SPIN_CAP) { atomicAdd(&bar[XB_TMO], 1u); break; } }
    }
    nloc = mine > 0u ? mine : 1u; nx = cnt > 0u ? cnt : 1u;
}
__device__ __forceinline__ void xcd_barrier(const XcdBarrier& b) {
    asm volatile("s_waitcnt vmcnt(0)" ::: "memory");
    __syncthreads();
    if (threadIdx.x == 0) {
        unsigned* bar = b.bar;
        __builtin_amdgcn_s_waitcnt(0);
        unsigned nloc = b.st[0], nx = b.st[1];
        if (nloc == 0u) { xcd_barrier_complete(bar, b.x, nloc, nx); b.st[0] = nloc; b.st[1] = nx; }
        const unsigned old = xb_add(&bar[XB_XSUB(b.x)], 1u);
        const unsigned gen = old / nloc;
        if (old + 1u == (gen + 1u) * nloc) {
            __builtin_amdgcn_fence(__ATOMIC_RELEASE, "agent");
            asm volatile("s_waitcnt vmcnt(0)" ::: "memory");
            const unsigned og = xb_add(&bar[XB_TOP], 1u);
            const unsigned tg = og / nx;
            if (og + 1u == (tg + 1u) * nx) xb_add(&bar[XB_TOPGEN], 1u);
            else XB_SPIN(xb_ld(&bar[XB_TOPGEN]) == tg, bar);
            __builtin_amdgcn_fence(__ATOMIC_ACQUIRE, "agent");
            xb_add(&bar[XB_XGEN(b.x)], 1u);
            asm volatile("s_waitcnt vmcnt(0)" ::: "memory");
        } else {
            XB_SPIN(xb_ld(&bar[XB_XGEN(b.x)]) == gen, bar);
            __builtin_amdgcn_fence(__ATOMIC_ACQUIRE, "agent");
            asm volatile("s_waitcnt vmcnt(0)" ::: "memory");
        }
    }
    __syncthreads();
}

namespace mk {
constexpr int LDS_BAR = 159744, LDS_FUSED = LDS_BAR + 256;
constexpr int CTL_QUEUE = 4096;
struct Params {
    const float *x, *attn_norm, *w_in, *rel_bias, *cmp_pos, *cmp_w1, *cmp_w2, *attn_out_norm, *conv_w, *conv_b, *dt_bias, *a_log, *d_skip, *ssm_out_norm, *w_out, *ffn_norm,
                *router_w, *router_b, *w_gu, *b_gu, *w_dn, *b_dn, *final_norm;
    float* out; unsigned* ctl; int* cnt;
    bf16_t *xb, *WinT, *WoutT, *w1T, *projb, *catb, *kc, *vc, *states; f8_t *WguT, *WdnT, *hn8, *act, *ymoe;
    float *posb, *alast, *wlist, *ssq; bf16_t* h1; int *list, *tinfo;
    int ph_lo, ph_hi;
};
constexpr int NT_WIN = 48 * 16, NT_WOUT = 16 * 16, NT_WGU = 32 * 32 * 8, NT_WDN = 32 * 16 * 8, NT_W1 = 2 * 32, NT_ALL = NT_WIN + NT_WOUT + NT_WGU + NT_WDN + NT_W1;
__device__ __forceinline__ void p0_prologue(LAS unsigned char* lds, const Params& p, int wg, int nwg) {
    const int tid = tid_fresh(), wid = __builtin_amdgcn_readfirstlane(tid >> 6), lane = tid & 63;
    for (int r = wg * 8 + wid; r < T; r += nwg * 8) rms_row_bf16(p.x + (size_t)r * D, p.xb + (size_t)r * D, lane);
    for (int o = wg * 8 + wid; o < 128; o += nwg * 8) { const int j = o >> 6, sl = o & 63; float s = 0.f;
#pragma unroll
        for (int kk = 0; kk < 32; ++kk) { const int k = sl * 32 + kk; s += p.cmp_pos[j * 2048 + k] * p.cmp_w1[((size_t)j * 2048 + k) * 64 + lane]; }
        p.posb[o * 64 + lane] = s; }
    LAS float* tl = (LAS float*)(lds + wid * WT_TILE_BYTES);
    __syncthreads();
    for (int task = wg * 8 + wid; task < NT_ALL; task += nwg * 8) { int idx = task;
        if (idx < NT_WIN) { wt_tile<false>(p.w_in, p.WinT, p.attn_norm, p.attn_norm, 1024, 1024, 2848, 3072, 0, 512, 0.125f * LOG2E, 48, 16, idx, tl, lane); continue; } idx -= NT_WIN;
        if (idx < NT_WOUT) { wt_tile<false>(p.w_out, p.WoutT, p.attn_out_norm, p.ssm_out_norm, 512, 1024, 1024, 1024, 0, 0, 1.f, 16, 16, idx, tl, lane); continue; } idx -= NT_WOUT;
        if (idx < NT_WGU) { wt_tile<true>(p.w_gu, p.WguT, p.ffn_norm, p.ffn_norm, 1024, 1024, 2048, 2048, 1, 2048, W8_SCALE, 32, 8, idx, tl, lane); continue; } idx -= NT_WGU;
        if (idx < NT_WDN) { wt_tile<true>(p.w_dn, p.WdnT, nullptr, nullptr, 0, 1024, 1024, 1024, 0, 1024, W8_SCALE, 16, 8, idx, tl, lane); continue; } idx -= NT_WDN;
        wt_tile<false>(p.cmp_w1, p.w1T, nullptr, nullptr, 0, 2048, 64, 64, 0, 0, 1.f, 1, 32, idx, tl, lane); }
}
__global__ void __launch_bounds__(512, 2) k_fused(Params p) {
    extern __shared__ __attribute__((aligned(16))) unsigned char dl[];
    LAS unsigned char* lds = (LAS unsigned char*)dl;
    const int wg = blockIdx.x, nwg = gridDim.x; int tid = tid_fresh();
    if (tid < 64) ((LAS unsigned*)(lds + LDS_BAR))[tid] = 0u;
    __syncthreads();
    XcdBarrier bar = xcd_barrier_post(p.ctl, (volatile LAS unsigned*)(lds + LDS_BAR));
#ifdef MK_ONLY
#define PH(k) ((k) == MK_ONLY && p.ph_lo <= (k) && (k) < p.ph_hi)
#else
#define PH(k) (p.ph_lo <= (k) && (k) < p.ph_hi)
#endif
#ifdef MK_REPEAT
#define REP(k) for (int _rep = 0; _rep < ((k) == MK_REPEAT ? 2 : 1); ++_rep)
#else
#define REP(k)
#endif
#ifdef MK_REPEAT
#define QREP _rep
#else
#define QREP 0
#endif
#ifdef MK_BARX2
#define SEAM(k) do { if (PH(k) && PH((k) + 1)) { xcd_barrier(bar); xcd_barrier(bar); } } while (0)
#else
#define SEAM(k) do { if (PH(k) && PH((k) + 1)) xcd_barrier(bar); } while (0)
#endif
    if (PH(0)) { p0_prologue(lds, p, wg, nwg);
#ifdef MK_P0X2
        __syncthreads(); p0_prologue(lds, p, wg, nwg);
#endif
    }
    SEAM(0);
    REP(1) if (PH(1)) { ProbProj P; P.S.init(T, NPROJ, nwg, wg); P.A = p.xb; P.Bt = p.WinT; P.O = p.projb; gemm_phase(lds, P); }
    SEAM(1);
    REP(2) if (PH(2)) {
        const SsdArgs SA{p.projb, p.conv_w, p.conv_b, p.dt_bias, p.a_log, p.d_skip, p.states, p.alast, p.catb};
        const CmpArgs CA{p.projb, p.w1T, p.posb, p.cmp_w2, p.kc, p.vc};
        for (int it = wg; it < 384; it += nwg) { const int v = 383 - it; if (v < 128) cmp_item(lds, CA, v); else ssd_a_item(lds, SA, v - 128); }
    }
    SEAM(2);
    REP(3) if (PH(3)) {
        const SsdArgs SA{p.projb, p.conv_w, p.conv_b, p.dt_bias, p.a_log, p.d_skip, p.states, p.alast, p.catb};
        const AttnArgs AA{p.projb, p.kc, p.vc, p.catb, p.ssq};
        bool btab_ok = false;
        LAS int* qslot = (LAS int*)(lds + LDS_BAR + 64);
        for (;;) {
            __syncthreads();
            if (tid_fresh() == 0) qslot[0] = (int)__hip_atomic_fetch_add(p.ctl + CTL_QUEUE + 64 * QREP, 1u, __ATOMIC_RELAXED, __HIP_MEMORY_SCOPE_AGENT);
            __syncthreads();
            const int it = qslot[0];
#if defined(MK_QX_ATTN)
            if (it >= 768 + 512) break;
            { const int i2 = it >= 768 ? it - 768 : it; if (i2 < 512) { if (!btab_ok) { attn_btab(lds, p.rel_bias); btab_ok = true; } attn_item(lds, AA, i2 & 7, 31 - (i2 >> 4), (i2 >> 3) & 1); } else { ssd_b_item(lds, SA, i2 - 512); btab_ok = false; } }
#elif defined(MK_QX_SSDB)
            if (it >= 768 + 256) break;
            { const int i2 = it >= 768 ? it - 256 : it; if (i2 < 512) attn_item(lds, AA, i2 & 7, 31 - (i2 >> 4), (i2 >> 3) & 1); else ssd_b_item(lds, SA, i2 - 512); }
#else
#if defined(MK_QX_BOTH)
            if (it >= 1536) break;
            { const int i2 = it >= 768 ? it - 768 : it; if (i2 < 512) { if (!btab_ok) { attn_btab(lds, p.rel_bias); btab_ok = true; } attn_item(lds, AA, i2 & 7, 31 - (i2 >> 4), (i2 >> 3) & 1); } else { ssd_b_item(lds, SA, i2 - 512); btab_ok = false; } }
#else
            if (it >= 768) break;
            if (it < 512) { if (!btab_ok) { attn_btab(lds, p.rel_bias); btab_ok = true; } attn_item(lds, AA, it & 7, 31 - (it >> 4), (it >> 3) & 1); } else { ssd_b_item(lds, SA, it - 512); btab_ok = false; }
#endif
#endif
        }
    }
    SEAM(3);
    REP(4) if (PH(4)) { ProbOut P; P.S.init(T, D, nwg, wg); P.A = p.catb; P.Bt = p.WoutT; P.R0 = p.x; P.O = p.h1; P.ssq = p.ssq; gemm_phase(lds, P); }
    SEAM(4);
    REP(5) if (PH(5)) { const bool dm = QREP != 0; const RouteArgs RA{p.h1, p.ffn_norm, p.router_w, p.router_b, p.hn8, dm ? p.cnt + 64 : p.cnt, dm ? (int*)p.act : p.list, dm ? (float*)p.act + (4u << 20) : p.wlist, dm ? (int*)p.act + (8u << 20) : p.tinfo}; route_phase(lds, RA, wg, nwg); }
    SEAM(5);
    REP(6) if (PH(6)) {
        tid = tid_fresh();
        __syncthreads();
        const int RT = moe_tables(lds, p.cnt);
        ProbMoe1 P; P.S.nN = 8; P.S.G = nwg; P.S.c = (nwg % 8 == 0) ? (wg & 7) * (nwg >> 3) + (wg >> 3) : wg; P.S.RT = RT; P.S.tile_e = (const LAS int*)(lds + LDS_TILE_E); P.S.tile_m = (const LAS int*)(lds + LDS_TILE_M);
        P.A = p.hn8; P.Bt = p.WguT; P.btab = (const LAS float*)(lds + LDS_BIASTAB); P.O = p.act; P.rowtab = (const LAS unsigned*)(lds + LDS_ROWTAB);
        LAS unsigned* rowtab = (LAS unsigned*)(lds + LDS_ROWTAB);
#pragma unroll 1
        for (int i = 0; i < 12; ++i) { Unit u; if (!P.S.next(i, u)) break; if (tid < 256) { const int pos = u.mt * 256 + tid; const int c = p.cnt[u.e];
            const int tok = (pos < c) ? (p.list[(size_t)u.e * T + pos] >> 2) : 0; rowtab[i * 256 + tid] = (unsigned)tok * KD; }
            else { const int j = tid - 256; ((LAS float*)(lds + LDS_BIASTAB))[i * 256 + j] = p.b_gu[u.e * 2048 + (j >> 7) * 1024 + u.pn * 128 + (j & 127)]; } }
        __syncthreads();
        gemm_phase(lds, P);
    }
    SEAM(6);
    REP(7) if (PH(7)) {
        __syncthreads();
        const int RT = moe_tables(lds, p.cnt);
        ProbMoe2 P; P.S.nN = 4; P.S.G = nwg; P.S.c = (nwg % 8 == 0) ? (wg & 7) * (nwg >> 3) + (wg >> 3) : wg; P.S.RT = RT; P.S.tile_e = (const LAS int*)(lds + LDS_TILE_E); P.S.tile_m = (const LAS int*)(lds + LDS_TILE_M);
        P.A = p.act; P.Bt = p.WdnT; P.btab = (const LAS float*)(lds + LDS_BIASTAB); P.O = p.ymoe;
#pragma unroll 1
        for (int i = 0; i < 12; ++i) { Unit u; if (!P.S.next(i, u)) break; if (tid_fresh() < 256) ((LAS float*)(lds + LDS_BIASTAB))[i * 256 + tid_fresh()] = p.b_dn[u.e * 1024 + u.pn * 256 + tid_fresh()]; }
        __syncthreads();
        gemm_phase(lds, P);
    }
    SEAM(7);
    REP(8) if (PH(8)) { const CombArgs CA{p.h1, p.ymoe, p.tinfo, p.wlist, p.cnt, p.final_norm, p.out}; combine_phase(lds, CA, wg, nwg); }
#undef PH
#undef SEAM
}
}

extern "C" void kernel_launch(void* const* d_in, const int* in_sizes, int n_in, void* d_out, int out_size, void* d_ws, size_t ws_size, hipStream_t stream) {
    using namespace mk;
    char* ws = (char*)d_ws; const size_t MB = 1u << 20;
    size_t o = 0; auto take = [&](size_t mb) { char* q = ws + o; o += mb * MB; return q; };
    Params p;
    memset(&p, 0, sizeof(p));
    const float** fin = (const float**)&p.x;
    for (int i = 0; i < 23; ++i) fin[i] = (const float*)d_in[i];
    p.out = (float*)d_out;
    p.ctl = (unsigned*)take(1); p.cnt = (int*)(p.ctl + 8192);
    p.xb = (bf16_t*)take(32); p.WinT = (bf16_t*)take(6); p.WoutT = (bf16_t*)take(2); p.WguT = (f8_t*)take(64); p.WdnT = (f8_t*)take(32); p.w1T = (bf16_t*)take(1);
    p.projb = (bf16_t*)take(96); p.catb = (bf16_t*)take(32); p.hn8 = (f8_t*)take(16); p.kc = (bf16_t*)take(1); p.vc = (bf16_t*)take(1); p.states = (bf16_t*)take(16);
    p.act = (f8_t*)take(72); p.ymoe = (f8_t*)take(72);
    p.posb = (float*)take(1); p.alast = (float*)take(1); p.ssq = (float*)take(1); p.h1 = (bf16_t*)take(32); p.wlist = (float*)take(2); p.list = (int*)take(2); p.tinfo = (int*)take(1);
    static int grid = 0;
    if (!grid) {
        int dev = 0, cus = 0, per_cu = 0;
        (void)hipGetDevice(&dev); (void)hipDeviceGetAttribute(&cus, hipDeviceAttributeMultiprocessorCount, dev);
        (void)hipFuncSetAttribute((const void*)k_fused, hipFuncAttributeMaxDynamicSharedMemorySize, LDS_FUSED);
        (void)hipOccupancyMaxActiveBlocksPerMultiprocessor(&per_cu, (const void*)k_fused, 512, LDS_FUSED);
        (void)hipGetLastError();
        grid = cus > 0 ? cus : 256;
    }
    (void)hipMemsetAsync(p.ctl, 0, 65536, stream);
#ifndef MK_SPLIT
    p.ph_lo = 0; p.ph_hi = 9;
    hipLaunchKernelGGL(k_fused, dim3(grid), dim3(512), LDS_FUSED, stream, p);
#else
    for (int k = 0; k < 9; ++k) { p.ph_lo = k; p.ph_hi = k + 1; hipLaunchKernelGGL(k_fused, dim3(grid), dim3(512), LDS_FUSED, stream, p); }
#endif
}
```

```cpp
#include <hip/hip_runtime.h>
#include <stdint.h>
#include <string.h>
#include <math.h>
namespace mk {
#define LAS __attribute__((address_space(3)))
typedef unsigned short bf16_t;
typedef short bf16x8 __attribute__((ext_vector_type(8)));
typedef float f32x4 __attribute__((ext_vector_type(4)));
typedef unsigned u32x4 __attribute__((ext_vector_type(4)));
typedef unsigned u32x2 __attribute__((ext_vector_type(2)));
typedef float f2_t __attribute__((ext_vector_type(2)));
constexpr int NB = 8, S = 2048, D = 1024, T = NB * S, NE = 32;
constexpr int BM = 256, BK = 64, HALF = 128, HTB = HALF * BK * 2, STAGE_BYTES = 8 * HTB, NXCD = 8, WGM = 8;
constexpr int KD = 1024;
constexpr int NPROJ = 3072;
constexpr int MAXSLOT = 65536 + 32 * 256;
constexpr int LDS_MISC = 131072, LDS_TILE_E = LDS_MISC + 64, LDS_TILE_M = LDS_TILE_E + 1536, LDS_ROWTAB = LDS_MISC + 4096, LDS_BIASTAB = LDS_ROWTAB + 12 * 1024, LDS_BYTES = LDS_BIASTAB + 12 * 1024;

__host__ __device__ __forceinline__ int lds_byte(int r, int c) { const int st = (r >> 4) * 2 + (c >> 5), rr = r & 15, cc = c & 31, ob = rr * 64 + cc * 2; return st * 1024 + (ob ^ (((ob >> 9) & 1) << 5)); }
__host__ __device__ __forceinline__ void stage_rc(int b, int& R, int& C) { const int st = b / 1024, sb = b % 1024, swz = sb ^ (((sb >> 9) & 1) << 5); R = (st >> 1) * 16 + swz / 64; C = (st & 1) * 32 + (swz % 64) / 2; }
__host__ __device__ __forceinline__ int perm32(int rho) { const int n = rho >> 4, i = rho & 15; return 8 * (i >> 2) + 4 * n + (i & 3); }
__device__ __forceinline__ unsigned cvt_pk_bf16(float lo, float hi) { unsigned r; asm volatile("v_cvt_pk_bf16_f32 %0, %1, %2" : "=v"(r) : "v"(lo), "v"(hi)); return r; }
__device__ __forceinline__ int tid_fresh() { int t = threadIdx.x; asm volatile("" : "+v"(t)); return t; }
__device__ __forceinline__ float bf2f(bf16_t b) { return __uint_as_float(((unsigned)b) << 16); }

struct Unit { int pm, pn, e, mt, li; };
struct StaticOrder {
    int nM, nN, nwg, G, c;
    __device__ void init(int M, int N, int G_, int c_) { nM = M / BM; nN = N / BM; nwg = nM * nN; G = G_; c = c_; }
    __device__ bool next(int i, Unit& u) const {
        const long L = (long)i * G + c; if (L >= nwg) return false;
        int wgid = (int)L; { const int q = nwg / NXCD, r = nwg % NXCD, xcd = wgid % NXCD, off = wgid / NXCD; wgid = (xcd < r ? xcd * (q + 1) : r * (q + 1) + (xcd - r) * q) + off; }
        const int nig = WGM * nN, gid = wgid / nig, fm = gid * WGM, gsz = (nM - fm) < WGM ? (nM - fm) : WGM;
        u.pm = fm + ((wgid % nig) % gsz); u.pn = (wgid % nig) / gsz; u.e = 0; u.mt = 0; u.li = i; return true;
    }
};
struct MoeOrder {
    int nN, G, c, RT; const LAS int* tile_e; const LAS int* tile_m;
    __device__ bool next(int i, Unit& u) const { const int L = i * G + c; if (L >= RT * nN) return false; const int rt = L / nN; u.pm = rt; u.pn = L - rt * nN; u.e = tile_e[rt]; u.mt = tile_m[rt]; u.li = i; return true; }
};

struct ProbProj {
    static constexpr bool PERM = true, F8 = false, MIDSCALE = false; static constexpr int ROWB = KD * 2;
    StaticOrder S; const bf16_t* A; const bf16_t* Bt; bf16_t* O;
    __device__ __forceinline__ bool next(int i, Unit& u) const { return S.next(i, u); }
    __device__ __forceinline__ const char* a_base(const Unit& u) const { return (const char*)A + (size_t)u.pm * (BM * KD * 2); }
    __device__ __forceinline__ const char* b_base(const Unit& u) const { return (const char*)Bt + (size_t)u.pn * (BM * KD * 2); }
    __device__ __forceinline__ void a_offs(int, const Unit&, unsigned (&v0)[2], unsigned (&v1)[2], const int (&R)[2], const int (&C)[2]) const {
#pragma unroll
        for (int i = 0; i < 2; ++i) { v0[i] = (unsigned)(R[i] * KD + C[i]) * 2u; v1[i] = v0[i] + (unsigned)(HALF * KD * 2); } }
    __device__ __forceinline__ void epi(const f32x4 (&acc)[2][2][4][2], const Unit& u, int wr, int wc, int fr, int fq) const {
        const int row0 = u.pm * BM + wr * 64 + fr, col0 = u.pn * BM + wc * 32 + 8 * fq;
#pragma unroll
        for (int ai = 0; ai < 2; ++ai)
#pragma unroll
            for (int m = 0; m < 4; ++m) { bf16_t* rowp = O + (size_t)(row0 + ai * HALF + m * 16) * NPROJ + col0;
#pragma unroll
                for (int bj = 0; bj < 2; ++bj) { const f32x4 v0 = acc[ai][bj][m][0], v1 = acc[ai][bj][m][1]; u32x4 w;
                    w.x = cvt_pk_bf16(v0[0], v0[1]); w.y = cvt_pk_bf16(v0[2], v0[3]); w.z = cvt_pk_bf16(v1[0], v1[1]); w.w = cvt_pk_bf16(v1[2], v1[3]);
                    *(u32x4*)(rowp + bj * HALF) = w; } }
    }
};
struct ProbOut {
    static constexpr bool PERM = false, F8 = false, MIDSCALE = true; static constexpr int ROWB = KD * 2;
    StaticOrder S; const bf16_t* A; const bf16_t* Bt; const float* R0; bf16_t* O; const float* ssq;
    __device__ __forceinline__ void midscale(f32x4 (&acc)[2][2][4][2], const Unit& u, int wr, int fr) const {
        asm volatile("" : "+v"(fr));
#pragma unroll
        for (int ai = 0; ai < 2; ++ai)
#pragma unroll
            for (int m = 0; m < 4; ++m) { const int row = u.pm * BM + ai * HALF + wr * 64 + m * 16 + fr; const f2_t q = *(const f2_t*)(ssq + (size_t)row * 2);
                const float rs = rsqrtf((q[0] + q[1]) * (1.f / 512.f) + 1e-6f);
#pragma unroll
                for (int bj = 0; bj < 2; ++bj)
#pragma unroll
                    for (int n = 0; n < 2; ++n) acc[ai][bj][m][n] = acc[ai][bj][m][n] * rs;
                asm volatile("" ::: "memory"); } }
    __device__ __forceinline__ bool next(int i, Unit& u) const { return S.next(i, u); }
    __device__ __forceinline__ const char* a_base(const Unit& u) const { return (const char*)A + (size_t)u.pm * (BM * KD * 2); }
    __device__ __forceinline__ const char* b_base(const Unit& u) const { return (const char*)Bt + (size_t)u.pn * (BM * KD * 2); }
    __device__ __forceinline__ void a_offs(int, const Unit&, unsigned (&v0)[2], unsigned (&v1)[2], const int (&R)[2], const int (&C)[2]) const {
#pragma unroll
        for (int i = 0; i < 2; ++i) { v0[i] = (unsigned)(R[i] * KD + C[i]) * 2u; v1[i] = v0[i] + (unsigned)(HALF * KD * 2); } }
    __device__ __forceinline__ void epi(const f32x4 (&acc)[2][2][4][2], const Unit& u, int wr, int wc, int fr, int fq) const {
        const int row0 = u.pm * BM + wr * 64 + fr, col0 = u.pn * BM + wc * 32 + 4 * fq;
#pragma unroll
        for (int ai = 0; ai < 2; ++ai)
#pragma unroll
            for (int m = 0; m < 4; ++m) { const size_t off = (size_t)(row0 + ai * HALF + m * 16) * D + col0;
#pragma unroll
                for (int bj = 0; bj < 2; ++bj)
#pragma unroll
                    for (int n = 0; n < 2; ++n) { const f32x4 r = *(const f32x4*)(R0 + off + bj * HALF + n * 16); const f32x4 o = acc[ai][bj][m][n] + r; *(u32x2*)(O + off + bj * HALF + n * 16) = (u32x2){cvt_pk_bf16(o[0], o[1]), cvt_pk_bf16(o[2], o[3])}; }
                asm volatile("" ::: "memory"); }
    }
};
typedef unsigned char f8_t;
typedef int i32x8 __attribute__((ext_vector_type(8)));
typedef int i32x4 __attribute__((ext_vector_type(4)));
constexpr float W8_SCALE = 32.f, W8_INV = 1.f / 32.f;
__device__ __forceinline__ unsigned pk4_fp8(float a, float b, float c, float d) { int r = __builtin_amdgcn_cvt_pk_fp8_f32(a, b, 0, false); r = __builtin_amdgcn_cvt_pk_fp8_f32(c, d, r, true); return (unsigned)r; }
struct ProbMoe1 {
    static constexpr bool PERM = true, F8 = true, MIDSCALE = false; static constexpr int ROWB = KD;
    MoeOrder S; const f8_t* A; const f8_t* Bt; const LAS float* btab; f8_t* O; const LAS unsigned* rowtab;
    __device__ __forceinline__ bool next(int i, Unit& u) const { return S.next(i, u); }
    __device__ __forceinline__ const char* a_base(const Unit&) const { return (const char*)A; }
    __device__ __forceinline__ const char* b_base(const Unit& u) const { return (const char*)Bt + ((size_t)u.e * 2048 + (size_t)u.pn * BM) * ROWB; }
    __device__ __forceinline__ void a_offs(int i, const Unit&, unsigned (&v0)[2], unsigned (&v1)[2], const int (&R)[2], const int (&C)[2]) const {
#pragma unroll
        for (int j = 0; j < 2; ++j) { v0[j] = rowtab[i * 256 + R[j]] + (unsigned)C[j] * 2u; v1[j] = rowtab[i * 256 + HALF + R[j]] + (unsigned)C[j] * 2u; } }
    __device__ __forceinline__ void epi(const f32x4 (&acc)[2][2][4][2], const Unit& u, int wr, int wc, int fr, int fq) const {
        const int row0 = u.pm * BM + wr * 64 + fr, jg0 = u.pn * HALF + wc * 32 + 8 * fq;
        f32x4 bg[2], bu[2];
#pragma unroll
        for (int n = 0; n < 2; ++n) { bg[n] = *(const LAS f32x4*)(btab + u.li * 256 + wc * 32 + 8 * fq + 4 * n); bu[n] = *(const LAS f32x4*)(btab + u.li * 256 + 128 + wc * 32 + 8 * fq + 4 * n); }
#pragma unroll
        for (int ai = 0; ai < 2; ++ai)
#pragma unroll
            for (int m = 0; m < 4; ++m) { float o[8];
#pragma unroll
                for (int n = 0; n < 2; ++n) { const f32x4 g4 = acc[ai][0][m][n] * W8_INV + bg[n], u4 = acc[ai][1][m][n] * W8_INV + bu[n];
#pragma unroll
                    for (int j = 0; j < 4; ++j) { const float g = fminf(g4[j], 7.f), uu = fminf(fmaxf(u4[j], -7.f), 7.f);
                        const float sg = __builtin_amdgcn_rcpf(1.f + __builtin_amdgcn_exp2f(-1.702f * 1.4426950408889634f * g)); o[n * 4 + j] = (uu + 1.f) * g * sg; } }
                *(u32x2*)(O + (size_t)(row0 + ai * HALF + m * 16) * 1024 + jg0) = (u32x2){pk4_fp8(o[0], o[1], o[2], o[3]), pk4_fp8(o[4], o[5], o[6], o[7])}; }
    }
};
struct ProbMoe2 {
    static constexpr bool PERM = true, F8 = true, MIDSCALE = false; static constexpr int ROWB = KD;
    MoeOrder S; const f8_t* A; const f8_t* Bt; const LAS float* btab; f8_t* O;
    __device__ __forceinline__ bool next(int i, Unit& u) const { return S.next(i, u); }
    __device__ __forceinline__ const char* a_base(const Unit& u) const { return (const char*)A + (size_t)u.pm * (BM * ROWB); }
    __device__ __forceinline__ const char* b_base(const Unit& u) const { return (const char*)Bt + ((size_t)u.e * 1024 + (size_t)u.pn * BM) * ROWB; }
    __device__ __forceinline__ void a_offs(int, const Unit&, unsigned (&v0)[2], unsigned (&v1)[2], const int (&R)[2], const int (&C)[2]) const {
#pragma unroll
        for (int i = 0; i < 2; ++i) { v0[i] = (unsigned)(R[i] * ROWB + C[i] * 2); v1[i] = v0[i] + (unsigned)(HALF * ROWB); } }
    __device__ __forceinline__ void epi(const f32x4 (&acc)[2][2][4][2], const Unit& u, int wr, int wc, int fr, int fq) const {
        const int rl0 = wr * 64 + fr, col0 = u.pn * BM + wc * 32 + 8 * fq;
#pragma unroll
        for (int ai = 0; ai < 2; ++ai)
#pragma unroll
            for (int m = 0; m < 4; ++m) { const int rl = rl0 + ai * HALF + m * 16;
                f8_t* rowp = O + (size_t)(u.pm * BM + rl) * 1024 + col0;
#pragma unroll
                for (int bj = 0; bj < 2; ++bj) { const f32x4 b0 = *(const LAS f32x4*)(btab + u.li * 256 + bj * HALF + wc * 32 + 8 * fq), b1 = *(const LAS f32x4*)(btab + u.li * 256 + bj * HALF + wc * 32 + 8 * fq + 4);
                    const f32x4 v0 = acc[ai][bj][m][0] * W8_INV + b0, v1 = acc[ai][bj][m][1] * W8_INV + b1;
                    *(u32x2*)(rowp + bj * HALF) = (u32x2){pk4_fp8(v0[0], v0[1], v0[2], v0[3]), pk4_fp8(v1[0], v1[1], v1[2], v1[3])}; }
                asm volatile("" ::: "memory"); }
    }
};

template <int N> struct FragBf { bf16x8 v[N][2];
    __device__ __forceinline__ void set(int i, int k, i32x4 x) { v[i][k] = __builtin_bit_cast(bf16x8, x); }
    __device__ __forceinline__ bf16x8 get(int i, int k) const { return v[i][k]; } };
template <int N> struct FragF8 { i32x8 v[N];
    __device__ __forceinline__ void set(int i, int k, i32x4 x) { if (k == 0) v[i].lo = x; else v[i].hi = x; }
    __device__ __forceinline__ bf16x8 get(int, int) const { return bf16x8{}; } };
template <bool F8> struct FragT { typedef FragBf<4> A_t; typedef FragBf<2> B_t; };
template <> struct FragT<true> { typedef FragF8<4> A_t; typedef FragF8<2> B_t; };
template <class P>
__device__ __forceinline__ void gemm_phase(LAS unsigned char* lds, const P& Pb) {
    const int tid = tid_fresh(), wid = __builtin_amdgcn_readfirstlane(tid >> 6), lane = tid & 63, wr = wid >> 2, wc = wid & 3, fr = lane & 15, fq = lane >> 4;
    constexpr int nt = P::ROWB / 128;
    int Rr[2], Cc[2]; unsigned voffB[2];
#pragma unroll
    for (int i = 0; i < 2; ++i) { int R, C; stage_rc(tid * 16 + i * 8192, R, C); const int Rb = P::PERM ? ((R & ~31) + perm32(R & 31)) : R; Rr[i] = R; Cc[i] = C; voffB[i] = (unsigned)(Rb * P::ROWB + C * 2); }
    constexpr size_t kstep = (size_t)(BK * 2);
    constexpr size_t hstep = (size_t)HALF * P::ROWB;
    const unsigned ldsw = (unsigned)wid * 1024u;
    const int aoff = lds_byte(wr * 64 + fr, fq * 8), boff = lds_byte(wc * 32 + fr, fq * 8);
#define PG8_SA(b, h) (((b) * 2 + (h)) * HTB)
#define PG8_SB(b, h) ((4 + (b) * 2 + (h)) * HTB)
#define PG8_STAGE(bufoff, gbase, voff) do { _Pragma("unroll") for (int _i = 0; _i < 2; ++_i) \
        __builtin_amdgcn_global_load_lds((const unsigned*)((const char*)(gbase) + (voff)[_i]), (LAS unsigned*)(lds + (bufoff) + ldsw + _i * 8192), 16, 0, 0); } while (0)
#define PG8_LDA(dst, b, h) do { _Pragma("unroll") for (int m = 0; m < 4; ++m) _Pragma("unroll") for (int k = 0; k < 2; ++k) dst.set(m, k, *(const LAS i32x4*)(lds + PG8_SA(b, h) + aoff + m * 2048 + k * 1024)); } while (0)
#define PG8_LDB(dst, b, h) do { _Pragma("unroll") for (int n = 0; n < 2; ++n) _Pragma("unroll") for (int k = 0; k < 2; ++k) dst.set(n, k, *(const LAS i32x4*)(lds + PG8_SB(b, h) + boff + n * 2048 + k * 1024)); } while (0)
#define PG8_MMA(ai, bj, At, Bt) do { __builtin_amdgcn_s_setprio(1); _Pragma("unroll") for (int m = 0; m < 4; ++m) _Pragma("unroll") for (int n = 0; n < 2; ++n) { \
        if constexpr (P::F8) acc[ai][bj][m][n] = __builtin_amdgcn_mfma_scale_f32_16x16x128_f8f6f4(Bt.v[n], At.v[m], acc[ai][bj][m][n], 0, 0, 0, 0x7f7f7f7f, 0, 0x7f7f7f7f); \
        else { _Pragma("unroll") for (int k = 0; k < 2; ++k) acc[ai][bj][m][n] = __builtin_amdgcn_mfma_f32_16x16x32_bf16(Bt.get(n, k), At.get(m, k), acc[ai][bj][m][n], 0, 0, 0); } } \
        __builtin_amdgcn_s_setprio(0); } while (0)
#define PG8_WAIT_V(n) asm volatile("s_waitcnt vmcnt(" #n ")" ::: "memory")
#define PG8_WAIT_L(n) asm volatile("s_waitcnt lgkmcnt(" #n ")" ::: "memory")
#define PG8_BAR __builtin_amdgcn_s_barrier()
#define PG8_SCHED __builtin_amdgcn_sched_barrier(0)
    Unit cur, nxt; int ui = 0;
    if (!Pb.next(0, cur)) return;
    f32x4 acc[2][2][4][2];
#pragma unroll
    for (int a = 0; a < 2; ++a)
#pragma unroll
        for (int b = 0; b < 2; ++b)
#pragma unroll
            for (int m = 0; m < 4; ++m)
#pragma unroll
                for (int n = 0; n < 2; ++n) acc[a][b][m][n] = (f32x4){0.f, 0.f, 0.f, 0.f};
    typedef typename FragT<P::F8>::A_t AFr; typedef typename FragT<P::F8>::B_t BFr;
    AFr At; BFr B0, B1;
    unsigned vA0[2], vA1[2];
    Pb.a_offs(0, cur, vA0, vA1, Rr, Cc);
    const char* cA = Pb.a_base(cur); const char* cB = Pb.b_base(cur);
    PG8_STAGE(PG8_SB(0, 0), cB, voffB); PG8_STAGE(PG8_SB(0, 1), cB + hstep, voffB); PG8_STAGE(PG8_SA(0, 0), cA, vA0); PG8_STAGE(PG8_SA(0, 1), cA, vA1);
    if (wr == 1) PG8_BAR;
    PG8_WAIT_V(2); PG8_BAR;
    PG8_STAGE(PG8_SB(1, 0), cB + kstep, voffB); PG8_STAGE(PG8_SA(1, 0), cA + kstep, vA0); PG8_STAGE(PG8_SB(1, 1), cB + hstep + kstep, voffB);
    PG8_WAIT_V(6); PG8_BAR;
    for (;;) {
        const bool has_next = Pb.next(ui + 1, nxt);
        const char* nA = has_next ? Pb.a_base(nxt) : cA; const char* nB = has_next ? Pb.b_base(nxt) : cB;
#define PG8_KITER \
            const bool last = (t == nt - 2); \
            if constexpr (P::MIDSCALE) { if (t == 8) Pb.midscale(acc, cur, wr, fr); } \
            const char* a1 = cA + (size_t)(t + 1) * kstep; \
            const char* a2 = last ? nA : cA + (size_t)(t + 2) * kstep; const char* b2 = last ? nB : cB + (size_t)(t + 2) * kstep; \
            const char* a3 = a2 + kstep; const char* b3 = b2 + kstep; \
            PG8_LDB(B0, 0, 0); PG8_LDB(B1, 0, 1); PG8_SCHED; PG8_LDA(At, 0, 0); PG8_STAGE(PG8_SA(1, 1), a1, vA1); \
            PG8_WAIT_V(8); PG8_WAIT_L(0); PG8_BAR; PG8_MMA(0, 0, At, B0); PG8_MMA(0, 1, At, B1); PG8_BAR; PG8_SCHED; \
            if (last && has_next) { \
                if constexpr (P::F8) { int R2[2], C2[2]; int t2 = tid; asm volatile("" : "+v"(t2)); \
_Pragma("unroll") \
                    for (int i = 0; i < 2; ++i) stage_rc(t2 * 16 + i * 8192, R2[i], C2[i]); \
                    Pb.a_offs(ui + 1, nxt, vA0, vA1, R2, C2); } \
                else Pb.a_offs(ui + 1, nxt, vA0, vA1, Rr, Cc); } \
            PG8_LDA(At, 0, 1); PG8_STAGE(PG8_SB(0, 0), b2, voffB); PG8_STAGE(PG8_SB(0, 1), b2 + hstep, voffB); PG8_STAGE(PG8_SA(0, 0), a2, vA0); \
            PG8_WAIT_V(8); PG8_WAIT_L(0); PG8_BAR; PG8_MMA(1, 0, At, B0); PG8_MMA(1, 1, At, B1); PG8_BAR; PG8_SCHED; \
            PG8_LDB(B0, 1, 0); PG8_LDB(B1, 1, 1); PG8_SCHED; PG8_LDA(At, 1, 0); PG8_STAGE(PG8_SA(0, 1), a2, vA1); \
            PG8_WAIT_V(8); PG8_WAIT_L(0); PG8_BAR; PG8_MMA(0, 0, At, B0); PG8_MMA(0, 1, At, B1); PG8_BAR; PG8_SCHED; \
            PG8_LDA(At, 1, 1); PG8_STAGE(PG8_SB(1, 0), b3, voffB); PG8_STAGE(PG8_SB(1, 1), b3 + hstep, voffB); PG8_STAGE(PG8_SA(1, 0), a3, vA0); \
            PG8_WAIT_V(8); PG8_WAIT_L(0); PG8_BAR; PG8_MMA(1, 0, At, B0); PG8_MMA(1, 1, At, B1); PG8_BAR; PG8_SCHED;
        if constexpr (P::F8) {
#pragma unroll 1
            for (int t = 0; t < nt; t += 2) { PG8_KITER }
        } else {
            for (int t = 0; t < nt; t += 2) { PG8_KITER }
        }
#undef PG8_KITER
        if (wr == 0) PG8_BAR;
        if constexpr (P::F8) { int ln2 = lane; asm volatile("" : "+v"(ln2)); Pb.epi(acc, cur, wr, wc, ln2 & 15, ln2 >> 4); } else Pb.epi(acc, cur, wr, wc, fr, fq);
        if (!has_next) break;
#pragma unroll
        for (int a = 0; a < 2; ++a)
#pragma unroll
            for (int b = 0; b < 2; ++b)
#pragma unroll
                for (int m = 0; m < 4; ++m)
#pragma unroll
                    for (int n = 0; n < 2; ++n) acc[a][b][m][n] = (f32x4){0.f, 0.f, 0.f, 0.f};
        cur = nxt; cA = nA; cB = nB; ++ui;
        if (wr == 1) PG8_BAR;
    }
    PG8_WAIT_V(0);
    PG8_BAR;
#undef PG8_SA
#undef PG8_SB
#undef PG8_STAGE
#undef PG8_LDA
#undef PG8_LDB
#undef PG8_MMA
#undef PG8_WAIT_V
#undef PG8_WAIT_L
#undef PG8_BAR
#undef PG8_SCHED
}

__device__ __forceinline__ int moe_tables(LAS unsigned char* lds, const int* cnt) {
    LAS int* tile_e = (LAS int*)(lds + LDS_TILE_E); LAS int* tile_m = (LAS int*)(lds + LDS_TILE_M); LAS int* rts = (LAS int*)(lds + LDS_MISC + 32);
    if (tid_fresh() == 0) { int a = 0; for (int e = 0; e < NE; ++e) { const int n = (cnt[e] + 255) >> 8; for (int m = 0; m < n; ++m) { tile_e[a] = e; tile_m[a] = m; ++a; } } rts[0] = a; }
    __syncthreads();
    return rts[0];
}
}
namespace mk {
__device__ __forceinline__ float wsum(float v) {
#pragma unroll
    for (int o = 1; o < 64; o <<= 1) v += __shfl_xor(v, o);
    return v; }
__device__ __forceinline__ unsigned short f2bf(float f) { unsigned u = __float_as_uint(f); u += 0x7FFFu + ((u >> 16) & 1u); return (unsigned short)(u >> 16); }
}
namespace mk {
typedef float f32x16 __attribute__((ext_vector_type(16)));
typedef short s16x4 __attribute__((ext_vector_type(4)));
typedef __bf16 bf2_t __attribute__((ext_vector_type(2)));
#define MFMA32(a, b, c) __builtin_amdgcn_mfma_f32_32x32x16_bf16((a), (b), (c), 0, 0, 0)
constexpr float LOG2E = 1.4426950408889634f;
constexpr int PROJ_LD = NPROJ;
constexpr int AT_KBUF = 0, AT_VBUF = 16384, AT_IMPW = 32768, AT_SCORE = 65536, AT_OBUF = 73728, AT_OSTR = 528, AT_BTAB = AT_OBUF + 64 * AT_OSTR  ,
              AT_SEL = AT_BTAB + 8 * 132 * 4  , AT_SSQ = AT_SEL + 512  , AT_END = AT_SSQ + 8 * 64 * 4  ;
struct AttnArgs { const bf16_t* projb; const bf16_t* kc; const bf16_t* vc; bf16_t* catb; float* ssq; };

__device__ __forceinline__ unsigned pk2(float a, float b) { f2_t v = {a, b}; return __builtin_bit_cast(unsigned, __builtin_convertvector(v, bf2_t)); }
__device__ __forceinline__ int t5_bucket(int n) { if (n < 0) n = 0; if (n < 16) return n; const float nf = (float)n; const int l = 16 + (int)(logf(nf / 16.f) / 2.0794415416798357f * 16.f); return l < 31 ? l : 31; }
__device__ __forceinline__ void stage_tile(LAS unsigned char* dst, const char* src, size_t row_stride, int wid, int lane, bool vswz) {
    const int row = 8 * wid + (lane >> 3), slot = lane & 7;
    const int f = vswz ? (((row >> 1) & 1) << 2) : ((row >> 1) & 7);
    __builtin_amdgcn_global_load_lds((const unsigned*)(src + (size_t)row * row_stride + ((slot ^ f) << 4)), (LAS unsigned*)(dst + wid * 1024), 16, 0, 0);
}
#define AT_CROW(r, h) (((r) & 3) + 8 * ((r) >> 2) + 4 * (h))
#define AT_PACK8(x, s) __builtin_bit_cast(bf16x8, (u32x4){pk2((x)[8 * (s)], (x)[8 * (s) + 1]), pk2((x)[8 * (s) + 2], (x)[8 * (s) + 3]), pk2((x)[8 * (s) + 4], (x)[8 * (s) + 5]), pk2((x)[8 * (s) + 6], (x)[8 * (s) + 7])})
__device__ __forceinline__ bf16x8 vt_frag(const LAS unsigned char* vt, unsigned vaddr, int rowoff) {
    const s16x4 lo = __builtin_amdgcn_ds_read_tr16_b64_v4i16((LAS s16x4*)(vt + vaddr + rowoff * 128));
    const s16x4 hi = __builtin_amdgcn_ds_read_tr16_b64_v4i16((LAS s16x4*)(vt + vaddr + (rowoff + 8) * 128));
    return __builtin_shufflevector(lo, hi, 0, 1, 2, 3, 4, 5, 6, 7);
}
template <bool FIRST>
__device__ __forceinline__ void obuf_acc(LAS unsigned char* lds, int tl, int hd, int h, float sc, const f32x16 (&oc)[2]) {
#pragma unroll
    for (int c = 0; c < 2; ++c)
#pragma unroll
        for (int qd = 0; qd < 4; ++qd) { LAS u32x2* p = (LAS u32x2*)(lds + AT_OBUF + tl * AT_OSTR + ((hd & 3) * 64 + 32 * c + 8 * qd + 4 * h) * 2);
            float a0 = sc * oc[c][4 * qd], a1 = sc * oc[c][4 * qd + 1], a2 = sc * oc[c][4 * qd + 2], a3 = sc * oc[c][4 * qd + 3];
            if (!FIRST) { const u32x2 o = *p; a0 += __uint_as_float(o.x << 16); a1 += __uint_as_float(o.x & 0xffff0000u); a2 += __uint_as_float(o.y << 16); a3 += __uint_as_float(o.y & 0xffff0000u); }
            *p = (u32x2){pk2(a0, a1), pk2(a2, a3)}; }
}
template <int KIND>
__device__ __forceinline__ void attn_tile(const LAS unsigned char* Kt, const LAS unsigned char* Vt, int kbase, int tq, bool sel, const bf16x8 (&qf)[4], const LAS float* bt, float cfar,
                                          f32x16 (&O)[2], float& m, float& l, int ql, int h, const unsigned (&vaddr)[2]) {
    f32x16 s0, s1;
#pragma unroll
    for (int r = 0; r < 16; ++r) { s0[r] = 0.f; s1[r] = 0.f; }
    const int fk = (ql >> 1) & 7;
#pragma unroll
    for (int s = 0; s < 4; ++s) { const int ch = ((2 * s + h) ^ fk) << 4;
        const bf16x8 k0 = *(const LAS bf16x8*)(Kt + ql * 128 + ch), k1 = *(const LAS bf16x8*)(Kt + (32 + ql) * 128 + ch);
        s0 = MFMA32(k0, qf[s], s0); s1 = MFMA32(k1, qf[s], s1); }
    float mx = -INFINITY;
    if (KIND == 0) {
#pragma unroll
        for (int r = 0; r < 16; ++r) mx = fmaxf(mx, fmaxf(s0[r], s1[r]));
        mx += cfar;
    } else {
        int tqq = tq - kbase; asm volatile("" : "+v"(tqq));
#pragma unroll
        for (int r = 0; r < 16; ++r) {
            const int d0 = tqq - AT_CROW(r, h), d1 = d0 - 32;
            float x0 = s0[r] + bt[min(max(d0, 0), 128)], x1 = s1[r] + bt[min(max(d1, 0), 128)];
            if (KIND == 2) { x0 = (d0 >= 0 && d0 < 512) ? x0 : -INFINITY; x1 = (d1 >= 0 && d1 < 512) ? x1 : -INFINITY; }
            s0[r] = x0; s1[r] = x1; mx = fmaxf(mx, fmaxf(x0, x1)); }
    }
    mx = sel ? mx : -INFINITY;
    mx = fmaxf(mx, __shfl_xor(mx, 32));
    const float mn = fmaxf(m, mx);
    const float alpha = __builtin_amdgcn_exp2f(m - mn);
    float msub = sel ? mn : INFINITY;
    if (KIND == 0) msub -= cfar;
    float ps = 0.f;
#pragma unroll
    for (int r = 0; r < 16; ++r) { const float p0 = __builtin_amdgcn_exp2f(s0[r] - msub), p1 = __builtin_amdgcn_exp2f(s1[r] - msub); s0[r] = p0; s1[r] = p1; ps += p0 + p1; }
    l = l * alpha + ps; m = mn;
    if (__any(alpha != 1.f)) {
#pragma unroll
        for (int r = 0; r < 16; ++r) { O[0][r] *= alpha; O[1][r] *= alpha; } }
#pragma unroll
    for (int sp = 0; sp < 2; ++sp) {
        const bf16x8 p0 = AT_PACK8(s0, sp), p1 = AT_PACK8(s1, sp);
#pragma unroll
        for (int c = 0; c < 2; ++c) { O[c] = MFMA32(vt_frag(Vt, vaddr[c], 16 * sp), p0, O[c]); O[c] = MFMA32(vt_frag(Vt, vaddr[c], 32 + 16 * sp), p1, O[c]); }
    }
}
template <int MODE>
__device__ __forceinline__ void attn_branch(LAS unsigned char* lds, unsigned U, unsigned mysel, const char* kcol, const char* vcol, size_t RS, int blk, int tq, const bf16x8 (&qf)[4],
                                            const LAS float* bt, float cfar, f32x16 (&oc)[2], float& m, float& l, int ql, int h, const unsigned (&vaddr)[2], int wid, int lane) {
#define AT_NEXT(n) (((n) >= 31) ? -1 : ((U & ~((2u << (n)) - 1u)) ? __builtin_ctz(U & ~((2u << (n)) - 1u)) : -1))
#define AT_ISSUE(n, st) do { stage_tile(lds + (st) * 16384, kcol + (size_t)(n) * 64 * RS, RS, wid, lane, false); stage_tile(lds + (st) * 16384 + 8192, vcol + (size_t)(n) * 64 * RS, RS, wid, lane, true); } while (0)
    int cur = __builtin_ctz(U | 0x80000000u), n1 = AT_NEXT(cur), n2 = (n1 >= 0) ? AT_NEXT(n1) : -1, st = 0;
    asm volatile("s_waitcnt lgkmcnt(0)" ::: "memory"); __builtin_amdgcn_s_barrier(); asm volatile("" ::: "memory");
    AT_ISSUE(cur, 0); if (n1 >= 0) AT_ISSUE(n1, 1); if (n2 >= 0) AT_ISSUE(n2, 2);
    for (;;) {
        if (n2 >= 0) asm volatile("s_waitcnt vmcnt(4)" ::: "memory"); else if (n1 >= 0) asm volatile("s_waitcnt vmcnt(2)" ::: "memory"); else asm volatile("s_waitcnt vmcnt(0)" ::: "memory");
        asm volatile("s_waitcnt lgkmcnt(0)" ::: "memory"); __builtin_amdgcn_s_barrier(); asm volatile("" ::: "memory");
        const int n3 = (n2 >= 0) ? AT_NEXT(n2) : -1;
        if (n3 >= 0) AT_ISSUE(n3, (st + 3) & 3);
        const LAS unsigned char* Kt = lds + st * 16384; const LAS unsigned char* Vt = Kt + 8192;
        const bool sel = (MODE == 0) ? (((mysel >> cur) & 1u) != 0u) : true;
        const bool masked = (cur == blk) || (MODE == 1 && cur + 8 == blk);
#ifdef MK_TILEX2
        { f32x16 od[2] = {oc[0], oc[1]}; float md = m, ld = l;
          attn_tile<0>(Kt, Vt, cur * 64, tq, sel, qf, bt, cfar, od, md, ld, ql, h, vaddr);
          asm volatile("" :: "v"(od[0]), "v"(od[1]), "v"(md), "v"(ld)); }
#endif
        if (masked) attn_tile<2>(Kt, Vt, cur * 64, tq, sel, qf, bt, cfar, oc, m, l, ql, h, vaddr);
        else if (cur + 3 <= blk) attn_tile<0>(Kt, Vt, cur * 64, tq, sel, qf, bt, cfar, oc, m, l, ql, h, vaddr);
        else attn_tile<1>(Kt, Vt, cur * 64, tq, sel, qf, bt, cfar, oc, m, l, ql, h, vaddr);
        if (n1 < 0) break;
        cur = n1; n1 = n2; n2 = n3; st = (st + 1) & 3;
    }
#undef AT_NEXT
#undef AT_ISSUE
}

__device__ __forceinline__ void attn_item(LAS unsigned char* lds, const AttnArgs& A, int b, int qt, int kvh) {
    const int tid = tid_fresh(), wid = __builtin_amdgcn_readfirstlane(tid >> 6), lane = tid & 63;
    const int g = wid >> 1, th = wid & 1, ql = lane & 31, h = lane >> 5;
    const int t0 = qt * 64, tl = th * 32 + ql, tq = t0 + tl, blk = qt;
    const int qq = (lane & 15) >> 2, pp = lane & 3, lb = (lane >> 4) & 1;
    unsigned vaddr[2];
#pragma unroll
    for (int c = 0; c < 2; ++c) vaddr[c] = (unsigned)((4 * h + qq) * 128 + (((4 * (c ^ ((qq >> 1) & 1))) + 2 * lb + (pp >> 1)) << 4) + 8 * (pp & 1));
    LAS float* impw = (LAS float*)(lds + AT_IMPW); LAS float* score = (LAS float*)(lds + AT_SCORE); LAS unsigned* selm = (LAS unsigned*)(lds + AT_SEL);
    const char* prow0 = (const char*)(A.projb + (size_t)b * S * PROJ_LD);
    const size_t RS = (size_t)PROJ_LD * 2;
    {
        const int hd = kvh * 4 + g;
        const LAS float* bt = (const LAS float*)(lds + AT_BTAB) + hd * 132;
        const float cfar = bt[128];
        bf16x8 qf[4];
#pragma unroll
        for (int s = 0; s < 4; ++s) qf[s] = *(const bf16x8*)(A.projb + ((size_t)b * S + tq) * PROJ_LD + hd * 64 + 16 * s + 8 * h);
        float gate[3];
#pragma unroll
        for (int j = 0; j < 3; ++j) { const float gv = bf2f(A.projb[((size_t)b * S + tq) * PROJ_LD + 1280 + j * 8 + hd]); gate[j] = 1.f / (1.f + __expf(-gv)); }
        __syncthreads();
        { const char* kcb = (const char*)(A.kc + (size_t)(b * 2 + kvh) * 128 * 64); const char* vcb = (const char*)(A.vc + (size_t)(b * 2 + kvh) * 128 * 64);
          stage_tile(lds + AT_KBUF, kcb, 128, wid, lane, false); stage_tile(lds + AT_KBUF + 8192, kcb + 64 * 128, 128, wid, lane, false);
          stage_tile(lds + AT_VBUF, vcb, 128, wid, lane, true); stage_tile(lds + AT_VBUF + 8192, vcb + 64 * 128, 128, wid, lane, true); }
        asm volatile("s_waitcnt vmcnt(0)" ::: "memory"); __syncthreads();
        {
            f32x16 sc[4]; const int fk = (ql >> 1) & 7; int tqc = tq; asm volatile("" : "+v"(tqc));
#pragma unroll
            for (int kb = 0; kb < 4; ++kb) {
#pragma unroll
                for (int r = 0; r < 16; ++r) sc[kb][r] = 0.f;
#pragma unroll
                for (int s = 0; s < 4; ++s) { const bf16x8 kf = *(const LAS bf16x8*)(lds + AT_KBUF + (32 * kb + ql) * 128 + (((2 * s + h) ^ fk) << 4)); sc[kb] = MFMA32(kf, qf[s], sc[kb]); }
                __builtin_amdgcn_sched_barrier(0); }
            float mx = -INFINITY;
#pragma unroll
            for (int kb = 0; kb < 4; ++kb)
#pragma unroll
                for (int r = 0; r < 16; ++r) { const int c = 32 * kb + AT_CROW(r, h); const int dist = tqc - 16 * c - 31; const float bv = bt[min(max(dist, 0), 128)]; const float x = (dist >= 0) ? sc[kb][r] + bv : -INFINITY; sc[kb][r] = x; mx = fmaxf(mx, x);
                    if ((r & 7) == 7) __builtin_amdgcn_sched_barrier(0); }
            mx = fmaxf(mx, __shfl_xor(mx, 32));
            const float mref = (mx == -INFINITY) ? 0.f : mx;
            float ls = 0.f;
#pragma unroll
            for (int kb = 0; kb < 4; ++kb)
#pragma unroll
                for (int r = 0; r < 16; ++r) { const float p = __builtin_amdgcn_exp2f(sc[kb][r] - mref); sc[kb][r] = p; ls += p; }
            ls += __shfl_xor(ls, 32);
            const float inv = 1.f / fmaxf(ls, 1e-30f);
#pragma unroll
            for (int kb = 0; kb < 4; ++kb)
#pragma unroll
                for (int r = 0; r < 16; ++r) sc[kb][r] *= inv;
            { float carry = 0.f;
#pragma unroll
              for (int i = 0; i < 16; ++i) { const int kb = i >> 2, qd = i & 3;
                  const float s4 = (sc[kb][4 * qd] + sc[kb][4 * qd + 1]) + (sc[kb][4 * qd + 2] + sc[kb][4 * qd + 3]);
                  const float rv = __shfl_xor(sc[kb][4 * qd + 3], 32);
                  impw[(wid * 32 + ql) * 32 + 2 * i + h] = s4 + (h ? rv : carry); carry = rv; } }
            f32x16 oc[2];
#pragma unroll
            for (int r = 0; r < 16; ++r) { oc[0][r] = 0.f; oc[1][r] = 0.f; }
#pragma unroll
            for (int kb = 0; kb < 4; ++kb)
#pragma unroll
                for (int sp = 0; sp < 2; ++sp) { const bf16x8 pf = AT_PACK8(sc[kb], sp);
#pragma unroll
                    for (int c = 0; c < 2; ++c) oc[c] = MFMA32(vt_frag(lds + AT_VBUF, vaddr[c], 32 * kb + 16 * sp), pf, oc[c]);
                    __builtin_amdgcn_sched_barrier(0); }
            obuf_acc<true>(lds, tl, hd, h, gate[0], oc);
        }
        __syncthreads();
        int tids = tid; asm volatile("" : "+v"(tids));
#pragma unroll
        for (int i = 0; i < 4; ++i) { const int id = tids + 512 * i, tk = id >> 5, n = id & 31, w0 = tk >> 5, q = tk & 31;
            float v = 0.f;
#pragma unroll
            for (int gg = 0; gg < 4; ++gg) v += impw[((2 * gg + w0) * 32 + q) * 32 + n];
            const bool forced = (n == 0) || (n == blk) || (n == blk - 1);
            score[tk * 32 + n] = forced ? 1e4f : ((n <= blk) ? v : -1.f); }
        __syncthreads();
        { const int tk = tids >> 3, part = tids & 7;
          float sv[32];
#pragma unroll
          for (int e4 = 0; e4 < 8; ++e4) { const f32x4 q4 = *(const LAS f32x4*)(score + tk * 32 + e4 * 4); sv[e4 * 4] = q4[0]; sv[e4 * 4 + 1] = q4[1]; sv[e4 * 4 + 2] = q4[2]; sv[e4 * 4 + 3] = q4[3]; }
          unsigned bits = 0u;
#pragma unroll
          for (int j = 0; j < 4; ++j) { const int n = 4 * part + j; const float sn = score[tk * 32 + n];
              int rank = 0;
#pragma unroll
              for (int mm = 0; mm < 32; ++mm) rank += (sv[mm] > sn || (sv[mm] == sn && mm < n)) ? 1 : 0;
              bits |= ((rank < 16) && (n <= blk)) ? (1u << n) : 0u; }
          bits |= (unsigned)__shfl_xor((int)bits, 1); bits |= (unsigned)__shfl_xor((int)bits, 2); bits |= (unsigned)__shfl_xor((int)bits, 4);
          if (part == 0) selm[tk] = bits; }
        __syncthreads();
        unsigned U = selm[lane];
#pragma unroll
        for (int o = 1; o < 64; o <<= 1) U |= (unsigned)__shfl_xor((int)U, o);
        U = (unsigned)__builtin_amdgcn_readfirstlane((int)U);
        const unsigned mysel = selm[tl];
        {
            f32x16 oc[2];
#pragma unroll
            for (int r = 0; r < 16; ++r) { oc[0][r] = 0.f; oc[1][r] = 0.f; }
            float m = -1e30f, l = 0.f;
            attn_branch<0>(lds, U, mysel, prow0 + (512 + 2 * 128 + kvh * 64) * 2, prow0 + (512 + 3 * 128 + kvh * 64) * 2, RS, blk, tq, qf, bt, cfar, oc, m, l, ql, h, vaddr, wid, lane);
            l += __shfl_xor(l, 32);
            const float sc1 = gate[1] / fmaxf(l, 1e-30f);
            obuf_acc<false>(lds, tl, hd, h, sc1, oc);
        }
        {
            f32x16 oc[2];
#pragma unroll
            for (int r = 0; r < 16; ++r) { oc[0][r] = 0.f; oc[1][r] = 0.f; }
            float m = -1e30f, l = 0.f;
            const int lo = (blk >= 8) ? blk - 8 : 0;
            const unsigned Uw = ((blk >= 31) ? 0xffffffffu : ((2u << blk) - 1u)) & ~((1u << lo) - 1u);
            attn_branch<1>(lds, Uw, 0u, prow0 + (512 + 4 * 128 + kvh * 64) * 2, prow0 + (512 + 5 * 128 + kvh * 64) * 2, RS, blk, tq, qf, bt, cfar, oc, m, l, ql, h, vaddr, wid, lane);
            l += __shfl_xor(l, 32);
            const float sc2 = gate[2] / fmaxf(l, 1e-30f);
            obuf_acc<false>(lds, tl, hd, h, sc2, oc);
        }
    }
    __syncthreads();
    int widn = wid; asm volatile("" : "+s"(widn));
    { u32x2 v[8]; float sq[8];
#pragma unroll
      for (int i = 0; i < 8; ++i) { v[i] = *(const LAS u32x2*)(lds + AT_OBUF + (widn + 8 * i) * AT_OSTR + lane * 8);
          const float f0 = __uint_as_float(v[i].x << 16), f1 = __uint_as_float(v[i].x & 0xffff0000u), f2 = __uint_as_float(v[i].y << 16), f3 = __uint_as_float(v[i].y & 0xffff0000u);
          sq[i] = (f0 * f0 + f1 * f1) + (f2 * f2 + f3 * f3); }
#pragma unroll
      for (int o = 1; o < 64; o <<= 1) {
#pragma unroll
          for (int i = 0; i < 8; ++i) sq[i] += __shfl_xor(sq[i], o); }
#pragma unroll
      for (int i = 0; i < 8; ++i) { const int row = widn + 8 * i;
          *(u32x2*)(A.catb + ((size_t)b * S + t0 + row) * 1024 + kvh * 256 + lane * 4) = v[i];
          if (lane == 0) A.ssq[((size_t)b * S + t0 + row) * 2 + kvh] = sq[i]; } }
    __syncthreads();
}
__device__ __forceinline__ void attn_btab(LAS unsigned char* lds, const float* rel_bias) {
    LAS float* bt = (LAS float*)(lds + AT_BTAB);
    for (int i = threadIdx.x; i < 8 * 129; i += 512) { const int hd = i / 129, d = i % 129; bt[hd * 132 + d] = rel_bias[t5_bucket(d) * 8 + hd] * LOG2E; }
    __syncthreads();
}
}
namespace mk {
constexpr int XBC_OFF = 1816, Z_OFF = 1304, DT_OFF = 2840, NCH = 16;
constexpr int SD_XS = 0, SD_B = 65536, SD_C = 98304, SD_PREV = 131072  , SD_ACS = SD_PREV + 16384, SD_DT = SD_ACS + 2048, SD_W = SD_DT + 2048, SD_WP = SD_W + 2048  , SD_END = SD_WP + 256;
struct SsdArgs { const bf16_t* projb; const float* conv_w; const float* conv_b; const float* dt_bias; const float* a_log; const float* d_skip; bf16_t* states; float* alast; bf16_t* catb; };

__device__ __forceinline__ void ssd_dt_acs(LAS unsigned char* lds, const SsdArgs& A, int b, int c, int grp, int wid, int lane) {
    if (wid < 4) { const int hd = grp * 4 + wid; const float Ah = -__expf(A.a_log[hd]), db = A.dt_bias[hd];
        const size_t row = (size_t)b * S + c * 128 + 2 * lane;
        float x0 = bf2f(A.projb[row * PROJ_LD + DT_OFF + hd]) + db, x1 = bf2f(A.projb[(row + 1) * PROJ_LD + DT_OFF + hd]) + db;
        const float d0 = (x0 > 20.f) ? x0 : log1pf(__expf(x0)), d1 = (x1 > 20.f) ? x1 : log1pf(__expf(x1));
        const float a0 = d0 * Ah, a1 = d1 * Ah; float incl = a0 + a1;
#pragma unroll
        for (int o = 1; o < 64; o <<= 1) { const float t = __shfl_up(incl, o); if (lane >= o) incl += t; }
        LAS float* acs = (LAS float*)(lds + SD_ACS) + wid * 128; LAS float* dtl = (LAS float*)(lds + SD_DT) + wid * 128;
        acs[2 * lane] = incl - a1; acs[2 * lane + 1] = incl; dtl[2 * lane] = d0; dtl[2 * lane + 1] = d1; }
}
template <bool PHASE_A>
__device__ __forceinline__ void ssd_conv(LAS unsigned char* lds, const SsdArgs& A, int b, int c, int grp, int wid, int lane) {
    const int ch = lane;
    if (PHASE_A && ch >= 48) return;
    const int rel = (ch < 32) ? grp * 256 + ch * 8 : (ch < 48) ? 512 + grp * 128 + (ch - 32) * 8 : 768 + grp * 128 + (ch - 48) * 8;
    float w[4][8], bias[8];
#pragma unroll
    for (int k = 0; k < 4; ++k) { const f32x4 u0 = *(const f32x4*)(A.conv_w + k * 1024 + rel), u1 = *(const f32x4*)(A.conv_w + k * 1024 + rel + 4);
#pragma unroll
        for (int j = 0; j < 4; ++j) { w[k][j] = u0[j]; w[k][4 + j] = u1[j]; } }
    { const f32x4 u0 = *(const f32x4*)(A.conv_b + rel), u1 = *(const f32x4*)(A.conv_b + rel + 4);
#pragma unroll
      for (int j = 0; j < 4; ++j) { bias[j] = u0[j]; bias[4 + j] = u1[j]; } }
    const int tl0 = wid * 16, ts0 = c * 128 + tl0;
    const bf16_t* src = A.projb + ((size_t)b * S + ts0) * PROJ_LD + XBC_OFF + rel;
    float x0[8], x1[8], x2[8];
#pragma unroll
    for (int j = 0; j < 8; ++j) { x0[j] = 0.f; x1[j] = 0.f; x2[j] = 0.f; }
    if (ts0 >= 3) {
        const bf16x8 r0 = *(const bf16x8*)(src - 3 * (ptrdiff_t)PROJ_LD), r1 = *(const bf16x8*)(src - 2 * (ptrdiff_t)PROJ_LD), r2 = *(const bf16x8*)(src - 1 * (ptrdiff_t)PROJ_LD);
#pragma unroll
        for (int j = 0; j < 8; ++j) { x0[j] = bf2f((bf16_t)r0[j]); x1[j] = bf2f((bf16_t)r1[j]); x2[j] = bf2f((bf16_t)r2[j]); } }
    const LAS float* wt = (const LAS float*)(lds + SD_W) + (ch >> 3) * 128;
    bf16x8 rvv[16];
#pragma unroll
    for (int i = 0; i < 16; ++i) rvv[i] = *(const bf16x8*)(src + (size_t)i * PROJ_LD);
#pragma unroll
    for (int i = 0; i < 16; ++i) {
        const bf16x8 rv = rvv[i];
        float x3[8], o[8];
#pragma unroll
        for (int j = 0; j < 8; ++j) { x3[j] = bf2f((bf16_t)rv[j]); const float a = bias[j] + w[0][j] * x0[j] + w[1][j] * x1[j] + w[2][j] * x2[j] + w[3][j] * x3[j]; o[j] = a / (1.f + __expf(-a)); x0[j] = x1[j]; x1[j] = x2[j]; x2[j] = x3[j]; }
        const int row = tl0 + i;
        if (PHASE_A && ch < 32) { const float sc = wt[row];
#pragma unroll
            for (int j = 0; j < 8; ++j) o[j] *= sc; }
        u32x4 pk; pk.x = pk2(o[0], o[1]); pk.y = pk2(o[2], o[3]); pk.z = pk2(o[4], o[5]); pk.w = pk2(o[6], o[7]);
        if (ch < 32) *(LAS u32x4*)(lds + SD_XS + row * 512 + ((ch ^ ((row & 3) << 2)) << 4)) = pk;
        else if (ch < 48) { const int cc = ch - 32; *(LAS u32x4*)(lds + SD_B + row * 256 + ((PHASE_A ? (cc ^ ((row & 3) << 2)) : (cc ^ (row & 15))) << 4)) = pk; }
        else { const int cc = ch - 48; *(LAS u32x4*)(lds + SD_C + row * 256 + ((cc ^ (row & 15)) << 4)) = pk; }
    }
}
__device__ __forceinline__ bf16x8 tr_frag2(const LAS unsigned char* base, int stride, int r0, int r1, int chunk0, int qq, int pp) {
    const int cl = chunk0 + (pp >> 1);
    const s16x4 lo = __builtin_amdgcn_ds_read_tr16_b64_v4i16((LAS s16x4*)(base + (r0 + qq) * stride + ((cl ^ (qq << 2)) << 4) + 8 * (pp & 1)));
    const s16x4 hi = __builtin_amdgcn_ds_read_tr16_b64_v4i16((LAS s16x4*)(base + (r1 + qq) * stride + ((cl ^ (qq << 2)) << 4) + 8 * (pp & 1)));
    return __builtin_shufflevector(lo, hi, 0, 1, 2, 3, 4, 5, 6, 7);
}
__device__ __forceinline__ void ssd_a_item(LAS unsigned char* lds, const SsdArgs& A, int item) {
    const int tid = tid_fresh(), wid = __builtin_amdgcn_readfirstlane(tid >> 6), lane = tid & 63;
    const int grp = item & 1, c = (item >> 1) & 15, b = item >> 5;
    const int ql = lane & 31, h = lane >> 5, qq = (lane & 15) >> 2, pp = lane & 3, lb2 = (lane >> 4) & 1;
    __syncthreads();
    ssd_dt_acs(lds, A, b, c, grp, wid, lane);
    __syncthreads();
    { LAS float* acs = (LAS float*)(lds + SD_ACS); LAS float* dtl = (LAS float*)(lds + SD_DT); LAS float* wt = (LAS float*)(lds + SD_W);
      const int hh = tid >> 7, t = tid & 127; const float al = acs[hh * 128 + 127];
      wt[hh * 128 + t] = dtl[hh * 128 + t] * __expf(al - acs[hh * 128 + t]);
      if (t == 0) A.alast[(b * 8 + grp * 4 + hh) * NCH + c] = al; }
    __syncthreads();
    ssd_conv<true>(lds, A, b, c, grp, wid, lane);
    __syncthreads();
    const int pb = wid >> 2, nb = wid & 3;
#pragma unroll 1
    for (int hh = 0; hh < 4; ++hh) {
        f32x16 acc;
#pragma unroll
        for (int r = 0; r < 16; ++r) acc[r] = 0.f;
#pragma unroll
        for (int kk = 0; kk < 8; ++kk) {
            const bf16x8 af = tr_frag2(lds + SD_XS, 512, 16 * kk + 8 * h, 16 * kk + 8 * h + 4, hh * 8 + 4 * pb + 2 * lb2, qq, pp);
            const bf16x8 bf = tr_frag2(lds + SD_B, 256, 16 * kk + 8 * h, 16 * kk + 8 * h + 4, 4 * nb + 2 * lb2, qq, pp);
            acc = MFMA32(af, bf, acc); }
        bf16_t* st = A.states + ((size_t)((b * NCH + c) * 8 + grp * 4 + hh) * 64) * 128;
#pragma unroll
        for (int r = 0; r < 16; ++r) st[(32 * pb + AT_CROW(r, h)) * 128 + 32 * nb + ql] = f2bf(acc[r]);
    }
}
__device__ __forceinline__ void ssd_b_item(LAS unsigned char* lds, const SsdArgs& A, int item) {
    const int tid = tid_fresh(), wid = __builtin_amdgcn_readfirstlane(tid >> 6), lane = tid & 63;
    const int grp = item & 1, b = (item >> 1) & 7, c = 15 - (item >> 4);
    const int ql = lane & 31, h = lane >> 5, qq = (lane & 15) >> 2, pp = lane & 3, lb2 = (lane >> 4) & 1;
    const int pb = wid >> 2, lb = wid & 3;
    LAS float* acs = (LAS float*)(lds + SD_ACS); LAS float* dtl = (LAS float*)(lds + SD_DT); LAS float* wp = (LAS float*)(lds + SD_WP);
    __syncthreads();
    ssd_dt_acs(lds, A, b, c, grp, wid, lane);
    if (tid >= 256 && tid < 320) { const int hh = (tid - 256) >> 4, cp = tid & 15; float s = 0.f;
        float al[16];
#pragma unroll
        for (int c2 = 0; c2 < 16; ++c2) al[c2] = A.alast[(b * 8 + grp * 4 + hh) * NCH + c2];
#pragma unroll
        for (int c2 = 0; c2 < 16; ++c2) s += (c2 > cp && c2 < c) ? al[c2] : 0.f;
        wp[hh * 16 + cp] = (cp < c) ? __expf(s) : 0.f; }
    ssd_conv<false>(lds, A, b, c, grp, wid, lane);
    __syncthreads();
#pragma unroll 1
    for (int hh = 0; hh < 4; ++hh) {
        const int hd = grp * 4 + hh;
        { float pv[16];
#pragma unroll
          for (int j = 0; j < 16; ++j) pv[j] = 0.f;
          const int p = tid >> 3, n0 = (tid & 7) * 16;
          const bf16_t* sp0 = A.states + ((size_t)((b * NCH) * 8 + hd) * 64 + p) * 128 + n0;
#pragma unroll
          for (int g8 = 0; g8 < 2; ++g8) {
              if (g8 * 8 < c) { bf16x8 s0[8], s1[8];
#pragma unroll
                  for (int u = 0; u < 8; ++u) { const bf16_t* sp = sp0 + (size_t)(g8 * 8 + u) * (8 * 64 * 128); s0[u] = *(const bf16x8*)sp; s1[u] = *(const bf16x8*)(sp + 8); }
#pragma unroll
                  for (int u = 0; u < 8; ++u) { const float wgt = wp[hh * 16 + g8 * 8 + u];
#pragma unroll
                      for (int j = 0; j < 8; ++j) { pv[j] += wgt * bf2f((bf16_t)s0[u][j]); pv[8 + j] += wgt * bf2f((bf16_t)s1[u][j]); } } } }
          LAS unsigned char* pbuf = lds + SD_PREV + p * 256;
          *(LAS u32x4*)(pbuf + ((((n0 >> 3)) ^ (p & 15)) << 4)) = (u32x4){pk2(pv[0], pv[1]), pk2(pv[2], pv[3]), pk2(pv[4], pv[5]), pk2(pv[6], pv[7])};
          *(LAS u32x4*)(pbuf + ((((n0 >> 3) + 1) ^ (p & 15)) << 4)) = (u32x4){pk2(pv[8], pv[9]), pk2(pv[10], pv[11]), pk2(pv[12], pv[13]), pk2(pv[14], pv[15])}; }
        __syncthreads();
        f32x16 acc;
#pragma unroll
        for (int r = 0; r < 16; ++r) acc[r] = 0.f;
#pragma unroll
        for (int kk = 0; kk < 8; ++kk) {
            const bf16x8 af = *(const LAS bf16x8*)(lds + SD_PREV + (32 * pb + ql) * 256 + (((2 * kk + h) ^ (ql & 15)) << 4));
            const bf16x8 bf = *(const LAS bf16x8*)(lds + SD_C + (32 * lb + ql) * 256 + (((2 * kk + h) ^ (ql & 15)) << 4));
            acc = MFMA32(af, bf, acc); }
        const float al = acs[hh * 128 + 32 * lb + ql];
        { const float e = __expf(al);
#pragma unroll
          for (int r = 0; r < 16; ++r) acc[r] *= e; }
        const float Dh = A.d_skip[hd];
#pragma unroll
        for (int sb = 0; sb < 4; ++sb) {
            if (sb <= lb) {
                f32x16 Pm;
#pragma unroll
                for (int r = 0; r < 16; ++r) Pm[r] = 0.f;
#pragma unroll
                for (int kk = 0; kk < 8; ++kk) {
                    const bf16x8 gf = *(const LAS bf16x8*)(lds + SD_B + (32 * sb + ql) * 256 + (((2 * kk + h) ^ (ql & 15)) << 4));
                    const bf16x8 cf = *(const LAS bf16x8*)(lds + SD_C + (32 * lb + ql) * 256 + (((2 * kk + h) ^ (ql & 15)) << 4));
                    Pm = MFMA32(gf, cf, Pm); }
#pragma unroll
                for (int r = 0; r < 16; ++r) { const int sl = 32 * sb + AT_CROW(r, h), ll = 32 * lb + ql;
                    const float as = acs[hh * 128 + sl], ds = dtl[hh * 128 + sl];
                    float v = Pm[r] * __expf(al - as) * ds; v = (sl <= ll) ? v : 0.f; v += (sl == ll) ? Dh : 0.f; Pm[r] = v; }
#pragma unroll
                for (int sp = 0; sp < 2; ++sp) { const bf16x8 pf = AT_PACK8(Pm, sp);
                    const bf16x8 af = tr_frag2(lds + SD_XS, 512, 32 * sb + 16 * sp + 4 * h, 32 * sb + 16 * sp + 8 + 4 * h, hh * 8 + 4 * pb + 2 * lb2, qq, pp);
                    acc = MFMA32(af, pf, acc); } }
        }
        { const bf16_t* zp = A.projb + ((size_t)b * S + c * 128 + 32 * lb + ql) * PROJ_LD + Z_OFF + hd * 64 + 32 * pb + 4 * h;
#pragma unroll
          for (int qd = 0; qd < 4; ++qd) { const u32x2 zz = *(const u32x2*)(zp + 8 * qd);
              const float z0 = __uint_as_float(zz.x << 16), z1 = __uint_as_float(zz.x & 0xffff0000u), z2 = __uint_as_float(zz.y << 16), z3 = __uint_as_float(zz.y & 0xffff0000u);
              acc[4 * qd] *= z0 / (1.f + __expf(-z0)); acc[4 * qd + 1] *= z1 / (1.f + __expf(-z1)); acc[4 * qd + 2] *= z2 / (1.f + __expf(-z2)); acc[4 * qd + 3] *= z3 / (1.f + __expf(-z3)); } }
        __syncthreads();
#pragma unroll
        for (int qd = 0; qd < 4; ++qd) { const int row = 32 * lb + ql, chn = hh * 8 + 4 * pb + qd;
            *(LAS u32x2*)(lds + SD_XS + row * 512 + ((chn ^ ((row & 3) << 2)) << 4) + 8 * h) = (u32x2){pk2(acc[4 * qd], acc[4 * qd + 1]), pk2(acc[4 * qd + 2], acc[4 * qd + 3])}; }
    }
    __syncthreads();
    int widn = wid; asm volatile("" : "+s"(widn));
#pragma unroll 1
    for (int i0 = 0; i0 < 16; i0 += 8) { u32x2 v[8]; float sq[8]; const int chn = lane >> 1;
#pragma unroll
        for (int i = 0; i < 8; ++i) { const int row = widn + 8 * (i0 + i);
            v[i] = *(const LAS u32x2*)(lds + SD_XS + row * 512 + ((chn ^ ((row & 3) << 2)) << 4) + 8 * (lane & 1));
            const float f0 = __uint_as_float(v[i].x << 16), f1 = __uint_as_float(v[i].x & 0xffff0000u), f2 = __uint_as_float(v[i].y << 16), f3 = __uint_as_float(v[i].y & 0xffff0000u);
            sq[i] = (f0 * f0 + f1 * f1) + (f2 * f2 + f3 * f3); }
#pragma unroll
        for (int o = 1; o < 64; o <<= 1) {
#pragma unroll
            for (int i = 0; i < 8; ++i) sq[i] += __shfl_xor(sq[i], o); }
#pragma unroll
        for (int i = 0; i < 8; ++i) { const int row = widn + 8 * (i0 + i); const float rs = rsqrtf(sq[i] * (1.f / 256.f) + 1e-6f);
            const float f0 = __uint_as_float(v[i].x << 16), f1 = __uint_as_float(v[i].x & 0xffff0000u), f2 = __uint_as_float(v[i].y << 16), f3 = __uint_as_float(v[i].y & 0xffff0000u);
            *(u32x2*)(A.catb + ((size_t)b * S + c * 128 + row) * 1024 + 512 + grp * 256 + lane * 4) = (u32x2){pk2(f0 * rs, f1 * rs), pk2(f2 * rs, f3 * rs)}; } }
}
}
namespace mk {
__device__ __forceinline__ void rms_row_bf16(const float* xr, bf16_t* o, int lane) {
    f32x4 v[4]; float s = 0.f;
#pragma unroll
    for (int j = 0; j < 4; ++j) { v[j] = *(const f32x4*)(xr + lane * 4 + 256 * j); s += (v[j][0] * v[j][0] + v[j][1] * v[j][1]) + (v[j][2] * v[j][2] + v[j][3] * v[j][3]); }
    s = wsum(s); const float rs = rsqrtf(s * (1.f / 1024.f) + 1e-6f);
#pragma unroll
    for (int j = 0; j < 4; ++j) *(u32x2*)(o + lane * 4 + 256 * j) = (u32x2){pk2(v[j][0] * rs, v[j][1] * rs), pk2(v[j][2] * rs, v[j][3] * rs)};
}
constexpr int WT_PITCH = 68, WT_TILE_BYTES = 64 * WT_PITCH * 4;
template <bool OUT8>
__device__ __forceinline__ void wt_tile(bool dry, const float* W, void* WTv, const float* gk1, const float* gk2, int ksplit, int K, int N, int NP, int mode, int nscale, float sc, int ntn, int ntk,
                                        int tile, LAS float* tl, int lane) {
    const int per = ntn * ntk, z = tile / per, rem = tile % per, n0 = (rem % ntn) * 64;
    const float* Wz = W + (size_t)z * K * N;
  for (int sub = 0; sub < (OUT8 ? 2 : 1); ++sub) {
    const int k0 = ((rem / ntn) * (OUT8 ? 2 : 1) + sub) * 64;
    const int lr = lane >> 4, lc = (lane & 15) * 4;
    f32x4 v[16];
#pragma unroll
    for (int i = 0; i < 16; ++i) { const int k = k0 + 4 * i + lr, n = n0 + lc; v[i] = (n < N) ? *(const f32x4*)(Wz + (size_t)k * N + n) : (f32x4){0.f, 0.f, 0.f, 0.f}; }
    if (gk1) {
#pragma unroll
        for (int i = 0; i < 16; ++i) { const int k = k0 + 4 * i + lr; const float g = (k < ksplit) ? gk1[k] : gk2[k - ksplit]; v[i] = v[i] * g; } }
#pragma unroll
    for (int i = 0; i < 16; ++i) { const int kk = 4 * i + lr; const int sw = OUT8 ? (((kk >> 4) & 3) << 3) : (((kk >> 3) & 7) << 2); *(LAS f32x4*)(tl + kk * WT_PITCH + (lc ^ sw)) = v[i]; }
    asm volatile("s_waitcnt lgkmcnt(0)" ::: "memory");
    if constexpr (OUT8) {
        const int kq = lane & 3; f8_t* WTz = (f8_t*)WTv + (size_t)z * NP * K;
#pragma unroll
        for (int it = 0; it < 4; ++it) { const int nl = 16 * it + (lane >> 2), n = n0 + nl; const float s = (n < nscale) ? sc : 1.f;
            int nm = n; if (mode == 1) { const int up = n >> 10, jj = n & 1023; nm = (jj >> 7) * 256 + up * 128 + (jj & 127); }
            const LAS float* src = tl + (16 * kq) * WT_PITCH + (nl ^ (kq << 3));
            u32x4 w;
            w.x = pk4_fp8(src[0] * s, src[WT_PITCH] * s, src[2 * WT_PITCH] * s, src[3 * WT_PITCH] * s); w.y = pk4_fp8(src[4 * WT_PITCH] * s, src[5 * WT_PITCH] * s, src[6 * WT_PITCH] * s, src[7 * WT_PITCH] * s);
            w.z = pk4_fp8(src[8 * WT_PITCH] * s, src[9 * WT_PITCH] * s, src[10 * WT_PITCH] * s, src[11 * WT_PITCH] * s); w.w = pk4_fp8(src[12 * WT_PITCH] * s, src[13 * WT_PITCH] * s, src[14 * WT_PITCH] * s, src[15 * WT_PITCH] * s);
            if (dry) { asm volatile("" :: "v"(w)); continue; }
            *(u32x4*)(WTz + (size_t)nm * K + k0 + 16 * kq) = w; }
    } else {
        const int kq = lane & 7; bf16_t* WTz = (bf16_t*)WTv + (size_t)z * NP * K;
#pragma unroll
        for (int it = 0; it < 8; ++it) { const int nl = 8 * it + (lane >> 3), n = n0 + nl; const float s = (n < nscale) ? sc : 1.f;
            int nm = n; if (mode == 1) { const int up = n >> 10, jj = n & 1023; nm = (jj >> 7) * 256 + up * 128 + (jj & 127); }
            const LAS float* src = tl + (8 * kq) * WT_PITCH + (nl ^ (kq << 2));
            u32x4 w; w.x = pk2(src[0] * s, src[WT_PITCH] * s); w.y = pk2(src[2 * WT_PITCH] * s, src[3 * WT_PITCH] * s); w.z = pk2(src[4 * WT_PITCH] * s, src[5 * WT_PITCH] * s); w.w = pk2(src[6 * WT_PITCH] * s, src[7 * WT_PITCH] * s);
            *(u32x4*)(WTz + (size_t)nm * K + k0 + 8 * kq) = w; }
    }
    asm volatile("s_waitcnt lgkmcnt(0)" ::: "memory");
  }
}
constexpr int CP_KX = 0  , CP_RED = 69632  , CP_HID = CP_RED + 32768  , CP_END = CP_HID + 8192 + 256;
struct CmpArgs { const bf16_t* projb; const bf16_t* w1T; const float* posb; const float* w2; bf16_t* kc; bf16_t* vc; };
__device__ __forceinline__ void cmp_item(LAS unsigned char* lds, const CmpArgs& A, int item) {
    const int tid = tid_fresh(), wid = __builtin_amdgcn_readfirstlane(tid >> 6), lane = tid & 63, ql = lane & 31, h = lane >> 5;
    const int cblk = item & 3, kvh = (item >> 2) & 1, b = (item >> 3) & 7, j = item >> 6;
    __syncthreads();
    { const int tok0 = 512 * cblk; const bf16_t* src = A.projb + ((size_t)b * S + tok0) * PROJ_LD + 512 + j * 128 + kvh * 64;
      for (int i = tid; i < 528 * 8; i += 512) { const int r = i >> 3, ch = i & 7; u32x4 v = (u32x4){0u, 0u, 0u, 0u};
          if (tok0 + r < S) v = *(const u32x4*)(src + (size_t)r * PROJ_LD + ch * 8);
          *(LAS u32x4*)(lds + CP_KX + r * 128 + ((ch ^ ((r >> 4) & 7)) << 4)) = v; } }
    if (tid < 64) { float a = 0.f;
#pragma unroll 16
        for (int sl = 0; sl < 64; ++sl) a += A.posb[(j * 64 + sl) * 64 + tid];
        ((LAS float*)(lds + CP_HID))[2048 + tid] = a; }
    __syncthreads();
    const int nb = wid & 1, kq = wid >> 1;
    f32x16 acc;
#pragma unroll
    for (int r = 0; r < 16; ++r) acc[r] = 0.f;
    const bf16_t* wrow = A.w1T + ((size_t)j * 64 + 32 * nb + ql) * 2048;
#pragma unroll 2
    for (int li = 0; li < 8; ++li) { const int l = 8 * kq + li;
#pragma unroll
        for (int s = 0; s < 4; ++s) {
            const int row = 16 * ql + l;
            const bf16x8 af = *(const LAS bf16x8*)(lds + CP_KX + row * 128 + (((2 * s + h) ^ ((row >> 4) & 7)) << 4));
            const bf16x8 bf = *(const bf16x8*)(wrow + l * 64 + 16 * s + 8 * h);
            acc = MFMA32(af, bf, acc); } }
    { LAS float* red = (LAS float*)(lds + CP_RED) + kq * 2048;
#pragma unroll
      for (int r = 0; r < 16; ++r) red[AT_CROW(r, h) * 64 + 32 * nb + ql] = acc[r]; }
    __syncthreads();
    { LAS float* red = (LAS float*)(lds + CP_RED); LAS float* hid = (LAS float*)(lds + CP_HID);
      for (int i = tid; i < 2048; i += 512) { const float a = (red[i] + red[2048 + i]) + (red[4096 + i] + red[6144 + i]) + hid[2048 + (i & 63)]; hid[i] = a / (1.f + __expf(-a)); } }
    __syncthreads();
    { const LAS float* hid = (const LAS float*)(lds + CP_HID); bf16_t* out = (j ? A.vc : A.kc) + (size_t)(b * 2 + kvh) * 128 * 64;
      for (int i = tid; i < 2048; i += 512) { const int cl = i >> 6, n2 = i & 63; float a = 0.f;
#pragma unroll 8
          for (int n = 0; n < 64; ++n) a += hid[cl * 64 + n] * A.w2[(j * 64 + n) * 64 + n2];
          const int c = 32 * cblk + cl; out[c * 64 + n2] = (c < 127) ? f2bf(a) : (bf16_t)0; } }
}
constexpr int RT_RW = 0;
struct RouteArgs { const bf16_t* h1; const float* ffn_norm; const float* router_w; const float* router_b; f8_t* hn8; int* cnt; int* list; float* wlist; int* tinfo; };
__device__ __forceinline__ void route_phase(LAS unsigned char* lds, const RouteArgs& A, int wg, int nwg) {
    const int tid = tid_fresh(), wid = __builtin_amdgcn_readfirstlane(tid >> 6), lane = tid & 63;
    LAS float* rw = (LAS float*)(lds + RT_RW);
    LAS float* lgt = (LAS float*)(lds + 131072);
    LAS int* lcnt = (LAS int*)(lds + 131072 + 16128); LAS int* gbase = lcnt + 32;
    __syncthreads();
    { f32x4 t4[16];
#pragma unroll
      for (int i = 0; i < 16; ++i) t4[i] = *(const f32x4*)(A.router_w + (size_t)(tid + 512 * i) * 4);
#pragma unroll
      for (int i = 0; i < 16; ++i) { const int q = tid + 512 * i, k = q >> 3, e0 = (q & 7) * 4; const float g = A.ffn_norm[k];
          rw[(e0 + 0) * 1024 + k] = t4[i][0] * g; rw[(e0 + 1) * 1024 + k] = t4[i][1] * g; rw[(e0 + 2) * 1024 + k] = t4[i][2] * g; rw[(e0 + 3) * 1024 + k] = t4[i][3] * g; } }
    if (tid < 32) lcnt[tid] = 0;
    __syncthreads();
    const int ex = ((lane >> 5) & 1) * 16 + ((lane >> 4) & 1) * 8 + ((lane >> 3) & 1) * 4 + ((lane >> 2) & 1) * 2 + ((lane >> 1) & 1);
    const float rbias = A.router_b[ex];
    int it = 0;
    for (int t0 = wg * 8 + wid; t0 < T; t0 += 2 * nwg * 8, it += 2) {
        const int t1 = t0 + nwg * 8; const bool has1 = t1 < T;
        f32x4 va[4], vb[4]; float sa = 0.f, sb = 0.f;
#pragma unroll
        for (int j = 0; j < 4; ++j) { const u32x2 ua = *(const u32x2*)(A.h1 + (size_t)t0 * D + lane * 4 + 256 * j); const u32x2 ub = has1 ? *(const u32x2*)(A.h1 + (size_t)t1 * D + lane * 4 + 256 * j) : (u32x2){0u, 0u};
            va[j] = (f32x4){__uint_as_float(ua.x << 16), __uint_as_float(ua.x & 0xffff0000u), __uint_as_float(ua.y << 16), __uint_as_float(ua.y & 0xffff0000u)};
            vb[j] = (f32x4){__uint_as_float(ub.x << 16), __uint_as_float(ub.x & 0xffff0000u), __uint_as_float(ub.y << 16), __uint_as_float(ub.y & 0xffff0000u)};
            sa += (va[j][0] * va[j][0] + va[j][1] * va[j][1]) + (va[j][2] * va[j][2] + va[j][3] * va[j][3]); sb += (vb[j][0] * vb[j][0] + vb[j][1] * vb[j][1]) + (vb[j][2] * vb[j][2] + vb[j][3] * vb[j][3]); }
#pragma unroll
        for (int o = 1; o < 64; o <<= 1) { sa += __shfl_xor(sa, o); sb += __shfl_xor(sb, o); }
        const float ra = rsqrtf(sa * (1.f / 1024.f) + 1e-6f), rb = rsqrtf(sb * (1.f / 1024.f) + 1e-6f);
#pragma unroll
        for (int j = 0; j < 4; ++j) { va[j] = va[j] * ra; vb[j] = vb[j] * rb; *(unsigned*)(A.hn8 + (size_t)t0 * D + lane * 4 + 256 * j) = pk4_fp8(va[j][0], va[j][1], va[j][2], va[j][3]);
            if (has1) *(unsigned*)(A.hn8 + (size_t)t1 * D + lane * 4 + 256 * j) = pk4_fp8(vb[j][0], vb[j][1], vb[j][2], vb[j][3]); }
        float pa[32], pb[32];
#pragma unroll
        for (int e = 0; e < 32; ++e) { pa[e] = 0.f; pb[e] = 0.f; }
#pragma unroll
        for (int e = 0; e < 32; ++e) {
#pragma unroll
            for (int j = 0; j < 4; ++j) { const f32x4 w4 = *(const LAS f32x4*)(rw + e * 1024 + lane * 4 + 256 * j);
                pa[e] += (va[j][0] * w4[0] + va[j][1] * w4[1]) + (va[j][2] * w4[2] + va[j][3] * w4[3]); pb[e] += (vb[j][0] * w4[0] + vb[j][1] * w4[1]) + (vb[j][2] * w4[2] + vb[j][3] * w4[3]); }
            if ((e & 3) == 3) __builtin_amdgcn_sched_barrier(0); }
        float r16a[16], r16b[16];
#pragma unroll
        for (int e = 0; e < 16; ++e) { const bool up = (lane & 32) != 0; r16a[e] = (up ? pa[16 + e] : pa[e]) + __shfl_xor(up ? pa[e] : pa[16 + e], 32); r16b[e] = (up ? pb[16 + e] : pb[e]) + __shfl_xor(up ? pb[e] : pb[16 + e], 32); }
        float r8a[8], r8b[8];
#pragma unroll
        for (int e = 0; e < 8; ++e) { const bool up = (lane & 16) != 0; r8a[e] = (up ? r16a[8 + e] : r16a[e]) + __shfl_xor(up ? r16a[e] : r16a[8 + e], 16); r8b[e] = (up ? r16b[8 + e] : r16b[e]) + __shfl_xor(up ? r16b[e] : r16b[8 + e], 16); }
        float r4a[4], r4b[4];
#pragma unroll
        for (int e = 0; e < 4; ++e) { const bool up = (lane & 8) != 0; r4a[e] = (up ? r8a[4 + e] : r8a[e]) + __shfl_xor(up ? r8a[e] : r8a[4 + e], 8); r4b[e] = (up ? r8b[4 + e] : r8b[e]) + __shfl_xor(up ? r8b[e] : r8b[4 + e], 8); }
        float r2a[2], r2b[2];
#pragma unroll
        for (int e = 0; e < 2; ++e) { const bool up = (lane & 4) != 0; r2a[e] = (up ? r4a[2 + e] : r4a[e]) + __shfl_xor(up ? r4a[e] : r4a[2 + e], 4); r2b[e] = (up ? r4b[2 + e] : r4b[e]) + __shfl_xor(up ? r4b[e] : r4b[2 + e], 4); }
        float r1a, r1b; { const bool up = (lane & 2) != 0; r1a = (up ? r2a[1] : r2a[0]) + __shfl_xor(up ? r2a[0] : r2a[1], 2); r1b = (up ? r2b[1] : r2b[0]) + __shfl_xor(up ? r2b[0] : r2b[1], 2); }
        r1a += __shfl_xor(r1a, 1); r1b += __shfl_xor(r1b, 1);
        if ((lane & 1) == 0) { const int l0 = it * 8 + wid; if (l0 < 112) lgt[l0 * 36 + ex] = r1a + rbias; if (has1 && l0 + 8 < 112) lgt[(l0 + 8) * 36 + ex] = r1b + rbias; }
    }
    __syncthreads();
    const int ntl = (T - wg * 8 + nwg * 8 - 1) / (nwg * 8) * 8;
    int te[4] = {0, 0, 0, 0}, lp[4] = {0, 0, 0, 0}; float tw[4] = {0.f, 0.f, 0.f, 0.f};
    const int tmine = wg * 8 + (tid & 7) + (tid >> 3) * nwg * 8; const bool mine = tid < 112 && tid < ntl && tmine < T;
    if (mine) { float v[32];
#pragma unroll
        for (int e4 = 0; e4 < 8; ++e4) { const f32x4 q4 = *(const LAS f32x4*)(lgt + tid * 36 + e4 * 4); v[e4 * 4] = q4[0]; v[e4 * 4 + 1] = q4[1]; v[e4 * 4 + 2] = q4[2]; v[e4 * 4 + 3] = q4[3]; }
        float tv[4];
#pragma unroll
        for (int k = 0; k < 4; ++k) { float best = -INFINITY; int bi = 0;
#pragma unroll
            for (int e = 0; e < 32; ++e) { const bool bt = v[e] > best; best = bt ? v[e] : best; bi = bt ? e : bi; }
#pragma unroll
            for (int e = 0; e < 32; ++e) v[e] = (e == bi) ? -INFINITY : v[e];
            tv[k] = best; te[k] = bi; }
        const float e1 = __expf(tv[1] - tv[0]), e2 = __expf(tv[2] - tv[0]), e3 = __expf(tv[3] - tv[0]); const float inv = 1.f / (1.f + e1 + e2 + e3);
        tw[0] = inv; tw[1] = e1 * inv; tw[2] = e2 * inv; tw[3] = e3 * inv;
#pragma unroll
        for (int k = 0; k < 4; ++k) lp[k] = __hip_atomic_fetch_add(lcnt + te[k], 1, __ATOMIC_RELAXED, __HIP_MEMORY_SCOPE_WORKGROUP); }
    __syncthreads();
    if (tid < 32) gbase[tid] = (int)__hip_atomic_fetch_add((unsigned*)A.cnt + tid, (unsigned)lcnt[tid], __ATOMIC_RELAXED, __HIP_MEMORY_SCOPE_AGENT);
    __syncthreads();
    if (mine) {
#pragma unroll
        for (int k = 0; k < 4; ++k) { const int e = te[k], pos = gbase[e] + lp[k], tk = tmine * 4 + k;
            A.list[(size_t)e * T + pos] = tk; A.wlist[tk] = tw[k]; A.tinfo[tk] = e | (pos << 8); } }
}
struct CombArgs { const bf16_t* h1; const f8_t* y; const int* tinfo; const float* tw; const int* cnt; const float* g; float* out; };
__device__ __forceinline__ void combine_phase(LAS unsigned char* lds, const CombArgs& A, int wg, int nwg) {
    const int tid = tid_fresh(), wid = __builtin_amdgcn_readfirstlane(tid >> 6), lane = tid & 63;
    LAS int* toff = (LAS int*)(lds + LDS_MISC + 64);
    __syncthreads();
    if (tid == 0) { int a = 0; for (int e = 0; e < NE; ++e) { toff[e] = a; a += (A.cnt[e] + 255) >> 8; } }
    __syncthreads();
    f32x4 gv[4];
#pragma unroll
    for (int j = 0; j < 4; ++j) gv[j] = *(const f32x4*)(A.g + lane * 4 + 256 * j);
    for (int t = wg * 8 + wid; t < T; t += nwg * 8) {
        size_t so[4]; float tw[4];
#pragma unroll
        for (int k = 0; k < 4; ++k) { const int inf = A.tinfo[t * 4 + k]; so[k] = ((size_t)toff[inf & 255] * 256 + (inf >> 8)) * 1024; tw[k] = A.tw[t * 4 + k]; }
        f32x4 v[4]; float s = 0.f;
#pragma unroll
        for (int j = 0; j < 4; ++j) { { const u32x2 uh = *(const u32x2*)(A.h1 + (size_t)t * D + lane * 4 + 256 * j); v[j] = (f32x4){__uint_as_float(uh.x << 16), __uint_as_float(uh.x & 0xffff0000u), __uint_as_float(uh.y << 16), __uint_as_float(uh.y & 0xffff0000u)}; }
#pragma unroll
            for (int k = 0; k < 4; ++k) { const unsigned yy = *(const unsigned*)(A.y + so[k] + lane * 4 + 256 * j);
                const f2_t lo = __builtin_amdgcn_cvt_pk_f32_fp8((int)yy, false), hi = __builtin_amdgcn_cvt_pk_f32_fp8((int)yy, true);
                v[j][0] += tw[k] * lo[0]; v[j][1] += tw[k] * lo[1]; v[j][2] += tw[k] * hi[0]; v[j][3] += tw[k] * hi[1]; }
            s += (v[j][0] * v[j][0] + v[j][1] * v[j][1]) + (v[j][2] * v[j][2] + v[j][3] * v[j][3]); }
        s = wsum(s); const float rs = rsqrtf(s * (1.f / 1024.f) + 1e-6f);
#pragma unroll
        for (int j = 0; j < 4; ++j) *(f32x4*)(A.out + (size_t)t * D + lane * 4 + 256 * j) = v[j] * rs * gv[j];
    }
}
}
#define XB_TMO      128
#define XB_XCNT(j)  (256  + 64 * (j))
#define XB_XSUB(j)  (1280 + 64 * (j))
#define XB_XGEN(j)  (2304 + 64 * (j))
#define XB_TOP      3328
#define XB_TOPGEN   3392
#define XCD_BAR_WORDS 3456
#define XB_SPIN_CAP (1u << 18)
__device__ __forceinline__ unsigned xb_ld(unsigned* p)              { return __hip_atomic_load(p, __ATOMIC_RELAXED, __HIP_MEMORY_SCOPE_AGENT); }
__device__ __forceinline__ unsigned xb_add(unsigned* p, unsigned v) { return __hip_atomic_fetch_add(p, v, __ATOMIC_RELAXED, __HIP_MEMORY_SCOPE_AGENT); }
__device__ __forceinline__ unsigned xb_xcc_id() { return (unsigned)__builtin_amdgcn_s_getreg((3 << 11) | 20) & 0xFu; }
#define XB_SPIN(cond, bar) do { unsigned _sp = 0; while (cond) { __builtin_amdgcn_s_sleep(1); \
    if ((++_sp & 255u) == 0u) { if (xb_ld(&(bar)[XB_TMO])) break; if (_sp > XB_SPIN_CAP) { atomicAdd(&(bar)[XB_TMO], 1u); break; } } } } while (0)
struct XcdBarrier { unsigned* bar; unsigned x; volatile LAS unsigned* st; };
__device__ __forceinline__ XcdBarrier xcd_barrier_post(unsigned* bar, volatile LAS unsigned* st) {
    XcdBarrier b; b.bar = bar; b.x = xb_xcc_id(); b.st = st;
    if (threadIdx.x == 0) (void)xb_add(&bar[XB_XCNT(b.x)], 1u);
    return b;
}
__device__ __forceinline__ void xcd_barrier_complete(unsigned* bar, unsigned x, unsigned& nloc, unsigned& nx) {
    const unsigned G = gridDim.x * gridDim.y * gridDim.z;
    unsigned sum, cnt, mine, sp = 0u;
    for (;;) {
        sum = 0u; cnt = 0u; mine = 0u;
#pragma unroll
        for (unsigned j = 0; j < 16; ++j) { const unsigned c = xb_ld(&bar[XB_XCNT(j)]); sum += c; cnt += (c > 0u) ? 1u : 0u; mine = (j == x) ? c : mine; }
        if (sum == G) break;
        __builtin_amdgcn_s_sleep(1);
        if ((++sp & 255u) == 0u) { if (xb_ld(&bar[XB_TMO])) break; if (sp > XB_SPIN_CAP) { atomicAdd(&bar[XB_TMO], 1u); break; } }
    }
    nloc = mine > 0u ? mine : 1u; nx = cnt > 0u ? cnt : 1u;
}
__device__ __forceinline__ void xcd_barrier(const XcdBarrier& b) {
    asm volatile("s_waitcnt vmcnt(0)" ::: "memory");
    __syncthreads();
    if (threadIdx.x == 0) {
        unsigned* bar = b.bar;
        __builtin_amdgcn_s_waitcnt(0);
        unsigned nloc = b.st[0], nx = b.st[1];
        if (nloc == 0u) { xcd_barrier_complete(bar, b.x, nloc, nx); b.st[0] = nloc; b.st[1] = nx; }
        const unsigned old = xb_add(&bar[XB_XSUB(b.x)], 1u);
        const unsigned gen = old / nloc;
        if (old + 1u == (gen + 1u) * nloc) {
            __builtin_amdgcn_fence(__ATOMIC_RELEASE, "agent");
            asm volatile("s_waitcnt vmcnt(0)" ::: "memory");
            const unsigned og = xb_add(&bar[XB_TOP], 1u);
            const unsigned tg = og / nx;
            if (og + 1u == (tg + 1u) * nx) xb_add(&bar[XB_TOPGEN], 1u);
            else XB_SPIN(xb_ld(&bar[XB_TOPGEN]) == tg, bar);
            __builtin_amdgcn_fence(__ATOMIC_ACQUIRE, "agent");
            xb_add(&bar[XB_XGEN(b.x)], 1u);
            asm volatile("s_waitcnt vmcnt(0)" ::: "memory");
        } else {
            XB_SPIN(xb_ld(&bar[XB_XGEN(b.x)]) == gen, bar);
            __builtin_amdgcn_fence(__ATOMIC_ACQUIRE, "agent");
            asm volatile("s_waitcnt vmcnt(0)" ::: "memory");
        }
    }
    __syncthreads();
}

namespace mk {
constexpr int LDS_BAR = 159744, LDS_FUSED = LDS_BAR + 256;
constexpr int CTL_QUEUE = 4096;
struct Params {
    const float *x, *attn_norm, *w_in, *rel_bias, *cmp_pos, *cmp_w1, *cmp_w2, *attn_out_norm, *conv_w, *conv_b, *dt_bias, *a_log, *d_skip, *ssm_out_norm, *w_out, *ffn_norm,
                *router_w, *router_b, *w_gu, *b_gu, *w_dn, *b_dn, *final_norm;
    float* out; unsigned* ctl; int* cnt;
    bf16_t *xb, *WinT, *WoutT, *w1T, *projb, *catb, *kc, *vc, *states; f8_t *WguT, *WdnT, *hn8, *act, *ymoe;
    float *posb, *alast, *wlist, *ssq; bf16_t* h1; int *list, *tinfo;
    int ph_lo, ph_hi;
};
constexpr int NT_WIN = 48 * 16, NT_WOUT = 16 * 16, NT_WGU = 32 * 32 * 8, NT_WDN = 32 * 16 * 8, NT_W1 = 2 * 32, NT_ALL = NT_WIN + NT_WOUT + NT_WGU + NT_WDN + NT_W1;
__device__ __forceinline__ void p0_prologue(LAS unsigned char* lds, const Params& p, int wg, int nwg, bool dry = false) {
    const int tid = tid_fresh(), wid = __builtin_amdgcn_readfirstlane(tid >> 6), lane = tid & 63;
    for (int r = wg * 8 + wid; r < T; r += nwg * 8) rms_row_bf16(p.x + (size_t)r * D, p.xb + (size_t)r * D, lane);
    for (int o = wg * 8 + wid; o < 128; o += nwg * 8) { const int j = o >> 6, sl = o & 63; float s = 0.f;
#pragma unroll
        for (int kk = 0; kk < 32; ++kk) { const int k = sl * 32 + kk; s += p.cmp_pos[j * 2048 + k] * p.cmp_w1[((size_t)j * 2048 + k) * 64 + lane]; }
        p.posb[o * 64 + lane] = s; }
    LAS float* tl = (LAS float*)(lds + wid * WT_TILE_BYTES);
    __syncthreads();
    for (int task = wg * 8 + wid; task < NT_ALL; task += nwg * 8) { int idx = task;
        if (idx < NT_WIN) { wt_tile<false>(dry, p.w_in, p.WinT, p.attn_norm, p.attn_norm, 1024, 1024, 2848, 3072, 0, 512, 0.125f * LOG2E, 48, 16, idx, tl, lane); continue; } idx -= NT_WIN;
        if (idx < NT_WOUT) { wt_tile<false>(dry, p.w_out, p.WoutT, p.attn_out_norm, p.ssm_out_norm, 512, 1024, 1024, 1024, 0, 0, 1.f, 16, 16, idx, tl, lane); continue; } idx -= NT_WOUT;
        if (idx < NT_WGU) { wt_tile<true>(dry, p.w_gu, p.WguT, p.ffn_norm, p.ffn_norm, 1024, 1024, 2048, 2048, 1, 2048, W8_SCALE, 32, 8, idx, tl, lane); continue; } idx -= NT_WGU;
        if (idx < NT_WDN) { wt_tile<true>(dry, p.w_dn, p.WdnT, nullptr, nullptr, 0, 1024, 1024, 1024, 0, 1024, W8_SCALE, 16, 8, idx, tl, lane); continue; } idx -= NT_WDN;
        wt_tile<false>(dry, p.cmp_w1, p.w1T, nullptr, nullptr, 0, 2048, 64, 64, 0, 0, 1.f, 1, 32, idx, tl, lane); }
}
__global__ void __launch_bounds__(512, 2) k_fused(Params p) {
    extern __shared__ __attribute__((aligned(16))) unsigned char dl[];
    LAS unsigned char* lds = (LAS unsigned char*)dl;
    const int wg = blockIdx.x, nwg = gridDim.x; int tid = tid_fresh();
    if (tid < 64) ((LAS unsigned*)(lds + LDS_BAR))[tid] = 0u;
    __syncthreads();
    XcdBarrier bar = xcd_barrier_post(p.ctl, (volatile LAS unsigned*)(lds + LDS_BAR));
#ifdef MK_ONLY
#define PH(k) ((k) == MK_ONLY && p.ph_lo <= (k) && (k) < p.ph_hi)
#else
#define PH(k) (p.ph_lo <= (k) && (k) < p.ph_hi)
#endif
#ifdef MK_REPEAT
#define REP(k) for (int _rep = 0; _rep < ((k) == MK_REPEAT ? 2 : 1); ++_rep)
#else
#define REP(k)
#endif
#ifdef MK_REPEAT
#define QREP _rep
#else
#define QREP 0
#endif
#ifdef MK_BARX2
#define SEAM(k) do { if (PH(k) && PH((k) + 1)) { xcd_barrier(bar); xcd_barrier(bar); } } while (0)
#else
#define SEAM(k) do { if (PH(k) && PH((k) + 1)) xcd_barrier(bar); } while (0)
#endif
    if (PH(0)) { p0_prologue(lds, p, wg, nwg);
#ifdef MK_P0X2
        __syncthreads(); p0_prologue(lds, p, wg, nwg, MK_P0X2 == 2);
#endif
    }
    SEAM(0);
    REP(1) if (PH(1)) { ProbProj P; P.S.init(T, NPROJ, nwg, wg); P.A = p.xb; P.Bt = p.WinT; P.O = p.projb; gemm_phase(lds, P); }
    SEAM(1);
    REP(2) if (PH(2)) {
        const SsdArgs SA{p.projb, p.conv_w, p.conv_b, p.dt_bias, p.a_log, p.d_skip, p.states, p.alast, p.catb};
        const CmpArgs CA{p.projb, p.w1T, p.posb, p.cmp_w2, p.kc, p.vc};
        for (int it = wg; it < 384; it += nwg) { const int v = 383 - it; if (v < 128) cmp_item(lds, CA, v); else ssd_a_item(lds, SA, v - 128); }
    }
    SEAM(2);
    REP(3) if (PH(3)) {
        const SsdArgs SA{p.projb, p.conv_w, p.conv_b, p.dt_bias, p.a_log, p.d_skip, p.states, p.alast, p.catb};
        const AttnArgs AA{p.projb, p.kc, p.vc, p.catb, p.ssq};
        bool btab_ok = false;
        LAS int* qslot = (LAS int*)(lds + LDS_BAR + 64);
        for (;;) {
            __syncthreads();
            if (tid_fresh() == 0) qslot[0] = (int)__hip_atomic_fetch_add(p.ctl + CTL_QUEUE + 64 * QREP, 1u, __ATOMIC_RELAXED, __HIP_MEMORY_SCOPE_AGENT);
            __syncthreads();
            const int it = qslot[0];
#if defined(MK_QX_ATTN)
            if (it >= 768 + 512) break;
            { const int i2 = it >= 768 ? it - 768 : it; if (i2 < 512) { if (!btab_ok) { attn_btab(lds, p.rel_bias); btab_ok = true; } attn_item(lds, AA, i2 & 7, 31 - (i2 >> 4), (i2 >> 3) & 1); } else { ssd_b_item(lds, SA, i2 - 512); btab_ok = false; } }
#elif defined(MK_QX_SSDB)
            if (it >= 768 + 256) break;
            { const int i2 = it >= 768 ? it - 256 : it; if (i2 < 512) attn_item(lds, AA, i2 & 7, 31 - (i2 >> 4), (i2 >> 3) & 1); else ssd_b_item(lds, SA, i2 - 512); }
#else
#if defined(MK_QX_BOTH)
            if (it >= 1536) break;
            { const int i2 = it >= 768 ? it - 768 : it; if (i2 < 512) { if (!btab_ok) { attn_btab(lds, p.rel_bias); btab_ok = true; } attn_item(lds, AA, i2 & 7, 31 - (i2 >> 4), (i2 >> 3) & 1); } else { ssd_b_item(lds, SA, i2 - 512); btab_ok = false; } }
#else
            if (it >= 768) break;
            if (it < 512) { if (!btab_ok) { attn_btab(lds, p.rel_bias); btab_ok = true; } attn_item(lds, AA, it & 7, 31 - (it >> 4), (it >> 3) & 1); } else { ssd_b_item(lds, SA, it - 512); btab_ok = false; }
#endif
#endif
        }
    }
    SEAM(3);
    REP(4) if (PH(4)) { ProbOut P; P.S.init(T, D, nwg, wg); P.A = p.catb; P.Bt = p.WoutT; P.R0 = p.x; P.O = p.h1; P.ssq = p.ssq; gemm_phase(lds, P); }
    SEAM(4);
    REP(5) if (PH(5)) { const bool dm = QREP != 0; const RouteArgs RA{p.h1, p.ffn_norm, p.router_w, p.router_b, p.hn8, dm ? p.cnt + 64 : p.cnt, dm ? (int*)p.act : p.list, dm ? (float*)p.act + (4u << 20) : p.wlist, dm ? (int*)p.act + (8u << 20) : p.tinfo}; route_phase(lds, RA, wg, nwg); }
    SEAM(5);
    REP(6) if (PH(6)) {
        tid = tid_fresh();
        __syncthreads();
        const int RT = moe_tables(lds, p.cnt);
        ProbMoe1 P; P.S.nN = 8; P.S.G = nwg; P.S.c = (nwg % 8 == 0) ? (wg & 7) * (nwg >> 3) + (wg >> 3) : wg; P.S.RT = RT; P.S.tile_e = (const LAS int*)(lds + LDS_TILE_E); P.S.tile_m = (const LAS int*)(lds + LDS_TILE_M);
        P.A = p.hn8; P.Bt = p.WguT; P.btab = (const LAS float*)(lds + LDS_BIASTAB); P.O = p.act; P.rowtab = (const LAS unsigned*)(lds + LDS_ROWTAB);
        LAS unsigned* rowtab = (LAS unsigned*)(lds + LDS_ROWTAB);
#pragma unroll 1
        for (int i = 0; i < 12; ++i) { Unit u; if (!P.S.next(i, u)) break; if (tid < 256) { const int pos = u.mt * 256 + tid; const int c = p.cnt[u.e];
            const int tok = (pos < c) ? (p.list[(size_t)u.e * T + pos] >> 2) : 0; rowtab[i * 256 + tid] = (unsigned)tok * KD; }
            else { const int j = tid - 256; ((LAS float*)(lds + LDS_BIASTAB))[i * 256 + j] = p.b_gu[u.e * 2048 + (j >> 7) * 1024 + u.pn * 128 + (j & 127)]; } }
        __syncthreads();
        gemm_phase(lds, P);
    }
    SEAM(6);
    REP(7) if (PH(7)) {
        __syncthreads();
        const int RT = moe_tables(lds, p.cnt);
        ProbMoe2 P; P.S.nN = 4; P.S.G = nwg; P.S.c = (nwg % 8 == 0) ? (wg & 7) * (nwg >> 3) + (wg >> 3) : wg; P.S.RT = RT; P.S.tile_e = (const LAS int*)(lds + LDS_TILE_E); P.S.tile_m = (const LAS int*)(lds + LDS_TILE_M);
        P.A = p.act; P.Bt = p.WdnT; P.btab = (const LAS float*)(lds + LDS_BIASTAB); P.O = p.ymoe;
#pragma unroll 1
        for (int i = 0; i < 12; ++i) { Unit u; if (!P.S.next(i, u)) break; if (tid_fresh() < 256) ((LAS float*)(lds + LDS_BIASTAB))[i * 256 + tid_fresh()] = p.b_dn[u.e * 1024 + u.pn * 256 + tid_fresh()]; }
        __syncthreads();
        gemm_phase(lds, P);
    }
    SEAM(7);
    REP(8) if (PH(8)) { const CombArgs CA{p.h1, p.ymoe, p.tinfo, p.wlist, p.cnt, p.final_norm, p.out}; combine_phase(lds, CA, wg, nwg); }
#undef PH
#undef SEAM
}
}

extern "C" void kernel_launch(void* const* d_in, const int* in_sizes, int n_in, void* d_out, int out_size, void* d_ws, size_t ws_size, hipStream_t stream) {
    using namespace mk;
    char* ws = (char*)d_ws; const size_t MB = 1u << 20;
    size_t o = 0; auto take = [&](size_t mb) { char* q = ws + o; o += mb * MB; return q; };
    Params p;
    memset(&p, 0, sizeof(p));
    const float** fin = (const float**)&p.x;
    for (int i = 0; i < 23; ++i) fin[i] = (const float*)d_in[i];
    p.out = (float*)d_out;
    p.ctl = (unsigned*)take(1); p.cnt = (int*)(p.ctl + 8192);
    p.xb = (bf16_t*)take(32); p.WinT = (bf16_t*)take(6); p.WoutT = (bf16_t*)take(2); p.WguT = (f8_t*)take(64); p.WdnT = (f8_t*)take(32); p.w1T = (bf16_t*)take(1);
    p.projb = (bf16_t*)take(96); p.catb = (bf16_t*)take(32); p.hn8 = (f8_t*)take(16); p.kc = (bf16_t*)take(1); p.vc = (bf16_t*)take(1); p.states = (bf16_t*)take(16);
    p.act = (f8_t*)take(72); p.ymoe = (f8_t*)take(72);
    p.posb = (float*)take(1); p.alast = (float*)take(1); p.ssq = (float*)take(1); p.h1 = (bf16_t*)take(32); p.wlist = (float*)take(2); p.list = (int*)take(2); p.tinfo = (int*)take(1);
    static int grid = 0;
    if (!grid) {
        int dev = 0, cus = 0, per_cu = 0;
        (void)hipGetDevice(&dev); (void)hipDeviceGetAttribute(&cus, hipDeviceAttributeMultiprocessorCount, dev);
        (void)hipFuncSetAttribute((const void*)k_fused, hipFuncAttributeMaxDynamicSharedMemorySize, LDS_FUSED);
        (void)hipOccupancyMaxActiveBlocksPerMultiprocessor(&per_cu, (const void*)k_fused, 512, LDS_FUSED);
        (void)hipGetLastError();
        grid = cus > 0 ? cus : 256;
    }
    (void)hipMemsetAsync(p.ctl, 0, 65536, stream);
#ifndef MK_SPLIT
    p.ph_lo = 0; p.ph_hi = 9;
    hipLaunchKernelGGL(k_fused, dim3(grid), dim3(512), LDS_FUSED, stream, p);
#else
    for (int k = 0; k < 9; ++k) { p.ph_lo = k; p.ph_hi = k + 1; hipLaunchKernelGGL(k_fused, dim3(grid), dim3(512), LDS_FUSED, stream, p); }
#endif
}
```

```cpp
#include <hip/hip_runtime.h>
#include <stdint.h>
#include <string.h>
#include <math.h>
namespace mk {
#define LAS __attribute__((address_space(3)))
typedef unsigned short bf16_t;
typedef short bf16x8 __attribute__((ext_vector_type(8)));
typedef float f32x4 __attribute__((ext_vector_type(4)));
typedef unsigned u32x4 __attribute__((ext_vector_type(4)));
typedef unsigned u32x2 __attribute__((ext_vector_type(2)));
typedef float f2_t __attribute__((ext_vector_type(2)));
constexpr int NB = 8, S = 2048, D = 1024, T = NB * S, NE = 32;
constexpr int BM = 256, BK = 64, HALF = 128, HTB = HALF * BK * 2, STAGE_BYTES = 8 * HTB, NXCD = 8, WGM = 8;
constexpr int KD = 1024;
constexpr int NPROJ = 3072;
constexpr int MAXSLOT = 65536 + 32 * 256;
constexpr int LDS_MISC = 131072, LDS_TILE_E = LDS_MISC + 64, LDS_TILE_M = LDS_TILE_E + 1536, LDS_ROWTAB = LDS_MISC + 4096, LDS_BIASTAB = LDS_ROWTAB + 12 * 1024, LDS_BYTES = LDS_BIASTAB + 12 * 1024;

__host__ __device__ __forceinline__ int lds_byte(int r, int c) { const int st = (r >> 4) * 2 + (c >> 5), rr = r & 15, cc = c & 31, ob = rr * 64 + cc * 2; return st * 1024 + (ob ^ (((ob >> 9) & 1) << 5)); }
__host__ __device__ __forceinline__ void stage_rc(int b, int& R, int& C) { const int st = b / 1024, sb = b % 1024, swz = sb ^ (((sb >> 9) & 1) << 5); R = (st >> 1) * 16 + swz / 64; C = (st & 1) * 32 + (swz % 64) / 2; }
__host__ __device__ __forceinline__ int perm32(int rho) { const int n = rho >> 4, i = rho & 15; return 8 * (i >> 2) + 4 * n + (i & 3); }
__device__ __forceinline__ unsigned cvt_pk_bf16(float lo, float hi) { unsigned r; asm volatile("v_cvt_pk_bf16_f32 %0, %1, %2" : "=v"(r) : "v"(lo), "v"(hi)); return r; }
__device__ __forceinline__ int tid_fresh() { int t = threadIdx.x; asm volatile("" : "+v"(t)); return t; }
__device__ __forceinline__ float bf2f(bf16_t b) { return __uint_as_float(((unsigned)b) << 16); }

struct Unit { int pm, pn, e, mt, li; };
struct StaticOrder {
    int nM, nN, nwg, G, c;
    __device__ void init(int M, int N, int G_, int c_) { nM = M / BM; nN = N / BM; nwg = nM * nN; G = G_; c = c_; }
    __device__ bool next(int i, Unit& u) const {
        const long L = (long)i * G + c; if (L >= nwg) return false;
        int wgid = (int)L; { const int q = nwg / NXCD, r = nwg % NXCD, xcd = wgid % NXCD, off = wgid / NXCD; wgid = (xcd < r ? xcd * (q + 1) : r * (q + 1) + (xcd - r) * q) + off; }
        const int nig = WGM * nN, gid = wgid / nig, fm = gid * WGM, gsz = (nM - fm) < WGM ? (nM - fm) : WGM;
        u.pm = fm + ((wgid % nig) % gsz); u.pn = (wgid % nig) / gsz; u.e = 0; u.mt = 0; u.li = i; return true;
    }
};
struct MoeOrder {
    int nN, G, c, RT; const LAS int* tile_e; const LAS int* tile_m;
    __device__ bool next(int i, Unit& u) const { const int L = i * G + c; if (L >= RT * nN) return false; const int rt = L / nN; u.pm = rt; u.pn = L - rt * nN; u.e = tile_e[rt]; u.mt = tile_m[rt]; u.li = i; return true; }
};

struct ProbProj {
    static constexpr bool PERM = true, F8 = false, MIDSCALE = false; static constexpr int ROWB = KD * 2;
    StaticOrder S; const bf16_t* A; const bf16_t* Bt; bf16_t* O;
    __device__ __forceinline__ bool next(int i, Unit& u) const { return S.next(i, u); }
    __device__ __forceinline__ const char* a_base(const Unit& u) const { return (const char*)A + (size_t)u.pm * (BM * KD * 2); }
    __device__ __forceinline__ const char* b_base(const Unit& u) const { return (const char*)Bt + (size_t)u.pn * (BM * KD * 2); }
    __device__ __forceinline__ void a_offs(int, const Unit&, unsigned (&v0)[2], unsigned (&v1)[2], const int (&R)[2], const int (&C)[2]) const {
#pragma unroll
        for (int i = 0; i < 2; ++i) { v0[i] = (unsigned)(R[i] * KD + C[i]) * 2u; v1[i] = v0[i] + (unsigned)(HALF * KD * 2); } }
    __device__ __forceinline__ void epi(const f32x4 (&acc)[2][2][4][2], const Unit& u, int wr, int wc, int fr, int fq) const {
        const int row0 = u.pm * BM + wr * 64 + fr, col0 = u.pn * BM + wc * 32 + 8 * fq;
#pragma unroll
        for (int ai = 0; ai < 2; ++ai)
#pragma unroll
            for (int m = 0; m < 4; ++m) { bf16_t* rowp = O + (size_t)(row0 + ai * HALF + m * 16) * NPROJ + col0;
#pragma unroll
                for (int bj = 0; bj < 2; ++bj) { const f32x4 v0 = acc[ai][bj][m][0], v1 = acc[ai][bj][m][1]; u32x4 w;
                    w.x = cvt_pk_bf16(v0[0], v0[1]); w.y = cvt_pk_bf16(v0[2], v0[3]); w.z = cvt_pk_bf16(v1[0], v1[1]); w.w = cvt_pk_bf16(v1[2], v1[3]);
                    *(u32x4*)(rowp + bj * HALF) = w; } }
    }
};
struct ProbOut {
    static constexpr bool PERM = false, F8 = false, MIDSCALE = true; static constexpr int ROWB = KD * 2;
    StaticOrder S; const bf16_t* A; const bf16_t* Bt; const float* R0; bf16_t* O; const float* ssq;
    __device__ __forceinline__ void midscale(f32x4 (&acc)[2][2][4][2], const Unit& u, int wr, int fr) const {
        asm volatile("" : "+v"(fr));
#pragma unroll
        for (int ai = 0; ai < 2; ++ai)
#pragma unroll
            for (int m = 0; m < 4; ++m) { const int row = u.pm * BM + ai * HALF + wr * 64 + m * 16 + fr; const f2_t q = *(const f2_t*)(ssq + (size_t)row * 2);
                const float rs = rsqrtf((q[0] + q[1]) * (1.f / 512.f) + 1e-6f);
#pragma unroll
                for (int bj = 0; bj < 2; ++bj)
#pragma unroll
                    for (int n = 0; n < 2; ++n) acc[ai][bj][m][n] = acc[ai][bj][m][n] * rs;
                asm volatile("" ::: "memory"); } }
    __device__ __forceinline__ bool next(int i, Unit& u) const { return S.next(i, u); }
    __device__ __forceinline__ const char* a_base(const Unit& u) const { return (const char*)A + (size_t)u.pm * (BM * KD * 2); }
    __device__ __forceinline__ const char* b_base(const Unit& u) const { return (const char*)Bt + (size_t)u.pn * (BM * KD * 2); }
    __device__ __forceinline__ void a_offs(int, const Unit&, unsigned (&v0)[2], unsigned (&v1)[2], const int (&R)[2], const int (&C)[2]) const {
#pragma unroll
        for (int i = 0; i < 2; ++i) { v0[i] = (unsigned)(R[i] * KD + C[i]) * 2u; v1[i] = v0[i] + (unsigned)(HALF * KD * 2); } }
    __device__ __forceinline__ void epi(const f32x4 (&acc)[2][2][4][2], const Unit& u, int wr, int wc, int fr, int fq) const {
        const int row0 = u.pm * BM + wr * 64 + fr, col0 = u.pn * BM + wc * 32 + 4 * fq;
#pragma unroll
        for (int ai = 0; ai < 2; ++ai)
#pragma unroll
            for (int m = 0; m < 4; ++m) { const size_t off = (size_t)(row0 + ai * HALF + m * 16) * D + col0;
#pragma unroll
                for (int bj = 0; bj < 2; ++bj)
#pragma unroll
                    for (int n = 0; n < 2; ++n) { const f32x4 r = *(const f32x4*)(R0 + off + bj * HALF + n * 16); const f32x4 o = acc[ai][bj][m][n] + r; *(u32x2*)(O + off + bj * HALF + n * 16) = (u32x2){cvt_pk_bf16(o[0], o[1]), cvt_pk_bf16(o[2], o[3])}; }
                asm volatile("" ::: "memory"); }
    }
};
typedef unsigned char f8_t;
typedef int i32x8 __attribute__((ext_vector_type(8)));
typedef int i32x4 __attribute__((ext_vector_type(4)));
constexpr float W8_SCALE = 32.f, W8_INV = 1.f / 32.f;
__device__ __forceinline__ unsigned pk4_fp8(float a, float b, float c, float d) { int r = __builtin_amdgcn_cvt_pk_fp8_f32(a, b, 0, false); r = __builtin_amdgcn_cvt_pk_fp8_f32(c, d, r, true); return (unsigned)r; }
struct ProbMoe1 {
    static constexpr bool PERM = true, F8 = true, MIDSCALE = false; static constexpr int ROWB = KD;
    MoeOrder S; const f8_t* A; const f8_t* Bt; const LAS float* btab; f8_t* O; const LAS unsigned* rowtab;
    __device__ __forceinline__ bool next(int i, Unit& u) const { return S.next(i, u); }
    __device__ __forceinline__ const char* a_base(const Unit&) const { return (const char*)A; }
    __device__ __forceinline__ const char* b_base(const Unit& u) const { return (const char*)Bt + ((size_t)u.e * 2048 + (size_t)u.pn * BM) * ROWB; }
    __device__ __forceinline__ void a_offs(int i, const Unit&, unsigned (&v0)[2], unsigned (&v1)[2], const int (&R)[2], const int (&C)[2]) const {
#pragma unroll
        for (int j = 0; j < 2; ++j) { v0[j] = rowtab[i * 256 + R[j]] + (unsigned)C[j] * 2u; v1[j] = rowtab[i * 256 + HALF + R[j]] + (unsigned)C[j] * 2u; } }
    __device__ __forceinline__ void epi(const f32x4 (&acc)[2][2][4][2], const Unit& u, int wr, int wc, int fr, int fq) const {
        const int row0 = u.pm * BM + wr * 64 + fr, jg0 = u.pn * HALF + wc * 32 + 8 * fq;
        f32x4 bg[2], bu[2];
#pragma unroll
        for (int n = 0; n < 2; ++n) { bg[n] = *(const LAS f32x4*)(btab + u.li * 256 + wc * 32 + 8 * fq + 4 * n); bu[n] = *(const LAS f32x4*)(btab + u.li * 256 + 128 + wc * 32 + 8 * fq + 4 * n); }
#pragma unroll
        for (int ai = 0; ai < 2; ++ai)
#pragma unroll
            for (int m = 0; m < 4; ++m) { float o[8];
#pragma unroll
                for (int n = 0; n < 2; ++n) { const f32x4 g4 = acc[ai][0][m][n] * W8_INV + bg[n], u4 = acc[ai][1][m][n] * W8_INV + bu[n];
#pragma unroll
                    for (int j = 0; j < 4; ++j) { const float g = fminf(g4[j], 7.f), uu = __builtin_amdgcn_fmed3f(u4[j], -7.f, 7.f);
                        const float sg = __builtin_amdgcn_rcpf(1.f + __builtin_amdgcn_exp2f(-1.702f * 1.4426950408889634f * g)); o[n * 4 + j] = __builtin_fmaf(uu, g, g) * sg; } }
                *(u32x2*)(O + (size_t)(row0 + ai * HALF + m * 16) * 1024 + jg0) = (u32x2){pk4_fp8(o[0], o[1], o[2], o[3]), pk4_fp8(o[4], o[5], o[6], o[7])}; }
    }
};
struct ProbMoe2 {
    static constexpr bool PERM = true, F8 = true, MIDSCALE = false; static constexpr int ROWB = KD;
    MoeOrder S; const f8_t* A; const f8_t* Bt; const LAS float* btab; f8_t* O;
    __device__ __forceinline__ bool next(int i, Unit& u) const { return S.next(i, u); }
    __device__ __forceinline__ const char* a_base(const Unit& u) const { return (const char*)A + (size_t)u.pm * (BM * ROWB); }
    __device__ __forceinline__ const char* b_base(const Unit& u) const { return (const char*)Bt + ((size_t)u.e * 1024 + (size_t)u.pn * BM) * ROWB; }
    __device__ __forceinline__ void a_offs(int, const Unit&, unsigned (&v0)[2], unsigned (&v1)[2], const int (&R)[2], const int (&C)[2]) const {
#pragma unroll
        for (int i = 0; i < 2; ++i) { v0[i] = (unsigned)(R[i] * ROWB + C[i] * 2); v1[i] = v0[i] + (unsigned)(HALF * ROWB); } }
    __device__ __forceinline__ void epi(const f32x4 (&acc)[2][2][4][2], const Unit& u, int wr, int wc, int fr, int fq) const {
        const int rl0 = wr * 64 + fr, col0 = u.pn * BM + wc * 32 + 8 * fq;
#pragma unroll
        for (int ai = 0; ai < 2; ++ai)
#pragma unroll
            for (int m = 0; m < 4; ++m) { const int rl = rl0 + ai * HALF + m * 16;
                f8_t* rowp = O + (size_t)(u.pm * BM + rl) * 1024 + col0;
#pragma unroll
                for (int bj = 0; bj < 2; ++bj) { const f32x4 b0 = *(const LAS f32x4*)(btab + u.li * 256 + bj * HALF + wc * 32 + 8 * fq), b1 = *(const LAS f32x4*)(btab + u.li * 256 + bj * HALF + wc * 32 + 8 * fq + 4);
                    const f32x4 v0 = acc[ai][bj][m][0] * W8_INV + b0, v1 = acc[ai][bj][m][1] * W8_INV + b1;
                    *(u32x2*)(rowp + bj * HALF) = (u32x2){pk4_fp8(v0[0], v0[1], v0[2], v0[3]), pk4_fp8(v1[0], v1[1], v1[2], v1[3])}; }
                asm volatile("" ::: "memory"); }
    }
};

template <int N> struct FragBf { bf16x8 v[N][2];
    __device__ __forceinline__ void set(int i, int k, i32x4 x) { v[i][k] = __builtin_bit_cast(bf16x8, x); }
    __device__ __forceinline__ bf16x8 get(int i, int k) const { return v[i][k]; } };
template <int N> struct FragF8 { i32x8 v[N];
    __device__ __forceinline__ void set(int i, int k, i32x4 x) { if (k == 0) v[i].lo = x; else v[i].hi = x; }
    __device__ __forceinline__ bf16x8 get(int, int) const { return bf16x8{}; } };
template <bool F8> struct FragT { typedef FragBf<4> A_t; typedef FragBf<2> B_t; };
template <> struct FragT<true> { typedef FragF8<4> A_t; typedef FragF8<2> B_t; };
template <class P>
__device__ __forceinline__ void gemm_phase(LAS unsigned char* lds, const P& Pb) {
    const int tid = tid_fresh(), wid = __builtin_amdgcn_readfirstlane(tid >> 6), lane = tid & 63, wr = wid >> 2, wc = wid & 3, fr = lane & 15, fq = lane >> 4;
    constexpr int nt = P::ROWB / 128;
    int Rr[2], Cc[2]; unsigned voffB[2];
#pragma unroll
    for (int i = 0; i < 2; ++i) { int R, C; stage_rc(tid * 16 + i * 8192, R, C); const int Rb = P::PERM ? ((R & ~31) + perm32(R & 31)) : R; Rr[i] = R; Cc[i] = C; voffB[i] = (unsigned)(Rb * P::ROWB + C * 2); }
    constexpr size_t kstep = (size_t)(BK * 2);
    constexpr size_t hstep = (size_t)HALF * P::ROWB;
    const unsigned ldsw = (unsigned)wid * 1024u;
    const int aoff = lds_byte(wr * 64 + fr, fq * 8), boff = lds_byte(wc * 32 + fr, fq * 8);
#define PG8_SA(b, h) (((b) * 2 + (h)) * HTB)
#define PG8_SB(b, h) ((4 + (b) * 2 + (h)) * HTB)
#define PG8_STAGE(bufoff, gbase, voff) do { _Pragma("unroll") for (int _i = 0; _i < 2; ++_i) \
        __builtin_amdgcn_global_load_lds((const unsigned*)((const char*)(gbase) + (voff)[_i]), (LAS unsigned*)(lds + (bufoff) + ldsw + _i * 8192), 16, 0, 0); } while (0)
#define PG8_LDA(dst, b, h) do { _Pragma("unroll") for (int m = 0; m < 4; ++m) _Pragma("unroll") for (int k = 0; k < 2; ++k) dst.set(m, k, *(const LAS i32x4*)(lds + PG8_SA(b, h) + aoff + m * 2048 + k * 1024)); } while (0)
#define PG8_LDB(dst, b, h) do { _Pragma("unroll") for (int n = 0; n < 2; ++n) _Pragma("unroll") for (int k = 0; k < 2; ++k) dst.set(n, k, *(const LAS i32x4*)(lds + PG8_SB(b, h) + boff + n * 2048 + k * 1024)); } while (0)
#define PG8_MMA(ai, bj, At, Bt) do { __builtin_amdgcn_s_setprio(1); _Pragma("unroll") for (int m = 0; m < 4; ++m) _Pragma("unroll") for (int n = 0; n < 2; ++n) { \
        if constexpr (P::F8) acc[ai][bj][m][n] = __builtin_amdgcn_mfma_scale_f32_16x16x128_f8f6f4(Bt.v[n], At.v[m], acc[ai][bj][m][n], 0, 0, 0, 0x7f7f7f7f, 0, 0x7f7f7f7f); \
        else { _Pragma("unroll") for (int k = 0; k < 2; ++k) acc[ai][bj][m][n] = __builtin_amdgcn_mfma_f32_16x16x32_bf16(Bt.get(n, k), At.get(m, k), acc[ai][bj][m][n], 0, 0, 0); } } \
        __builtin_amdgcn_s_setprio(0); } while (0)
#define PG8_WAIT_V(n) asm volatile("s_waitcnt vmcnt(" #n ")" ::: "memory")
#define PG8_WAIT_L(n) asm volatile("s_waitcnt lgkmcnt(" #n ")" ::: "memory")
#define PG8_BAR __builtin_amdgcn_s_barrier()
#define PG8_SCHED __builtin_amdgcn_sched_barrier(0)
    Unit cur, nxt; int ui = 0;
    if (!Pb.next(0, cur)) return;
    f32x4 acc[2][2][4][2];
#pragma unroll
    for (int a = 0; a < 2; ++a)
#pragma unroll
        for (int b = 0; b < 2; ++b)
#pragma unroll
            for (int m = 0; m < 4; ++m)
#pragma unroll
                for (int n = 0; n < 2; ++n) acc[a][b][m][n] = (f32x4){0.f, 0.f, 0.f, 0.f};
    typedef typename FragT<P::F8>::A_t AFr; typedef typename FragT<P::F8>::B_t BFr;
    AFr At; BFr B0, B1;
    unsigned vA0[2], vA1[2];
    Pb.a_offs(0, cur, vA0, vA1, Rr, Cc);
    const char* cA = Pb.a_base(cur); const char* cB = Pb.b_base(cur);
    PG8_STAGE(PG8_SB(0, 0), cB, voffB); PG8_STAGE(PG8_SB(0, 1), cB + hstep, voffB); PG8_STAGE(PG8_SA(0, 0), cA, vA0); PG8_STAGE(PG8_SA(0, 1), cA, vA1);
    if (wr == 1) PG8_BAR;
    PG8_WAIT_V(2); PG8_BAR;
    PG8_STAGE(PG8_SB(1, 0), cB + kstep, voffB); PG8_STAGE(PG8_SA(1, 0), cA + kstep, vA0); PG8_STAGE(PG8_SB(1, 1), cB + hstep + kstep, voffB);
    PG8_WAIT_V(6); PG8_BAR;
    for (;;) {
        const bool has_next = Pb.next(ui + 1, nxt);
        const char* nA = has_next ? Pb.a_base(nxt) : cA; const char* nB = has_next ? Pb.b_base(nxt) : cB;
#define PG8_KITER \
            const bool last = (t == nt - 2); \
            if constexpr (P::MIDSCALE) { if (t == 8) Pb.midscale(acc, cur, wr, fr); } \
            const char* a1 = cA + (size_t)(t + 1) * kstep; \
            const char* a2 = last ? nA : cA + (size_t)(t + 2) * kstep; const char* b2 = last ? nB : cB + (size_t)(t + 2) * kstep; \
            const char* a3 = a2 + kstep; const char* b3 = b2 + kstep; \
            PG8_LDB(B0, 0, 0); PG8_LDB(B1, 0, 1); PG8_SCHED; PG8_LDA(At, 0, 0); PG8_STAGE(PG8_SA(1, 1), a1, vA1); \
            PG8_WAIT_V(8); PG8_WAIT_L(0); PG8_BAR; PG8_MMA(0, 0, At, B0); PG8_MMA(0, 1, At, B1); PG8_BAR; PG8_SCHED; \
            if (last && has_next) { \
                if constexpr (P::F8) { int R2[2], C2[2]; int t2 = tid; asm volatile("" : "+v"(t2)); \
_Pragma("unroll") \
                    for (int i = 0; i < 2; ++i) stage_rc(t2 * 16 + i * 8192, R2[i], C2[i]); \
                    Pb.a_offs(ui + 1, nxt, vA0, vA1, R2, C2); } \
                else Pb.a_offs(ui + 1, nxt, vA0, vA1, Rr, Cc); } \
            PG8_LDA(At, 0, 1); PG8_STAGE(PG8_SB(0, 0), b2, voffB); PG8_STAGE(PG8_SB(0, 1), b2 + hstep, voffB); PG8_STAGE(PG8_SA(0, 0), a2, vA0); \
            PG8_WAIT_V(8); PG8_WAIT_L(0); PG8_BAR; PG8_MMA(1, 0, At, B0); PG8_MMA(1, 1, At, B1); PG8_BAR; PG8_SCHED; \
            PG8_LDB(B0, 1, 0); PG8_LDB(B1, 1, 1); PG8_SCHED; PG8_LDA(At, 1, 0); PG8_STAGE(PG8_SA(0, 1), a2, vA1); \
            PG8_WAIT_V(8); PG8_WAIT_L(0); PG8_BAR; PG8_MMA(0, 0, At, B0); PG8_MMA(0, 1, At, B1); PG8_BAR; PG8_SCHED; \
            PG8_LDA(At, 1, 1); PG8_STAGE(PG8_SB(1, 0), b3, voffB); PG8_STAGE(PG8_SB(1, 1), b3 + hstep, voffB); PG8_STAGE(PG8_SA(1, 0), a3, vA0); \
            PG8_WAIT_V(8); PG8_WAIT_L(0); PG8_BAR; PG8_MMA(1, 0, At, B0); PG8_MMA(1, 1, At, B1); PG8_BAR; PG8_SCHED;
        if constexpr (P::F8) {
#pragma unroll 1
            for (int t = 0; t < nt; t += 2) { PG8_KITER }
        } else {
            for (int t = 0; t < nt; t += 2) { PG8_KITER }
        }
#undef PG8_KITER
        if (wr == 0) PG8_BAR;
        if constexpr (P::F8) { int ln2 = lane; asm volatile("" : "+v"(ln2)); Pb.epi(acc, cur, wr, wc, ln2 & 15, ln2 >> 4); } else Pb.epi(acc, cur, wr, wc, fr, fq);
        if (!has_next) break;
#pragma unroll
        for (int a = 0; a < 2; ++a)
#pragma unroll
            for (int b = 0; b < 2; ++b)
#pragma unroll
                for (int m = 0; m < 4; ++m)
#pragma unroll
                    for (int n = 0; n < 2; ++n) acc[a][b][m][n] = (f32x4){0.f, 0.f, 0.f, 0.f};
        cur = nxt; cA = nA; cB = nB; ++ui;
        if (wr == 1) PG8_BAR;
    }
    PG8_WAIT_V(0);
    PG8_BAR;
#undef PG8_SA
#undef PG8_SB
#undef PG8_STAGE
#undef PG8_LDA
#undef PG8_LDB
#undef PG8_MMA
#undef PG8_WAIT_V
#undef PG8_WAIT_L
#undef PG8_BAR
#undef PG8_SCHED
}

__device__ __forceinline__ int moe_tables(LAS unsigned char* lds, const int* cnt) {
    LAS int* tile_e = (LAS int*)(lds + LDS_TILE_E); LAS int* tile_m = (LAS int*)(lds + LDS_TILE_M); LAS int* rts = (LAS int*)(lds + LDS_MISC + 32);
    if (tid_fresh() == 0) { int a = 0; for (int e = 0; e < NE; ++e) { const int n = (cnt[e] + 255) >> 8; for (int m = 0; m < n; ++m) { tile_e[a] = e; tile_m[a] = m; ++a; } } rts[0] = a; }
    __syncthreads();
    return rts[0];
}
}
namespace mk {
__device__ __forceinline__ float wsum(float v) {
#pragma unroll
    for (int o = 1; o < 64; o <<= 1) v += __shfl_xor(v, o);
    return v; }
__device__ __forceinline__ unsigned short f2bf(float f) { unsigned u = __float_as_uint(f); u += 0x7FFFu + ((u >> 16) & 1u); return (unsigned short)(u >> 16); }
}
namespace mk {
typedef float f32x16 __attribute__((ext_vector_type(16)));
typedef short s16x4 __attribute__((ext_vector_type(4)));
typedef __bf16 bf2_t __attribute__((ext_vector_type(2)));
#define MFMA32(a, b, c) __builtin_amdgcn_mfma_f32_32x32x16_bf16((a), (b), (c), 0, 0, 0)
constexpr float LOG2E = 1.4426950408889634f;
constexpr int PROJ_LD = NPROJ;
constexpr int AT_NPB = 2  , AT_KBUF = 0, AT_VBUF = 16384, AT_IMPW = 32768, AT_SCORE = 2 * AT_NPB * 16384  , AT_OBUF = AT_SCORE + 8192, AT_OSTR = 528, AT_BTAB = AT_OBUF + 64 * AT_OSTR  ,
              AT_SEL = AT_BTAB + 8 * 132 * 4  , AT_SSQ = AT_SEL + 512  , AT_END = AT_SSQ + 8 * 64 * 4  ;
struct AttnArgs { const bf16_t* projb; const bf16_t* kc; const bf16_t* vc; bf16_t* catb; float* ssq; };

__device__ __forceinline__ unsigned pk2(float a, float b) { f2_t v = {a, b}; return __builtin_bit_cast(unsigned, __builtin_convertvector(v, bf2_t)); }
__device__ __forceinline__ int t5_bucket(int n) { if (n < 0) n = 0; if (n < 16) return n; const float nf = (float)n; const int l = 16 + (int)(logf(nf / 16.f) / 2.0794415416798357f * 16.f); return l < 31 ? l : 31; }
__device__ __forceinline__ float xh_max(float x) { const auto r = __builtin_amdgcn_permlane32_swap(__float_as_uint(x), __float_as_uint(x), false, false); return fmaxf(__uint_as_float(r[0]), __uint_as_float(r[1])); }
__device__ __forceinline__ float xh_sum(float x) { const auto r = __builtin_amdgcn_permlane32_swap(__float_as_uint(x), __float_as_uint(x), false, false); return __uint_as_float(r[0]) + __uint_as_float(r[1]); }
__device__ __forceinline__ float xh_other(float x, int h) { const auto r = __builtin_amdgcn_permlane32_swap(__float_as_uint(x), __float_as_uint(x), false, false); return __uint_as_float(h ? r[0] : r[1]); }
__device__ __forceinline__ void stage_tile(LAS unsigned char* dst, const char* src, size_t row_stride, int wid, int lane, bool vswz) {
    const int row = 8 * wid + (lane >> 3), slot = lane & 7;
    const int f = vswz ? (((row >> 1) & 1) << 2) : ((row >> 1) & 7);
    __builtin_amdgcn_global_load_lds((const unsigned*)(src + (size_t)row * row_stride + ((slot ^ f) << 4)), (LAS unsigned*)(dst + wid * 1024), 16, 0, 0);
}
#define AT_CROW(r, h) (((r) & 3) + 8 * ((r) >> 2) + 4 * (h))
#define AT_PACK8(x, s) __builtin_bit_cast(bf16x8, (u32x4){pk2((x)[8 * (s)], (x)[8 * (s) + 1]), pk2((x)[8 * (s) + 2], (x)[8 * (s) + 3]), pk2((x)[8 * (s) + 4], (x)[8 * (s) + 5]), pk2((x)[8 * (s) + 6], (x)[8 * (s) + 7])})
__device__ __forceinline__ bf16x8 vt_frag(const LAS unsigned char* vt, unsigned vaddr, int rowoff) {
    const s16x4 lo = __builtin_amdgcn_ds_read_tr16_b64_v4i16((LAS s16x4*)(vt + vaddr + rowoff * 128));
    const s16x4 hi = __builtin_amdgcn_ds_read_tr16_b64_v4i16((LAS s16x4*)(vt + vaddr + (rowoff + 8) * 128));
    return __builtin_shufflevector(lo, hi, 0, 1, 2, 3, 4, 5, 6, 7);
}
template <bool FIRST>
__device__ __forceinline__ void obuf_acc(LAS unsigned char* lds, int tl, int hd, int h, float sc, const f32x16 (&oc)[2]) {
#pragma unroll
    for (int c = 0; c < 2; ++c)
#pragma unroll
        for (int qd = 0; qd < 4; ++qd) { LAS u32x2* p = (LAS u32x2*)(lds + AT_OBUF + tl * AT_OSTR + ((hd & 3) * 64 + 32 * c + 8 * qd + 4 * h) * 2);
            float a0 = sc * oc[c][4 * qd], a1 = sc * oc[c][4 * qd + 1], a2 = sc * oc[c][4 * qd + 2], a3 = sc * oc[c][4 * qd + 3];
            if (!FIRST) { const u32x2 o = *p; a0 += __uint_as_float(o.x << 16); a1 += __uint_as_float(o.x & 0xffff0000u); a2 += __uint_as_float(o.y << 16); a3 += __uint_as_float(o.y & 0xffff0000u); }
            *p = (u32x2){pk2(a0, a1), pk2(a2, a3)}; }
}
template <int KIND>
__device__ __forceinline__ void attn_tile(const LAS unsigned char* Kt, const LAS unsigned char* Vt, int kbase, int tq, bool sel, const bf16x8 (&qf)[4], const LAS float* bt, float cfar,
                                          f32x16 (&O)[2], float& m, float& l, int ql, int h, const unsigned (&vaddr)[2]) {
    f32x16 s0, s1;
#pragma unroll
    for (int r = 0; r < 16; ++r) { s0[r] = 0.f; s1[r] = 0.f; }
    const int fk = (ql >> 1) & 7;
#pragma unroll
    for (int s = 0; s < 4; ++s) { const int ch = ((2 * s + h) ^ fk) << 4;
        const bf16x8 k0 = *(const LAS bf16x8*)(Kt + ql * 128 + ch), k1 = *(const LAS bf16x8*)(Kt + (32 + ql) * 128 + ch);
        s0 = MFMA32(k0, qf[s], s0); s1 = MFMA32(k1, qf[s], s1); }
    float mx = -INFINITY;
    if (KIND == 0) {
#pragma unroll
        for (int r = 0; r < 16; ++r) mx = fmaxf(mx, fmaxf(s0[r], s1[r]));
        mx += cfar;
    } else {
        int tqq = tq - kbase; asm volatile("" : "+v"(tqq));
#pragma unroll
        for (int r = 0; r < 16; ++r) {
            const int d0 = tqq - AT_CROW(r, h), d1 = d0 - 32;
            float x0 = s0[r] + bt[min(max(d0, 0), 128)], x1 = s1[r] + bt[min(max(d1, 0), 128)];
            if (KIND == 2) { x0 = (d0 >= 0 && d0 < 512) ? x0 : -INFINITY; x1 = (d1 >= 0 && d1 < 512) ? x1 : -INFINITY; }
            s0[r] = x0; s1[r] = x1; mx = fmaxf(mx, fmaxf(x0, x1)); }
    }
    mx = sel ? mx : -INFINITY;
    mx = xh_max(mx);
    const float mn = fmaxf(m, mx);
    const float alpha = __builtin_amdgcn_exp2f(m - mn);
    float msub = sel ? mn : INFINITY;
    if (KIND == 0) msub -= cfar;
    float ps = 0.f;
#pragma unroll
    for (int r = 0; r < 16; ++r) { const float p0 = __builtin_amdgcn_exp2f(s0[r] - msub), p1 = __builtin_amdgcn_exp2f(s1[r] - msub); s0[r] = p0; s1[r] = p1; ps += p0 + p1; }
    l = l * alpha + ps; m = mn;
    if (__any(alpha != 1.f)) {
#pragma unroll
        for (int r = 0; r < 16; ++r) { O[0][r] *= alpha; O[1][r] *= alpha; } }
#pragma unroll
    for (int sp = 0; sp < 2; ++sp) {
        const bf16x8 p0 = AT_PACK8(s0, sp), p1 = AT_PACK8(s1, sp);
#pragma unroll
        for (int c = 0; c < 2; ++c) { O[c] = MFMA32(vt_frag(Vt, vaddr[c], 16 * sp), p0, O[c]); O[c] = MFMA32(vt_frag(Vt, vaddr[c], 32 + 16 * sp), p1, O[c]); }
    }
}
template <int MODE>
__device__ __forceinline__ void attn_branch(LAS unsigned char* lds, unsigned U, unsigned mysel, const char* kcol, const char* vcol, size_t RS, int blk, int tq, const bf16x8 (&qf)[4],
                                            const LAS float* bt, float cfar, f32x16 (&oc)[2], float& m, float& l, int ql, int h, const unsigned (&vaddr)[2], int wid, int lane) {
#define AT_NEXT(n) (((n) >= 31) ? -1 : ((U & ~((2u << (n)) - 1u)) ? __builtin_ctz(U & ~((2u << (n)) - 1u)) : -1))
#define AT_ISSUE(n, st) do { stage_tile(lds + (st) * 16384, kcol + (size_t)(n) * 64 * RS, RS, wid, lane, false); stage_tile(lds + (st) * 16384 + 8192, vcol + (size_t)(n) * 64 * RS, RS, wid, lane, true); } while (0)
    int tl_[AT_NPB], pb = 0;
    tl_[0] = __builtin_ctz(U | 0x80000000u);
#pragma unroll
    for (int q = 1; q < AT_NPB; ++q) tl_[q] = (tl_[q - 1] >= 0) ? AT_NEXT(tl_[q - 1]) : -1;
    asm volatile("s_waitcnt lgkmcnt(0)" ::: "memory"); __builtin_amdgcn_s_barrier(); asm volatile("" ::: "memory");
#pragma unroll
    for (int q = 0; q < AT_NPB; ++q) if (tl_[q] >= 0) AT_ISSUE(tl_[q], q);
    for (;;) {
        asm volatile("s_waitcnt vmcnt(0)" ::: "memory");
        asm volatile("s_waitcnt lgkmcnt(0)" ::: "memory"); __builtin_amdgcn_s_barrier(); asm volatile("" ::: "memory");
        int nx[AT_NPB];
        nx[0] = (tl_[AT_NPB - 1] >= 0) ? AT_NEXT(tl_[AT_NPB - 1]) : -1;
#pragma unroll
        for (int q = 1; q < AT_NPB; ++q) nx[q] = (nx[q - 1] >= 0) ? AT_NEXT(nx[q - 1]) : -1;
#pragma unroll
        for (int q = 0; q < AT_NPB; ++q) if (nx[q] >= 0) AT_ISSUE(nx[q], AT_NPB * (pb ^ 1) + q);
#pragma unroll
        for (int q = 0; q < AT_NPB; ++q) { const int tcur = tl_[q]; if (tcur < 0) break;
            const LAS unsigned char* Kt = lds + (AT_NPB * pb + q) * 16384; const LAS unsigned char* Vt = Kt + 8192;
            const bool sel = (MODE == 0) ? (((mysel >> tcur) & 1u) != 0u) : true;
            const bool masked = (tcur == blk) || (MODE == 1 && tcur + 8 == blk);
            if (masked) attn_tile<2>(Kt, Vt, tcur * 64, tq, sel, qf, bt, cfar, oc, m, l, ql, h, vaddr);
            else if (tcur + 3 <= blk) attn_tile<0>(Kt, Vt, tcur * 64, tq, sel, qf, bt, cfar, oc, m, l, ql, h, vaddr);
            else attn_tile<1>(Kt, Vt, tcur * 64, tq, sel, qf, bt, cfar, oc, m, l, ql, h, vaddr); }
        if (nx[0] < 0) break;
#pragma unroll
        for (int q = 0; q < AT_NPB; ++q) tl_[q] = nx[q];
        pb ^= 1;
    }
#undef AT_NEXT
#undef AT_ISSUE
}

__device__ __forceinline__ void attn_item(LAS unsigned char* lds, const AttnArgs& A, int b, int qt, int kvh) {
    const int tid = tid_fresh(), wid = __builtin_amdgcn_readfirstlane(tid >> 6), lane = tid & 63;
    const int g = wid >> 1, th = wid & 1, ql = lane & 31, h = lane >> 5;
    const int t0 = qt * 64, tl = th * 32 + ql, tq = t0 + tl, blk = qt;
    const int qq = (lane & 15) >> 2, pp = lane & 3, lb = (lane >> 4) & 1;
    unsigned vaddr[2];
#pragma unroll
    for (int c = 0; c < 2; ++c) vaddr[c] = (unsigned)((4 * h + qq) * 128 + (((4 * (c ^ ((qq >> 1) & 1))) + 2 * lb + (pp >> 1)) << 4) + 8 * (pp & 1));
    LAS float* impw = (LAS float*)(lds + AT_IMPW); LAS float* score = (LAS float*)(lds + AT_SCORE); LAS unsigned* selm = (LAS unsigned*)(lds + AT_SEL);
    const char* prow0 = (const char*)(A.projb + (size_t)b * S * PROJ_LD);
    const size_t RS = (size_t)PROJ_LD * 2;
    {
        const int hd = kvh * 4 + g;
        const LAS float* bt = (const LAS float*)(lds + AT_BTAB) + hd * 132;
        const float cfar = bt[128];
        bf16x8 qf[4];
#pragma unroll
        for (int s = 0; s < 4; ++s) qf[s] = *(const bf16x8*)(A.projb + ((size_t)b * S + tq) * PROJ_LD + hd * 64 + 16 * s + 8 * h);
        float gate[3];
#pragma unroll
        for (int j = 0; j < 3; ++j) { const float gv = bf2f(A.projb[((size_t)b * S + tq) * PROJ_LD + 1280 + j * 8 + hd]); gate[j] = 1.f / (1.f + __expf(-gv)); }
        __syncthreads();
        { const char* kcb = (const char*)(A.kc + (size_t)(b * 2 + kvh) * 128 * 64); const char* vcb = (const char*)(A.vc + (size_t)(b * 2 + kvh) * 128 * 64);
          stage_tile(lds + AT_KBUF, kcb, 128, wid, lane, false); stage_tile(lds + AT_KBUF + 8192, kcb + 64 * 128, 128, wid, lane, false);
          stage_tile(lds + AT_VBUF, vcb, 128, wid, lane, true); stage_tile(lds + AT_VBUF + 8192, vcb + 64 * 128, 128, wid, lane, true); }
        asm volatile("s_waitcnt vmcnt(0)" ::: "memory"); __syncthreads();
        {
            f32x16 sc[4]; const int fk = (ql >> 1) & 7; int tqc = tq; asm volatile("" : "+v"(tqc));
            const int nkb = ((t0 + 32) >> 4) / 32 + 1;
#pragma unroll
            for (int kb = 0; kb < 4; ++kb) {
#pragma unroll
                for (int r = 0; r < 16; ++r) sc[kb][r] = 0.f;
                if (kb < nkb) {
#pragma unroll
                for (int s = 0; s < 4; ++s) { const bf16x8 kf = *(const LAS bf16x8*)(lds + AT_KBUF + (32 * kb + ql) * 128 + (((2 * s + h) ^ fk) << 4)); sc[kb] = MFMA32(kf, qf[s], sc[kb]); } }
                __builtin_amdgcn_sched_barrier(0); }
            float mx = -INFINITY;
#pragma unroll
            for (int kb = 0; kb < 4; ++kb) {
                if (kb >= nkb) {
#pragma unroll
                    for (int r = 0; r < 16; ++r) sc[kb][r] = -INFINITY;
                    continue; }
#pragma unroll
                for (int r = 0; r < 16; ++r) { const int c = 32 * kb + AT_CROW(r, h); const int dist = tqc - 16 * c - 31; const float bv = bt[min(max(dist, 0), 128)]; const float x = (dist >= 0) ? sc[kb][r] + bv : -INFINITY; sc[kb][r] = x; mx = fmaxf(mx, x);
                    if ((r & 7) == 7) __builtin_amdgcn_sched_barrier(0); } }
            mx = xh_max(mx);
            const float mref = (mx == -INFINITY) ? 0.f : mx;
            float ls = 0.f;
#pragma unroll
            for (int kb = 0; kb < 4; ++kb) {
                if (kb >= nkb) {
#pragma unroll
                    for (int r = 0; r < 16; ++r) sc[kb][r] = 0.f;
                    continue; }
#pragma unroll
                for (int r = 0; r < 16; ++r) { const float p = __builtin_amdgcn_exp2f(sc[kb][r] - mref); sc[kb][r] = p; ls += p; } }
            ls = xh_sum(ls);
            const float inv = 1.f / fmaxf(ls, 1e-30f);
#pragma unroll
            for (int kb = 0; kb < 4; ++kb) { if (kb >= nkb) continue;
#pragma unroll
                for (int r = 0; r < 16; ++r) sc[kb][r] *= inv; }
            if (blk >= 16) { float carry = 0.f;
#pragma unroll
              for (int i = 0; i < 16; ++i) { const int kb = i >> 2, qd = i & 3;
                  const float s4 = (sc[kb][4 * qd] + sc[kb][4 * qd + 1]) + (sc[kb][4 * qd + 2] + sc[kb][4 * qd + 3]);
                  const float rv = xh_other(sc[kb][4 * qd + 3], h);
                  impw[(wid * 32 + ql) * 32 + 2 * i + h] = s4 + (h ? rv : carry); carry = rv; } }
            f32x16 oc[2];
#pragma unroll
            for (int r = 0; r < 16; ++r) { oc[0][r] = 0.f; oc[1][r] = 0.f; }
#pragma unroll
            for (int kb = 0; kb < 4; ++kb) { if (kb >= nkb) continue;
#pragma unroll
                for (int sp = 0; sp < 2; ++sp) { const bf16x8 pf = AT_PACK8(sc[kb], sp);
#pragma unroll
                    for (int c = 0; c < 2; ++c) oc[c] = MFMA32(vt_frag(lds + AT_VBUF, vaddr[c], 32 * kb + 16 * sp), pf, oc[c]);
                    __builtin_amdgcn_sched_barrier(0); } }
            obuf_acc<true>(lds, tl, hd, h, gate[0], oc);
        }
        __syncthreads();
        unsigned U = (blk >= 31) ? 0xffffffffu : ((2u << blk) - 1u);
        if (blk >= 16) {
        int tids = tid; asm volatile("" : "+v"(tids));
#pragma unroll
        for (int i = 0; i < 4; ++i) { const int id = tids + 512 * i, tk = id >> 5, n = id & 31, w0 = tk >> 5, q = tk & 31;
            float v = 0.f;
#pragma unroll
            for (int gg = 0; gg < 4; ++gg) v += impw[((2 * gg + w0) * 32 + q) * 32 + n];
            const bool forced = (n == 0) || (n == blk) || (n == blk - 1);
            score[tk * 32 + n] = forced ? 1e4f : ((n <= blk) ? v : -1.f); }
        __syncthreads();
        { const int tk = tids >> 3, part = tids & 7;
          float sv[32];
#pragma unroll
          for (int e4 = 0; e4 < 8; ++e4) { const f32x4 q4 = *(const LAS f32x4*)(score + tk * 32 + e4 * 4); sv[e4 * 4] = q4[0]; sv[e4 * 4 + 1] = q4[1]; sv[e4 * 4 + 2] = q4[2]; sv[e4 * 4 + 3] = q4[3]; }
          unsigned bits = 0u;
#pragma unroll
          for (int j = 0; j < 4; ++j) { const int n = 4 * part + j; const float sn = score[tk * 32 + n];
              int rank = 0;
#pragma unroll
              for (int mm = 0; mm < 32; ++mm) rank += (sv[mm] > sn || (sv[mm] == sn && mm < n)) ? 1 : 0;
              bits |= ((rank < 16) && (n <= blk)) ? (1u << n) : 0u; }
          bits |= (unsigned)__shfl_xor((int)bits, 1); bits |= (unsigned)__shfl_xor((int)bits, 2); bits |= (unsigned)__shfl_xor((int)bits, 4);
          if (part == 0) selm[tk] = bits; }
        __syncthreads();
        U = selm[lane];
#pragma unroll
        for (int o = 1; o < 64; o <<= 1) U |= (unsigned)__shfl_xor((int)U, o);
        U = (unsigned)__builtin_amdgcn_readfirstlane((int)U);
        }
        const unsigned mysel = (blk >= 16) ? selm[tl] : U;
        {
            f32x16 oc[2];
#pragma unroll
            for (int r = 0; r < 16; ++r) { oc[0][r] = 0.f; oc[1][r] = 0.f; }
            float m = -1e30f, l = 0.f;
            attn_branch<0>(lds, U, mysel, prow0 + (512 + 2 * 128 + kvh * 64) * 2, prow0 + (512 + 3 * 128 + kvh * 64) * 2, RS, blk, tq, qf, bt, cfar, oc, m, l, ql, h, vaddr, wid, lane);
            l = xh_sum(l);
            const float sc1 = gate[1] / fmaxf(l, 1e-30f);
            obuf_acc<false>(lds, tl, hd, h, sc1, oc);
        }
        {
            f32x16 oc[2];
#pragma unroll
            for (int r = 0; r < 16; ++r) { oc[0][r] = 0.f; oc[1][r] = 0.f; }
            float m = -1e30f, l = 0.f;
            const int lo = (blk >= 8) ? blk - 8 : 0;
            const unsigned Uw = ((blk >= 31) ? 0xffffffffu : ((2u << blk) - 1u)) & ~((1u << lo) - 1u);
            attn_branch<1>(lds, Uw, 0u, prow0 + (512 + 4 * 128 + kvh * 64) * 2, prow0 + (512 + 5 * 128 + kvh * 64) * 2, RS, blk, tq, qf, bt, cfar, oc, m, l, ql, h, vaddr, wid, lane);
            l = xh_sum(l);
            const float sc2 = gate[2] / fmaxf(l, 1e-30f);
            obuf_acc<false>(lds, tl, hd, h, sc2, oc);
        }
    }
    __syncthreads();
    int widn = wid; asm volatile("" : "+s"(widn));
    { u32x2 v[8]; float sq[8];
#pragma unroll
      for (int i = 0; i < 8; ++i) { v[i] = *(const LAS u32x2*)(lds + AT_OBUF + (widn + 8 * i) * AT_OSTR + lane * 8);
          const float f0 = __uint_as_float(v[i].x << 16), f1 = __uint_as_float(v[i].x & 0xffff0000u), f2 = __uint_as_float(v[i].y << 16), f3 = __uint_as_float(v[i].y & 0xffff0000u);
          sq[i] = (f0 * f0 + f1 * f1) + (f2 * f2 + f3 * f3); }
#pragma unroll
      for (int o = 1; o < 64; o <<= 1) {
#pragma unroll
          for (int i = 0; i < 8; ++i) sq[i] += __shfl_xor(sq[i], o); }
#pragma unroll
      for (int i = 0; i < 8; ++i) { const int row = widn + 8 * i;
          *(u32x2*)(A.catb + ((size_t)b * S + t0 + row) * 1024 + kvh * 256 + lane * 4) = v[i];
          if (lane == 0) A.ssq[((size_t)b * S + t0 + row) * 2 + kvh] = sq[i]; } }
    __syncthreads();
}
__device__ __forceinline__ void attn_btab(LAS unsigned char* lds, const float* rel_bias) {
    LAS float* bt = (LAS float*)(lds + AT_BTAB);
    for (int i = threadIdx.x; i < 8 * 129; i += 512) { const int hd = i / 129, d = i % 129; bt[hd * 132 + d] = rel_bias[t5_bucket(d) * 8 + hd] * LOG2E; }
    __syncthreads();
}
}
namespace mk {
constexpr int XBC_OFF = 1816, Z_OFF = 1304, DT_OFF = 2840, NCH = 16;
constexpr int SD_XS = 0, SD_B = 65536, SD_C = 98304, SD_PREV = 131072  , SD_ACS = SD_PREV + 16384, SD_DT = SD_ACS + 2048, SD_W = SD_DT + 2048, SD_WP = SD_W + 2048  , SD_END = SD_WP + 256;
struct SsdArgs { const bf16_t* projb; const float* conv_w; const float* conv_b; const float* dt_bias; const float* a_log; const float* d_skip; bf16_t* states; float* alast; bf16_t* catb; };

__device__ __forceinline__ void ssd_dt_acs(LAS unsigned char* lds, const SsdArgs& A, int b, int c, int grp, int wid, int lane) {
    if (wid < 4) { const int hd = grp * 4 + wid; const float Ah = -__expf(A.a_log[hd]), db = A.dt_bias[hd];
        const size_t row = (size_t)b * S + c * 128 + 2 * lane;
        float x0 = bf2f(A.projb[row * PROJ_LD + DT_OFF + hd]) + db, x1 = bf2f(A.projb[(row + 1) * PROJ_LD + DT_OFF + hd]) + db;
        const float d0 = (x0 > 20.f) ? x0 : log1pf(__expf(x0)), d1 = (x1 > 20.f) ? x1 : log1pf(__expf(x1));
        const float a0 = d0 * Ah, a1 = d1 * Ah; float incl = a0 + a1;
#pragma unroll
        for (int o = 1; o < 64; o <<= 1) { const float t = __shfl_up(incl, o); if (lane >= o) incl += t; }
        LAS float* acs = (LAS float*)(lds + SD_ACS) + wid * 128; LAS float* dtl = (LAS float*)(lds + SD_DT) + wid * 128;
        acs[2 * lane] = incl - a1; acs[2 * lane + 1] = incl; dtl[2 * lane] = d0; dtl[2 * lane + 1] = d1;
        LAS float* lw = (LAS float*)(lds + SD_W) + wid * 128;
        lw[2 * lane] = (__logf(d0) - (incl - a1)) * 1.4426950408889634f; lw[2 * lane + 1] = (__logf(d1) - incl) * 1.4426950408889634f; }
}
template <bool PHASE_A>
__device__ __forceinline__ void ssd_conv(LAS unsigned char* lds, const SsdArgs& A, int b, int c, int grp, int wid, int lane) {
    const int ch = lane;
    if (PHASE_A && ch >= 48) return;
    const int rel = (ch < 32) ? grp * 256 + ch * 8 : (ch < 48) ? 512 + grp * 128 + (ch - 32) * 8 : 768 + grp * 128 + (ch - 48) * 8;
    float w[4][8], bias[8];
#pragma unroll
    for (int k = 0; k < 4; ++k) { const f32x4 u0 = *(const f32x4*)(A.conv_w + k * 1024 + rel), u1 = *(const f32x4*)(A.conv_w + k * 1024 + rel + 4);
#pragma unroll
        for (int j = 0; j < 4; ++j) { w[k][j] = u0[j]; w[k][4 + j] = u1[j]; } }
    { const f32x4 u0 = *(const f32x4*)(A.conv_b + rel), u1 = *(const f32x4*)(A.conv_b + rel + 4);
#pragma unroll
      for (int j = 0; j < 4; ++j) { bias[j] = u0[j]; bias[4 + j] = u1[j]; } }
    const int tl0 = wid * 16, ts0 = c * 128 + tl0;
    const bf16_t* src = A.projb + ((size_t)b * S + ts0) * PROJ_LD + XBC_OFF + rel;
    float x0[8], x1[8], x2[8];
#pragma unroll
    for (int j = 0; j < 8; ++j) { x0[j] = 0.f; x1[j] = 0.f; x2[j] = 0.f; }
    if (ts0 >= 3) {
        const bf16x8 r0 = *(const bf16x8*)(src - 3 * (ptrdiff_t)PROJ_LD), r1 = *(const bf16x8*)(src - 2 * (ptrdiff_t)PROJ_LD), r2 = *(const bf16x8*)(src - 1 * (ptrdiff_t)PROJ_LD);
#pragma unroll
        for (int j = 0; j < 8; ++j) { x0[j] = bf2f((bf16_t)r0[j]); x1[j] = bf2f((bf16_t)r1[j]); x2[j] = bf2f((bf16_t)r2[j]); } }
    const LAS float* wt = (const LAS float*)(lds + SD_W) + (ch >> 3) * 128;
    bf16x8 rvv[16];
#pragma unroll
    for (int i = 0; i < 16; ++i) rvv[i] = *(const bf16x8*)(src + (size_t)i * PROJ_LD);
#pragma unroll
    for (int i = 0; i < 16; ++i) {
        const bf16x8 rv = rvv[i];
        float x3[8], o[8];
#pragma unroll
        for (int j = 0; j < 8; ++j) { x3[j] = bf2f((bf16_t)rv[j]); const float a = bias[j] + w[0][j] * x0[j] + w[1][j] * x1[j] + w[2][j] * x2[j] + w[3][j] * x3[j]; o[j] = a * __builtin_amdgcn_rcpf(1.f + __builtin_amdgcn_exp2f(-1.4426950408889634f * a)); x0[j] = x1[j]; x1[j] = x2[j]; x2[j] = x3[j]; }
        const int row = tl0 + i;
        if (PHASE_A && ch < 32) { const float sc = wt[row];
#pragma unroll
            for (int j = 0; j < 8; ++j) o[j] *= sc; }
        u32x4 pk; pk.x = pk2(o[0], o[1]); pk.y = pk2(o[2], o[3]); pk.z = pk2(o[4], o[5]); pk.w = pk2(o[6], o[7]);
        if (ch < 32) *(LAS u32x4*)(lds + SD_XS + row * 512 + ((ch ^ ((row & 3) << 2)) << 4)) = pk;
        else if (ch < 48) { const int cc = ch - 32; *(LAS u32x4*)(lds + SD_B + row * 256 + ((PHASE_A ? (cc ^ ((row & 3) << 2)) : (cc ^ (row & 15))) << 4)) = pk; }
        else { const int cc = ch - 48; *(LAS u32x4*)(lds + SD_C + row * 256 + ((cc ^ (row & 15)) << 4)) = pk; }
    }
}
__device__ __forceinline__ bf16x8 tr_frag2(const LAS unsigned char* base, int stride, int r0, int r1, int chunk0, int qq, int pp) {
    const int cl = chunk0 + (pp >> 1);
    const s16x4 lo = __builtin_amdgcn_ds_read_tr16_b64_v4i16((LAS s16x4*)(base + (r0 + qq) * stride + ((cl ^ (qq << 2)) << 4) + 8 * (pp & 1)));
    const s16x4 hi = __builtin_amdgcn_ds_read_tr16_b64_v4i16((LAS s16x4*)(base + (r1 + qq) * stride + ((cl ^ (qq << 2)) << 4) + 8 * (pp & 1)));
    return __builtin_shufflevector(lo, hi, 0, 1, 2, 3, 4, 5, 6, 7);
}
__device__ __forceinline__ void ssd_a_item(LAS unsigned char* lds, const SsdArgs& A, int item) {
    const int tid = tid_fresh(), wid = __builtin_amdgcn_readfirstlane(tid >> 6), lane = tid & 63;
    const int grp = item & 1, c = (item >> 1) & 15, b = item >> 5;
    const int ql = lane & 31, h = lane >> 5, qq = (lane & 15) >> 2, pp = lane & 3, lb2 = (lane >> 4) & 1;
    __syncthreads();
    ssd_dt_acs(lds, A, b, c, grp, wid, lane);
    __syncthreads();
    { LAS float* acs = (LAS float*)(lds + SD_ACS); LAS float* dtl = (LAS float*)(lds + SD_DT); LAS float* wt = (LAS float*)(lds + SD_W);
      const int hh = tid >> 7, t = tid & 127; const float al = acs[hh * 128 + 127];
      wt[hh * 128 + t] = dtl[hh * 128 + t] * __expf(al - acs[hh * 128 + t]);
      if (t == 0) A.alast[(b * 8 + grp * 4 + hh) * NCH + c] = al; }
    __syncthreads();
    ssd_conv<true>(lds, A, b, c, grp, wid, lane);
    __syncthreads();
    const int pb = wid >> 2, nb = wid & 3;
#pragma unroll 1
    for (int hh = 0; hh < 4; ++hh) {
        f32x16 acc;
#pragma unroll
        for (int r = 0; r < 16; ++r) acc[r] = 0.f;
#pragma unroll
        for (int kk = 0; kk < 8; ++kk) {
            const bf16x8 af = tr_frag2(lds + SD_XS, 512, 16 * kk + 8 * h, 16 * kk + 8 * h + 4, hh * 8 + 4 * pb + 2 * lb2, qq, pp);
            const bf16x8 bf = tr_frag2(lds + SD_B, 256, 16 * kk + 8 * h, 16 * kk + 8 * h + 4, 4 * nb + 2 * lb2, qq, pp);
            acc = MFMA32(af, bf, acc); }
        bf16_t* st = A.states + ((size_t)((b * NCH + c) * 8 + grp * 4 + hh) * 64) * 128;
#pragma unroll
        for (int r = 0; r < 16; ++r) st[(32 * pb + AT_CROW(r, h)) * 128 + 32 * nb + ql] = f2bf(acc[r]);
    }
}
__device__ __forceinline__ void ssd_b_item(LAS unsigned char* lds, const SsdArgs& A, int item) {
    const int tid = tid_fresh(), wid = __builtin_amdgcn_readfirstlane(tid >> 6), lane = tid & 63;
    const int grp = item & 1, b = (item >> 1) & 7, c = 15 - (item >> 4);
    const int ql = lane & 31, h = lane >> 5, qq = (lane & 15) >> 2, pp = lane & 3, lb2 = (lane >> 4) & 1;
    const int pb = wid >> 2, lb = wid & 3;
    LAS float* acs = (LAS float*)(lds + SD_ACS); LAS float* dtl = (LAS float*)(lds + SD_DT); LAS float* wp = (LAS float*)(lds + SD_WP);
    __syncthreads();
    ssd_dt_acs(lds, A, b, c, grp, wid, lane);
    if (tid >= 256 && tid < 320) { const int hh = (tid - 256) >> 4, cp = tid & 15; float s = 0.f;
        float al[16];
#pragma unroll
        for (int c2 = 0; c2 < 16; ++c2) al[c2] = A.alast[(b * 8 + grp * 4 + hh) * NCH + c2];
#pragma unroll
        for (int c2 = 0; c2 < 16; ++c2) s += (c2 > cp && c2 < c) ? al[c2] : 0.f;
        wp[hh * 16 + cp] = (cp < c) ? __expf(s) : 0.f; }
    ssd_conv<false>(lds, A, b, c, grp, wid, lane);
    __syncthreads();
#pragma unroll 1
    for (int hh = 0; hh < 4; ++hh) {
        const int hd = grp * 4 + hh;
        { float pv[16];
#pragma unroll
          for (int j = 0; j < 16; ++j) pv[j] = 0.f;
          const int p = tid >> 3, n0 = (tid & 7) * 16;
          const bf16_t* sp0 = A.states + ((size_t)((b * NCH) * 8 + hd) * 64 + p) * 128 + n0;
#pragma unroll
          for (int g8 = 0; g8 < 2; ++g8) {
              if (g8 * 8 < c) { bf16x8 s0[8], s1[8];
#pragma unroll
                  for (int u = 0; u < 8; ++u) { const bf16_t* sp = sp0 + (size_t)(g8 * 8 + u) * (8 * 64 * 128); s0[u] = *(const bf16x8*)sp; s1[u] = *(const bf16x8*)(sp + 8); }
#pragma unroll
                  for (int u = 0; u < 8; ++u) { const float wgt = wp[hh * 16 + g8 * 8 + u];
                      if (wgt != 0.f) {
#pragma unroll
                          for (int j = 0; j < 8; ++j) { pv[j] += wgt * bf2f((bf16_t)s0[u][j]); pv[8 + j] += wgt * bf2f((bf16_t)s1[u][j]); } } } } }
          LAS unsigned char* pbuf = lds + SD_PREV + p * 256;
          *(LAS u32x4*)(pbuf + ((((n0 >> 3)) ^ (p & 15)) << 4)) = (u32x4){pk2(pv[0], pv[1]), pk2(pv[2], pv[3]), pk2(pv[4], pv[5]), pk2(pv[6], pv[7])};
          *(LAS u32x4*)(pbuf + ((((n0 >> 3) + 1) ^ (p & 15)) << 4)) = (u32x4){pk2(pv[8], pv[9]), pk2(pv[10], pv[11]), pk2(pv[12], pv[13]), pk2(pv[14], pv[15])}; }
        __syncthreads();
        f32x16 acc;
#pragma unroll
        for (int r = 0; r < 16; ++r) acc[r] = 0.f;
#pragma unroll
        for (int kk = 0; kk < 8; ++kk) {
            const bf16x8 af = *(const LAS bf16x8*)(lds + SD_PREV + (32 * pb + ql) * 256 + (((2 * kk + h) ^ (ql & 15)) << 4));
            const bf16x8 bf = *(const LAS bf16x8*)(lds + SD_C + (32 * lb + ql) * 256 + (((2 * kk + h) ^ (ql & 15)) << 4));
            acc = MFMA32(af, bf, acc); }
        const float al = acs[hh * 128 + 32 * lb + ql];
        { const float e = __expf(al);
#pragma unroll
          for (int r = 0; r < 16; ++r) acc[r] *= e; }
        const float Dh = A.d_skip[hd]; const float al2 = al * 1.4426950408889634f; const LAS float* lw = (const LAS float*)(lds + SD_W);
#pragma unroll
        for (int sb = 0; sb < 4; ++sb) {
            if (sb <= lb) {
                f32x16 Pm;
#pragma unroll
                for (int r = 0; r < 16; ++r) Pm[r] = 0.f;
#pragma unroll
                for (int kk = 0; kk < 8; ++kk) {
                    const bf16x8 gf = *(const LAS bf16x8*)(lds + SD_B + (32 * sb + ql) * 256 + (((2 * kk + h) ^ (ql & 15)) << 4));
                    const bf16x8 cf = *(const LAS bf16x8*)(lds + SD_C + (32 * lb + ql) * 256 + (((2 * kk + h) ^ (ql & 15)) << 4));
                    Pm = MFMA32(gf, cf, Pm); }
#pragma unroll
                for (int r = 0; r < 16; ++r) { const int sl = 32 * sb + AT_CROW(r, h), ll = 32 * lb + ql;
                    float v = Pm[r] * __builtin_amdgcn_exp2f(al2 + lw[hh * 128 + sl]); v = (sl <= ll) ? v : 0.f; v += (sl == ll) ? Dh : 0.f; Pm[r] = v; }
#pragma unroll
                for (int sp = 0; sp < 2; ++sp) { const bf16x8 pf = AT_PACK8(Pm, sp);
                    const bf16x8 af = tr_frag2(lds + SD_XS, 512, 32 * sb + 16 * sp + 4 * h, 32 * sb + 16 * sp + 8 + 4 * h, hh * 8 + 4 * pb + 2 * lb2, qq, pp);
                    acc = MFMA32(af, pf, acc); } }
        }
        { const bf16_t* zp = A.projb + ((size_t)b * S + c * 128 + 32 * lb + ql) * PROJ_LD + Z_OFF + hd * 64 + 32 * pb + 4 * h;
#pragma unroll
          for (int qd = 0; qd < 4; ++qd) { const u32x2 zz = *(const u32x2*)(zp + 8 * qd);
              const float z0 = __uint_as_float(zz.x << 16), z1 = __uint_as_float(zz.x & 0xffff0000u), z2 = __uint_as_float(zz.y << 16), z3 = __uint_as_float(zz.y & 0xffff0000u);
              acc[4 * qd] *= z0 * __builtin_amdgcn_rcpf(1.f + __builtin_amdgcn_exp2f(-1.4426950408889634f * z0)); acc[4 * qd + 1] *= z1 * __builtin_amdgcn_rcpf(1.f + __builtin_amdgcn_exp2f(-1.4426950408889634f * z1));
              acc[4 * qd + 2] *= z2 * __builtin_amdgcn_rcpf(1.f + __builtin_amdgcn_exp2f(-1.4426950408889634f * z2)); acc[4 * qd + 3] *= z3 * __builtin_amdgcn_rcpf(1.f + __builtin_amdgcn_exp2f(-1.4426950408889634f * z3)); } }
        __syncthreads();
#pragma unroll
        for (int qd = 0; qd < 4; ++qd) { const int row = 32 * lb + ql, chn = hh * 8 + 4 * pb + qd;
            *(LAS u32x2*)(lds + SD_XS + row * 512 + ((chn ^ ((row & 3) << 2)) << 4) + 8 * h) = (u32x2){pk2(acc[4 * qd], acc[4 * qd + 1]), pk2(acc[4 * qd + 2], acc[4 * qd + 3])}; }
    }
    __syncthreads();
    int widn = wid; asm volatile("" : "+s"(widn));
#pragma unroll 1
    for (int i0 = 0; i0 < 16; i0 += 8) { u32x2 v[8]; float sq[8]; const int chn = lane >> 1;
#pragma unroll
        for (int i = 0; i < 8; ++i) { const int row = widn + 8 * (i0 + i);
            v[i] = *(const LAS u32x2*)(lds + SD_XS + row * 512 + ((chn ^ ((row & 3) << 2)) << 4) + 8 * (lane & 1));
            const float f0 = __uint_as_float(v[i].x << 16), f1 = __uint_as_float(v[i].x & 0xffff0000u), f2 = __uint_as_float(v[i].y << 16), f3 = __uint_as_float(v[i].y & 0xffff0000u);
            sq[i] = (f0 * f0 + f1 * f1) + (f2 * f2 + f3 * f3); }
#pragma unroll
        for (int o = 1; o < 64; o <<= 1) {
#pragma unroll
            for (int i = 0; i < 8; ++i) sq[i] += __shfl_xor(sq[i], o); }
#pragma unroll
        for (int i = 0; i < 8; ++i) { const int row = widn + 8 * (i0 + i); const float rs = rsqrtf(sq[i] * (1.f / 256.f) + 1e-6f);
            const float f0 = __uint_as_float(v[i].x << 16), f1 = __uint_as_float(v[i].x & 0xffff0000u), f2 = __uint_as_float(v[i].y << 16), f3 = __uint_as_float(v[i].y & 0xffff0000u);
            *(u32x2*)(A.catb + ((size_t)b * S + c * 128 + row) * 1024 + 512 + grp * 256 + lane * 4) = (u32x2){pk2(f0 * rs, f1 * rs), pk2(f2 * rs, f3 * rs)}; } }
}
}
namespace mk {
__device__ __forceinline__ void rms_row_bf16(const float* xr, bf16_t* o, int lane) {
    f32x4 v[4]; float s = 0.f;
#pragma unroll
    for (int j = 0; j < 4; ++j) { v[j] = *(const f32x4*)(xr + lane * 4 + 256 * j); s += (v[j][0] * v[j][0] + v[j][1] * v[j][1]) + (v[j][2] * v[j][2] + v[j][3] * v[j][3]); }
    s = wsum(s); const float rs = rsqrtf(s * (1.f / 1024.f) + 1e-6f);
#pragma unroll
    for (int j = 0; j < 4; ++j) *(u32x2*)(o + lane * 4 + 256 * j) = (u32x2){pk2(v[j][0] * rs, v[j][1] * rs), pk2(v[j][2] * rs, v[j][3] * rs)};
}
constexpr int WT_PITCH = 68, WT_TILE_BYTES = 64 * WT_PITCH * 4;
template <bool OUT8>
__device__ __forceinline__ void wt_tile(bool dry, const float* W, void* WTv, const float* gk1, const float* gk2, int ksplit, int K, int N, int NP, int mode, int nscale, float sc, int ntn, int ntk,
                                        int tile, LAS float* tl, int lane) {
    const int per = ntn * ntk, z = tile / per, rem = tile % per, n0 = (rem % ntn) * 64;
    const float* Wz = W + (size_t)z * K * N;
  for (int sub = 0; sub < (OUT8 ? 2 : 1); ++sub) {
    const int k0 = ((rem / ntn) * (OUT8 ? 2 : 1) + sub) * 64;
    const int lr = lane >> 4, lc = (lane & 15) * 4;
    f32x4 v[16];
#pragma unroll
    for (int i = 0; i < 16; ++i) { const int k = k0 + 4 * i + lr, n = n0 + lc; v[i] = (n < N) ? *(const f32x4*)(Wz + (size_t)k * N + n) : (f32x4){0.f, 0.f, 0.f, 0.f}; }
    if (gk1) {
#pragma unroll
        for (int i = 0; i < 16; ++i) { const int k = k0 + 4 * i + lr; const float g = (k < ksplit) ? gk1[k] : gk2[k - ksplit]; v[i] = v[i] * g; } }
#pragma unroll
    for (int i = 0; i < 16; ++i) { const int kk = 4 * i + lr; const int sw = OUT8 ? (((kk >> 4) & 3) << 3) : (((kk >> 3) & 7) << 2); *(LAS f32x4*)(tl + kk * WT_PITCH + (lc ^ sw)) = v[i]; }
    asm volatile("s_waitcnt lgkmcnt(0)" ::: "memory");
    if constexpr (OUT8) {
        const int kq = lane & 3; f8_t* WTz = (f8_t*)WTv + (size_t)z * NP * K;
#pragma unroll
        for (int it = 0; it < 4; ++it) { const int nl = 16 * it + (lane >> 2), n = n0 + nl; const float s = (n < nscale) ? sc : 1.f;
            int nm = n; if (mode == 1) { const int up = n >> 10, jj = n & 1023; nm = (jj >> 7) * 256 + up * 128 + (jj & 127); }
            const LAS float* src = tl + (16 * kq) * WT_PITCH + (nl ^ (kq << 3));
            u32x4 w;
            w.x = pk4_fp8(src[0] * s, src[WT_PITCH] * s, src[2 * WT_PITCH] * s, src[3 * WT_PITCH] * s); w.y = pk4_fp8(src[4 * WT_PITCH] * s, src[5 * WT_PITCH] * s, src[6 * WT_PITCH] * s, src[7 * WT_PITCH] * s);
            w.z = pk4_fp8(src[8 * WT_PITCH] * s, src[9 * WT_PITCH] * s, src[10 * WT_PITCH] * s, src[11 * WT_PITCH] * s); w.w = pk4_fp8(src[12 * WT_PITCH] * s, src[13 * WT_PITCH] * s, src[14 * WT_PITCH] * s, src[15 * WT_PITCH] * s);
            if (dry) { asm volatile("" :: "v"(w)); continue; }
            *(u32x4*)(WTz + (size_t)nm * K + k0 + 16 * kq) = w; }
    } else {
        const int kq = lane & 7; bf16_t* WTz = (bf16_t*)WTv + (size_t)z * NP * K;
#pragma unroll
        for (int it = 0; it < 8; ++it) { const int nl = 8 * it + (lane >> 3), n = n0 + nl; const float s = (n < nscale) ? sc : 1.f;
            int nm = n; if (mode == 1) { const int up = n >> 10, jj = n & 1023; nm = (jj >> 7) * 256 + up * 128 + (jj & 127); }
            const LAS float* src = tl + (8 * kq) * WT_PITCH + (nl ^ (kq << 2));
            u32x4 w; w.x = pk2(src[0] * s, src[WT_PITCH] * s); w.y = pk2(src[2 * WT_PITCH] * s, src[3 * WT_PITCH] * s); w.z = pk2(src[4 * WT_PITCH] * s, src[5 * WT_PITCH] * s); w.w = pk2(src[6 * WT_PITCH] * s, src[7 * WT_PITCH] * s);
            *(u32x4*)(WTz + (size_t)nm * K + k0 + 8 * kq) = w; }
    }
    asm volatile("s_waitcnt lgkmcnt(0)" ::: "memory");
  }
}
constexpr int CP_KX = 0  , CP_RED = 69632  , CP_HID = CP_RED + 32768  , CP_END = CP_HID + 8192 + 256;
struct CmpArgs { const bf16_t* projb; const bf16_t* w1T; const float* posb; const float* w2; bf16_t* kc; bf16_t* vc; };
__device__ __forceinline__ void cmp_item(LAS unsigned char* lds, const CmpArgs& A, int item) {
    const int tid = tid_fresh(), wid = __builtin_amdgcn_readfirstlane(tid >> 6), lane = tid & 63, ql = lane & 31, h = lane >> 5;
    const int cblk = item & 3, kvh = (item >> 2) & 1, b = (item >> 3) & 7, j = item >> 6;
    __syncthreads();
    { const int tok0 = 512 * cblk; const bf16_t* src = A.projb + ((size_t)b * S + tok0) * PROJ_LD + 512 + j * 128 + kvh * 64;
      for (int i = tid; i < 528 * 8; i += 512) { const int r = i >> 3, ch = i & 7; u32x4 v = (u32x4){0u, 0u, 0u, 0u};
          if (tok0 + r < S) v = *(const u32x4*)(src + (size_t)r * PROJ_LD + ch * 8);
          *(LAS u32x4*)(lds + CP_KX + r * 128 + ((ch ^ ((r >> 4) & 7)) << 4)) = v; } }
    if (tid < 64) { float a = 0.f;
#pragma unroll 16
        for (int sl = 0; sl < 64; ++sl) a += A.posb[(j * 64 + sl) * 64 + tid];
        ((LAS float*)(lds + CP_HID))[2048 + tid] = a; }
    __syncthreads();
    const int nb = wid & 1, kq = wid >> 1;
    f32x16 acc;
#pragma unroll
    for (int r = 0; r < 16; ++r) acc[r] = 0.f;
    const bf16_t* wrow = A.w1T + ((size_t)j * 64 + 32 * nb + ql) * 2048;
#pragma unroll 2
    for (int li = 0; li < 8; ++li) { const int l = 8 * kq + li;
#pragma unroll
        for (int s = 0; s < 4; ++s) {
            const int row = 16 * ql + l;
            const bf16x8 af = *(const LAS bf16x8*)(lds + CP_KX + row * 128 + (((2 * s + h) ^ ((row >> 4) & 7)) << 4));
            const bf16x8 bf = *(const bf16x8*)(wrow + l * 64 + 16 * s + 8 * h);
            acc = MFMA32(af, bf, acc); } }
    { LAS float* red = (LAS float*)(lds + CP_RED) + kq * 2048;
#pragma unroll
      for (int r = 0; r < 16; ++r) red[AT_CROW(r, h) * 64 + 32 * nb + ql] = acc[r]; }
    __syncthreads();
    { LAS float* red = (LAS float*)(lds + CP_RED); LAS float* hid = (LAS float*)(lds + CP_HID);
      for (int i = tid; i < 2048; i += 512) { const float a = (red[i] + red[2048 + i]) + (red[4096 + i] + red[6144 + i]) + hid[2048 + (i & 63)]; hid[i] = a * __builtin_amdgcn_rcpf(1.f + __builtin_amdgcn_exp2f(-1.4426950408889634f * a)); } }
    __syncthreads();
    { const LAS float* hid = (const LAS float*)(lds + CP_HID); bf16_t* out = (j ? A.vc : A.kc) + (size_t)(b * 2 + kvh) * 128 * 64;
      for (int i = tid; i < 2048; i += 512) { const int cl = i >> 6, n2 = i & 63; float a = 0.f;
#pragma unroll 8
          for (int n = 0; n < 64; ++n) a += hid[cl * 64 + n] * A.w2[(j * 64 + n) * 64 + n2];
          const int c = 32 * cblk + cl; out[c * 64 + n2] = (c < 127) ? f2bf(a) : (bf16_t)0; } }
}
constexpr int RT_RW = 0;
struct RouteArgs { const bf16_t* h1; const float* ffn_norm; const float* router_w; const float* router_b; f8_t* hn8; int* cnt; int* list; float* wlist; int* tinfo; };
__device__ __forceinline__ void route_phase(LAS unsigned char* lds, const RouteArgs& A, int wg, int nwg) {
    const int tid = tid_fresh(), wid = __builtin_amdgcn_readfirstlane(tid >> 6), lane = tid & 63;
    LAS float* rw = (LAS float*)(lds + RT_RW);
    LAS float* lgt = (LAS float*)(lds + 131072);
    LAS int* lcnt = (LAS int*)(lds + 131072 + 16128); LAS int* gbase = lcnt + 32;
    __syncthreads();
    { f32x4 t4[16];
#pragma unroll
      for (int i = 0; i < 16; ++i) t4[i] = *(const f32x4*)(A.router_w + (size_t)(tid + 512 * i) * 4);
#pragma unroll
      for (int i = 0; i < 16; ++i) { const int q = tid + 512 * i, k = q >> 3, e0 = (q & 7) * 4; const float g = A.ffn_norm[k];
          rw[(e0 + 0) * 1024 + k] = t4[i][0] * g; rw[(e0 + 1) * 1024 + k] = t4[i][1] * g; rw[(e0 + 2) * 1024 + k] = t4[i][2] * g; rw[(e0 + 3) * 1024 + k] = t4[i][3] * g; } }
    if (tid < 32) lcnt[tid] = 0;
    __syncthreads();
    const int ex = ((lane >> 5) & 1) * 16 + ((lane >> 4) & 1) * 8 + ((lane >> 3) & 1) * 4 + ((lane >> 2) & 1) * 2 + ((lane >> 1) & 1);
    const float rbias = A.router_b[ex];
    int it = 0;
    for (int t0 = wg * 8 + wid; t0 < T; t0 += 2 * nwg * 8, it += 2) {
        const int t1 = t0 + nwg * 8; const bool has1 = t1 < T;
        f32x4 va[4], vb[4]; float sa = 0.f, sb = 0.f;
#pragma unroll
        for (int j = 0; j < 4; ++j) { const u32x2 ua = *(const u32x2*)(A.h1 + (size_t)t0 * D + lane * 4 + 256 * j); const u32x2 ub = has1 ? *(const u32x2*)(A.h1 + (size_t)t1 * D + lane * 4 + 256 * j) : (u32x2){0u, 0u};
            va[j] = (f32x4){__uint_as_float(ua.x << 16), __uint_as_float(ua.x & 0xffff0000u), __uint_as_float(ua.y << 16), __uint_as_float(ua.y & 0xffff0000u)};
            vb[j] = (f32x4){__uint_as_float(ub.x << 16), __uint_as_float(ub.x & 0xffff0000u), __uint_as_float(ub.y << 16), __uint_as_float(ub.y & 0xffff0000u)};
            sa += (va[j][0] * va[j][0] + va[j][1] * va[j][1]) + (va[j][2] * va[j][2] + va[j][3] * va[j][3]); sb += (vb[j][0] * vb[j][0] + vb[j][1] * vb[j][1]) + (vb[j][2] * vb[j][2] + vb[j][3] * vb[j][3]); }
#pragma unroll
        for (int o = 1; o < 64; o <<= 1) { sa += __shfl_xor(sa, o); sb += __shfl_xor(sb, o); }
        const float ra = rsqrtf(sa * (1.f / 1024.f) + 1e-6f), rb = rsqrtf(sb * (1.f / 1024.f) + 1e-6f);
#pragma unroll
        for (int j = 0; j < 4; ++j) { va[j] = va[j] * ra; vb[j] = vb[j] * rb; *(unsigned*)(A.hn8 + (size_t)t0 * D + lane * 4 + 256 * j) = pk4_fp8(va[j][0], va[j][1], va[j][2], va[j][3]);
            if (has1) *(unsigned*)(A.hn8 + (size_t)t1 * D + lane * 4 + 256 * j) = pk4_fp8(vb[j][0], vb[j][1], vb[j][2], vb[j][3]); }
        float pa[32], pb[32];
        { f2_t xab[4][4];
#pragma unroll
          for (int j = 0; j < 4; ++j)
#pragma unroll
              for (int i = 0; i < 4; ++i) xab[j][i] = (f2_t){va[j][i], vb[j][i]};
#pragma unroll
          for (int e = 0; e < 32; ++e) { f2_t ac = {0.f, 0.f};
#pragma unroll
              for (int j = 0; j < 4; ++j) { const f32x4 w4 = *(const LAS f32x4*)(rw + e * 1024 + lane * 4 + 256 * j);
#pragma unroll
                  for (int i = 0; i < 4; ++i) ac = __builtin_elementwise_fma(xab[j][i], (f2_t){w4[i], w4[i]}, ac); }
              pa[e] = ac[0]; pb[e] = ac[1];
              if ((e & 3) == 3) __builtin_amdgcn_sched_barrier(0); } }
        float r16a[16], r16b[16];
#pragma unroll
        for (int e = 0; e < 16; ++e) { const bool up = (lane & 32) != 0; r16a[e] = (up ? pa[16 + e] : pa[e]) + __shfl_xor(up ? pa[e] : pa[16 + e], 32); r16b[e] = (up ? pb[16 + e] : pb[e]) + __shfl_xor(up ? pb[e] : pb[16 + e], 32); }
        float r8a[8], r8b[8];
#pragma unroll
        for (int e = 0; e < 8; ++e) { const bool up = (lane & 16) != 0; r8a[e] = (up ? r16a[8 + e] : r16a[e]) + __shfl_xor(up ? r16a[e] : r16a[8 + e], 16); r8b[e] = (up ? r16b[8 + e] : r16b[e]) + __shfl_xor(up ? r16b[e] : r16b[8 + e], 16); }
        float r4a[4], r4b[4];
#pragma unroll
        for (int e = 0; e < 4; ++e) { const bool up = (lane & 8) != 0; r4a[e] = (up ? r8a[4 + e] : r8a[e]) + __shfl_xor(up ? r8a[e] : r8a[4 + e], 8); r4b[e] = (up ? r8b[4 + e] : r8b[e]) + __shfl_xor(up ? r8b[e] : r8b[4 + e], 8); }
        float r2a[2], r2b[2];
#pragma unroll
        for (int e = 0; e < 2; ++e) { const bool up = (lane & 4) != 0; r2a[e] = (up ? r4a[2 + e] : r4a[e]) + __shfl_xor(up ? r4a[e] : r4a[2 + e], 4); r2b[e] = (up ? r4b[2 + e] : r4b[e]) + __shfl_xor(up ? r4b[e] : r4b[2 + e], 4); }
        float r1a, r1b; { const bool up = (lane & 2) != 0; r1a = (up ? r2a[1] : r2a[0]) + __shfl_xor(up ? r2a[0] : r2a[1], 2); r1b = (up ? r2b[1] : r2b[0]) + __shfl_xor(up ? r2b[0] : r2b[1], 2); }
        r1a += __shfl_xor(r1a, 1); r1b += __shfl_xor(r1b, 1);
        if ((lane & 1) == 0) { const int l0 = it * 8 + wid; if (l0 < 112) lgt[l0 * 36 + ex] = r1a + rbias; if (has1 && l0 + 8 < 112) lgt[(l0 + 8) * 36 + ex] = r1b + rbias; }
    }
    __syncthreads();
    const int ntl = (T - wg * 8 + nwg * 8 - 1) / (nwg * 8) * 8;
    int te[4] = {0, 0, 0, 0}, lp[4] = {0, 0, 0, 0}; float tw[4] = {0.f, 0.f, 0.f, 0.f};
    const int tmine = wg * 8 + (tid & 7) + (tid >> 3) * nwg * 8; const bool mine = tid < 112 && tid < ntl && tmine < T;
    if (mine) { float v[32];
#pragma unroll
        for (int e4 = 0; e4 < 8; ++e4) { const f32x4 q4 = *(const LAS f32x4*)(lgt + tid * 36 + e4 * 4); v[e4 * 4] = q4[0]; v[e4 * 4 + 1] = q4[1]; v[e4 * 4 + 2] = q4[2]; v[e4 * 4 + 3] = q4[3]; }
        float tv[4];
#pragma unroll
        for (int k = 0; k < 4; ++k) { float best = -INFINITY; int bi = 0;
#pragma unroll
            for (int e = 0; e < 32; ++e) { const bool bt = v[e] > best; best = bt ? v[e] : best; bi = bt ? e : bi; }
#pragma unroll
            for (int e = 0; e < 32; ++e) v[e] = (e == bi) ? -INFINITY : v[e];
            tv[k] = best; te[k] = bi; }
        const float e1 = __expf(tv[1] - tv[0]), e2 = __expf(tv[2] - tv[0]), e3 = __expf(tv[3] - tv[0]); const float inv = 1.f / (1.f + e1 + e2 + e3);
        tw[0] = inv; tw[1] = e1 * inv; tw[2] = e2 * inv; tw[3] = e3 * inv;
#pragma unroll
        for (int k = 0; k < 4; ++k) lp[k] = __hip_atomic_fetch_add(lcnt + te[k], 1, __ATOMIC_RELAXED, __HIP_MEMORY_SCOPE_WORKGROUP); }
    __syncthreads();
    if (tid < 32) gbase[tid] = (int)__hip_atomic_fetch_add((unsigned*)A.cnt + tid, (unsigned)lcnt[tid], __ATOMIC_RELAXED, __HIP_MEMORY_SCOPE_AGENT);
    __syncthreads();
    if (mine) {
#pragma unroll
        for (int k = 0; k < 4; ++k) { const int e = te[k], pos = gbase[e] + lp[k], tk = tmine * 4 + k;
            A.list[(size_t)e * T + pos] = tk; A.wlist[tk] = tw[k]; A.tinfo[tk] = e | (pos << 8); } }
}
struct CombArgs { const bf16_t* h1; const f8_t* y; const int* tinfo; const float* tw; const int* cnt; const float* g; float* out; };
__device__ __forceinline__ void combine_phase(LAS unsigned char* lds, const CombArgs& A, int wg, int nwg) {
    const int tid = tid_fresh(), wid = __builtin_amdgcn_readfirstlane(tid >> 6), lane = tid & 63;
    LAS int* toff = (LAS int*)(lds + LDS_MISC + 64);
    __syncthreads();
    if (tid == 0) { int a = 0; for (int e = 0; e < NE; ++e) { toff[e] = a; a += (A.cnt[e] + 255) >> 8; } }
    __syncthreads();
    f32x4 gv[4];
#pragma unroll
    for (int j = 0; j < 4; ++j) gv[j] = *(const f32x4*)(A.g + lane * 4 + 256 * j);
    for (int t = wg * 8 + wid; t < T; t += nwg * 8) {
        size_t so[4]; float tw[4];
#pragma unroll
        for (int k = 0; k < 4; ++k) { const int inf = A.tinfo[t * 4 + k]; so[k] = ((size_t)toff[inf & 255] * 256 + (inf >> 8)) * 1024; tw[k] = A.tw[t * 4 + k]; }
        f32x4 v[4]; float s = 0.f;
#pragma unroll
        for (int j = 0; j < 4; ++j) { { const u32x2 uh = *(const u32x2*)(A.h1 + (size_t)t * D + lane * 4 + 256 * j); v[j] = (f32x4){__uint_as_float(uh.x << 16), __uint_as_float(uh.x & 0xffff0000u), __uint_as_float(uh.y << 16), __uint_as_float(uh.y & 0xffff0000u)}; }
#pragma unroll
            for (int k = 0; k < 4; ++k) { const unsigned yy = *(const unsigned*)(A.y + so[k] + lane * 4 + 256 * j);
                const f2_t lo = __builtin_amdgcn_cvt_pk_f32_fp8((int)yy, false), hi = __builtin_amdgcn_cvt_pk_f32_fp8((int)yy, true);
                v[j][0] += tw[k] * lo[0]; v[j][1] += tw[k] * lo[1]; v[j][2] += tw[k] * hi[0]; v[j][3] += tw[k] * hi[1]; }
            s += (v[j][0] * v[j][0] + v[j][1] * v[j][1]) + (v[j][2] * v[j][2] + v[j][3] * v[j][3]); }
        s = wsum(s); const float rs = rsqrtf(s * (1.f / 1024.f) + 1e-6f);
#pragma unroll
        for (int j = 0; j < 4; ++j) *(f32x4*)(A.out + (size_t)t * D + lane * 4 + 256 * j) = v[j] * rs * gv[j];
    }
}
}
#define XB_TMO      128
#define XB_XCNT(j)  (256  + 64 * (j))
#define XB_XSUB(j)  (1280 + 64 * (j))
#define XB_XGEN(j)  (2304 + 64 * (j))
#define XB_TOP      3328
#define XB_TOPGEN   3392
#define XCD_BAR_WORDS 3456
#define XB_SPIN_CAP (1u << 18)
__device__ __forceinline__ unsigned xb_ld(unsigned* p)              { return __hip_atomic_load(p, __ATOMIC_RELAXED, __HIP_MEMORY_SCOPE_AGENT); }
__device__ __forceinline__ unsigned xb_add(unsigned* p, unsigned v) { return __hip_atomic_fetch_add(p, v, __ATOMIC_RELAXED, __HIP_MEMORY_SCOPE_AGENT); }
__device__ __forceinline__ unsigned xb_xcc_id() { return (unsigned)__builtin_amdgcn_s_getreg((3 << 11) | 20) & 0xFu; }
#define XB_SPIN(cond, bar) do { unsigned _sp = 0; while (cond) { __builtin_amdgcn_s_sleep(1); \
    if ((++_sp & 255u) == 0u) { if (xb_ld(&(bar)[XB_TMO])) break; if (_sp > XB_SPIN_CAP) { atomicAdd(&(bar)[XB_TMO], 1u); break; } } } } while (0)
struct XcdBarrier { unsigned* bar; unsigned x; volatile LAS unsigned* st; };
__device__ __forceinline__ XcdBarrier xcd_barrier_post(unsigned* bar, volatile LAS unsigned* st) {
    XcdBarrier b; b.bar = bar; b.x = xb_xcc_id(); b.st = st;
    if (threadIdx.x == 0) (void)xb_add(&bar[XB_XCNT(b.x)], 1u);
    return b;
}
__device__ __forceinline__ void xcd_barrier_complete(unsigned* bar, unsigned x, unsigned& nloc, unsigned& nx) {
    const unsigned G = gridDim.x * gridDim.y * gridDim.z;
    unsigned sum, cnt, mine, sp = 0u;
    for (;;) {
        sum = 0u; cnt = 0u; mine = 0u;
#pragma unroll
        for (unsigned j = 0; j < 16; ++j) { const unsigned c = xb_ld(&bar[XB_XCNT(j)]); sum += c; cnt += (c > 0u) ? 1u : 0u; mine = (j == x) ? c : mine; }
        if (sum == G) break;
        __builtin_amdgcn_s_sleep(1);
        if ((++sp & 255u) == 0u) { if (xb_ld(&bar[XB_TMO])) break; if (sp > XB_SPIN_CAP) { atomicAdd(&bar[XB_TMO], 1u); break; } }
    }
    nloc = mine > 0u ? mine : 1u; nx = cnt > 0u ? cnt : 1u;
}
__device__ __forceinline__ void xcd_barrier(const XcdBarrier& b) {
    asm volatile("s_waitcnt vmcnt(0)" ::: "memory");
    __syncthreads();
    if (threadIdx.x == 0) {
        unsigned* bar = b.bar;
        __builtin_amdgcn_s_waitcnt(0);
        unsigned nloc = b.st[0], nx = b.st[1];
        if (nloc == 0u) { xcd_barrier_complete(bar, b.x, nloc, nx); b.st[0] = nloc; b.st[1] = nx; }
        const unsigned old = xb_add(&bar[XB_XSUB(b.x)], 1u);
        const unsigned gen = old / nloc;
        if (old + 1u == (gen + 1u) * nloc) {
            __builtin_amdgcn_fence(__ATOMIC_RELEASE, "agent");
            asm volatile("s_waitcnt vmcnt(0)" ::: "memory");
            const unsigned og = xb_add(&bar[XB_TOP], 1u);
            const unsigned tg = og / nx;
            if (og + 1u == (tg + 1u) * nx) xb_add(&bar[XB_TOPGEN], 1u);
            else XB_SPIN(xb_ld(&bar[XB_TOPGEN]) == tg, bar);
            __builtin_amdgcn_fence(__ATOMIC_ACQUIRE, "agent");
            xb_add(&bar[XB_XGEN(b.x)], 1u);
            asm volatile("s_waitcnt vmcnt(0)" ::: "memory");
        } else {
            XB_SPIN(xb_ld(&bar[XB_XGEN(b.x)]) == gen, bar);
            __builtin_amdgcn_fence(__ATOMIC_ACQUIRE, "agent");
            asm volatile("s_waitcnt vmcnt(0)" ::: "memory");
        }
    }
    __syncthreads();
}

namespace mk {
constexpr int LDS_BAR = 159744, LDS_FUSED = LDS_BAR + 256;
constexpr int CTL_QUEUE = 4096;
struct Params {
    const float *x, *attn_norm, *w_in, *rel_bias, *cmp_pos, *cmp_w1, *cmp_w2, *attn_out_norm, *conv_w, *conv_b, *dt_bias, *a_log, *d_skip, *ssm_out_norm, *w_out, *ffn_norm,
                *router_w, *router_b, *w_gu, *b_gu, *w_dn, *b_dn, *final_norm;
    float* out; unsigned* ctl; int* cnt;
    bf16_t *xb, *WinT, *WoutT, *w1T, *projb, *catb, *kc, *vc, *states; f8_t *WguT, *WdnT, *hn8, *act, *ymoe;
    float *posb, *alast, *wlist, *ssq; bf16_t* h1; int *list, *tinfo;
    int ph_lo, ph_hi;
};
constexpr int NT_WIN = 48 * 16, NT_WOUT = 16 * 16, NT_WGU = 32 * 32 * 8, NT_WDN = 32 * 16 * 8, NT_W1 = 2 * 32, NT_ALL = NT_WIN + NT_WOUT + NT_WGU + NT_WDN + NT_W1;
__device__ __forceinline__ void p0_prologue(LAS unsigned char* lds, const Params& p, int wg, int nwg, bool dry = false) {
    const int tid = tid_fresh(), wid = __builtin_amdgcn_readfirstlane(tid >> 6), lane = tid & 63;
    for (int r = wg * 8 + wid; r < T; r += nwg * 8) rms_row_bf16(p.x + (size_t)r * D, p.xb + (size_t)r * D, lane);
    for (int o = wg * 8 + wid; o < 128; o += nwg * 8) { const int j = o >> 6, sl = o & 63; float s = 0.f;
#pragma unroll
        for (int kk = 0; kk < 32; ++kk) { const int k = sl * 32 + kk; s += p.cmp_pos[j * 2048 + k] * p.cmp_w1[((size_t)j * 2048 + k) * 64 + lane]; }
        p.posb[o * 64 + lane] = s; }
    LAS float* tl = (LAS float*)(lds + wid * WT_TILE_BYTES);
    __syncthreads();
    for (int task = wg * 8 + wid; task < NT_ALL; task += nwg * 8) { int idx = task;
        if (idx < NT_WIN) { wt_tile<false>(dry, p.w_in, p.WinT, p.attn_norm, p.attn_norm, 1024, 1024, 2848, 3072, 0, 512, 0.125f * LOG2E, 48, 16, idx, tl, lane); continue; } idx -= NT_WIN;
        if (idx < NT_WOUT) { wt_tile<false>(dry, p.w_out, p.WoutT, p.attn_out_norm, p.ssm_out_norm, 512, 1024, 1024, 1024, 0, 0, 1.f, 16, 16, idx, tl, lane); continue; } idx -= NT_WOUT;
        if (idx < NT_WGU) { wt_tile<true>(dry, p.w_gu, p.WguT, p.ffn_norm, p.ffn_norm, 1024, 1024, 2048, 2048, 1, 2048, W8_SCALE, 32, 8, idx, tl, lane); continue; } idx -= NT_WGU;
        if (idx < NT_WDN) { wt_tile<true>(dry, p.w_dn, p.WdnT, nullptr, nullptr, 0, 1024, 1024, 1024, 0, 1024, W8_SCALE, 16, 8, idx, tl, lane); continue; } idx -= NT_WDN;
        wt_tile<false>(dry, p.cmp_w1, p.w1T, nullptr, nullptr, 0, 2048, 64, 64, 0, 0, 1.f, 1, 32, idx, tl, lane); }
}

#define MK_PHASE_FN __device__ __forceinline__
MK_PHASE_FN void ph_proj(LAS unsigned char* lds, const bf16_t* xb, const bf16_t* WinT, bf16_t* projb, int wg, int nwg) {
    ProbProj P; P.S.init(T, NPROJ, nwg, wg); P.A = xb; P.Bt = WinT; P.O = projb; gemm_phase(lds, P); }
MK_PHASE_FN void ph_out(LAS unsigned char* lds, const bf16_t* catb, const bf16_t* WoutT, const float* x, bf16_t* h1, const float* ssq, int wg, int nwg) {
    ProbOut P; P.S.init(T, D, nwg, wg); P.A = catb; P.Bt = WoutT; P.R0 = x; P.O = h1; P.ssq = ssq; gemm_phase(lds, P); }
__global__ void __launch_bounds__(512, 2) k_fused(Params p) {
    extern __shared__ __attribute__((aligned(16))) unsigned char dl[];
    LAS unsigned char* lds = (LAS unsigned char*)dl;
    const int wg = blockIdx.x, nwg = gridDim.x; int tid = tid_fresh();
    if (tid < 64) ((LAS unsigned*)(lds + LDS_BAR))[tid] = 0u;
    __syncthreads();
    XcdBarrier bar = xcd_barrier_post(p.ctl, (volatile LAS unsigned*)(lds + LDS_BAR));
#ifdef MK_ONLY
#define PH(k) ((k) == MK_ONLY && p.ph_lo <= (k) && (k) < p.ph_hi)
#else
#define PH(k) (p.ph_lo <= (k) && (k) < p.ph_hi)
#endif
#ifdef MK_REPEAT
#define REP(k) for (int _rep = 0; _rep < ((k) == MK_REPEAT ? 2 : 1); ++_rep)
#else
#define REP(k)
#endif
#ifdef MK_REPEAT
#define QREP _rep
#else
#define QREP 0
#endif
#ifdef MK_BARX2
#define SEAM(k) do { if (PH(k) && PH((k) + 1)) { xcd_barrier(bar); xcd_barrier(bar); } } while (0)
#else
#define SEAM(k) do { if (PH(k) && PH((k) + 1)) xcd_barrier(bar); } while (0)
#endif
    if (PH(0)) { p0_prologue(lds, p, wg, nwg);
#ifdef MK_P0X2
        __syncthreads(); p0_prologue(lds, p, wg, nwg, MK_P0X2 == 2);
#endif
    }
    SEAM(0);
    REP(1) if (PH(1)) ph_proj(lds, p.xb, p.WinT, p.projb, wg, nwg);
    SEAM(1);
    REP(2) if (PH(2)) {
        const SsdArgs SA{p.projb, p.conv_w, p.conv_b, p.dt_bias, p.a_log, p.d_skip, p.states, p.alast, p.catb};
        const CmpArgs CA{p.projb, p.w1T, p.posb, p.cmp_w2, p.kc, p.vc};
        for (int it = wg; it < 384; it += nwg) { const int v = 383 - it; if (v < 128) cmp_item(lds, CA, v); else ssd_a_item(lds, SA, v - 128); }
    }
    SEAM(2);
    REP(3) if (PH(3)) {
        const SsdArgs SA{p.projb, p.conv_w, p.conv_b, p.dt_bias, p.a_log, p.d_skip, p.states, p.alast, p.catb};
        const AttnArgs AA{p.projb, p.kc, p.vc, p.catb, p.ssq};
        bool btab_ok = false;
        LAS int* qslot = (LAS int*)(lds + LDS_BAR + 64);
        for (;;) {
            __syncthreads();
            if (tid_fresh() == 0) qslot[0] = (int)__hip_atomic_fetch_add(p.ctl + CTL_QUEUE + 64 * QREP, 1u, __ATOMIC_RELAXED, __HIP_MEMORY_SCOPE_AGENT);
            __syncthreads();
            const int it = qslot[0];
#if defined(MK_QX_ATTN)
            if (it >= 768 + 512) break;
            { const int i2 = it >= 768 ? it - 768 : it; if (i2 < 512) { if (!btab_ok) { attn_btab(lds, p.rel_bias); btab_ok = true; } attn_item(lds, AA, i2 & 7, 31 - (i2 >> 4), (i2 >> 3) & 1); } else { ssd_b_item(lds, SA, i2 - 512); btab_ok = false; } }
#elif defined(MK_QX_SSDB)
            if (it >= 768 + 256) break;
            { const int i2 = it >= 768 ? it - 256 : it; if (i2 < 512) attn_item(lds, AA, i2 & 7, 31 - (i2 >> 4), (i2 >> 3) & 1); else ssd_b_item(lds, SA, i2 - 512); }
#else
#if defined(MK_QX_BOTH)
            if (it >= 1536) break;
            { const int i2 = it >= 768 ? it - 768 : it; if (i2 < 512) { if (!btab_ok) { attn_btab(lds, p.rel_bias); btab_ok = true; } attn_item(lds, AA, i2 & 7, 31 - (i2 >> 4), (i2 >> 3) & 1); } else { ssd_b_item(lds, SA, i2 - 512); btab_ok = false; } }
#else
            if (it >= 768) break;
            if (it < 512) { if (!btab_ok) { attn_btab(lds, p.rel_bias); btab_ok = true; } attn_item(lds, AA, it & 7, 31 - (it >> 4), (it >> 3) & 1); } else { ssd_b_item(lds, SA, it - 512); btab_ok = false; }
#endif
#endif
        }
    }
    SEAM(3);
    REP(4) if (PH(4)) ph_out(lds, p.catb, p.WoutT, p.x, p.h1, p.ssq, wg, nwg);
    SEAM(4);
    REP(5) if (PH(5)) { const bool dm = QREP != 0; const RouteArgs RA{p.h1, p.ffn_norm, p.router_w, p.router_b, p.hn8, dm ? p.cnt + 64 : p.cnt, dm ? (int*)p.act : p.list, dm ? (float*)p.act + (4u << 20) : p.wlist, dm ? (int*)p.act + (8u << 20) : p.tinfo}; route_phase(lds, RA, wg, nwg); }
    SEAM(5);
    REP(6) if (PH(6)) {
        tid = tid_fresh();
        __syncthreads();
        const int RT = moe_tables(lds, p.cnt);
        ProbMoe1 P; P.S.nN = 8; P.S.G = nwg; P.S.c = (nwg % 8 == 0) ? (wg & 7) * (nwg >> 3) + (wg >> 3) : wg; P.S.RT = RT; P.S.tile_e = (const LAS int*)(lds + LDS_TILE_E); P.S.tile_m = (const LAS int*)(lds + LDS_TILE_M);
        P.A = p.hn8; P.Bt = p.WguT; P.btab = (const LAS float*)(lds + LDS_BIASTAB); P.O = p.act; P.rowtab = (const LAS unsigned*)(lds + LDS_ROWTAB);
        LAS unsigned* rowtab = (LAS unsigned*)(lds + LDS_ROWTAB);
#pragma unroll 1
        for (int i = 0; i < 12; ++i) { Unit u; if (!P.S.next(i, u)) break; if (tid < 256) { const int pos = u.mt * 256 + tid; const int c = p.cnt[u.e];
            const int tok = (pos < c) ? (p.list[(size_t)u.e * T + pos] >> 2) : 0; rowtab[i * 256 + tid] = (unsigned)tok * KD; }
            else { const int j = tid - 256; ((LAS float*)(lds + LDS_BIASTAB))[i * 256 + j] = p.b_gu[u.e * 2048 + (j >> 7) * 1024 + u.pn * 128 + (j & 127)]; } }
        __syncthreads();
        gemm_phase(lds, P);
    }
    SEAM(6);
    REP(7) if (PH(7)) {
        __syncthreads();
        const int RT = moe_tables(lds, p.cnt);
        ProbMoe2 P; P.S.nN = 4; P.S.G = nwg; P.S.c = (nwg % 8 == 0) ? (wg & 7) * (nwg >> 3) + (wg >> 3) : wg; P.S.RT = RT; P.S.tile_e = (const LAS int*)(lds + LDS_TILE_E); P.S.tile_m = (const LAS int*)(lds + LDS_TILE_M);
        P.A = p.act; P.Bt = p.WdnT; P.btab = (const LAS float*)(lds + LDS_BIASTAB); P.O = p.ymoe;
#pragma unroll 1
        for (int i = 0; i < 12; ++i) { Unit u; if (!P.S.next(i, u)) break; if (tid_fresh() < 256) ((LAS float*)(lds + LDS_BIASTAB))[i * 256 + tid_fresh()] = p.b_dn[u.e * 1024 + u.pn * 256 + tid_fresh()]; }
        __syncthreads();
        gemm_phase(lds, P);
    }
    SEAM(7);
    REP(8) if (PH(8)) { const CombArgs CA{p.h1, p.ymoe, p.tinfo, p.wlist, p.cnt, p.final_norm, p.out}; combine_phase(lds, CA, wg, nwg); }
#undef PH
#undef SEAM
}
}

extern "C" void kernel_launch(void* const* d_in, const int* in_sizes, int n_in, void* d_out, int out_size, void* d_ws, size_t ws_size, hipStream_t stream) {
    using namespace mk;
    char* ws = (char*)d_ws; const size_t MB = 1u << 20;
    size_t o = 0; auto take = [&](size_t mb) { char* q = ws + o; o += mb * MB; return q; };
    Params p;
    memset(&p, 0, sizeof(p));
    const float** fin = (const float**)&p.x;
    for (int i = 0; i < 23; ++i) fin[i] = (const float*)d_in[i];
    p.out = (float*)d_out;
    p.ctl = (unsigned*)take(1); p.cnt = (int*)(p.ctl + 8192);
    p.xb = (bf16_t*)take(32); p.WinT = (bf16_t*)take(6); p.WoutT = (bf16_t*)take(2); p.WguT = (f8_t*)take(64); p.WdnT = (f8_t*)take(32); p.w1T = (bf16_t*)take(1);
    p.projb = (bf16_t*)take(96); p.catb = (bf16_t*)take(32); p.hn8 = (f8_t*)take(16); p.kc = (bf16_t*)take(1); p.vc = (bf16_t*)take(1); p.states = (bf16_t*)take(16);
    p.act = (f8_t*)take(72); p.ymoe = (f8_t*)take(72);
    p.posb = (float*)take(1); p.alast = (float*)take(1); p.ssq = (float*)take(1); p.h1 = (bf16_t*)take(32); p.wlist = (float*)take(2); p.list = (int*)take(2); p.tinfo = (int*)take(1);
    static int grid = 0;
    if (!grid) {
        int dev = 0, cus = 0, per_cu = 0;
        (void)hipGetDevice(&dev); (void)hipDeviceGetAttribute(&cus, hipDeviceAttributeMultiprocessorCount, dev);
        (void)hipFuncSetAttribute((const void*)k_fused, hipFuncAttributeMaxDynamicSharedMemorySize, LDS_FUSED);
        (void)hipOccupancyMaxActiveBlocksPerMultiprocessor(&per_cu, (const void*)k_fused, 512, LDS_FUSED);
        (void)hipGetLastError();
        grid = cus > 0 ? cus : 256;
    }
    (void)hipMemsetAsync(p.ctl, 0, 65536, stream);
#ifndef MK_SPLIT
    p.ph_lo = 0; p.ph_hi = 9;
    hipLaunchKernelGGL(k_fused, dim3(grid), dim3(512), LDS_FUSED, stream, p);
#else
    for (int k = 0; k < 9; ++k) { p.ph_lo = k; p.ph_hi = k + 1; hipLaunchKernelGGL(k_fused, dim3(grid), dim3(512), LDS_FUSED, stream, p); }
#endif
}
```

```cpp
#include <hip/hip_runtime.h>
#include <stdint.h>
#include <string.h>
#include <math.h>
namespace mk {
#define LAS __attribute__((address_space(3)))
typedef unsigned short bf16_t;
typedef short bf16x8 __attribute__((ext_vector_type(8)));
typedef float f32x4 __attribute__((ext_vector_type(4)));
typedef unsigned u32x4 __attribute__((ext_vector_type(4)));
typedef unsigned u32x2 __attribute__((ext_vector_type(2)));
typedef float f2_t __attribute__((ext_vector_type(2)));
constexpr int NB = 8, S = 2048, D = 1024, T = NB * S, NE = 32;
constexpr int BM = 256, BK = 64, HALF = 128, HTB = HALF * BK * 2, STAGE_BYTES = 8 * HTB, NXCD = 8, WGM = 8;
constexpr int CNT_STRIDE = 32;
constexpr int KD = 1024;
constexpr int NPROJ = 3072;
constexpr int MAXSLOT = 65536 + 32 * 256;
constexpr int LDS_MISC = 131072, LDS_TILE_E = LDS_MISC + 64, LDS_TILE_M = LDS_TILE_E + 1536, LDS_CNT = LDS_MISC + 3200, LDS_ROWTAB = LDS_MISC + 4096, LDS_BIASTAB = LDS_ROWTAB + 12 * 1024, LDS_BYTES = LDS_BIASTAB + 12 * 1024;

__host__ __device__ __forceinline__ int lds_byte(int r, int c) { const int st = (r >> 4) * 2 + (c >> 5), rr = r & 15, cc = c & 31, ob = rr * 64 + cc * 2; return st * 1024 + (ob ^ (((ob >> 9) & 1) << 5)); }
__host__ __device__ __forceinline__ void stage_rc(int b, int& R, int& C) { const int st = b / 1024, sb = b % 1024, swz = sb ^ (((sb >> 9) & 1) << 5); R = (st >> 1) * 16 + swz / 64; C = (st & 1) * 32 + (swz % 64) / 2; }
__host__ __device__ __forceinline__ int perm32(int rho) { const int n = rho >> 4, i = rho & 15; return 8 * (i >> 2) + 4 * n + (i & 3); }
__device__ __forceinline__ unsigned cvt_pk_bf16(float lo, float hi) { unsigned r; asm volatile("v_cvt_pk_bf16_f32 %0, %1, %2" : "=v"(r) : "v"(lo), "v"(hi)); return r; }
__device__ __forceinline__ int tid_fresh() { int t = threadIdx.x; asm volatile("" : "+v"(t)); return t; }
__device__ __forceinline__ float bf2f(bf16_t b) { return __uint_as_float(((unsigned)b) << 16); }

struct Unit { int pm, pn, e, mt, li; };
struct StaticOrder {
    int nM, nN, nwg, G, c;
    __device__ __forceinline__ void init(int M, int N, int G_, int c_) { nM = M / BM; nN = N / BM; nwg = nM * nN; G = G_; c = c_; }
    __device__ __forceinline__ bool next(int i, Unit& u) const {
        const long L = (long)i * G + c; if (L >= nwg) return false;
        int wgid = (int)L; { const int q = nwg / NXCD, r = nwg % NXCD, xcd = wgid % NXCD, off = wgid / NXCD; wgid = (xcd < r ? xcd * (q + 1) : r * (q + 1) + (xcd - r) * q) + off; }
        const int nig = WGM * nN, gid = wgid / nig, fm = gid * WGM, gsz = (nM - fm) < WGM ? (nM - fm) : WGM;
        u.pm = fm + ((wgid % nig) % gsz); u.pn = (wgid % nig) / gsz; u.e = 0; u.mt = 0; u.li = i; return true;
    }
};
struct MoeOrder {
    int nN, G, c, RT; const LAS int* tile_e; const LAS int* tile_m;
    __device__ __forceinline__ bool next(int i, Unit& u) const { const int L = i * G + c; if (L >= RT * nN) return false; const int rt = L / nN; u.pm = rt; u.pn = L - rt * nN; u.e = tile_e[rt]; u.mt = tile_m[rt]; u.li = i; return true; }
};

struct ProbProj {
    static constexpr bool F8 = false, MIDSCALE = false; static constexpr int PERM = 2, ROWB = KD * 2;
    StaticOrder S; const bf16_t* A; const bf16_t* Bt; bf16_t* O;
    __device__ __forceinline__ bool next(int i, Unit& u) const { return S.next(i, u); }
    __device__ __forceinline__ const char* a_base(const Unit& u) const { return (const char*)A + (size_t)u.pm * (BM * KD * 2); }
    __device__ __forceinline__ const char* b_base(const Unit& u) const { return (const char*)Bt + (size_t)u.pn * (BM * KD * 2); }
    __device__ __forceinline__ void a_offs(int, const Unit&, unsigned (&v0)[2], unsigned (&v1)[2], const int (&R)[2], const int (&C)[2]) const {
#pragma unroll
        for (int i = 0; i < 2; ++i) { v0[i] = (unsigned)(R[i] * KD + C[i]) * 2u; v1[i] = v0[i] + (unsigned)(HALF * KD * 2); } }
    __device__ __forceinline__ void epi(const f32x4 (&acc)[2][2][4][2], const Unit& u, int wr, int wc, int fr, int fq) const {
        const int row0 = u.pm * BM + wr * 64 + fr, col0 = u.pn * BM + wc * 64 + 16 * fq;
#pragma unroll
        for (int ai = 0; ai < 2; ++ai)
#pragma unroll
            for (int m = 0; m < 4; ++m) { bf16_t* rowp = O + (size_t)(row0 + ai * HALF + m * 16) * NPROJ + col0;
#pragma unroll
                for (int bj = 0; bj < 2; ++bj) { const f32x4 v0 = acc[ai][bj][m][0], v1 = acc[ai][bj][m][1]; u32x4 w;
                    w.x = cvt_pk_bf16(v0[0], v0[1]); w.y = cvt_pk_bf16(v0[2], v0[3]); w.z = cvt_pk_bf16(v1[0], v1[1]); w.w = cvt_pk_bf16(v1[2], v1[3]);
                    *(u32x4*)(rowp + bj * 8) = w; } }
    }
};
struct ProbOut {
    static constexpr bool F8 = false, MIDSCALE = true; static constexpr int PERM = 2, ROWB = KD * 2;
    StaticOrder S; const bf16_t* A; const bf16_t* Bt; const float* R0; bf16_t* O; const float* ssq;
    __device__ __forceinline__ void midscale(f32x4 (&acc)[2][2][4][2], const Unit& u, int wr, int fr) const {
        asm volatile("" : "+v"(fr));
#pragma unroll
        for (int ai = 0; ai < 2; ++ai)
#pragma unroll
            for (int m = 0; m < 4; ++m) { const int row = u.pm * BM + ai * HALF + wr * 64 + m * 16 + fr; const f2_t q = *(const f2_t*)(ssq + (size_t)row * 2);
                const float rs = rsqrtf((q[0] + q[1]) * (1.f / 512.f) + 1e-6f);
#pragma unroll
                for (int bj = 0; bj < 2; ++bj)
#pragma unroll
                    for (int n = 0; n < 2; ++n) acc[ai][bj][m][n] = acc[ai][bj][m][n] * rs;
                asm volatile("" ::: "memory"); } }
    __device__ __forceinline__ bool next(int i, Unit& u) const { return S.next(i, u); }
    __device__ __forceinline__ const char* a_base(const Unit& u) const { return (const char*)A + (size_t)u.pm * (BM * KD * 2); }
    __device__ __forceinline__ const char* b_base(const Unit& u) const { return (const char*)Bt + (size_t)u.pn * (BM * KD * 2); }
    __device__ __forceinline__ void a_offs(int, const Unit&, unsigned (&v0)[2], unsigned (&v1)[2], const int (&R)[2], const int (&C)[2]) const {
#pragma unroll
        for (int i = 0; i < 2; ++i) { v0[i] = (unsigned)(R[i] * KD + C[i]) * 2u; v1[i] = v0[i] + (unsigned)(HALF * KD * 2); } }
    __device__ __forceinline__ void epi(const f32x4 (&acc)[2][2][4][2], const Unit& u, int wr, int wc, int fr, int fq) const {
        const int row0 = u.pm * BM + wr * 64 + fr, col0 = u.pn * BM + wc * 64 + 16 * fq;
#pragma unroll
        for (int ai = 0; ai < 2; ++ai)
#pragma unroll
            for (int m = 0; m < 4; ++m) { const size_t off = (size_t)(row0 + ai * HALF + m * 16) * D + col0;
#pragma unroll
                for (int bj = 0; bj < 2; ++bj) { const f32x4 r0 = *(const f32x4*)(R0 + off + bj * 8), r1 = *(const f32x4*)(R0 + off + bj * 8 + 4);
                    const f32x4 o0 = acc[ai][bj][m][0] + r0, o1 = acc[ai][bj][m][1] + r1; u32x4 w;
                    w.x = cvt_pk_bf16(o0[0], o0[1]); w.y = cvt_pk_bf16(o0[2], o0[3]); w.z = cvt_pk_bf16(o1[0], o1[1]); w.w = cvt_pk_bf16(o1[2], o1[3]);
                    *(u32x4*)(O + off + bj * 8) = w; }
                asm volatile("" ::: "memory"); }
    }
};
typedef unsigned char f8_t;
typedef int i32x8 __attribute__((ext_vector_type(8)));
typedef int i32x4 __attribute__((ext_vector_type(4)));
constexpr float W8_SCALE = 32.f, W8_INV = 1.f / 32.f;
__device__ __forceinline__ unsigned pk4_fp8(float a, float b, float c, float d) { int r = __builtin_amdgcn_cvt_pk_fp8_f32(a, b, 0, false); r = __builtin_amdgcn_cvt_pk_fp8_f32(c, d, r, true); return (unsigned)r; }
struct ProbMoe1 {
    static constexpr bool F8 = true, MIDSCALE = false; static constexpr int PERM = 1, ROWB = KD;
    MoeOrder S; const f8_t* A; const f8_t* Bt; const LAS float* btab; f8_t* O; const LAS unsigned* rowtab;
    __device__ __forceinline__ bool next(int i, Unit& u) const { return S.next(i, u); }
    __device__ __forceinline__ const char* a_base(const Unit&) const { return (const char*)A; }
    __device__ __forceinline__ const char* b_base(const Unit& u) const { return (const char*)Bt + ((size_t)u.e * 2048 + (size_t)u.pn * BM) * ROWB; }
    __device__ __forceinline__ void a_offs(int i, const Unit&, unsigned (&v0)[2], unsigned (&v1)[2], const int (&R)[2], const int (&C)[2]) const {
#pragma unroll
        for (int j = 0; j < 2; ++j) { v0[j] = rowtab[i * 256 + R[j]] + (unsigned)C[j] * 2u; v1[j] = rowtab[i * 256 + HALF + R[j]] + (unsigned)C[j] * 2u; } }
    __device__ __forceinline__ void epi(const f32x4 (&acc)[2][2][4][2], const Unit& u, int wr, int wc, int fr, int fq) const {
        const int row0 = u.pm * BM + wr * 64 + fr, jg0 = u.pn * HALF + wc * 32 + 8 * fq;
        f32x4 bg[2], bu[2];
#pragma unroll
        for (int n = 0; n < 2; ++n) { bg[n] = *(const LAS f32x4*)(btab + u.li * 256 + wc * 32 + 8 * fq + 4 * n); bu[n] = *(const LAS f32x4*)(btab + u.li * 256 + 128 + wc * 32 + 8 * fq + 4 * n); }
#pragma unroll
        for (int ai = 0; ai < 2; ++ai)
#pragma unroll
            for (int m = 0; m < 4; ++m) { float o[8];
#pragma unroll
                for (int n = 0; n < 2; ++n) { const f32x4 g4 = acc[ai][0][m][n] * W8_INV + bg[n], u4 = acc[ai][1][m][n] * W8_INV + bu[n];
#pragma unroll
                    for (int j = 0; j < 4; ++j) { const float g = fminf(g4[j], 7.f), uu = __builtin_amdgcn_fmed3f(u4[j], -7.f, 7.f);
                        const float sg = __builtin_amdgcn_rcpf(1.f + __builtin_amdgcn_exp2f(-1.702f * 1.4426950408889634f * g)); o[n * 4 + j] = __builtin_fmaf(uu, g, g) * sg; } }
                *(u32x2*)(O + (size_t)(row0 + ai * HALF + m * 16) * 1024 + jg0) = (u32x2){pk4_fp8(o[0], o[1], o[2], o[3]), pk4_fp8(o[4], o[5], o[6], o[7])}; }
    }
};
struct ProbMoe2 {
    static constexpr bool F8 = true, MIDSCALE = false; static constexpr int PERM = 2, ROWB = KD;
    MoeOrder S; const f8_t* A; const f8_t* Bt; const LAS float* btab; f8_t* O;
    __device__ __forceinline__ bool next(int i, Unit& u) const { return S.next(i, u); }
    __device__ __forceinline__ const char* a_base(const Unit& u) const { return (const char*)A + (size_t)u.pm * (BM * ROWB); }
    __device__ __forceinline__ const char* b_base(const Unit& u) const { return (const char*)Bt + ((size_t)u.e * 1024 + (size_t)u.pn * BM) * ROWB; }
    __device__ __forceinline__ void a_offs(int, const Unit&, unsigned (&v0)[2], unsigned (&v1)[2], const int (&R)[2], const int (&C)[2]) const {
#pragma unroll
        for (int i = 0; i < 2; ++i) { v0[i] = (unsigned)(R[i] * ROWB + C[i] * 2); v1[i] = v0[i] + (unsigned)(HALF * ROWB); } }
    __device__ __forceinline__ void epi(const f32x4 (&acc)[2][2][4][2], const Unit& u, int wr, int wc, int fr, int fq) const {
        const int rl0 = wr * 64 + fr, cl0 = wc * 64 + 16 * fq, col0 = u.pn * BM + cl0;
#pragma unroll
        for (int ai = 0; ai < 2; ++ai)
#pragma unroll
            for (int m = 0; m < 4; ++m) { const int rl = rl0 + ai * HALF + m * 16;
                f8_t* rowp = O + (size_t)(u.pm * BM + rl) * 1024 + col0; u32x4 w; unsigned d[4];
#pragma unroll
                for (int bj = 0; bj < 2; ++bj) { const f32x4 b0 = *(const LAS f32x4*)(btab + u.li * 256 + cl0 + bj * 8), b1 = *(const LAS f32x4*)(btab + u.li * 256 + cl0 + bj * 8 + 4);
                    const f32x4 v0 = acc[ai][bj][m][0] * W8_INV + b0, v1 = acc[ai][bj][m][1] * W8_INV + b1;
                    d[2 * bj] = pk4_fp8(v0[0], v0[1], v0[2], v0[3]); d[2 * bj + 1] = pk4_fp8(v1[0], v1[1], v1[2], v1[3]); }
                w.x = d[0]; w.y = d[1]; w.z = d[2]; w.w = d[3];
                *(u32x4*)rowp = w;
                asm volatile("" ::: "memory"); }
    }
};

template <int N> struct FragBf { bf16x8 v[N][2];
    __device__ __forceinline__ void set(int i, int k, i32x4 x) { v[i][k] = __builtin_bit_cast(bf16x8, x); }
    __device__ __forceinline__ bf16x8 get(int i, int k) const { return v[i][k]; } };
template <int N> struct FragF8 { i32x8 v[N];
    __device__ __forceinline__ void set(int i, int k, i32x4 x) { if (k == 0) v[i].lo = x; else v[i].hi = x; }
    __device__ __forceinline__ bf16x8 get(int, int) const { return bf16x8{}; } };
template <bool F8> struct FragT { typedef FragBf<4> A_t; typedef FragBf<2> B_t; };
template <> struct FragT<true> { typedef FragF8<4> A_t; typedef FragF8<2> B_t; };
template <class P>
__device__ __forceinline__ void gemm_phase(LAS unsigned char* lds, const P& Pb) {
    const int tid = tid_fresh(), wid = __builtin_amdgcn_readfirstlane(tid >> 6), lane = tid & 63, wr = wid >> 2, wc = wid & 3, fr = lane & 15, fq = lane >> 4;
    constexpr int nt = P::ROWB / 128;
    int Rr[2], Cc[2]; unsigned voffB[2];
#pragma unroll
    for (int i = 0; i < 2; ++i) { int R, C; stage_rc(tid * 16 + i * 8192, R, C); const int Rb = (P::PERM == 2) ? ((R >> 5) * 64 + ((R >> 2) & 3) * 16 + ((R >> 4) & 1) * 4 + (R & 3)) : (P::PERM == 1) ? ((R & ~31) + perm32(R & 31)) : R; Rr[i] = R; Cc[i] = C; voffB[i] = (unsigned)(Rb * P::ROWB + C * 2); }
    constexpr size_t kstep = (size_t)(BK * 2);
    constexpr size_t hstep = (size_t)((P::PERM == 2) ? 8 : HALF) * P::ROWB;
    const unsigned ldsw = (unsigned)wid * 1024u;
    const int aoff = lds_byte(wr * 64 + fr, fq * 8), boff = lds_byte(wc * 32 + fr, fq * 8);
#define PG8_SA(b, h) (((b) * 2 + (h)) * HTB)
#define PG8_SB(b, h) ((4 + (b) * 2 + (h)) * HTB)
#define PG8_STAGE(bufoff, gbase, voff) do { _Pragma("unroll") for (int _i = 0; _i < 2; ++_i) \
        __builtin_amdgcn_global_load_lds((const unsigned*)((const char*)(gbase) + (voff)[_i]), (LAS unsigned*)(lds + (bufoff) + ldsw + _i * 8192), 16, 0, 0); } while (0)
#define PG8_LDA(dst, b, h) do { _Pragma("unroll") for (int m = 0; m < 4; ++m) _Pragma("unroll") for (int k = 0; k < 2; ++k) dst.set(m, k, *(const LAS i32x4*)(lds + PG8_SA(b, h) + aoff + m * 2048 + k * 1024)); } while (0)
#define PG8_LDB(dst, b, h) do { _Pragma("unroll") for (int n = 0; n < 2; ++n) _Pragma("unroll") for (int k = 0; k < 2; ++k) dst.set(n, k, *(const LAS i32x4*)(lds + PG8_SB(b, h) + boff + n * 2048 + k * 1024)); } while (0)
#define PG8_MMA(ai, bj, At, Bt) do { __builtin_amdgcn_s_setprio(1); _Pragma("unroll") for (int m = 0; m < 4; ++m) _Pragma("unroll") for (int n = 0; n < 2; ++n) { \
        if constexpr (P::F8) acc[ai][bj][m][n] = __builtin_amdgcn_mfma_scale_f32_16x16x128_f8f6f4(Bt.v[n], At.v[m], acc[ai][bj][m][n], 0, 0, 0, 0x7f7f7f7f, 0, 0x7f7f7f7f); \
        else { _Pragma("unroll") for (int k = 0; k < 2; ++k) acc[ai][bj][m][n] = __builtin_amdgcn_mfma_f32_16x16x32_bf16(Bt.get(n, k), At.get(m, k), acc[ai][bj][m][n], 0, 0, 0); } } \
        __builtin_amdgcn_s_setprio(0); } while (0)
#define PG8_WAIT_V(n) asm volatile("s_waitcnt vmcnt(" #n ")" ::: "memory")
#define PG8_WAIT_L(n) asm volatile("s_waitcnt lgkmcnt(" #n ")" ::: "memory")
#define PG8_BAR __builtin_amdgcn_s_barrier()
#define PG8_SCHED __builtin_amdgcn_sched_barrier(0)
    Unit cur, nxt; int ui = 0;
    if (!Pb.next(0, cur)) return;
    f32x4 acc[2][2][4][2];
#pragma unroll
    for (int a = 0; a < 2; ++a)
#pragma unroll
        for (int b = 0; b < 2; ++b)
#pragma unroll
            for (int m = 0; m < 4; ++m)
#pragma unroll
                for (int n = 0; n < 2; ++n) acc[a][b][m][n] = (f32x4){0.f, 0.f, 0.f, 0.f};
    typedef typename FragT<P::F8>::A_t AFr; typedef typename FragT<P::F8>::B_t BFr;
    AFr At; BFr B0, B1;
    unsigned vA0[2], vA1[2];
    Pb.a_offs(0, cur, vA0, vA1, Rr, Cc);
    const char* cA = Pb.a_base(cur); const char* cB = Pb.b_base(cur);
    PG8_STAGE(PG8_SB(0, 0), cB, voffB); PG8_STAGE(PG8_SB(0, 1), cB + hstep, voffB); PG8_STAGE(PG8_SA(0, 0), cA, vA0); PG8_STAGE(PG8_SA(0, 1), cA, vA1);
    if (wr == 1) PG8_BAR;
    PG8_WAIT_V(2); PG8_BAR;
    PG8_STAGE(PG8_SB(1, 0), cB + kstep, voffB); PG8_STAGE(PG8_SA(1, 0), cA + kstep, vA0); PG8_STAGE(PG8_SB(1, 1), cB + hstep + kstep, voffB);
    PG8_WAIT_V(6); PG8_BAR;
    for (;;) {
        const bool has_next = Pb.next(ui + 1, nxt);
        const char* nA = has_next ? Pb.a_base(nxt) : cA; const char* nB = has_next ? Pb.b_base(nxt) : cB;
#ifdef MK_KX2
#define PG8_NTL (P::F8 ? 2 * nt : nt)
#define PG8_KOF(x) (P::F8 ? ((x) & (nt - 1)) : (x))
#else
#define PG8_NTL nt
#define PG8_KOF(x) (x)
#endif
#define PG8_KITER \
            const bool last = (t == PG8_NTL - 2); \
            if constexpr (P::MIDSCALE) { if (t == 8) Pb.midscale(acc, cur, wr, fr); } \
            const char* a1 = cA + (size_t)PG8_KOF(t + 1) * kstep; \
            const char* a2 = last ? nA : cA + (size_t)PG8_KOF(t + 2) * kstep; const char* b2 = last ? nB : cB + (size_t)PG8_KOF(t + 2) * kstep; \
            const char* a3 = a2 + kstep; const char* b3 = b2 + kstep; \
            PG8_LDB(B0, 0, 0); PG8_LDB(B1, 0, 1); PG8_SCHED; PG8_LDA(At, 0, 0); PG8_STAGE(PG8_SA(1, 1), a1, vA1); \
            PG8_WAIT_V(8); PG8_WAIT_L(0); PG8_BAR; PG8_MMA(0, 0, At, B0); PG8_MMA(0, 1, At, B1); PG8_BAR; PG8_SCHED; \
            if (last && has_next) { \
                if constexpr (P::F8) { int R2[2], C2[2]; int t2 = tid; asm volatile("" : "+v"(t2)); \
_Pragma("unroll") \
                    for (int i = 0; i < 2; ++i) stage_rc(t2 * 16 + i * 8192, R2[i], C2[i]); \
                    Pb.a_offs(ui + 1, nxt, vA0, vA1, R2, C2); } \
                else Pb.a_offs(ui + 1, nxt, vA0, vA1, Rr, Cc); } \
            PG8_LDA(At, 0, 1); PG8_STAGE(PG8_SB(0, 0), b2, voffB); PG8_STAGE(PG8_SB(0, 1), b2 + hstep, voffB); PG8_STAGE(PG8_SA(0, 0), a2, vA0); \
            PG8_WAIT_V(8); PG8_WAIT_L(0); PG8_BAR; PG8_MMA(1, 0, At, B0); PG8_MMA(1, 1, At, B1); PG8_BAR; PG8_SCHED; \
            PG8_LDB(B0, 1, 0); PG8_LDB(B1, 1, 1); PG8_SCHED; PG8_LDA(At, 1, 0); PG8_STAGE(PG8_SA(0, 1), a2, vA1); \
            PG8_WAIT_V(8); PG8_WAIT_L(0); PG8_BAR; PG8_MMA(0, 0, At, B0); PG8_MMA(0, 1, At, B1); PG8_BAR; PG8_SCHED; \
            PG8_LDA(At, 1, 1); PG8_STAGE(PG8_SB(1, 0), b3, voffB); PG8_STAGE(PG8_SB(1, 1), b3 + hstep, voffB); PG8_STAGE(PG8_SA(1, 0), a3, vA0); \
            PG8_WAIT_V(8); PG8_WAIT_L(0); PG8_BAR; PG8_MMA(1, 0, At, B0); PG8_MMA(1, 1, At, B1); PG8_BAR; PG8_SCHED;
        if constexpr (P::F8) {
#pragma unroll 1
            for (int t = 0; t < PG8_NTL; t += 2) { PG8_KITER }
        } else {
            for (int t = 0; t < nt; t += 2) { PG8_KITER }
        }
#undef PG8_KITER
        if (wr == 0) PG8_BAR;
#ifdef MK_KX2
        if constexpr (P::F8) {
#pragma unroll
            for (int a = 0; a < 2; ++a)
#pragma unroll
                for (int b = 0; b < 2; ++b)
#pragma unroll
                    for (int m = 0; m < 4; ++m)
#pragma unroll
                        for (int n = 0; n < 2; ++n) acc[a][b][m][n] *= 0.5f; }
#endif
#ifdef MK_EPIX2
        if constexpr (P::F8) { int ln3 = lane; asm volatile("" : "+v"(ln3)); Pb.epi(acc, cur, wr, wc, ln3 & 15, ln3 >> 4); }
#endif
        if constexpr (P::F8) { int ln2 = lane; asm volatile("" : "+v"(ln2)); Pb.epi(acc, cur, wr, wc, ln2 & 15, ln2 >> 4); } else Pb.epi(acc, cur, wr, wc, fr, fq);
        if (!has_next) break;
#pragma unroll
        for (int a = 0; a < 2; ++a)
#pragma unroll
            for (int b = 0; b < 2; ++b)
#pragma unroll
                for (int m = 0; m < 4; ++m)
#pragma unroll
                    for (int n = 0; n < 2; ++n) acc[a][b][m][n] = (f32x4){0.f, 0.f, 0.f, 0.f};
        cur = nxt; cA = nA; cB = nB; ++ui;
        if (wr == 1) PG8_BAR;
    }
    PG8_WAIT_V(0);
    PG8_BAR;
#undef PG8_SA
#undef PG8_SB
#undef PG8_STAGE
#undef PG8_LDA
#undef PG8_LDB
#undef PG8_MMA
#undef PG8_WAIT_V
#undef PG8_WAIT_L
#undef PG8_BAR
#undef PG8_SCHED
}

__device__ __forceinline__ int moe_tables(LAS unsigned char* lds, const int* cnt) {
    LAS int* tile_e = (LAS int*)(lds + LDS_TILE_E); LAS int* tile_m = (LAS int*)(lds + LDS_TILE_M); LAS int* rts = (LAS int*)(lds + LDS_MISC + 32); LAS int* lcnt = (LAS int*)(lds + LDS_CNT);
    const int t = tid_fresh();
    if (t < 64) {
        const int c = (t < NE) ? cnt[t * CNT_STRIDE] : 0; const int n = (c + 255) >> 8; int pre = n;
#pragma unroll
        for (int d = 1; d < 32; d <<= 1) { const int v = __shfl_up(pre, d, 64); if (t >= d) pre += v; }
        if (t < NE) { lcnt[t] = c; const int a0 = pre - n; for (int m = 0; m < n; ++m) { tile_e[a0 + m] = t; tile_m[a0 + m] = m; } }
        if (t == NE - 1) rts[0] = pre;
    }
    __syncthreads();
    return rts[0];
}
}
namespace mk {
__device__ __forceinline__ float wsum(float v) {
#pragma unroll
    for (int o = 1; o < 64; o <<= 1) v += __shfl_xor(v, o);
    return v; }
__device__ __forceinline__ unsigned short f2bf(float f) { unsigned u = __float_as_uint(f); u += 0x7FFFu + ((u >> 16) & 1u); return (unsigned short)(u >> 16); }
}
namespace mk {
typedef float f32x16 __attribute__((ext_vector_type(16)));
typedef short s16x4 __attribute__((ext_vector_type(4)));
typedef __bf16 bf2_t __attribute__((ext_vector_type(2)));
#define MFMA32(a, b, c) __builtin_amdgcn_mfma_f32_32x32x16_bf16((a), (b), (c), 0, 0, 0)
constexpr float LOG2E = 1.4426950408889634f;
constexpr int PROJ_LD = NPROJ;
constexpr int AT_NPB = 2  , AT_KBUF = 0, AT_VBUF = 16384, AT_IMPW = 32768, AT_SCORE = 2 * AT_NPB * 16384  , AT_OBUF = AT_SCORE + 8192, AT_OSTR = 528, AT_BTAB = AT_OBUF + 64 * AT_OSTR  ,
              AT_SEL = AT_BTAB + 8 * 132 * 4  , AT_SSQ = AT_SEL + 512  , AT_END = AT_SSQ + 8 * 64 * 4  ;
struct AttnArgs { const bf16_t* projb; const bf16_t* kc; const bf16_t* vc; bf16_t* catb; float* ssq; };

__device__ __forceinline__ unsigned pk2(float a, float b) { f2_t v = {a, b}; return __builtin_bit_cast(unsigned, __builtin_convertvector(v, bf2_t)); }
__device__ __forceinline__ int t5_bucket(int n) { if (n < 0) n = 0; if (n < 16) return n; const float nf = (float)n; const int l = 16 + (int)(logf(nf / 16.f) / 2.0794415416798357f * 16.f); return l < 31 ? l : 31; }
__device__ __forceinline__ float xh_max(float x) { const auto r = __builtin_amdgcn_permlane32_swap(__float_as_uint(x), __float_as_uint(x), false, false); return fmaxf(__uint_as_float(r[0]), __uint_as_float(r[1])); }
__device__ __forceinline__ float xh_sum(float x) { const auto r = __builtin_amdgcn_permlane32_swap(__float_as_uint(x), __float_as_uint(x), false, false); return __uint_as_float(r[0]) + __uint_as_float(r[1]); }
__device__ __forceinline__ float xh_other(float x, int h) { const auto r = __builtin_amdgcn_permlane32_swap(__float_as_uint(x), __float_as_uint(x), false, false); return __uint_as_float(h ? r[0] : r[1]); }
__device__ __forceinline__ void stage_tile(LAS unsigned char* dst, const char* src, size_t row_stride, int wid, int lane, bool vswz) {
    const int row = 8 * wid + (lane >> 3), slot = lane & 7;
    const int f = vswz ? (((row >> 1) & 1) << 2) : ((row >> 1) & 7);
    __builtin_amdgcn_global_load_lds((const unsigned*)(src + (size_t)row * row_stride + ((slot ^ f) << 4)), (LAS unsigned*)(dst + wid * 1024), 16, 0, 0);
}
#define AT_CROW(r, h) (((r) & 3) + 8 * ((r) >> 2) + 4 * (h))
#define AT_PACK8(x, s) __builtin_bit_cast(bf16x8, (u32x4){pk2((x)[8 * (s)], (x)[8 * (s) + 1]), pk2((x)[8 * (s) + 2], (x)[8 * (s) + 3]), pk2((x)[8 * (s) + 4], (x)[8 * (s) + 5]), pk2((x)[8 * (s) + 6], (x)[8 * (s) + 7])})
__device__ __forceinline__ bf16x8 vt_frag(const LAS unsigned char* vt, unsigned vaddr, int rowoff) {
    const s16x4 lo = __builtin_amdgcn_ds_read_tr16_b64_v4i16((LAS s16x4*)(vt + vaddr + rowoff * 128));
    const s16x4 hi = __builtin_amdgcn_ds_read_tr16_b64_v4i16((LAS s16x4*)(vt + vaddr + (rowoff + 8) * 128));
    return __builtin_shufflevector(lo, hi, 0, 1, 2, 3, 4, 5, 6, 7);
}
template <bool FIRST>
__device__ __forceinline__ void obuf_acc(LAS unsigned char* lds, int tl, int hd, int h, float sc, const f32x16 (&oc)[2]) {
#pragma unroll
    for (int c = 0; c < 2; ++c)
#pragma unroll
        for (int qd = 0; qd < 4; ++qd) { LAS u32x2* p = (LAS u32x2*)(lds + AT_OBUF + tl * AT_OSTR + ((hd & 3) * 64 + 32 * c + 8 * qd + 4 * h) * 2);
            float a0 = sc * oc[c][4 * qd], a1 = sc * oc[c][4 * qd + 1], a2 = sc * oc[c][4 * qd + 2], a3 = sc * oc[c][4 * qd + 3];
            if (!FIRST) { const u32x2 o = *p; a0 += __uint_as_float(o.x << 16); a1 += __uint_as_float(o.x & 0xffff0000u); a2 += __uint_as_float(o.y << 16); a3 += __uint_as_float(o.y & 0xffff0000u); }
            *p = (u32x2){pk2(a0, a1), pk2(a2, a3)}; }
}
template <int KIND>
__device__ __forceinline__ void attn_tile(const LAS unsigned char* Kt, const LAS unsigned char* Vt, int kbase, int tq, bool sel, const bf16x8 (&qf)[4], const LAS float* bt, float cfar,
                                          f32x16 (&O)[2], float& m, float& l, int ql, int h, const unsigned (&vaddr)[2]) {
    f32x16 s0, s1;
#pragma unroll
    for (int r = 0; r < 16; ++r) { s0[r] = 0.f; s1[r] = 0.f; }
    const int fk = (ql >> 1) & 7;
#pragma unroll
    for (int s = 0; s < 4; ++s) { const int ch = ((2 * s + h) ^ fk) << 4;
        const bf16x8 k0 = *(const LAS bf16x8*)(Kt + ql * 128 + ch), k1 = *(const LAS bf16x8*)(Kt + (32 + ql) * 128 + ch);
        s0 = MFMA32(k0, qf[s], s0); s1 = MFMA32(k1, qf[s], s1); }
    float mx = -INFINITY;
    if (KIND == 0) {
#pragma unroll
        for (int r = 0; r < 16; ++r) mx = fmaxf(mx, fmaxf(s0[r], s1[r]));
        mx += cfar;
    } else {
        int tqq = tq - kbase; asm volatile("" : "+v"(tqq));
#pragma unroll
        for (int r = 0; r < 16; ++r) {
            const int d0 = tqq - AT_CROW(r, h), d1 = d0 - 32;
            float x0 = s0[r] + bt[min(max(d0, 0), 128)], x1 = s1[r] + bt[min(max(d1, 0), 128)];
            if (KIND == 2) { x0 = (d0 >= 0 && d0 < 512) ? x0 : -INFINITY; x1 = (d1 >= 0 && d1 < 512) ? x1 : -INFINITY; }
            s0[r] = x0; s1[r] = x1; mx = fmaxf(mx, fmaxf(x0, x1)); }
    }
    mx = sel ? mx : -INFINITY;
    mx = xh_max(mx);
    const float mn = fmaxf(m, mx);
    const float alpha = __builtin_amdgcn_exp2f(m - mn);
    float msub = sel ? mn : INFINITY;
    if (KIND == 0) msub -= cfar;
    float ps = 0.f;
#pragma unroll
    for (int r = 0; r < 16; ++r) { const float p0 = __builtin_amdgcn_exp2f(s0[r] - msub), p1 = __builtin_amdgcn_exp2f(s1[r] - msub); s0[r] = p0; s1[r] = p1; ps += p0 + p1; }
    l = l * alpha + ps; m = mn;
    if (__any(alpha != 1.f)) {
#pragma unroll
        for (int r = 0; r < 16; ++r) { O[0][r] *= alpha; O[1][r] *= alpha; } }
#pragma unroll
    for (int sp = 0; sp < 2; ++sp) {
        const bf16x8 p0 = AT_PACK8(s0, sp), p1 = AT_PACK8(s1, sp);
#pragma unroll
        for (int c = 0; c < 2; ++c) { O[c] = MFMA32(vt_frag(Vt, vaddr[c], 16 * sp), p0, O[c]); O[c] = MFMA32(vt_frag(Vt, vaddr[c], 32 + 16 * sp), p1, O[c]); }
    }
}
template <int MODE>
__device__ __forceinline__ void attn_branch(LAS unsigned char* lds, unsigned U, unsigned mysel, const char* kcol, const char* vcol, size_t RS, int blk, int tq, const bf16x8 (&qf)[4],
                                            const LAS float* bt, float cfar, f32x16 (&oc)[2], float& m, float& l, int ql, int h, const unsigned (&vaddr)[2], int wid, int lane) {
#define AT_NEXT(n) (((n) >= 31) ? -1 : ((U & ~((2u << (n)) - 1u)) ? __builtin_ctz(U & ~((2u << (n)) - 1u)) : -1))
#define AT_ISSUE(n, st) do { stage_tile(lds + (st) * 16384, kcol + (size_t)(n) * 64 * RS, RS, wid, lane, false); stage_tile(lds + (st) * 16384 + 8192, vcol + (size_t)(n) * 64 * RS, RS, wid, lane, true); } while (0)
    int tl_[AT_NPB], pb = 0;
    tl_[0] = __builtin_ctz(U | 0x80000000u);
#pragma unroll
    for (int q = 1; q < AT_NPB; ++q) tl_[q] = (tl_[q - 1] >= 0) ? AT_NEXT(tl_[q - 1]) : -1;
    asm volatile("s_waitcnt lgkmcnt(0)" ::: "memory"); __builtin_amdgcn_s_barrier(); asm volatile("" ::: "memory");
#pragma unroll
    for (int q = 0; q < AT_NPB; ++q) if (tl_[q] >= 0) AT_ISSUE(tl_[q], q);
    for (;;) {
        asm volatile("s_waitcnt vmcnt(0)" ::: "memory");
        asm volatile("s_waitcnt lgkmcnt(0)" ::: "memory"); __builtin_amdgcn_s_barrier(); asm volatile("" ::: "memory");
        int nx[AT_NPB];
        nx[0] = (tl_[AT_NPB - 1] >= 0) ? AT_NEXT(tl_[AT_NPB - 1]) : -1;
#pragma unroll
        for (int q = 1; q < AT_NPB; ++q) nx[q] = (nx[q - 1] >= 0) ? AT_NEXT(nx[q - 1]) : -1;
#pragma unroll
        for (int q = 0; q < AT_NPB; ++q) if (nx[q] >= 0) AT_ISSUE(nx[q], AT_NPB * (pb ^ 1) + q);
#pragma unroll
        for (int q = 0; q < AT_NPB; ++q) { const int tcur = tl_[q]; if (tcur < 0) break;
            const LAS unsigned char* Kt = lds + (AT_NPB * pb + q) * 16384; const LAS unsigned char* Vt = Kt + 8192;
            const bool sel = (MODE == 0) ? (((mysel >> tcur) & 1u) != 0u) : true;
            const bool masked = (tcur == blk) || (MODE == 1 && tcur + 8 == blk);
            if (masked) attn_tile<2>(Kt, Vt, tcur * 64, tq, sel, qf, bt, cfar, oc, m, l, ql, h, vaddr);
            else if (tcur + 3 <= blk) attn_tile<0>(Kt, Vt, tcur * 64, tq, sel, qf, bt, cfar, oc, m, l, ql, h, vaddr);
            else attn_tile<1>(Kt, Vt, tcur * 64, tq, sel, qf, bt, cfar, oc, m, l, ql, h, vaddr); }
        if (nx[0] < 0) break;
#pragma unroll
        for (int q = 0; q < AT_NPB; ++q) tl_[q] = nx[q];
        pb ^= 1;
    }
#undef AT_NEXT
#undef AT_ISSUE
}

__device__ __forceinline__ void attn_item(LAS unsigned char* lds, const AttnArgs& A, int b, int qt, int kvh) {
    const int tid = tid_fresh(), wid = __builtin_amdgcn_readfirstlane(tid >> 6), lane = tid & 63;
    const int g = wid >> 1, th = wid & 1, ql = lane & 31, h = lane >> 5;
    const int t0 = qt * 64, tl = th * 32 + ql, tq = t0 + tl, blk = qt;
    const int qq = (lane & 15) >> 2, pp = lane & 3, lb = (lane >> 4) & 1;
    unsigned vaddr[2];
#pragma unroll
    for (int c = 0; c < 2; ++c) vaddr[c] = (unsigned)((4 * h + qq) * 128 + (((4 * (c ^ ((qq >> 1) & 1))) + 2 * lb + (pp >> 1)) << 4) + 8 * (pp & 1));
    LAS float* impw = (LAS float*)(lds + AT_IMPW); LAS float* score = (LAS float*)(lds + AT_SCORE); LAS unsigned* selm = (LAS unsigned*)(lds + AT_SEL);
    const char* prow0 = (const char*)(A.projb + (size_t)b * S * PROJ_LD);
    const size_t RS = (size_t)PROJ_LD * 2;
    {
        const int hd = kvh * 4 + g;
        const LAS float* bt = (const LAS float*)(lds + AT_BTAB) + hd * 132;
        const float cfar = bt[128];
        bf16x8 qf[4];
#pragma unroll
        for (int s = 0; s < 4; ++s) qf[s] = *(const bf16x8*)(A.projb + ((size_t)b * S + tq) * PROJ_LD + hd * 64 + 16 * s + 8 * h);
        float gate[3];
#pragma unroll
        for (int j = 0; j < 3; ++j) { const float gv = bf2f(A.projb[((size_t)b * S + tq) * PROJ_LD + 1280 + j * 8 + hd]); gate[j] = 1.f / (1.f + __expf(-gv)); }
        __syncthreads();
        { const char* kcb = (const char*)(A.kc + (size_t)(b * 2 + kvh) * 128 * 64); const char* vcb = (const char*)(A.vc + (size_t)(b * 2 + kvh) * 128 * 64);
          stage_tile(lds + AT_KBUF, kcb, 128, wid, lane, false); stage_tile(lds + AT_KBUF + 8192, kcb + 64 * 128, 128, wid, lane, false);
          stage_tile(lds + AT_VBUF, vcb, 128, wid, lane, true); stage_tile(lds + AT_VBUF + 8192, vcb + 64 * 128, 128, wid, lane, true); }
        asm volatile("s_waitcnt vmcnt(0)" ::: "memory"); __syncthreads();
        {
            f32x16 sc[4]; const int fk = (ql >> 1) & 7; int tqc = tq; asm volatile("" : "+v"(tqc));
            const int nkb = ((t0 + 32) >> 4) / 32 + 1;
#pragma unroll
            for (int kb = 0; kb < 4; ++kb) {
#pragma unroll
                for (int r = 0; r < 16; ++r) sc[kb][r] = 0.f;
                if (kb < nkb) {
#pragma unroll
                for (int s = 0; s < 4; ++s) { const bf16x8 kf = *(const LAS bf16x8*)(lds + AT_KBUF + (32 * kb + ql) * 128 + (((2 * s + h) ^ fk) << 4)); sc[kb] = MFMA32(kf, qf[s], sc[kb]); } }
                __builtin_amdgcn_sched_barrier(0); }
            float mx = -INFINITY;
#pragma unroll
            for (int kb = 0; kb < 4; ++kb) {
                if (kb >= nkb) {
#pragma unroll
                    for (int r = 0; r < 16; ++r) sc[kb][r] = -INFINITY;
                    continue; }
#pragma unroll
                for (int r = 0; r < 16; ++r) { const int c = 32 * kb + AT_CROW(r, h); const int dist = tqc - 16 * c - 31; const float bv = bt[min(max(dist, 0), 128)]; const float x = (dist >= 0) ? sc[kb][r] + bv : -INFINITY; sc[kb][r] = x; mx = fmaxf(mx, x);
                    if ((r & 7) == 7) __builtin_amdgcn_sched_barrier(0); } }
            mx = xh_max(mx);
            const float mref = (mx == -INFINITY) ? 0.f : mx;
            float ls = 0.f;
#pragma unroll
            for (int kb = 0; kb < 4; ++kb) {
                if (kb >= nkb) {
#pragma unroll
                    for (int r = 0; r < 16; ++r) sc[kb][r] = 0.f;
                    continue; }
#pragma unroll
                for (int r = 0; r < 16; ++r) { const float p = __builtin_amdgcn_exp2f(sc[kb][r] - mref); sc[kb][r] = p; ls += p; } }
            ls = xh_sum(ls);
            const float inv = 1.f / fmaxf(ls, 1e-30f);
#pragma unroll
            for (int kb = 0; kb < 4; ++kb) { if (kb >= nkb) continue;
#pragma unroll
                for (int r = 0; r < 16; ++r) sc[kb][r] *= inv; }
            if (blk >= 16) { float carry = 0.f;
#pragma unroll
              for (int i = 0; i < 16; ++i) { const int kb = i >> 2, qd = i & 3;
                  const float s4 = (sc[kb][4 * qd] + sc[kb][4 * qd + 1]) + (sc[kb][4 * qd + 2] + sc[kb][4 * qd + 3]);
                  const float rv = xh_other(sc[kb][4 * qd + 3], h);
                  impw[(wid * 32 + ql) * 32 + 2 * i + h] = s4 + (h ? rv : carry); carry = rv; } }
            f32x16 oc[2];
#pragma unroll
            for (int r = 0; r < 16; ++r) { oc[0][r] = 0.f; oc[1][r] = 0.f; }
#pragma unroll
            for (int kb = 0; kb < 4; ++kb) { if (kb >= nkb) continue;
#pragma unroll
                for (int sp = 0; sp < 2; ++sp) { const bf16x8 pf = AT_PACK8(sc[kb], sp);
#pragma unroll
                    for (int c = 0; c < 2; ++c) oc[c] = MFMA32(vt_frag(lds + AT_VBUF, vaddr[c], 32 * kb + 16 * sp), pf, oc[c]);
                    __builtin_amdgcn_sched_barrier(0); } }
            obuf_acc<true>(lds, tl, hd, h, gate[0], oc);
        }
        __syncthreads();
        unsigned U = (blk >= 31) ? 0xffffffffu : ((2u << blk) - 1u);
        if (blk >= 16) {
        int tids = tid; asm volatile("" : "+v"(tids));
#pragma unroll
        for (int i = 0; i < 4; ++i) { const int id = tids + 512 * i, tk = id >> 5, n = id & 31, w0 = tk >> 5, q = tk & 31;
            float v = 0.f;
#pragma unroll
            for (int gg = 0; gg < 4; ++gg) v += impw[((2 * gg + w0) * 32 + q) * 32 + n];
            const bool forced = (n == 0) || (n == blk) || (n == blk - 1);
            score[tk * 32 + n] = forced ? 1e4f : ((n <= blk) ? v : -1.f); }
        __syncthreads();
        { const int tk = tids >> 3, part = tids & 7;
          float sv[32];
#pragma unroll
          for (int e4 = 0; e4 < 8; ++e4) { const f32x4 q4 = *(const LAS f32x4*)(score + tk * 32 + e4 * 4); sv[e4 * 4] = q4[0]; sv[e4 * 4 + 1] = q4[1]; sv[e4 * 4 + 2] = q4[2]; sv[e4 * 4 + 3] = q4[3]; }
          unsigned bits = 0u;
#pragma unroll
          for (int j = 0; j < 4; ++j) { const int n = 4 * part + j; const float sn = score[tk * 32 + n];
              int rank = 0;
#pragma unroll
              for (int mm = 0; mm < 32; ++mm) rank += (sv[mm] > sn || (sv[mm] == sn && mm < n)) ? 1 : 0;
              bits |= ((rank < 16) && (n <= blk)) ? (1u << n) : 0u; }
          bits |= (unsigned)__shfl_xor((int)bits, 1); bits |= (unsigned)__shfl_xor((int)bits, 2); bits |= (unsigned)__shfl_xor((int)bits, 4);
          if (part == 0) selm[tk] = bits; }
        __syncthreads();
        U = selm[lane];
#pragma unroll
        for (int o = 1; o < 64; o <<= 1) U |= (unsigned)__shfl_xor((int)U, o);
        U = (unsigned)__builtin_amdgcn_readfirstlane((int)U);
        }
        const unsigned mysel = (blk >= 16) ? selm[tl] : U;
        {
            f32x16 oc[2];
#pragma unroll
            for (int r = 0; r < 16; ++r) { oc[0][r] = 0.f; oc[1][r] = 0.f; }
            float m = -1e30f, l = 0.f;
            attn_branch<0>(lds, U, mysel, prow0 + (512 + 2 * 128 + kvh * 64) * 2, prow0 + (512 + 3 * 128 + kvh * 64) * 2, RS, blk, tq, qf, bt, cfar, oc, m, l, ql, h, vaddr, wid, lane);
            l = xh_sum(l);
            const float sc1 = gate[1] / fmaxf(l, 1e-30f);
            obuf_acc<false>(lds, tl, hd, h, sc1, oc);
        }
        {
            f32x16 oc[2];
#pragma unroll
            for (int r = 0; r < 16; ++r) { oc[0][r] = 0.f; oc[1][r] = 0.f; }
            float m = -1e30f, l = 0.f;
            const int lo = (blk >= 8) ? blk - 8 : 0;
            const unsigned Uw = ((blk >= 31) ? 0xffffffffu : ((2u << blk) - 1u)) & ~((1u << lo) - 1u);
            attn_branch<1>(lds, Uw, 0u, prow0 + (512 + 4 * 128 + kvh * 64) * 2, prow0 + (512 + 5 * 128 + kvh * 64) * 2, RS, blk, tq, qf, bt, cfar, oc, m, l, ql, h, vaddr, wid, lane);
            l = xh_sum(l);
            const float sc2 = gate[2] / fmaxf(l, 1e-30f);
            obuf_acc<false>(lds, tl, hd, h, sc2, oc);
        }
    }
    __syncthreads();
    int widn = wid; asm volatile("" : "+s"(widn));
    { u32x2 v[8]; float sq[8];
#pragma unroll
      for (int i = 0; i < 8; ++i) { v[i] = *(const LAS u32x2*)(lds + AT_OBUF + (widn + 8 * i) * AT_OSTR + lane * 8);
          const float f0 = __uint_as_float(v[i].x << 16), f1 = __uint_as_float(v[i].x & 0xffff0000u), f2 = __uint_as_float(v[i].y << 16), f3 = __uint_as_float(v[i].y & 0xffff0000u);
          sq[i] = (f0 * f0 + f1 * f1) + (f2 * f2 + f3 * f3); }
#pragma unroll
      for (int o = 1; o < 64; o <<= 1) {
#pragma unroll
          for (int i = 0; i < 8; ++i) sq[i] += __shfl_xor(sq[i], o); }
#pragma unroll
      for (int i = 0; i < 8; ++i) { const int row = widn + 8 * i;
          *(u32x2*)(A.catb + ((size_t)b * S + t0 + row) * 1024 + kvh * 256 + lane * 4) = v[i];
          if (lane == 0) A.ssq[((size_t)b * S + t0 + row) * 2 + kvh] = sq[i]; } }
    __syncthreads();
}
__device__ __forceinline__ void attn_btab(LAS unsigned char* lds, const float* rel_bias) {
    LAS float* bt = (LAS float*)(lds + AT_BTAB);
    float v[3];
#pragma unroll
    for (int q = 0; q < 3; ++q) { const int i = (int)threadIdx.x + 512 * q; const int hd = i / 129, d = i % 129; v[q] = (i < 8 * 129) ? rel_bias[t5_bucket(d) * 8 + hd] : 0.f; }
#pragma unroll
    for (int q = 0; q < 3; ++q) { const int i = (int)threadIdx.x + 512 * q; const int hd = i / 129, d = i % 129; if (i < 8 * 129) bt[hd * 132 + d] = v[q] * LOG2E; }
    __syncthreads();
}
}
namespace mk {
constexpr int XBC_OFF = 1816, Z_OFF = 1304, DT_OFF = 2840, NCH = 16;
constexpr int SD_XS = 0, SD_B = 65536, SD_C = 98304, SD_PREV = 131072  , SD_ACS = SD_PREV + 16384, SD_DT = SD_ACS + 2048, SD_W = SD_DT + 2048, SD_WP = SD_W + 2048  , SD_END = SD_WP + 256;
struct SsdArgs { const bf16_t* projb; const float* conv_w; const float* conv_b; const float* dt_bias; const float* a_log; const float* d_skip; bf16_t* states; float* alast; bf16_t* catb; };

__device__ __forceinline__ void ssd_dt_acs(LAS unsigned char* lds, const SsdArgs& A, int b, int c, int grp, int wid, int lane) {
    if (wid < 4) { const int hd = grp * 4 + wid; const float Ah = -__expf(A.a_log[hd]), db = A.dt_bias[hd];
        const size_t row = (size_t)b * S + c * 128 + 2 * lane;
        float x0 = bf2f(A.projb[row * PROJ_LD + DT_OFF + hd]) + db, x1 = bf2f(A.projb[(row + 1) * PROJ_LD + DT_OFF + hd]) + db;
        const float d0 = (x0 > 20.f) ? x0 : log1pf(__expf(x0)), d1 = (x1 > 20.f) ? x1 : log1pf(__expf(x1));
        const float a0 = d0 * Ah, a1 = d1 * Ah; float incl = a0 + a1;
#pragma unroll
        for (int o = 1; o < 64; o <<= 1) { const float t = __shfl_up(incl, o); if (lane >= o) incl += t; }
        LAS float* acs = (LAS float*)(lds + SD_ACS) + wid * 128; LAS float* dtl = (LAS float*)(lds + SD_DT) + wid * 128;
        acs[2 * lane] = incl - a1; acs[2 * lane + 1] = incl; dtl[2 * lane] = d0; dtl[2 * lane + 1] = d1;
        LAS float* lw = (LAS float*)(lds + SD_W) + wid * 128;
        lw[2 * lane] = (__logf(d0) - (incl - a1)) * 1.4426950408889634f; lw[2 * lane + 1] = (__logf(d1) - incl) * 1.4426950408889634f; }
}
template <bool PHASE_A>
__device__ __forceinline__ void ssd_conv(LAS unsigned char* lds, const SsdArgs& A, int b, int c, int grp, int wid, int lane) {
    const int ch = lane;
    if (PHASE_A && ch >= 48) return;
    const int rel = (ch < 32) ? grp * 256 + ch * 8 : (ch < 48) ? 512 + grp * 128 + (ch - 32) * 8 : 768 + grp * 128 + (ch - 48) * 8;
    float w[4][8], bias[8];
#pragma unroll
    for (int k = 0; k < 4; ++k) { const f32x4 u0 = *(const f32x4*)(A.conv_w + k * 1024 + rel), u1 = *(const f32x4*)(A.conv_w + k * 1024 + rel + 4);
#pragma unroll
        for (int j = 0; j < 4; ++j) { w[k][j] = u0[j]; w[k][4 + j] = u1[j]; } }
    { const f32x4 u0 = *(const f32x4*)(A.conv_b + rel), u1 = *(const f32x4*)(A.conv_b + rel + 4);
#pragma unroll
      for (int j = 0; j < 4; ++j) { bias[j] = u0[j]; bias[4 + j] = u1[j]; } }
    const int tl0 = wid * 16, ts0 = c * 128 + tl0;
    const bf16_t* src = A.projb + ((size_t)b * S + ts0) * PROJ_LD + XBC_OFF + rel;
    float x0[8], x1[8], x2[8];
#pragma unroll
    for (int j = 0; j < 8; ++j) { x0[j] = 0.f; x1[j] = 0.f; x2[j] = 0.f; }
    if (ts0 >= 3) {
        const bf16x8 r0 = *(const bf16x8*)(src - 3 * (ptrdiff_t)PROJ_LD), r1 = *(const bf16x8*)(src - 2 * (ptrdiff_t)PROJ_LD), r2 = *(const bf16x8*)(src - 1 * (ptrdiff_t)PROJ_LD);
#pragma unroll
        for (int j = 0; j < 8; ++j) { x0[j] = bf2f((bf16_t)r0[j]); x1[j] = bf2f((bf16_t)r1[j]); x2[j] = bf2f((bf16_t)r2[j]); } }
    const LAS float* wt = (const LAS float*)(lds + SD_W) + (ch >> 3) * 128;
    bf16x8 rvv[16];
#pragma unroll
    for (int i = 0; i < 16; ++i) rvv[i] = *(const bf16x8*)(src + (size_t)i * PROJ_LD);
#pragma unroll
    for (int i = 0; i < 16; ++i) {
        const bf16x8 rv = rvv[i];
        float x3[8], o[8];
#pragma unroll
        for (int j = 0; j < 8; ++j) { x3[j] = bf2f((bf16_t)rv[j]); const float a = bias[j] + w[0][j] * x0[j] + w[1][j] * x1[j] + w[2][j] * x2[j] + w[3][j] * x3[j]; o[j] = a * __builtin_amdgcn_rcpf(1.f + __builtin_amdgcn_exp2f(-1.4426950408889634f * a)); x0[j] = x1[j]; x1[j] = x2[j]; x2[j] = x3[j]; }
        const int row = tl0 + i;
        if (PHASE_A && ch < 32) { const float sc = wt[row];
#pragma unroll
            for (int j = 0; j < 8; ++j) o[j] *= sc; }
        u32x4 pk; pk.x = pk2(o[0], o[1]); pk.y = pk2(o[2], o[3]); pk.z = pk2(o[4], o[5]); pk.w = pk2(o[6], o[7]);
        if (ch < 32) *(LAS u32x4*)(lds + SD_XS + row * 512 + ((ch ^ ((row & 3) << 2)) << 4)) = pk;
        else if (ch < 48) { const int cc = ch - 32; *(LAS u32x4*)(lds + SD_B + row * 256 + ((PHASE_A ? (cc ^ ((row & 3) << 2)) : (cc ^ (row & 15))) << 4)) = pk; }
        else { const int cc = ch - 48; *(LAS u32x4*)(lds + SD_C + row * 256 + ((cc ^ (row & 15)) << 4)) = pk; }
    }
}
__device__ __forceinline__ bf16x8 tr_frag2(const LAS unsigned char* base, int stride, int r0, int r1, int chunk0, int qq, int pp) {
    const int cl = chunk0 + (pp >> 1);
    const s16x4 lo = __builtin_amdgcn_ds_read_tr16_b64_v4i16((LAS s16x4*)(base + (r0 + qq) * stride + ((cl ^ (qq << 2)) << 4) + 8 * (pp & 1)));
    const s16x4 hi = __builtin_amdgcn_ds_read_tr16_b64_v4i16((LAS s16x4*)(base + (r1 + qq) * stride + ((cl ^ (qq << 2)) << 4) + 8 * (pp & 1)));
    return __builtin_shufflevector(lo, hi, 0, 1, 2, 3, 4, 5, 6, 7);
}
__device__ __forceinline__ void ssd_a_item(LAS unsigned char* lds, const SsdArgs& A, int item) {
    const int tid = tid_fresh(), wid = __builtin_amdgcn_readfirstlane(tid >> 6), lane = tid & 63;
    const int grp = item & 1, c = (item >> 1) & 15, b = item >> 5;
    const int ql = lane & 31, h = lane >> 5, qq = (lane & 15) >> 2, pp = lane & 3, lb2 = (lane >> 4) & 1;
    __syncthreads();
    ssd_dt_acs(lds, A, b, c, grp, wid, lane);
    __syncthreads();
    { LAS float* acs = (LAS float*)(lds + SD_ACS); LAS float* dtl = (LAS float*)(lds + SD_DT); LAS float* wt = (LAS float*)(lds + SD_W);
      const int hh = tid >> 7, t = tid & 127; const float al = acs[hh * 128 + 127];
      wt[hh * 128 + t] = dtl[hh * 128 + t] * __expf(al - acs[hh * 128 + t]);
      if (t == 0) A.alast[(b * 8 + grp * 4 + hh) * NCH + c] = al; }
    __syncthreads();
    ssd_conv<true>(lds, A, b, c, grp, wid, lane);
    __syncthreads();
    const int pb = wid >> 2, nb = wid & 3;
#pragma unroll 1
    for (int hh = 0; hh < 4; ++hh) {
        f32x16 acc;
#pragma unroll
        for (int r = 0; r < 16; ++r) acc[r] = 0.f;
#pragma unroll
        for (int kk = 0; kk < 8; ++kk) {
            const bf16x8 af = tr_frag2(lds + SD_XS, 512, 16 * kk + 8 * h, 16 * kk + 8 * h + 4, hh * 8 + 4 * pb + 2 * lb2, qq, pp);
            const bf16x8 bf = tr_frag2(lds + SD_B, 256, 16 * kk + 8 * h, 16 * kk + 8 * h + 4, 4 * nb + 2 * lb2, qq, pp);
            acc = MFMA32(af, bf, acc); }
        { LAS unsigned char* tb = lds + SD_C;
#pragma unroll
          for (int r = 0; r < 16; ++r) *(LAS bf16_t*)(tb + (32 * pb + AT_CROW(r, h)) * 264 + (32 * nb + ql) * 2) = f2bf(acc[r]);
          __syncthreads();
          bf16_t* st = A.states + ((size_t)((b * NCH + c) * 8 + grp * 4 + hh) * 64) * 128;
#pragma unroll
          for (int q = 0; q < 2; ++q) { const int i = tid + 512 * q, pr = i >> 4, ch = i & 15;
              const LAS unsigned char* src = tb + pr * 264 + ch * 16;
              const u32x2 lo = *(const LAS u32x2*)src, hi = *(const LAS u32x2*)(src + 8);
              *(u32x4*)(st + pr * 128 + ch * 8) = (u32x4){lo.x, lo.y, hi.x, hi.y}; }
          __syncthreads(); }
    }
}
__device__ __forceinline__ void ssd_b_item(LAS unsigned char* lds, const SsdArgs& A, int item) {
    const int tid = tid_fresh(), wid = __builtin_amdgcn_readfirstlane(tid >> 6), lane = tid & 63;
    const int grp = item & 1, b = (item >> 1) & 7, c = 15 - (item >> 4);
    const int ql = lane & 31, h = lane >> 5, qq = (lane & 15) >> 2, pp = lane & 3, lb2 = (lane >> 4) & 1;
    const int pb = wid >> 2, lb = wid & 3;
    LAS float* acs = (LAS float*)(lds + SD_ACS); LAS float* dtl = (LAS float*)(lds + SD_DT); LAS float* wp = (LAS float*)(lds + SD_WP);
    __syncthreads();
    ssd_dt_acs(lds, A, b, c, grp, wid, lane);
    if (tid >= 256 && tid < 320) { const int hh = (tid - 256) >> 4, cp = tid & 15; float s = 0.f;
        float al[16];
#pragma unroll
        for (int c2 = 0; c2 < 16; ++c2) al[c2] = A.alast[(b * 8 + grp * 4 + hh) * NCH + c2];
#pragma unroll
        for (int c2 = 0; c2 < 16; ++c2) s += (c2 > cp && c2 < c) ? al[c2] : 0.f;
        wp[hh * 16 + cp] = (cp < c) ? __expf(s) : 0.f; }
    ssd_conv<false>(lds, A, b, c, grp, wid, lane);
    __syncthreads();
#pragma unroll 1
    for (int hh = 0; hh < 4; ++hh) {
        const int hd = grp * 4 + hh;
        const float Dh = A.d_skip[hd];
        u32x2 zz4[4];
        { const bf16_t* zp = A.projb + ((size_t)b * S + c * 128 + 32 * lb + ql) * PROJ_LD + Z_OFF + hd * 64 + 32 * pb + 4 * h;
#pragma unroll
          for (int qd = 0; qd < 4; ++qd) zz4[qd] = *(const u32x2*)(zp + 8 * qd); }
        { float pv[16];
#pragma unroll
          for (int j = 0; j < 16; ++j) pv[j] = 0.f;
          const int p = tid >> 3, n0 = (tid & 7) * 8;
          const bf16_t* sp0 = A.states + ((size_t)((b * NCH) * 8 + hd) * 64 + p) * 128 + n0;
#pragma unroll
          for (int g8 = 0; g8 < 2; ++g8) {
              if (g8 * 8 < c) { bf16x8 s0[8], s1[8];
#pragma unroll
                  for (int u = 0; u < 8; ++u) { const bf16_t* sp = sp0 + (size_t)(g8 * 8 + u) * (8 * 64 * 128); s0[u] = *(const bf16x8*)sp; s1[u] = *(const bf16x8*)(sp + 64); }
#pragma unroll
                  for (int u = 0; u < 8; ++u) { const float wgt = wp[hh * 16 + g8 * 8 + u];
                      if (wgt != 0.f) {
#pragma unroll
                          for (int j = 0; j < 8; ++j) { pv[j] += wgt * bf2f((bf16_t)s0[u][j]); pv[8 + j] += wgt * bf2f((bf16_t)s1[u][j]); } } } } }
          LAS unsigned char* pbuf = lds + SD_PREV + p * 256;
          *(LAS u32x4*)(pbuf + ((((n0 >> 3)) ^ (p & 15)) << 4)) = (u32x4){pk2(pv[0], pv[1]), pk2(pv[2], pv[3]), pk2(pv[4], pv[5]), pk2(pv[6], pv[7])};
          *(LAS u32x4*)(pbuf + ((((n0 >> 3) + 8) ^ (p & 15)) << 4)) = (u32x4){pk2(pv[8], pv[9]), pk2(pv[10], pv[11]), pk2(pv[12], pv[13]), pk2(pv[14], pv[15])}; }
        __syncthreads();
        f32x16 acc;
#pragma unroll
        for (int r = 0; r < 16; ++r) acc[r] = 0.f;
#pragma unroll
        for (int kk = 0; kk < 8; ++kk) {
            const bf16x8 af = *(const LAS bf16x8*)(lds + SD_PREV + (32 * pb + ql) * 256 + (((2 * kk + h) ^ (ql & 15)) << 4));
            const bf16x8 bf = *(const LAS bf16x8*)(lds + SD_C + (32 * lb + ql) * 256 + (((2 * kk + h) ^ (ql & 15)) << 4));
            acc = MFMA32(af, bf, acc); }
        const float al = acs[hh * 128 + 32 * lb + ql];
        { const float e = __expf(al);
#pragma unroll
          for (int r = 0; r < 16; ++r) acc[r] *= e; }
        const float al2 = al * 1.4426950408889634f; const LAS float* lw = (const LAS float*)(lds + SD_W);
#pragma unroll
        for (int sb = 0; sb < 4; ++sb) {
            if (sb <= lb) {
                f32x16 Pm;
#pragma unroll
                for (int r = 0; r < 16; ++r) Pm[r] = 0.f;
#pragma unroll
                for (int kk = 0; kk < 8; ++kk) {
                    const bf16x8 gf = *(const LAS bf16x8*)(lds + SD_B + (32 * sb + ql) * 256 + (((2 * kk + h) ^ (ql & 15)) << 4));
                    const bf16x8 cf = *(const LAS bf16x8*)(lds + SD_C + (32 * lb + ql) * 256 + (((2 * kk + h) ^ (ql & 15)) << 4));
                    Pm = MFMA32(gf, cf, Pm); }
#pragma unroll
                for (int r = 0; r < 16; ++r) { const int sl = 32 * sb + AT_CROW(r, h), ll = 32 * lb + ql;
                    float v = Pm[r] * __builtin_amdgcn_exp2f(al2 + lw[hh * 128 + sl]); v = (sl <= ll) ? v : 0.f; v += (sl == ll) ? Dh : 0.f; Pm[r] = v; }
#pragma unroll
                for (int sp = 0; sp < 2; ++sp) { const bf16x8 pf = AT_PACK8(Pm, sp);
                    const bf16x8 af = tr_frag2(lds + SD_XS, 512, 32 * sb + 16 * sp + 4 * h, 32 * sb + 16 * sp + 8 + 4 * h, hh * 8 + 4 * pb + 2 * lb2, qq, pp);
                    acc = MFMA32(af, pf, acc); } }
        }
        {
#pragma unroll
          for (int qd = 0; qd < 4; ++qd) { const u32x2 zz = zz4[qd];
              const float z0 = __uint_as_float(zz.x << 16), z1 = __uint_as_float(zz.x & 0xffff0000u), z2 = __uint_as_float(zz.y << 16), z3 = __uint_as_float(zz.y & 0xffff0000u);
              acc[4 * qd] *= z0 * __builtin_amdgcn_rcpf(1.f + __builtin_amdgcn_exp2f(-1.4426950408889634f * z0)); acc[4 * qd + 1] *= z1 * __builtin_amdgcn_rcpf(1.f + __builtin_amdgcn_exp2f(-1.4426950408889634f * z1));
              acc[4 * qd + 2] *= z2 * __builtin_amdgcn_rcpf(1.f + __builtin_amdgcn_exp2f(-1.4426950408889634f * z2)); acc[4 * qd + 3] *= z3 * __builtin_amdgcn_rcpf(1.f + __builtin_amdgcn_exp2f(-1.4426950408889634f * z3)); } }
        __syncthreads();
#pragma unroll
        for (int qd = 0; qd < 4; ++qd) { const int row = 32 * lb + ql, chn = hh * 8 + 4 * pb + qd;
            *(LAS u32x2*)(lds + SD_XS + row * 512 + ((chn ^ ((row & 3) << 2)) << 4) + 8 * h) = (u32x2){pk2(acc[4 * qd], acc[4 * qd + 1]), pk2(acc[4 * qd + 2], acc[4 * qd + 3])}; }
    }
    __syncthreads();
    int widn = wid; asm volatile("" : "+s"(widn));
#pragma unroll 1
    for (int i0 = 0; i0 < 16; i0 += 8) { u32x2 v[8]; float sq[8]; const int chn = lane >> 1;
#pragma unroll
        for (int i = 0; i < 8; ++i) { const int row = widn + 8 * (i0 + i);
            v[i] = *(const LAS u32x2*)(lds + SD_XS + row * 512 + ((chn ^ ((row & 3) << 2)) << 4) + 8 * (lane & 1));
            const float f0 = __uint_as_float(v[i].x << 16), f1 = __uint_as_float(v[i].x & 0xffff0000u), f2 = __uint_as_float(v[i].y << 16), f3 = __uint_as_float(v[i].y & 0xffff0000u);
            sq[i] = (f0 * f0 + f1 * f1) + (f2 * f2 + f3 * f3); }
#pragma unroll
        for (int o = 1; o < 64; o <<= 1) {
#pragma unroll
            for (int i = 0; i < 8; ++i) sq[i] += __shfl_xor(sq[i], o); }
#pragma unroll
        for (int i = 0; i < 8; ++i) { const int row = widn + 8 * (i0 + i); const float rs = rsqrtf(sq[i] * (1.f / 256.f) + 1e-6f);
            const float f0 = __uint_as_float(v[i].x << 16), f1 = __uint_as_float(v[i].x & 0xffff0000u), f2 = __uint_as_float(v[i].y << 16), f3 = __uint_as_float(v[i].y & 0xffff0000u);
            *(u32x2*)(A.catb + ((size_t)b * S + c * 128 + row) * 1024 + 512 + grp * 256 + lane * 4) = (u32x2){pk2(f0 * rs, f1 * rs), pk2(f2 * rs, f3 * rs)}; } }
}
}
namespace mk {
template <int NR>
__device__ __forceinline__ void rms_rows_bf16(const float* x, bf16_t* o, int r0, int lane) {
    f32x4 v[NR][4]; float s[NR];
#pragma unroll
    for (int i = 0; i < NR; ++i) { const int r = r0 + i; const float* xr = x + (size_t)(r < T ? r : 0) * D;
#pragma unroll
        for (int j = 0; j < 4; ++j) v[i][j] = *(const f32x4*)(xr + lane * 4 + 256 * j); }
#pragma unroll
    for (int i = 0; i < NR; ++i) { s[i] = 0.f;
#pragma unroll
        for (int j = 0; j < 4; ++j) s[i] += (v[i][j][0] * v[i][j][0] + v[i][j][1] * v[i][j][1]) + (v[i][j][2] * v[i][j][2] + v[i][j][3] * v[i][j][3]); }
#pragma unroll
    for (int o2 = 1; o2 < 64; o2 <<= 1) {
#pragma unroll
        for (int i = 0; i < NR; ++i) s[i] += __shfl_xor(s[i], o2); }
#pragma unroll
    for (int i = 0; i < NR; ++i) { const int r = r0 + i; if (r >= T) break; const float rs = rsqrtf(s[i] * (1.f / 1024.f) + 1e-6f);
#pragma unroll
        for (int j = 0; j < 4; ++j) *(u32x2*)(o + (size_t)r * D + lane * 4 + 256 * j) = (u32x2){pk2(v[i][j][0] * rs, v[i][j][1] * rs), pk2(v[i][j][2] * rs, v[i][j][3] * rs)}; }
}
constexpr int WT_PITCH = 68, WT_TILE_BYTES = 64 * WT_PITCH * 4;
template <bool OUT8>
__device__ __forceinline__ void wt_tile(bool dry, const float* W, void* WTv, const float* gk1, const float* gk2, int ksplit, int K, int N, int NP, int mode, int nscale, float sc, int ntn, int ntk,
                                        int tile, LAS float* tl, int lane) {
    const int per = ntn * ntk, z = tile / per, rem = tile % per, n0 = (rem % ntn) * 64;
    const float* Wz = W + (size_t)z * K * N;
  for (int sub = 0; sub < (OUT8 ? 2 : 1); ++sub) {
    const int k0 = ((rem / ntn) * (OUT8 ? 2 : 1) + sub) * 64;
    const int lr = lane >> 4, lc = (lane & 15) * 4;
    f32x4 v[16];
#pragma unroll
    for (int i = 0; i < 16; ++i) { const int k = k0 + 4 * i + lr, n = n0 + lc; v[i] = (n < N) ? *(const f32x4*)(Wz + (size_t)k * N + n) : (f32x4){0.f, 0.f, 0.f, 0.f}; }
    if (gk1) {
#pragma unroll
        for (int i = 0; i < 16; ++i) { const int k = k0 + 4 * i + lr; const float g = (k < ksplit) ? gk1[k] : gk2[k - ksplit]; v[i] = v[i] * g; } }
#pragma unroll
    for (int i = 0; i < 16; ++i) { const int kk = 4 * i + lr; const int sw = OUT8 ? (((kk >> 4) & 3) << 3) : (((kk >> 3) & 7) << 2); *(LAS f32x4*)(tl + kk * WT_PITCH + (lc ^ sw)) = v[i]; }
    asm volatile("s_waitcnt lgkmcnt(0)" ::: "memory");
    if constexpr (OUT8) {
        const int kq = lane & 3; f8_t* WTz = (f8_t*)WTv + (size_t)z * NP * K;
#pragma unroll
        for (int it = 0; it < 4; ++it) { const int nl = 16 * it + (lane >> 2), n = n0 + nl; const float s = (n < nscale) ? sc : 1.f;
            int nm = n; if (mode == 1) { const int up = n >> 10, jj = n & 1023; nm = (jj >> 7) * 256 + up * 128 + (jj & 127); }
            const LAS float* src = tl + (16 * kq) * WT_PITCH + (nl ^ (kq << 3));
            u32x4 w;
            w.x = pk4_fp8(src[0] * s, src[WT_PITCH] * s, src[2 * WT_PITCH] * s, src[3 * WT_PITCH] * s); w.y = pk4_fp8(src[4 * WT_PITCH] * s, src[5 * WT_PITCH] * s, src[6 * WT_PITCH] * s, src[7 * WT_PITCH] * s);
            w.z = pk4_fp8(src[8 * WT_PITCH] * s, src[9 * WT_PITCH] * s, src[10 * WT_PITCH] * s, src[11 * WT_PITCH] * s); w.w = pk4_fp8(src[12 * WT_PITCH] * s, src[13 * WT_PITCH] * s, src[14 * WT_PITCH] * s, src[15 * WT_PITCH] * s);
            if (dry) { asm volatile("" :: "v"(w)); continue; }
            *(u32x4*)(WTz + (size_t)nm * K + k0 + 16 * kq) = w; }
    } else {
        const int kq = lane & 7; bf16_t* WTz = (bf16_t*)WTv + (size_t)z * NP * K;
#pragma unroll
        for (int it = 0; it < 8; ++it) { const int nl = 8 * it + (lane >> 3), n = n0 + nl; const float s = (n < nscale) ? sc : 1.f;
            int nm = n; if (mode == 1) { const int up = n >> 10, jj = n & 1023; nm = (jj >> 7) * 256 + up * 128 + (jj & 127); }
            const LAS float* src = tl + (8 * kq) * WT_PITCH + (nl ^ (kq << 2));
            u32x4 w; w.x = pk2(src[0] * s, src[WT_PITCH] * s); w.y = pk2(src[2 * WT_PITCH] * s, src[3 * WT_PITCH] * s); w.z = pk2(src[4 * WT_PITCH] * s, src[5 * WT_PITCH] * s); w.w = pk2(src[6 * WT_PITCH] * s, src[7 * WT_PITCH] * s);
            *(u32x4*)(WTz + (size_t)nm * K + k0 + 8 * kq) = w; }
    }
    asm volatile("s_waitcnt lgkmcnt(0)" ::: "memory");
  }
}
struct Wt8 { const float* W; f8_t* WT; const float* gk; int K, N, nn, mode; };
__device__ __forceinline__ void wt8_load(f32x4 (&v)[16], const Wt8& J, int sid, int lane) {
    const int per = 8 * J.nn, z = sid / per, rem = sid % per, k0 = (rem / J.nn) * 128 + 16 * (lane >> 3), n0 = (rem % J.nn) * 32 + 4 * (lane & 7);
    const float* Wz = J.W + (size_t)z * J.K * J.N + (size_t)k0 * J.N + n0;
#pragma unroll
    for (int i = 0; i < 16; ++i) v[i] = *(const f32x4*)(Wz + (size_t)i * J.N);
}
__device__ __forceinline__ void wt8_store(f32x4 (&v)[16], const Wt8& J, int sid, float sc, int lane) {
    const int per = 8 * J.nn, z = sid / per, rem = sid % per, k0 = (rem / J.nn) * 128 + 16 * (lane >> 3), n0 = (rem % J.nn) * 32 + 4 * (lane & 7);
    float g[16];
    if (J.gk) {
#pragma unroll
        for (int q = 0; q < 4; ++q) { const f32x4 g4 = *(const f32x4*)(J.gk + k0 + 4 * q); g[4 * q] = g4[0] * sc; g[4 * q + 1] = g4[1] * sc; g[4 * q + 2] = g4[2] * sc; g[4 * q + 3] = g4[3] * sc; }
    } else {
#pragma unroll
        for (int i = 0; i < 16; ++i) g[i] = sc; }
    f8_t* WTz = J.WT + (size_t)z * J.N * J.K + k0;
#pragma unroll
    for (int j = 0; j < 4; ++j) { const int n = n0 + j;
        int nm = n; if (J.mode == 1) { const int up = n >> 10, jj = n & 1023; nm = (jj >> 7) * 256 + up * 128 + (jj & 127); }
        u32x4 w;
        w.x = pk4_fp8(v[0][j] * g[0], v[1][j] * g[1], v[2][j] * g[2], v[3][j] * g[3]); w.y = pk4_fp8(v[4][j] * g[4], v[5][j] * g[5], v[6][j] * g[6], v[7][j] * g[7]);
        w.z = pk4_fp8(v[8][j] * g[8], v[9][j] * g[9], v[10][j] * g[10], v[11][j] * g[11]); w.w = pk4_fp8(v[12][j] * g[12], v[13][j] * g[13], v[14][j] * g[14], v[15][j] * g[15]);
        *(u32x4*)(WTz + (size_t)nm * J.K) = w; }
}
constexpr int CP_KX = 0  , CP_RED = 69632  , CP_HID = CP_RED + 32768  , CP_END = CP_HID + 8192 + 256, CP_POSB = CP_END  , CP_W2 = CP_POSB + 2048  ;
struct CmpArgs { const bf16_t* projb; const bf16_t* w1T; const float* posb; const float* w2; bf16_t* kc; bf16_t* vc; };
__device__ __forceinline__ void cmp_item(LAS unsigned char* lds, const CmpArgs& A, int item) {
    const int tid = tid_fresh(), wid = __builtin_amdgcn_readfirstlane(tid >> 6), lane = tid & 63, ql = lane & 31, h = lane >> 5;
    const int cblk = item & 3, kvh = (item >> 2) & 1, b = (item >> 3) & 7, j = item >> 6;
    __syncthreads();
    { const int tok0 = 512 * cblk; const bf16_t* src = A.projb + ((size_t)b * S + tok0) * PROJ_LD + 512 + j * 128 + kvh * 64;
      u32x4 v[9];
#pragma unroll
      for (int q = 0; q < 9; ++q) { const int i = tid + 512 * q, r = i >> 3, ch = i & 7; v[q] = (u32x4){0u, 0u, 0u, 0u};
          if (i < 528 * 8 && tok0 + r < S) v[q] = *(const u32x4*)(src + (size_t)r * PROJ_LD + ch * 8); }
#pragma unroll
      for (int q = 0; q < 9; ++q) { const int i = tid + 512 * q, r = i >> 3, ch = i & 7;
          if (i < 528 * 8) *(LAS u32x4*)(lds + CP_KX + r * 128 + ((ch ^ ((r >> 4) & 7)) << 4)) = v[q]; } }
    { float a = 0.f; const int g = tid >> 6, n = tid & 63;
#pragma unroll
      for (int sl = 0; sl < 8; ++sl) a += A.posb[(j * 64 + 8 * g + sl) * 64 + n];
      ((LAS float*)(lds + CP_POSB))[tid] = a;
      const f32x4 w0 = *(const f32x4*)(A.w2 + (size_t)j * 4096 + tid * 4), w1 = *(const f32x4*)(A.w2 + (size_t)j * 4096 + 2048 + tid * 4);
      *(LAS f32x4*)(lds + CP_W2 + tid * 16) = w0; *(LAS f32x4*)(lds + CP_W2 + 8192 + tid * 16) = w1; }
    __syncthreads();
    const int nb = wid & 1, kq = wid >> 1;
    f32x16 acc;
#pragma unroll
    for (int r = 0; r < 16; ++r) acc[r] = 0.f;
    const bf16_t* wrow = A.w1T + ((size_t)j * 64 + 32 * nb + ql) * 2048;
#pragma unroll
    for (int li = 0; li < 8; ++li) { const int l = 8 * kq + li;
#pragma unroll
        for (int s = 0; s < 4; ++s) {
            const int row = 16 * ql + l;
            const bf16x8 af = *(const LAS bf16x8*)(lds + CP_KX + row * 128 + (((2 * s + h) ^ ((row >> 4) & 7)) << 4));
            const bf16x8 bf = *(const bf16x8*)(wrow + l * 64 + 16 * s + 8 * h);
            acc = MFMA32(af, bf, acc); } }
    { LAS float* red = (LAS float*)(lds + CP_RED) + kq * 2048;
#pragma unroll
      for (int r = 0; r < 16; ++r) red[AT_CROW(r, h) * 64 + 32 * nb + ql] = acc[r]; }
    __syncthreads();
    { LAS float* red = (LAS float*)(lds + CP_RED); LAS float* hid = (LAS float*)(lds + CP_HID); const LAS float* pbp = (const LAS float*)(lds + CP_POSB) + (tid & 63);
      const float pbs = ((pbp[0] + pbp[64]) + (pbp[128] + pbp[192])) + ((pbp[256] + pbp[320]) + (pbp[384] + pbp[448]));
      for (int i = tid; i < 2048; i += 512) { const float a = (red[i] + red[2048 + i]) + (red[4096 + i] + red[6144 + i]) + pbs; hid[i] = a * __builtin_amdgcn_rcpf(1.f + __builtin_amdgcn_exp2f(-1.4426950408889634f * a)); } }
    __syncthreads();
    { const LAS float* hid = (const LAS float*)(lds + CP_HID); bf16_t* out = (j ? A.vc : A.kc) + (size_t)(b * 2 + kvh) * 128 * 64;
      for (int i = tid; i < 2048; i += 512) { const int cl = i >> 6, n2 = i & 63; float a = 0.f;
#pragma unroll 8
          for (int n = 0; n < 64; ++n) a += hid[cl * 64 + n] * ((const LAS float*)(lds + CP_W2))[n * 64 + n2];
          const int c = 32 * cblk + cl; out[c * 64 + n2] = (c < 127) ? f2bf(a) : (bf16_t)0; } }
}
constexpr int RP_PART = 0  , RP_SSQ = 65536  , RP_RSTD = RP_SSQ + 2048, RP_LGT = 131072  , RP_LCNT = RP_LGT + 128 * 36 * 4;
struct RouteArgs { const bf16_t* h1; const bf16_t* rws; const float* router_b; f8_t* hn8; int* cnt; int* list; float* wlist; int* tinfo; };
__device__ __forceinline__ void route_phase(LAS unsigned char* lds, const RouteArgs& A, int wg, int nwg) {
    const int tid = tid_fresh(), wid = __builtin_amdgcn_readfirstlane(tid >> 6), lane = tid & 63, ql = lane & 31, h = lane >> 5;
    LAS float* part = (LAS float*)(lds + RP_PART); LAS float* ssqp = (LAS float*)(lds + RP_SSQ); LAS float* rstdv = (LAS float*)(lds + RP_RSTD);
    LAS float* lgt = (LAS float*)(lds + RP_LGT);
    LAS int* lcnt = (LAS int*)(lds + RP_LCNT); LAS int* gbase = lcnt + 32;
    const int ntl = (T - wg * 8 + nwg * 8 - 1) / (nwg * 8) * 8;
    __syncthreads();
    if (tid < 32) lcnt[tid] = 0;
    const int kof = 128 * wid + 64 * h;
    for (int g0 = 0; g0 < ntl; g0 += 64) {
        u32x4 af[2][8]; bool val[2]; size_t tokb[2];
#pragma unroll
        for (int mt = 0; mt < 2; ++mt) { const int sl = g0 + 32 * mt + ql; const int tok = wg * 8 + (sl & 7) + (sl >> 3) * nwg * 8; val[mt] = sl < ntl && tok < T; tokb[mt] = (size_t)tok * D;
#pragma unroll
            for (int ks = 0; ks < 8; ++ks) af[mt][ks] = val[mt] ? *(const u32x4*)(A.h1 + tokb[mt] + kof + 8 * ks) : (u32x4){0u, 0u, 0u, 0u}; }
        f32x16 acc[2];
#pragma unroll
        for (int r = 0; r < 16; ++r) { acc[0][r] = 0.f; acc[1][r] = 0.f; }
#pragma unroll
        for (int ks = 0; ks < 8; ++ks)
#pragma unroll
            for (int tm = 0; tm < 3; ++tm) { const bf16x8 bfr = *(const bf16x8*)(A.rws + (size_t)(tm * 32 + ql) * 1024 + kof + 8 * ks);
                acc[0] = MFMA32(__builtin_bit_cast(bf16x8, af[0][ks]), bfr, acc[0]); acc[1] = MFMA32(__builtin_bit_cast(bf16x8, af[1][ks]), bfr, acc[1]); }
#pragma unroll
        for (int mt = 0; mt < 2; ++mt) { float sq = 0.f;
#pragma unroll
            for (int ks = 0; ks < 8; ++ks)
#pragma unroll
                for (int c = 0; c < 4; ++c) { const unsigned u = af[mt][ks][c]; const float lo = __uint_as_float(u << 16), hi = __uint_as_float(u & 0xffff0000u); sq += lo * lo + hi * hi; }
            sq += __shfl_xor(sq, 32);
            if (h == 0) ssqp[wid * 64 + 32 * mt + ql] = sq;
#pragma unroll
            for (int r = 0; r < 16; ++r) part[(wid * 64 + 32 * mt + AT_CROW(r, h)) * 32 + ql] = acc[mt][r]; }
        __syncthreads();
        { const int row = tid >> 3, e4 = (tid & 7) * 4; float ss = 0.f; f32x4 sum = (f32x4){0.f, 0.f, 0.f, 0.f};
#pragma unroll
          for (int w = 0; w < 8; ++w) { ss += ssqp[w * 64 + row]; sum += *(const LAS f32x4*)(part + (w * 64 + row) * 32 + e4); }
          const float rs = rsqrtf(ss * (1.f / 1024.f) + 1e-6f); const f32x4 bias = *(const f32x4*)(A.router_b + e4);
          if (g0 + row < 128) *(LAS f32x4*)(lgt + (g0 + row) * 36 + e4) = sum * rs + bias;
          if ((tid & 7) == 0) rstdv[row] = rs; }
        __syncthreads();
#pragma unroll
        for (int mt = 0; mt < 2; ++mt) if (val[mt]) { const float rs = rstdv[32 * mt + ql];
#pragma unroll
            for (int q = 0; q < 4; ++q) { u32x4 w; unsigned d[4];
#pragma unroll
                for (int c2 = 0; c2 < 4; ++c2) { const u32x4 a = af[mt][2 * q + (c2 >> 1)]; const unsigned u0 = a[(c2 & 1) * 2], u1 = a[(c2 & 1) * 2 + 1];
                    d[c2] = pk4_fp8(__uint_as_float(u0 << 16) * rs, __uint_as_float(u0 & 0xffff0000u) * rs, __uint_as_float(u1 << 16) * rs, __uint_as_float(u1 & 0xffff0000u) * rs); }
                w.x = d[0]; w.y = d[1]; w.z = d[2]; w.w = d[3];
                *(u32x4*)(A.hn8 + tokb[mt] + kof + 16 * q) = w; } }
    }
    __syncthreads();
    int te[4] = {0, 0, 0, 0}, lp[4] = {0, 0, 0, 0}; float tw[4] = {0.f, 0.f, 0.f, 0.f};
    const int tmine = wg * 8 + (tid & 7) + (tid >> 3) * nwg * 8; const bool mine = tid < 128 && tid < ntl && tmine < T;
    if (mine) { float v[32];
#pragma unroll
        for (int e4 = 0; e4 < 8; ++e4) { const f32x4 q4 = *(const LAS f32x4*)(lgt + tid * 36 + e4 * 4); v[e4 * 4] = q4[0]; v[e4 * 4 + 1] = q4[1]; v[e4 * 4 + 2] = q4[2]; v[e4 * 4 + 3] = q4[3]; }
        float tv[4];
#pragma unroll
        for (int k = 0; k < 4; ++k) { float best = -INFINITY; int bi = 0;
#pragma unroll
            for (int e = 0; e < 32; ++e) { const bool bt = v[e] > best; best = bt ? v[e] : best; bi = bt ? e : bi; }
#pragma unroll
            for (int e = 0; e < 32; ++e) v[e] = (e == bi) ? -INFINITY : v[e];
            tv[k] = best; te[k] = bi; }
        const float e1 = __expf(tv[1] - tv[0]), e2 = __expf(tv[2] - tv[0]), e3 = __expf(tv[3] - tv[0]); const float inv = 1.f / (1.f + e1 + e2 + e3);
        tw[0] = inv; tw[1] = e1 * inv; tw[2] = e2 * inv; tw[3] = e3 * inv;
#pragma unroll
        for (int k = 0; k < 4; ++k) lp[k] = __hip_atomic_fetch_add(lcnt + te[k], 1, __ATOMIC_RELAXED, __HIP_MEMORY_SCOPE_WORKGROUP); }
    __syncthreads();
    if (tid < 32) gbase[tid] = (int)__hip_atomic_fetch_add((unsigned*)A.cnt + tid * CNT_STRIDE, (unsigned)lcnt[tid], __ATOMIC_RELAXED, __HIP_MEMORY_SCOPE_AGENT);
    __syncthreads();
    if (mine) {
#pragma unroll
        for (int k = 0; k < 4; ++k) { const int e = te[k], pos = gbase[e] + lp[k], tk = tmine * 4 + k;
            A.list[(size_t)e * T + pos] = tk; A.wlist[tk] = tw[k]; A.tinfo[tk] = e | (pos << 8); } }
}
struct CombArgs { const bf16_t* h1; const f8_t* y; const int* tinfo; const float* tw; const int* cnt; const float* g; float* out; };
__device__ __forceinline__ void combine_phase(LAS unsigned char* lds, const CombArgs& A, int wg, int nwg) {
    const int tid = tid_fresh(), wid = __builtin_amdgcn_readfirstlane(tid >> 6), lane = tid & 63;
    LAS int* toff = (LAS int*)(lds + LDS_MISC + 64);
    __syncthreads();
    if (tid < 64) { const int n = (tid < NE) ? (A.cnt[tid * CNT_STRIDE] + 255) >> 8 : 0; int pre = n;
#pragma unroll
        for (int d = 1; d < 32; d <<= 1) { const int v = __shfl_up(pre, d, 64); if (tid >= d) pre += v; }
        if (tid < NE) toff[tid] = pre - n; }
    __syncthreads();
    f32x4 gv[4];
#pragma unroll
    for (int j = 0; j < 4; ++j) gv[j] = *(const f32x4*)(A.g + lane * 4 + 256 * j);
    for (int t = wg * 8 + wid; t < T; t += nwg * 8) {
        size_t so[4]; float tw[4];
#pragma unroll
        for (int k = 0; k < 4; ++k) { const int inf = A.tinfo[t * 4 + k]; so[k] = ((size_t)toff[inf & 255] * 256 + (inf >> 8)) * 1024; tw[k] = A.tw[t * 4 + k]; }
        f32x4 v[4]; float s = 0.f;
#pragma unroll
        for (int j = 0; j < 4; ++j) { { const u32x2 uh = *(const u32x2*)(A.h1 + (size_t)t * D + lane * 4 + 256 * j); v[j] = (f32x4){__uint_as_float(uh.x << 16), __uint_as_float(uh.x & 0xffff0000u), __uint_as_float(uh.y << 16), __uint_as_float(uh.y & 0xffff0000u)}; }
#pragma unroll
            for (int k = 0; k < 4; ++k) { const unsigned yy = *(const unsigned*)(A.y + so[k] + lane * 4 + 256 * j);
                const f2_t lo = __builtin_amdgcn_cvt_pk_f32_fp8((int)yy, false), hi = __builtin_amdgcn_cvt_pk_f32_fp8((int)yy, true);
                v[j][0] += tw[k] * lo[0]; v[j][1] += tw[k] * lo[1]; v[j][2] += tw[k] * hi[0]; v[j][3] += tw[k] * hi[1]; }
            s += (v[j][0] * v[j][0] + v[j][1] * v[j][1]) + (v[j][2] * v[j][2] + v[j][3] * v[j][3]); }
        s = wsum(s); const float rs = rsqrtf(s * (1.f / 1024.f) + 1e-6f);
#pragma unroll
        for (int j = 0; j < 4; ++j) *(f32x4*)(A.out + (size_t)t * D + lane * 4 + 256 * j) = v[j] * rs * gv[j];
    }
}
}
#define XB_TMO      128
#define XB_XCNT(j)  (256  + 64 * (j))
#define XB_XSUB(j)  (1280 + 64 * (j))
#define XB_XGEN(j)  (2304 + 64 * (j))
#define XB_TOP      3328
#define XB_TOPGEN   3392
#define XCD_BAR_WORDS 3456
#define XB_SPIN_CAP (1u << 18)
__device__ __forceinline__ unsigned xb_ld(unsigned* p)              { return __hip_atomic_load(p, __ATOMIC_RELAXED, __HIP_MEMORY_SCOPE_AGENT); }
__device__ __forceinline__ unsigned xb_add(unsigned* p, unsigned v) { return __hip_atomic_fetch_add(p, v, __ATOMIC_RELAXED, __HIP_MEMORY_SCOPE_AGENT); }
__device__ __forceinline__ unsigned xb_xcc_id() { return (unsigned)__builtin_amdgcn_s_getreg((3 << 11) | 20) & 0xFu; }
#define XB_SPIN(cond, bar) do { unsigned _sp = 0; while (cond) { __builtin_amdgcn_s_sleep(1); \
    if ((++_sp & 255u) == 0u) { if (xb_ld(&(bar)[XB_TMO])) break; if (_sp > XB_SPIN_CAP) { atomicAdd(&(bar)[XB_TMO], 1u); break; } } } } while (0)
struct XcdBarrier { unsigned* bar; unsigned x; volatile LAS unsigned* st; };
__device__ __forceinline__ XcdBarrier xcd_barrier_post(unsigned* bar, volatile LAS unsigned* st) {
    XcdBarrier b; b.bar = bar; b.x = xb_xcc_id(); b.st = st;
    if (threadIdx.x == 0) (void)xb_add(&bar[XB_XCNT(b.x)], 1u);
    return b;
}
__device__ __forceinline__ void xcd_barrier_complete(unsigned* bar, unsigned x, unsigned& nloc, unsigned& nx) {
    const unsigned G = gridDim.x * gridDim.y * gridDim.z;
    unsigned sum, cnt, mine, sp = 0u;
    for (;;) {
        sum = 0u; cnt = 0u; mine = 0u;
#pragma unroll
        for (unsigned j = 0; j < 16; ++j) { const unsigned c = xb_ld(&bar[XB_XCNT(j)]); sum += c; cnt += (c > 0u) ? 1u : 0u; mine = (j == x) ? c : mine; }
        if (sum == G) break;
        __builtin_amdgcn_s_sleep(1);
        if ((++sp & 255u) == 0u) { if (xb_ld(&bar[XB_TMO])) break; if (sp > XB_SPIN_CAP) { atomicAdd(&bar[XB_TMO], 1u); break; } }
    }
    nloc = mine > 0u ? mine : 1u; nx = cnt > 0u ? cnt : 1u;
}
__device__ __forceinline__ void xcd_barrier(const XcdBarrier& b) {
    asm volatile("s_waitcnt vmcnt(0)" ::: "memory");
    __syncthreads();
    if (threadIdx.x == 0) {
        unsigned* bar = b.bar;
        __builtin_amdgcn_s_waitcnt(0);
        unsigned nloc = b.st[0], nx = b.st[1];
        if (nloc == 0u) { xcd_barrier_complete(bar, b.x, nloc, nx); b.st[0] = nloc; b.st[1] = nx; }
        const unsigned old = xb_add(&bar[XB_XSUB(b.x)], 1u);
        const unsigned gen = old / nloc;
        if (old + 1u == (gen + 1u) * nloc) {
            __builtin_amdgcn_fence(__ATOMIC_RELEASE, "agent");
            asm volatile("s_waitcnt vmcnt(0)" ::: "memory");
            const unsigned og = xb_add(&bar[XB_TOP], 1u);
            const unsigned tg = og / nx;
            if (og + 1u == (tg + 1u) * nx) xb_add(&bar[XB_TOPGEN], 1u);
            else XB_SPIN(xb_ld(&bar[XB_TOPGEN]) == tg, bar);
            __builtin_amdgcn_fence(__ATOMIC_ACQUIRE, "agent");
            xb_add(&bar[XB_XGEN(b.x)], 1u);
            asm volatile("s_waitcnt vmcnt(0)" ::: "memory");
        } else {
            XB_SPIN(xb_ld(&bar[XB_XGEN(b.x)]) == gen, bar);
            __builtin_amdgcn_fence(__ATOMIC_ACQUIRE, "agent");
            asm volatile("s_waitcnt vmcnt(0)" ::: "memory");
        }
    }
    __syncthreads();
}

namespace mk {
constexpr int LDS_BAR = 159744, LDS_FUSED = LDS_BAR + 256;
constexpr int CTL_QUEUE = 4096;
struct Params {
    const float *x, *attn_norm, *w_in, *rel_bias, *cmp_pos, *cmp_w1, *cmp_w2, *attn_out_norm, *conv_w, *conv_b, *dt_bias, *a_log, *d_skip, *ssm_out_norm, *w_out, *ffn_norm,
                *router_w, *router_b, *w_gu, *b_gu, *w_dn, *b_dn, *final_norm;
    float* out; unsigned* ctl; int* cnt;
    bf16_t *xb, *WinT, *WoutT, *w1T, *projb, *catb, *kc, *vc, *states, *rws; f8_t *WguT, *WdnT, *hn8, *act, *ymoe;
    float *posb, *alast, *wlist, *ssq; bf16_t* h1; int *list, *tinfo;
    int ph_lo, ph_hi;
};
constexpr int NT_WIN = 48 * 16, NT_WOUT = 16 * 16, NT_WGU = 32 * 32 * 8, NT_WDN = 32 * 16 * 8, NT_W1 = 2 * 32, NT_ALL = NT_WIN + NT_WOUT + NT_WGU + NT_WDN + NT_W1;
__device__ __forceinline__ void p0_prologue(LAS unsigned char* lds, const Params& p, int wg, int nwg, int part, bool dry = false) {
    const int tid = tid_fresh(), wid = __builtin_amdgcn_readfirstlane(tid >> 6), lane = tid & 63;
    LAS float* tl = (LAS float*)(lds + wid * WT_TILE_BYTES);
    if (part == 0) {
    for (int r = (wg * 8 + wid) * 4; r < T; r += 4 * nwg * 8) rms_rows_bf16<4>(p.x, p.xb, r, lane);
    for (int o = wg * 8 + wid; o < 128; o += nwg * 8) { const int j = o >> 6, sl = o & 63; float s = 0.f;
#pragma unroll
        for (int kk = 0; kk < 32; ++kk) { const int k = sl * 32 + kk; s += p.cmp_pos[j * 2048 + k] * p.cmp_w1[((size_t)j * 2048 + k) * 64 + lane]; }
        p.posb[o * 64 + lane] = s; }
    for (int o = (nwg - 1 - wg) * 8 + wid; o < 512; o += nwg * 8) {
        const int e = o >> 4, k = (o & 15) * 64 + lane; const float v = p.router_w[k * NE + e] * p.ffn_norm[k];
        const bf16_t b0 = f2bf(v); const float r1 = v - bf2f(b0); const bf16_t b1 = f2bf(r1); const float r2 = r1 - bf2f(b1); const bf16_t b2 = f2bf(r2);
        p.rws[(size_t)e * 1024 + k] = b0; p.rws[(size_t)(32 + e) * 1024 + k] = b1; p.rws[(size_t)(64 + e) * 1024 + k] = b2; }
    __syncthreads();
    for (int task = wg * 8 + wid; task < NT_WIN + NT_WOUT + NT_W1; task += nwg * 8) { int idx = task;
        if (idx < NT_WIN) { wt_tile<false>(dry, p.w_in, p.WinT, p.attn_norm, p.attn_norm, 1024, 1024, 2848, 3072, 0, 512, 0.125f * LOG2E, 48, 16, idx, tl, lane); continue; } idx -= NT_WIN;
        if (idx < NT_WOUT) { wt_tile<false>(dry, p.w_out, p.WoutT, p.attn_out_norm, p.ssm_out_norm, 512, 1024, 1024, 1024, 0, 0, 1.f, 16, 16, idx, tl, lane); continue; } idx -= NT_WOUT;
        wt_tile<false>(dry, p.cmp_w1, p.w1T, nullptr, nullptr, 0, 2048, 64, 64, 0, 0, 1.f, 1, 32, idx, tl, lane); }
    } else {
    __syncthreads();
    for (int task = wg * 8 + wid; task < NT_WGU + NT_WDN; task += nwg * 8) { int idx = task;
        if (idx < NT_WGU) { wt_tile<true>(dry, p.w_gu, p.WguT, p.ffn_norm, p.ffn_norm, 1024, 1024, 2048, 2048, 1, 2048, W8_SCALE, 32, 8, idx, tl, lane); continue; } idx -= NT_WGU;
        wt_tile<true>(dry, p.w_dn, p.WdnT, nullptr, nullptr, 0, 1024, 1024, 1024, 0, 1024, W8_SCALE, 16, 8, idx, tl, lane); }
    __syncthreads();
    }
}

__device__ __forceinline__ void cvt_task_gu(LAS unsigned char* lds, const Params& p, int task, int wid, int lane) {
    wt_tile<true>(false, p.w_gu, p.WguT, p.ffn_norm, p.ffn_norm, 1024, 1024, 2048, 2048, 1, 2048, W8_SCALE, 32, 8, task, (LAS float*)(lds + wid * WT_TILE_BYTES), lane); }
__device__ __forceinline__ void cvt_task_dn(LAS unsigned char* lds, const Params& p, int task, int wid, int lane) {
    wt_tile<true>(false, p.w_dn, p.WdnT, nullptr, nullptr, 0, 1024, 1024, 1024, 0, 1024, W8_SCALE, 16, 8, task, (LAS float*)(lds + wid * WT_TILE_BYTES), lane); }

#define MK_PHASE_FN __device__ __forceinline__
MK_PHASE_FN void ph_proj(LAS unsigned char* lds, const bf16_t* xb, const bf16_t* WinT, bf16_t* projb, int wg, int nwg) {
    ProbProj P; P.S.init(T, NPROJ, nwg, wg); P.A = xb; P.Bt = WinT; P.O = projb; gemm_phase(lds, P); }
MK_PHASE_FN void ph_out(LAS unsigned char* lds, const bf16_t* catb, const bf16_t* WoutT, const float* x, bf16_t* h1, const float* ssq, int wg, int nwg) {
    ProbOut P; P.S.init(T, D, nwg, wg); P.A = catb; P.Bt = WoutT; P.R0 = x; P.O = h1; P.ssq = ssq; gemm_phase(lds, P); }
__global__ void __launch_bounds__(512, 2) k_fused(Params p) {
    extern __shared__ __attribute__((aligned(16))) unsigned char dl[];
    LAS unsigned char* lds = (LAS unsigned char*)dl;
    const int wg = blockIdx.x, nwg = gridDim.x; int tid = tid_fresh();
    if (tid < 64) ((LAS unsigned*)(lds + LDS_BAR))[tid] = 0u;
    __syncthreads();
    XcdBarrier bar = xcd_barrier_post(p.ctl, (volatile LAS unsigned*)(lds + LDS_BAR));
#ifdef MK_ONLY
#define PH(k) ((k) == MK_ONLY && p.ph_lo <= (k) && (k) < p.ph_hi)
#else
#define PH(k) (p.ph_lo <= (k) && (k) < p.ph_hi)
#endif
#ifdef MK_REPEAT
#define REP(k) for (int _rep = 0; _rep < ((k) == MK_REPEAT ? 2 : 1); ++_rep)
#else
#define REP(k)
#endif
#ifdef MK_REPEAT
#define QREP _rep
#else
#define QREP 0
#endif
#ifdef MK_BARX2
#define SEAM(k) do { if (PH(k) && PH((k) + 1)) { xcd_barrier(bar); xcd_barrier(bar); } } while (0)
#else
#define SEAM(k) do { if (PH(k) && PH((k) + 1)) xcd_barrier(bar); } while (0)
#endif
    if (PH(0)) { p0_prologue(lds, p, wg, nwg, 0); }
    SEAM(0);
    REP(1) if (PH(1)) ph_proj(lds, p.xb, p.WinT, p.projb, wg, nwg);
    SEAM(1);
    REP(2) if (PH(2)) {
        const SsdArgs SA{p.projb, p.conv_w, p.conv_b, p.dt_bias, p.a_log, p.d_skip, p.states, p.alast, p.catb};
        const CmpArgs CA{p.projb, p.w1T, p.posb, p.cmp_w2, p.kc, p.vc};
        for (int it = wg; it < 384; it += nwg) { const int v = 383 - it; if (v < 128) cmp_item(lds, CA, v); else ssd_a_item(lds, SA, v - 128); }
    }
    SEAM(2);
    REP(3) if (PH(3)) {
        const SsdArgs SA{p.projb, p.conv_w, p.conv_b, p.dt_bias, p.a_log, p.d_skip, p.states, p.alast, p.catb};
        const AttnArgs AA{p.projb, p.kc, p.vc, p.catb, p.ssq};
        bool btab_ok = false;
        LAS int* qslot = (LAS int*)(lds + LDS_BAR + 64);
        for (;;) {
            __syncthreads();
            if (tid_fresh() == 0) qslot[0] = (int)__hip_atomic_fetch_add(p.ctl + CTL_QUEUE + 64 * QREP, 1u, __ATOMIC_RELAXED, __HIP_MEMORY_SCOPE_AGENT);
            __syncthreads();
            const int it = qslot[0];
#if defined(MK_QX_ATTN)
            if (it >= 768 + 512) break;
            { const int i2 = it >= 768 ? it - 768 : it; if (i2 < 512) { if (!btab_ok) { attn_btab(lds, p.rel_bias); btab_ok = true; } attn_item(lds, AA, i2 & 7, 31 - (i2 >> 4), (i2 >> 3) & 1); } else { ssd_b_item(lds, SA, i2 - 512); btab_ok = false; } }
#elif defined(MK_QX_SSDB)
            if (it >= 768 + 256) break;
            { const int i2 = it >= 768 ? it - 256 : it; if (i2 < 512) attn_item(lds, AA, i2 & 7, 31 - (i2 >> 4), (i2 >> 3) & 1); else ssd_b_item(lds, SA, i2 - 512); }
#else
#if defined(MK_QX_BOTH)
            if (it >= 1536) break;
            { const int i2 = it >= 768 ? it - 768 : it; if (i2 < 512) { if (!btab_ok) { attn_btab(lds, p.rel_bias); btab_ok = true; } attn_item(lds, AA, i2 & 7, 31 - (i2 >> 4), (i2 >> 3) & 1); } else { ssd_b_item(lds, SA, i2 - 512); btab_ok = false; } }
#else
            if (it >= 768) break;
            if (it < 512) { if (!btab_ok) { attn_btab(lds, p.rel_bias); btab_ok = true; } attn_item(lds, AA, it & 7, 31 - (it >> 4), (it >> 3) & 1);
                { const int t3 = tid_fresh(), w3 = __builtin_amdgcn_readfirstlane(t3 >> 6);
                  const int l3 = t3 & 63;
                  const Wt8 JG{p.w_gu, p.WguT, p.ffn_norm, 1024, 2048, 64, 1}, JD{p.w_dn, p.WdnT, nullptr, 1024, 1024, 32, 0};
                  const int ga = it * 32 + 4 * w3, gd = it * 16 + 2 * w3;
                  f32x4 va[16], vb[16];
                  wt8_load(va, JG, ga, l3); wt8_load(vb, JG, ga + 1, l3);
                  wt8_store(va, JG, ga, W8_SCALE, l3); wt8_load(va, JG, ga + 2, l3);
                  wt8_store(vb, JG, ga + 1, W8_SCALE, l3); wt8_load(vb, JG, ga + 3, l3);
                  wt8_store(va, JG, ga + 2, W8_SCALE, l3); wt8_load(va, JD, gd, l3);
                  wt8_store(vb, JG, ga + 3, W8_SCALE, l3); wt8_load(vb, JD, gd + 1, l3);
                  wt8_store(va, JD, gd, W8_SCALE, l3); wt8_store(vb, JD, gd + 1, W8_SCALE, l3); }
            } else { ssd_b_item(lds, SA, it - 512); btab_ok = false; }
#endif
#endif
        }
    }
    SEAM(3);
    REP(4) if (PH(4)) ph_out(lds, p.catb, p.WoutT, p.x, p.h1, p.ssq, wg, nwg);
    SEAM(4);
    REP(5) if (PH(5)) { const bool dm = QREP != 0; const RouteArgs RA{p.h1, p.rws, p.router_b, p.hn8, dm ? p.cnt + 2048 : p.cnt, dm ? (int*)p.act : p.list, dm ? (float*)p.act + (4u << 20) : p.wlist, dm ? (int*)p.act + (8u << 20) : p.tinfo}; route_phase(lds, RA, wg, nwg); }
    SEAM(5);
    REP(6) if (PH(6)) {
        tid = tid_fresh();
        __syncthreads();
        const int RT = moe_tables(lds, p.cnt);
        ProbMoe1 P; P.S.nN = 8; P.S.G = nwg; P.S.c = (nwg % 8 == 0) ? (wg & 7) * (nwg >> 3) + (wg >> 3) : wg; P.S.RT = RT; P.S.tile_e = (const LAS int*)(lds + LDS_TILE_E); P.S.tile_m = (const LAS int*)(lds + LDS_TILE_M);
        P.A = p.hn8; P.Bt = p.WguT; P.btab = (const LAS float*)(lds + LDS_BIASTAB); P.O = p.act; P.rowtab = (const LAS unsigned*)(lds + LDS_ROWTAB);
        LAS unsigned* rowtab = (LAS unsigned*)(lds + LDS_ROWTAB);
        {
            const LAS int* lcnt = (const LAS int*)(lds + LDS_CNT); int tokv[12]; float bv[12];
#pragma unroll
            for (int i = 0; i < 12; ++i) { Unit u; tokv[i] = 0; bv[i] = 0.f; if (P.S.next(i, u)) {
                if (tid < 256) { const int pos = u.mt * 256 + tid; if (pos < lcnt[u.e]) tokv[i] = p.list[(size_t)u.e * T + pos] >> 2; }
                else { const int j = tid - 256; bv[i] = p.b_gu[u.e * 2048 + (j >> 7) * 1024 + u.pn * 128 + (j & 127)]; } } }
#pragma unroll
            for (int i = 0; i < 12; ++i) { if (tid < 256) rowtab[i * 256 + tid] = (unsigned)tokv[i] * KD; else ((LAS float*)(lds + LDS_BIASTAB))[i * 256 + tid - 256] = bv[i]; }
        }
        __syncthreads();
        gemm_phase(lds, P);
    }
    SEAM(6);
    REP(7) if (PH(7)) {
        __syncthreads();
        const int RT = moe_tables(lds, p.cnt);
        ProbMoe2 P; P.S.nN = 4; P.S.G = nwg; P.S.c = (nwg % 8 == 0) ? (wg & 7) * (nwg >> 3) + (wg >> 3) : wg; P.S.RT = RT; P.S.tile_e = (const LAS int*)(lds + LDS_TILE_E); P.S.tile_m = (const LAS int*)(lds + LDS_TILE_M);
        P.A = p.act; P.Bt = p.WdnT; P.btab = (const LAS float*)(lds + LDS_BIASTAB); P.O = p.ymoe;
        { const int t7 = tid_fresh(); float bv[12];
#pragma unroll
            for (int i = 0; i < 12; ++i) { Unit u; bv[i] = 0.f; if (t7 < 256 && P.S.next(i, u)) bv[i] = p.b_dn[u.e * 1024 + u.pn * 256 + t7]; }
#pragma unroll
            for (int i = 0; i < 12; ++i) if (t7 < 256) ((LAS float*)(lds + LDS_BIASTAB))[i * 256 + t7] = bv[i]; }
        __syncthreads();
        gemm_phase(lds, P);
    }
    SEAM(7);
    REP(8) if (PH(8)) { const CombArgs CA{p.h1, p.ymoe, p.tinfo, p.wlist, p.cnt, p.final_norm, p.out}; combine_phase(lds, CA, wg, nwg); }
#undef PH
#undef SEAM
}
}

extern "C" void kernel_launch(void* const* d_in, const int* in_sizes, int n_in, void* d_out, int out_size, void* d_ws, size_t ws_size, hipStream_t stream) {
    using namespace mk;
    char* ws = (char*)d_ws; const size_t MB = 1u << 20;
    size_t o = 0; auto take = [&](size_t mb) { char* q = ws + o; o += mb * MB; return q; };
    Params p;
    memset(&p, 0, sizeof(p));
    const float** fin = (const float**)&p.x;
    for (int i = 0; i < 23; ++i) fin[i] = (const float*)d_in[i];
    p.out = (float*)d_out;
    p.ctl = (unsigned*)take(1); p.cnt = (int*)(p.ctl + 8192);
    p.xb = (bf16_t*)take(32); p.WinT = (bf16_t*)take(6); p.WoutT = (bf16_t*)take(2); p.WguT = (f8_t*)take(64); p.WdnT = (f8_t*)take(32); p.w1T = (bf16_t*)take(1);
    p.projb = (bf16_t*)take(96); p.catb = (bf16_t*)take(32); p.hn8 = (f8_t*)take(16); p.kc = (bf16_t*)take(1); p.vc = (bf16_t*)take(1); p.states = (bf16_t*)take(16); p.rws = (bf16_t*)take(1);
    p.act = (f8_t*)take(72); p.ymoe = (f8_t*)take(72);
    p.posb = (float*)take(1); p.alast = (float*)take(1); p.ssq = (float*)take(1); p.h1 = (bf16_t*)take(32); p.wlist = (float*)take(2); p.list = (int*)take(2); p.tinfo = (int*)take(1);
    static int grid = 0;
    if (!grid) {
        int dev = 0, cus = 0, per_cu = 0;
        (void)hipGetDevice(&dev); (void)hipDeviceGetAttribute(&cus, hipDeviceAttributeMultiprocessorCount, dev);
        (void)hipFuncSetAttribute((const void*)k_fused, hipFuncAttributeMaxDynamicSharedMemorySize, LDS_FUSED);
        (void)hipOccupancyMaxActiveBlocksPerMultiprocessor(&per_cu, (const void*)k_fused, 512, LDS_FUSED);
        (void)hipGetLastError();
        grid = cus > 0 ? cus : 256;
    }
    (void)hipMemsetAsync(p.ctl, 0, 65536, stream);
#ifndef MK_SPLIT
    p.ph_lo = 0; p.ph_hi = 9;
    hipLaunchKernelGGL(k_fused, dim3(grid), dim3(512), LDS_FUSED, stream, p);
#else
    for (int k = 0; k < 9; ++k) { p.ph_lo = k; p.ph_hi = k + 1; hipLaunchKernelGGL(k_fused, dim3(grid), dim3(512), LDS_FUSED, stream, p); }
#endif
}
```

```cpp
#include <hip/hip_runtime.h>
#include <stdint.h>
#include <string.h>
#include <math.h>
namespace mk {
#define LAS __attribute__((address_space(3)))
typedef unsigned short bf16_t;
typedef short bf16x8 __attribute__((ext_vector_type(8)));
typedef float f32x4 __attribute__((ext_vector_type(4)));
typedef unsigned u32x4 __attribute__((ext_vector_type(4)));
typedef unsigned u32x2 __attribute__((ext_vector_type(2)));
typedef float f2_t __attribute__((ext_vector_type(2)));
constexpr int NB = 8, S = 2048, D = 1024, T = NB * S, NE = 32;
constexpr int BM = 256, BK = 64, HALF = 128, HTB = HALF * BK * 2, STAGE_BYTES = 8 * HTB, NXCD = 8, WGM = 8;
constexpr int CNT_STRIDE = 32;
constexpr int KD = 1024;
constexpr int NPROJ = 3072;
constexpr int MAXSLOT = 65536 + 32 * 256;
constexpr int LDS_MISC = 131072, LDS_TILE_E = LDS_MISC + 64, LDS_TILE_M = LDS_TILE_E + 1536, LDS_CNT = LDS_MISC + 3200, LDS_ROWTAB = LDS_MISC + 4096, LDS_BIASTAB = LDS_ROWTAB + 12 * 1024, LDS_BYTES = LDS_BIASTAB + 12 * 1024;

__host__ __device__ __forceinline__ int lds_byte(int r, int c) { const int st = (r >> 4) * 2 + (c >> 5), rr = r & 15, cc = c & 31, ob = rr * 64 + cc * 2; return st * 1024 + (ob ^ (((ob >> 9) & 1) << 5)); }
__host__ __device__ __forceinline__ void stage_rc(int b, int& R, int& C) { const int st = b / 1024, sb = b % 1024, swz = sb ^ (((sb >> 9) & 1) << 5); R = (st >> 1) * 16 + swz / 64; C = (st & 1) * 32 + (swz % 64) / 2; }
__host__ __device__ __forceinline__ int perm32(int rho) { const int n = rho >> 4, i = rho & 15; return 8 * (i >> 2) + 4 * n + (i & 3); }
__device__ __forceinline__ unsigned cvt_pk_bf16(float lo, float hi) { unsigned r; asm volatile("v_cvt_pk_bf16_f32 %0, %1, %2" : "=v"(r) : "v"(lo), "v"(hi)); return r; }
__device__ __forceinline__ int tid_fresh() { int t = threadIdx.x; asm volatile("" : "+v"(t)); return t; }
__device__ __forceinline__ float bf2f(bf16_t b) { return __uint_as_float(((unsigned)b) << 16); }

struct Unit { int pm, pn, e, mt, li; };
struct StaticOrder {
    int nM, nN, nwg, G, c;
    __device__ __forceinline__ void init(int M, int N, int G_, int c_) { nM = M / BM; nN = N / BM; nwg = nM * nN; G = G_; c = c_; }
    __device__ __forceinline__ bool next(int i, Unit& u) const {
        const long L = (long)i * G + c; if (L >= nwg) return false;
        int wgid = (int)L; { const int q = nwg / NXCD, r = nwg % NXCD, xcd = wgid % NXCD, off = wgid / NXCD; wgid = (xcd < r ? xcd * (q + 1) : r * (q + 1) + (xcd - r) * q) + off; }
        const int nig = WGM * nN, gid = wgid / nig, fm = gid * WGM, gsz = (nM - fm) < WGM ? (nM - fm) : WGM;
        u.pm = fm + ((wgid % nig) % gsz); u.pn = (wgid % nig) / gsz; u.e = 0; u.mt = 0; u.li = i; return true;
    }
};
struct MoeOrder {
    int nN, G, c, RT; const LAS int* tile_e; const LAS int* tile_m;
    __device__ __forceinline__ bool next(int i, Unit& u) const { const int L = i * G + c; if (L >= RT * nN) return false; const int rt = L / nN; u.pm = rt; u.pn = L - rt * nN; u.e = tile_e[rt]; u.mt = tile_m[rt]; u.li = i; return true; }
};

struct ProbProj {
    static constexpr bool F8 = false, MIDSCALE = false; static constexpr int PERM = 2, ROWB = KD * 2;
    StaticOrder S; const bf16_t* A; const bf16_t* Bt; bf16_t* O;
    __device__ __forceinline__ bool next(int i, Unit& u) const { return S.next(i, u); }
    __device__ __forceinline__ const char* a_base(const Unit& u) const { return (const char*)A + (size_t)u.pm * (BM * KD * 2); }
    __device__ __forceinline__ const char* b_base(const Unit& u) const { return (const char*)Bt + (size_t)u.pn * (BM * KD * 2); }
    __device__ __forceinline__ void a_offs(int, const Unit&, unsigned (&v0)[2], unsigned (&v1)[2], const int (&R)[2], const int (&C)[2]) const {
#pragma unroll
        for (int i = 0; i < 2; ++i) { v0[i] = (unsigned)(R[i] * KD + C[i]) * 2u; v1[i] = v0[i] + (unsigned)(HALF * KD * 2); } }
    __device__ __forceinline__ void epi(const f32x4 (&acc)[2][2][4][2], const Unit& u, int wr, int wc, int fr, int fq) const {
        const int row0 = u.pm * BM + wr * 64 + fr, col0 = u.pn * BM + wc * 64 + 16 * fq;
#pragma unroll
        for (int ai = 0; ai < 2; ++ai)
#pragma unroll
            for (int m = 0; m < 4; ++m) { bf16_t* rowp = O + (size_t)(row0 + ai * HALF + m * 16) * NPROJ + col0;
#pragma unroll
                for (int bj = 0; bj < 2; ++bj) { const f32x4 v0 = acc[ai][bj][m][0], v1 = acc[ai][bj][m][1]; u32x4 w;
                    w.x = cvt_pk_bf16(v0[0], v0[1]); w.y = cvt_pk_bf16(v0[2], v0[3]); w.z = cvt_pk_bf16(v1[0], v1[1]); w.w = cvt_pk_bf16(v1[2], v1[3]);
                    *(u32x4*)(rowp + bj * 8) = w; } }
    }
};
struct ProbOut {
    static constexpr bool F8 = false, MIDSCALE = true; static constexpr int PERM = 2, ROWB = KD * 2;
    StaticOrder S; const bf16_t* A; const bf16_t* Bt; const float* R0; bf16_t* O; const float* ssq;
    __device__ __forceinline__ void midscale(f32x4 (&acc)[2][2][4][2], const Unit& u, int wr, int fr) const {
        asm volatile("" : "+v"(fr));
#pragma unroll
        for (int ai = 0; ai < 2; ++ai)
#pragma unroll
            for (int m = 0; m < 4; ++m) { const int row = u.pm * BM + ai * HALF + wr * 64 + m * 16 + fr; const f2_t q = *(const f2_t*)(ssq + (size_t)row * 2);
                const float rs = rsqrtf((q[0] + q[1]) * (1.f / 512.f) + 1e-6f);
#pragma unroll
                for (int bj = 0; bj < 2; ++bj)
#pragma unroll
                    for (int n = 0; n < 2; ++n) acc[ai][bj][m][n] = acc[ai][bj][m][n] * rs;
                asm volatile("" ::: "memory"); } }
    __device__ __forceinline__ bool next(int i, Unit& u) const { return S.next(i, u); }
    __device__ __forceinline__ const char* a_base(const Unit& u) const { return (const char*)A + (size_t)u.pm * (BM * KD * 2); }
    __device__ __forceinline__ const char* b_base(const Unit& u) const { return (const char*)Bt + (size_t)u.pn * (BM * KD * 2); }
    __device__ __forceinline__ void a_offs(int, const Unit&, unsigned (&v0)[2], unsigned (&v1)[2], const int (&R)[2], const int (&C)[2]) const {
#pragma unroll
        for (int i = 0; i < 2; ++i) { v0[i] = (unsigned)(R[i] * KD + C[i]) * 2u; v1[i] = v0[i] + (unsigned)(HALF * KD * 2); } }
    __device__ __forceinline__ void epi(const f32x4 (&acc)[2][2][4][2], const Unit& u, int wr, int wc, int fr, int fq) const {
        const int row0 = u.pm * BM + wr * 64 + fr, col0 = u.pn * BM + wc * 64 + 16 * fq;
#pragma unroll
        for (int ai = 0; ai < 2; ++ai)
#pragma unroll
            for (int m = 0; m < 4; ++m) { const size_t off = (size_t)(row0 + ai * HALF + m * 16) * D + col0;
#pragma unroll
                for (int bj = 0; bj < 2; ++bj) { const f32x4 r0 = *(const f32x4*)(R0 + off + bj * 8), r1 = *(const f32x4*)(R0 + off + bj * 8 + 4);
                    const f32x4 o0 = acc[ai][bj][m][0] + r0, o1 = acc[ai][bj][m][1] + r1; u32x4 w;
                    w.x = cvt_pk_bf16(o0[0], o0[1]); w.y = cvt_pk_bf16(o0[2], o0[3]); w.z = cvt_pk_bf16(o1[0], o1[1]); w.w = cvt_pk_bf16(o1[2], o1[3]);
                    *(u32x4*)(O + off + bj * 8) = w; }
                asm volatile("" ::: "memory"); }
    }
};
typedef unsigned char f8_t;
typedef int i32x8 __attribute__((ext_vector_type(8)));
typedef int i32x4 __attribute__((ext_vector_type(4)));
constexpr float W8_SCALE = 32.f, W8_INV = 1.f / 32.f;
__device__ __forceinline__ unsigned pk4_fp8(float a, float b, float c, float d) { int r = __builtin_amdgcn_cvt_pk_fp8_f32(a, b, 0, false); r = __builtin_amdgcn_cvt_pk_fp8_f32(c, d, r, true); return (unsigned)r; }
struct ProbMoe1 {
    static constexpr bool F8 = true, MIDSCALE = false; static constexpr int PERM = 1, ROWB = KD;
    MoeOrder S; const f8_t* A; const f8_t* Bt; const LAS float* btab; f8_t* O; const LAS unsigned* rowtab;
    __device__ __forceinline__ bool next(int i, Unit& u) const { return S.next(i, u); }
    __device__ __forceinline__ const char* a_base(const Unit&) const { return (const char*)A; }
    __device__ __forceinline__ const char* b_base(const Unit& u) const { return (const char*)Bt + ((size_t)u.e * 2048 + (size_t)u.pn * BM) * ROWB; }
    __device__ __forceinline__ void a_offs(int i, const Unit&, unsigned (&v0)[2], unsigned (&v1)[2], const int (&R)[2], const int (&C)[2]) const {
#pragma unroll
        for (int j = 0; j < 2; ++j) { v0[j] = rowtab[i * 256 + R[j]] + (unsigned)C[j] * 2u; v1[j] = rowtab[i * 256 + HALF + R[j]] + (unsigned)C[j] * 2u; } }
    __device__ __forceinline__ void epi(const f32x4 (&acc)[2][2][4][2], const Unit& u, int wr, int wc, int fr, int fq) const {
        const int row0 = u.pm * BM + wr * 64 + fr, jg0 = u.pn * HALF + wc * 32 + 8 * fq;
        f32x4 bg[2], bu[2];
#pragma unroll
        for (int n = 0; n < 2; ++n) { bg[n] = *(const LAS f32x4*)(btab + u.li * 256 + wc * 32 + 8 * fq + 4 * n); bu[n] = *(const LAS f32x4*)(btab + u.li * 256 + 128 + wc * 32 + 8 * fq + 4 * n); }
        const bool odd = (fq & 1) != 0; const int jg1 = jg0 - (odd ? 8 : 0);
#pragma unroll
        for (int ai = 0; ai < 2; ++ai)
#pragma unroll
            for (int mp = 0; mp < 2; ++mp) { unsigned d[2][2];
#pragma unroll
                for (int mm = 0; mm < 2; ++mm) { const int m = 2 * mp + mm; float o[8];
#pragma unroll
                    for (int n = 0; n < 2; ++n) { const f32x4 g4 = acc[ai][0][m][n] * W8_INV + bg[n], u4 = acc[ai][1][m][n] * W8_INV + bu[n];
#pragma unroll
                        for (int j = 0; j < 4; ++j) { const float g = fminf(g4[j], 7.f), uu = __builtin_amdgcn_fmed3f(u4[j], -7.f, 7.f);
                            const float sg = __builtin_amdgcn_rcpf(1.f + __builtin_amdgcn_exp2f(-1.702f * 1.4426950408889634f * g)); o[n * 4 + j] = __builtin_fmaf(uu, g, g) * sg; } }
                    d[mm][0] = pk4_fp8(o[0], o[1], o[2], o[3]); d[mm][1] = pk4_fp8(o[4], o[5], o[6], o[7]); }
                const unsigned s0 = odd ? d[0][0] : d[1][0], s1 = odd ? d[0][1] : d[1][1];
                const unsigned r0 = (unsigned)__shfl_xor((int)s0, 16), r1 = (unsigned)__shfl_xor((int)s1, 16);
                const unsigned k0 = odd ? d[1][0] : d[0][0], k1 = odd ? d[1][1] : d[0][1];
                const u32x4 w = odd ? (u32x4){r0, r1, k0, k1} : (u32x4){k0, k1, r0, r1};
                *(u32x4*)(O + (size_t)(row0 + ai * HALF + (2 * mp + (odd ? 1 : 0)) * 16) * 1024 + jg1) = w; }
    }
};
struct ProbMoe2 {
    static constexpr bool F8 = true, MIDSCALE = false; static constexpr int PERM = 2, ROWB = KD;
    MoeOrder S; const f8_t* A; const f8_t* Bt; const LAS float* btab; f8_t* O;
    __device__ __forceinline__ bool next(int i, Unit& u) const { return S.next(i, u); }
    __device__ __forceinline__ const char* a_base(const Unit& u) const { return (const char*)A + (size_t)u.pm * (BM * ROWB); }
    __device__ __forceinline__ const char* b_base(const Unit& u) const { return (const char*)Bt + ((size_t)u.e * 1024 + (size_t)u.pn * BM) * ROWB; }
    __device__ __forceinline__ void a_offs(int, const Unit&, unsigned (&v0)[2], unsigned (&v1)[2], const int (&R)[2], const int (&C)[2]) const {
#pragma unroll
        for (int i = 0; i < 2; ++i) { v0[i] = (unsigned)(R[i] * ROWB + C[i] * 2); v1[i] = v0[i] + (unsigned)(HALF * ROWB); } }
    __device__ __forceinline__ void epi(const f32x4 (&acc)[2][2][4][2], const Unit& u, int wr, int wc, int fr, int fq) const {
        const int rl0 = wr * 64 + fr, cl0 = wc * 64 + 16 * fq, col0 = u.pn * BM + cl0;
#pragma unroll
        for (int ai = 0; ai < 2; ++ai)
#pragma unroll
            for (int m = 0; m < 4; ++m) { const int rl = rl0 + ai * HALF + m * 16;
                f8_t* rowp = O + (size_t)(u.pm * BM + rl) * 1024 + col0; u32x4 w; unsigned d[4];
#pragma unroll
                for (int bj = 0; bj < 2; ++bj) { const f32x4 b0 = *(const LAS f32x4*)(btab + u.li * 256 + cl0 + bj * 8), b1 = *(const LAS f32x4*)(btab + u.li * 256 + cl0 + bj * 8 + 4);
                    const f32x4 v0 = acc[ai][bj][m][0] * W8_INV + b0, v1 = acc[ai][bj][m][1] * W8_INV + b1;
                    d[2 * bj] = pk4_fp8(v0[0], v0[1], v0[2], v0[3]); d[2 * bj + 1] = pk4_fp8(v1[0], v1[1], v1[2], v1[3]); }
                w.x = d[0]; w.y = d[1]; w.z = d[2]; w.w = d[3];
                *(u32x4*)rowp = w;
                asm volatile("" ::: "memory"); }
    }
};

template <int N> struct FragBf { bf16x8 v[N][2];
    __device__ __forceinline__ void set(int i, int k, i32x4 x) { v[i][k] = __builtin_bit_cast(bf16x8, x); }
    __device__ __forceinline__ bf16x8 get(int i, int k) const { return v[i][k]; } };
template <int N> struct FragF8 { i32x8 v[N];
    __device__ __forceinline__ void set(int i, int k, i32x4 x) { if (k == 0) v[i].lo = x; else v[i].hi = x; }
    __device__ __forceinline__ bf16x8 get(int, int) const { return bf16x8{}; } };
template <bool F8> struct FragT { typedef FragBf<4> A_t; typedef FragBf<2> B_t; };
template <> struct FragT<true> { typedef FragF8<4> A_t; typedef FragF8<2> B_t; };
template <class P>
__device__ __forceinline__ void gemm_phase(LAS unsigned char* lds, const P& Pb) {
    const int tid = tid_fresh(), wid = __builtin_amdgcn_readfirstlane(tid >> 6), lane = tid & 63, wr = wid >> 2, wc = wid & 3, fr = lane & 15, fq = lane >> 4;
    constexpr int nt = P::ROWB / 128;
    int Rr[2], Cc[2]; unsigned voffB[2];
#pragma unroll
    for (int i = 0; i < 2; ++i) { int R, C; stage_rc(tid * 16 + i * 8192, R, C); const int Rb = (P::PERM == 2) ? ((R >> 5) * 64 + ((R >> 2) & 3) * 16 + ((R >> 4) & 1) * 4 + (R & 3)) : (P::PERM == 1) ? ((R & ~31) + perm32(R & 31)) : R; Rr[i] = R; Cc[i] = C; voffB[i] = (unsigned)(Rb * P::ROWB + C * 2); }
    constexpr size_t kstep = (size_t)(BK * 2);
    constexpr size_t hstep = (size_t)((P::PERM == 2) ? 8 : HALF) * P::ROWB;
    const unsigned ldsw = (unsigned)wid * 1024u;
    const int aoff = lds_byte(wr * 64 + fr, fq * 8), boff = lds_byte(wc * 32 + fr, fq * 8);
#define PG8_SA(b, h) (((b) * 2 + (h)) * HTB)
#define PG8_SB(b, h) ((4 + (b) * 2 + (h)) * HTB)
#define PG8_STAGE(bufoff, gbase, voff) do { _Pragma("unroll") for (int _i = 0; _i < 2; ++_i) \
        __builtin_amdgcn_global_load_lds((const unsigned*)((const char*)(gbase) + (voff)[_i]), (LAS unsigned*)(lds + (bufoff) + ldsw + _i * 8192), 16, 0, 0); } while (0)
#define PG8_LDA(dst, b, h) do { _Pragma("unroll") for (int m = 0; m < 4; ++m) _Pragma("unroll") for (int k = 0; k < 2; ++k) dst.set(m, k, *(const LAS i32x4*)(lds + PG8_SA(b, h) + aoff + m * 2048 + k * 1024)); } while (0)
#define PG8_LDB(dst, b, h) do { _Pragma("unroll") for (int n = 0; n < 2; ++n) _Pragma("unroll") for (int k = 0; k < 2; ++k) dst.set(n, k, *(const LAS i32x4*)(lds + PG8_SB(b, h) + boff + n * 2048 + k * 1024)); } while (0)
#define PG8_MMA(ai, bj, At, Bt) do { __builtin_amdgcn_s_setprio(1); _Pragma("unroll") for (int m = 0; m < 4; ++m) _Pragma("unroll") for (int n = 0; n < 2; ++n) { \
        if constexpr (P::F8) acc[ai][bj][m][n] = __builtin_amdgcn_mfma_scale_f32_16x16x128_f8f6f4(Bt.v[n], At.v[m], acc[ai][bj][m][n], 0, 0, 0, 0x7f7f7f7f, 0, 0x7f7f7f7f); \
        else { _Pragma("unroll") for (int k = 0; k < 2; ++k) acc[ai][bj][m][n] = __builtin_amdgcn_mfma_f32_16x16x32_bf16(Bt.get(n, k), At.get(m, k), acc[ai][bj][m][n], 0, 0, 0); } } \
        __builtin_amdgcn_s_setprio(0); } while (0)
#define PG8_WAIT_V(n) asm volatile("s_waitcnt vmcnt(" #n ")" ::: "memory")
#define PG8_WAIT_L(n) asm volatile("s_waitcnt lgkmcnt(" #n ")" ::: "memory")
#define PG8_BAR __builtin_amdgcn_s_barrier()
#define PG8_SCHED __builtin_amdgcn_sched_barrier(0)
    Unit cur, nxt; int ui = 0;
    if (!Pb.next(0, cur)) return;
    f32x4 acc[2][2][4][2];
#pragma unroll
    for (int a = 0; a < 2; ++a)
#pragma unroll
        for (int b = 0; b < 2; ++b)
#pragma unroll
            for (int m = 0; m < 4; ++m)
#pragma unroll
                for (int n = 0; n < 2; ++n) acc[a][b][m][n] = (f32x4){0.f, 0.f, 0.f, 0.f};
    typedef typename FragT<P::F8>::A_t AFr; typedef typename FragT<P::F8>::B_t BFr;
    AFr At; BFr B0, B1;
    unsigned vA0[2], vA1[2];
    Pb.a_offs(0, cur, vA0, vA1, Rr, Cc);
    const char* cA = Pb.a_base(cur); const char* cB = Pb.b_base(cur);
    PG8_STAGE(PG8_SB(0, 0), cB, voffB); PG8_STAGE(PG8_SB(0, 1), cB + hstep, voffB); PG8_STAGE(PG8_SA(0, 0), cA, vA0); PG8_STAGE(PG8_SA(0, 1), cA, vA1);
    if (wr == 1) PG8_BAR;
    PG8_WAIT_V(2); PG8_BAR;
    PG8_STAGE(PG8_SB(1, 0), cB + kstep, voffB); PG8_STAGE(PG8_SA(1, 0), cA + kstep, vA0); PG8_STAGE(PG8_SB(1, 1), cB + hstep + kstep, voffB);
    PG8_WAIT_V(6); PG8_BAR;
    for (;;) {
        const bool has_next = Pb.next(ui + 1, nxt);
        const char* nA = has_next ? Pb.a_base(nxt) : cA; const char* nB = has_next ? Pb.b_base(nxt) : cB;
#ifdef MK_KX2
#define PG8_NTL (P::F8 ? 2 * nt : nt)
#define PG8_KOF(x) (P::F8 ? ((x) & (nt - 1)) : (x))
#else
#define PG8_NTL nt
#define PG8_KOF(x) (x)
#endif
#define PG8_KITER \
            const bool last = (t == PG8_NTL - 2); \
            if constexpr (P::MIDSCALE) { if (t == 8) Pb.midscale(acc, cur, wr, fr); } \
            const char* a1 = cA + (size_t)PG8_KOF(t + 1) * kstep; \
            const char* a2 = last ? nA : cA + (size_t)PG8_KOF(t + 2) * kstep; const char* b2 = last ? nB : cB + (size_t)PG8_KOF(t + 2) * kstep; \
            const char* a3 = a2 + kstep; const char* b3 = b2 + kstep; \
            PG8_LDB(B0, 0, 0); PG8_LDB(B1, 0, 1); PG8_SCHED; PG8_LDA(At, 0, 0); PG8_STAGE(PG8_SA(1, 1), a1, vA1); \
            PG8_WAIT_V(8); PG8_WAIT_L(0); PG8_BAR; PG8_MMA(0, 0, At, B0); PG8_MMA(0, 1, At, B1); PG8_BAR; PG8_SCHED; \
            if (last && has_next) { \
                if constexpr (P::F8) { int R2[2], C2[2]; int t2 = tid; asm volatile("" : "+v"(t2)); \
_Pragma("unroll") \
                    for (int i = 0; i < 2; ++i) stage_rc(t2 * 16 + i * 8192, R2[i], C2[i]); \
                    Pb.a_offs(ui + 1, nxt, vA0, vA1, R2, C2); } \
                else Pb.a_offs(ui + 1, nxt, vA0, vA1, Rr, Cc); } \
            PG8_LDA(At, 0, 1); PG8_STAGE(PG8_SB(0, 0), b2, voffB); PG8_STAGE(PG8_SB(0, 1), b2 + hstep, voffB); PG8_STAGE(PG8_SA(0, 0), a2, vA0); \
            PG8_WAIT_V(8); PG8_WAIT_L(0); PG8_BAR; PG8_MMA(1, 0, At, B0); PG8_MMA(1, 1, At, B1); PG8_BAR; PG8_SCHED; \
            PG8_LDB(B0, 1, 0); PG8_LDB(B1, 1, 1); PG8_SCHED; PG8_LDA(At, 1, 0); PG8_STAGE(PG8_SA(0, 1), a2, vA1); \
            PG8_WAIT_V(8); PG8_WAIT_L(0); PG8_BAR; PG8_MMA(0, 0, At, B0); PG8_MMA(0, 1, At, B1); PG8_BAR; PG8_SCHED; \
            PG8_LDA(At, 1, 1); PG8_STAGE(PG8_SB(1, 0), b3, voffB); PG8_STAGE(PG8_SB(1, 1), b3 + hstep, voffB); PG8_STAGE(PG8_SA(1, 0), a3, vA0); \
            PG8_WAIT_V(8); PG8_WAIT_L(0); PG8_BAR; PG8_MMA(1, 0, At, B0); PG8_MMA(1, 1, At, B1); PG8_BAR; PG8_SCHED;
        if constexpr (P::F8) {
#pragma unroll 1
            for (int t = 0; t < PG8_NTL; t += 2) { PG8_KITER }
        } else {
            for (int t = 0; t < nt; t += 2) { PG8_KITER }
        }
#undef PG8_KITER
        if (wr == 0) PG8_BAR;
#ifdef MK_KX2
        if constexpr (P::F8) {
#pragma unroll
            for (int a = 0; a < 2; ++a)
#pragma unroll
                for (int b = 0; b < 2; ++b)
#pragma unroll
                    for (int m = 0; m < 4; ++m)
#pragma unroll
                        for (int n = 0; n < 2; ++n) acc[a][b][m][n] *= 0.5f; }
#endif
#ifdef MK_EPIX2
        if constexpr (P::F8) { int ln3 = lane; asm volatile("" : "+v"(ln3)); Pb.epi(acc, cur, wr, wc, ln3 & 15, ln3 >> 4); }
#endif
        if constexpr (P::F8) { int ln2 = lane; asm volatile("" : "+v"(ln2)); Pb.epi(acc, cur, wr, wc, ln2 & 15, ln2 >> 4); } else Pb.epi(acc, cur, wr, wc, fr, fq);
        if (!has_next) break;
#pragma unroll
        for (int a = 0; a < 2; ++a)
#pragma unroll
            for (int b = 0; b < 2; ++b)
#pragma unroll
                for (int m = 0; m < 4; ++m)
#pragma unroll
                    for (int n = 0; n < 2; ++n) acc[a][b][m][n] = (f32x4){0.f, 0.f, 0.f, 0.f};
        cur = nxt; cA = nA; cB = nB; ++ui;
        if (wr == 1) PG8_BAR;
    }
    PG8_WAIT_V(0);
    PG8_BAR;
#undef PG8_SA
#undef PG8_SB
#undef PG8_STAGE
#undef PG8_LDA
#undef PG8_LDB
#undef PG8_MMA
#undef PG8_WAIT_V
#undef PG8_WAIT_L
#undef PG8_BAR
#undef PG8_SCHED
}

__device__ __forceinline__ int moe_tables(LAS unsigned char* lds, const int* cnt) {
    LAS int* tile_e = (LAS int*)(lds + LDS_TILE_E); LAS int* tile_m = (LAS int*)(lds + LDS_TILE_M); LAS int* rts = (LAS int*)(lds + LDS_MISC + 32); LAS int* lcnt = (LAS int*)(lds + LDS_CNT);
    const int t = tid_fresh();
    if (t < 64) {
        const int c = (t < NE) ? cnt[t * CNT_STRIDE] : 0; const int n = (c + 255) >> 8; int pre = n;
#pragma unroll
        for (int d = 1; d < 32; d <<= 1) { const int v = __shfl_up(pre, d, 64); if (t >= d) pre += v; }
        if (t < NE) { lcnt[t] = c; const int a0 = pre - n; for (int m = 0; m < n; ++m) { tile_e[a0 + m] = t; tile_m[a0 + m] = m; } }
        if (t == NE - 1) rts[0] = pre;
    }
    __syncthreads();
    return rts[0];
}
}
namespace mk {
__device__ __forceinline__ float wsum(float v) {
#pragma unroll
    for (int o = 1; o < 64; o <<= 1) v += __shfl_xor(v, o);
    return v; }
__device__ __forceinline__ unsigned short f2bf(float f) { unsigned u = __float_as_uint(f); u += 0x7FFFu + ((u >> 16) & 1u); return (unsigned short)(u >> 16); }
}
namespace mk {
typedef float f32x16 __attribute__((ext_vector_type(16)));
typedef short s16x4 __attribute__((ext_vector_type(4)));
typedef __bf16 bf2_t __attribute__((ext_vector_type(2)));
#define MFMA32(a, b, c) __builtin_amdgcn_mfma_f32_32x32x16_bf16((a), (b), (c), 0, 0, 0)
constexpr float LOG2E = 1.4426950408889634f;
constexpr int PROJ_LD = NPROJ;
constexpr int AT_NPB = 2  , AT_KBUF = 0, AT_VBUF = 16384, AT_IMPW = 32768, AT_SCORE = 2 * AT_NPB * 16384  , AT_OBUF = AT_SCORE + 8192, AT_OSTR = 528, AT_BTAB = AT_OBUF + 64 * AT_OSTR  ,
              AT_SEL = AT_BTAB + 8 * 132 * 4  , AT_SSQ = AT_SEL + 512  , AT_END = AT_SSQ + 8 * 64 * 4  ;
struct AttnArgs { const bf16_t* projb; const bf16_t* kc; const bf16_t* vc; bf16_t* catb; float* ssq; };

__device__ __forceinline__ unsigned pk2(float a, float b) { f2_t v = {a, b}; return __builtin_bit_cast(unsigned, __builtin_convertvector(v, bf2_t)); }
__device__ __forceinline__ int t5_bucket(int n) { if (n < 0) n = 0; if (n < 16) return n; const float nf = (float)n; const int l = 16 + (int)(logf(nf / 16.f) / 2.0794415416798357f * 16.f); return l < 31 ? l : 31; }
__device__ __forceinline__ float xh_max(float x) { const auto r = __builtin_amdgcn_permlane32_swap(__float_as_uint(x), __float_as_uint(x), false, false); return fmaxf(__uint_as_float(r[0]), __uint_as_float(r[1])); }
__device__ __forceinline__ float xh_sum(float x) { const auto r = __builtin_amdgcn_permlane32_swap(__float_as_uint(x), __float_as_uint(x), false, false); return __uint_as_float(r[0]) + __uint_as_float(r[1]); }
__device__ __forceinline__ float xh_other(float x, int h) { const auto r = __builtin_amdgcn_permlane32_swap(__float_as_uint(x), __float_as_uint(x), false, false); return __uint_as_float(h ? r[0] : r[1]); }
__device__ __forceinline__ void stage_tile(LAS unsigned char* dst, const char* src, size_t row_stride, int wid, int lane, bool vswz) {
    const int row = 8 * wid + (lane >> 3), slot = lane & 7;
    const int f = vswz ? (((row >> 1) & 1) << 2) : ((row >> 1) & 7);
    __builtin_amdgcn_global_load_lds((const unsigned*)(src + (size_t)row * row_stride + ((slot ^ f) << 4)), (LAS unsigned*)(dst + wid * 1024), 16, 0, 0);
}
#define AT_CROW(r, h) (((r) & 3) + 8 * ((r) >> 2) + 4 * (h))
#define AT_PACK8(x, s) __builtin_bit_cast(bf16x8, (u32x4){pk2((x)[8 * (s)], (x)[8 * (s) + 1]), pk2((x)[8 * (s) + 2], (x)[8 * (s) + 3]), pk2((x)[8 * (s) + 4], (x)[8 * (s) + 5]), pk2((x)[8 * (s) + 6], (x)[8 * (s) + 7])})
__device__ __forceinline__ bf16x8 vt_frag(const LAS unsigned char* vt, unsigned vaddr, int rowoff) {
    const s16x4 lo = __builtin_amdgcn_ds_read_tr16_b64_v4i16((LAS s16x4*)(vt + vaddr + rowoff * 128));
    const s16x4 hi = __builtin_amdgcn_ds_read_tr16_b64_v4i16((LAS s16x4*)(vt + vaddr + (rowoff + 8) * 128));
    return __builtin_shufflevector(lo, hi, 0, 1, 2, 3, 4, 5, 6, 7);
}
template <bool FIRST>
__device__ __forceinline__ void obuf_acc(LAS unsigned char* lds, int tl, int hd, int h, float sc, const f32x16 (&oc)[2]) {
#pragma unroll
    for (int c = 0; c < 2; ++c)
#pragma unroll
        for (int qd = 0; qd < 4; ++qd) { LAS u32x2* p = (LAS u32x2*)(lds + AT_OBUF + tl * AT_OSTR + ((hd & 3) * 64 + 32 * c + 8 * qd + 4 * h) * 2);
            float a0 = sc * oc[c][4 * qd], a1 = sc * oc[c][4 * qd + 1], a2 = sc * oc[c][4 * qd + 2], a3 = sc * oc[c][4 * qd + 3];
            if (!FIRST) { const u32x2 o = *p; a0 += __uint_as_float(o.x << 16); a1 += __uint_as_float(o.x & 0xffff0000u); a2 += __uint_as_float(o.y << 16); a3 += __uint_as_float(o.y & 0xffff0000u); }
            *p = (u32x2){pk2(a0, a1), pk2(a2, a3)}; }
}
template <int KIND>
__device__ __forceinline__ void attn_tile(const LAS unsigned char* Kt, const LAS unsigned char* Vt, int kbase, int tq, bool sel, const bf16x8 (&qf)[4], const LAS float* bt, float cfar,
                                          f32x16 (&O)[2], float& m, float& l, int ql, int h, const unsigned (&vaddr)[2]) {
    f32x16 s0, s1;
#pragma unroll
    for (int r = 0; r < 16; ++r) { s0[r] = 0.f; s1[r] = 0.f; }
    const int fk = (ql >> 1) & 7;
#pragma unroll
    for (int s = 0; s < 4; ++s) { const int ch = ((2 * s + h) ^ fk) << 4;
        const bf16x8 k0 = *(const LAS bf16x8*)(Kt + ql * 128 + ch), k1 = *(const LAS bf16x8*)(Kt + (32 + ql) * 128 + ch);
        s0 = MFMA32(k0, qf[s], s0); s1 = MFMA32(k1, qf[s], s1); }
    float mx = -INFINITY;
    if (KIND == 0) {
#pragma unroll
        for (int r = 0; r < 16; ++r) mx = fmaxf(mx, fmaxf(s0[r], s1[r]));
        mx += cfar;
    } else {
        int tqq = tq - kbase; asm volatile("" : "+v"(tqq));
#pragma unroll
        for (int r = 0; r < 16; ++r) {
            const int d0 = tqq - AT_CROW(r, h), d1 = d0 - 32;
            float x0 = s0[r] + bt[min(max(d0, 0), 128)], x1 = s1[r] + bt[min(max(d1, 0), 128)];
            if (KIND == 2) { x0 = (d0 >= 0 && d0 < 512) ? x0 : -INFINITY; x1 = (d1 >= 0 && d1 < 512) ? x1 : -INFINITY; }
            s0[r] = x0; s1[r] = x1; mx = fmaxf(mx, fmaxf(x0, x1)); }
    }
    mx = sel ? mx : -INFINITY;
    mx = xh_max(mx);
    const float mn = fmaxf(m, mx);
    const float alpha = __builtin_amdgcn_exp2f(m - mn);
    float msub = sel ? mn : INFINITY;
    if (KIND == 0) msub -= cfar;
    float ps = 0.f;
#pragma unroll
    for (int r = 0; r < 16; ++r) { const float p0 = __builtin_amdgcn_exp2f(s0[r] - msub), p1 = __builtin_amdgcn_exp2f(s1[r] - msub); s0[r] = p0; s1[r] = p1; ps += p0 + p1; }
    l = l * alpha + ps; m = mn;
    if (__any(alpha != 1.f)) {
#pragma unroll
        for (int r = 0; r < 16; ++r) { O[0][r] *= alpha; O[1][r] *= alpha; } }
#pragma unroll
    for (int sp = 0; sp < 2; ++sp) {
        const bf16x8 p0 = AT_PACK8(s0, sp), p1 = AT_PACK8(s1, sp);
#pragma unroll
        for (int c = 0; c < 2; ++c) { O[c] = MFMA32(vt_frag(Vt, vaddr[c], 16 * sp), p0, O[c]); O[c] = MFMA32(vt_frag(Vt, vaddr[c], 32 + 16 * sp), p1, O[c]); }
    }
}
template <int MODE>
__device__ __forceinline__ void attn_branch(LAS unsigned char* lds, unsigned U, unsigned mysel, const char* kcol, const char* vcol, size_t RS, int blk, int tq, const bf16x8 (&qf)[4],
                                            const LAS float* bt, float cfar, f32x16 (&oc)[2], float& m, float& l, int ql, int h, const unsigned (&vaddr)[2], int wid, int lane) {
#define AT_NEXT(n) (((n) >= 31) ? -1 : ((U & ~((2u << (n)) - 1u)) ? __builtin_ctz(U & ~((2u << (n)) - 1u)) : -1))
#define AT_ISSUE(n, st) do { stage_tile(lds + (st) * 16384, kcol + (size_t)(n) * 64 * RS, RS, wid, lane, false); stage_tile(lds + (st) * 16384 + 8192, vcol + (size_t)(n) * 64 * RS, RS, wid, lane, true); } while (0)
    int tl_[AT_NPB], pb = 0;
    tl_[0] = __builtin_ctz(U | 0x80000000u);
#pragma unroll
    for (int q = 1; q < AT_NPB; ++q) tl_[q] = (tl_[q - 1] >= 0) ? AT_NEXT(tl_[q - 1]) : -1;
    asm volatile("s_waitcnt lgkmcnt(0)" ::: "memory"); __builtin_amdgcn_s_barrier(); asm volatile("" ::: "memory");
#pragma unroll
    for (int q = 0; q < AT_NPB; ++q) if (tl_[q] >= 0) AT_ISSUE(tl_[q], q);
    for (;;) {
        asm volatile("s_waitcnt vmcnt(0)" ::: "memory");
        asm volatile("s_waitcnt lgkmcnt(0)" ::: "memory"); __builtin_amdgcn_s_barrier(); asm volatile("" ::: "memory");
        int nx[AT_NPB];
        nx[0] = (tl_[AT_NPB - 1] >= 0) ? AT_NEXT(tl_[AT_NPB - 1]) : -1;
#pragma unroll
        for (int q = 1; q < AT_NPB; ++q) nx[q] = (nx[q - 1] >= 0) ? AT_NEXT(nx[q - 1]) : -1;
#pragma unroll
        for (int q = 0; q < AT_NPB; ++q) if (nx[q] >= 0) AT_ISSUE(nx[q], AT_NPB * (pb ^ 1) + q);
#pragma unroll
        for (int q = 0; q < AT_NPB; ++q) { const int tcur = tl_[q]; if (tcur < 0) break;
            const LAS unsigned char* Kt = lds + (AT_NPB * pb + q) * 16384; const LAS unsigned char* Vt = Kt + 8192;
            const bool sel = (MODE == 0) ? (((mysel >> tcur) & 1u) != 0u) : true;
            const bool masked = (tcur == blk) || (MODE == 1 && tcur + 8 == blk);
            if (masked) attn_tile<2>(Kt, Vt, tcur * 64, tq, sel, qf, bt, cfar, oc, m, l, ql, h, vaddr);
            else if (tcur + 3 <= blk) attn_tile<0>(Kt, Vt, tcur * 64, tq, sel, qf, bt, cfar, oc, m, l, ql, h, vaddr);
            else attn_tile<1>(Kt, Vt, tcur * 64, tq, sel, qf, bt, cfar, oc, m, l, ql, h, vaddr); }
        if (nx[0] < 0) break;
#pragma unroll
        for (int q = 0; q < AT_NPB; ++q) tl_[q] = nx[q];
        pb ^= 1;
    }
#undef AT_NEXT
#undef AT_ISSUE
}

__device__ __forceinline__ void attn_item(LAS unsigned char* lds, const AttnArgs& A, int b, int qt, int kvh) {
    const int tid = tid_fresh(), wid = __builtin_amdgcn_readfirstlane(tid >> 6), lane = tid & 63;
    const int g = wid >> 1, th = wid & 1, ql = lane & 31, h = lane >> 5;
    const int t0 = qt * 64, tl = th * 32 + ql, tq = t0 + tl, blk = qt;
    const int qq = (lane & 15) >> 2, pp = lane & 3, lb = (lane >> 4) & 1;
    unsigned vaddr[2];
#pragma unroll
    for (int c = 0; c < 2; ++c) vaddr[c] = (unsigned)((4 * h + qq) * 128 + (((4 * (c ^ ((qq >> 1) & 1))) + 2 * lb + (pp >> 1)) << 4) + 8 * (pp & 1));
    LAS float* impw = (LAS float*)(lds + AT_IMPW); LAS float* score = (LAS float*)(lds + AT_SCORE); LAS unsigned* selm = (LAS unsigned*)(lds + AT_SEL);
    const char* prow0 = (const char*)(A.projb + (size_t)b * S * PROJ_LD);
    const size_t RS = (size_t)PROJ_LD * 2;
    {
        const int hd = kvh * 4 + g;
        const LAS float* bt = (const LAS float*)(lds + AT_BTAB) + hd * 132;
        const float cfar = bt[128];
        bf16x8 qf[4];
#pragma unroll
        for (int s = 0; s < 4; ++s) qf[s] = *(const bf16x8*)(A.projb + ((size_t)b * S + tq) * PROJ_LD + hd * 64 + 16 * s + 8 * h);
        float gate[3];
#pragma unroll
        for (int j = 0; j < 3; ++j) { const float gv = bf2f(A.projb[((size_t)b * S + tq) * PROJ_LD + 1280 + j * 8 + hd]); gate[j] = 1.f / (1.f + __expf(-gv)); }
        __syncthreads();
        { const char* kcb = (const char*)(A.kc + (size_t)(b * 2 + kvh) * 128 * 64); const char* vcb = (const char*)(A.vc + (size_t)(b * 2 + kvh) * 128 * 64);
          stage_tile(lds + AT_KBUF, kcb, 128, wid, lane, false); stage_tile(lds + AT_KBUF + 8192, kcb + 64 * 128, 128, wid, lane, false);
          stage_tile(lds + AT_VBUF, vcb, 128, wid, lane, true); stage_tile(lds + AT_VBUF + 8192, vcb + 64 * 128, 128, wid, lane, true); }
        asm volatile("s_waitcnt vmcnt(0)" ::: "memory"); __syncthreads();
        {
            f32x16 sc[4]; const int fk = (ql >> 1) & 7; int tqc = tq; asm volatile("" : "+v"(tqc));
            const int nkb = ((t0 + 32) >> 4) / 32 + 1;
#pragma unroll
            for (int kb = 0; kb < 4; ++kb) {
#pragma unroll
                for (int r = 0; r < 16; ++r) sc[kb][r] = 0.f;
                if (kb < nkb) {
#pragma unroll
                for (int s = 0; s < 4; ++s) { const bf16x8 kf = *(const LAS bf16x8*)(lds + AT_KBUF + (32 * kb + ql) * 128 + (((2 * s + h) ^ fk) << 4)); sc[kb] = MFMA32(kf, qf[s], sc[kb]); } }
                __builtin_amdgcn_sched_barrier(0); }
            float mx = -INFINITY;
#pragma unroll
            for (int kb = 0; kb < 4; ++kb) {
                if (kb >= nkb) {
#pragma unroll
                    for (int r = 0; r < 16; ++r) sc[kb][r] = -INFINITY;
                    continue; }
#pragma unroll
                for (int r = 0; r < 16; ++r) { const int c = 32 * kb + AT_CROW(r, h); const int dist = tqc - 16 * c - 31; const float bv = bt[min(max(dist, 0), 128)]; const float x = (dist >= 0) ? sc[kb][r] + bv : -INFINITY; sc[kb][r] = x; mx = fmaxf(mx, x);
                    if ((r & 7) == 7) __builtin_amdgcn_sched_barrier(0); } }
            mx = xh_max(mx);
            const float mref = (mx == -INFINITY) ? 0.f : mx;
            float ls = 0.f;
#pragma unroll
            for (int kb = 0; kb < 4; ++kb) {
                if (kb >= nkb) {
#pragma unroll
                    for (int r = 0; r < 16; ++r) sc[kb][r] = 0.f;
                    continue; }
#pragma unroll
                for (int r = 0; r < 16; ++r) { const float p = __builtin_amdgcn_exp2f(sc[kb][r] - mref); sc[kb][r] = p; ls += p; } }
            ls = xh_sum(ls);
            const float inv = 1.f / fmaxf(ls, 1e-30f);
#pragma unroll
            for (int kb = 0; kb < 4; ++kb) { if (kb >= nkb) continue;
#pragma unroll
                for (int r = 0; r < 16; ++r) sc[kb][r] *= inv; }
            if (blk >= 16) { float carry = 0.f;
#pragma unroll
              for (int i = 0; i < 16; ++i) { const int kb = i >> 2, qd = i & 3;
                  const float s4 = (sc[kb][4 * qd] + sc[kb][4 * qd + 1]) + (sc[kb][4 * qd + 2] + sc[kb][4 * qd + 3]);
                  const float rv = xh_other(sc[kb][4 * qd + 3], h);
                  impw[(wid * 32 + ql) * 32 + 2 * i + h] = s4 + (h ? rv : carry); carry = rv; } }
            f32x16 oc[2];
#pragma unroll
            for (int r = 0; r < 16; ++r) { oc[0][r] = 0.f; oc[1][r] = 0.f; }
#pragma unroll
            for (int kb = 0; kb < 4; ++kb) { if (kb >= nkb) continue;
#pragma unroll
                for (int sp = 0; sp < 2; ++sp) { const bf16x8 pf = AT_PACK8(sc[kb], sp);
#pragma unroll
                    for (int c = 0; c < 2; ++c) oc[c] = MFMA32(vt_frag(lds + AT_VBUF, vaddr[c], 32 * kb + 16 * sp), pf, oc[c]);
                    __builtin_amdgcn_sched_barrier(0); } }
            obuf_acc<true>(lds, tl, hd, h, gate[0], oc);
        }
        __syncthreads();
        unsigned U = (blk >= 31) ? 0xffffffffu : ((2u << blk) - 1u);
        if (blk >= 16) {
        int tids = tid; asm volatile("" : "+v"(tids));
#pragma unroll
        for (int i = 0; i < 4; ++i) { const int id = tids + 512 * i, tk = id >> 5, n = id & 31, w0 = tk >> 5, q = tk & 31;
            float v = 0.f;
#pragma unroll
            for (int gg = 0; gg < 4; ++gg) v += impw[((2 * gg + w0) * 32 + q) * 32 + n];
            const bool forced = (n == 0) || (n == blk) || (n == blk - 1);
            score[tk * 32 + n] = forced ? 1e4f : ((n <= blk) ? v : -1.f); }
        __syncthreads();
        { const int tk = tids >> 3, part = tids & 7;
          float sv[32];
#pragma unroll
          for (int e4 = 0; e4 < 8; ++e4) { const f32x4 q4 = *(const LAS f32x4*)(score + tk * 32 + e4 * 4); sv[e4 * 4] = q4[0]; sv[e4 * 4 + 1] = q4[1]; sv[e4 * 4 + 2] = q4[2]; sv[e4 * 4 + 3] = q4[3]; }
          unsigned bits = 0u;
#pragma unroll
          for (int j = 0; j < 4; ++j) { const int n = 4 * part + j; const float sn = score[tk * 32 + n];
              int rank = 0;
#pragma unroll
              for (int mm = 0; mm < 32; ++mm) rank += (sv[mm] > sn || (sv[mm] == sn && mm < n)) ? 1 : 0;
              bits |= ((rank < 16) && (n <= blk)) ? (1u << n) : 0u; }
          bits |= (unsigned)__shfl_xor((int)bits, 1); bits |= (unsigned)__shfl_xor((int)bits, 2); bits |= (unsigned)__shfl_xor((int)bits, 4);
          if (part == 0) selm[tk] = bits; }
        __syncthreads();
        U = selm[lane];
#pragma unroll
        for (int o = 1; o < 64; o <<= 1) U |= (unsigned)__shfl_xor((int)U, o);
        U = (unsigned)__builtin_amdgcn_readfirstlane((int)U);
        }
        const unsigned mysel = (blk >= 16) ? selm[tl] : U;
        {
            f32x16 oc[2];
#pragma unroll
            for (int r = 0; r < 16; ++r) { oc[0][r] = 0.f; oc[1][r] = 0.f; }
            float m = -1e30f, l = 0.f;
            attn_branch<0>(lds, U, mysel, prow0 + (512 + 2 * 128 + kvh * 64) * 2, prow0 + (512 + 3 * 128 + kvh * 64) * 2, RS, blk, tq, qf, bt, cfar, oc, m, l, ql, h, vaddr, wid, lane);
            l = xh_sum(l);
            const float sc1 = gate[1] / fmaxf(l, 1e-30f);
            obuf_acc<false>(lds, tl, hd, h, sc1, oc);
        }
        {
            f32x16 oc[2];
#pragma unroll
            for (int r = 0; r < 16; ++r) { oc[0][r] = 0.f; oc[1][r] = 0.f; }
            float m = -1e30f, l = 0.f;
            const int lo = (blk >= 8) ? blk - 8 : 0;
            const unsigned Uw = ((blk >= 31) ? 0xffffffffu : ((2u << blk) - 1u)) & ~((1u << lo) - 1u);
            attn_branch<1>(lds, Uw, 0u, prow0 + (512 + 4 * 128 + kvh * 64) * 2, prow0 + (512 + 5 * 128 + kvh * 64) * 2, RS, blk, tq, qf, bt, cfar, oc, m, l, ql, h, vaddr, wid, lane);
            l = xh_sum(l);
            const float sc2 = gate[2] / fmaxf(l, 1e-30f);
            obuf_acc<false>(lds, tl, hd, h, sc2, oc);
        }
    }
    __syncthreads();
    int widn = wid; asm volatile("" : "+s"(widn));
    { u32x2 v[8]; float sq[8];
#pragma unroll
      for (int i = 0; i < 8; ++i) { v[i] = *(const LAS u32x2*)(lds + AT_OBUF + (widn + 8 * i) * AT_OSTR + lane * 8);
          const float f0 = __uint_as_float(v[i].x << 16), f1 = __uint_as_float(v[i].x & 0xffff0000u), f2 = __uint_as_float(v[i].y << 16), f3 = __uint_as_float(v[i].y & 0xffff0000u);
          sq[i] = (f0 * f0 + f1 * f1) + (f2 * f2 + f3 * f3); }
#pragma unroll
      for (int o = 1; o < 64; o <<= 1) {
#pragma unroll
          for (int i = 0; i < 8; ++i) sq[i] += __shfl_xor(sq[i], o); }
#pragma unroll
      for (int i = 0; i < 8; ++i) { const int row = widn + 8 * i;
          *(u32x2*)(A.catb + ((size_t)b * S + t0 + row) * 1024 + kvh * 256 + lane * 4) = v[i];
          if (lane == 0) A.ssq[((size_t)b * S + t0 + row) * 2 + kvh] = sq[i]; } }
    __syncthreads();
}
__device__ __forceinline__ void attn_btab(LAS unsigned char* lds, const float* rel_bias) {
    LAS float* bt = (LAS float*)(lds + AT_BTAB);
    float v[3];
#pragma unroll
    for (int q = 0; q < 3; ++q) { const int i = (int)threadIdx.x + 512 * q; const int hd = i / 129, d = i % 129; v[q] = (i < 8 * 129) ? rel_bias[t5_bucket(d) * 8 + hd] : 0.f; }
#pragma unroll
    for (int q = 0; q < 3; ++q) { const int i = (int)threadIdx.x + 512 * q; const int hd = i / 129, d = i % 129; if (i < 8 * 129) bt[hd * 132 + d] = v[q] * LOG2E; }
    __syncthreads();
}
}
namespace mk {
constexpr int XBC_OFF = 1816, Z_OFF = 1304, DT_OFF = 2840, NCH = 16;
constexpr int SD_XS = 0, SD_B = 65536, SD_C = 98304, SD_PREV = 131072  , SD_ACS = SD_PREV + 16384, SD_DT = SD_ACS + 2048, SD_W = SD_DT + 2048, SD_WP = SD_W + 2048  , SD_END = SD_WP + 256;
struct SsdArgs { const bf16_t* projb; const float* conv_w; const float* conv_b; const float* dt_bias; const float* a_log; const float* d_skip; bf16_t* states; float* alast; bf16_t* catb; };

__device__ __forceinline__ void ssd_dt_acs(LAS unsigned char* lds, const SsdArgs& A, int b, int c, int grp, int wid, int lane) {
    if (wid < 4) { const int hd = grp * 4 + wid; const float Ah = -__expf(A.a_log[hd]), db = A.dt_bias[hd];
        const size_t row = (size_t)b * S + c * 128 + 2 * lane;
        float x0 = bf2f(A.projb[row * PROJ_LD + DT_OFF + hd]) + db, x1 = bf2f(A.projb[(row + 1) * PROJ_LD + DT_OFF + hd]) + db;
        const float d0 = (x0 > 20.f) ? x0 : log1pf(__expf(x0)), d1 = (x1 > 20.f) ? x1 : log1pf(__expf(x1));
        const float a0 = d0 * Ah, a1 = d1 * Ah; float incl = a0 + a1;
#pragma unroll
        for (int o = 1; o < 64; o <<= 1) { const float t = __shfl_up(incl, o); if (lane >= o) incl += t; }
        LAS float* acs = (LAS float*)(lds + SD_ACS) + wid * 128; LAS float* dtl = (LAS float*)(lds + SD_DT) + wid * 128;
        acs[2 * lane] = incl - a1; acs[2 * lane + 1] = incl; dtl[2 * lane] = d0; dtl[2 * lane + 1] = d1;
        LAS float* lw = (LAS float*)(lds + SD_W) + wid * 128;
        lw[2 * lane] = (__logf(d0) - (incl - a1)) * 1.4426950408889634f; lw[2 * lane + 1] = (__logf(d1) - incl) * 1.4426950408889634f; }
}
template <bool PHASE_A>
__device__ __forceinline__ void ssd_conv(LAS unsigned char* lds, const SsdArgs& A, int b, int c, int grp, int wid, int lane) {
    const int ch = lane;
    if (PHASE_A && ch >= 48) return;
    const int rel = (ch < 32) ? grp * 256 + ch * 8 : (ch < 48) ? 512 + grp * 128 + (ch - 32) * 8 : 768 + grp * 128 + (ch - 48) * 8;
    float w[4][8], bias[8];
#pragma unroll
    for (int k = 0; k < 4; ++k) { const f32x4 u0 = *(const f32x4*)(A.conv_w + k * 1024 + rel), u1 = *(const f32x4*)(A.conv_w + k * 1024 + rel + 4);
#pragma unroll
        for (int j = 0; j < 4; ++j) { w[k][j] = u0[j]; w[k][4 + j] = u1[j]; } }
    { const f32x4 u0 = *(const f32x4*)(A.conv_b + rel), u1 = *(const f32x4*)(A.conv_b + rel + 4);
#pragma unroll
      for (int j = 0; j < 4; ++j) { bias[j] = u0[j]; bias[4 + j] = u1[j]; } }
    const int tl0 = wid * 16, ts0 = c * 128 + tl0;
    const bf16_t* src = A.projb + ((size_t)b * S + ts0) * PROJ_LD + XBC_OFF + rel;
    float x0[8], x1[8], x2[8];
#pragma unroll
    for (int j = 0; j < 8; ++j) { x0[j] = 0.f; x1[j] = 0.f; x2[j] = 0.f; }
    if (ts0 >= 3) {
        const bf16x8 r0 = *(const bf16x8*)(src - 3 * (ptrdiff_t)PROJ_LD), r1 = *(const bf16x8*)(src - 2 * (ptrdiff_t)PROJ_LD), r2 = *(const bf16x8*)(src - 1 * (ptrdiff_t)PROJ_LD);
#pragma unroll
        for (int j = 0; j < 8; ++j) { x0[j] = bf2f((bf16_t)r0[j]); x1[j] = bf2f((bf16_t)r1[j]); x2[j] = bf2f((bf16_t)r2[j]); } }
    const LAS float* wt = (const LAS float*)(lds + SD_W) + (ch >> 3) * 128;
    bf16x8 rvv[16];
#pragma unroll
    for (int i = 0; i < 16; ++i) rvv[i] = *(const bf16x8*)(src + (size_t)i * PROJ_LD);
#pragma unroll
    for (int i = 0; i < 16; ++i) {
        const bf16x8 rv = rvv[i];
        float x3[8], o[8];
#pragma unroll
        for (int j = 0; j < 8; ++j) { x3[j] = bf2f((bf16_t)rv[j]); const float a = bias[j] + w[0][j] * x0[j] + w[1][j] * x1[j] + w[2][j] * x2[j] + w[3][j] * x3[j]; o[j] = a * __builtin_amdgcn_rcpf(1.f + __builtin_amdgcn_exp2f(-1.4426950408889634f * a)); x0[j] = x1[j]; x1[j] = x2[j]; x2[j] = x3[j]; }
        const int row = tl0 + i;
        if (PHASE_A && ch < 32) { const float sc = wt[row];
#pragma unroll
            for (int j = 0; j < 8; ++j) o[j] *= sc; }
        u32x4 pk; pk.x = pk2(o[0], o[1]); pk.y = pk2(o[2], o[3]); pk.z = pk2(o[4], o[5]); pk.w = pk2(o[6], o[7]);
        if (ch < 32) *(LAS u32x4*)(lds + SD_XS + row * 512 + ((ch ^ ((row & 3) << 2)) << 4)) = pk;
        else if (ch < 48) { const int cc = ch - 32; *(LAS u32x4*)(lds + SD_B + row * 256 + ((PHASE_A ? (cc ^ ((row & 3) << 2)) : (cc ^ (row & 15))) << 4)) = pk; }
        else { const int cc = ch - 48; *(LAS u32x4*)(lds + SD_C + row * 256 + ((cc ^ (row & 15)) << 4)) = pk; }
    }
}
__device__ __forceinline__ bf16x8 tr_frag2(const LAS unsigned char* base, int stride, int r0, int r1, int chunk0, int qq, int pp) {
    const int cl = chunk0 + (pp >> 1);
    const s16x4 lo = __builtin_amdgcn_ds_read_tr16_b64_v4i16((LAS s16x4*)(base + (r0 + qq) * stride + ((cl ^ (qq << 2)) << 4) + 8 * (pp & 1)));
    const s16x4 hi = __builtin_amdgcn_ds_read_tr16_b64_v4i16((LAS s16x4*)(base + (r1 + qq) * stride + ((cl ^ (qq << 2)) << 4) + 8 * (pp & 1)));
    return __builtin_shufflevector(lo, hi, 0, 1, 2, 3, 4, 5, 6, 7);
}
__device__ __forceinline__ void ssd_a_item(LAS unsigned char* lds, const SsdArgs& A, int item) {
    const int tid = tid_fresh(), wid = __builtin_amdgcn_readfirstlane(tid >> 6), lane = tid & 63;
    const int grp = item & 1, c = (item >> 1) & 15, b = item >> 5;
    const int ql = lane & 31, h = lane >> 5, qq = (lane & 15) >> 2, pp = lane & 3, lb2 = (lane >> 4) & 1;
    __syncthreads();
    ssd_dt_acs(lds, A, b, c, grp, wid, lane);
    __syncthreads();
    { LAS float* acs = (LAS float*)(lds + SD_ACS); LAS float* dtl = (LAS float*)(lds + SD_DT); LAS float* wt = (LAS float*)(lds + SD_W);
      const int hh = tid >> 7, t = tid & 127; const float al = acs[hh * 128 + 127];
      wt[hh * 128 + t] = dtl[hh * 128 + t] * __expf(al - acs[hh * 128 + t]);
      if (t == 0) A.alast[(b * 8 + grp * 4 + hh) * NCH + c] = al; }
    __syncthreads();
    ssd_conv<true>(lds, A, b, c, grp, wid, lane);
    __syncthreads();
    const int pb = wid >> 2, nb = wid & 3;
#pragma unroll 1
    for (int hh = 0; hh < 4; ++hh) {
        f32x16 acc;
#pragma unroll
        for (int r = 0; r < 16; ++r) acc[r] = 0.f;
#pragma unroll
        for (int kk = 0; kk < 8; ++kk) {
            const bf16x8 af = tr_frag2(lds + SD_XS, 512, 16 * kk + 8 * h, 16 * kk + 8 * h + 4, hh * 8 + 4 * pb + 2 * lb2, qq, pp);
            const bf16x8 bf = tr_frag2(lds + SD_B, 256, 16 * kk + 8 * h, 16 * kk + 8 * h + 4, 4 * nb + 2 * lb2, qq, pp);
            acc = MFMA32(af, bf, acc); }
        bf16_t* st = A.states + ((size_t)((b * NCH + c) * 8 + grp * 4 + hh) * 64) * 128;
#pragma unroll
        for (int r = 0; r < 16; ++r) st[(32 * pb + AT_CROW(r, h)) * 128 + 32 * nb + ql] = f2bf(acc[r]);
    }
}
__device__ __forceinline__ void ssd_b_item(LAS unsigned char* lds, const SsdArgs& A, int item) {
    const int tid = tid_fresh(), wid = __builtin_amdgcn_readfirstlane(tid >> 6), lane = tid & 63;
    const int grp = item & 1, b = (item >> 1) & 7, c = 15 - (item >> 4);
    const int ql = lane & 31, h = lane >> 5, qq = (lane & 15) >> 2, pp = lane & 3, lb2 = (lane >> 4) & 1;
    const int pb = wid >> 2, lb = wid & 3;
    LAS float* acs = (LAS float*)(lds + SD_ACS); LAS float* dtl = (LAS float*)(lds + SD_DT); LAS float* wp = (LAS float*)(lds + SD_WP);
    __syncthreads();
    ssd_dt_acs(lds, A, b, c, grp, wid, lane);
    if (tid >= 256 && tid < 320) { const int hh = (tid - 256) >> 4, cp = tid & 15; float s = 0.f;
        float al[16];
#pragma unroll
        for (int c2 = 0; c2 < 16; ++c2) al[c2] = A.alast[(b * 8 + grp * 4 + hh) * NCH + c2];
#pragma unroll
        for (int c2 = 0; c2 < 16; ++c2) s += (c2 > cp && c2 < c) ? al[c2] : 0.f;
        wp[hh * 16 + cp] = (cp < c) ? __expf(s) : 0.f; }
    ssd_conv<false>(lds, A, b, c, grp, wid, lane);
    __syncthreads();
#pragma unroll 1
    for (int hh = 0; hh < 4; ++hh) {
        const int hd = grp * 4 + hh;
        const float Dh = A.d_skip[hd];
        u32x2 zz4[4];
        { const bf16_t* zp = A.projb + ((size_t)b * S + c * 128 + 32 * lb + ql) * PROJ_LD + Z_OFF + hd * 64 + 32 * pb + 4 * h;
#pragma unroll
          for (int qd = 0; qd < 4; ++qd) zz4[qd] = *(const u32x2*)(zp + 8 * qd); }
        { float pv[16];
#pragma unroll
          for (int j = 0; j < 16; ++j) pv[j] = 0.f;
          const int p = tid >> 3, n0 = (tid & 7) * 16;
          const bf16_t* sp0 = A.states + ((size_t)((b * NCH) * 8 + hd) * 64 + p) * 128 + n0;
#pragma unroll
          for (int g8 = 0; g8 < 2; ++g8) {
              if (g8 * 8 < c) { bf16x8 s0[8], s1[8];
#pragma unroll
                  for (int u = 0; u < 8; ++u) { const bf16_t* sp = sp0 + (size_t)(g8 * 8 + u) * (8 * 64 * 128); s0[u] = *(const bf16x8*)sp; s1[u] = *(const bf16x8*)(sp + 8); }
#pragma unroll
                  for (int u = 0; u < 8; ++u) { const float wgt = wp[hh * 16 + g8 * 8 + u];
                      if (wgt != 0.f) {
#pragma unroll
                          for (int j = 0; j < 8; ++j) { pv[j] += wgt * bf2f((bf16_t)s0[u][j]); pv[8 + j] += wgt * bf2f((bf16_t)s1[u][j]); } } } } }
          LAS unsigned char* pbuf = lds + SD_PREV + p * 256;
          *(LAS u32x4*)(pbuf + ((((n0 >> 3)) ^ (p & 15)) << 4)) = (u32x4){pk2(pv[0], pv[1]), pk2(pv[2], pv[3]), pk2(pv[4], pv[5]), pk2(pv[6], pv[7])};
          *(LAS u32x4*)(pbuf + ((((n0 >> 3) + 1) ^ (p & 15)) << 4)) = (u32x4){pk2(pv[8], pv[9]), pk2(pv[10], pv[11]), pk2(pv[12], pv[13]), pk2(pv[14], pv[15])}; }
        __syncthreads();
        f32x16 acc;
#pragma unroll
        for (int r = 0; r < 16; ++r) acc[r] = 0.f;
#pragma unroll
        for (int kk = 0; kk < 8; ++kk) {
            const bf16x8 af = *(const LAS bf16x8*)(lds + SD_PREV + (32 * pb + ql) * 256 + (((2 * kk + h) ^ (ql & 15)) << 4));
            const bf16x8 bf = *(const LAS bf16x8*)(lds + SD_C + (32 * lb + ql) * 256 + (((2 * kk + h) ^ (ql & 15)) << 4));
            acc = MFMA32(af, bf, acc); }
        const float al = acs[hh * 128 + 32 * lb + ql];
        { const float e = __expf(al);
#pragma unroll
          for (int r = 0; r < 16; ++r) acc[r] *= e; }
        const float al2 = al * 1.4426950408889634f; const LAS float* lw = (const LAS float*)(lds + SD_W);
#pragma unroll
        for (int sb = 0; sb < 4; ++sb) {
            if (sb <= lb) {
                f32x16 Pm;
#pragma unroll
                for (int r = 0; r < 16; ++r) Pm[r] = 0.f;
#pragma unroll
                for (int kk = 0; kk < 8; ++kk) {
                    const bf16x8 gf = *(const LAS bf16x8*)(lds + SD_B + (32 * sb + ql) * 256 + (((2 * kk + h) ^ (ql & 15)) << 4));
                    const bf16x8 cf = *(const LAS bf16x8*)(lds + SD_C + (32 * lb + ql) * 256 + (((2 * kk + h) ^ (ql & 15)) << 4));
                    Pm = MFMA32(gf, cf, Pm); }
#pragma unroll
                for (int r = 0; r < 16; ++r) { const int sl = 32 * sb + AT_CROW(r, h), ll = 32 * lb + ql;
                    float v = Pm[r] * __builtin_amdgcn_exp2f(al2 + lw[hh * 128 + sl]); v = (sl <= ll) ? v : 0.f; v += (sl == ll) ? Dh : 0.f; Pm[r] = v; }
#pragma unroll
                for (int sp = 0; sp < 2; ++sp) { const bf16x8 pf = AT_PACK8(Pm, sp);
                    const bf16x8 af = tr_frag2(lds + SD_XS, 512, 32 * sb + 16 * sp + 4 * h, 32 * sb + 16 * sp + 8 + 4 * h, hh * 8 + 4 * pb + 2 * lb2, qq, pp);
                    acc = MFMA32(af, pf, acc); } }
        }
        {
#pragma unroll
          for (int qd = 0; qd < 4; ++qd) { const u32x2 zz = zz4[qd];
              const float z0 = __uint_as_float(zz.x << 16), z1 = __uint_as_float(zz.x & 0xffff0000u), z2 = __uint_as_float(zz.y << 16), z3 = __uint_as_float(zz.y & 0xffff0000u);
              acc[4 * qd] *= z0 * __builtin_amdgcn_rcpf(1.f + __builtin_amdgcn_exp2f(-1.4426950408889634f * z0)); acc[4 * qd + 1] *= z1 * __builtin_amdgcn_rcpf(1.f + __builtin_amdgcn_exp2f(-1.4426950408889634f * z1));
              acc[4 * qd + 2] *= z2 * __builtin_amdgcn_rcpf(1.f + __builtin_amdgcn_exp2f(-1.4426950408889634f * z2)); acc[4 * qd + 3] *= z3 * __builtin_amdgcn_rcpf(1.f + __builtin_amdgcn_exp2f(-1.4426950408889634f * z3)); } }
        __syncthreads();
#pragma unroll
        for (int qd = 0; qd < 4; ++qd) { const int row = 32 * lb + ql, chn = hh * 8 + 4 * pb + qd;
            *(LAS u32x2*)(lds + SD_XS + row * 512 + ((chn ^ ((row & 3) << 2)) << 4) + 8 * h) = (u32x2){pk2(acc[4 * qd], acc[4 * qd + 1]), pk2(acc[4 * qd + 2], acc[4 * qd + 3])}; }
    }
    __syncthreads();
    int widn = wid; asm volatile("" : "+s"(widn));
#pragma unroll 1
    for (int i0 = 0; i0 < 16; i0 += 8) { u32x2 v[8]; float sq[8]; const int chn = lane >> 1;
#pragma unroll
        for (int i = 0; i < 8; ++i) { const int row = widn + 8 * (i0 + i);
            v[i] = *(const LAS u32x2*)(lds + SD_XS + row * 512 + ((chn ^ ((row & 3) << 2)) << 4) + 8 * (lane & 1));
            const float f0 = __uint_as_float(v[i].x << 16), f1 = __uint_as_float(v[i].x & 0xffff0000u), f2 = __uint_as_float(v[i].y << 16), f3 = __uint_as_float(v[i].y & 0xffff0000u);
            sq[i] = (f0 * f0 + f1 * f1) + (f2 * f2 + f3 * f3); }
#pragma unroll
        for (int o = 1; o < 64; o <<= 1) {
#pragma unroll
            for (int i = 0; i < 8; ++i) sq[i] += __shfl_xor(sq[i], o); }
#pragma unroll
        for (int i = 0; i < 8; ++i) { const int row = widn + 8 * (i0 + i); const float rs = rsqrtf(sq[i] * (1.f / 256.f) + 1e-6f);
            const float f0 = __uint_as_float(v[i].x << 16), f1 = __uint_as_float(v[i].x & 0xffff0000u), f2 = __uint_as_float(v[i].y << 16), f3 = __uint_as_float(v[i].y & 0xffff0000u);
            *(u32x2*)(A.catb + ((size_t)b * S + c * 128 + row) * 1024 + 512 + grp * 256 + lane * 4) = (u32x2){pk2(f0 * rs, f1 * rs), pk2(f2 * rs, f3 * rs)}; } }
}
}
namespace mk {
template <int NR>
__device__ __forceinline__ void rms_rows_bf16(const float* x, bf16_t* o, int r0, int lane) {
    f32x4 v[NR][4]; float s[NR];
#pragma unroll
    for (int i = 0; i < NR; ++i) { const int r = r0 + i; const float* xr = x + (size_t)(r < T ? r : 0) * D;
#pragma unroll
        for (int j = 0; j < 4; ++j) v[i][j] = *(const f32x4*)(xr + lane * 4 + 256 * j); }
#pragma unroll
    for (int i = 0; i < NR; ++i) { s[i] = 0.f;
#pragma unroll
        for (int j = 0; j < 4; ++j) s[i] += (v[i][j][0] * v[i][j][0] + v[i][j][1] * v[i][j][1]) + (v[i][j][2] * v[i][j][2] + v[i][j][3] * v[i][j][3]); }
#pragma unroll
    for (int o2 = 1; o2 < 64; o2 <<= 1) {
#pragma unroll
        for (int i = 0; i < NR; ++i) s[i] += __shfl_xor(s[i], o2); }
#pragma unroll
    for (int i = 0; i < NR; ++i) { const int r = r0 + i; if (r >= T) break; const float rs = rsqrtf(s[i] * (1.f / 1024.f) + 1e-6f);
#pragma unroll
        for (int j = 0; j < 4; ++j) *(u32x2*)(o + (size_t)r * D + lane * 4 + 256 * j) = (u32x2){pk2(v[i][j][0] * rs, v[i][j][1] * rs), pk2(v[i][j][2] * rs, v[i][j][3] * rs)}; }
}
constexpr int WT_PITCH = 68, WT_TILE_BYTES = 64 * WT_PITCH * 4;
template <bool OUT8>
__device__ __forceinline__ void wt_tile(bool dry, const float* W, void* WTv, const float* gk1, const float* gk2, int ksplit, int K, int N, int NP, int mode, int nscale, float sc, int ntn, int ntk,
                                        int tile, LAS float* tl, int lane) {
    const int per = ntn * ntk, z = tile / per, rem = tile % per, n0 = (rem % ntn) * 64;
    const float* Wz = W + (size_t)z * K * N;
  for (int sub = 0; sub < (OUT8 ? 2 : 1); ++sub) {
    const int k0 = ((rem / ntn) * (OUT8 ? 2 : 1) + sub) * 64;
    const int lr = lane >> 4, lc = (lane & 15) * 4;
    f32x4 v[16];
#pragma unroll
    for (int i = 0; i < 16; ++i) { const int k = k0 + 4 * i + lr, n = n0 + lc; v[i] = (n < N) ? *(const f32x4*)(Wz + (size_t)k * N + n) : (f32x4){0.f, 0.f, 0.f, 0.f}; }
    if (gk1) {
#pragma unroll
        for (int i = 0; i < 16; ++i) { const int k = k0 + 4 * i + lr; const float g = (k < ksplit) ? gk1[k] : gk2[k - ksplit]; v[i] = v[i] * g; } }
#pragma unroll
    for (int i = 0; i < 16; ++i) { const int kk = 4 * i + lr; const int sw = OUT8 ? (((kk >> 4) & 3) << 3) : (((kk >> 3) & 7) << 2); *(LAS f32x4*)(tl + kk * WT_PITCH + (lc ^ sw)) = v[i]; }
    asm volatile("s_waitcnt lgkmcnt(0)" ::: "memory");
    if constexpr (OUT8) {
        const int kq = lane & 3; f8_t* WTz = (f8_t*)WTv + (size_t)z * NP * K;
#pragma unroll
        for (int it = 0; it < 4; ++it) { const int nl = 16 * it + (lane >> 2), n = n0 + nl; const float s = (n < nscale) ? sc : 1.f;
            int nm = n; if (mode == 1) { const int up = n >> 10, jj = n & 1023; nm = (jj >> 7) * 256 + up * 128 + (jj & 127); }
            const LAS float* src = tl + (16 * kq) * WT_PITCH + (nl ^ (kq << 3));
            u32x4 w;
            w.x = pk4_fp8(src[0] * s, src[WT_PITCH] * s, src[2 * WT_PITCH] * s, src[3 * WT_PITCH] * s); w.y = pk4_fp8(src[4 * WT_PITCH] * s, src[5 * WT_PITCH] * s, src[6 * WT_PITCH] * s, src[7 * WT_PITCH] * s);
            w.z = pk4_fp8(src[8 * WT_PITCH] * s, src[9 * WT_PITCH] * s, src[10 * WT_PITCH] * s, src[11 * WT_PITCH] * s); w.w = pk4_fp8(src[12 * WT_PITCH] * s, src[13 * WT_PITCH] * s, src[14 * WT_PITCH] * s, src[15 * WT_PITCH] * s);
            if (dry) { asm volatile("" :: "v"(w)); continue; }
            *(u32x4*)(WTz + (size_t)nm * K + k0 + 16 * kq) = w; }
    } else {
        const int kq = lane & 7; bf16_t* WTz = (bf16_t*)WTv + (size_t)z * NP * K;
#pragma unroll
        for (int it = 0; it < 8; ++it) { const int nl = 8 * it + (lane >> 3), n = n0 + nl; const float s = (n < nscale) ? sc : 1.f;
            int nm = n; if (mode == 1) { const int up = n >> 10, jj = n & 1023; nm = (jj >> 7) * 256 + up * 128 + (jj & 127); }
            const LAS float* src = tl + (8 * kq) * WT_PITCH + (nl ^ (kq << 2));
            u32x4 w; w.x = pk2(src[0] * s, src[WT_PITCH] * s); w.y = pk2(src[2 * WT_PITCH] * s, src[3 * WT_PITCH] * s); w.z = pk2(src[4 * WT_PITCH] * s, src[5 * WT_PITCH] * s); w.w = pk2(src[6 * WT_PITCH] * s, src[7 * WT_PITCH] * s);
            *(u32x4*)(WTz + (size_t)nm * K + k0 + 8 * kq) = w; }
    }
    asm volatile("s_waitcnt lgkmcnt(0)" ::: "memory");
  }
}
struct Wt8 { const float* W; f8_t* WT; const float* gk; int K, N, nn, mode; };
__device__ __forceinline__ void wt8_load(f32x4 (&v)[16], const Wt8& J, int sid, int lane) {
    const int per = 8 * J.nn, z = sid / per, rem = sid % per, k0 = (rem / J.nn) * 128 + 16 * (lane >> 3), n0 = (rem % J.nn) * 32 + 4 * (lane & 7);
    const float* Wz = J.W + (size_t)z * J.K * J.N + (size_t)k0 * J.N + n0;
#pragma unroll
    for (int i = 0; i < 16; ++i) v[i] = *(const f32x4*)(Wz + (size_t)i * J.N);
}
__device__ __forceinline__ void wt8_store(f32x4 (&v)[16], const Wt8& J, int sid, float sc, int lane) {
    const int per = 8 * J.nn, z = sid / per, rem = sid % per, k0 = (rem / J.nn) * 128 + 16 * (lane >> 3), n0 = (rem % J.nn) * 32 + 4 * (lane & 7);
    float g[16];
    if (J.gk) {
#pragma unroll
        for (int q = 0; q < 4; ++q) { const f32x4 g4 = *(const f32x4*)(J.gk + k0 + 4 * q); g[4 * q] = g4[0] * sc; g[4 * q + 1] = g4[1] * sc; g[4 * q + 2] = g4[2] * sc; g[4 * q + 3] = g4[3] * sc; }
    } else {
#pragma unroll
        for (int i = 0; i < 16; ++i) g[i] = sc; }
    f8_t* WTz = J.WT + (size_t)z * J.N * J.K + k0;
#pragma unroll
    for (int j = 0; j < 4; ++j) { const int n = n0 + j;
        int nm = n; if (J.mode == 1) { const int up = n >> 10, jj = n & 1023; nm = (jj >> 7) * 256 + up * 128 + (jj & 127); }
        u32x4 w;
        w.x = pk4_fp8(v[0][j] * g[0], v[1][j] * g[1], v[2][j] * g[2], v[3][j] * g[3]); w.y = pk4_fp8(v[4][j] * g[4], v[5][j] * g[5], v[6][j] * g[6], v[7][j] * g[7]);
        w.z = pk4_fp8(v[8][j] * g[8], v[9][j] * g[9], v[10][j] * g[10], v[11][j] * g[11]); w.w = pk4_fp8(v[12][j] * g[12], v[13][j] * g[13], v[14][j] * g[14], v[15][j] * g[15]);
        *(u32x4*)(WTz + (size_t)nm * J.K) = w; }
}
constexpr int CP_KX = 0  , CP_RED = 69632  , CP_HID = CP_RED + 32768  , CP_END = CP_HID + 8192 + 256, CP_POSB = CP_END  , CP_W2 = CP_POSB + 2048  ;
struct CmpArgs { const bf16_t* projb; const bf16_t* w1T; const float* posb; const float* w2; bf16_t* kc; bf16_t* vc; };
__device__ __forceinline__ void cmp_item(LAS unsigned char* lds, const CmpArgs& A, int item) {
    const int tid = tid_fresh(), wid = __builtin_amdgcn_readfirstlane(tid >> 6), lane = tid & 63, ql = lane & 31, h = lane >> 5;
    const int cblk = item & 3, kvh = (item >> 2) & 1, b = (item >> 3) & 7, j = item >> 6;
    __syncthreads();
    { const int tok0 = 512 * cblk; const bf16_t* src = A.projb + ((size_t)b * S + tok0) * PROJ_LD + 512 + j * 128 + kvh * 64;
      u32x4 v[9];
#pragma unroll
      for (int q = 0; q < 9; ++q) { const int i = tid + 512 * q, r = i >> 3, ch = i & 7; v[q] = (u32x4){0u, 0u, 0u, 0u};
          if (i < 528 * 8 && tok0 + r < S) v[q] = *(const u32x4*)(src + (size_t)r * PROJ_LD + ch * 8); }
#pragma unroll
      for (int q = 0; q < 9; ++q) { const int i = tid + 512 * q, r = i >> 3, ch = i & 7;
          if (i < 528 * 8) *(LAS u32x4*)(lds + CP_KX + r * 128 + ((ch ^ ((r >> 4) & 7)) << 4)) = v[q]; } }
    { float a = 0.f; const int g = tid >> 6, n = tid & 63;
#pragma unroll
      for (int sl = 0; sl < 8; ++sl) a += A.posb[(j * 64 + 8 * g + sl) * 64 + n];
      ((LAS float*)(lds + CP_POSB))[tid] = a;
      const f32x4 w0 = *(const f32x4*)(A.w2 + (size_t)j * 4096 + tid * 4), w1 = *(const f32x4*)(A.w2 + (size_t)j * 4096 + 2048 + tid * 4);
      *(LAS f32x4*)(lds + CP_W2 + tid * 16) = w0; *(LAS f32x4*)(lds + CP_W2 + 8192 + tid * 16) = w1; }
    __syncthreads();
    const int nb = wid & 1, kq = wid >> 1;
    f32x16 acc;
#pragma unroll
    for (int r = 0; r < 16; ++r) acc[r] = 0.f;
    const bf16_t* wrow = A.w1T + ((size_t)j * 64 + 32 * nb + ql) * 2048;
#pragma unroll
    for (int li = 0; li < 8; ++li) { const int l = 8 * kq + li;
#pragma unroll
        for (int s = 0; s < 4; ++s) {
            const int row = 16 * ql + l;
            const bf16x8 af = *(const LAS bf16x8*)(lds + CP_KX + row * 128 + (((2 * s + h) ^ ((row >> 4) & 7)) << 4));
            const bf16x8 bf = *(const bf16x8*)(wrow + l * 64 + 16 * s + 8 * h);
            acc = MFMA32(af, bf, acc); } }
    { LAS float* red = (LAS float*)(lds + CP_RED) + kq * 2048;
#pragma unroll
      for (int r = 0; r < 16; ++r) red[AT_CROW(r, h) * 64 + 32 * nb + ql] = acc[r]; }
    __syncthreads();
    { LAS float* red = (LAS float*)(lds + CP_RED); LAS float* hid = (LAS float*)(lds + CP_HID); const LAS float* pbp = (const LAS float*)(lds + CP_POSB) + (tid & 63);
      const float pbs = ((pbp[0] + pbp[64]) + (pbp[128] + pbp[192])) + ((pbp[256] + pbp[320]) + (pbp[384] + pbp[448]));
      for (int i = tid; i < 2048; i += 512) { const float a = (red[i] + red[2048 + i]) + (red[4096 + i] + red[6144 + i]) + pbs; hid[i] = a * __builtin_amdgcn_rcpf(1.f + __builtin_amdgcn_exp2f(-1.4426950408889634f * a)); } }
    __syncthreads();
    { const LAS float* hid = (const LAS float*)(lds + CP_HID); bf16_t* out = (j ? A.vc : A.kc) + (size_t)(b * 2 + kvh) * 128 * 64;
      for (int i = tid; i < 2048; i += 512) { const int cl = i >> 6, n2 = i & 63; float a = 0.f;
#pragma unroll 8
          for (int n = 0; n < 64; ++n) a += hid[cl * 64 + n] * ((const LAS float*)(lds + CP_W2))[n * 64 + n2];
          const int c = 32 * cblk + cl; out[c * 64 + n2] = (c < 127) ? f2bf(a) : (bf16_t)0; } }
}
constexpr int RP_PART = 0  , RP_SSQ = 65536  , RP_RSTD = RP_SSQ + 2048, RP_LGT = 131072  , RP_LCNT = RP_LGT + 128 * 36 * 4;
struct RouteArgs { const bf16_t* h1; const bf16_t* rws; const float* router_b; f8_t* hn8; int* cnt; int* list; float* wlist; int* tinfo; };
__device__ __forceinline__ void route_phase(LAS unsigned char* lds, const RouteArgs& A, int wg, int nwg) {
    const int tid = tid_fresh(), wid = __builtin_amdgcn_readfirstlane(tid >> 6), lane = tid & 63, ql = lane & 31, h = lane >> 5;
    LAS float* part = (LAS float*)(lds + RP_PART); LAS float* ssqp = (LAS float*)(lds + RP_SSQ); LAS float* rstdv = (LAS float*)(lds + RP_RSTD);
    LAS float* lgt = (LAS float*)(lds + RP_LGT);
    LAS int* lcnt = (LAS int*)(lds + RP_LCNT); LAS int* gbase = lcnt + 32;
    const int ntl = (T - wg * 8 + nwg * 8 - 1) / (nwg * 8) * 8;
    __syncthreads();
    if (tid < 32) lcnt[tid] = 0;
    const int kof = 128 * wid + 64 * h;
    for (int g0 = 0; g0 < ntl; g0 += 64) {
        u32x4 af[2][8]; bool val[2]; size_t tokb[2];
#pragma unroll
        for (int mt = 0; mt < 2; ++mt) { const int sl = g0 + 32 * mt + ql; const int tok = wg * 8 + (sl & 7) + (sl >> 3) * nwg * 8; val[mt] = sl < ntl && tok < T; tokb[mt] = (size_t)tok * D;
#pragma unroll
            for (int ks = 0; ks < 8; ++ks) af[mt][ks] = val[mt] ? *(const u32x4*)(A.h1 + tokb[mt] + kof + 8 * ks) : (u32x4){0u, 0u, 0u, 0u}; }
        f32x16 acc[2];
#pragma unroll
        for (int r = 0; r < 16; ++r) { acc[0][r] = 0.f; acc[1][r] = 0.f; }
#pragma unroll
        for (int ks = 0; ks < 8; ++ks)
#pragma unroll
            for (int tm = 0; tm < 3; ++tm) { const bf16x8 bfr = *(const bf16x8*)(A.rws + (size_t)(tm * 32 + ql) * 1024 + kof + 8 * ks);
                acc[0] = MFMA32(__builtin_bit_cast(bf16x8, af[0][ks]), bfr, acc[0]); acc[1] = MFMA32(__builtin_bit_cast(bf16x8, af[1][ks]), bfr, acc[1]); }
#pragma unroll
        for (int mt = 0; mt < 2; ++mt) { float sq = 0.f;
#pragma unroll
            for (int ks = 0; ks < 8; ++ks)
#pragma unroll
                for (int c = 0; c < 4; ++c) { const unsigned u = af[mt][ks][c]; const float lo = __uint_as_float(u << 16), hi = __uint_as_float(u & 0xffff0000u); sq += lo * lo + hi * hi; }
            sq += __shfl_xor(sq, 32);
            if (h == 0) ssqp[wid * 64 + 32 * mt + ql] = sq;
#pragma unroll
            for (int r = 0; r < 16; ++r) part[(wid * 64 + 32 * mt + AT_CROW(r, h)) * 32 + ql] = acc[mt][r]; }
        __syncthreads();
        { const int row = tid >> 3, e4 = (tid & 7) * 4; float ss = 0.f; f32x4 sum = (f32x4){0.f, 0.f, 0.f, 0.f};
#pragma unroll
          for (int w = 0; w < 8; ++w) { ss += ssqp[w * 64 + row]; sum += *(const LAS f32x4*)(part + (w * 64 + row) * 32 + e4); }
          const float rs = rsqrtf(ss * (1.f / 1024.f) + 1e-6f); const f32x4 bias = *(const f32x4*)(A.router_b + e4);
          if (g0 + row < 128) *(LAS f32x4*)(lgt + (g0 + row) * 36 + e4) = sum * rs + bias;
          if ((tid & 7) == 0) rstdv[row] = rs; }
        __syncthreads();
#pragma unroll
        for (int mt = 0; mt < 2; ++mt) if (val[mt]) { const float rs = rstdv[32 * mt + ql];
#pragma unroll
            for (int q = 0; q < 4; ++q) { u32x4 w; unsigned d[4];
#pragma unroll
                for (int c2 = 0; c2 < 4; ++c2) { const u32x4 a = af[mt][2 * q + (c2 >> 1)]; const unsigned u0 = a[(c2 & 1) * 2], u1 = a[(c2 & 1) * 2 + 1];
                    d[c2] = pk4_fp8(__uint_as_float(u0 << 16) * rs, __uint_as_float(u0 & 0xffff0000u) * rs, __uint_as_float(u1 << 16) * rs, __uint_as_float(u1 & 0xffff0000u) * rs); }
                w.x = d[0]; w.y = d[1]; w.z = d[2]; w.w = d[3];
                *(u32x4*)(A.hn8 + tokb[mt] + kof + 16 * q) = w; } }
    }
    __syncthreads();
    int te[4] = {0, 0, 0, 0}, lp[4] = {0, 0, 0, 0}; float tw[4] = {0.f, 0.f, 0.f, 0.f};
    const int tmine = wg * 8 + (tid & 7) + (tid >> 3) * nwg * 8; const bool mine = tid < 128 && tid < ntl && tmine < T;
    if (mine) { float v[32];
#pragma unroll
        for (int e4 = 0; e4 < 8; ++e4) { const f32x4 q4 = *(const LAS f32x4*)(lgt + tid * 36 + e4 * 4); v[e4 * 4] = q4[0]; v[e4 * 4 + 1] = q4[1]; v[e4 * 4 + 2] = q4[2]; v[e4 * 4 + 3] = q4[3]; }
        float tv[4];
#pragma unroll
        for (int k = 0; k < 4; ++k) { float best = -INFINITY; int bi = 0;
#pragma unroll
            for (int e = 0; e < 32; ++e) { const bool bt = v[e] > best; best = bt ? v[e] : best; bi = bt ? e : bi; }
#pragma unroll
            for (int e = 0; e < 32; ++e) v[e] = (e == bi) ? -INFINITY : v[e];
            tv[k] = best; te[k] = bi; }
        const float e1 = __expf(tv[1] - tv[0]), e2 = __expf(tv[2] - tv[0]), e3 = __expf(tv[3] - tv[0]); const float inv = 1.f / (1.f + e1 + e2 + e3);
        tw[0] = inv; tw[1] = e1 * inv; tw[2] = e2 * inv; tw[3] = e3 * inv;
#pragma unroll
        for (int k = 0; k < 4; ++k) lp[k] = __hip_atomic_fetch_add(lcnt + te[k], 1, __ATOMIC_RELAXED, __HIP_MEMORY_SCOPE_WORKGROUP); }
    __syncthreads();
    if (tid < 32) gbase[tid] = (int)__hip_atomic_fetch_add((unsigned*)A.cnt + tid * CNT_STRIDE, (unsigned)lcnt[tid], __ATOMIC_RELAXED, __HIP_MEMORY_SCOPE_AGENT);
    __syncthreads();
    if (mine) {
#pragma unroll
        for (int k = 0; k < 4; ++k) { const int e = te[k], pos = gbase[e] + lp[k], tk = tmine * 4 + k;
            A.list[(size_t)e * T + pos] = tk; A.wlist[tk] = tw[k]; A.tinfo[tk] = e | (pos << 8); } }
}
struct CombArgs { const bf16_t* h1; const f8_t* y; const int* tinfo; const float* tw; const int* cnt; const float* g; float* out; };
__device__ __forceinline__ void combine_phase(LAS unsigned char* lds, const CombArgs& A, int wg, int nwg) {
    const int tid = tid_fresh(), wid = __builtin_amdgcn_readfirstlane(tid >> 6), lane = tid & 63;
    LAS int* toff = (LAS int*)(lds + LDS_MISC + 64);
    __syncthreads();
    if (tid < 64) { const int n = (tid < NE) ? (A.cnt[tid * CNT_STRIDE] + 255) >> 8 : 0; int pre = n;
#pragma unroll
        for (int d = 1; d < 32; d <<= 1) { const int v = __shfl_up(pre, d, 64); if (tid >= d) pre += v; }
        if (tid < NE) toff[tid] = pre - n; }
    __syncthreads();
    f32x4 gv[4];
#pragma unroll
    for (int j = 0; j < 4; ++j) gv[j] = *(const f32x4*)(A.g + lane * 4 + 256 * j);
    for (int t = wg * 8 + wid; t < T; t += nwg * 8) {
        size_t so[4]; float tw[4];
#pragma unroll
        for (int k = 0; k < 4; ++k) { const int inf = A.tinfo[t * 4 + k]; so[k] = ((size_t)toff[inf & 255] * 256 + (inf >> 8)) * 1024; tw[k] = A.tw[t * 4 + k]; }
        f32x4 v[4]; float s = 0.f;
#pragma unroll
        for (int j = 0; j < 4; ++j) { { const u32x2 uh = *(const u32x2*)(A.h1 + (size_t)t * D + lane * 4 + 256 * j); v[j] = (f32x4){__uint_as_float(uh.x << 16), __uint_as_float(uh.x & 0xffff0000u), __uint_as_float(uh.y << 16), __uint_as_float(uh.y & 0xffff0000u)}; }
#pragma unroll
            for (int k = 0; k < 4; ++k) { const unsigned yy = *(const unsigned*)(A.y + so[k] + lane * 4 + 256 * j);
                const f2_t lo = __builtin_amdgcn_cvt_pk_f32_fp8((int)yy, false), hi = __builtin_amdgcn_cvt_pk_f32_fp8((int)yy, true);
                v[j][0] += tw[k] * lo[0]; v[j][1] += tw[k] * lo[1]; v[j][2] += tw[k] * hi[0]; v[j][3] += tw[k] * hi[1]; }
            s += (v[j][0] * v[j][0] + v[j][1] * v[j][1]) + (v[j][2] * v[j][2] + v[j][3] * v[j][3]); }
        s = wsum(s); const float rs = rsqrtf(s * (1.f / 1024.f) + 1e-6f);
#pragma unroll
        for (int j = 0; j < 4; ++j) *(f32x4*)(A.out + (size_t)t * D + lane * 4 + 256 * j) = v[j] * rs * gv[j];
    }
}
}
#define XB_TMO      128
#define XB_XCNT(j)  (256  + 64 * (j))
#define XB_XSUB(j)  (1280 + 64 * (j))
#define XB_XGEN(j)  (2304 + 64 * (j))
#define XB_TOP      3328
#define XB_TOPGEN   3392
#define XCD_BAR_WORDS 3456
#define XB_SPIN_CAP (1u << 18)
__device__ __forceinline__ unsigned xb_ld(unsigned* p)              { return __hip_atomic_load(p, __ATOMIC_RELAXED, __HIP_MEMORY_SCOPE_AGENT); }
__device__ __forceinline__ unsigned xb_add(unsigned* p, unsigned v) { return __hip_atomic_fetch_add(p, v, __ATOMIC_RELAXED, __HIP_MEMORY_SCOPE_AGENT); }
__device__ __forceinline__ unsigned xb_xcc_id() { return (unsigned)__builtin_amdgcn_s_getreg((3 << 11) | 20) & 0xFu; }
#define XB_SPIN(cond, bar) do { unsigned _sp = 0; while (cond) { __builtin_amdgcn_s_sleep(1); \
    if ((++_sp & 255u) == 0u) { if (xb_ld(&(bar)[XB_TMO])) break; if (_sp > XB_SPIN_CAP) { atomicAdd(&(bar)[XB_TMO], 1u); break; } } } } while (0)
struct XcdBarrier { unsigned* bar; unsigned x; volatile LAS unsigned* st; };
__device__ __forceinline__ XcdBarrier xcd_barrier_post(unsigned* bar, volatile LAS unsigned* st) {
    XcdBarrier b; b.bar = bar; b.x = xb_xcc_id(); b.st = st;
    if (threadIdx.x == 0) (void)xb_add(&bar[XB_XCNT(b.x)], 1u);
    return b;
}
__device__ __forceinline__ void xcd_barrier_complete(unsigned* bar, unsigned x, unsigned& nloc, unsigned& nx) {
    const unsigned G = gridDim.x * gridDim.y * gridDim.z;
    unsigned sum, cnt, mine, sp = 0u;
    for (;;) {
        sum = 0u; cnt = 0u; mine = 0u;
#pragma unroll
        for (unsigned j = 0; j < 16; ++j) { const unsigned c = xb_ld(&bar[XB_XCNT(j)]); sum += c; cnt += (c > 0u) ? 1u : 0u; mine = (j == x) ? c : mine; }
        if (sum == G) break;
        __builtin_amdgcn_s_sleep(1);
        if ((++sp & 255u) == 0u) { if (xb_ld(&bar[XB_TMO])) break; if (sp > XB_SPIN_CAP) { atomicAdd(&bar[XB_TMO], 1u); break; } }
    }
    nloc = mine > 0u ? mine : 1u; nx = cnt > 0u ? cnt : 1u;
}
__device__ __forceinline__ void xcd_barrier(const XcdBarrier& b) {
    asm volatile("s_waitcnt vmcnt(0)" ::: "memory");
    __syncthreads();
    if (threadIdx.x == 0) {
        unsigned* bar = b.bar;
        __builtin_amdgcn_s_waitcnt(0);
        unsigned nloc = b.st[0], nx = b.st[1];
        if (nloc == 0u) { xcd_barrier_complete(bar, b.x, nloc, nx); b.st[0] = nloc; b.st[1] = nx; }
        const unsigned old = xb_add(&bar[XB_XSUB(b.x)], 1u);
        const unsigned gen = old / nloc;
        if (old + 1u == (gen + 1u) * nloc) {
            __builtin_amdgcn_fence(__ATOMIC_RELEASE, "agent");
            asm volatile("s_waitcnt vmcnt(0)" ::: "memory");
            const unsigned og = xb_add(&bar[XB_TOP], 1u);
            const unsigned tg = og / nx;
            if (og + 1u == (tg + 1u) * nx) xb_add(&bar[XB_TOPGEN], 1u);
            else XB_SPIN(xb_ld(&bar[XB_TOPGEN]) == tg, bar);
            __builtin_amdgcn_fence(__ATOMIC_ACQUIRE, "agent");
            xb_add(&bar[XB_XGEN(b.x)], 1u);
            asm volatile("s_waitcnt vmcnt(0)" ::: "memory");
        } else {
            XB_SPIN(xb_ld(&bar[XB_XGEN(b.x)]) == gen, bar);
            __builtin_amdgcn_fence(__ATOMIC_ACQUIRE, "agent");
            asm volatile("s_waitcnt vmcnt(0)" ::: "memory");
        }
    }
    __syncthreads();
}

namespace mk {
constexpr int LDS_BAR = 159744, LDS_FUSED = LDS_BAR + 256;
constexpr int CTL_QUEUE = 4096;
struct Params {
    const float *x, *attn_norm, *w_in, *rel_bias, *cmp_pos, *cmp_w1, *cmp_w2, *attn_out_norm, *conv_w, *conv_b, *dt_bias, *a_log, *d_skip, *ssm_out_norm, *w_out, *ffn_norm,
                *router_w, *router_b, *w_gu, *b_gu, *w_dn, *b_dn, *final_norm;
    float* out; unsigned* ctl; int* cnt;
    bf16_t *xb, *WinT, *WoutT, *w1T, *projb, *catb, *kc, *vc, *states, *rws; f8_t *WguT, *WdnT, *hn8, *act, *ymoe;
    float *posb, *alast, *wlist, *ssq; bf16_t* h1; int *list, *tinfo;
    int ph_lo, ph_hi;
};
constexpr int NT_WIN = 48 * 16, NT_WOUT = 16 * 16, NT_WGU = 32 * 32 * 8, NT_WDN = 32 * 16 * 8, NT_W1 = 2 * 32, NT_ALL = NT_WIN + NT_WOUT + NT_WGU + NT_WDN + NT_W1;
__device__ __forceinline__ void p0_prologue(LAS unsigned char* lds, const Params& p, int wg, int nwg, int part, bool dry = false) {
    const int tid = tid_fresh(), wid = __builtin_amdgcn_readfirstlane(tid >> 6), lane = tid & 63;
    LAS float* tl = (LAS float*)(lds + wid * WT_TILE_BYTES);
    if (part == 0) {
    for (int r = (wg * 8 + wid) * 4; r < T; r += 4 * nwg * 8) rms_rows_bf16<4>(p.x, p.xb, r, lane);
    for (int o = wg * 8 + wid; o < 128; o += nwg * 8) { const int j = o >> 6, sl = o & 63; float s = 0.f;
#pragma unroll
        for (int kk = 0; kk < 32; ++kk) { const int k = sl * 32 + kk; s += p.cmp_pos[j * 2048 + k] * p.cmp_w1[((size_t)j * 2048 + k) * 64 + lane]; }
        p.posb[o * 64 + lane] = s; }
    for (int o = (nwg - 1 - wg) * 8 + wid; o < 512; o += nwg * 8) {
        const int e = o >> 4, k = (o & 15) * 64 + lane; const float v = p.router_w[k * NE + e] * p.ffn_norm[k];
        const bf16_t b0 = f2bf(v); const float r1 = v - bf2f(b0); const bf16_t b1 = f2bf(r1); const float r2 = r1 - bf2f(b1); const bf16_t b2 = f2bf(r2);
        p.rws[(size_t)e * 1024 + k] = b0; p.rws[(size_t)(32 + e) * 1024 + k] = b1; p.rws[(size_t)(64 + e) * 1024 + k] = b2; }
    __syncthreads();
    for (int task = wg * 8 + wid; task < NT_WIN + NT_WOUT + NT_W1; task += nwg * 8) { int idx = task;
        if (idx < NT_WIN) { wt_tile<false>(dry, p.w_in, p.WinT, p.attn_norm, p.attn_norm, 1024, 1024, 2848, 3072, 0, 512, 0.125f * LOG2E, 48, 16, idx, tl, lane); continue; } idx -= NT_WIN;
        if (idx < NT_WOUT) { wt_tile<false>(dry, p.w_out, p.WoutT, p.attn_out_norm, p.ssm_out_norm, 512, 1024, 1024, 1024, 0, 0, 1.f, 16, 16, idx, tl, lane); continue; } idx -= NT_WOUT;
        wt_tile<false>(dry, p.cmp_w1, p.w1T, nullptr, nullptr, 0, 2048, 64, 64, 0, 0, 1.f, 1, 32, idx, tl, lane); }
    } else {
    __syncthreads();
    for (int task = wg * 8 + wid; task < NT_WGU + NT_WDN; task += nwg * 8) { int idx = task;
        if (idx < NT_WGU) { wt_tile<true>(dry, p.w_gu, p.WguT, p.ffn_norm, p.ffn_norm, 1024, 1024, 2048, 2048, 1, 2048, W8_SCALE, 32, 8, idx, tl, lane); continue; } idx -= NT_WGU;
        wt_tile<true>(dry, p.w_dn, p.WdnT, nullptr, nullptr, 0, 1024, 1024, 1024, 0, 1024, W8_SCALE, 16, 8, idx, tl, lane); }
    __syncthreads();
    }
}

__device__ __forceinline__ void cvt_task_gu(LAS unsigned char* lds, const Params& p, int task, int wid, int lane) {
    wt_tile<true>(false, p.w_gu, p.WguT, p.ffn_norm, p.ffn_norm, 1024, 1024, 2048, 2048, 1, 2048, W8_SCALE, 32, 8, task, (LAS float*)(lds + wid * WT_TILE_BYTES), lane); }
__device__ __forceinline__ void cvt_task_dn(LAS unsigned char* lds, const Params& p, int task, int wid, int lane) {
    wt_tile<true>(false, p.w_dn, p.WdnT, nullptr, nullptr, 0, 1024, 1024, 1024, 0, 1024, W8_SCALE, 16, 8, task, (LAS float*)(lds + wid * WT_TILE_BYTES), lane); }

#define MK_PHASE_FN __device__ __forceinline__
MK_PHASE_FN void ph_proj(LAS unsigned char* lds, const bf16_t* xb, const bf16_t* WinT, bf16_t* projb, int wg, int nwg) {
    ProbProj P; P.S.init(T, NPROJ, nwg, wg); P.A = xb; P.Bt = WinT; P.O = projb; gemm_phase(lds, P); }
MK_PHASE_FN void ph_out(LAS unsigned char* lds, const bf16_t* catb, const bf16_t* WoutT, const float* x, bf16_t* h1, const float* ssq, int wg, int nwg) {
    ProbOut P; P.S.init(T, D, nwg, wg); P.A = catb; P.Bt = WoutT; P.R0 = x; P.O = h1; P.ssq = ssq; gemm_phase(lds, P); }
__global__ void __launch_bounds__(512, 2) k_fused(Params p) {
    extern __shared__ __attribute__((aligned(16))) unsigned char dl[];
    LAS unsigned char* lds = (LAS unsigned char*)dl;
    const int wg = blockIdx.x, nwg = gridDim.x; int tid = tid_fresh();
    if (tid < 64) ((LAS unsigned*)(lds + LDS_BAR))[tid] = 0u;
    __syncthreads();
    XcdBarrier bar = xcd_barrier_post(p.ctl, (volatile LAS unsigned*)(lds + LDS_BAR));
#ifdef MK_ONLY
#define PH(k) ((k) == MK_ONLY && p.ph_lo <= (k) && (k) < p.ph_hi)
#else
#define PH(k) (p.ph_lo <= (k) && (k) < p.ph_hi)
#endif
#ifdef MK_REPEAT
#define REP(k) for (int _rep = 0; _rep < ((k) == MK_REPEAT ? 2 : 1); ++_rep)
#else
#define REP(k)
#endif
#ifdef MK_REPEAT
#define QREP _rep
#else
#define QREP 0
#endif
#ifdef MK_BARX2
#define SEAM(k) do { if (PH(k) && PH((k) + 1)) { xcd_barrier(bar); xcd_barrier(bar); } } while (0)
#else
#define SEAM(k) do { if (PH(k) && PH((k) + 1)) xcd_barrier(bar); } while (0)
#endif
    if (PH(0)) { p0_prologue(lds, p, wg, nwg, 0); }
    SEAM(0);
    REP(1) if (PH(1)) ph_proj(lds, p.xb, p.WinT, p.projb, wg, nwg);
    SEAM(1);
    REP(2) if (PH(2)) {
        const SsdArgs SA{p.projb, p.conv_w, p.conv_b, p.dt_bias, p.a_log, p.d_skip, p.states, p.alast, p.catb};
        const CmpArgs CA{p.projb, p.w1T, p.posb, p.cmp_w2, p.kc, p.vc};
        for (int it = wg; it < 384; it += nwg) { const int v = 383 - it; if (v < 128) cmp_item(lds, CA, v); else ssd_a_item(lds, SA, v - 128); }
    }
    SEAM(2);
    REP(3) if (PH(3)) {
        const SsdArgs SA{p.projb, p.conv_w, p.conv_b, p.dt_bias, p.a_log, p.d_skip, p.states, p.alast, p.catb};
        const AttnArgs AA{p.projb, p.kc, p.vc, p.catb, p.ssq};
        bool btab_ok = false;
        LAS int* qslot = (LAS int*)(lds + LDS_BAR + 64);
        for (;;) {
            __syncthreads();
            if (tid_fresh() == 0) qslot[0] = (int)__hip_atomic_fetch_add(p.ctl + CTL_QUEUE + 64 * QREP, 1u, __ATOMIC_RELAXED, __HIP_MEMORY_SCOPE_AGENT);
            __syncthreads();
            const int it = qslot[0];
#if defined(MK_QX_ATTN)
            if (it >= 768 + 512) break;
            { const int i2 = it >= 768 ? it - 768 : it; if (i2 < 512) { if (!btab_ok) { attn_btab(lds, p.rel_bias); btab_ok = true; } attn_item(lds, AA, i2 & 7, 31 - (i2 >> 4), (i2 >> 3) & 1); } else { ssd_b_item(lds, SA, i2 - 512); btab_ok = false; } }
#elif defined(MK_QX_SSDB)
            if (it >= 768 + 256) break;
            { const int i2 = it >= 768 ? it - 256 : it; if (i2 < 512) attn_item(lds, AA, i2 & 7, 31 - (i2 >> 4), (i2 >> 3) & 1); else ssd_b_item(lds, SA, i2 - 512); }
#else
#if defined(MK_QX_BOTH)
            if (it >= 1536) break;
            { const int i2 = it >= 768 ? it - 768 : it; if (i2 < 512) { if (!btab_ok) { attn_btab(lds, p.rel_bias); btab_ok = true; } attn_item(lds, AA, i2 & 7, 31 - (i2 >> 4), (i2 >> 3) & 1); } else { ssd_b_item(lds, SA, i2 - 512); btab_ok = false; } }
#else
            if (it >= 768) break;
            if (it < 512) { if (!btab_ok) { attn_btab(lds, p.rel_bias); btab_ok = true; } attn_item(lds, AA, it & 7, 31 - (it >> 4), (it >> 3) & 1);
                { const int t3 = tid_fresh(), w3 = __builtin_amdgcn_readfirstlane(t3 >> 6);
                  const int l3 = t3 & 63;
                  const Wt8 JG{p.w_gu, p.WguT, p.ffn_norm, 1024, 2048, 64, 1}, JD{p.w_dn, p.WdnT, nullptr, 1024, 1024, 32, 0};
                  const int ga = it * 32 + 4 * w3, gd = it * 16 + 2 * w3;
                  f32x4 va[16], vb[16];
                  wt8_load(va, JG, ga, l3); wt8_load(vb, JG, ga + 1, l3);
                  wt8_store(va, JG, ga, W8_SCALE, l3); wt8_load(va, JG, ga + 2, l3);
                  wt8_store(vb, JG, ga + 1, W8_SCALE, l3); wt8_load(vb, JG, ga + 3, l3);
                  wt8_store(va, JG, ga + 2, W8_SCALE, l3); wt8_load(va, JD, gd, l3);
                  wt8_store(vb, JG, ga + 3, W8_SCALE, l3); wt8_load(vb, JD, gd + 1, l3);
                  wt8_store(va, JD, gd, W8_SCALE, l3); wt8_store(vb, JD, gd + 1, W8_SCALE, l3); }
            } else { ssd_b_item(lds, SA, it - 512); btab_ok = false; }
#endif
#endif
        }
    }
    SEAM(3);
    REP(4) if (PH(4)) ph_out(lds, p.catb, p.WoutT, p.x, p.h1, p.ssq, wg, nwg);
    SEAM(4);
    REP(5) if (PH(5)) { const bool dm = QREP != 0; const RouteArgs RA{p.h1, p.rws, p.router_b, p.hn8, dm ? p.cnt + 2048 : p.cnt, dm ? (int*)p.act : p.list, dm ? (float*)p.act + (4u << 20) : p.wlist, dm ? (int*)p.act + (8u << 20) : p.tinfo}; route_phase(lds, RA, wg, nwg); }
    SEAM(5);
    REP(6) if (PH(6)) {
        tid = tid_fresh();
        __syncthreads();
        const int RT = moe_tables(lds, p.cnt);
        ProbMoe1 P; P.S.nN = 8; P.S.G = nwg; P.S.c = (nwg % 8 == 0) ? (wg & 7) * (nwg >> 3) + (wg >> 3) : wg; P.S.RT = RT; P.S.tile_e = (const LAS int*)(lds + LDS_TILE_E); P.S.tile_m = (const LAS int*)(lds + LDS_TILE_M);
        P.A = p.hn8; P.Bt = p.WguT; P.btab = (const LAS float*)(lds + LDS_BIASTAB); P.O = p.act; P.rowtab = (const LAS unsigned*)(lds + LDS_ROWTAB);
        LAS unsigned* rowtab = (LAS unsigned*)(lds + LDS_ROWTAB);
        {
            const LAS int* lcnt = (const LAS int*)(lds + LDS_CNT); int tokv[12]; float bv[12];
#pragma unroll
            for (int i = 0; i < 12; ++i) { Unit u; tokv[i] = 0; bv[i] = 0.f; if (P.S.next(i, u)) {
                if (tid < 256) { const int pos = u.mt * 256 + tid; if (pos < lcnt[u.e]) tokv[i] = p.list[(size_t)u.e * T + pos] >> 2; }
                else { const int j = tid - 256; bv[i] = p.b_gu[u.e * 2048 + (j >> 7) * 1024 + u.pn * 128 + (j & 127)]; } } }
#pragma unroll
            for (int i = 0; i < 12; ++i) { if (tid < 256) rowtab[i * 256 + tid] = (unsigned)tokv[i] * KD; else ((LAS float*)(lds + LDS_BIASTAB))[i * 256 + tid - 256] = bv[i]; }
        }
        __syncthreads();
        gemm_phase(lds, P);
    }
    SEAM(6);
    REP(7) if (PH(7)) {
        __syncthreads();
        const int RT = moe_tables(lds, p.cnt);
        ProbMoe2 P; P.S.nN = 4; P.S.G = nwg; P.S.c = (nwg % 8 == 0) ? (wg & 7) * (nwg >> 3) + (wg >> 3) : wg; P.S.RT = RT; P.S.tile_e = (const LAS int*)(lds + LDS_TILE_E); P.S.tile_m = (const LAS int*)(lds + LDS_TILE_M);
        P.A = p.act; P.Bt = p.WdnT; P.btab = (const LAS float*)(lds + LDS_BIASTAB); P.O = p.ymoe;
        { const int t7 = tid_fresh(); float bv[12];
#pragma unroll
            for (int i = 0; i < 12; ++i) { Unit u; bv[i] = 0.f; if (t7 < 256 && P.S.next(i, u)) bv[i] = p.b_dn[u.e * 1024 + u.pn * 256 + t7]; }
#pragma unroll
            for (int i = 0; i < 12; ++i) if (t7 < 256) ((LAS float*)(lds + LDS_BIASTAB))[i * 256 + t7] = bv[i]; }
        __syncthreads();
        gemm_phase(lds, P);
    }
    SEAM(7);
    REP(8) if (PH(8)) { const CombArgs CA{p.h1, p.ymoe, p.tinfo, p.wlist, p.cnt, p.final_norm, p.out}; combine_phase(lds, CA, wg, nwg); }
#undef PH
#undef SEAM
}
}

extern "C" void kernel_launch(void* const* d_in, const int* in_sizes, int n_in, void* d_out, int out_size, void* d_ws, size_t ws_size, hipStream_t stream) {
    using namespace mk;
    char* ws = (char*)d_ws; const size_t MB = 1u << 20;
    size_t o = 0; auto take = [&](size_t mb) { char* q = ws + o; o += mb * MB; return q; };
    Params p;
    memset(&p, 0, sizeof(p));
    const float** fin = (const float**)&p.x;
    for (int i = 0; i < 23; ++i) fin[i] = (const float*)d_in[i];
    p.out = (float*)d_out;
    p.ctl = (unsigned*)take(1); p.cnt = (int*)(p.ctl + 8192);
    p.xb = (bf16_t*)take(32); p.WinT = (bf16_t*)take(6); p.WoutT = (bf16_t*)take(2); p.WguT = (f8_t*)take(64); p.WdnT = (f8_t*)take(32); p.w1T = (bf16_t*)take(1);
    p.projb = (bf16_t*)take(96); p.catb = (bf16_t*)take(32); p.hn8 = (f8_t*)take(16); p.kc = (bf16_t*)take(1); p.vc = (bf16_t*)take(1); p.states = (bf16_t*)take(16); p.rws = (bf16_t*)take(1);
    p.act = (f8_t*)take(72); p.ymoe = (f8_t*)take(72);
    p.posb = (float*)take(1); p.alast = (float*)take(1); p.ssq = (float*)take(1); p.h1 = (bf16_t*)take(32); p.wlist = (float*)take(2); p.list = (int*)take(2); p.tinfo = (int*)take(1);
    static int grid = 0;
    if (!grid) {
        int dev = 0, cus = 0, per_cu = 0;
        (void)hipGetDevice(&dev); (void)hipDeviceGetAttribute(&cus, hipDeviceAttributeMultiprocessorCount, dev);
        (void)hipFuncSetAttribute((const void*)k_fused, hipFuncAttributeMaxDynamicSharedMemorySize, LDS_FUSED);
        (void)hipOccupancyMaxActiveBlocksPerMultiprocessor(&per_cu, (const void*)k_fused, 512, LDS_FUSED);
        (void)hipGetLastError();
        grid = cus > 0 ? cus : 256;
    }
    (void)hipMemsetAsync(p.ctl, 0, 65536, stream);
#ifndef MK_SPLIT
    p.ph_lo = 0; p.ph_hi = 9;
    hipLaunchKernelGGL(k_fused, dim3(grid), dim3(512), LDS_FUSED, stream, p);
#else
    for (int k = 0; k < 9; ++k) { p.ph_lo = k; p.ph_hi = k + 1; hipLaunchKernelGGL(k_fused, dim3(grid), dim3(512), LDS_FUSED, stream, p); }
#endif
}
```

```cpp
#include <hip/hip_runtime.h>
#include <stdint.h>
#include <string.h>
#include <math.h>
namespace mk {
#define LAS __attribute__((address_space(3)))
typedef unsigned short bf16_t;
typedef short bf16x8 __attribute__((ext_vector_type(8)));
typedef float f32x4 __attribute__((ext_vector_type(4)));
typedef unsigned u32x4 __attribute__((ext_vector_type(4)));
typedef unsigned u32x2 __attribute__((ext_vector_type(2)));
typedef float f2_t __attribute__((ext_vector_type(2)));
constexpr int NB = 8, S = 2048, D = 1024, T = NB * S, NE = 32;
constexpr int BM = 256, BK = 64, HALF = 128, HTB = HALF * BK * 2, STAGE_BYTES = 8 * HTB, NXCD = 8, WGM = 8;
constexpr int CNT_STRIDE = 32;
constexpr int KD = 1024;
constexpr int NPROJ = 3072;
constexpr int MAXSLOT = 65536 + 32 * 256;
constexpr int LDS_MISC = 131072, LDS_TILE_E = LDS_MISC + 64, LDS_TILE_M = LDS_TILE_E + 1536, LDS_CNT = LDS_MISC + 3200, LDS_TOFF = LDS_MISC + 3328  , LDS_ROWTAB = LDS_MISC + 4096, LDS_BIASTAB = LDS_ROWTAB + 12 * 1024, LDS_BYTES = LDS_BIASTAB + 12 * 1024;

__host__ __device__ __forceinline__ int lds_byte(int r, int c) { const int st = (r >> 4) * 2 + (c >> 5), rr = r & 15, cc = c & 31, ob = rr * 64 + cc * 2; return st * 1024 + (ob ^ (((ob >> 9) & 1) << 5)); }
__host__ __device__ __forceinline__ void stage_rc(int b, int& R, int& C) { const int st = b / 1024, sb = b % 1024, swz = sb ^ (((sb >> 9) & 1) << 5); R = (st >> 1) * 16 + swz / 64; C = (st & 1) * 32 + (swz % 64) / 2; }
__host__ __device__ __forceinline__ int perm32(int rho) { const int n = rho >> 4, i = rho & 15; return 8 * (i >> 2) + 4 * n + (i & 3); }
__device__ __forceinline__ unsigned cvt_pk_bf16(float lo, float hi) { unsigned r; asm volatile("v_cvt_pk_bf16_f32 %0, %1, %2" : "=v"(r) : "v"(lo), "v"(hi)); return r; }
__device__ __forceinline__ int tid_fresh() { int t = threadIdx.x; asm volatile("" : "+v"(t)); return t; }
__device__ __forceinline__ float bf2f(bf16_t b) { return __uint_as_float(((unsigned)b) << 16); }

struct Unit { int pm, pn, e, mt, li; };
struct StaticOrder {
    int nM, nN, nwg, G, c;
    __device__ __forceinline__ void init(int M, int N, int G_, int c_) { nM = M / BM; nN = N / BM; nwg = nM * nN; G = G_; c = c_; }
    __device__ __forceinline__ bool next(int i, Unit& u) const {
        const long L = (long)i * G + c; if (L >= nwg) return false;
        int wgid = (int)L; { const int q = nwg / NXCD, r = nwg % NXCD, xcd = wgid % NXCD, off = wgid / NXCD; wgid = (xcd < r ? xcd * (q + 1) : r * (q + 1) + (xcd - r) * q) + off; }
        const int nig = WGM * nN, gid = wgid / nig, fm = gid * WGM, gsz = (nM - fm) < WGM ? (nM - fm) : WGM;
        u.pm = fm + ((wgid % nig) % gsz); u.pn = (wgid % nig) / gsz; u.e = 0; u.mt = 0; u.li = i; return true;
    }
};
struct MoeOrder {
    int nN, G, c, RT; const LAS int* tile_e; const LAS int* tile_m;
    __device__ __forceinline__ bool next(int i, Unit& u) const {
        const int tpr = G / nN, t0 = i * tpr, nrem = RT - t0;
        if (nrem <= 0) return false;
        int rt, pn;
        if (G == 256 && nrem < tpr) { const int x = c >> 5, j = c & 31, tl = x + 8 * (j / nN); if (tl >= nrem) return false; rt = t0 + tl; pn = j % nN; }
        else { const int L = i * G + c; rt = L / nN; pn = L - rt * nN; if (rt >= RT) return false; }
        u.pm = rt; u.pn = pn; u.e = tile_e[rt]; u.mt = tile_m[rt]; u.li = i; return true; }
};

struct ProbProj {
    static constexpr bool F8 = false, MIDSCALE = false; static constexpr int PERM = 2, ROWB = KD * 2;
    StaticOrder S; const bf16_t* A; const bf16_t* Bt; bf16_t* O;
    __device__ __forceinline__ bool next(int i, Unit& u) const { return S.next(i, u); }
    __device__ __forceinline__ const char* a_base(const Unit& u) const { return (const char*)A + (size_t)u.pm * (BM * KD * 2); }
    __device__ __forceinline__ const char* b_base(const Unit& u) const { return (const char*)Bt + (size_t)u.pn * (BM * KD * 2); }
    __device__ __forceinline__ void a_offs(int, const Unit&, unsigned (&v0)[2], unsigned (&v1)[2], const int (&R)[2], const int (&C)[2]) const {
#pragma unroll
        for (int i = 0; i < 2; ++i) { v0[i] = (unsigned)(R[i] * KD + C[i]) * 2u; v1[i] = v0[i] + (unsigned)(HALF * KD * 2); } }
    __device__ __forceinline__ void epi(const f32x4 (&acc)[2][2][4][2], const Unit& u, int wr, int wc, int fr, int fq) const {
        const int row0 = u.pm * BM + wr * 64 + fr, col0 = u.pn * BM + wc * 64 + 16 * fq;
#pragma unroll
        for (int ai = 0; ai < 2; ++ai)
#pragma unroll
            for (int m = 0; m < 4; ++m) { bf16_t* rowp = O + (size_t)(row0 + ai * HALF + m * 16) * NPROJ + col0;
#pragma unroll
                for (int bj = 0; bj < 2; ++bj) { const f32x4 v0 = acc[ai][bj][m][0], v1 = acc[ai][bj][m][1]; u32x4 w;
                    w.x = cvt_pk_bf16(v0[0], v0[1]); w.y = cvt_pk_bf16(v0[2], v0[3]); w.z = cvt_pk_bf16(v1[0], v1[1]); w.w = cvt_pk_bf16(v1[2], v1[3]);
                    *(u32x4*)(rowp + bj * 8) = w; } }
    }
};
struct ProbOut {
    static constexpr bool F8 = false, MIDSCALE = true; static constexpr int PERM = 2, ROWB = KD * 2;
    StaticOrder S; const bf16_t* A; const bf16_t* Bt; const float* R0; bf16_t* O; const float* ssq;
    __device__ __forceinline__ void midscale(f32x4 (&acc)[2][2][4][2], const Unit& u, int wr, int fr) const {
        asm volatile("" : "+v"(fr));
#pragma unroll
        for (int ai = 0; ai < 2; ++ai)
#pragma unroll
            for (int m = 0; m < 4; ++m) { const int row = u.pm * BM + ai * HALF + wr * 64 + m * 16 + fr; const f2_t q = *(const f2_t*)(ssq + (size_t)row * 2);
                const float rs = rsqrtf((q[0] + q[1]) * (1.f / 512.f) + 1e-6f);
#pragma unroll
                for (int bj = 0; bj < 2; ++bj)
#pragma unroll
                    for (int n = 0; n < 2; ++n) acc[ai][bj][m][n] = acc[ai][bj][m][n] * rs;
                asm volatile("" ::: "memory"); } }
    __device__ __forceinline__ bool next(int i, Unit& u) const { return S.next(i, u); }
    __device__ __forceinline__ const char* a_base(const Unit& u) const { return (const char*)A + (size_t)u.pm * (BM * KD * 2); }
    __device__ __forceinline__ const char* b_base(const Unit& u) const { return (const char*)Bt + (size_t)u.pn * (BM * KD * 2); }
    __device__ __forceinline__ void a_offs(int, const Unit&, unsigned (&v0)[2], unsigned (&v1)[2], const int (&R)[2], const int (&C)[2]) const {
#pragma unroll
        for (int i = 0; i < 2; ++i) { v0[i] = (unsigned)(R[i] * KD + C[i]) * 2u; v1[i] = v0[i] + (unsigned)(HALF * KD * 2); } }
    __device__ __forceinline__ void epi(const f32x4 (&acc)[2][2][4][2], const Unit& u, int wr, int wc, int fr, int fq) const {
        const int row0 = u.pm * BM + wr * 64 + fr, col0 = u.pn * BM + wc * 64 + 16 * fq;
#pragma unroll
        for (int ai = 0; ai < 2; ++ai)
#pragma unroll
            for (int m = 0; m < 4; ++m) { const size_t off = (size_t)(row0 + ai * HALF + m * 16) * D + col0;
#pragma unroll
                for (int bj = 0; bj < 2; ++bj) { const f32x4 r0 = *(const f32x4*)(R0 + off + bj * 8), r1 = *(const f32x4*)(R0 + off + bj * 8 + 4);
                    const f32x4 o0 = acc[ai][bj][m][0] + r0, o1 = acc[ai][bj][m][1] + r1; u32x4 w;
                    w.x = cvt_pk_bf16(o0[0], o0[1]); w.y = cvt_pk_bf16(o0[2], o0[3]); w.z = cvt_pk_bf16(o1[0], o1[1]); w.w = cvt_pk_bf16(o1[2], o1[3]);
                    *(u32x4*)(O + off + bj * 8) = w; }
                asm volatile("" ::: "memory"); }
    }
};
typedef unsigned char f8_t;
typedef int i32x8 __attribute__((ext_vector_type(8)));
typedef int i32x4 __attribute__((ext_vector_type(4)));
constexpr float W8_SCALE = 32.f, W8_INV = 1.f / 32.f;
__device__ __forceinline__ unsigned pk4_fp8(float a, float b, float c, float d) { int r = __builtin_amdgcn_cvt_pk_fp8_f32(a, b, 0, false); r = __builtin_amdgcn_cvt_pk_fp8_f32(c, d, r, true); return (unsigned)r; }
struct ProbMoe1 {
    static constexpr bool F8 = true, MIDSCALE = false; static constexpr int PERM = 1, ROWB = KD;
    MoeOrder S; const f8_t* A; const f8_t* Bt; const LAS float* btab; f8_t* O; const LAS unsigned* rowtab;
    __device__ __forceinline__ bool next(int i, Unit& u) const { return S.next(i, u); }
    __device__ __forceinline__ const char* a_base(const Unit&) const { return (const char*)A; }
    __device__ __forceinline__ const char* b_base(const Unit& u) const { return (const char*)Bt + ((size_t)u.e * 2048 + (size_t)u.pn * BM) * ROWB; }
    __device__ __forceinline__ void a_offs(int i, const Unit&, unsigned (&v0)[2], unsigned (&v1)[2], const int (&R)[2], const int (&C)[2]) const {
#pragma unroll
        for (int j = 0; j < 2; ++j) { v0[j] = rowtab[i * 256 + R[j]] + (unsigned)C[j] * 2u; v1[j] = rowtab[i * 256 + HALF + R[j]] + (unsigned)C[j] * 2u; } }
    __device__ __forceinline__ void epi(const f32x4 (&acc)[2][2][4][2], const Unit& u, int wr, int wc, int fr, int fq) const {
        const int row0 = u.pm * BM + wr * 64 + fr, jg0 = u.pn * HALF + wc * 32 + 8 * fq;
        f32x4 bg[2], bu[2];
#pragma unroll
        for (int n = 0; n < 2; ++n) { bg[n] = *(const LAS f32x4*)(btab + u.li * 256 + wc * 32 + 8 * fq + 4 * n); bu[n] = *(const LAS f32x4*)(btab + u.li * 256 + 128 + wc * 32 + 8 * fq + 4 * n); }
#pragma unroll
        for (int ai = 0; ai < 2; ++ai)
#pragma unroll
            for (int m = 0; m < 4; ++m) { float o[8];
#pragma unroll
                for (int n = 0; n < 2; ++n) {
                    const f32x4 ag = acc[ai][0][m][n], au = acc[ai][1][m][n];
#pragma unroll
                    for (int hp = 0; hp < 2; ++hp) { const f2_t wi = {W8_INV, W8_INV}, kn = {-1.702f * 1.4426950408889634f, -1.702f * 1.4426950408889634f}, one2 = {1.f, 1.f};
                        f2_t g2 = __builtin_elementwise_fma((f2_t){ag[2 * hp], ag[2 * hp + 1]}, wi, (f2_t){bg[n][2 * hp], bg[n][2 * hp + 1]});
                        f2_t u2 = __builtin_elementwise_fma((f2_t){au[2 * hp], au[2 * hp + 1]}, wi, (f2_t){bu[n][2 * hp], bu[n][2 * hp + 1]});
                        g2 = (f2_t){fminf(g2[0], 7.f), fminf(g2[1], 7.f)}; u2 = (f2_t){__builtin_amdgcn_fmed3f(u2[0], -7.f, 7.f), __builtin_amdgcn_fmed3f(u2[1], -7.f, 7.f)};
                        const f2_t t2 = g2 * kn; const f2_t d2 = (f2_t){__builtin_amdgcn_exp2f(t2[0]), __builtin_amdgcn_exp2f(t2[1])} + one2;
                        const f2_t r2 = (f2_t){__builtin_amdgcn_rcpf(d2[0]), __builtin_amdgcn_rcpf(d2[1])};
                        const f2_t o2 = __builtin_elementwise_fma(u2, g2, g2) * r2;
                        o[n * 4 + 2 * hp] = o2[0]; o[n * 4 + 2 * hp + 1] = o2[1]; } }
                *(u32x2*)(O + (size_t)(row0 + ai * HALF + m * 16) * 1024 + jg0) = (u32x2){pk4_fp8(o[0], o[1], o[2], o[3]), pk4_fp8(o[4], o[5], o[6], o[7])}; }
    }
};
struct ProbMoe2 {
    static constexpr bool F8 = true, MIDSCALE = false; static constexpr int PERM = 2, ROWB = KD;
    MoeOrder S; const f8_t* A; const f8_t* Bt; const LAS float* btab; f8_t* O;
    __device__ __forceinline__ bool next(int i, Unit& u) const { return S.next(i, u); }
    __device__ __forceinline__ const char* a_base(const Unit& u) const { return (const char*)A + (size_t)u.pm * (BM * ROWB); }
    __device__ __forceinline__ const char* b_base(const Unit& u) const { return (const char*)Bt + ((size_t)u.e * 1024 + (size_t)u.pn * BM) * ROWB; }
    __device__ __forceinline__ void a_offs(int, const Unit&, unsigned (&v0)[2], unsigned (&v1)[2], const int (&R)[2], const int (&C)[2]) const {
#pragma unroll
        for (int i = 0; i < 2; ++i) { v0[i] = (unsigned)(R[i] * ROWB + C[i] * 2); v1[i] = v0[i] + (unsigned)(HALF * ROWB); } }
    __device__ __forceinline__ void epi(const f32x4 (&acc)[2][2][4][2], const Unit& u, int wr, int wc, int fr, int fq) const {
        const int rl0 = wr * 64 + fr, cl0 = wc * 64 + 16 * fq, col0 = u.pn * BM + cl0;
#pragma unroll
        for (int ai = 0; ai < 2; ++ai)
#pragma unroll
            for (int m = 0; m < 4; ++m) { const int rl = rl0 + ai * HALF + m * 16;
                f8_t* rowp = O + (size_t)(u.pm * BM + rl) * 1024 + col0; u32x4 w; unsigned d[4];
#pragma unroll
                for (int bj = 0; bj < 2; ++bj) { const f32x4 b0 = *(const LAS f32x4*)(btab + u.li * 256 + cl0 + bj * 8), b1 = *(const LAS f32x4*)(btab + u.li * 256 + cl0 + bj * 8 + 4);
                    const f32x4 v0 = acc[ai][bj][m][0] * W8_INV + b0, v1 = acc[ai][bj][m][1] * W8_INV + b1;
                    d[2 * bj] = pk4_fp8(v0[0], v0[1], v0[2], v0[3]); d[2 * bj + 1] = pk4_fp8(v1[0], v1[1], v1[2], v1[3]); }
                w.x = d[0]; w.y = d[1]; w.z = d[2]; w.w = d[3];
                *(u32x4*)rowp = w;
                asm volatile("" ::: "memory"); }
    }
};

template <int N> struct FragBf { bf16x8 v[N][2];
    __device__ __forceinline__ void set(int i, int k, i32x4 x) { v[i][k] = __builtin_bit_cast(bf16x8, x); }
    __device__ __forceinline__ bf16x8 get(int i, int k) const { return v[i][k]; } };
template <int N> struct FragF8 { i32x8 v[N];
    __device__ __forceinline__ void set(int i, int k, i32x4 x) { if (k == 0) v[i].lo = x; else v[i].hi = x; }
    __device__ __forceinline__ bf16x8 get(int, int) const { return bf16x8{}; } };
template <bool F8> struct FragT { typedef FragBf<4> A_t; typedef FragBf<2> B_t; };
template <> struct FragT<true> { typedef FragF8<4> A_t; typedef FragF8<2> B_t; };
template <class P>
__device__ __forceinline__ void gemm_phase(LAS unsigned char* lds, const P& Pb) {
    const int tid = tid_fresh(), wid = __builtin_amdgcn_readfirstlane(tid >> 6), lane = tid & 63, wr = wid >> 2, wc = wid & 3, fr = lane & 15, fq = lane >> 4;
    constexpr int nt = P::ROWB / 128;
    int Rr[2], Cc[2]; unsigned voffB[2];
#pragma unroll
    for (int i = 0; i < 2; ++i) { int R, C; stage_rc(tid * 16 + i * 8192, R, C); const int Rb = (P::PERM == 2) ? ((R >> 5) * 64 + ((R >> 2) & 3) * 16 + ((R >> 4) & 1) * 4 + (R & 3)) : (P::PERM == 1) ? ((R & ~31) + perm32(R & 31)) : R; Rr[i] = R; Cc[i] = C; voffB[i] = (unsigned)(Rb * P::ROWB + C * 2); }
    constexpr size_t kstep = (size_t)(BK * 2);
    constexpr size_t hstep = (size_t)((P::PERM == 2) ? 8 : HALF) * P::ROWB;
    const unsigned ldsw = (unsigned)wid * 1024u;
    const int aoff = lds_byte(wr * 64 + fr, fq * 8), boff = lds_byte(wc * 32 + fr, fq * 8);
#define PG8_SA(b, h) (((b) * 2 + (h)) * HTB)
#define PG8_SB(b, h) ((4 + (b) * 2 + (h)) * HTB)
#define PG8_STAGE(bufoff, gbase, voff) do { _Pragma("unroll") for (int _i = 0; _i < 2; ++_i) \
        __builtin_amdgcn_global_load_lds((const unsigned*)((const char*)(gbase) + (voff)[_i]), (LAS unsigned*)(lds + (bufoff) + ldsw + _i * 8192), 16, 0, 0); } while (0)
#define PG8_LDA(dst, b, h) do { _Pragma("unroll") for (int m = 0; m < 4; ++m) _Pragma("unroll") for (int k = 0; k < 2; ++k) dst.set(m, k, *(const LAS i32x4*)(lds + PG8_SA(b, h) + aoff + m * 2048 + k * 1024)); } while (0)
#define PG8_LDB(dst, b, h) do { _Pragma("unroll") for (int n = 0; n < 2; ++n) _Pragma("unroll") for (int k = 0; k < 2; ++k) dst.set(n, k, *(const LAS i32x4*)(lds + PG8_SB(b, h) + boff + n * 2048 + k * 1024)); } while (0)
#define PG8_MMA(ai, bj, At, Bt) do { __builtin_amdgcn_s_setprio(1); _Pragma("unroll") for (int m = 0; m < 4; ++m) _Pragma("unroll") for (int n = 0; n < 2; ++n) { \
        if constexpr (P::F8) acc[ai][bj][m][n] = __builtin_amdgcn_mfma_scale_f32_16x16x128_f8f6f4(Bt.v[n], At.v[m], acc[ai][bj][m][n], 0, 0, 0, 0x7f7f7f7f, 0, 0x7f7f7f7f); \
        else { _Pragma("unroll") for (int k = 0; k < 2; ++k) acc[ai][bj][m][n] = __builtin_amdgcn_mfma_f32_16x16x32_bf16(Bt.get(n, k), At.get(m, k), acc[ai][bj][m][n], 0, 0, 0); } } \
        __builtin_amdgcn_s_setprio(0); } while (0)
#define PG8_PIN0 do { if constexpr (P::F8) asm volatile("" : "+v"(acc[0][0][0][0]), "+v"(acc[0][0][0][1]), "+v"(acc[0][0][1][0]), "+v"(acc[0][0][1][1]), "+v"(acc[0][0][2][0]), "+v"(acc[0][0][2][1]), \
        "+v"(acc[0][0][3][0]), "+v"(acc[0][0][3][1]), "+v"(acc[0][1][0][0]), "+v"(acc[0][1][0][1]), "+v"(acc[0][1][1][0]), "+v"(acc[0][1][1][1]), "+v"(acc[0][1][2][0]), "+v"(acc[0][1][2][1]), \
        "+v"(acc[0][1][3][0]), "+v"(acc[0][1][3][1])); } while (0)
#define PG8_WAIT_V(n) asm volatile("s_waitcnt vmcnt(" #n ")" ::: "memory")
#define PG8_WAIT_L(n) asm volatile("s_waitcnt lgkmcnt(" #n ")" ::: "memory")
#define PG8_BAR __builtin_amdgcn_s_barrier()
#define PG8_SCHED __builtin_amdgcn_sched_barrier(0)
    Unit cur, nxt; int ui = 0;
    if (!Pb.next(0, cur)) return;
    f32x4 acc[2][2][4][2];
#pragma unroll
    for (int a = 0; a < 2; ++a)
#pragma unroll
        for (int b = 0; b < 2; ++b)
#pragma unroll
            for (int m = 0; m < 4; ++m)
#pragma unroll
                for (int n = 0; n < 2; ++n) acc[a][b][m][n] = (f32x4){0.f, 0.f, 0.f, 0.f};
    typedef typename FragT<P::F8>::A_t AFr; typedef typename FragT<P::F8>::B_t BFr;
    AFr At; BFr B0, B1;
    unsigned vA0[2], vA1[2];
    Pb.a_offs(0, cur, vA0, vA1, Rr, Cc);
    const char* cA = Pb.a_base(cur); const char* cB = Pb.b_base(cur);
    PG8_STAGE(PG8_SB(0, 0), cB, voffB); PG8_STAGE(PG8_SB(0, 1), cB + hstep, voffB); PG8_STAGE(PG8_SA(0, 0), cA, vA0); PG8_STAGE(PG8_SA(0, 1), cA, vA1);
    if (wr == 1) PG8_BAR;
    PG8_WAIT_V(2); PG8_BAR;
    PG8_STAGE(PG8_SB(1, 0), cB + kstep, voffB); PG8_STAGE(PG8_SA(1, 0), cA + kstep, vA0); PG8_STAGE(PG8_SB(1, 1), cB + hstep + kstep, voffB);
    PG8_WAIT_V(6); PG8_BAR;
    for (;;) {
        const bool has_next = Pb.next(ui + 1, nxt);
        const char* nA = has_next ? Pb.a_base(nxt) : cA; const char* nB = has_next ? Pb.b_base(nxt) : cB;
#ifdef MK_KX2
#define PG8_NTL (P::F8 ? 2 * nt : nt)
#define PG8_KOF(x) (P::F8 ? ((x) & (nt - 1)) : (x))
#else
#define PG8_NTL nt
#define PG8_KOF(x) (x)
#endif
#define PG8_KITER \
            const bool last = (t == PG8_NTL - 2); \
            if constexpr (P::MIDSCALE) { if (t == 8) Pb.midscale(acc, cur, wr, fr); } \
            const char* a1 = cA + (size_t)PG8_KOF(t + 1) * kstep; \
            const char* a2 = last ? nA : cA + (size_t)PG8_KOF(t + 2) * kstep; const char* b2 = last ? nB : cB + (size_t)PG8_KOF(t + 2) * kstep; \
            const char* a3 = a2 + kstep; const char* b3 = b2 + kstep; \
            PG8_LDB(B0, 0, 0); PG8_LDB(B1, 0, 1); PG8_SCHED; PG8_LDA(At, 0, 0); PG8_STAGE(PG8_SA(1, 1), a1, vA1); \
            PG8_WAIT_V(8); PG8_WAIT_L(0); PG8_BAR; PG8_MMA(0, 0, At, B0); PG8_MMA(0, 1, At, B1); PG8_PIN0; PG8_BAR; PG8_SCHED; \
            if (last && has_next) { \
                if constexpr (P::F8) { int R2[2], C2[2]; int t2 = tid; asm volatile("" : "+v"(t2)); \
_Pragma("unroll") \
                    for (int i = 0; i < 2; ++i) stage_rc(t2 * 16 + i * 8192, R2[i], C2[i]); \
                    Pb.a_offs(ui + 1, nxt, vA0, vA1, R2, C2); } \
                else Pb.a_offs(ui + 1, nxt, vA0, vA1, Rr, Cc); } \
            PG8_LDA(At, 0, 1); PG8_STAGE(PG8_SB(0, 0), b2, voffB); PG8_STAGE(PG8_SB(0, 1), b2 + hstep, voffB); PG8_STAGE(PG8_SA(0, 0), a2, vA0); \
            PG8_WAIT_V(8); PG8_WAIT_L(0); PG8_BAR; PG8_MMA(1, 0, At, B0); PG8_MMA(1, 1, At, B1); PG8_BAR; PG8_SCHED; \
            PG8_LDB(B0, 1, 0); PG8_LDB(B1, 1, 1); PG8_SCHED; PG8_LDA(At, 1, 0); PG8_STAGE(PG8_SA(0, 1), a2, vA1); \
            PG8_WAIT_V(8); PG8_WAIT_L(0); PG8_BAR; PG8_MMA(0, 0, At, B0); PG8_MMA(0, 1, At, B1); PG8_BAR; PG8_SCHED; \
            PG8_LDA(At, 1, 1); PG8_STAGE(PG8_SB(1, 0), b3, voffB); PG8_STAGE(PG8_SB(1, 1), b3 + hstep, voffB); PG8_STAGE(PG8_SA(1, 0), a3, vA0); \
            PG8_WAIT_V(8); PG8_WAIT_L(0); PG8_BAR; PG8_MMA(1, 0, At, B0); PG8_MMA(1, 1, At, B1); PG8_BAR; PG8_SCHED;
        if constexpr (P::F8) {
#pragma unroll 1
            for (int t = 0; t < PG8_NTL; t += 2) { PG8_KITER }
        } else {
            for (int t = 0; t < nt; t += 2) { PG8_KITER }
        }
#undef PG8_KITER
        if (wr == 0) PG8_BAR;
#ifdef MK_KX2
        if constexpr (P::F8) {
#pragma unroll
            for (int a = 0; a < 2; ++a)
#pragma unroll
                for (int b = 0; b < 2; ++b)
#pragma unroll
                    for (int m = 0; m < 4; ++m)
#pragma unroll
                        for (int n = 0; n < 2; ++n) acc[a][b][m][n] *= 0.5f; }
#endif
#ifdef MK_EPIX2
        if constexpr (P::F8) { int ln3 = lane; asm volatile("" : "+v"(ln3)); Pb.epi(acc, cur, wr, wc, ln3 & 15, ln3 >> 4); }
#endif
        if constexpr (P::F8) { int ln2 = lane; asm volatile("" : "+v"(ln2)); Pb.epi(acc, cur, wr, wc, ln2 & 15, ln2 >> 4); } else Pb.epi(acc, cur, wr, wc, fr, fq);
        if (!has_next) break;
#pragma unroll
        for (int a = 0; a < 2; ++a)
#pragma unroll
            for (int b = 0; b < 2; ++b)
#pragma unroll
                for (int m = 0; m < 4; ++m)
#pragma unroll
                    for (int n = 0; n < 2; ++n) acc[a][b][m][n] = (f32x4){0.f, 0.f, 0.f, 0.f};
        cur = nxt; cA = nA; cB = nB; ++ui;
        if (wr == 1) PG8_BAR;
    }
    PG8_WAIT_V(0);
    PG8_BAR;
#undef PG8_SA
#undef PG8_SB
#undef PG8_STAGE
#undef PG8_LDA
#undef PG8_LDB
#undef PG8_MMA
#undef PG8_WAIT_V
#undef PG8_PIN0
#undef PG8_WAIT_L
#undef PG8_BAR
#undef PG8_SCHED
}

__device__ __forceinline__ int moe_tables(LAS unsigned char* lds, const int* cnt) {
    LAS int* tile_e = (LAS int*)(lds + LDS_TILE_E); LAS int* tile_m = (LAS int*)(lds + LDS_TILE_M); LAS int* rts = (LAS int*)(lds + LDS_MISC + 32); LAS int* lcnt = (LAS int*)(lds + LDS_CNT);
    const int t = tid_fresh();
    if (t < 64) {
        const int c = (t < NE) ? cnt[t * CNT_STRIDE] : 0; const int n = (c + 255) >> 8; int pre = n;
#pragma unroll
        for (int d = 1; d < 32; d <<= 1) { const int v = __shfl_up(pre, d, 64); if (t >= d) pre += v; }
        if (t < NE) { lcnt[t] = c; const int a0 = pre - n; ((LAS int*)(lds + LDS_TOFF))[t] = a0; for (int m = 0; m < n; ++m) { tile_e[a0 + m] = t; tile_m[a0 + m] = m; } }
        if (t == NE - 1) rts[0] = pre;
    }
    __syncthreads();
    return rts[0];
}
}
namespace mk {
__device__ __forceinline__ float wsum(float v) {
#pragma unroll
    for (int o = 1; o < 64; o <<= 1) v += __shfl_xor(v, o);
    return v; }
__device__ __forceinline__ unsigned short f2bf(float f) { unsigned u = __float_as_uint(f); u += 0x7FFFu + ((u >> 16) & 1u); return (unsigned short)(u >> 16); }
}
namespace mk {
typedef float f32x16 __attribute__((ext_vector_type(16)));
typedef short s16x4 __attribute__((ext_vector_type(4)));
typedef __bf16 bf2_t __attribute__((ext_vector_type(2)));
#define MFMA32(a, b, c) __builtin_amdgcn_mfma_f32_32x32x16_bf16((a), (b), (c), 0, 0, 0)
constexpr float LOG2E = 1.4426950408889634f;
constexpr float AT_THR = 8.f;
constexpr int PROJ_LD = NPROJ;
constexpr int AT_NPB = 2  , AT_KBUF = 0, AT_VBUF = 16384, AT_IMPW = 32768, AT_SCORE = 2 * AT_NPB * 16384  , AT_OBUF = AT_SCORE + 8192, AT_OSTR = 528, AT_BTAB = AT_OBUF + 64 * AT_OSTR  ,
              AT_SEL = AT_BTAB + 8 * 132 * 4  , AT_SSQ = AT_SEL + 512  , AT_END = AT_SSQ + 8 * 64 * 4  ;
struct AttnArgs { const bf16_t* projb; const bf16_t* kc; const bf16_t* vc; bf16_t* catb; float* ssq; };

__device__ __forceinline__ unsigned pk2(float a, float b) { f2_t v = {a, b}; return __builtin_bit_cast(unsigned, __builtin_convertvector(v, bf2_t)); }
__device__ __forceinline__ int t5_bucket(int n) { if (n < 0) n = 0; if (n < 16) return n; const float nf = (float)n; const int l = 16 + (int)(logf(nf / 16.f) / 2.0794415416798357f * 16.f); return l < 31 ? l : 31; }
__device__ __forceinline__ float xh_max(float x) { const auto r = __builtin_amdgcn_permlane32_swap(__float_as_uint(x), __float_as_uint(x), false, false); return fmaxf(__uint_as_float(r[0]), __uint_as_float(r[1])); }
__device__ __forceinline__ float xh_sum(float x) { const auto r = __builtin_amdgcn_permlane32_swap(__float_as_uint(x), __float_as_uint(x), false, false); return __uint_as_float(r[0]) + __uint_as_float(r[1]); }
__device__ __forceinline__ float xh_other(float x, int h) { const auto r = __builtin_amdgcn_permlane32_swap(__float_as_uint(x), __float_as_uint(x), false, false); return __uint_as_float(h ? r[0] : r[1]); }
__device__ __forceinline__ void stage_tile(LAS unsigned char* dst, const char* src, size_t row_stride, int wid, int lane, bool vswz) {
    const int row = 8 * wid + (lane >> 3), slot = lane & 7;
    const int f = vswz ? (((row >> 1) & 1) << 2) : ((row >> 1) & 7);
    __builtin_amdgcn_global_load_lds((const unsigned*)(src + (size_t)row * row_stride + ((slot ^ f) << 4)), (LAS unsigned*)(dst + wid * 1024), 16, 0, 0);
}
#define AT_CROW(r, h) (((r) & 3) + 8 * ((r) >> 2) + 4 * (h))
#define AT_PACK8(x, s) __builtin_bit_cast(bf16x8, (u32x4){pk2((x)[8 * (s)], (x)[8 * (s) + 1]), pk2((x)[8 * (s) + 2], (x)[8 * (s) + 3]), pk2((x)[8 * (s) + 4], (x)[8 * (s) + 5]), pk2((x)[8 * (s) + 6], (x)[8 * (s) + 7])})
__device__ __forceinline__ bf16x8 vt_frag(const LAS unsigned char* vt, unsigned vaddr, int rowoff) {
    const s16x4 lo = __builtin_amdgcn_ds_read_tr16_b64_v4i16((LAS s16x4*)(vt + vaddr + rowoff * 128));
    const s16x4 hi = __builtin_amdgcn_ds_read_tr16_b64_v4i16((LAS s16x4*)(vt + vaddr + (rowoff + 8) * 128));
    return __builtin_shufflevector(lo, hi, 0, 1, 2, 3, 4, 5, 6, 7);
}
template <bool FIRST>
__device__ __forceinline__ void obuf_acc(LAS unsigned char* lds, int tl, int hd, int h, float sc, const f32x16 (&oc)[2]) {
#pragma unroll
    for (int c = 0; c < 2; ++c)
#pragma unroll
        for (int qd = 0; qd < 4; ++qd) { LAS u32x2* p = (LAS u32x2*)(lds + AT_OBUF + tl * AT_OSTR + ((hd & 3) * 64 + 32 * c + 8 * qd + 4 * h) * 2);
            float a0 = sc * oc[c][4 * qd], a1 = sc * oc[c][4 * qd + 1], a2 = sc * oc[c][4 * qd + 2], a3 = sc * oc[c][4 * qd + 3];
            if (!FIRST) { const u32x2 o = *p; a0 += __uint_as_float(o.x << 16); a1 += __uint_as_float(o.x & 0xffff0000u); a2 += __uint_as_float(o.y << 16); a3 += __uint_as_float(o.y & 0xffff0000u); }
            *p = (u32x2){pk2(a0, a1), pk2(a2, a3)}; }
}
__device__ __forceinline__ void attn_tile(const int kind, const LAS unsigned char* Kt, const LAS unsigned char* Vt, int kbase, int tq, bool sel, const bf16x8 (&qf)[4], const LAS float* bt, float cfar,
                                          f32x16 (&O)[2], float& m, float& l, int ql, int h, const unsigned (&vaddr)[2]) {
    f32x16 s0, s1;
    const int fk = (ql >> 1) & 7;
    bf16x8 kf0[4], kf1[4];
#pragma unroll
    for (int s = 0; s < 4; ++s) { const int ch = ((2 * s + h) ^ fk) << 4; kf0[s] = *(const LAS bf16x8*)(Kt + ql * 128 + ch); kf1[s] = *(const LAS bf16x8*)(Kt + (32 + ql) * 128 + ch); }
    if (kind == 0) {
#pragma unroll
        for (int r = 0; r < 16; ++r) { s0[r] = 0.f; s1[r] = 0.f; }
        __builtin_amdgcn_s_setprio(1);
#pragma unroll
        for (int s = 0; s < 4; ++s) { s0 = MFMA32(kf0[s], qf[s], s0); s1 = MFMA32(kf1[s], qf[s], s1); }
        __builtin_amdgcn_s_setprio(0);
    } else {
        int tqq = tq - kbase; asm volatile("" : "+v"(tqq));
#pragma unroll
        for (int r = 0; r < 16; ++r) { const int d0 = tqq - AT_CROW(r, h), d1 = d0 - 32; s0[r] = bt[min(max(d0, 0), 128)]; s1[r] = bt[min(max(d1, 0), 128)]; }
        __builtin_amdgcn_s_setprio(1);
#pragma unroll
        for (int s = 0; s < 4; ++s) { s0 = MFMA32(kf0[s], qf[s], s0); s1 = MFMA32(kf1[s], qf[s], s1); }
        __builtin_amdgcn_s_setprio(0);
        if (kind == 2) {
#pragma unroll
            for (int r = 0; r < 16; ++r) { const int d0 = tqq - AT_CROW(r, h), d1 = d0 - 32;
                s0[r] = (d0 >= 0 && d0 < 512) ? s0[r] : -INFINITY; s1[r] = (d1 >= 0 && d1 < 512) ? s1[r] : -INFINITY; } }
    }
    float mx = __builtin_fmaxf(s0[15], s1[15]);
#define AT_MAX3X8(acc_, o_) asm("v_max3_f32 %0, %0, %1, %2\n\tv_max3_f32 %0, %0, %3, %4\n\tv_max3_f32 %0, %0, %5, %6\n\tv_max3_f32 %0, %0, %7, %8\n\t" \
        "v_max3_f32 %0, %0, %9, %10\n\tv_max3_f32 %0, %0, %11, %12\n\tv_max3_f32 %0, %0, %13, %14\n\tv_max3_f32 %0, %0, %15, %16" : "+v"(acc_) : \
        "v"(s0[o_]), "v"(s1[o_]), "v"(s0[o_ + 1]), "v"(s1[o_ + 1]), "v"(s0[o_ + 2]), "v"(s1[o_ + 2]), "v"(s0[o_ + 3]), "v"(s1[o_ + 3]), \
        "v"(s0[o_ + 4]), "v"(s1[o_ + 4]), "v"(s0[o_ + 5]), "v"(s1[o_ + 5]), "v"(s0[o_ + 6]), "v"(s1[o_ + 6]), "v"(s0[o_ + 7]), "v"(s1[o_ + 7]))
    AT_MAX3X8(mx, 0); AT_MAX3X8(mx, 8);
    if (kind == 0) mx += cfar;
#undef AT_MAX3X8
    mx = sel ? mx : -INFINITY;
    mx = xh_max(mx);
    const float mn = (mx > m + AT_THR) ? mx : m;
    const float alpha = __builtin_amdgcn_exp2f(m - mn);
    float msub = sel ? mn : INFINITY;
    if (kind == 0) msub -= cfar;
    float ps = 0.f;
#pragma unroll
    for (int r = 0; r < 16; ++r) { const float p0 = __builtin_amdgcn_exp2f(s0[r] - msub), p1 = __builtin_amdgcn_exp2f(s1[r] - msub); s0[r] = p0; s1[r] = p1; ps += p0 + p1; }
    l = l * alpha + ps; m = mn;
    if (__any(alpha != 1.f)) {
#pragma unroll
        for (int r = 0; r < 16; ++r) { asm volatile("v_mul_f32 %0, %1, %0" : "+v"(O[0][r]) : "v"(alpha)); asm volatile("v_mul_f32 %0, %1, %0" : "+v"(O[1][r]) : "v"(alpha)); } }
    __builtin_amdgcn_s_setprio(1);
#pragma unroll
    for (int sp = 0; sp < 2; ++sp) {
        const bf16x8 p0 = AT_PACK8(s0, sp), p1 = AT_PACK8(s1, sp);
#pragma unroll
        for (int c = 0; c < 2; ++c) { O[c] = MFMA32(vt_frag(Vt, vaddr[c], 16 * sp), p0, O[c]); O[c] = MFMA32(vt_frag(Vt, vaddr[c], 32 + 16 * sp), p1, O[c]); }
    }
    __builtin_amdgcn_s_setprio(0);
}
template <int MODE>
__device__ __forceinline__ void attn_branch(LAS unsigned char* lds, unsigned U, unsigned mysel, const char* kcol, const char* vcol, size_t RS, int blk, int tq, const bf16x8 (&qf)[4],
                                            const LAS float* bt, float cfar, f32x16 (&oc)[2], float& m, float& l, int ql, int h, const unsigned (&vaddr)[2], int wid, int lane) {
#define AT_NEXT(n) (((n) >= 31) ? -1 : ((U & ~((2u << (n)) - 1u)) ? __builtin_ctz(U & ~((2u << (n)) - 1u)) : -1))
#define AT_ISSUE(n, st) do { stage_tile(lds + (st) * 16384, kcol + (size_t)(n) * 64 * RS, RS, wid, lane, false); stage_tile(lds + (st) * 16384 + 8192, vcol + (size_t)(n) * 64 * RS, RS, wid, lane, true); } while (0)
    int tl_[AT_NPB], pb = 0;
    tl_[0] = __builtin_ctz(U | 0x80000000u);
#pragma unroll
    for (int q = 1; q < AT_NPB; ++q) tl_[q] = (tl_[q - 1] >= 0) ? AT_NEXT(tl_[q - 1]) : -1;
    asm volatile("s_waitcnt lgkmcnt(0)" ::: "memory"); __builtin_amdgcn_s_barrier(); asm volatile("" ::: "memory");
#pragma unroll
    for (int q = 0; q < AT_NPB; ++q) if (tl_[q] >= 0) AT_ISSUE(tl_[q], q);
    for (;;) {
        asm volatile("s_waitcnt vmcnt(0)" ::: "memory");
        asm volatile("s_waitcnt lgkmcnt(0)" ::: "memory"); __builtin_amdgcn_s_barrier(); asm volatile("" ::: "memory");
        int nx[AT_NPB];
        nx[0] = (tl_[AT_NPB - 1] >= 0) ? AT_NEXT(tl_[AT_NPB - 1]) : -1;
#pragma unroll
        for (int q = 1; q < AT_NPB; ++q) nx[q] = (nx[q - 1] >= 0) ? AT_NEXT(nx[q - 1]) : -1;
#pragma unroll
        for (int q = 0; q < AT_NPB; ++q) if (nx[q] >= 0) AT_ISSUE(nx[q], AT_NPB * (pb ^ 1) + q);
#pragma unroll
        for (int q = 0; q < AT_NPB; ++q) { const int tcur = tl_[q]; if (tcur < 0) break;
            const LAS unsigned char* Kt = lds + (AT_NPB * pb + q) * 16384; const LAS unsigned char* Vt = Kt + 8192;
            const bool sel = (MODE == 0) ? (((mysel >> tcur) & 1u) != 0u) : true;
            const bool masked = (tcur == blk) || (MODE == 1 && tcur + 8 == blk);
            attn_tile(masked ? 2 : ((tcur + 3 <= blk) ? 0 : 1), Kt, Vt, tcur * 64, tq, sel, qf, bt, cfar, oc, m, l, ql, h, vaddr); }
        if (nx[0] < 0) break;
#pragma unroll
        for (int q = 0; q < AT_NPB; ++q) tl_[q] = nx[q];
        pb ^= 1;
    }
#undef AT_NEXT
#undef AT_ISSUE
}

__device__ __forceinline__ void attn_item(LAS unsigned char* lds, const AttnArgs& A, int b, int qt, int kvh) {
    const int tid = tid_fresh(), wid = __builtin_amdgcn_readfirstlane(tid >> 6), lane = tid & 63;
    const int g = wid >> 1, th = wid & 1, ql = lane & 31, h = lane >> 5;
    const int t0 = qt * 64, tl = th * 32 + ql, tq = t0 + tl, blk = qt;
    const int qq = (lane & 15) >> 2, pp = lane & 3, lb = (lane >> 4) & 1;
    unsigned vaddr[2];
#pragma unroll
    for (int c = 0; c < 2; ++c) vaddr[c] = (unsigned)((4 * h + qq) * 128 + (((4 * (c ^ ((qq >> 1) & 1))) + 2 * lb + (pp >> 1)) << 4) + 8 * (pp & 1));
    LAS float* impw = (LAS float*)(lds + AT_IMPW); LAS float* score = (LAS float*)(lds + AT_SCORE); LAS unsigned* selm = (LAS unsigned*)(lds + AT_SEL);
    const char* prow0 = (const char*)(A.projb + (size_t)b * S * PROJ_LD);
    const size_t RS = (size_t)PROJ_LD * 2;
    {
        const int hd = kvh * 4 + g;
        const LAS float* bt = (const LAS float*)(lds + AT_BTAB) + hd * 132;
        const float cfar = bt[128];
        bf16x8 qf[4];
#pragma unroll
        for (int s = 0; s < 4; ++s) qf[s] = *(const bf16x8*)(A.projb + ((size_t)b * S + tq) * PROJ_LD + hd * 64 + 16 * s + 8 * h);
        float gate[3];
#pragma unroll
        for (int j = 0; j < 3; ++j) { const float gv = bf2f(A.projb[((size_t)b * S + tq) * PROJ_LD + 1280 + j * 8 + hd]); gate[j] = 1.f / (1.f + __expf(-gv)); }
        __syncthreads();
        { const char* kcb = (const char*)(A.kc + (size_t)(b * 2 + kvh) * 128 * 64); const char* vcb = (const char*)(A.vc + (size_t)(b * 2 + kvh) * 128 * 64);
          stage_tile(lds + AT_KBUF, kcb, 128, wid, lane, false); stage_tile(lds + AT_KBUF + 8192, kcb + 64 * 128, 128, wid, lane, false);
          stage_tile(lds + AT_VBUF, vcb, 128, wid, lane, true); stage_tile(lds + AT_VBUF + 8192, vcb + 64 * 128, 128, wid, lane, true); }
        asm volatile("s_waitcnt vmcnt(0)" ::: "memory"); __syncthreads();
        {
            f32x16 sc[4]; const int fk = (ql >> 1) & 7; int tqc = tq; asm volatile("" : "+v"(tqc));
            const int nkb = ((t0 + 32) >> 4) / 32 + 1;
#pragma unroll
            for (int kb = 0; kb < 4; ++kb) {
#pragma unroll
                for (int r = 0; r < 16; ++r) sc[kb][r] = 0.f;
                if (kb < nkb) {
#pragma unroll
                for (int s = 0; s < 4; ++s) { const bf16x8 kf = *(const LAS bf16x8*)(lds + AT_KBUF + (32 * kb + ql) * 128 + (((2 * s + h) ^ fk) << 4)); sc[kb] = MFMA32(kf, qf[s], sc[kb]); } }
                __builtin_amdgcn_sched_barrier(0); }
            float mx = -INFINITY;
#pragma unroll
            for (int kb = 0; kb < 4; ++kb) {
                if (kb >= nkb) {
#pragma unroll
                    for (int r = 0; r < 16; ++r) sc[kb][r] = -INFINITY;
                    continue; }
#pragma unroll
                for (int r = 0; r < 16; ++r) { const int c = 32 * kb + AT_CROW(r, h); const int dist = tqc - 16 * c - 31; const float bv = bt[min(max(dist, 0), 128)]; const float x = (dist >= 0) ? sc[kb][r] + bv : -INFINITY; sc[kb][r] = x; mx = fmaxf(mx, x);
                    if ((r & 7) == 7) __builtin_amdgcn_sched_barrier(0); } }
            mx = xh_max(mx);
            const float mref = (mx == -INFINITY) ? 0.f : mx;
            float ls = 0.f;
#pragma unroll
            for (int kb = 0; kb < 4; ++kb) {
                if (kb >= nkb) {
#pragma unroll
                    for (int r = 0; r < 16; ++r) sc[kb][r] = 0.f;
                    continue; }
#pragma unroll
                for (int r = 0; r < 16; ++r) { const float p = __builtin_amdgcn_exp2f(sc[kb][r] - mref); sc[kb][r] = p; ls += p; } }
            ls = xh_sum(ls);
            const float inv = 1.f / fmaxf(ls, 1e-30f);
#pragma unroll
            for (int kb = 0; kb < 4; ++kb) { if (kb >= nkb) continue;
#pragma unroll
                for (int r = 0; r < 16; ++r) sc[kb][r] *= inv; }
            if (blk >= 16) { float carry = 0.f;
#pragma unroll
              for (int i = 0; i < 16; ++i) { const int kb = i >> 2, qd = i & 3;
                  const float s4 = (sc[kb][4 * qd] + sc[kb][4 * qd + 1]) + (sc[kb][4 * qd + 2] + sc[kb][4 * qd + 3]);
                  const float rv = xh_other(sc[kb][4 * qd + 3], h);
                  impw[(wid * 32 + ql) * 32 + 2 * i + h] = s4 + (h ? rv : carry); carry = rv; } }
            f32x16 oc[2];
#pragma unroll
            for (int r = 0; r < 16; ++r) { oc[0][r] = 0.f; oc[1][r] = 0.f; }
#pragma unroll
            for (int kb = 0; kb < 4; ++kb) { if (kb >= nkb) continue;
#pragma unroll
                for (int sp = 0; sp < 2; ++sp) { const bf16x8 pf = AT_PACK8(sc[kb], sp);
#pragma unroll
                    for (int c = 0; c < 2; ++c) oc[c] = MFMA32(vt_frag(lds + AT_VBUF, vaddr[c], 32 * kb + 16 * sp), pf, oc[c]);
                    __builtin_amdgcn_sched_barrier(0); } }
            obuf_acc<true>(lds, tl, hd, h, gate[0], oc);
        }
        __syncthreads();
        unsigned U = (blk >= 31) ? 0xffffffffu : ((2u << blk) - 1u);
        if (blk >= 16) {
        int tids = tid; asm volatile("" : "+v"(tids));
#pragma unroll
        for (int i = 0; i < 4; ++i) { const int id = tids + 512 * i, tk = id >> 5, n = id & 31, w0 = tk >> 5, q = tk & 31;
            float v = 0.f;
#pragma unroll
            for (int gg = 0; gg < 4; ++gg) v += impw[((2 * gg + w0) * 32 + q) * 32 + n];
            const bool forced = (n == 0) || (n == blk) || (n == blk - 1);
            score[tk * 32 + n] = forced ? 1e4f : ((n <= blk) ? v : -1.f); }
        __syncthreads();
        { const int tk = tids >> 3, part = tids & 7;
          float sv[32];
#pragma unroll
          for (int e4 = 0; e4 < 8; ++e4) { const f32x4 q4 = *(const LAS f32x4*)(score + tk * 32 + e4 * 4); sv[e4 * 4] = q4[0]; sv[e4 * 4 + 1] = q4[1]; sv[e4 * 4 + 2] = q4[2]; sv[e4 * 4 + 3] = q4[3]; }
          unsigned bits = 0u;
#pragma unroll
          for (int j = 0; j < 4; ++j) { const int n = 4 * part + j; const float sn = score[tk * 32 + n];
              int rank = 0;
#pragma unroll
              for (int mm = 0; mm < 32; ++mm) rank += (sv[mm] > sn || (sv[mm] == sn && mm < n)) ? 1 : 0;
              bits |= ((rank < 16) && (n <= blk)) ? (1u << n) : 0u; }
          bits |= (unsigned)__shfl_xor((int)bits, 1); bits |= (unsigned)__shfl_xor((int)bits, 2); bits |= (unsigned)__shfl_xor((int)bits, 4);
          if (part == 0) selm[tk] = bits; }
        __syncthreads();
        U = selm[lane];
#pragma unroll
        for (int o = 1; o < 64; o <<= 1) U |= (unsigned)__shfl_xor((int)U, o);
        U = (unsigned)__builtin_amdgcn_readfirstlane((int)U);
        }
        const unsigned mysel = (blk >= 16) ? selm[tl] : U;
        {
            f32x16 oc[2];
#pragma unroll
            for (int r = 0; r < 16; ++r) { oc[0][r] = 0.f; oc[1][r] = 0.f; }
            float m = -1e30f, l = 0.f;
            attn_branch<0>(lds, U, mysel, prow0 + (512 + 2 * 128 + kvh * 64) * 2, prow0 + (512 + 3 * 128 + kvh * 64) * 2, RS, blk, tq, qf, bt, cfar, oc, m, l, ql, h, vaddr, wid, lane);
            l = xh_sum(l);
            const float sc1 = gate[1] / fmaxf(l, 1e-30f);
            obuf_acc<false>(lds, tl, hd, h, sc1, oc);
        }
        {
            f32x16 oc[2];
#pragma unroll
            for (int r = 0; r < 16; ++r) { oc[0][r] = 0.f; oc[1][r] = 0.f; }
            float m = -1e30f, l = 0.f;
            const int lo = (blk >= 8) ? blk - 8 : 0;
            const unsigned Uw = ((blk >= 31) ? 0xffffffffu : ((2u << blk) - 1u)) & ~((1u << lo) - 1u);
            attn_branch<1>(lds, Uw, 0u, prow0 + (512 + 4 * 128 + kvh * 64) * 2, prow0 + (512 + 5 * 128 + kvh * 64) * 2, RS, blk, tq, qf, bt, cfar, oc, m, l, ql, h, vaddr, wid, lane);
            l = xh_sum(l);
            const float sc2 = gate[2] / fmaxf(l, 1e-30f);
            obuf_acc<false>(lds, tl, hd, h, sc2, oc);
        }
    }
    __syncthreads();
    int widn = wid; asm volatile("" : "+s"(widn));
    { u32x2 v[8]; float sq[8];
#pragma unroll
      for (int i = 0; i < 8; ++i) { v[i] = *(const LAS u32x2*)(lds + AT_OBUF + (widn + 8 * i) * AT_OSTR + lane * 8);
          const float f0 = __uint_as_float(v[i].x << 16), f1 = __uint_as_float(v[i].x & 0xffff0000u), f2 = __uint_as_float(v[i].y << 16), f3 = __uint_as_float(v[i].y & 0xffff0000u);
          sq[i] = (f0 * f0 + f1 * f1) + (f2 * f2 + f3 * f3); }
#pragma unroll
      for (int o = 1; o < 64; o <<= 1) {
#pragma unroll
          for (int i = 0; i < 8; ++i) sq[i] += __shfl_xor(sq[i], o); }
#pragma unroll
      for (int i = 0; i < 8; ++i) { const int row = widn + 8 * i;
          *(u32x2*)(A.catb + ((size_t)b * S + t0 + row) * 1024 + kvh * 256 + lane * 4) = v[i];
          if (lane == 0) A.ssq[((size_t)b * S + t0 + row) * 2 + kvh] = sq[i]; } }
    __syncthreads();
}
__device__ __forceinline__ void attn_btab(LAS unsigned char* lds, const float* rel_bias) {
    LAS float* bt = (LAS float*)(lds + AT_BTAB);
    float v[3];
#pragma unroll
    for (int q = 0; q < 3; ++q) { const int i = (int)threadIdx.x + 512 * q; const int hd = i / 129, d = i % 129; v[q] = (i < 8 * 129) ? rel_bias[t5_bucket(d) * 8 + hd] : 0.f; }
#pragma unroll
    for (int q = 0; q < 3; ++q) { const int i = (int)threadIdx.x + 512 * q; const int hd = i / 129, d = i % 129; if (i < 8 * 129) bt[hd * 132 + d] = v[q] * LOG2E; }
    __syncthreads();
}
}
namespace mk {
constexpr int XBC_OFF = 1816, Z_OFF = 1304, DT_OFF = 2840, NCH = 16;
constexpr int SD_XS = 0, SD_B = 65536, SD_C = 98304, SD_PREV = 131072  , SD_ACS = SD_PREV + 16384, SD_DT = SD_ACS + 2048, SD_W = SD_DT + 2048, SD_WP = SD_W + 2048  , SD_END = SD_WP + 256;
struct SsdArgs { const bf16_t* projb; const float* conv_w; const float* conv_b; const float* dt_bias; const float* a_log; const float* d_skip; bf16_t* states; float* alast; bf16_t* catb; };

__device__ __forceinline__ void ssd_dt_acs(LAS unsigned char* lds, const SsdArgs& A, int b, int c, int grp, int wid, int lane) {
    if (wid < 4) { const int hd = grp * 4 + wid; const float Ah = -__expf(A.a_log[hd]), db = A.dt_bias[hd];
        const size_t row = (size_t)b * S + c * 128 + 2 * lane;
        float x0 = bf2f(A.projb[row * PROJ_LD + DT_OFF + hd]) + db, x1 = bf2f(A.projb[(row + 1) * PROJ_LD + DT_OFF + hd]) + db;
        const float d0 = (x0 > 20.f) ? x0 : log1pf(__expf(x0)), d1 = (x1 > 20.f) ? x1 : log1pf(__expf(x1));
        const float a0 = d0 * Ah, a1 = d1 * Ah; float incl = a0 + a1;
#pragma unroll
        for (int o = 1; o < 64; o <<= 1) { const float t = __shfl_up(incl, o); if (lane >= o) incl += t; }
        LAS float* acs = (LAS float*)(lds + SD_ACS) + wid * 128; LAS float* dtl = (LAS float*)(lds + SD_DT) + wid * 128;
        acs[2 * lane] = incl - a1; acs[2 * lane + 1] = incl; dtl[2 * lane] = d0; dtl[2 * lane + 1] = d1;
        LAS float* lw = (LAS float*)(lds + SD_W) + wid * 128;
        lw[2 * lane] = (__logf(d0) - (incl - a1)) * 1.4426950408889634f; lw[2 * lane + 1] = (__logf(d1) - incl) * 1.4426950408889634f; }
}
template <bool PHASE_A>
__device__ __forceinline__ void ssd_conv(LAS unsigned char* lds, const SsdArgs& A, int b, int c, int grp, int wid, int lane) {
    const int ch = lane;
    if (PHASE_A && ch >= 48) return;
    const int rel = (ch < 32) ? grp * 256 + ch * 8 : (ch < 48) ? 512 + grp * 128 + (ch - 32) * 8 : 768 + grp * 128 + (ch - 48) * 8;
    float w[4][8], bias[8];
#pragma unroll
    for (int k = 0; k < 4; ++k) { const f32x4 u0 = *(const f32x4*)(A.conv_w + k * 1024 + rel), u1 = *(const f32x4*)(A.conv_w + k * 1024 + rel + 4);
#pragma unroll
        for (int j = 0; j < 4; ++j) { w[k][j] = u0[j]; w[k][4 + j] = u1[j]; } }
    { const f32x4 u0 = *(const f32x4*)(A.conv_b + rel), u1 = *(const f32x4*)(A.conv_b + rel + 4);
#pragma unroll
      for (int j = 0; j < 4; ++j) { bias[j] = u0[j]; bias[4 + j] = u1[j]; } }
    const int tl0 = wid * 16, ts0 = c * 128 + tl0;
    const bf16_t* src = A.projb + ((size_t)b * S + ts0) * PROJ_LD + XBC_OFF + rel;
    float x0[8], x1[8], x2[8];
#pragma unroll
    for (int j = 0; j < 8; ++j) { x0[j] = 0.f; x1[j] = 0.f; x2[j] = 0.f; }
    if (ts0 >= 3) {
        const bf16x8 r0 = *(const bf16x8*)(src - 3 * (ptrdiff_t)PROJ_LD), r1 = *(const bf16x8*)(src - 2 * (ptrdiff_t)PROJ_LD), r2 = *(const bf16x8*)(src - 1 * (ptrdiff_t)PROJ_LD);
#pragma unroll
        for (int j = 0; j < 8; ++j) { x0[j] = bf2f((bf16_t)r0[j]); x1[j] = bf2f((bf16_t)r1[j]); x2[j] = bf2f((bf16_t)r2[j]); } }
    const LAS float* wt = (const LAS float*)(lds + SD_W) + (ch >> 3) * 128;
    bf16x8 rvv[16];
#pragma unroll
    for (int i = 0; i < 16; ++i) rvv[i] = *(const bf16x8*)(src + (size_t)i * PROJ_LD);
#pragma unroll
    for (int i = 0; i < 16; ++i) {
        const bf16x8 rv = rvv[i];
        float x3[8], o[8];
#pragma unroll
        for (int j = 0; j < 8; ++j) { x3[j] = bf2f((bf16_t)rv[j]); const float a = bias[j] + w[0][j] * x0[j] + w[1][j] * x1[j] + w[2][j] * x2[j] + w[3][j] * x3[j]; o[j] = a * __builtin_amdgcn_rcpf(1.f + __builtin_amdgcn_exp2f(-1.4426950408889634f * a)); x0[j] = x1[j]; x1[j] = x2[j]; x2[j] = x3[j]; }
        const int row = tl0 + i;
        if (PHASE_A && ch < 32) { const float sc = wt[row];
#pragma unroll
            for (int j = 0; j < 8; ++j) o[j] *= sc; }
        u32x4 pk; pk.x = pk2(o[0], o[1]); pk.y = pk2(o[2], o[3]); pk.z = pk2(o[4], o[5]); pk.w = pk2(o[6], o[7]);
        if (ch < 32) *(LAS u32x4*)(lds + SD_XS + row * 512 + ((ch ^ ((row & 3) << 2)) << 4)) = pk;
        else if (ch < 48) { const int cc = ch - 32; *(LAS u32x4*)(lds + SD_B + row * 256 + ((PHASE_A ? (cc ^ ((row & 3) << 2)) : (cc ^ (row & 15))) << 4)) = pk; }
        else { const int cc = ch - 48; *(LAS u32x4*)(lds + SD_C + row * 256 + ((cc ^ (row & 15)) << 4)) = pk; }
    }
}
__device__ __forceinline__ bf16x8 tr_frag2(const LAS unsigned char* base, int stride, int r0, int r1, int chunk0, int qq, int pp) {
    const int cl = chunk0 + (pp >> 1);
    const s16x4 lo = __builtin_amdgcn_ds_read_tr16_b64_v4i16((LAS s16x4*)(base + (r0 + qq) * stride + ((cl ^ (qq << 2)) << 4) + 8 * (pp & 1)));
    const s16x4 hi = __builtin_amdgcn_ds_read_tr16_b64_v4i16((LAS s16x4*)(base + (r1 + qq) * stride + ((cl ^ (qq << 2)) << 4) + 8 * (pp & 1)));
    return __builtin_shufflevector(lo, hi, 0, 1, 2, 3, 4, 5, 6, 7);
}
__device__ __forceinline__ void ssd_a_item(LAS unsigned char* lds, const SsdArgs& A, int item) {
    const int tid = tid_fresh(), wid = __builtin_amdgcn_readfirstlane(tid >> 6), lane = tid & 63;
    const int grp = item & 1, c = (item >> 1) & 15, b = item >> 5;
    const int ql = lane & 31, h = lane >> 5, qq = (lane & 15) >> 2, pp = lane & 3, lb2 = (lane >> 4) & 1;
    __syncthreads();
    ssd_dt_acs(lds, A, b, c, grp, wid, lane);
    __syncthreads();
    { LAS float* acs = (LAS float*)(lds + SD_ACS); LAS float* dtl = (LAS float*)(lds + SD_DT); LAS float* wt = (LAS float*)(lds + SD_W);
      const int hh = tid >> 7, t = tid & 127; const float al = acs[hh * 128 + 127];
      wt[hh * 128 + t] = dtl[hh * 128 + t] * __expf(al - acs[hh * 128 + t]);
      if (t == 0) A.alast[(b * 8 + grp * 4 + hh) * NCH + c] = al; }
    __syncthreads();
    ssd_conv<true>(lds, A, b, c, grp, wid, lane);
    __syncthreads();
    const int pb = wid >> 2, nb = wid & 3;
#pragma unroll 1
    for (int hh = 0; hh < 4; ++hh) {
        f32x16 acc;
#pragma unroll
        for (int r = 0; r < 16; ++r) acc[r] = 0.f;
#pragma unroll
        for (int kk = 0; kk < 8; ++kk) {
            const bf16x8 af = tr_frag2(lds + SD_XS, 512, 16 * kk + 8 * h, 16 * kk + 8 * h + 4, hh * 8 + 4 * pb + 2 * lb2, qq, pp);
            const bf16x8 bf = tr_frag2(lds + SD_B, 256, 16 * kk + 8 * h, 16 * kk + 8 * h + 4, 4 * nb + 2 * lb2, qq, pp);
            acc = MFMA32(af, bf, acc); }
        bf16_t* st = A.states + ((size_t)((b * NCH + c) * 8 + grp * 4 + hh) * 64) * 128;
#pragma unroll
        for (int r = 0; r < 16; ++r) st[(32 * pb + AT_CROW(r, h)) * 128 + 32 * nb + ql] = f2bf(acc[r]);
    }
}
template <class TailF>
__device__ __forceinline__ void ssd_b_item(LAS unsigned char* lds, const SsdArgs& A, int item, TailF tail) {
    const int tid = tid_fresh(), wid = __builtin_amdgcn_readfirstlane(tid >> 6), lane = tid & 63;
    const int grp = item & 1, b = (item >> 1) & 7, c = 15 - (item >> 4);
    const int ql = lane & 31, h = lane >> 5, qq = (lane & 15) >> 2, pp = lane & 3, lb2 = (lane >> 4) & 1;
    const int pb = wid >> 2, lb = wid & 3;
    LAS float* acs = (LAS float*)(lds + SD_ACS); LAS float* dtl = (LAS float*)(lds + SD_DT); LAS float* wp = (LAS float*)(lds + SD_WP);
    __syncthreads();
    ssd_dt_acs(lds, A, b, c, grp, wid, lane);
    if (tid >= 256 && tid < 320) { const int hh = (tid - 256) >> 4, cp = tid & 15; float s = 0.f;
        float al[16];
#pragma unroll
        for (int c2 = 0; c2 < 16; ++c2) al[c2] = A.alast[(b * 8 + grp * 4 + hh) * NCH + c2];
#pragma unroll
        for (int c2 = 0; c2 < 16; ++c2) s += (c2 > cp && c2 < c) ? al[c2] : 0.f;
        wp[hh * 16 + cp] = (cp < c) ? __expf(s) : 0.f; }
    ssd_conv<false>(lds, A, b, c, grp, wid, lane);
    __syncthreads();
#pragma unroll 1
    for (int hh = 0; hh < 4; ++hh) {
        const int hd = grp * 4 + hh;
        const float Dh = A.d_skip[hd];
        u32x2 zz4[4];
        { const bf16_t* zp = A.projb + ((size_t)b * S + c * 128 + 32 * lb + ql) * PROJ_LD + Z_OFF + hd * 64 + 32 * pb + 4 * h;
#pragma unroll
          for (int qd = 0; qd < 4; ++qd) zz4[qd] = *(const u32x2*)(zp + 8 * qd); }
        { float pv[16];
#pragma unroll
          for (int j = 0; j < 16; ++j) pv[j] = 0.f;
          const int p = tid >> 3, n0 = (tid & 7) * 16;
          const bf16_t* sp0 = A.states + ((size_t)((b * NCH) * 8 + hd) * 64 + p) * 128 + n0;
#pragma unroll
          for (int g8 = 0; g8 < 2; ++g8) {
              if (g8 * 8 < c) { bf16x8 s0[8], s1[8];
#pragma unroll
                  for (int u = 0; u < 8; ++u) { const bf16_t* sp = sp0 + (size_t)(g8 * 8 + u) * (8 * 64 * 128); s0[u] = *(const bf16x8*)sp; s1[u] = *(const bf16x8*)(sp + 8); }
#pragma unroll
                  for (int u = 0; u < 8; ++u) { const float wgt = wp[hh * 16 + g8 * 8 + u];
                      if (wgt != 0.f) {
#pragma unroll
                          for (int j = 0; j < 8; ++j) { pv[j] += wgt * bf2f((bf16_t)s0[u][j]); pv[8 + j] += wgt * bf2f((bf16_t)s1[u][j]); } } } } }
          LAS unsigned char* pbuf = lds + SD_PREV + p * 256;
          *(LAS u32x4*)(pbuf + ((((n0 >> 3)) ^ (p & 15)) << 4)) = (u32x4){pk2(pv[0], pv[1]), pk2(pv[2], pv[3]), pk2(pv[4], pv[5]), pk2(pv[6], pv[7])};
          *(LAS u32x4*)(pbuf + ((((n0 >> 3) + 1) ^ (p & 15)) << 4)) = (u32x4){pk2(pv[8], pv[9]), pk2(pv[10], pv[11]), pk2(pv[12], pv[13]), pk2(pv[14], pv[15])}; }
        __syncthreads();
        f32x16 acc;
#pragma unroll
        for (int r = 0; r < 16; ++r) acc[r] = 0.f;
#pragma unroll
        for (int kk = 0; kk < 8; ++kk) {
            const bf16x8 af = *(const LAS bf16x8*)(lds + SD_PREV + (32 * pb + ql) * 256 + (((2 * kk + h) ^ (ql & 15)) << 4));
            const bf16x8 bf = *(const LAS bf16x8*)(lds + SD_C + (32 * lb + ql) * 256 + (((2 * kk + h) ^ (ql & 15)) << 4));
            acc = MFMA32(af, bf, acc); }
        const float al = acs[hh * 128 + 32 * lb + ql];
        { const float e = __expf(al);
#pragma unroll
          for (int r = 0; r < 16; ++r) acc[r] *= e; }
        const float al2 = al * 1.4426950408889634f; const LAS float* lw = (const LAS float*)(lds + SD_W);
#pragma unroll
        for (int sb = 0; sb < 4; ++sb) {
            if (sb <= lb) {
                f32x16 Pm;
#pragma unroll
                for (int r = 0; r < 16; ++r) Pm[r] = 0.f;
#pragma unroll
                for (int kk = 0; kk < 8; ++kk) {
                    const bf16x8 gf = *(const LAS bf16x8*)(lds + SD_B + (32 * sb + ql) * 256 + (((2 * kk + h) ^ (ql & 15)) << 4));
                    const bf16x8 cf = *(const LAS bf16x8*)(lds + SD_C + (32 * lb + ql) * 256 + (((2 * kk + h) ^ (ql & 15)) << 4));
                    Pm = MFMA32(gf, cf, Pm); }
#pragma unroll
                for (int r = 0; r < 16; ++r) { const int sl = 32 * sb + AT_CROW(r, h), ll = 32 * lb + ql;
                    float v = Pm[r] * __builtin_amdgcn_exp2f(al2 + lw[hh * 128 + sl]); v = (sl <= ll) ? v : 0.f; v += (sl == ll) ? Dh : 0.f; Pm[r] = v; }
#pragma unroll
                for (int sp = 0; sp < 2; ++sp) { const bf16x8 pf = AT_PACK8(Pm, sp);
                    const bf16x8 af = tr_frag2(lds + SD_XS, 512, 32 * sb + 16 * sp + 4 * h, 32 * sb + 16 * sp + 8 + 4 * h, hh * 8 + 4 * pb + 2 * lb2, qq, pp);
                    acc = MFMA32(af, pf, acc); } }
        }
        {
#pragma unroll
          for (int qd = 0; qd < 4; ++qd) { const u32x2 zz = zz4[qd];
              const float z0 = __uint_as_float(zz.x << 16), z1 = __uint_as_float(zz.x & 0xffff0000u), z2 = __uint_as_float(zz.y << 16), z3 = __uint_as_float(zz.y & 0xffff0000u);
              acc[4 * qd] *= z0 * __builtin_amdgcn_rcpf(1.f + __builtin_amdgcn_exp2f(-1.4426950408889634f * z0)); acc[4 * qd + 1] *= z1 * __builtin_amdgcn_rcpf(1.f + __builtin_amdgcn_exp2f(-1.4426950408889634f * z1));
              acc[4 * qd + 2] *= z2 * __builtin_amdgcn_rcpf(1.f + __builtin_amdgcn_exp2f(-1.4426950408889634f * z2)); acc[4 * qd + 3] *= z3 * __builtin_amdgcn_rcpf(1.f + __builtin_amdgcn_exp2f(-1.4426950408889634f * z3)); } }
        __syncthreads();
#pragma unroll
        for (int qd = 0; qd < 4; ++qd) { const int row = 32 * lb + ql, chn = hh * 8 + 4 * pb + qd;
            *(LAS u32x2*)(lds + SD_XS + row * 512 + ((chn ^ ((row & 3) << 2)) << 4) + 8 * h) = (u32x2){pk2(acc[4 * qd], acc[4 * qd + 1]), pk2(acc[4 * qd + 2], acc[4 * qd + 3])}; }
    }
    __syncthreads();
    tail();
    int widn = wid; asm volatile("" : "+s"(widn));
#pragma unroll 1
    for (int i0 = 0; i0 < 16; i0 += 8) { u32x2 v[8]; float sq[8]; const int chn = lane >> 1;
#pragma unroll
        for (int i = 0; i < 8; ++i) { const int row = widn + 8 * (i0 + i);
            v[i] = *(const LAS u32x2*)(lds + SD_XS + row * 512 + ((chn ^ ((row & 3) << 2)) << 4) + 8 * (lane & 1));
            const float f0 = __uint_as_float(v[i].x << 16), f1 = __uint_as_float(v[i].x & 0xffff0000u), f2 = __uint_as_float(v[i].y << 16), f3 = __uint_as_float(v[i].y & 0xffff0000u);
            sq[i] = (f0 * f0 + f1 * f1) + (f2 * f2 + f3 * f3); }
#pragma unroll
        for (int o = 1; o < 64; o <<= 1) {
#pragma unroll
            for (int i = 0; i < 8; ++i) sq[i] += __shfl_xor(sq[i], o); }
#pragma unroll
        for (int i = 0; i < 8; ++i) { const int row = widn + 8 * (i0 + i); const float rs = rsqrtf(sq[i] * (1.f / 256.f) + 1e-6f);
            const float f0 = __uint_as_float(v[i].x << 16), f1 = __uint_as_float(v[i].x & 0xffff0000u), f2 = __uint_as_float(v[i].y << 16), f3 = __uint_as_float(v[i].y & 0xffff0000u);
            *(u32x2*)(A.catb + ((size_t)b * S + c * 128 + row) * 1024 + 512 + grp * 256 + lane * 4) = (u32x2){pk2(f0 * rs, f1 * rs), pk2(f2 * rs, f3 * rs)}; } }
}
}
namespace mk {
template <int NR>
__device__ __forceinline__ void rms_rows_bf16(const float* x, bf16_t* o, int r0, int lane) {
    f32x4 v[NR][4]; float s[NR];
#pragma unroll
    for (int i = 0; i < NR; ++i) { const int r = r0 + i; const float* xr = x + (size_t)(r < T ? r : 0) * D;
#pragma unroll
        for (int j = 0; j < 4; ++j) v[i][j] = __builtin_nontemporal_load((const f32x4*)(xr + lane * 4 + 256 * j)); }
#pragma unroll
    for (int i = 0; i < NR; ++i) { s[i] = 0.f;
#pragma unroll
        for (int j = 0; j < 4; ++j) s[i] += (v[i][j][0] * v[i][j][0] + v[i][j][1] * v[i][j][1]) + (v[i][j][2] * v[i][j][2] + v[i][j][3] * v[i][j][3]); }
#pragma unroll
    for (int o2 = 1; o2 < 64; o2 <<= 1) {
#pragma unroll
        for (int i = 0; i < NR; ++i) s[i] += __shfl_xor(s[i], o2); }
#pragma unroll
    for (int i = 0; i < NR; ++i) { const int r = r0 + i; if (r >= T) break; const float rs = rsqrtf(s[i] * (1.f / 1024.f) + 1e-6f);
#pragma unroll
        for (int j = 0; j < 4; ++j) *(u32x2*)(o + (size_t)r * D + lane * 4 + 256 * j) = (u32x2){pk2(v[i][j][0] * rs, v[i][j][1] * rs), pk2(v[i][j][2] * rs, v[i][j][3] * rs)}; }
}
constexpr int WT_PITCH = 68, WT_TILE_BYTES = 64 * WT_PITCH * 4;
template <bool OUT8>
__device__ __forceinline__ void wt_tile(bool dry, const float* W, void* WTv, const float* gk1, const float* gk2, int ksplit, int K, int N, int NP, int mode, int nscale, float sc, int ntn, int ntk,
                                        int tile, LAS float* tl, int lane) {
    const int per = ntn * ntk, z = tile / per, rem = tile % per, n0 = (rem % ntn) * 64;
    const float* Wz = W + (size_t)z * K * N;
  for (int sub = 0; sub < (OUT8 ? 2 : 1); ++sub) {
    const int k0 = ((rem / ntn) * (OUT8 ? 2 : 1) + sub) * 64;
    const int lr = lane >> 4, lc = (lane & 15) * 4;
    f32x4 v[16];
#pragma unroll
    for (int i = 0; i < 16; ++i) { const int k = k0 + 4 * i + lr, n = n0 + lc; v[i] = (n < N) ? __builtin_nontemporal_load((const f32x4*)(Wz + (size_t)k * N + n)) : (f32x4){0.f, 0.f, 0.f, 0.f}; }
    if (gk1) {
#pragma unroll
        for (int i = 0; i < 16; ++i) { const int k = k0 + 4 * i + lr; const float g = (k < ksplit) ? gk1[k] : gk2[k - ksplit]; v[i] = v[i] * g; } }
#pragma unroll
    for (int i = 0; i < 16; ++i) { const int kk = 4 * i + lr; const int sw = OUT8 ? (((kk >> 4) & 3) << 3) : (((kk >> 3) & 7) << 2); *(LAS f32x4*)(tl + kk * WT_PITCH + (lc ^ sw)) = v[i]; }
    asm volatile("s_waitcnt lgkmcnt(0)" ::: "memory");
    if constexpr (OUT8) {
        const int kq = lane & 3; f8_t* WTz = (f8_t*)WTv + (size_t)z * NP * K;
#pragma unroll
        for (int it = 0; it < 4; ++it) { const int nl = 16 * it + (lane >> 2), n = n0 + nl; const float s = (n < nscale) ? sc : 1.f;
            int nm = n; if (mode == 1) { const int up = n >> 10, jj = n & 1023; nm = (jj >> 7) * 256 + up * 128 + (jj & 127); }
            const LAS float* src = tl + (16 * kq) * WT_PITCH + (nl ^ (kq << 3));
            u32x4 w;
            w.x = pk4_fp8(src[0] * s, src[WT_PITCH] * s, src[2 * WT_PITCH] * s, src[3 * WT_PITCH] * s); w.y = pk4_fp8(src[4 * WT_PITCH] * s, src[5 * WT_PITCH] * s, src[6 * WT_PITCH] * s, src[7 * WT_PITCH] * s);
            w.z = pk4_fp8(src[8 * WT_PITCH] * s, src[9 * WT_PITCH] * s, src[10 * WT_PITCH] * s, src[11 * WT_PITCH] * s); w.w = pk4_fp8(src[12 * WT_PITCH] * s, src[13 * WT_PITCH] * s, src[14 * WT_PITCH] * s, src[15 * WT_PITCH] * s);
            if (dry) { asm volatile("" :: "v"(w)); continue; }
            *(u32x4*)(WTz + (size_t)nm * K + k0 + 16 * kq) = w; }
    } else {
        const int kq = lane & 7; bf16_t* WTz = (bf16_t*)WTv + (size_t)z * NP * K;
#pragma unroll
        for (int it = 0; it < 8; ++it) { const int nl = 8 * it + (lane >> 3), n = n0 + nl; const float s = (n < nscale) ? sc : 1.f;
            int nm = n; if (mode == 1) { const int up = n >> 10, jj = n & 1023; nm = (jj >> 7) * 256 + up * 128 + (jj & 127); }
            const LAS float* src = tl + (8 * kq) * WT_PITCH + (nl ^ (kq << 2));
            u32x4 w; w.x = pk2(src[0] * s, src[WT_PITCH] * s); w.y = pk2(src[2 * WT_PITCH] * s, src[3 * WT_PITCH] * s); w.z = pk2(src[4 * WT_PITCH] * s, src[5 * WT_PITCH] * s); w.w = pk2(src[6 * WT_PITCH] * s, src[7 * WT_PITCH] * s);
            *(u32x4*)(WTz + (size_t)nm * K + k0 + 8 * kq) = w; }
    }
    asm volatile("s_waitcnt lgkmcnt(0)" ::: "memory");
  }
}
struct Wt8 { const float* W; f8_t* WT; const float* gk; int K, N, nn, mode; };
__device__ __forceinline__ void wt8_load(f32x4 (&v)[16], const Wt8& J, int sid, int lane) {
    const int per = 8 * J.nn, z = sid / per, rem = sid % per, k0 = (rem / J.nn) * 128 + 16 * (lane >> 3), n0 = (rem % J.nn) * 32 + 4 * (lane & 7);
    const float* Wz = J.W + (size_t)z * J.K * J.N + (size_t)k0 * J.N + n0;
#pragma unroll
    for (int i = 0; i < 16; ++i) v[i] = __builtin_nontemporal_load((const f32x4*)(Wz + (size_t)i * J.N));
}
__device__ __forceinline__ void wt8_store(f32x4 (&v)[16], const Wt8& J, int sid, float sc, int lane) {
    const int per = 8 * J.nn, z = sid / per, rem = sid % per, k0 = (rem / J.nn) * 128 + 16 * (lane >> 3), n0 = (rem % J.nn) * 32 + 4 * (lane & 7);
    float g[16];
    if (J.gk) {
#pragma unroll
        for (int q = 0; q < 4; ++q) { const f32x4 g4 = *(const f32x4*)(J.gk + k0 + 4 * q); g[4 * q] = g4[0] * sc; g[4 * q + 1] = g4[1] * sc; g[4 * q + 2] = g4[2] * sc; g[4 * q + 3] = g4[3] * sc; }
    } else {
#pragma unroll
        for (int i = 0; i < 16; ++i) g[i] = sc; }
    f8_t* WTz = J.WT + (size_t)z * J.N * J.K + k0;
#pragma unroll
    for (int j = 0; j < 4; ++j) { const int n = n0 + j;
        int nm = n; if (J.mode == 1) { const int up = n >> 10, jj = n & 1023; nm = (jj >> 7) * 256 + up * 128 + (jj & 127); }
        u32x4 w;
        w.x = pk4_fp8(v[0][j] * g[0], v[1][j] * g[1], v[2][j] * g[2], v[3][j] * g[3]); w.y = pk4_fp8(v[4][j] * g[4], v[5][j] * g[5], v[6][j] * g[6], v[7][j] * g[7]);
        w.z = pk4_fp8(v[8][j] * g[8], v[9][j] * g[9], v[10][j] * g[10], v[11][j] * g[11]); w.w = pk4_fp8(v[12][j] * g[12], v[13][j] * g[13], v[14][j] * g[14], v[15][j] * g[15]);
        *(u32x4*)(WTz + (size_t)nm * J.K) = w; }
}
constexpr int CP_KX = 0  , CP_RED = 69632  , CP_HID = CP_RED + 32768  , CP_END = CP_HID + 8192 + 256, CP_POSB = CP_END  , CP_W2 = CP_POSB + 2048  ;
struct CmpArgs { const bf16_t* projb; const bf16_t* w1T; const float* posb; const float* w2; bf16_t* kc; bf16_t* vc; };
__device__ __forceinline__ void cmp_item(LAS unsigned char* lds, const CmpArgs& A, int item) {
    const int tid = tid_fresh(), wid = __builtin_amdgcn_readfirstlane(tid >> 6), lane = tid & 63, ql = lane & 31, h = lane >> 5;
    const int cblk = item & 3, kvh = (item >> 2) & 1, b = (item >> 3) & 7, j = item >> 6;
    __syncthreads();
    { const int tok0 = 512 * cblk; const bf16_t* src = A.projb + ((size_t)b * S + tok0) * PROJ_LD + 512 + j * 128 + kvh * 64;
      u32x4 v[9];
#pragma unroll
      for (int q = 0; q < 9; ++q) { const int i = tid + 512 * q, r = i >> 3, ch = i & 7; v[q] = (u32x4){0u, 0u, 0u, 0u};
          if (i < 528 * 8 && tok0 + r < S) v[q] = *(const u32x4*)(src + (size_t)r * PROJ_LD + ch * 8); }
#pragma unroll
      for (int q = 0; q < 9; ++q) { const int i = tid + 512 * q, r = i >> 3, ch = i & 7;
          if (i < 528 * 8) *(LAS u32x4*)(lds + CP_KX + r * 128 + ((ch ^ ((r >> 4) & 7)) << 4)) = v[q]; } }
    { float a = 0.f; const int g = tid >> 6, n = tid & 63;
#pragma unroll
      for (int sl = 0; sl < 8; ++sl) a += A.posb[(j * 64 + 8 * g + sl) * 64 + n];
      ((LAS float*)(lds + CP_POSB))[tid] = a;
      const f32x4 w0 = *(const f32x4*)(A.w2 + (size_t)j * 4096 + tid * 4), w1 = *(const f32x4*)(A.w2 + (size_t)j * 4096 + 2048 + tid * 4);
      *(LAS f32x4*)(lds + CP_W2 + tid * 16) = w0; *(LAS f32x4*)(lds + CP_W2 + 8192 + tid * 16) = w1; }
    __syncthreads();
    const int nb = wid & 1, kq = wid >> 1;
    f32x16 acc;
#pragma unroll
    for (int r = 0; r < 16; ++r) acc[r] = 0.f;
    const bf16_t* wfr = A.w1T + ((size_t)(((j * 4 + kq) * 2 + nb) * 8) * 4 * 64 + lane) * 8;
#pragma unroll
    for (int li = 0; li < 8; ++li) { const int l = 8 * kq + li;
#pragma unroll
        for (int s = 0; s < 4; ++s) {
            const int row = 16 * ql + l;
            const bf16x8 af = *(const LAS bf16x8*)(lds + CP_KX + row * 128 + (((2 * s + h) ^ ((row >> 4) & 7)) << 4));
            const bf16x8 bf = *(const bf16x8*)(wfr + (size_t)(li * 4 + s) * 512);
            acc = MFMA32(af, bf, acc); } }
    { LAS float* red = (LAS float*)(lds + CP_RED) + kq * 2048;
#pragma unroll
      for (int r = 0; r < 16; ++r) red[AT_CROW(r, h) * 64 + 32 * nb + ql] = acc[r]; }
    __syncthreads();
    { LAS float* red = (LAS float*)(lds + CP_RED); LAS float* hid = (LAS float*)(lds + CP_HID); const LAS float* pbp = (const LAS float*)(lds + CP_POSB) + (tid & 63);
      const float pbs = ((pbp[0] + pbp[64]) + (pbp[128] + pbp[192])) + ((pbp[256] + pbp[320]) + (pbp[384] + pbp[448]));
      for (int i = tid; i < 2048; i += 512) { const float a = (red[i] + red[2048 + i]) + (red[4096 + i] + red[6144 + i]) + pbs; hid[i] = a * __builtin_amdgcn_rcpf(1.f + __builtin_amdgcn_exp2f(-1.4426950408889634f * a)); } }
    __syncthreads();
    { const LAS float* hid = (const LAS float*)(lds + CP_HID); bf16_t* out = (j ? A.vc : A.kc) + (size_t)(b * 2 + kvh) * 128 * 64;
      for (int i = tid; i < 2048; i += 512) { const int cl = i >> 6, n2 = i & 63; float a = 0.f;
#pragma unroll 8
          for (int n = 0; n < 64; ++n) a += hid[cl * 64 + n] * ((const LAS float*)(lds + CP_W2))[n * 64 + n2];
          const int c = 32 * cblk + cl; out[c * 64 + n2] = (c < 127) ? f2bf(a) : (bf16_t)0; } }
}
constexpr int RP_STAGE = 0  , RP_PITCH = 2064, RP_PART = 0  , RP_HN = 0  , RP_HPITCH = 1040,
              RP_SSQ = 132096  , RP_RSTD = RP_SSQ + 2048, RP_LGT = RP_RSTD + 256  , RP_LCNT = RP_LGT + 128 * 36 * 4;
struct RouteArgs { const bf16_t* h1; const bf16_t* rws; const float* router_b; f8_t* hn8; int* cnt; int* list; float* wlist; int* tinfo; };
__device__ __forceinline__ void route_phase(LAS unsigned char* lds, const RouteArgs& A, int wg, int nwg) {
    const int tid = tid_fresh(), wid = __builtin_amdgcn_readfirstlane(tid >> 6), lane = tid & 63, ql = lane & 31, h = lane >> 5;
    LAS float* part = (LAS float*)(lds + RP_PART); LAS float* rstdv = (LAS float*)(lds + RP_RSTD);
    LAS float* lgt = (LAS float*)(lds + RP_LGT);
    LAS int* lcnt = (LAS int*)(lds + RP_LCNT); LAS int* gbase = lcnt + 32;
    const int ntl = (T - wg * 8 + nwg * 8 - 1) / (nwg * 8) * 8;
    __syncthreads();
    if (tid < 32) lcnt[tid] = 0;
    const int kof = 128 * wid + 64 * h;
#ifdef MK_RTX2
    for (int rep_ = 0; rep_ < 2; ++rep_)
#endif
    for (int g0 = 0; g0 < ntl; g0 += 64) {
#pragma unroll 1
        for (int i0 = 0; i0 < 8; i0 += 4) { u32x4 sv[4][2]; float sq[4];
#pragma unroll
          for (int i = 0; i < 4; ++i) { const int sl = g0 + 8 * wid + i0 + i; const int tok = wg * 8 + (sl & 7) + (sl >> 3) * nwg * 8; const bool ok = sl < ntl && tok < T;
#pragma unroll
              for (int hf = 0; hf < 2; ++hf) sv[i][hf] = ok ? *(const u32x4*)(A.h1 + (size_t)tok * D + hf * 512 + lane * 8) : (u32x4){0u, 0u, 0u, 0u}; }
#pragma unroll
          for (int i = 0; i < 4; ++i) { sq[i] = 0.f;
#pragma unroll
              for (int hf = 0; hf < 2; ++hf)
#pragma unroll
                  for (int c = 0; c < 4; ++c) { const unsigned u = sv[i][hf][c]; const float lo = __uint_as_float(u << 16), hi = __uint_as_float(u & 0xffff0000u); sq[i] += lo * lo + hi * hi; } }
#pragma unroll
          for (int o = 1; o < 64; o <<= 1) {
#pragma unroll
              for (int i = 0; i < 4; ++i) sq[i] += __shfl_xor(sq[i], o); }
#pragma unroll
          for (int i = 0; i < 4; ++i) { const int rl = 8 * wid + i0 + i, sl = g0 + rl; const int tok = wg * 8 + (sl & 7) + (sl >> 3) * nwg * 8; const bool ok = sl < ntl && tok < T;
              const float rs = rsqrtf(sq[i] * (1.f / 1024.f) + 1e-6f);
              if (lane == 0) rstdv[rl] = rs;
#pragma unroll
              for (int hf = 0; hf < 2; ++hf) { const u32x4 a = sv[i][hf];
                  *(LAS u32x4*)(lds + RP_STAGE + rl * RP_PITCH + hf * 1024 + lane * 16) = a;
                  if (ok) *(u32x2*)(A.hn8 + (size_t)tok * D + hf * 512 + lane * 8) = (u32x2){
                      pk4_fp8(__uint_as_float(a.x << 16) * rs, __uint_as_float(a.x & 0xffff0000u) * rs, __uint_as_float(a.y << 16) * rs, __uint_as_float(a.y & 0xffff0000u) * rs),
                      pk4_fp8(__uint_as_float(a.z << 16) * rs, __uint_as_float(a.z & 0xffff0000u) * rs, __uint_as_float(a.w << 16) * rs, __uint_as_float(a.w & 0xffff0000u) * rs)}; } } }
        __syncthreads();
        f32x16 acc[2];
#pragma unroll
        for (int r = 0; r < 16; ++r) { acc[0][r] = 0.f; acc[1][r] = 0.f; }
#pragma unroll
        for (int ks = 0; ks < 8; ++ks) {
            const bf16x8 a0 = *(const LAS bf16x8*)(lds + RP_STAGE + ql * RP_PITCH + (kof + 8 * ks) * 2), a1 = *(const LAS bf16x8*)(lds + RP_STAGE + (32 + ql) * RP_PITCH + (kof + 8 * ks) * 2);
#pragma unroll
            for (int tm = 0; tm < 3; ++tm) { const bf16x8 bfr = *(const bf16x8*)(A.rws + ((size_t)((wid * 8 + ks) * 3 + tm) * 64 + lane) * 8);
                acc[0] = MFMA32(a0, bfr, acc[0]); acc[1] = MFMA32(a1, bfr, acc[1]); } }
        __syncthreads();
#pragma unroll
        for (int mt = 0; mt < 2; ++mt)
#pragma unroll
            for (int r = 0; r < 16; ++r) part[(wid * 64 + 32 * mt + AT_CROW(r, h)) * 32 + ql] = acc[mt][r];
        __syncthreads();
        { const int row = tid >> 3, e4 = (tid & 7) * 4; f32x4 sum = (f32x4){0.f, 0.f, 0.f, 0.f};
#pragma unroll
          for (int w = 0; w < 8; ++w) sum += *(const LAS f32x4*)(part + (w * 64 + row) * 32 + e4);
          const float rs = rstdv[row]; const f32x4 bias = *(const f32x4*)(A.router_b + e4);
          if (g0 + row < 128) *(LAS f32x4*)(lgt + (g0 + row) * 36 + e4) = sum * rs + bias; }
        __syncthreads();
    }
    __syncthreads();
    int te[4] = {0, 0, 0, 0}, lp[4] = {0, 0, 0, 0}; float tw[4] = {0.f, 0.f, 0.f, 0.f};
    const int tmine = wg * 8 + (tid & 7) + (tid >> 3) * nwg * 8; const bool mine = tid < 128 && tid < ntl && tmine < T;
    if (mine) { float v[32];
#pragma unroll
        for (int e4 = 0; e4 < 8; ++e4) { const f32x4 q4 = *(const LAS f32x4*)(lgt + tid * 36 + e4 * 4); v[e4 * 4] = q4[0]; v[e4 * 4 + 1] = q4[1]; v[e4 * 4 + 2] = q4[2]; v[e4 * 4 + 3] = q4[3]; }
        float tv[4];
#pragma unroll
        for (int k = 0; k < 4; ++k) { float best = -INFINITY; int bi = 0;
#pragma unroll
            for (int e = 0; e < 32; ++e) { const bool bt = v[e] > best; best = bt ? v[e] : best; bi = bt ? e : bi; }
#pragma unroll
            for (int e = 0; e < 32; ++e) v[e] = (e == bi) ? -INFINITY : v[e];
            tv[k] = best; te[k] = bi; }
        const float e1 = __expf(tv[1] - tv[0]), e2 = __expf(tv[2] - tv[0]), e3 = __expf(tv[3] - tv[0]); const float inv = 1.f / (1.f + e1 + e2 + e3);
        tw[0] = inv; tw[1] = e1 * inv; tw[2] = e2 * inv; tw[3] = e3 * inv;
#pragma unroll
        for (int k = 0; k < 4; ++k) lp[k] = __hip_atomic_fetch_add(lcnt + te[k], 1, __ATOMIC_RELAXED, __HIP_MEMORY_SCOPE_WORKGROUP); }
    __syncthreads();
    if (tid < 32) gbase[tid] = (int)__hip_atomic_fetch_add((unsigned*)A.cnt + tid * CNT_STRIDE, (unsigned)lcnt[tid], __ATOMIC_RELAXED, __HIP_MEMORY_SCOPE_AGENT);
    __syncthreads();
    if (mine) {
#pragma unroll
        for (int k = 0; k < 4; ++k) { const int e = te[k], pos = gbase[e] + lp[k], tk = tmine * 4 + k;
            A.list[(size_t)e * T + pos] = tk; A.wlist[tk] = tw[k]; A.tinfo[tk] = e | (pos << 8); } }
}
struct CombArgs { const bf16_t* h1; const f8_t* y; const int* tinfo; const float* tw; const int* cnt; const float* g; float* out; int keep; };
__device__ __forceinline__ void combine_phase(LAS unsigned char* lds, const CombArgs& A, int wg, int nwg) {
    const int tid = tid_fresh(), wid = __builtin_amdgcn_readfirstlane(tid >> 6), lane = tid & 63;
    LAS int* toff = (LAS int*)(lds + (A.keep ? LDS_TOFF : LDS_MISC + 64));
    __syncthreads();
    if (!A.keep) {
    if (tid < 64) { const int n = (tid < NE) ? (A.cnt[tid * CNT_STRIDE] + 255) >> 8 : 0; int pre = n;
#pragma unroll
        for (int d = 1; d < 32; d <<= 1) { const int v = __shfl_up(pre, d, 64); if (tid >= d) pre += v; }
        if (tid < NE) toff[tid] = pre - n; }
    __syncthreads(); }
    f32x4 gv[4];
#pragma unroll
    for (int j = 0; j < 4; ++j) gv[j] = *(const f32x4*)(A.g + lane * 4 + 256 * j);
    for (int t = wg * 8 + wid; t < T; t += nwg * 8) {
        size_t so[4]; float tw[4];
#pragma unroll
        for (int k = 0; k < 4; ++k) { const int inf = A.tinfo[t * 4 + k]; so[k] = ((size_t)toff[inf & 255] * 256 + (inf >> 8)) * 1024; tw[k] = A.tw[t * 4 + k]; }
        f32x4 v[4]; float s = 0.f;
#pragma unroll
        for (int j = 0; j < 4; ++j) { { const u32x2 uh = *(const u32x2*)(A.h1 + (size_t)t * D + lane * 4 + 256 * j); v[j] = (f32x4){__uint_as_float(uh.x << 16), __uint_as_float(uh.x & 0xffff0000u), __uint_as_float(uh.y << 16), __uint_as_float(uh.y & 0xffff0000u)}; }
#pragma unroll
            for (int k = 0; k < 4; ++k) { const unsigned yy = *(const unsigned*)(A.y + so[k] + lane * 4 + 256 * j);
                const f2_t lo = __builtin_amdgcn_cvt_pk_f32_fp8((int)yy, false), hi = __builtin_amdgcn_cvt_pk_f32_fp8((int)yy, true);
                v[j][0] += tw[k] * lo[0]; v[j][1] += tw[k] * lo[1]; v[j][2] += tw[k] * hi[0]; v[j][3] += tw[k] * hi[1]; }
            s += (v[j][0] * v[j][0] + v[j][1] * v[j][1]) + (v[j][2] * v[j][2] + v[j][3] * v[j][3]); }
        s = wsum(s); const float rs = rsqrtf(s * (1.f / 1024.f) + 1e-6f);
#pragma unroll
        for (int j = 0; j < 4; ++j) *(f32x4*)(A.out + (size_t)t * D + lane * 4 + 256 * j) = v[j] * rs * gv[j];
    }
}
}
#define XB_TMO      128
#define XB_XCNT(j)  (256  + 64 * (j))
#define XB_XSUB(j)  (1280 + 64 * (j))
#define XB_XGEN(j)  (2304 + 64 * (j))
#define XB_TOP      3328
#define XB_TOPGEN   3392
#define XCD_BAR_WORDS 3456
#define XB_SPIN_CAP (1u << 18)
__device__ __forceinline__ unsigned xb_ld(unsigned* p)              { return __hip_atomic_load(p, __ATOMIC_RELAXED, __HIP_MEMORY_SCOPE_AGENT); }
__device__ __forceinline__ unsigned xb_add(unsigned* p, unsigned v) { return __hip_atomic_fetch_add(p, v, __ATOMIC_RELAXED, __HIP_MEMORY_SCOPE_AGENT); }
__device__ __forceinline__ unsigned xb_xcc_id() { return (unsigned)__builtin_amdgcn_s_getreg((3 << 11) | 20) & 0xFu; }
#define XB_SPIN(cond, bar) do { unsigned _sp = 0; while (cond) { __builtin_amdgcn_s_sleep(1); \
    if ((++_sp & 255u) == 0u) { if (xb_ld(&(bar)[XB_TMO])) break; if (_sp > XB_SPIN_CAP) { atomicAdd(&(bar)[XB_TMO], 1u); break; } } } } while (0)
struct XcdBarrier { unsigned* bar; unsigned x; volatile LAS unsigned* st; };
__device__ __forceinline__ XcdBarrier xcd_barrier_post(unsigned* bar, volatile LAS unsigned* st) {
    XcdBarrier b; b.bar = bar; b.x = xb_xcc_id(); b.st = st;
    if (threadIdx.x == 0) (void)xb_add(&bar[XB_XCNT(b.x)], 1u);
    return b;
}
__device__ __forceinline__ void xcd_barrier_complete(unsigned* bar, unsigned x, unsigned& nloc, unsigned& nx) {
    const unsigned G = gridDim.x * gridDim.y * gridDim.z;
    unsigned sum, cnt, mine, sp = 0u;
    for (;;) {
        sum = 0u; cnt = 0u; mine = 0u;
#pragma unroll
        for (unsigned j = 0; j < 16; ++j) { const unsigned c = xb_ld(&bar[XB_XCNT(j)]); sum += c; cnt += (c > 0u) ? 1u : 0u; mine = (j == x) ? c : mine; }
        if (sum == G) break;
        __builtin_amdgcn_s_sleep(1);
        if ((++sp & 255u) == 0u) { if (xb_ld(&bar[XB_TMO])) break; if (sp > XB_SPIN_CAP) { atomicAdd(&bar[XB_TMO], 1u); break; } }
    }
    nloc = mine > 0u ? mine : 1u; nx = cnt > 0u ? cnt : 1u;
}
__device__ __forceinline__ void xcd_barrier(const XcdBarrier& b) {
    asm volatile("s_waitcnt vmcnt(0)" ::: "memory");
    __syncthreads();
    if (threadIdx.x == 0) {
        unsigned* bar = b.bar;
        __builtin_amdgcn_s_waitcnt(0);
        unsigned nloc = b.st[0], nx = b.st[1];
        if (nloc == 0u) { xcd_barrier_complete(bar, b.x, nloc, nx); b.st[0] = nloc; b.st[1] = nx; }
        const unsigned old = xb_add(&bar[XB_XSUB(b.x)], 1u);
        const unsigned gen = old / nloc;
        if (old + 1u == (gen + 1u) * nloc) {
            __builtin_amdgcn_fence(__ATOMIC_RELEASE, "agent");
            asm volatile("s_waitcnt vmcnt(0)" ::: "memory");
            const unsigned og = xb_add(&bar[XB_TOP], 1u);
            const unsigned tg = og / nx;
            if (og + 1u == (tg + 1u) * nx) xb_add(&bar[XB_TOPGEN], 1u);
            else XB_SPIN(xb_ld(&bar[XB_TOPGEN]) == tg, bar);
            __builtin_amdgcn_fence(__ATOMIC_ACQUIRE, "agent");
            xb_add(&bar[XB_XGEN(b.x)], 1u);
            asm volatile("s_waitcnt vmcnt(0)" ::: "memory");
        } else {
            XB_SPIN(xb_ld(&bar[XB_XGEN(b.x)]) == gen, bar);
            __builtin_amdgcn_fence(__ATOMIC_ACQUIRE, "agent");
            asm volatile("s_waitcnt vmcnt(0)" ::: "memory");
        }
    }
    __syncthreads();
}

namespace mk {
constexpr int LDS_BAR = 159744, LDS_FUSED = LDS_BAR + 256;
constexpr int CTL_QUEUE = 4096;
struct Params {
    const float *x, *attn_norm, *w_in, *rel_bias, *cmp_pos, *cmp_w1, *cmp_w2, *attn_out_norm, *conv_w, *conv_b, *dt_bias, *a_log, *d_skip, *ssm_out_norm, *w_out, *ffn_norm,
                *router_w, *router_b, *w_gu, *b_gu, *w_dn, *b_dn, *final_norm;
    float* out; unsigned* ctl; int* cnt;
    bf16_t *xb, *WinT, *WoutT, *w1T, *projb, *catb, *kc, *vc, *states, *rws; f8_t *WguT, *WdnT, *hn8, *act, *ymoe;
    float *posb, *alast, *wlist, *ssq; bf16_t* h1; int *list, *tinfo;
    int ph_lo, ph_hi;
};
constexpr int NT_WIN = 48 * 16, NT_WOUT = 16 * 16, NT_WGU = 32 * 32 * 8, NT_WDN = 32 * 16 * 8, NT_W1 = 512  , NT_ALL = NT_WIN + NT_WOUT + NT_WGU + NT_WDN + NT_W1;
__device__ __forceinline__ void p0_prologue(LAS unsigned char* lds, const Params& p, int wg, int nwg, int part, bool dry = false) {
    const int tid = tid_fresh(), wid = __builtin_amdgcn_readfirstlane(tid >> 6), lane = tid & 63;
    LAS float* tl = (LAS float*)(lds + wid * WT_TILE_BYTES);
    if (part == 0) {
    for (int r = (wg * 8 + wid) * 4; r < T; r += 4 * nwg * 8) rms_rows_bf16<4>(p.x, p.xb, r, lane);
    for (int o = wg * 8 + wid; o < 128; o += nwg * 8) { const int j = o >> 6, sl = o & 63; float s = 0.f;
#pragma unroll
        for (int kk = 0; kk < 32; ++kk) { const int k = sl * 32 + kk; s += p.cmp_pos[j * 2048 + k] * p.cmp_w1[((size_t)j * 2048 + k) * 64 + lane]; }
        p.posb[o * 64 + lane] = s; }
    for (int o = (nwg - 1 - wg) * 8 + wid; o < 512; o += nwg * 8) {
        const int e = o >> 4, k = (o & 15) * 64 + lane; const float v = p.router_w[k * NE + e] * p.ffn_norm[k];
        const bf16_t b0 = f2bf(v); const float r1 = v - bf2f(b0); const bf16_t b1 = f2bf(r1); const float r2 = r1 - bf2f(b1); const bf16_t b2 = f2bf(r2);
        const int fw = k >> 7, fh = (k >> 6) & 1, fks = (k >> 3) & 7, fj = k & 7;
        const size_t fb = ((size_t)((fw * 8 + fks) * 3) * 64 + fh * 32 + e) * 8 + fj;
        p.rws[fb] = b0; p.rws[fb + 512] = b1; p.rws[fb + 1024] = b2; }
    __syncthreads();
    for (int task = wg * 8 + wid; task < NT_WIN + NT_WOUT + NT_W1; task += nwg * 8) { int idx = task;
        if (idx < NT_WIN) { wt_tile<false>(dry, p.w_in, p.WinT, p.attn_norm, p.attn_norm, 1024, 1024, 2848, 3072, 0, 512, 0.125f * LOG2E, 48, 16, idx, tl, lane); continue; } idx -= NT_WIN;
        if (idx < NT_WOUT) { wt_tile<false>(dry, p.w_out, p.WoutT, p.attn_out_norm, p.ssm_out_norm, 512, 1024, 1024, 1024, 0, 0, 1.f, 16, 16, idx, tl, lane); continue; } idx -= NT_WOUT;
        {
            const int s4 = idx & 3, li = (idx >> 2) & 7, nb = (idx >> 5) & 1, kq = (idx >> 6) & 3, j = idx >> 8, ql = lane & 31, hh = lane >> 5;
            const float* src = p.cmp_w1 + ((size_t)j * 2048 + (size_t)(8 * kq + li) * 64 + 16 * s4 + 8 * hh) * 64 + 32 * nb + ql; float v[8];
#pragma unroll
            for (int i = 0; i < 8; ++i) v[i] = src[i * 64];
            *(u32x4*)(p.w1T + ((size_t)idx * 64 + lane) * 8) = (u32x4){pk2(v[0], v[1]), pk2(v[2], v[3]), pk2(v[4], v[5]), pk2(v[6], v[7])}; } }
    } else {
    __syncthreads();
    for (int task = wg * 8 + wid; task < NT_WGU + NT_WDN; task += nwg * 8) { int idx = task;
        if (idx < NT_WGU) { wt_tile<true>(dry, p.w_gu, p.WguT, p.ffn_norm, p.ffn_norm, 1024, 1024, 2048, 2048, 1, 2048, W8_SCALE, 32, 8, idx, tl, lane); continue; } idx -= NT_WGU;
        wt_tile<true>(dry, p.w_dn, p.WdnT, nullptr, nullptr, 0, 1024, 1024, 1024, 0, 1024, W8_SCALE, 16, 8, idx, tl, lane); }
    __syncthreads();
    }
}

__device__ __forceinline__ void cvt_task_gu(LAS unsigned char* lds, const Params& p, int task, int wid, int lane) {
    wt_tile<true>(false, p.w_gu, p.WguT, p.ffn_norm, p.ffn_norm, 1024, 1024, 2048, 2048, 1, 2048, W8_SCALE, 32, 8, task, (LAS float*)(lds + wid * WT_TILE_BYTES), lane); }
__device__ __forceinline__ void cvt_task_dn(LAS unsigned char* lds, const Params& p, int task, int wid, int lane) {
    wt_tile<true>(false, p.w_dn, p.WdnT, nullptr, nullptr, 0, 1024, 1024, 1024, 0, 1024, W8_SCALE, 16, 8, task, (LAS float*)(lds + wid * WT_TILE_BYTES), lane); }

#define MK_PHASE_FN __device__ __forceinline__
MK_PHASE_FN void ph_proj(LAS unsigned char* lds, const bf16_t* xb, const bf16_t* WinT, bf16_t* projb, int wg, int nwg) {
    ProbProj P; P.S.init(T, NPROJ, nwg, wg); P.A = xb; P.Bt = WinT; P.O = projb; gemm_phase(lds, P); }
MK_PHASE_FN void ph_out(LAS unsigned char* lds, const bf16_t* catb, const bf16_t* WoutT, const float* x, bf16_t* h1, const float* ssq, int wg, int nwg) {
    ProbOut P; P.S.init(T, D, nwg, wg); P.A = catb; P.Bt = WoutT; P.R0 = x; P.O = h1; P.ssq = ssq; gemm_phase(lds, P); }
__global__ void __launch_bounds__(512, 2) k_fused(Params p) {
    extern __shared__ __attribute__((aligned(16))) unsigned char dl[];
    LAS unsigned char* lds = (LAS unsigned char*)dl;
    const int wg = blockIdx.x, nwg = gridDim.x; int tid = tid_fresh();
    if (tid < 64) ((LAS unsigned*)(lds + LDS_BAR))[tid] = 0u;
    __syncthreads();
    XcdBarrier bar = xcd_barrier_post(p.ctl, (volatile LAS unsigned*)(lds + LDS_BAR));
#ifdef MK_ONLY
#define PH(k) ((k) == MK_ONLY && p.ph_lo <= (k) && (k) < p.ph_hi)
#else
#define PH(k) (p.ph_lo <= (k) && (k) < p.ph_hi)
#endif
#ifdef MK_REPEAT
#define REP(k) for (int _rep = 0; _rep < ((k) == MK_REPEAT ? 2 : 1); ++_rep)
#else
#define REP(k)
#endif
#ifdef MK_REPEAT
#define QREP _rep
#else
#define QREP 0
#endif
#ifdef MK_BARX2
#define SEAM(k) do { if (PH(k) && PH((k) + 1)) { xcd_barrier(bar); xcd_barrier(bar); } } while (0)
#else
#define SEAM(k) do { if (PH(k) && PH((k) + 1)) xcd_barrier(bar); } while (0)
#endif
    if (PH(0)) { p0_prologue(lds, p, wg, nwg, 0); }
    SEAM(0);
    REP(1) if (PH(1)) ph_proj(lds, p.xb, p.WinT, p.projb, wg, nwg);
    SEAM(1);
    REP(2) if (PH(2)) {
        const SsdArgs SA{p.projb, p.conv_w, p.conv_b, p.dt_bias, p.a_log, p.d_skip, p.states, p.alast, p.catb};
        const CmpArgs CA{p.projb, p.w1T, p.posb, p.cmp_w2, p.kc, p.vc};
        for (int it = wg; it < 384; it += nwg) { const int v = 383 - it; if (v < 128) cmp_item(lds, CA, v); else ssd_a_item(lds, SA, v - 128); }
        if (nwg == 256 && wg >= 128) {
            const int t2 = tid_fresh(), w2 = __builtin_amdgcn_readfirstlane(t2 >> 6), l2 = t2 & 63; const Wt8 JD{p.w_dn, p.WdnT, nullptr, 1024, 1024, 32, 0};
            const int gd = (wg - 128) * 32 + 4 * w2; f32x4 va[16], vb[16];
            wt8_load(va, JD, gd, l2); wt8_load(vb, JD, gd + 1, l2);
            wt8_store(va, JD, gd, W8_SCALE, l2); wt8_load(va, JD, gd + 2, l2);
            wt8_store(vb, JD, gd + 1, W8_SCALE, l2); wt8_load(vb, JD, gd + 3, l2);
            wt8_store(va, JD, gd + 2, W8_SCALE, l2); wt8_store(vb, JD, gd + 3, W8_SCALE, l2); }
    }
    SEAM(2);
    REP(3) if (PH(3)) {
        const SsdArgs SA{p.projb, p.conv_w, p.conv_b, p.dt_bias, p.a_log, p.d_skip, p.states, p.alast, p.catb};
        const AttnArgs AA{p.projb, p.kc, p.vc, p.catb, p.ssq};
        bool btab_ok = false;
        LAS int* qslot = (LAS int*)(lds + LDS_BAR + 64);
        bool first = true, pre = false;
        for (;;) {
            int it;
            if (first) { it = wg; first = false; }
            else {
                __syncthreads();
                if (!pre) { if (tid_fresh() == 0) qslot[0] = (int)__hip_atomic_fetch_add(p.ctl + CTL_QUEUE + 64 * QREP, 1u, __ATOMIC_RELAXED, __HIP_MEMORY_SCOPE_AGENT);
                            __syncthreads(); }
                it = qslot[0] + nwg; pre = false; }
#if defined(MK_QX_ATTN)
            if (it >= 768 + 512) break;
            { const int i2 = it >= 768 ? it - 768 : it; if (i2 < 512) { if (!btab_ok) { attn_btab(lds, p.rel_bias); btab_ok = true; } attn_item(lds, AA, i2 & 7, 31 - (i2 >> 4), (i2 >> 3) & 1); } else { ssd_b_item(lds, SA, i2 - 512, [](){}); btab_ok = false; } }
#elif defined(MK_QX_SSDB)
            if (it >= 768 + 256) break;
            { const int i2 = it >= 768 ? it - 256 : it; if (i2 < 512) attn_item(lds, AA, i2 & 7, 31 - (i2 >> 4), (i2 >> 3) & 1); else ssd_b_item(lds, SA, i2 - 512, [](){}); }
#else
#if defined(MK_QX_BOTH)
            if (it >= 1536) break;
            { const int i2 = it >= 768 ? it - 768 : it; if (i2 < 512) { if (!btab_ok) { attn_btab(lds, p.rel_bias); btab_ok = true; } attn_item(lds, AA, i2 & 7, 31 - (i2 >> 4), (i2 >> 3) & 1); } else { ssd_b_item(lds, SA, i2 - 512, [](){}); btab_ok = false; } }
#else
            if (it >= 768) break;
            if (it < 512) { if (!btab_ok) { attn_btab(lds, p.rel_bias); btab_ok = true; } attn_item(lds, AA, it & 7, 31 - (it >> 4), (it >> 3) & 1);
                { const int t3 = tid_fresh(), w3 = __builtin_amdgcn_readfirstlane(t3 >> 6);
                  const int l3 = t3 & 63;
                  const Wt8 JG{p.w_gu, p.WguT, p.ffn_norm, 1024, 2048, 64, 1}, JD{p.w_dn, p.WdnT, nullptr, 1024, 1024, 32, 0};
                  const int ga = it * 32 + 4 * w3, gd = 4096 + it * 8 + w3;
                  f32x4 va[16], vb[16];
                  wt8_load(va, JG, ga, l3); wt8_load(vb, JG, ga + 1, l3);
                  wt8_store(va, JG, ga, W8_SCALE, l3); wt8_load(va, JG, ga + 2, l3);
                  wt8_store(vb, JG, ga + 1, W8_SCALE, l3); wt8_load(vb, JG, ga + 3, l3);
                  wt8_store(va, JG, ga + 2, W8_SCALE, l3); wt8_load(va, JD, gd, l3);
                  wt8_store(vb, JG, ga + 3, W8_SCALE, l3); wt8_store(va, JD, gd, W8_SCALE, l3); }
            } else { unsigned nxq = 0u;
                ssd_b_item(lds, SA, it - 512, [&]() { if (tid_fresh() == 0) nxq = __hip_atomic_fetch_add(p.ctl + CTL_QUEUE + 64 * QREP, 1u, __ATOMIC_RELAXED, __HIP_MEMORY_SCOPE_AGENT); });
                if (tid_fresh() == 0) qslot[0] = (int)nxq; pre = true; btab_ok = false; }
#endif
#endif
        }
    }
    SEAM(3);
    REP(4) if (PH(4)) ph_out(lds, p.catb, p.WoutT, p.x, p.h1, p.ssq, wg, nwg);
    SEAM(4);
    REP(5) if (PH(5)) {
        if (nwg != 256) {
            const int t5 = tid_fresh(), w5 = __builtin_amdgcn_readfirstlane(t5 >> 6), l5 = t5 & 63; const Wt8 JD{p.w_dn, p.WdnT, nullptr, 1024, 1024, 32, 0};
            for (int sid = wg * 8 + w5; sid < 4096; sid += nwg * 8) { f32x4 va[16]; wt8_load(va, JD, sid, l5); wt8_store(va, JD, sid, W8_SCALE, l5); } }
        const bool dm = QREP != 0; const RouteArgs RA{p.h1, p.rws, p.router_b, p.hn8, dm ? p.cnt + 2048 : p.cnt, dm ? (int*)p.act : p.list, dm ? (float*)p.act + (4u << 20) : p.wlist, dm ? (int*)p.act + (8u << 20) : p.tinfo}; route_phase(lds, RA, wg, nwg); }
    SEAM(5);
    REP(6) if (PH(6)) {
        tid = tid_fresh();
        __syncthreads();
        const int RT = moe_tables(lds, p.cnt);
        ProbMoe1 P; P.S.nN = 8; P.S.G = nwg; P.S.c = (nwg % 8 == 0) ? (wg & 7) * (nwg >> 3) + (wg >> 3) : wg; P.S.RT = RT; P.S.tile_e = (const LAS int*)(lds + LDS_TILE_E); P.S.tile_m = (const LAS int*)(lds + LDS_TILE_M);
        P.A = p.hn8; P.Bt = p.WguT; P.btab = (const LAS float*)(lds + LDS_BIASTAB); P.O = p.act; P.rowtab = (const LAS unsigned*)(lds + LDS_ROWTAB);
        LAS unsigned* rowtab = (LAS unsigned*)(lds + LDS_ROWTAB);
        {
            const LAS int* lcnt = (const LAS int*)(lds + LDS_CNT); int tokv[12]; float bv[12];
#pragma unroll
            for (int i = 0; i < 12; ++i) { Unit u; tokv[i] = 0; bv[i] = 0.f; if (P.S.next(i, u)) {
                if (tid < 256) { const int pos = u.mt * 256 + tid; if (pos < lcnt[u.e]) tokv[i] = p.list[(size_t)u.e * T + pos] >> 2; }
                else { const int j = tid - 256; bv[i] = p.b_gu[u.e * 2048 + (j >> 7) * 1024 + u.pn * 128 + (j & 127)]; } } }
#pragma unroll
            for (int i = 0; i < 12; ++i) { if (tid < 256) rowtab[i * 256 + tid] = (unsigned)tokv[i] * KD; else ((LAS float*)(lds + LDS_BIASTAB))[i * 256 + tid - 256] = bv[i]; }
        }
        __syncthreads();
        gemm_phase(lds, P);
    }
    SEAM(6);
    REP(7) if (PH(7)) {
        __syncthreads();
        const int RT = (p.ph_lo <= 6) ? ((const LAS int*)(lds + LDS_MISC + 32))[0] : moe_tables(lds, p.cnt);
        ProbMoe2 P; P.S.nN = 4; P.S.G = nwg; P.S.c = (nwg % 8 == 0) ? (wg & 7) * (nwg >> 3) + (wg >> 3) : wg; P.S.RT = RT; P.S.tile_e = (const LAS int*)(lds + LDS_TILE_E); P.S.tile_m = (const LAS int*)(lds + LDS_TILE_M);
        P.A = p.act; P.Bt = p.WdnT; P.btab = (const LAS float*)(lds + LDS_BIASTAB); P.O = p.ymoe;
        { const int t7 = tid_fresh(); float bv[12];
#pragma unroll
            for (int i = 0; i < 12; ++i) { Unit u; bv[i] = 0.f; if (t7 < 256 && P.S.next(i, u)) bv[i] = p.b_dn[u.e * 1024 + u.pn * 256 + t7]; }
#pragma unroll
            for (int i = 0; i < 12; ++i) if (t7 < 256) ((LAS float*)(lds + LDS_BIASTAB))[i * 256 + t7] = bv[i]; }
        __syncthreads();
        gemm_phase(lds, P);
    }
    SEAM(7);
    REP(8) if (PH(8)) { const CombArgs CA{p.h1, p.ymoe, p.tinfo, p.wlist, p.cnt, p.final_norm, p.out, (p.ph_lo <= 6) ? 1 : 0}; combine_phase(lds, CA, wg, nwg); }
#undef PH
#undef SEAM
}
}

extern "C" void kernel_launch(void* const* d_in, const int* in_sizes, int n_in, void* d_out, int out_size, void* d_ws, size_t ws_size, hipStream_t stream) {
    using namespace mk;
    char* ws = (char*)d_ws; const size_t MB = 1u << 20;
    size_t o = 0; auto take = [&](size_t mb) { char* q = ws + o; o += mb * MB; return q; };
    Params p;
    memset(&p, 0, sizeof(p));
    const float** fin = (const float**)&p.x;
    for (int i = 0; i < 23; ++i) fin[i] = (const float*)d_in[i];
    p.out = (float*)d_out;
    p.ctl = (unsigned*)take(1); p.cnt = (int*)(p.ctl + 8192);
    p.xb = (bf16_t*)take(32); p.WinT = (bf16_t*)take(6); p.WoutT = (bf16_t*)take(2); p.WguT = (f8_t*)take(64); p.WdnT = (f8_t*)take(32); p.w1T = (bf16_t*)take(1);
    p.projb = (bf16_t*)take(96); p.catb = (bf16_t*)take(32); p.hn8 = (f8_t*)take(16); p.kc = (bf16_t*)take(1); p.vc = (bf16_t*)take(1); p.states = (bf16_t*)take(16); p.rws = (bf16_t*)take(1);
    p.act = (f8_t*)take(72); p.ymoe = (f8_t*)take(72);
    p.posb = (float*)take(1); p.alast = (float*)take(1); p.ssq = (float*)take(1); p.h1 = (bf16_t*)take(32); p.wlist = (float*)take(2); p.list = (int*)take(2); p.tinfo = (int*)take(1);
    static int grid = 0;
    if (!grid) {
        int dev = 0, cus = 0, per_cu = 0;
        (void)hipGetDevice(&dev); (void)hipDeviceGetAttribute(&cus, hipDeviceAttributeMultiprocessorCount, dev);
        (void)hipFuncSetAttribute((const void*)k_fused, hipFuncAttributeMaxDynamicSharedMemorySize, LDS_FUSED);
        (void)hipOccupancyMaxActiveBlocksPerMultiprocessor(&per_cu, (const void*)k_fused, 512, LDS_FUSED);
        (void)hipGetLastError();
        grid = cus > 0 ? cus : 256;
    }
    (void)hipMemsetAsync(p.ctl, 0, 65536, stream);
#ifndef MK_SPLIT
    p.ph_lo = 0; p.ph_hi = 9;
    hipLaunchKernelGGL(k_fused, dim3(grid), dim3(512), LDS_FUSED, stream, p);
#else
    for (int k = 0; k < 9; ++k) { p.ph_lo = k; p.ph_hi = k + 1; hipLaunchKernelGGL(k_fused, dim3(grid), dim3(512), LDS_FUSED, stream, p); }
#endif
}
```
